# Optimizing an MI355X kernel written in HIP

```python
import jax
import jax.numpy as jnp
from jax import lax
import numpy as np

D_MODEL = 1024
BATCH = 1
SEQ = 16384
DEPTH = 2

GRID_W = 64
CTX_LEN = 256
N_MIXERS = 2
N_MOD = 6
EPS = 1e-6

D_RNN = 1280
RG_BLOCKS = 10
RG_BLOCK_W = D_RNN // RG_BLOCKS
CONV_W = 4
CONV_PAD_L = 2
CONV_PAD_R = CONV_W - 1 - CONV_PAD_L
RG_C = 8.0
RG_A_MIN = 0.9
RG_A_MAX = 0.999

ML_HEADS = 8
ML_DQK = D_MODEL // (2 * ML_HEADS)
ML_DV = D_MODEL // ML_HEADS
ML_CHUNK = 64
ML_QK_W = ML_HEADS * ML_DQK
ML_V_W = ML_HEADS * ML_DV
ML_IN_W = 2 * ML_QK_W + ML_V_W + D_MODEL + 4 * ML_HEADS
ML_FGATE_BIAS_LO = 3.0
ML_FGATE_BIAS_HI = 6.0

N_GROUPS = 4
EXPERTS_PER_GROUP = 8
N_EXPERTS = N_GROUPS * EXPERTS_PER_GROUP
TOP_K = 2
D_EXPERT = 512
MOE_BLOCK = 128

kernel_name = 'bidir_rglru_mlstm_hier_moe_prefix_dit'


def rms_norm(x, g):
    xf = x.astype(jnp.float32)
    y = xf * lax.rsqrt(jnp.mean(xf * xf, axis=-1, keepdims=True) + EPS)
    return (y * g.astype(jnp.float32)).astype(x.dtype)


def modulate(h, shift, scale):
    return h * (1.0 + scale) + shift


def adaln(cond, w, b):
    m = jax.nn.silu(cond) @ w + b
    return jnp.split(m, N_MOD, axis=-1)


def to_colmajor(t, rows):
    b, n, d = t.shape
    return t.reshape(b, rows, GRID_W, d).transpose(0, 2, 1, 3).reshape(b, n, d)


def from_colmajor(t, rows):
    b, n, d = t.shape
    return t.reshape(b, GRID_W, rows, d).transpose(0, 2, 1, 3).reshape(b, n, d)


def centred_dwconv(u, w, bias):
    n = u.shape[1]
    up = jnp.pad(u, ((0, 0), (CONV_PAD_L, CONV_PAD_R), (0, 0)))
    out = bias + up[:, 0:n] * w[0]
    for j in range(1, CONV_W):
        out = out + up[:, j:j + n] * w[j]
    return out


def rglru_coeffs(u, w_a, b_a, w_x, b_x, lam):
    b, n, _ = u.shape
    uf = u.astype(jnp.float32)
    ub = uf.reshape(b, n, RG_BLOCKS, RG_BLOCK_W)
    r = jax.nn.sigmoid(jnp.einsum('bnhi,hij->bnhj', ub, w_a.astype(jnp.float32)).reshape(b, n, D_RNN) + b_a.astype(jnp.float32))
    ig = jax.nn.sigmoid(jnp.einsum('bnhi,hij->bnhj', ub, w_x.astype(jnp.float32)).reshape(b, n, D_RNN) + b_x.astype(jnp.float32))
    log_a = -RG_C * r * jax.nn.softplus(-lam.astype(jnp.float32))
    a = jnp.exp(log_a)
    return a, jnp.sqrt(-jnp.expm1(2.0 * log_a)) * ig * uf


def linear_scan(a, b, h0, reverse):
    def combine(left, right):
        a_l, b_l = left
        a_r, b_r = right
        return a_l * a_r, a_r * b_l + b_r
    a_cum, b_cum = lax.associative_scan(combine, (a, b), reverse=reverse, axis=1)
    return b_cum + a_cum * h0[:, None, :]


def rglru_mixer(h, hc, w_in, conv_w, conv_b, w_a, b_a, w_x, b_x, lam, w_out, ctx_out):
    px = h @ w_in
    pc = hc @ w_in
    ux = centred_dwconv(px[..., D_RNN:], conv_w, conv_b)
    uc = centred_dwconv(pc[..., D_RNN:], conv_w, conv_b)
    zero = jnp.zeros((h.shape[0], D_RNN), jnp.float32)
    hx_dirs = []
    hc_dirs = []
    for d in range(2):
        rev = d == 1
        a_c, b_c = rglru_coeffs(uc, w_a[d], b_a[d], w_x[d], b_x[d], lam[d])
        hcd = linear_scan(a_c, b_c, zero, rev)
        h0 = hcd[:, 0] if rev else hcd[:, -1]
        a_l, b_l = rglru_coeffs(ux, w_a[d], b_a[d], w_x[d], b_x[d], lam[d])
        hx_dirs.append(linear_scan(a_l, b_l, h0, rev))
        hc_dirs.append(hcd)
    y_x = (jax.nn.gelu(px[..., :D_RNN]) * (hx_dirs[0] + hx_dirs[1]).astype(h.dtype)) @ w_out
    y_c = None
    if ctx_out:
        y_c = (jax.nn.gelu(pc[..., :D_RNN]) * (hc_dirs[0] + hc_dirs[1]).astype(h.dtype)) @ w_out
    return y_x, y_c


def mlstm_chunkwise(q, k, v, log_i, log_f, state):
    b, nh, n, _ = q.shape
    dv = v.shape[-1]
    nc = n // ML_CHUNK

    def chunks(t):
        return jnp.moveaxis(t.reshape((b, nh, nc, ML_CHUNK) + t.shape[3:]), 2, 0)

    lower = jnp.tril(jnp.ones((ML_CHUNK, ML_CHUNK), dtype=bool))

    def step(carry, inp):
        c_mat, n_vec, m = carry
        qc, kc, vc, li, lf = inp
        cum_f = jnp.cumsum(lf, axis=-1)
        log_w = jnp.where(lower, cum_f[..., :, None] - cum_f[..., None, :] + li[..., None, :], -jnp.inf)
        log_inter = cum_f + m[..., None]
        m_t = jnp.maximum(log_inter, jnp.max(log_w, axis=-1))
        w_intra = jnp.exp(log_w - m_t[..., None])
        w_inter = jnp.exp(log_inter - m_t)
        s = jnp.einsum('bhtd,bhsd->bhts', qc, kc) * w_intra
        num = w_inter[..., None] * jnp.einsum('bhtd,bhde->bhte', qc, c_mat) + jnp.einsum('bhts,bhse->bhte', s, vc)
        den = w_inter * jnp.einsum('bhtd,bhd->bht', qc, n_vec) + jnp.sum(s, axis=-1)
        h_out = num / jnp.maximum(jnp.abs(den), jnp.exp(-m_t))[..., None]
        m_new = m_t[..., -1]
        w_state = jnp.exp(cum_f[..., -1:] - cum_f + li - m_new[..., None])
        decay = jnp.exp(cum_f[..., -1] + m - m_new)
        kw = kc * w_state[..., None]
        c_new = decay[..., None, None] * c_mat + jnp.einsum('bhsd,bhse->bhde', kw, vc)
        n_new = decay[..., None] * n_vec + jnp.sum(kw, axis=2)
        return (c_new, n_new, m_new), h_out

    final, hs = lax.scan(step, state, (chunks(q), chunks(k), chunks(v), chunks(log_i), chunks(log_f)))
    return jnp.moveaxis(hs, 0, 2).reshape(b, nh, n, dv), final


def mlstm_mixer(h, hc, w_in, b_gates, norm_g, w_out, ctx_out):
    rows = h.shape[1] // GRID_W

    def project(t):
        p = (t @ w_in).astype(jnp.float32)
        b, n, _ = p.shape

        def heads(cols, dh):
            return cols.reshape(b, n, ML_HEADS, dh).transpose(0, 2, 1, 3)

        q = heads(p[..., :ML_QK_W], ML_DQK) * (ML_DQK ** -0.5)
        k = heads(p[..., ML_QK_W:2 * ML_QK_W], ML_DQK)
        v = heads(p[..., 2 * ML_QK_W:2 * ML_QK_W + ML_V_W], ML_DV)
        o = p[..., 2 * ML_QK_W + ML_V_W:2 * ML_QK_W + ML_V_W + D_MODEL]
        g = (p[..., ML_IN_W - 4 * ML_HEADS:] + b_gates.astype(jnp.float32)).reshape(b, n, 4, ML_HEADS).transpose(2, 0, 3, 1)
        return q, k, v, o, g

    qx, kx, vx, ox, gx = project(to_colmajor(h, rows))
    qc, kc, vc, oc, gc = project(hc)
    b = h.shape[0]
    zero = (jnp.zeros((b, ML_HEADS, ML_DQK, ML_DV), jnp.float32),
            jnp.zeros((b, ML_HEADS, ML_DQK), jnp.float32),
            jnp.zeros((b, ML_HEADS), jnp.float32))

    def flip(t):
        return jnp.flip(t, axis=2)

    hc_f, st_f = mlstm_chunkwise(qc, kc, vc, gc[0], jax.nn.log_sigmoid(gc[1]), zero)
    hx_f, _ = mlstm_chunkwise(qx, kx, vx, gx[0], jax.nn.log_sigmoid(gx[1]), st_f)
    hc_b, st_b = mlstm_chunkwise(flip(qc), flip(kc), flip(vc), flip(gc[2]), flip(jax.nn.log_sigmoid(gc[3])), zero)
    hx_b, _ = mlstm_chunkwise(flip(qx), flip(kx), flip(vx), flip(gx[2]), flip(jax.nn.log_sigmoid(gx[3])), st_b)

    def finish(h_f, h_b, o):
        hs = (h_f + h_b).transpose(0, 2, 1, 3)
        hn = hs * lax.rsqrt(jnp.mean(hs * hs, axis=-1, keepdims=True) + EPS) * norm_g.astype(jnp.float32).reshape(ML_HEADS, ML_DV)
        bb, n = hn.shape[:2]
        return (hn.reshape(bb, n, ML_V_W) * jax.nn.sigmoid(o)).astype(h.dtype) @ w_out

    y_x = from_colmajor(finish(hx_f, flip(hx_b), ox), rows)
    y_c = finish(hc_f, flip(hc_b), oc) if ctx_out else None
    return y_x, y_c


def hier_moe(h, w_grp, b_grp, w_exp, b_exp, w_gate, w_up, w_down):
    t_count, d = h.shape
    hf = h.astype(jnp.float32)
    grp_logits = hf @ w_grp.astype(jnp.float32) + b_grp.astype(jnp.float32)
    p_grp = jax.nn.softmax(grp_logits, axis=-1)
    _, grp = lax.top_k(grp_logits, 1)
    p_sel = jnp.take_along_axis(p_grp, grp, axis=-1)
    exp_logits = (hf @ w_exp.astype(jnp.float32) + b_exp.astype(jnp.float32)).reshape(t_count, N_GROUPS, EXPERTS_PER_GROUP)
    in_grp = jnp.take_along_axis(exp_logits, grp[:, :, None], axis=1)[:, 0]
    top_v, top_i = lax.top_k(in_grp, TOP_K)
    wts = jax.nn.softmax(top_v, axis=-1) * p_sel
    eid = grp * EXPERTS_PER_GROUP + top_i

    n_assign = t_count * TOP_K
    e_flat = eid.reshape(-1)
    order = jnp.argsort(e_flat)
    e_s = e_flat[order]
    tok_s = order // TOP_K
    w_s = wts.reshape(-1)[order]
    counts = jnp.bincount(e_flat, length=N_EXPERTS)
    padded = (counts + MOE_BLOCK - 1) // MOE_BLOCK * MOE_BLOCK
    pad_end = jnp.cumsum(padded)
    pad_start = pad_end - padded
    raw_start = jnp.cumsum(counts) - counts
    dest = pad_start[e_s] + jnp.arange(n_assign) - raw_start[e_s]
    n_rows = n_assign + N_EXPERTS * MOE_BLOCK
    n_blocks = n_rows // MOE_BLOCK
    buf = jnp.zeros((n_rows, d), h.dtype).at[dest].set(h[tok_s])
    blk_e = jnp.clip(jnp.searchsorted(pad_end, jnp.arange(n_blocks) * MOE_BLOCK, side='right'), 0, N_EXPERTS - 1)

    def expert_block(args):
        xb, e = args
        return (jax.nn.silu(xb @ w_gate[e]) * (xb @ w_up[e])) @ w_down[e]

    y_buf = lax.map(expert_block, (buf.reshape(n_blocks, MOE_BLOCK, d), blk_e))
    y_s = y_buf.reshape(n_rows, d)[dest]
    out = jax.ops.segment_sum(y_s.astype(jnp.float32) * w_s[:, None], tok_s, num_segments=t_count)
    return out.astype(h.dtype)


def setup_inputs(seed: int = 0) -> dict:
    key = jax.random.key(seed)
    keys = iter(jax.random.split(key, 96))

    def nrm(shape, scale):
        return jax.random.normal(next(keys), shape, jnp.float32) * scale

    d = D_MODEL
    inputs = {
        'x': nrm((BATCH, SEQ, d), 1.0),
        'c': nrm((BATCH, d), 1.0),
        'ctx': nrm((BATCH, CTX_LEN, d), 1.0),
        'c_ctx': nrm((d,), 1.0),
    }
    for i in range(DEPTH):
        p = 'l%d_' % i
        inputs[p + 'ada_w'] = nrm((d, N_MOD * d), 0.5 * d ** -0.5)
        inputs[p + 'ada_b'] = nrm((N_MOD * d,), 0.02)
        inputs[p + 'norm1_g'] = 1.0 + nrm((d,), 0.02)
        inputs[p + 'norm2_g'] = 1.0 + nrm((d,), 0.02)
        if i % N_MIXERS == 0:
            inputs[p + 'rg_w_in'] = nrm((d, 2 * D_RNN), d ** -0.5)
            inputs[p + 'rg_conv_w'] = nrm((CONV_W, D_RNN), CONV_W ** -0.5)
            inputs[p + 'rg_conv_b'] = nrm((D_RNN,), 0.02)
            inputs[p + 'rg_w_a'] = nrm((2, RG_BLOCKS, RG_BLOCK_W, RG_BLOCK_W), RG_BLOCK_W ** -0.5)
            inputs[p + 'rg_b_a'] = nrm((2, D_RNN), 0.02)
            inputs[p + 'rg_w_x'] = nrm((2, RG_BLOCKS, RG_BLOCK_W, RG_BLOCK_W), RG_BLOCK_W ** -0.5)
            inputs[p + 'rg_b_x'] = nrm((2, D_RNN), 0.02)
            a0 = jax.random.uniform(next(keys), (2, D_RNN), jnp.float32, RG_A_MIN ** (1.0 / RG_C), RG_A_MAX ** (1.0 / RG_C))
            inputs[p + 'rg_lambda'] = jnp.log(a0) - jnp.log1p(-a0)
            inputs[p + 'rg_w_out'] = nrm((D_RNN, d), D_RNN ** -0.5)
        else:
            inputs[p + 'ml_w_in'] = nrm((d, ML_IN_W), d ** -0.5)
            fb = jnp.linspace(ML_FGATE_BIAS_LO, ML_FGATE_BIAS_HI, ML_HEADS, dtype=jnp.float32)
            inputs[p + 'ml_b_gates'] = jnp.concatenate([nrm((ML_HEADS,), 0.1), fb + nrm((ML_HEADS,), 0.1),
                                                        nrm((ML_HEADS,), 0.1), fb + nrm((ML_HEADS,), 0.1)])
            inputs[p + 'ml_norm_g'] = 1.0 + nrm((ML_V_W,), 0.02)
            inputs[p + 'ml_w_out'] = nrm((ML_V_W, d), ML_V_W ** -0.5)
        inputs[p + 'moe_w_grp'] = nrm((d, N_GROUPS), d ** -0.5)
        inputs[p + 'moe_b_grp'] = nrm((N_GROUPS,), 0.01)
        inputs[p + 'moe_w_exp'] = nrm((d, N_EXPERTS), d ** -0.5)
        inputs[p + 'moe_b_exp'] = nrm((N_EXPERTS,), 0.01)
        inputs[p + 'moe_w_gate'] = nrm((N_EXPERTS, d, D_EXPERT), d ** -0.5)
        inputs[p + 'moe_w_up'] = nrm((N_EXPERTS, d, D_EXPERT), d ** -0.5)
        inputs[p + 'moe_w_down'] = nrm((N_EXPERTS, D_EXPERT, d), D_EXPERT ** -0.5)
    inputs['final_norm_g'] = 1.0 + nrm((d,), 0.02)
    return inputs


def reference(x, c, ctx, c_ctx,
              l0_ada_w, l0_ada_b, l0_norm1_g, l0_norm2_g,
              l0_rg_w_in, l0_rg_conv_w, l0_rg_conv_b, l0_rg_w_a, l0_rg_b_a, l0_rg_w_x, l0_rg_b_x, l0_rg_lambda, l0_rg_w_out,
              l0_moe_w_grp, l0_moe_b_grp, l0_moe_w_exp, l0_moe_b_exp, l0_moe_w_gate, l0_moe_w_up, l0_moe_w_down,
              l1_ada_w, l1_ada_b, l1_norm1_g, l1_norm2_g,
              l1_ml_w_in, l1_ml_b_gates, l1_ml_norm_g, l1_ml_w_out,
              l1_moe_w_grp, l1_moe_b_grp, l1_moe_w_exp, l1_moe_b_exp, l1_moe_w_gate, l1_moe_w_up, l1_moe_w_down,
              final_norm_g):
    layers = (
        (l0_ada_w, l0_ada_b, l0_norm1_g, l0_norm2_g,
         (l0_rg_w_in, l0_rg_conv_w, l0_rg_conv_b, l0_rg_w_a, l0_rg_b_a, l0_rg_w_x, l0_rg_b_x, l0_rg_lambda, l0_rg_w_out),
         (l0_moe_w_grp, l0_moe_b_grp, l0_moe_w_exp, l0_moe_b_exp, l0_moe_w_gate, l0_moe_w_up, l0_moe_w_down)),
        (l1_ada_w, l1_ada_b, l1_norm1_g, l1_norm2_g,
         (l1_ml_w_in, l1_ml_b_gates, l1_ml_norm_g, l1_ml_w_out),
         (l1_moe_w_grp, l1_moe_b_grp, l1_moe_w_exp, l1_moe_b_exp, l1_moe_w_gate, l1_moe_w_up, l1_moe_w_down)),
    )
    b, n, d = x.shape
    for i in range(DEPTH):
        ada_w, ada_b, g1, g2, mix_p, moe_p = layers[i]
        need_ctx = i < DEPTH - 1
        sh1, sc1, gt1, sh2, sc2, gt2 = [m[:, None, :] for m in adaln(c, ada_w, ada_b)]
        csh1, csc1, cgt1, csh2, csc2, cgt2 = adaln(c_ctx, ada_w, ada_b)
        hx = modulate(rms_norm(x, g1), sh1, sc1)
        hc = modulate(rms_norm(ctx, g1), csh1, csc1)
        if i % N_MIXERS == 0:
            yx, yc = rglru_mixer(hx, hc, *mix_p, ctx_out=need_ctx)
        else:
            yx, yc = mlstm_mixer(hx, hc, *mix_p, ctx_out=need_ctx)
        x = x + gt1 * yx
        h2 = modulate(rms_norm(x, g2), sh2, sc2)
        if need_ctx:
            ctx = ctx + cgt1 * yc
            hc2 = modulate(rms_norm(ctx, g2), csh2, csc2)
            tokens = jnp.concatenate([h2.reshape(b * n, d), hc2.reshape(-1, d)], axis=0)
            f = hier_moe(tokens, *moe_p)
            x = x + gt2 * f[:b * n].reshape(b, n, d)
            ctx = ctx + cgt2 * f[b * n:].reshape(b, -1, d)
        else:
            x = x + gt2 * hier_moe(h2.reshape(b * n, d), *moe_p).reshape(b, n, d)
    return rms_norm(x, final_norm_g)
```

```cpp
#include <hip/hip_runtime.h>
#include <hip/hip_cooperative_groups.h>
#include <cstdio>
#include <cstdint>
namespace cg = cooperative_groups;

#define DEV __device__ __forceinline__
typedef unsigned short bf16_t;
typedef short bf16x8 __attribute__((ext_vector_type(8)));
typedef short s16x4 __attribute__((ext_vector_type(4)));
typedef float f32x4 __attribute__((ext_vector_type(4)));
typedef unsigned u32x4 __attribute__((ext_vector_type(4)));
typedef unsigned u32x2 __attribute__((ext_vector_type(2)));
#define LAS __attribute__((address_space(3)))

constexpr int D = 1024, NL = 16384, NC = 256, T = NL + NC, NTILE = T / 128;
constexpr int DR = 1280, NEXP = 32, DE = 512;
constexpr int RGT = 64, NRT = T / RGT, NRT_LAT = NL / RGT;
constexpr int MLW = 3104;
constexpr float EPS = 1e-6f;

constexpr size_t al256(size_t x) { return (x + 255) & ~(size_t)255; }
constexpr size_t WS_BAR   = 0;
constexpr size_t WS_CNT   = 16384;
constexpr size_t WS_ZERO_BYTES = 16384 + 256;
constexpr size_t WS_MODS  = 32768;
constexpr size_t WS_LIST  = WS_MODS + al256(2 * 2 * 6144 * 4);
constexpr size_t WS_AW    = WS_LIST + al256((size_t)2 * 32 * T * 4);
constexpr size_t WS_AGG   = WS_AW + al256((size_t)2 * T * 4);
constexpr size_t WS_CARRY = WS_AGG + al256((size_t)2 * NRT * DR * 2 * 4);
constexpr size_t WS_GL    = WS_CARRY + al256((size_t)2 * NRT * DR * 4);
constexpr size_t WS_NVEC  = WS_GL + al256((size_t)T * 32 * 4);
constexpr size_t WS_DEC   = WS_NVEC + al256((size_t)NTILE * 16 * 64 * 4);
constexpr size_t WS_HA    = WS_DEC + al256((size_t)NTILE * 16 * 4);
constexpr size_t WS_X1    = WS_HA + al256((size_t)T * D * 2);
constexpr size_t WS_X2    = WS_X1 + al256((size_t)T * D * 4);
constexpr size_t WS_HM    = WS_X2 + al256((size_t)T * D * 4);
constexpr size_t WS_R0    = WS_HM + al256((size_t)2 * T * DE * 2);
constexpr size_t WS_GG    = WS_R0;
constexpr size_t WS_PR    = WS_GG + al256((size_t)T * DR * 2);
constexpr size_t WS_S     = WS_PR + al256((size_t)T * DR * 2);
constexpr size_t WS_PF    = WS_S + al256((size_t)T * DR * 2);
constexpr size_t WS_PB    = WS_PF + al256((size_t)T * DR * 2);
constexpr size_t WS_R0END = WS_PB + al256((size_t)T * DR * 2);
constexpr size_t WS_Y     = WS_R0;
constexpr size_t WS_Q     = WS_R0 + al256((size_t)2 * T * D * 2);
constexpr size_t WS_K     = WS_Q + al256((size_t)T * 512 * 2);
constexpr size_t WS_KT    = WS_K + al256((size_t)T * 512 * 2);
constexpr size_t WS_VT    = WS_KT + al256((size_t)T * 512 * 2);
constexpr size_t WS_OG    = WS_VT + al256((size_t)T * D * 2);
constexpr size_t WS_UT    = WS_OG + al256((size_t)T * D * 2);
constexpr size_t WS_L1END = WS_UT + al256((size_t)NTILE * 16 * 8192 * 4);
constexpr size_t WS_END   = WS_R0END > WS_L1END ? WS_R0END : WS_L1END;

struct Params {
  const float* in[40];
  float* out;
  char* ws;
};

DEV unsigned pk2(float lo, float hi) { unsigned r; asm("v_cvt_pk_bf16_f32 %0, %1, %2" : "=v"(r) : "v"(lo), "v"(hi)); return r; }
DEV float bflo(unsigned u) { return __uint_as_float(u << 16); }
DEV float bfhi(unsigned u) { return __uint_as_float(u & 0xffff0000u); }
DEV float bf2f(bf16_t b) { return __uint_as_float((unsigned)b << 16); }
DEV bf16_t f2bf(float f) { return (bf16_t)(pk2(f, 0.f) & 0xffffu); }
DEV float sigmoidf_(float x) { return 1.f / (1.f + __expf(-x)); }
DEV float siluf_(float x) { return x / (1.f + __expf(-x)); }
DEV float gelu_tanh(float x) { const float u = 0.7978845608028654f * (x + 0.044715f * x * x * x); return 0.5f * x * (1.f + tanhf(u)); }
DEV float wave_sum(float v) {
#pragma unroll
  for (int o = 1; o < 64; o <<= 1) v += __shfl_xor(v, o);
  return v;
}
DEV s16x4 ldtr(const char* p) { return __builtin_bit_cast(s16x4, __builtin_amdgcn_ds_read_tr16_b64_v4i16((LAS s16x4*)p)); }
DEV int seqrow_of_token(int t) { return (t & 63) * 256 + (t >> 6); }
DEV int token_of_seqrow(int s) { return (s & 255) * 64 + (s >> 8); }

constexpr int AS_STRIDE = 144;
constexpr int BS_STRIDE = 320;
constexpr int GEMM_AS = 0, GEMM_BS = 128 * AS_STRIDE, GEMM_SMEM = GEMM_BS + 64 * BS_STRIDE;

DEV int bs_off(int k, int n) { return k * BS_STRIDE + ((((n >> 4) ^ ((k >> 3) & 1))) << 5) + (n & 15) * 2; }

DEV void gemm128(char* smem, int KT, const bf16_t* const (&ap)[4], const float* bp, size_t ldb, bool bvalid, f32x4 (&acc)[4][4]) {
  const int tid = threadIdx.x, lane = tid & 63, wave = tid >> 6, wr = wave >> 1, wc = wave & 1;
  const int fr = lane & 15, fq = lane >> 4, q4 = (lane & 15) >> 2, p4 = lane & 3;
  char* As = smem + GEMM_AS; char* Bs = smem + GEMM_BS;
#pragma unroll
  for (int m = 0; m < 4; ++m)
#pragma unroll
    for (int n = 0; n < 4; ++n) acc[m][n] = (f32x4){0.f, 0.f, 0.f, 0.f};
  u32x4 ra[4]; f32x4 rb[8];
  auto gload = [&](int kt) {
#pragma unroll
    for (int i = 0; i < 4; ++i) ra[i] = *(const u32x4*)(ap[i] + kt * 64);
#pragma unroll
    for (int i = 0; i < 8; ++i) {
      if (bvalid) rb[i] = *(const f32x4*)(bp + (size_t)(kt * 64 + 8 * i) * ldb);
      else rb[i] = (f32x4){0.f, 0.f, 0.f, 0.f};
    }
  };
  const int a_w = ((tid >> 3)) * AS_STRIDE + (tid & 7) * 16;
  const int bk0 = tid >> 5, bn0 = 4 * (tid & 31);
  gload(0);
  for (int kt = 0; kt < KT; ++kt) {
    __syncthreads();
#pragma unroll
    for (int i = 0; i < 4; ++i) *(u32x4*)(As + a_w + i * 32 * AS_STRIDE) = ra[i];
#pragma unroll
    for (int i = 0; i < 8; ++i) {
      u32x2 v; v.x = pk2(rb[i].x, rb[i].y); v.y = pk2(rb[i].z, rb[i].w);
      *(u32x2*)(Bs + bs_off(bk0 + 8 * i, bn0)) = v;
    }
    __syncthreads();
    if (kt + 1 < KT) gload(kt + 1);
#pragma unroll
    for (int ks = 0; ks < 2; ++ks) {
      bf16x8 a[4], b[4];
#pragma unroll
      for (int m = 0; m < 4; ++m) a[m] = *(const bf16x8*)(As + (wr * 64 + m * 16 + fr) * AS_STRIDE + (ks * 32 + fq * 8) * 2);
#pragma unroll
      for (int n = 0; n < 4; ++n) {
        const int ncol = wc * 64 + n * 16 + 4 * p4;
        const s16x4 lo = ldtr(Bs + bs_off(ks * 32 + fq * 8 + q4, ncol));
        const s16x4 hi = ldtr(Bs + bs_off(ks * 32 + fq * 8 + 4 + q4, ncol));
        b[n] = (bf16x8){lo.x, lo.y, lo.z, lo.w, hi.x, hi.y, hi.z, hi.w};
      }
#pragma unroll
      for (int m = 0; m < 4; ++m)
#pragma unroll
        for (int n = 0; n < 4; ++n) acc[m][n] = __builtin_amdgcn_mfma_f32_16x16x32_bf16(a[m], b[n], acc[m][n], 0, 0, 0);
    }
  }
  __syncthreads();
}

DEV void ph_adaln(const Params& p, char* smem, int bid, int nb) {
  float* sc = (float*)smem; float* sx = sc + 1024; f32x4* red = (f32x4*)(sx + 1024);
  const int tid = threadIdx.x;
  for (int i = tid; i < 1024; i += 256) { sc[i] = siluf_(p.in[1][i]); sx[i] = siluf_(p.in[3][i]); }
  __syncthreads();
  float* mods = (float*)(p.ws + WS_MODS);
  const int cl = tid & 15, kg = tid >> 4;
  for (int u = bid; u < 192; u += nb) {
    const int l = u / 96, c0 = (u % 96) * 64;
    const float* W = p.in[l ? 24 : 4]; const float* B = p.in[l ? 25 : 5];
    f32x4 ac = {0.f, 0.f, 0.f, 0.f}, ax = {0.f, 0.f, 0.f, 0.f};
    const float* wp = W + (size_t)(kg * 64) * 6144 + c0 + 4 * cl;
#pragma unroll 8
    for (int kk = 0; kk < 64; ++kk) {
      const f32x4 w = *(const f32x4*)(wp + (size_t)kk * 6144);
      const float a = sc[kg * 64 + kk], b = sx[kg * 64 + kk];
      ac += a * w; ax += b * w;
    }
    red[kg * 16 + cl] = ac; red[256 + kg * 16 + cl] = ax;
    __syncthreads();
    if (tid < 32) {
      const int which = tid >> 4, c = tid & 15;
      f32x4 s = {0.f, 0.f, 0.f, 0.f};
      for (int g = 0; g < 16; ++g) s += red[which * 256 + g * 16 + c];
      const f32x4 bb = *(const f32x4*)(B + c0 + 4 * c);
      *(f32x4*)(mods + (size_t)(l * 2 + which) * 6144 + c0 + 4 * c) = s + bb;
    }
    __syncthreads();
  }
}

DEV void ph_norm0(const Params& p, int bid, int nb) {
  const int lane = threadIdx.x & 63, wave = threadIdx.x >> 6;
  const float* mods = (const float*)(p.ws + WS_MODS);
  bf16_t* hA = (bf16_t*)(p.ws + WS_HA);
  const float* g1 = p.in[6];
  for (int r = bid * 4 + wave; r < T; r += nb * 4) {
    const float* src = r < NL ? p.in[0] + (size_t)r * D : p.in[2] + (size_t)(r - NL) * D;
    const float* md = mods + (r < NL ? 0 : 6144);
    f32x4 v[4]; float ss = 0.f;
#pragma unroll
    for (int i = 0; i < 4; ++i) { v[i] = *(const f32x4*)(src + 4 * lane + 256 * i); ss += v[i].x * v[i].x + v[i].y * v[i].y + v[i].z * v[i].z + v[i].w * v[i].w; }
    const float rstd = rsqrtf(wave_sum(ss) * (1.f / D) + EPS);
#pragma unroll
    for (int i = 0; i < 4; ++i) {
      const int c = 4 * lane + 256 * i;
      const f32x4 g = *(const f32x4*)(g1 + c), sh = *(const f32x4*)(md + c), sc = *(const f32x4*)(md + 1024 + c);
      const f32x4 h = v[i] * rstd * g * (1.f + sc) + sh;
      u32x2 o; o.x = pk2(h.x, h.y); o.y = pk2(h.z, h.w);
      *(u32x2*)(hA + (size_t)r * D + c) = o;
    }
  }
}

DEV void ph_rg_inproj(const Params& p, char* smem, int bid, int nb) {
  const int tid = threadIdx.x, lane = tid & 63, wave = tid >> 6, wr = wave >> 1, wc = wave & 1, fr = lane & 15, fq = lane >> 4;
  const bf16_t* hA = (const bf16_t*)(p.ws + WS_HA);
  bf16_t* gg = (bf16_t*)(p.ws + WS_GG); bf16_t* pr = (bf16_t*)(p.ws + WS_PR);
  const float* W = p.in[8];
  for (int u = bid; u < NTILE * 20; u += nb) {
    const int nt = u % 20, mt = u / 20, r0 = mt * 128, n0 = nt * 128;
    const bf16_t* ap[4];
#pragma unroll
    for (int i = 0; i < 4; ++i) ap[i] = hA + (size_t)(r0 + (tid >> 3) + 32 * i) * D + (tid & 7) * 8;
    f32x4 acc[4][4];
    gemm128(smem, 16, ap, W + (size_t)(tid >> 5) * 2560 + n0 + 4 * (tid & 31), 2560, true, acc);
#pragma unroll
    for (int m = 0; m < 4; ++m)
#pragma unroll
      for (int n = 0; n < 4; ++n)
#pragma unroll
        for (int j = 0; j < 4; ++j) {
          const int row = r0 + wr * 64 + m * 16 + fq * 4 + j, col = n0 + wc * 64 + n * 16 + fr;
          const float v = acc[m][n][j];
          if (col < DR) gg[(size_t)row * DR + col] = f2bf(gelu_tanh(v));
          else pr[(size_t)row * DR + col - DR] = f2bf(v);
        }
  }
}

constexpr int RG_AS_STRIDE = 272;
constexpr int RG_MT = RGT / 16;
constexpr int RG_AS = 0, RG_BS = RGT * RG_AS_STRIDE, RG_SMEM = RG_BS + 128 * BS_STRIDE;

template <bool REV>
DEV void rg_scan(f32x4 (&A)[RG_MT][2], f32x4 (&B)[RG_MT][2], float (&aggP)[2], float (&aggH)[2]) {
  const int lane = threadIdx.x & 63, fq = lane >> 4, fr = lane & 15;
#pragma unroll
  for (int n = 0; n < 2; ++n) {
    float cP = 1.f, cH = 0.f;
#pragma unroll
    for (int mm = 0; mm < RG_MT; ++mm) {
      const int m = REV ? RG_MT - 1 - mm : mm;
      float P[4], H[4];
      if (!REV) {
        P[0] = A[m][n][0]; H[0] = B[m][n][0];
#pragma unroll
        for (int j = 1; j < 4; ++j) { P[j] = A[m][n][j] * P[j - 1]; H[j] = A[m][n][j] * H[j - 1] + B[m][n][j]; }
      } else {
        P[3] = A[m][n][3]; H[3] = B[m][n][3];
#pragma unroll
        for (int j = 2; j >= 0; --j) { P[j] = A[m][n][j] * P[j + 1]; H[j] = A[m][n][j] * H[j + 1] + B[m][n][j]; }
      }
      float IP = REV ? P[0] : P[3], IH = REV ? H[0] : H[3];
      float tP, tH;
      tP = REV ? __shfl_down(IP, 16) : __shfl_up(IP, 16); tH = REV ? __shfl_down(IH, 16) : __shfl_up(IH, 16);
      if (REV ? (fq <= 2) : (fq >= 1)) { IH = IP * tH + IH; IP = IP * tP; }
      tP = REV ? __shfl_down(IP, 32) : __shfl_up(IP, 32); tH = REV ? __shfl_down(IH, 32) : __shfl_up(IH, 32);
      if (REV ? (fq <= 1) : (fq >= 2)) { IH = IP * tH + IH; IP = IP * tP; }
      float EP = REV ? __shfl_down(IP, 16) : __shfl_up(IP, 16), EH = REV ? __shfl_down(IH, 16) : __shfl_up(IH, 16);
      if (REV ? (fq == 3) : (fq == 0)) { EP = 1.f; EH = 0.f; }
      const float hin = EP * cH + EH, pin = EP * cP;
#pragma unroll
      for (int j = 0; j < 4; ++j) { B[m][n][j] = H[j] + P[j] * hin; A[m][n][j] = P[j] * pin; }
      const float TP = __shfl(IP, (REV ? 0 : 48) + fr), TH = __shfl(IH, (REV ? 0 : 48) + fr);
      cH = TP * cH + TH; cP = TP * cP;
    }
    aggP[n] = cP; aggH[n] = cH;
  }
}

DEV void ph_rg_scan(const Params& p, char* smem, int bid, int nb) {
  char* As = smem + RG_AS; char* Bs = smem + RG_BS;
  const bf16_t* pr = (const bf16_t*)(p.ws + WS_PR);
  bf16_t* Sb = (bf16_t*)(p.ws + WS_S); bf16_t* Pfb = (bf16_t*)(p.ws + WS_PF); bf16_t* Pbb = (bf16_t*)(p.ws + WS_PB);
  float* agg = (float*)(p.ws + WS_AGG);
  const float* conv_w = p.in[9]; const float* conv_b = p.in[10];
  for (int u = bid; u < NRT * 10; u += nb) {
    int tid = threadIdx.x; asm volatile("" : "+v"(tid));
    const int lane = tid & 63, wave = tid >> 6, fr = lane & 15, fq = lane >> 4, q4 = fr >> 2, p4 = lane & 3;
    const int hb = u % 10, tile = u / 10, r0 = tile * RGT, ch0 = hb * 128;
    const int seg_lo = tile < NRT_LAT ? 0 : NL, seg_hi = tile < NRT_LAT ? NL : T;
    __syncthreads();
    {
      const int cg8 = tid & 15, rg = tid >> 4, c = ch0 + 8 * cg8;
      float w[4][8], bias[8];
#pragma unroll
      for (int j = 0; j < 4; ++j) { const f32x4 a = *(const f32x4*)(conv_w + j * DR + c), b = *(const f32x4*)(conv_w + j * DR + c + 4);
        w[j][0] = a.x; w[j][1] = a.y; w[j][2] = a.z; w[j][3] = a.w; w[j][4] = b.x; w[j][5] = b.y; w[j][6] = b.z; w[j][7] = b.w; }
      { const f32x4 a = *(const f32x4*)(conv_b + c), b = *(const f32x4*)(conv_b + c + 4);
        bias[0] = a.x; bias[1] = a.y; bias[2] = a.z; bias[3] = a.w; bias[4] = b.x; bias[5] = b.y; bias[6] = b.z; bias[7] = b.w; }
      float win[4][8];
      auto ldrow = [&](int r, float (&dst)[8]) {
        if (r >= seg_lo && r < seg_hi) { const u32x4 v = *(const u32x4*)(pr + (size_t)r * DR + c);
          dst[0] = bflo(v.x); dst[1] = bfhi(v.x); dst[2] = bflo(v.y); dst[3] = bfhi(v.y); dst[4] = bflo(v.z); dst[5] = bfhi(v.z); dst[6] = bflo(v.w); dst[7] = bfhi(v.w); }
        else {
#pragma unroll
          for (int e = 0; e < 8; ++e) dst[e] = 0.f; }
      };
      const int rb = r0 + rg * 4;
      ldrow(rb - 2, win[0]); ldrow(rb - 1, win[1]); ldrow(rb, win[2]);
#pragma unroll
      for (int t = 0; t < 4; ++t) {
        ldrow(rb + t + 1, win[(t + 3) & 3]);
        float o[8];
#pragma unroll
        for (int e = 0; e < 8; ++e) o[e] = bias[e] + w[0][e] * win[t & 3][e] + w[1][e] * win[(t + 1) & 3][e] + w[2][e] * win[(t + 2) & 3][e] + w[3][e] * win[(t + 3) & 3][e];
        u32x4 ov; ov.x = pk2(o[0], o[1]); ov.y = pk2(o[2], o[3]); ov.z = pk2(o[4], o[5]); ov.w = pk2(o[6], o[7]);
        *(u32x4*)(As + (rg * 4 + t) * RG_AS_STRIDE + cg8 * 16) = ov;
      }
    }
    u32x2 hfk[RG_MT][2];
#pragma unroll
    for (int d = 0; d < 2; ++d) {
      f32x4 accA[RG_MT][2], accX[RG_MT][2];
#pragma unroll
      for (int which = 0; which < 2; ++which) {
        const float* W = (which ? p.in[13] : p.in[11]) + (size_t)(d * 10 + hb) * 16384;
        __syncthreads();
#pragma unroll 1
        for (int ib = 0; ib < 4; ++ib) {
#pragma unroll
          for (int ii = 0; ii < 4; ++ii) {
            const int f = tid + 256 * (ib * 4 + ii), k = f >> 5, n = 4 * (f & 31);
            const f32x4 v = *(const f32x4*)(W + k * 128 + n);
            u32x2 o; o.x = pk2(v.x, v.y); o.y = pk2(v.z, v.w);
            *(u32x2*)(Bs + bs_off(k, n)) = o;
          }
        }
        __syncthreads();
        f32x4 (&acc)[RG_MT][2] = which ? accX : accA;
#pragma unroll
        for (int m = 0; m < RG_MT; ++m) { acc[m][0] = (f32x4){0.f, 0.f, 0.f, 0.f}; acc[m][1] = (f32x4){0.f, 0.f, 0.f, 0.f}; }
#pragma unroll
        for (int ks = 0; ks < 4; ++ks) {
          bf16x8 b[2];
#pragma unroll
          for (int n = 0; n < 2; ++n) {
            const int ncol = wave * 32 + n * 16 + 4 * p4;
            const s16x4 lo = ldtr(Bs + bs_off(ks * 32 + fq * 8 + q4, ncol));
            const s16x4 hi = ldtr(Bs + bs_off(ks * 32 + fq * 8 + 4 + q4, ncol));
            b[n] = (bf16x8){lo.x, lo.y, lo.z, lo.w, hi.x, hi.y, hi.z, hi.w};
          }
#pragma unroll
          for (int m = 0; m < RG_MT; ++m) {
            const bf16x8 a = *(const bf16x8*)(As + (m * 16 + fr) * RG_AS_STRIDE + (ks * 32 + fq * 8) * 2);
            acc[m][0] = __builtin_amdgcn_mfma_f32_16x16x32_bf16(a, b[0], acc[m][0], 0, 0, 0);
            acc[m][1] = __builtin_amdgcn_mfma_f32_16x16x32_bf16(a, b[1], acc[m][1], 0, 0, 0);
          }
        }
      }
#pragma unroll
      for (int n = 0; n < 2; ++n) {
        const int cl = wave * 32 + n * 16 + fr, ch = ch0 + cl;
        const float ba = p.in[12][d * DR + ch], bx = p.in[14][d * DR + ch], lam = p.in[15][d * DR + ch];
        const float nl = -lam;
        const float sp = nl > 20.f ? nl : log1pf(__expf(nl));
        const float c8 = -8.f * sp;
#pragma unroll
        for (int m = 0; m < RG_MT; ++m)
#pragma unroll
          for (int j = 0; j < 4; ++j) {
            const int row = m * 16 + fq * 4 + j;
            const float r = sigmoidf_(accA[m][n][j] + ba), ig = sigmoidf_(accX[m][n][j] + bx);
            const float la = c8 * r;
            const float a = __expf(la);
            const float x2 = 2.f * la;
            const float om = x2 > -0.1f ? -x2 * (1.f + x2 * (0.5f + x2 * (0.16666667f + x2 * 0.041666668f))) : 1.f - a * a;
            const float mult = sqrtf(om);
            const float uu = bf2f(*(const bf16_t*)(As + row * RG_AS_STRIDE + cl * 2));
            accA[m][n][j] = a; accX[m][n][j] = mult * ig * uu;
            if (j == 3) __builtin_amdgcn_sched_barrier(0);
          }
      }
      float aggP[2], aggH[2];
      if (d == 0) rg_scan<false>(accA, accX, aggP, aggH); else rg_scan<true>(accA, accX, aggP, aggH);
      if (fq == 0) {
#pragma unroll
        for (int n = 0; n < 2; ++n) {
          const int ch = ch0 + wave * 32 + n * 16 + fr;
          float* ag = agg + ((size_t)(d * NRT + tile) * DR + ch) * 2;
          ag[0] = aggP[n]; ag[1] = aggH[n];
        }
      }
      bf16_t* Pout = d ? Pbb : Pfb;
#pragma unroll
      for (int m = 0; m < RG_MT; ++m)
#pragma unroll
        for (int n = 0; n < 2; ++n) {
          if (d == 0) { hfk[m][n].x = pk2(accX[m][n][0], accX[m][n][1]); hfk[m][n].y = pk2(accX[m][n][2], accX[m][n][3]); }
          else { accX[m][n][0] += bflo(hfk[m][n].x); accX[m][n][1] += bfhi(hfk[m][n].x); accX[m][n][2] += bflo(hfk[m][n].y); accX[m][n][3] += bfhi(hfk[m][n].y); }
#pragma unroll
          for (int j = 0; j < 4; ++j) {
            const unsigned o = (unsigned)(r0 + m * 16 + fq * 4 + j) * DR + ch0 + wave * 32 + n * 16 + fr;
            Pout[o] = f2bf(accA[m][n][j]);
            if (d == 1) Sb[o] = f2bf(accX[m][n][j]);
          }
          __builtin_amdgcn_sched_barrier(0);
        }
    }
  }
}

DEV void ph_rg_carry(const Params& p, int bid, int nb) {
  const float* agg = (const float*)(p.ws + WS_AGG); float* carry = (float*)(p.ws + WS_CARRY);
  for (int i = bid * 256 + threadIdx.x; i < 2 * DR; i += nb * 256) {
    const int d = i / DR, ch = i % DR;
    float st = 0.f;
    for (int s = 0; s < NRT; ++s) {
      int tile;
      if (d == 0) tile = s < (NRT - NRT_LAT) ? NRT_LAT + s : s - (NRT - NRT_LAT);
      else tile = NRT - 1 - s;
      const float* ag = agg + ((size_t)(d * NRT + tile) * DR + ch) * 2;
      carry[(size_t)(d * NRT + tile) * DR + ch] = st;
      st = ag[0] * st + ag[1];
    }
  }
}

DEV void ph_rg_final(const Params& p, int bid, int nb) {
  const bf16_t* gg = (const bf16_t*)(p.ws + WS_GG); const bf16_t* Sb = (const bf16_t*)(p.ws + WS_S);
  const bf16_t* Pfb = (const bf16_t*)(p.ws + WS_PF); const bf16_t* Pbb = (const bf16_t*)(p.ws + WS_PB);
  const float* carry = (const float*)(p.ws + WS_CARRY);
  bf16_t* y = (bf16_t*)(p.ws + WS_PR);
  const int total = T * (DR / 8);
  for (int i = bid * 256 + threadIdx.x; i < total; i += nb * 256) {
    const int r = i / 160, c = (i % 160) * 8, tile = r / RGT;
    const size_t o = (size_t)r * DR + c;
    const u32x4 g = *(const u32x4*)(gg + o), s = *(const u32x4*)(Sb + o), pf = *(const u32x4*)(Pfb + o), pb = *(const u32x4*)(Pbb + o);
    const float* cf = carry + (size_t)tile * DR + c; const float* cb = carry + (size_t)(NRT + tile) * DR + c;
    const f32x4 cf0 = *(const f32x4*)cf, cf1 = *(const f32x4*)(cf + 4), cb0 = *(const f32x4*)cb, cb1 = *(const f32x4*)(cb + 4);
    u32x4 o4;
    o4.x = pk2(bflo(g.x) * (bflo(s.x) + bflo(pf.x) * cf0.x + bflo(pb.x) * cb0.x), bfhi(g.x) * (bfhi(s.x) + bfhi(pf.x) * cf0.y + bfhi(pb.x) * cb0.y));
    o4.y = pk2(bflo(g.y) * (bflo(s.y) + bflo(pf.y) * cf0.z + bflo(pb.y) * cb0.z), bfhi(g.y) * (bfhi(s.y) + bfhi(pf.y) * cf0.w + bfhi(pb.y) * cb0.w));
    o4.z = pk2(bflo(g.z) * (bflo(s.z) + bflo(pf.z) * cf1.x + bflo(pb.z) * cb1.x), bfhi(g.z) * (bfhi(s.z) + bfhi(pf.z) * cf1.y + bfhi(pb.z) * cb1.y));
    o4.w = pk2(bflo(g.w) * (bflo(s.w) + bflo(pf.w) * cf1.z + bflo(pb.w) * cb1.z), bfhi(g.w) * (bfhi(s.w) + bfhi(pf.w) * cf1.w + bfhi(pb.w) * cb1.w));
    *(u32x4*)(y + o) = o4;
  }
}

template <int LAYER>
DEV void ph_outproj(const Params& p, char* smem, int bid, int nb) {
  const int tid = threadIdx.x, lane = tid & 63, wave = tid >> 6, wr = wave >> 1, wc = wave & 1, fr = lane & 15, fq = lane >> 4;
  const float* mods = (const float*)(p.ws + WS_MODS) + LAYER * 2 * 6144;
  float* x1 = (float*)(p.ws + WS_X1);
  const float* x2 = (const float*)(p.ws + WS_X2);
  const int KD = LAYER == 0 ? DR : D, MT = LAYER == 0 ? NTILE : 128;
  const bf16_t* A = (const bf16_t*)(p.ws + (LAYER == 0 ? WS_PR : WS_HA));
  const float* W = p.in[LAYER == 0 ? 16 : 31];
  for (int u = bid; u < MT * 8; u += nb) {
    const int nt = u % 8, mt = u / 8, r0 = mt * 128, n0 = nt * 128;
    const bf16_t* ap[4];
#pragma unroll
    for (int i = 0; i < 4; ++i) ap[i] = A + (size_t)(r0 + (tid >> 3) + 32 * i) * KD + (tid & 7) * 8;
    f32x4 acc[4][4];
    gemm128(smem, KD / 64, ap, W + (size_t)(tid >> 5) * D + n0 + 4 * (tid & 31), D, true, acc);
#pragma unroll
    for (int m = 0; m < 4; ++m)
#pragma unroll
      for (int j = 0; j < 4; ++j) {
        const int row = r0 + wr * 64 + m * 16 + fq * 4 + j;
        const int trow = LAYER == 0 ? row : token_of_seqrow(row);
        const float* xin = LAYER == 0 ? (row < NL ? p.in[0] + (size_t)row * D : p.in[2] + (size_t)(row - NL) * D) : x2 + (size_t)trow * D;
        const float* gt = mods + ((LAYER == 0 && row >= NL) ? 6144 : 0) + 2048;
#pragma unroll
        for (int n = 0; n < 4; ++n) {
          const int col = n0 + wc * 64 + n * 16 + fr;
          x1[(size_t)trow * D + col] = xin[col] + gt[col] * acc[m][n][j];
        }
      }
  }
}

constexpr int RT_STRIDE = 1028;
constexpr int RT_H2 = 0, RT_RED = 16 * RT_STRIDE * 4, RT_SMEM = RT_RED + 4 * 16 * 48 * 4;
template <int LAYER>
DEV void ph_router(const Params& p, char* smem, int bid, int nb) {
  const int tid = threadIdx.x, lane = tid & 63, wave = tid >> 6;
  constexpr int NTOK = LAYER == 0 ? T : NL;
  const float* mods = (const float*)(p.ws + WS_MODS) + LAYER * 2 * 6144;
  const float* x1 = (const float*)(p.ws + WS_X1);
  bf16_t* hA = (bf16_t*)(p.ws + WS_HA);
  const float* g2 = p.in[LAYER == 0 ? 7 : 27];
  const float* Wg = p.in[LAYER == 0 ? 17 : 32]; const float* Bg = p.in[LAYER == 0 ? 18 : 33];
  const float* We = p.in[LAYER == 0 ? 19 : 34]; const float* Be = p.in[LAYER == 0 ? 20 : 35];
  int* cnt = (int*)(p.ws + WS_CNT) + LAYER * 32;
  int* list = (int*)(p.ws + WS_LIST) + (size_t)LAYER * 32 * T;
  float* aw = (float*)(p.ws + WS_AW);
  float* h2s = (float*)(smem + RT_H2); float* red = (float*)(smem + RT_RED);
  for (int u = bid; u < NTOK / 16; u += nb) {
    const int t0 = u * 16;
    __syncthreads();
#pragma unroll
    for (int rr = 0; rr < 4; ++rr) {
      const int lr = wave * 4 + rr, t = t0 + lr;
      const float* md = mods + ((LAYER == 0 && t >= NL) ? 6144 : 0);
      const float* src = x1 + (size_t)t * D;
      f32x4 v[4]; float ss = 0.f;
#pragma unroll
      for (int i = 0; i < 4; ++i) { v[i] = *(const f32x4*)(src + 4 * lane + 256 * i); ss += v[i].x * v[i].x + v[i].y * v[i].y + v[i].z * v[i].z + v[i].w * v[i].w; }
      const float rstd = rsqrtf(wave_sum(ss) * (1.f / D) + EPS);
#pragma unroll
      for (int i = 0; i < 4; ++i) {
        const int c = 4 * lane + 256 * i;
        const f32x4 g = *(const f32x4*)(g2 + c), sh = *(const f32x4*)(md + 3072 + c), sc = *(const f32x4*)(md + 4096 + c);
        const f32x4 h = v[i] * rstd * g * (1.f + sc) + sh;
        *(f32x4*)(h2s + lr * RT_STRIDE + c) = h;
        u32x2 o; o.x = pk2(h.x, h.y); o.y = pk2(h.z, h.w);
        *(u32x2*)(hA + (size_t)t * D + c) = o;
      }
    }
    __syncthreads();
    {
      f32x4 a0 = {0.f, 0.f, 0.f, 0.f}, a1 = a0, a2 = a0;
      const int tok = lane & 15, kk = lane >> 4;
#pragma unroll 4
      for (int s = 0; s < 64; ++s) {
        const int k = wave * 256 + s * 4 + kk;
        const float a = h2s[tok * RT_STRIDE + k];
        const float b0 = We[k * 32 + tok], b1 = We[k * 32 + 16 + tok];
        const float b2 = tok < 4 ? Wg[k * 4 + tok] : 0.f;
        a0 = __builtin_amdgcn_mfma_f32_16x16x4f32(a, b0, a0, 0, 0, 0);
        a1 = __builtin_amdgcn_mfma_f32_16x16x4f32(a, b1, a1, 0, 0, 0);
        a2 = __builtin_amdgcn_mfma_f32_16x16x4f32(a, b2, a2, 0, 0, 0);
      }
#pragma unroll
      for (int j = 0; j < 4; ++j) {
        float* rp = red + ((wave * 16) + kk * 4 + j) * 48;
        rp[tok] = a0[j]; rp[16 + tok] = a1[j]; rp[32 + tok] = a2[j];
      }
    }
    __syncthreads();
    if (tid < 16) {
      const int t = t0 + tid;
      auto lg = [&](int c) { return red[(0 * 16 + tid) * 48 + c] + red[(1 * 16 + tid) * 48 + c] + red[(2 * 16 + tid) * 48 + c] + red[(3 * 16 + tid) * 48 + c]; };
      float gl[4];
#pragma unroll
      for (int i = 0; i < 4; ++i) gl[i] = lg(32 + i) + Bg[i];
      int grp = 0; float gm = gl[0];
#pragma unroll
      for (int i = 1; i < 4; ++i) if (gl[i] > gm) { gm = gl[i]; grp = i; }
      float den = 0.f;
#pragma unroll
      for (int i = 0; i < 4; ++i) den += __expf(gl[i] - gm);
      const float psel = 1.f / den;
      float v0 = -INFINITY, v1 = -INFINITY; int i0 = 0, i1 = 0;
      for (int i = 0; i < 8; ++i) {
        const float v = lg(grp * 8 + i) + Be[grp * 8 + i];
        if (v > v0) { v1 = v0; i1 = i0; v0 = v; i0 = i; }
        else if (v > v1) { v1 = v; i1 = i; }
      }
      const float e1 = __expf(v1 - v0);
      const float w0 = psel / (1.f + e1), w1 = psel * e1 / (1.f + e1);
      const int ea = grp * 8 + i0, eb = grp * 8 + i1;
      const int pa = atomicAdd(&cnt[ea], 1); list[(size_t)ea * T + pa] = 2 * t;
      const int pb = atomicAdd(&cnt[eb], 1); list[(size_t)eb * T + pb] = 2 * t + 1;
      aw[2 * t] = w0; aw[2 * t + 1] = w1;
    }
  }
}

DEV int moe_find(const int* cnt, int u, int ntile_n, int& e, int& mt, int& nt, int& ce) {
  int base = 0;
  for (int i = 0; i < NEXP; ++i) {
    const int c = cnt[i], m = (c + 127) >> 7, tot = m * ntile_n;
    if (u < base + tot) { const int r = u - base; e = i; nt = r / m; mt = r % m; ce = c; return 1; }
    base += tot;
  }
  return 0;
}
template <int LAYER>
DEV void ph_moe1(const Params& p, char* smem, int bid, int nb) {
  const int tid = threadIdx.x, lane = tid & 63, wave = tid >> 6, wr = wave >> 1, wc = wave & 1, fr = lane & 15, fq = lane >> 4;
  const int* cnt = (const int*)(p.ws + WS_CNT) + LAYER * 32;
  const int* list = (const int*)(p.ws + WS_LIST) + (size_t)LAYER * 32 * T;
  const bf16_t* hA = (const bf16_t*)(p.ws + WS_HA);
  bf16_t* Hm = (bf16_t*)(p.ws + WS_HM);
  const float* Wgate = p.in[LAYER == 0 ? 21 : 36]; const float* Wup = p.in[LAYER == 0 ? 22 : 37];
  for (int u = bid;; u += nb) {
    int e, mt, nt, ce;
    if (!moe_find(cnt, u, 8, e, mt, nt, ce)) break;
    const int* le = list + (size_t)e * T + mt * 128;
    const int nrow = min(128, ce - mt * 128);
    const bf16_t* ap[4];
#pragma unroll
    for (int i = 0; i < 4; ++i) { const int m = (tid >> 3) + 32 * i; const int ent = le[m < nrow ? m : 0]; ap[i] = hA + (size_t)(ent >> 1) * D + (tid & 7) * 8; }
    const int c = 4 * (tid & 31), wcc = c >> 6, nn = (c >> 4) & 3;
    const float* bp = (nn < 2 ? Wgate : Wup) + (size_t)e * D * DE + (size_t)(tid >> 5) * DE + nt * 64 + wcc * 32 + (nn & 1) * 16 + (c & 15);
    f32x4 acc[4][4];
    gemm128(smem, 16, ap, bp, DE, true, acc);
#pragma unroll
    for (int m = 0; m < 4; ++m)
#pragma unroll
      for (int j = 0; j < 4; ++j) {
        const int row = wr * 64 + m * 16 + fq * 4 + j;
        if (row < nrow) {
          const int ent = le[row];
#pragma unroll
          for (int n = 0; n < 2; ++n) {
            const float g = acc[m][n][j], uu = acc[m][n + 2][j];
            Hm[(size_t)ent * DE + nt * 64 + wc * 32 + n * 16 + fr] = f2bf(siluf_(g) * uu);
          }
        }
      }
  }
}
template <int LAYER>
DEV void ph_moe2(const Params& p, char* smem, int bid, int nb) {
  const int tid = threadIdx.x, lane = tid & 63, wave = tid >> 6, wr = wave >> 1, wc = wave & 1, fr = lane & 15, fq = lane >> 4;
  const int* cnt = (const int*)(p.ws + WS_CNT) + LAYER * 32;
  const int* list = (const int*)(p.ws + WS_LIST) + (size_t)LAYER * 32 * T;
  const bf16_t* Hm = (const bf16_t*)(p.ws + WS_HM);
  const float* aw = (const float*)(p.ws + WS_AW);
  bf16_t* Y = (bf16_t*)(p.ws + WS_Y);
  const float* Wd = p.in[LAYER == 0 ? 23 : 38];
  for (int u = bid;; u += nb) {
    int e, mt, nt, ce;
    if (!moe_find(cnt, u, 8, e, mt, nt, ce)) break;
    const int* le = list + (size_t)e * T + mt * 128;
    const int nrow = min(128, ce - mt * 128);
    const bf16_t* ap[4];
#pragma unroll
    for (int i = 0; i < 4; ++i) { const int m = (tid >> 3) + 32 * i; const int ent = le[m < nrow ? m : 0]; ap[i] = Hm + (size_t)ent * DE + (tid & 7) * 8; }
    const float* bp = Wd + (size_t)e * DE * D + (size_t)(tid >> 5) * D + nt * 128 + 4 * (tid & 31);
    f32x4 acc[4][4];
    gemm128(smem, 8, ap, bp, D, true, acc);
#pragma unroll
    for (int m = 0; m < 4; ++m)
#pragma unroll
      for (int j = 0; j < 4; ++j) {
        const int row = wr * 64 + m * 16 + fq * 4 + j;
        if (row < nrow) {
          const int ent = le[row]; const float w = aw[ent];
#pragma unroll
          for (int n = 0; n < 4; ++n) Y[(size_t)ent * D + nt * 128 + wc * 64 + n * 16 + fr] = f2bf(w * acc[m][n][j]);
        }
      }
  }
}

DEV void ph_combine0(const Params& p, int bid, int nb) {
  const int lane = threadIdx.x & 63, wave = threadIdx.x >> 6;
  const float* mods0 = (const float*)(p.ws + WS_MODS); const float* mods1 = mods0 + 2 * 6144;
  const float* x1 = (const float*)(p.ws + WS_X1); float* x2 = (float*)(p.ws + WS_X2);
  const bf16_t* Y = (const bf16_t*)(p.ws + WS_Y);
  bf16_t* hA = (bf16_t*)(p.ws + WS_HA);
  const float* g1 = p.in[26];
  for (int t = bid * 4 + wave; t < T; t += nb * 4) {
    const float* m0 = mods0 + (t < NL ? 0 : 6144); const float* m1 = mods1 + (t < NL ? 0 : 6144);
    const int orow = t < NL ? seqrow_of_token(t) : t;
    f32x4 v[4]; float ss = 0.f;
#pragma unroll
    for (int i = 0; i < 4; ++i) {
      const int c = 4 * lane + 256 * i;
      const f32x4 xv = *(const f32x4*)(x1 + (size_t)t * D + c), gt = *(const f32x4*)(m0 + 5120 + c);
      const u32x2 ya = *(const u32x2*)(Y + (size_t)(2 * t) * D + c), yb = *(const u32x2*)(Y + (size_t)(2 * t + 1) * D + c);
      f32x4 f; f.x = bflo(ya.x) + bflo(yb.x); f.y = bfhi(ya.x) + bfhi(yb.x); f.z = bflo(ya.y) + bflo(yb.y); f.w = bfhi(ya.y) + bfhi(yb.y);
      v[i] = xv + gt * f;
      *(f32x4*)(x2 + (size_t)t * D + c) = v[i];
      ss += v[i].x * v[i].x + v[i].y * v[i].y + v[i].z * v[i].z + v[i].w * v[i].w;
    }
    const float rstd = rsqrtf(wave_sum(ss) * (1.f / D) + EPS);
#pragma unroll
    for (int i = 0; i < 4; ++i) {
      const int c = 4 * lane + 256 * i;
      const f32x4 g = *(const f32x4*)(g1 + c), sh = *(const f32x4*)(m1 + c), sc = *(const f32x4*)(m1 + 1024 + c);
      const f32x4 h = v[i] * rstd * g * (1.f + sc) + sh;
      u32x2 o; o.x = pk2(h.x, h.y); o.y = pk2(h.z, h.w);
      *(u32x2*)(hA + (size_t)orow * D + c) = o;
    }
  }
}

DEV void ph_ml_inproj(const Params& p, char* smem, int bid, int nb) {
  const int tid = threadIdx.x, lane = tid & 63, wave = tid >> 6, wr = wave >> 1, wc = wave & 1, fr = lane & 15, fq = lane >> 4;
  const bf16_t* hA = (const bf16_t*)(p.ws + WS_HA);
  bf16_t* qb = (bf16_t*)(p.ws + WS_Q); bf16_t* kb = (bf16_t*)(p.ws + WS_K); bf16_t* kT = (bf16_t*)(p.ws + WS_KT);
  bf16_t* vT = (bf16_t*)(p.ws + WS_VT); bf16_t* og = (bf16_t*)(p.ws + WS_OG); float* gl = (float*)(p.ws + WS_GL);
  const float* W = p.in[28]; const float* bgt = p.in[29];
  for (int u = bid; u < NTILE * 25; u += nb) {
    const int nt = u % 25, mt = u / 25, r0 = mt * 128, n0 = nt * 128;
    const bf16_t* ap[4];
#pragma unroll
    for (int i = 0; i < 4; ++i) ap[i] = hA + (size_t)(r0 + (tid >> 3) + 32 * i) * D + (tid & 7) * 8;
    const int bc = n0 + 4 * (tid & 31);
    const bool bvalid = bc < MLW;
    f32x4 acc[4][4];
    gemm128(smem, 16, ap, W + (size_t)(tid >> 5) * MLW + (bvalid ? bc : 0), MLW, bvalid, acc);
#pragma unroll
    for (int n = 0; n < 4; ++n) {
      const int col = n0 + wc * 64 + n * 16 + fr;
      if (col >= MLW) continue;
#pragma unroll
      for (int m = 0; m < 4; ++m) {
        const int rowb = r0 + wr * 64 + m * 16 + fq * 4;
        const f32x4 v = acc[m][n];
        if (col < 512) {
#pragma unroll
          for (int j = 0; j < 4; ++j) qb[(size_t)(rowb + j) * 512 + col] = f2bf(v[j] * 0.125f);
        } else if (col < 1024) {
#pragma unroll
          for (int j = 0; j < 4; ++j) kb[(size_t)(rowb + j) * 512 + col - 512] = f2bf(v[j]);
          u32x2 o; o.x = pk2(v[0], v[1]); o.y = pk2(v[2], v[3]);
          *(u32x2*)(kT + (size_t)(col - 512) * T + rowb) = o;
        } else if (col < 2048) {
          u32x2 o; o.x = pk2(v[0], v[1]); o.y = pk2(v[2], v[3]);
          *(u32x2*)(vT + (size_t)(col - 1024) * T + rowb) = o;
        } else if (col < 3072) {
#pragma unroll
          for (int j = 0; j < 4; ++j) og[(size_t)(rowb + j) * D + col - 2048] = f2bf(sigmoidf_(v[j]));
        } else {
          const int jj = col - 3072; const float bb = bgt[jj];
#pragma unroll
          for (int j = 0; j < 4; ++j) {
            const float g = v[j] + bb;
            gl[(size_t)(rowb + j) * 32 + jj] = ((jj >> 3) & 1) ? (fminf(g, 0.f) - log1pf(__expf(-fabsf(g)))) : g;
          }
        }
      }
    }
  }
}

DEV void ml_gate_scans(const float* gl, int r0, int h, float* li_f, float* cf, float* li_b, float* cb) {
  const int tid = threadIdx.x, lane = tid & 63, wave = tid >> 6;
  if (tid < 128) { li_f[tid] = gl[(size_t)(r0 + tid) * 32 + h]; li_b[tid] = gl[(size_t)(r0 + tid) * 32 + 16 + h]; }
  if (wave == 0) {
    const float v0 = gl[(size_t)(r0 + 2 * lane) * 32 + 8 + h], v1 = gl[(size_t)(r0 + 2 * lane + 1) * 32 + 8 + h];
    const float s = v0 + v1; float inc = s;
#pragma unroll
    for (int o = 1; o < 64; o <<= 1) { const float t = __shfl_up(inc, o); if (lane >= o) inc += t; }
    const float ex = inc - s;
    cf[2 * lane] = ex + v0; cf[2 * lane + 1] = ex + s;
  } else if (wave == 1) {
    const float v0 = gl[(size_t)(r0 + 127 - 2 * lane) * 32 + 24 + h], v1 = gl[(size_t)(r0 + 126 - 2 * lane) * 32 + 24 + h];
    const float s = v0 + v1; float inc = s;
#pragma unroll
    for (int o = 1; o < 64; o <<= 1) { const float t = __shfl_up(inc, o); if (lane >= o) inc += t; }
    const float ex = inc - s;
    cb[127 - 2 * lane] = ex + v0; cb[126 - 2 * lane] = ex + s;
  }
}

constexpr int MLA_STRIDE = 272;
constexpr int MLA_AW = 0, MLA_BV = 2 * 64 * MLA_STRIDE, MLA_G = MLA_BV + 128 * MLA_STRIDE, MLA_SMEM = MLA_G + 6 * 128 * 4;
DEV void ph_ml_state(const Params& p, char* smem, int bid, int nb) {
  const int tid = threadIdx.x, lane = tid & 63, wave = tid >> 6, fr = lane & 15, fq = lane >> 4;
  const float* gl = (const float*)(p.ws + WS_GL);
  const bf16_t* kT = (const bf16_t*)(p.ws + WS_KT); const bf16_t* vT = (const bf16_t*)(p.ws + WS_VT);
  float* UT = (float*)(p.ws + WS_UT); float* nvec = (float*)(p.ws + WS_NVEC); float* dec = (float*)(p.ws + WS_DEC);
  char* Aw = smem + MLA_AW; char* Bv = smem + MLA_BV;
  float* li_f = (float*)(smem + MLA_G); float* cf = li_f + 128; float* li_b = cf + 128; float* cb = li_b + 128; float* wf = cb + 128; float* wb = wf + 128;
  for (int u = bid; u < NTILE * 8; u += nb) {
    const int h = u % 8, c = u / 8, r0 = c * 128;
    __syncthreads();
    ml_gate_scans(gl, r0, h, li_f, cf, li_b, cb);
    __syncthreads();
    if (tid < 128) { wf[tid] = __expf(cf[127] - cf[tid] + li_f[tid]); wb[tid] = __expf(cb[0] - cb[tid] + li_b[tid]); }
    if (tid == 0) { dec[(c * 8 + h) * 2] = __expf(cf[127]); dec[(c * 8 + h) * 2 + 1] = __expf(cb[0]); }
#pragma unroll
    for (int i = 0; i < 8; ++i) {
      const int f = tid + 256 * i, e = f >> 4, pc = f & 15;
      *(u32x4*)(Bv + e * MLA_STRIDE + pc * 16) = *(const u32x4*)(vT + (size_t)(h * 128 + e) * T + r0 + pc * 8);
    }
    __syncthreads();
#pragma unroll
    for (int i = 0; i < 4; ++i) {
      const int f = tid + 256 * i, d = f >> 4, pc = f & 15;
      const u32x4 kv = *(const u32x4*)(kT + (size_t)(h * 64 + d) * T + r0 + pc * 8);
      float k8[8] = {bflo(kv.x), bfhi(kv.x), bflo(kv.y), bfhi(kv.y), bflo(kv.z), bfhi(kv.z), bflo(kv.w), bfhi(kv.w)};
      u32x4 of, ob;
      of.x = pk2(k8[0] * wf[pc * 8 + 0], k8[1] * wf[pc * 8 + 1]); of.y = pk2(k8[2] * wf[pc * 8 + 2], k8[3] * wf[pc * 8 + 3]);
      of.z = pk2(k8[4] * wf[pc * 8 + 4], k8[5] * wf[pc * 8 + 5]); of.w = pk2(k8[6] * wf[pc * 8 + 6], k8[7] * wf[pc * 8 + 7]);
      ob.x = pk2(k8[0] * wb[pc * 8 + 0], k8[1] * wb[pc * 8 + 1]); ob.y = pk2(k8[2] * wb[pc * 8 + 2], k8[3] * wb[pc * 8 + 3]);
      ob.z = pk2(k8[4] * wb[pc * 8 + 4], k8[5] * wb[pc * 8 + 5]); ob.w = pk2(k8[6] * wb[pc * 8 + 6], k8[7] * wb[pc * 8 + 7]);
      *(u32x4*)(Aw + d * MLA_STRIDE + pc * 16) = of;
      *(u32x4*)(Aw + (64 + d) * MLA_STRIDE + pc * 16) = ob;
    }
    __syncthreads();
    if (tid < 128) {
      float s = 0.f;
      for (int pc = 0; pc < 16; ++pc) { const u32x4 v = *(const u32x4*)(Aw + tid * MLA_STRIDE + pc * 16);
        s += (bflo(v.x) + bfhi(v.x)) + (bflo(v.y) + bfhi(v.y)) + (bflo(v.z) + bfhi(v.z)) + (bflo(v.w) + bfhi(v.w)); }
      nvec[(size_t)((c * 8 + h) * 2 + (tid >> 6)) * 64 + (tid & 63)] = s;
    }
#pragma unroll
    for (int dir = 0; dir < 2; ++dir) {
      f32x4 acc[4][2];
#pragma unroll
      for (int m = 0; m < 4; ++m) { acc[m][0] = (f32x4){0.f, 0.f, 0.f, 0.f}; acc[m][1] = (f32x4){0.f, 0.f, 0.f, 0.f}; }
#pragma unroll
      for (int ks = 0; ks < 4; ++ks) {
        bf16x8 b[2];
#pragma unroll
        for (int n = 0; n < 2; ++n) b[n] = *(const bf16x8*)(Bv + (wave * 32 + n * 16 + fr) * MLA_STRIDE + (ks * 32 + fq * 8) * 2);
#pragma unroll
        for (int m = 0; m < 4; ++m) {
          const bf16x8 a = *(const bf16x8*)(Aw + (dir * 64 + m * 16 + fr) * MLA_STRIDE + (ks * 32 + fq * 8) * 2);
          acc[m][0] = __builtin_amdgcn_mfma_f32_16x16x32_bf16(a, b[0], acc[m][0], 0, 0, 0);
          acc[m][1] = __builtin_amdgcn_mfma_f32_16x16x32_bf16(a, b[1], acc[m][1], 0, 0, 0);
        }
      }
      float* Uo = UT + (size_t)((c * 8 + h) * 2 + dir) * 8192;
#pragma unroll
      for (int m = 0; m < 4; ++m)
#pragma unroll
        for (int n = 0; n < 2; ++n) *(f32x4*)(Uo + (wave * 32 + n * 16 + fr) * 64 + m * 16 + fq * 4) = acc[m][n];
    }
  }
}

DEV void ph_ml_chain(const Params& p, int bid, int nb) {
  float* UT = (float*)(p.ws + WS_UT); float* nvec = (float*)(p.ws + WS_NVEC); const float* dec = (const float*)(p.ws + WS_DEC);
  const int total = 16 * (8192 + 64);
  for (int i = bid * 256 + threadIdx.x; i < total; i += nb * 256) {
    const int hd = i / 8256, idx = i % 8256;
    const int dir = hd & 1;
    float st = 0.f;
    for (int s = 0; s < NTILE; ++s) {
      int c;
      if (dir == 0) c = s < 2 ? 128 + s : s - 2; else c = 129 - s;
      float* ptr = idx < 8192 ? UT + (size_t)(c * 16 + hd) * 8192 + idx : nvec + (size_t)(c * 16 + hd) * 64 + (idx - 8192);
      const float uv = *ptr; const float dc = dec[c * 16 + hd];
      *ptr = st;
      st = dc * st + uv;
    }
  }
}

constexpr int MLC_QS = 0;
constexpr int MLC_KS = 9216;
constexpr int MLC_Q2 = MLC_KS + 18432;
constexpr int MLC_BS = MLC_Q2 + 17408;
constexpr int MLC_G  = MLC_BS + 18432;
constexpr int MLC_SMEM = MLC_G + (4 * 128 + 6 * 64) * 4;
DEV void ph_ml_out(const Params& p, char* smem, int bid, int nb) {
  const int tid = threadIdx.x, lane = tid & 63, wave = tid >> 6, fr = lane & 15, fq = lane >> 4;
  const float* gl = (const float*)(p.ws + WS_GL);
  const bf16_t* qb = (const bf16_t*)(p.ws + WS_Q); const bf16_t* kb = (const bf16_t*)(p.ws + WS_K); const bf16_t* vT = (const bf16_t*)(p.ws + WS_VT);
  const bf16_t* og = (const bf16_t*)(p.ws + WS_OG);
  const float* UT = (const float*)(p.ws + WS_UT); const float* nvec = (const float*)(p.ws + WS_NVEC);
  bf16_t* yA = (bf16_t*)(p.ws + WS_HA);
  const float* ng = p.in[30];
  char* Qs = smem + MLC_QS; char* Ks = smem + MLC_KS; char* Ps = Ks; char* Q2 = smem + MLC_Q2; char* Bs = smem + MLC_BS;
  float* li_f = (float*)(smem + MLC_G); float* cf = li_f + 128; float* li_b = cf + 128; float* cb = li_b + 128;
  float* qn = cb + 128; float* sfq = qn + 128; float* sbq = sfq + 64; float* nv = sbq + 64;
  for (int u = bid; u < 128 * 2 * 8; u += nb) {
    const int h = u % 8, th = (u / 8) & 1, c = u / 16, r0 = c * 128, rt = r0 + th * 64;
    __syncthreads();
    ml_gate_scans(gl, r0, h, li_f, cf, li_b, cb);
    if (tid >= 128) nv[tid - 128] = nvec[(size_t)((c * 8 + h) * 2 + ((tid - 128) >> 6)) * 64 + (tid & 63)];
#pragma unroll
    for (int i = 0; i < 2; ++i) { const int f = tid + 256 * i, r = f >> 3, pc = f & 7;
      *(u32x4*)(Qs + r * 144 + pc * 16) = *(const u32x4*)(qb + (size_t)(rt + r) * 512 + h * 64 + pc * 8); }
#pragma unroll
    for (int i = 0; i < 4; ++i) { const int f = tid + 256 * i, r = f >> 3, pc = f & 7;
      *(u32x4*)(Ks + r * 144 + pc * 16) = *(const u32x4*)(kb + (size_t)(r0 + r) * 512 + h * 64 + pc * 8); }
    __syncthreads();
    if (tid < 128) {
      const int t = tid & 63, dir = tid >> 6; float s = 0.f;
      for (int pc = 0; pc < 8; ++pc) { const u32x4 v = *(const u32x4*)(Qs + t * 144 + pc * 16); const float* nn = nv + dir * 64 + pc * 8;
        s += bflo(v.x) * nn[0] + bfhi(v.x) * nn[1] + bflo(v.y) * nn[2] + bfhi(v.y) * nn[3] + bflo(v.z) * nn[4] + bfhi(v.z) * nn[5] + bflo(v.w) * nn[6] + bfhi(v.w) * nn[7]; }
      qn[dir * 64 + t] = s;
    }
    f32x4 S[8];
#pragma unroll
    for (int n = 0; n < 8; ++n) S[n] = (f32x4){0.f, 0.f, 0.f, 0.f};
#pragma unroll
    for (int ks = 0; ks < 2; ++ks) {
      const bf16x8 a = *(const bf16x8*)(Qs + (wave * 16 + fr) * 144 + (ks * 32 + fq * 8) * 2);
#pragma unroll
      for (int n = 0; n < 8; ++n) {
        const bf16x8 b = *(const bf16x8*)(Ks + (n * 16 + fr) * 144 + (ks * 32 + fq * 8) * 2);
        S[n] = __builtin_amdgcn_mfma_f32_16x16x32_bf16(a, b, S[n], 0, 0, 0);
      }
    }
    __syncthreads();
    float rfv[4], rbv[4];
    {
      float sumf[4] = {0.f, 0.f, 0.f, 0.f}, sumb[4] = {0.f, 0.f, 0.f, 0.f};
      float Sf[8][4], Sb_[8][4];
#pragma unroll
      for (int j = 0; j < 4; ++j) {
        const int tl = wave * 16 + fq * 4 + j, tc = th * 64 + tl;
        const float cft = cf[tc], cbt = cb[tc];
#pragma unroll
        for (int n = 0; n < 8; ++n) {
          const int s = n * 16 + fr;
          const float df = s <= tc ? __expf(cft - cf[s] + li_f[s]) : 0.f;
          const float db = s >= tc ? __expf(cbt - cb[s] + li_b[s]) : 0.f;
          Sf[n][j] = S[n][j] * df; Sb_[n][j] = S[n][j] * db;
          sumf[j] += Sf[n][j]; sumb[j] += Sb_[n][j];
        }
      }
#pragma unroll
      for (int j = 0; j < 4; ++j) {
#pragma unroll
        for (int o = 1; o < 16; o <<= 1) { sumf[j] += __shfl_xor(sumf[j], o); sumb[j] += __shfl_xor(sumb[j], o); }
        const int tl = wave * 16 + fq * 4 + j, tc = th * 64 + tl;
        const float ef = __expf(cf[tc]), eb = __expf(cb[tc]);
        const float denf = ef * qn[tl] + sumf[j], denb = eb * qn[64 + tl] + sumb[j];
        rfv[j] = 1.f / fmaxf(fabsf(denf), 1.f); rbv[j] = 1.f / fmaxf(fabsf(denb), 1.f);
        if (fr == 0) { sfq[tl] = ef * rfv[j]; sbq[tl] = eb * rbv[j]; }
      }
#pragma unroll
      for (int n = 0; n < 8; ++n)
#pragma unroll
        for (int j = 0; j < 4; ++j) {
          const int tl = wave * 16 + fq * 4 + j;
          *(bf16_t*)(Ps + tl * MLA_STRIDE + (n * 16 + fr) * 2) = f2bf(Sf[n][j] * rfv[j] + Sb_[n][j] * rbv[j]);
        }
    }
    __syncthreads();
#pragma unroll
    for (int i = 0; i < 2; ++i) { const int f = tid + 256 * i, r = f >> 3, pc = f & 7;
      const u32x4 v = *(const u32x4*)(Qs + r * 144 + pc * 16); const float a = sfq[r], b = sbq[r];
      u32x4 o1, o2;
      o1.x = pk2(bflo(v.x) * a, bfhi(v.x) * a); o1.y = pk2(bflo(v.y) * a, bfhi(v.y) * a); o1.z = pk2(bflo(v.z) * a, bfhi(v.z) * a); o1.w = pk2(bflo(v.w) * a, bfhi(v.w) * a);
      o2.x = pk2(bflo(v.x) * b, bfhi(v.x) * b); o2.y = pk2(bflo(v.y) * b, bfhi(v.y) * b); o2.z = pk2(bflo(v.z) * b, bfhi(v.z) * b); o2.w = pk2(bflo(v.w) * b, bfhi(v.w) * b);
      *(u32x4*)(Q2 + r * MLA_STRIDE + pc * 16) = o1; *(u32x4*)(Q2 + r * MLA_STRIDE + 128 + pc * 16) = o2; }
    f32x4 Hh[8];
#pragma unroll
    for (int n = 0; n < 8; ++n) Hh[n] = (f32x4){0.f, 0.f, 0.f, 0.f};
#pragma unroll
    for (int kc = 0; kc < 4; ++kc) {
      __syncthreads();
      if (kc < 2) {
#pragma unroll
        for (int i = 0; i < 4; ++i) { const int f = tid + 256 * i, e = f >> 3, pc = f & 7;
          *(u32x4*)(Bs + e * 144 + pc * 16) = *(const u32x4*)(vT + (size_t)(h * 128 + e) * T + r0 + kc * 64 + pc * 8); }
      } else {
        const float* Cs = UT + (size_t)((c * 8 + h) * 2 + (kc - 2)) * 8192;
#pragma unroll
        for (int i = 0; i < 4; ++i) { const int f = tid + 256 * i, e = f >> 3, pc = f & 7;
          const f32x4 a = *(const f32x4*)(Cs + e * 64 + pc * 8), b = *(const f32x4*)(Cs + e * 64 + pc * 8 + 4);
          u32x4 o; o.x = pk2(a.x, a.y); o.y = pk2(a.z, a.w); o.z = pk2(b.x, b.y); o.w = pk2(b.z, b.w);
          *(u32x4*)(Bs + e * 144 + pc * 16) = o; }
      }
      __syncthreads();
      const char* Asrc = kc < 2 ? Ps + kc * 128 : Q2 + (kc - 2) * 128;
#pragma unroll
      for (int ks = 0; ks < 2; ++ks) {
        const bf16x8 a = *(const bf16x8*)(Asrc + (wave * 16 + fr) * MLA_STRIDE + (ks * 32 + fq * 8) * 2);
#pragma unroll
        for (int n = 0; n < 8; ++n) {
          const bf16x8 b = *(const bf16x8*)(Bs + (n * 16 + fr) * 144 + (ks * 32 + fq * 8) * 2);
          Hh[n] = __builtin_amdgcn_mfma_f32_16x16x32_bf16(a, b, Hh[n], 0, 0, 0);
        }
      }
    }
#pragma unroll
    for (int j = 0; j < 4; ++j) {
      float ss = 0.f;
#pragma unroll
      for (int n = 0; n < 8; ++n) ss += Hh[n][j] * Hh[n][j];
#pragma unroll
      for (int o = 1; o < 16; o <<= 1) ss += __shfl_xor(ss, o);
      const float rstd = rsqrtf(ss * (1.f / 128.f) + EPS);
      const size_t row = (size_t)(rt + wave * 16 + fq * 4 + j);
#pragma unroll
      for (int n = 0; n < 8; ++n) {
        const int col = h * 128 + n * 16 + fr;
        yA[row * D + col] = f2bf(Hh[n][j] * rstd * ng[col] * bf2f(og[row * D + col]));
      }
    }
  }
}

DEV void ph_final(const Params& p, int bid, int nb) {
  const int lane = threadIdx.x & 63, wave = threadIdx.x >> 6;
  const float* mods1 = (const float*)(p.ws + WS_MODS) + 2 * 6144;
  const float* x1 = (const float*)(p.ws + WS_X1);
  const bf16_t* Y = (const bf16_t*)(p.ws + WS_Y);
  const float* gf = p.in[39];
  for (int t = bid * 4 + wave; t < NL; t += nb * 4) {
    f32x4 v[4]; float ss = 0.f;
#pragma unroll
    for (int i = 0; i < 4; ++i) {
      const int c = 4 * lane + 256 * i;
      const f32x4 xv = *(const f32x4*)(x1 + (size_t)t * D + c), gt = *(const f32x4*)(mods1 + 5120 + c);
      const u32x2 ya = *(const u32x2*)(Y + (size_t)(2 * t) * D + c), yb = *(const u32x2*)(Y + (size_t)(2 * t + 1) * D + c);
      f32x4 f; f.x = bflo(ya.x) + bflo(yb.x); f.y = bfhi(ya.x) + bfhi(yb.x); f.z = bflo(ya.y) + bflo(yb.y); f.w = bfhi(ya.y) + bfhi(yb.y);
      v[i] = xv + gt * f;
      ss += v[i].x * v[i].x + v[i].y * v[i].y + v[i].z * v[i].z + v[i].w * v[i].w;
    }
    const float rstd = rsqrtf(wave_sum(ss) * (1.f / D) + EPS);
#pragma unroll
    for (int i = 0; i < 4; ++i) {
      const int c = 4 * lane + 256 * i;
      *(f32x4*)(p.out + (size_t)t * D + c) = v[i] * rstd * *(const f32x4*)(gf + c);
    }
  }
}

constexpr int NPHASE = 21;
constexpr int SMEM_BYTES = 79872;
static_assert(RT_SMEM <= SMEM_BYTES && RG_SMEM <= SMEM_BYTES && MLA_SMEM <= SMEM_BYTES && MLC_SMEM <= SMEM_BYTES && GEMM_SMEM <= SMEM_BYTES, "smem");

template <int PH>
DEV void run_phase(const Params& p, char* smem, int bid, int nb) {
  if constexpr (PH == 0) ph_adaln(p, smem, bid, nb);
  else if constexpr (PH == 1) ph_norm0(p, bid, nb);
  else if constexpr (PH == 2) ph_rg_inproj(p, smem, bid, nb);
  else if constexpr (PH == 3) ph_rg_scan(p, smem, bid, nb);
  else if constexpr (PH == 4) ph_rg_carry(p, bid, nb);
  else if constexpr (PH == 5) ph_rg_final(p, bid, nb);
  else if constexpr (PH == 6) ph_outproj<0>(p, smem, bid, nb);
  else if constexpr (PH == 7) ph_router<0>(p, smem, bid, nb);
  else if constexpr (PH == 8) ph_moe1<0>(p, smem, bid, nb);
  else if constexpr (PH == 9) ph_moe2<0>(p, smem, bid, nb);
  else if constexpr (PH == 10) ph_combine0(p, bid, nb);
  else if constexpr (PH == 11) ph_ml_inproj(p, smem, bid, nb);
  else if constexpr (PH == 12) ph_ml_state(p, smem, bid, nb);
  else if constexpr (PH == 13) ph_ml_chain(p, bid, nb);
  else if constexpr (PH == 14) ph_ml_out(p, smem, bid, nb);
  else if constexpr (PH == 15) ph_outproj<1>(p, smem, bid, nb);
  else if constexpr (PH == 16) ph_router<1>(p, smem, bid, nb);
  else if constexpr (PH == 17) ph_moe1<1>(p, smem, bid, nb);
  else if constexpr (PH == 18) ph_moe2<1>(p, smem, bid, nb);
  else if constexpr (PH == 19) ph_final(p, bid, nb);
}

template <int PH>
__global__ void __launch_bounds__(256, 2) phase_kernel(Params p) {
  extern __shared__ __attribute__((aligned(16))) char smem[];
  run_phase<PH>(p, smem, blockIdx.x, gridDim.x);
}

template <int PH>
static void launch_phase(const Params& p, int grid, hipStream_t stream) {
  static bool attr = false;
  if (!attr) { hipFuncSetAttribute((const void*)phase_kernel<PH>, hipFuncAttributeMaxDynamicSharedMemorySize, SMEM_BYTES); attr = true; }
  hipLaunchKernelGGL(phase_kernel<PH>, dim3(grid), dim3(256), SMEM_BYTES, stream, p);
}

extern "C" void kernel_launch(void* const* d_in, const int* in_sizes, int n_in, void* d_out, int out_size, void* d_ws, size_t ws_size, hipStream_t stream) {
  if (n_in != 40 || ws_size < WS_END) { fprintf(stderr, "kernel_launch: unexpected inputs (n_in %d, ws %zu, need %zu)\n", n_in, ws_size, (size_t)WS_END); return; }
  Params p{};
  for (int i = 0; i < 40; ++i) p.in[i] = (const float*)d_in[i];
  p.out = (float*)d_out; p.ws = (char*)d_ws;
  hipMemsetAsync((char*)d_ws, 0, WS_ZERO_BYTES, stream);
  const int G = 1024;
  launch_phase<0>(p, 192, stream);
  launch_phase<1>(p, G, stream);
  launch_phase<2>(p, G, stream);
  launch_phase<3>(p, G, stream);
  launch_phase<4>(p, 10, stream);
  launch_phase<5>(p, G, stream);
  launch_phase<6>(p, G, stream);
  launch_phase<7>(p, G, stream);
  launch_phase<8>(p, G, stream);
  launch_phase<9>(p, G, stream);
  launch_phase<10>(p, G, stream);
  launch_phase<11>(p, G, stream);
  launch_phase<12>(p, G, stream);
  launch_phase<13>(p, 516, stream);
  launch_phase<14>(p, G, stream);
  launch_phase<15>(p, G, stream);
  launch_phase<16>(p, G, stream);
  launch_phase<17>(p, G, stream);
  launch_phase<18>(p, G, stream);
  launch_phase<19>(p, G, stream);
}
```

```cpp
#include <hip/hip_runtime.h>
#include <hip/hip_cooperative_groups.h>
#include <cstdio>
#include <cstdint>
namespace cg = cooperative_groups;

#define DEV __device__ __forceinline__
typedef unsigned short bf16_t;
typedef short bf16x8 __attribute__((ext_vector_type(8)));
typedef short s16x4 __attribute__((ext_vector_type(4)));
typedef float f32x4 __attribute__((ext_vector_type(4)));
typedef unsigned u32x4 __attribute__((ext_vector_type(4)));
typedef unsigned u32x2 __attribute__((ext_vector_type(2)));
#define LAS __attribute__((address_space(3)))

constexpr int D = 1024, NL = 16384, NC = 256, T = NL + NC, NTILE = T / 128;
constexpr int DR = 1280, NEXP = 32, DE = 512;
constexpr int RGT = 64, NRT = T / RGT, NRT_LAT = NL / RGT;
constexpr int MLW = 3104;
constexpr float EPS = 1e-6f;

constexpr size_t al256(size_t x) { return (x + 255) & ~(size_t)255; }
constexpr size_t WS_BAR   = 0;
constexpr size_t WS_CNT   = 16384;
constexpr size_t WS_ZERO_BYTES = 16384 + 256;
constexpr size_t WS_MODS  = 32768;
constexpr size_t WS_LIST  = WS_MODS + al256(2 * 2 * 6144 * 4);
constexpr size_t WS_AW    = WS_LIST + al256((size_t)2 * 32 * T * 4);
constexpr size_t WS_AGG   = WS_AW + al256((size_t)2 * T * 4);
constexpr size_t WS_CARRY = WS_AGG + al256((size_t)2 * NRT * DR * 2 * 4);
constexpr size_t WS_GL    = WS_CARRY + al256((size_t)2 * NRT * DR * 4);
constexpr size_t WS_NVEC  = WS_GL + al256((size_t)T * 32 * 4);
constexpr size_t WS_DEC   = WS_NVEC + al256((size_t)NTILE * 16 * 64 * 4);
constexpr size_t WS_HA    = WS_DEC + al256((size_t)NTILE * 16 * 4);
constexpr size_t WS_X1    = WS_HA + al256((size_t)T * D * 2);
constexpr size_t WS_X2    = WS_X1 + al256((size_t)T * D * 4);
constexpr size_t WS_HM    = WS_X2 + al256((size_t)T * D * 4);
constexpr size_t WS_R0    = WS_HM + al256((size_t)2 * T * DE * 2);
constexpr size_t WS_GG    = WS_R0;
constexpr size_t WS_PR    = WS_GG + al256((size_t)T * DR * 2);
constexpr size_t WS_S     = WS_PR + al256((size_t)T * DR * 2);
constexpr size_t WS_PF    = WS_S + al256((size_t)T * DR * 2);
constexpr size_t WS_PB    = WS_PF + al256((size_t)T * DR * 2);
constexpr size_t WS_R0END = WS_PB + al256((size_t)T * DR * 2);
constexpr size_t WS_Y     = WS_R0;
constexpr size_t WS_Q     = WS_R0 + al256((size_t)2 * T * D * 2);
constexpr size_t WS_K     = WS_Q + al256((size_t)T * 512 * 2);
constexpr size_t WS_KT    = WS_K + al256((size_t)T * 512 * 2);
constexpr size_t WS_VT    = WS_KT + al256((size_t)T * 512 * 2);
constexpr size_t WS_OG    = WS_VT + al256((size_t)T * D * 2);
constexpr size_t WS_UT    = WS_OG + al256((size_t)T * D * 2);
constexpr size_t WS_L1END = WS_UT + al256((size_t)NTILE * 16 * 8192 * 4);
constexpr size_t WS_END   = WS_R0END > WS_L1END ? WS_R0END : WS_L1END;

struct Params {
  const float* in[40];
  float* out;
  char* ws;
};

DEV unsigned pk2(float lo, float hi) { unsigned r; asm("v_cvt_pk_bf16_f32 %0, %1, %2" : "=v"(r) : "v"(lo), "v"(hi)); return r; }
DEV float bflo(unsigned u) { return __uint_as_float(u << 16); }
DEV float bfhi(unsigned u) { return __uint_as_float(u & 0xffff0000u); }
DEV float bf2f(bf16_t b) { return __uint_as_float((unsigned)b << 16); }
DEV bf16_t f2bf(float f) { return (bf16_t)(pk2(f, 0.f) & 0xffffu); }
DEV float sigmoidf_(float x) { return 1.f / (1.f + __expf(-x)); }
DEV float siluf_(float x) { return x / (1.f + __expf(-x)); }
DEV float gelu_tanh(float x) { const float u = 0.7978845608028654f * (x + 0.044715f * x * x * x); return 0.5f * x * (1.f + tanhf(u)); }
DEV float wave_sum(float v) {
#pragma unroll
  for (int o = 1; o < 64; o <<= 1) v += __shfl_xor(v, o);
  return v;
}
DEV s16x4 ldtr(const char* p) { return __builtin_bit_cast(s16x4, __builtin_amdgcn_ds_read_tr16_b64_v4i16((LAS s16x4*)p)); }
DEV int tidx() { int t = threadIdx.x; asm volatile("" : "+v"(t)); return t; }
DEV int seqrow_of_token(int t) { return (t & 63) * 256 + (t >> 6); }
DEV int token_of_seqrow(int s) { return (s & 255) * 64 + (s >> 8); }

constexpr int AS_STRIDE = 144;
constexpr int BS_STRIDE = 320;
constexpr int GEMM_AS = 0, GEMM_BS = 128 * AS_STRIDE, GEMM_SMEM = GEMM_BS + 64 * BS_STRIDE;

DEV int bs_off(int k, int n) { return k * BS_STRIDE + ((((n >> 4) ^ ((k >> 3) & 1))) << 5) + (n & 15) * 2; }

DEV void gemm128(char* smem, int KT, const bf16_t* const (&ap)[4], const float* bp, size_t ldb, bool bvalid, f32x4 (&acc)[4][4]) {
  const int tid = tidx(), lane = tid & 63, wave = tid >> 6, wr = wave >> 1, wc = wave & 1;
  const int fr = lane & 15, fq = lane >> 4, q4 = (lane & 15) >> 2, p4 = lane & 3;
  char* As = smem + GEMM_AS; char* Bs = smem + GEMM_BS;
#pragma unroll
  for (int m = 0; m < 4; ++m)
#pragma unroll
    for (int n = 0; n < 4; ++n) acc[m][n] = (f32x4){0.f, 0.f, 0.f, 0.f};
  u32x4 ra[4]; f32x4 rb[8];
  auto gload = [&](int kt) {
#pragma unroll
    for (int i = 0; i < 4; ++i) ra[i] = *(const u32x4*)(ap[i] + kt * 64);
#pragma unroll
    for (int i = 0; i < 8; ++i) {
      if (bvalid) rb[i] = *(const f32x4*)(bp + (size_t)(kt * 64 + 8 * i) * ldb);
      else rb[i] = (f32x4){0.f, 0.f, 0.f, 0.f};
    }
  };
  const int a_w = ((tid >> 3)) * AS_STRIDE + (tid & 7) * 16;
  const int bk0 = tid >> 5, bn0 = 4 * (tid & 31);
  gload(0);
  for (int kt = 0; kt < KT; ++kt) {
    __syncthreads();
#pragma unroll
    for (int i = 0; i < 4; ++i) *(u32x4*)(As + a_w + i * 32 * AS_STRIDE) = ra[i];
#pragma unroll
    for (int i = 0; i < 8; ++i) {
      u32x2 v; v.x = pk2(rb[i].x, rb[i].y); v.y = pk2(rb[i].z, rb[i].w);
      *(u32x2*)(Bs + bs_off(bk0 + 8 * i, bn0)) = v;
    }
    __syncthreads();
    if (kt + 1 < KT) gload(kt + 1);
#pragma unroll
    for (int ks = 0; ks < 2; ++ks) {
      bf16x8 a[4], b[4];
#pragma unroll
      for (int m = 0; m < 4; ++m) a[m] = *(const bf16x8*)(As + (wr * 64 + m * 16 + fr) * AS_STRIDE + (ks * 32 + fq * 8) * 2);
#pragma unroll
      for (int n = 0; n < 4; ++n) {
        const int ncol = wc * 64 + n * 16 + 4 * p4;
        const s16x4 lo = ldtr(Bs + bs_off(ks * 32 + fq * 8 + q4, ncol));
        const s16x4 hi = ldtr(Bs + bs_off(ks * 32 + fq * 8 + 4 + q4, ncol));
        b[n] = (bf16x8){lo.x, lo.y, lo.z, lo.w, hi.x, hi.y, hi.z, hi.w};
      }
#pragma unroll
      for (int m = 0; m < 4; ++m)
#pragma unroll
        for (int n = 0; n < 4; ++n) acc[m][n] = __builtin_amdgcn_mfma_f32_16x16x32_bf16(a[m], b[n], acc[m][n], 0, 0, 0);
    }
  }
  __syncthreads();
}

DEV void ph_adaln(const Params& p, char* smem, int bid, int nb) {
  float* sc = (float*)smem; float* sx = sc + 1024; f32x4* red = (f32x4*)(sx + 1024);
  const int tid = tidx();
  for (int i = tid; i < 1024; i += 256) { sc[i] = siluf_(p.in[1][i]); sx[i] = siluf_(p.in[3][i]); }
  __syncthreads();
  float* mods = (float*)(p.ws + WS_MODS);
  const int cl = tid & 15, kg = tid >> 4;
  for (int u = bid; u < 192; u += nb) {
    const int l = u / 96, c0 = (u % 96) * 64;
    const float* W = p.in[l ? 24 : 4]; const float* B = p.in[l ? 25 : 5];
    f32x4 ac = {0.f, 0.f, 0.f, 0.f}, ax = {0.f, 0.f, 0.f, 0.f};
    const float* wp = W + (size_t)(kg * 64) * 6144 + c0 + 4 * cl;
#pragma unroll 8
    for (int kk = 0; kk < 64; ++kk) {
      const f32x4 w = *(const f32x4*)(wp + (size_t)kk * 6144);
      const float a = sc[kg * 64 + kk], b = sx[kg * 64 + kk];
      ac += a * w; ax += b * w;
    }
    red[kg * 16 + cl] = ac; red[256 + kg * 16 + cl] = ax;
    __syncthreads();
    if (tid < 32) {
      const int which = tid >> 4, c = tid & 15;
      f32x4 s = {0.f, 0.f, 0.f, 0.f};
      for (int g = 0; g < 16; ++g) s += red[which * 256 + g * 16 + c];
      const f32x4 bb = *(const f32x4*)(B + c0 + 4 * c);
      *(f32x4*)(mods + (size_t)(l * 2 + which) * 6144 + c0 + 4 * c) = s + bb;
    }
    __syncthreads();
  }
}

DEV void ph_norm0(const Params& p, int bid, int nb) {
  const int lane = tidx() & 63, wave = tidx() >> 6;
  const float* mods = (const float*)(p.ws + WS_MODS);
  bf16_t* hA = (bf16_t*)(p.ws + WS_HA);
  const float* g1 = p.in[6];
  for (int r = bid * 4 + wave; r < T; r += nb * 4) {
    const float* src = r < NL ? p.in[0] + (size_t)r * D : p.in[2] + (size_t)(r - NL) * D;
    const float* md = mods + (r < NL ? 0 : 6144);
    f32x4 v[4]; float ss = 0.f;
#pragma unroll
    for (int i = 0; i < 4; ++i) { v[i] = *(const f32x4*)(src + 4 * lane + 256 * i); ss += v[i].x * v[i].x + v[i].y * v[i].y + v[i].z * v[i].z + v[i].w * v[i].w; }
    const float rstd = rsqrtf(wave_sum(ss) * (1.f / D) + EPS);
#pragma unroll
    for (int i = 0; i < 4; ++i) {
      const int c = 4 * lane + 256 * i;
      const f32x4 g = *(const f32x4*)(g1 + c), sh = *(const f32x4*)(md + c), sc = *(const f32x4*)(md + 1024 + c);
      const f32x4 h = v[i] * rstd * g * (1.f + sc) + sh;
      u32x2 o; o.x = pk2(h.x, h.y); o.y = pk2(h.z, h.w);
      *(u32x2*)(hA + (size_t)r * D + c) = o;
    }
  }
}

DEV void ph_rg_inproj(const Params& p, char* smem, int bid, int nb) {
  const int tid = tidx(), lane = tid & 63, wave = tid >> 6, wr = wave >> 1, wc = wave & 1, fr = lane & 15, fq = lane >> 4;
  const bf16_t* hA = (const bf16_t*)(p.ws + WS_HA);
  bf16_t* gg = (bf16_t*)(p.ws + WS_GG); bf16_t* pr = (bf16_t*)(p.ws + WS_PR);
  const float* W = p.in[8];
  for (int u = bid; u < NTILE * 20; u += nb) {
    const int nt = u % 20, mt = u / 20, r0 = mt * 128, n0 = nt * 128;
    const bf16_t* ap[4];
#pragma unroll
    for (int i = 0; i < 4; ++i) ap[i] = hA + (size_t)(r0 + (tid >> 3) + 32 * i) * D + (tid & 7) * 8;
    f32x4 acc[4][4];
    gemm128(smem, 16, ap, W + (size_t)(tid >> 5) * 2560 + n0 + 4 * (tid & 31), 2560, true, acc);
#pragma unroll
    for (int m = 0; m < 4; ++m)
#pragma unroll
      for (int n = 0; n < 4; ++n)
#pragma unroll
        for (int j = 0; j < 4; ++j) {
          const int row = r0 + wr * 64 + m * 16 + fq * 4 + j, col = n0 + wc * 64 + n * 16 + fr;
          const float v = acc[m][n][j];
          if (col < DR) gg[(size_t)row * DR + col] = f2bf(gelu_tanh(v));
          else pr[(size_t)row * DR + col - DR] = f2bf(v);
        }
  }
}

constexpr int RG_AS_STRIDE = 272;
constexpr int RG_MT = RGT / 16;
constexpr int RG_AS = 0, RG_BS = RGT * RG_AS_STRIDE, RG_SMEM = RG_BS + 128 * BS_STRIDE;

template <bool REV>
DEV void rg_scan(f32x4 (&A)[RG_MT][2], f32x4 (&B)[RG_MT][2], float (&aggP)[2], float (&aggH)[2]) {
  const int lane = tidx() & 63, fq = lane >> 4, fr = lane & 15;
#pragma unroll
  for (int n = 0; n < 2; ++n) {
    float cP = 1.f, cH = 0.f;
#pragma unroll
    for (int mm = 0; mm < RG_MT; ++mm) {
      const int m = REV ? RG_MT - 1 - mm : mm;
      float P[4], H[4];
      if (!REV) {
        P[0] = A[m][n][0]; H[0] = B[m][n][0];
#pragma unroll
        for (int j = 1; j < 4; ++j) { P[j] = A[m][n][j] * P[j - 1]; H[j] = A[m][n][j] * H[j - 1] + B[m][n][j]; }
      } else {
        P[3] = A[m][n][3]; H[3] = B[m][n][3];
#pragma unroll
        for (int j = 2; j >= 0; --j) { P[j] = A[m][n][j] * P[j + 1]; H[j] = A[m][n][j] * H[j + 1] + B[m][n][j]; }
      }
      float IP = REV ? P[0] : P[3], IH = REV ? H[0] : H[3];
      float tP, tH;
      tP = REV ? __shfl_down(IP, 16) : __shfl_up(IP, 16); tH = REV ? __shfl_down(IH, 16) : __shfl_up(IH, 16);
      if (REV ? (fq <= 2) : (fq >= 1)) { IH = IP * tH + IH; IP = IP * tP; }
      tP = REV ? __shfl_down(IP, 32) : __shfl_up(IP, 32); tH = REV ? __shfl_down(IH, 32) : __shfl_up(IH, 32);
      if (REV ? (fq <= 1) : (fq >= 2)) { IH = IP * tH + IH; IP = IP * tP; }
      float EP = REV ? __shfl_down(IP, 16) : __shfl_up(IP, 16), EH = REV ? __shfl_down(IH, 16) : __shfl_up(IH, 16);
      if (REV ? (fq == 3) : (fq == 0)) { EP = 1.f; EH = 0.f; }
      const float hin = EP * cH + EH, pin = EP * cP;
#pragma unroll
      for (int j = 0; j < 4; ++j) { B[m][n][j] = H[j] + P[j] * hin; A[m][n][j] = P[j] * pin; }
      const float TP = __shfl(IP, (REV ? 0 : 48) + fr), TH = __shfl(IH, (REV ? 0 : 48) + fr);
      cH = TP * cH + TH; cP = TP * cP;
    }
    aggP[n] = cP; aggH[n] = cH;
  }
}

DEV void ph_rg_scan(const Params& p, char* smem, int bid, int nb) {
  char* As = smem + RG_AS; char* Bs = smem + RG_BS;
  const bf16_t* pr = (const bf16_t*)(p.ws + WS_PR);
  bf16_t* Sb = (bf16_t*)(p.ws + WS_S); bf16_t* Pfb = (bf16_t*)(p.ws + WS_PF); bf16_t* Pbb = (bf16_t*)(p.ws + WS_PB);
  float* agg = (float*)(p.ws + WS_AGG);
  const float* conv_w = p.in[9]; const float* conv_b = p.in[10];
  for (int u = bid; u < NRT * 10; u += nb) {
    const int tid = tidx();
    const int lane = tid & 63, wave = tid >> 6, fr = lane & 15, fq = lane >> 4, q4 = fr >> 2, p4 = lane & 3;
    const int hb = u % 10, tile = u / 10, r0 = tile * RGT, ch0 = hb * 128;
    const int seg_lo = tile < NRT_LAT ? 0 : NL, seg_hi = tile < NRT_LAT ? NL : T;
    __syncthreads();
    {
      const int cg8 = tid & 15, rg = tid >> 4, c = ch0 + 8 * cg8;
      float w[4][8], bias[8];
#pragma unroll
      for (int j = 0; j < 4; ++j) { const f32x4 a = *(const f32x4*)(conv_w + j * DR + c), b = *(const f32x4*)(conv_w + j * DR + c + 4);
        w[j][0] = a.x; w[j][1] = a.y; w[j][2] = a.z; w[j][3] = a.w; w[j][4] = b.x; w[j][5] = b.y; w[j][6] = b.z; w[j][7] = b.w; }
      { const f32x4 a = *(const f32x4*)(conv_b + c), b = *(const f32x4*)(conv_b + c + 4);
        bias[0] = a.x; bias[1] = a.y; bias[2] = a.z; bias[3] = a.w; bias[4] = b.x; bias[5] = b.y; bias[6] = b.z; bias[7] = b.w; }
      float win[4][8];
      auto ldrow = [&](int r, float (&dst)[8]) {
        if (r >= seg_lo && r < seg_hi) { const u32x4 v = *(const u32x4*)(pr + (size_t)r * DR + c);
          dst[0] = bflo(v.x); dst[1] = bfhi(v.x); dst[2] = bflo(v.y); dst[3] = bfhi(v.y); dst[4] = bflo(v.z); dst[5] = bfhi(v.z); dst[6] = bflo(v.w); dst[7] = bfhi(v.w); }
        else {
#pragma unroll
          for (int e = 0; e < 8; ++e) dst[e] = 0.f; }
      };
      const int rb = r0 + rg * 4;
      ldrow(rb - 2, win[0]); ldrow(rb - 1, win[1]); ldrow(rb, win[2]);
#pragma unroll
      for (int t = 0; t < 4; ++t) {
        ldrow(rb + t + 1, win[(t + 3) & 3]);
        float o[8];
#pragma unroll
        for (int e = 0; e < 8; ++e) o[e] = bias[e] + w[0][e] * win[t & 3][e] + w[1][e] * win[(t + 1) & 3][e] + w[2][e] * win[(t + 2) & 3][e] + w[3][e] * win[(t + 3) & 3][e];
        u32x4 ov; ov.x = pk2(o[0], o[1]); ov.y = pk2(o[2], o[3]); ov.z = pk2(o[4], o[5]); ov.w = pk2(o[6], o[7]);
        *(u32x4*)(As + (rg * 4 + t) * RG_AS_STRIDE + cg8 * 16) = ov;
      }
    }
    u32x2 hfk[RG_MT][2];
#pragma unroll
    for (int d = 0; d < 2; ++d) {
      f32x4 accA[RG_MT][2], accX[RG_MT][2];
#pragma unroll
      for (int which = 0; which < 2; ++which) {
        const float* W = (which ? p.in[13] : p.in[11]) + (size_t)(d * 10 + hb) * 16384;
        __syncthreads();
#pragma unroll 1
        for (int ib = 0; ib < 4; ++ib) {
#pragma unroll
          for (int ii = 0; ii < 4; ++ii) {
            const int f = tid + 256 * (ib * 4 + ii), k = f >> 5, n = 4 * (f & 31);
            const f32x4 v = *(const f32x4*)(W + k * 128 + n);
            u32x2 o; o.x = pk2(v.x, v.y); o.y = pk2(v.z, v.w);
            *(u32x2*)(Bs + bs_off(k, n)) = o;
          }
        }
        __syncthreads();
        f32x4 (&acc)[RG_MT][2] = which ? accX : accA;
#pragma unroll
        for (int m = 0; m < RG_MT; ++m) { acc[m][0] = (f32x4){0.f, 0.f, 0.f, 0.f}; acc[m][1] = (f32x4){0.f, 0.f, 0.f, 0.f}; }
#pragma unroll
        for (int ks = 0; ks < 4; ++ks) {
          bf16x8 b[2];
#pragma unroll
          for (int n = 0; n < 2; ++n) {
            const int ncol = wave * 32 + n * 16 + 4 * p4;
            const s16x4 lo = ldtr(Bs + bs_off(ks * 32 + fq * 8 + q4, ncol));
            const s16x4 hi = ldtr(Bs + bs_off(ks * 32 + fq * 8 + 4 + q4, ncol));
            b[n] = (bf16x8){lo.x, lo.y, lo.z, lo.w, hi.x, hi.y, hi.z, hi.w};
          }
#pragma unroll
          for (int m = 0; m < RG_MT; ++m) {
            const bf16x8 a = *(const bf16x8*)(As + (m * 16 + fr) * RG_AS_STRIDE + (ks * 32 + fq * 8) * 2);
            acc[m][0] = __builtin_amdgcn_mfma_f32_16x16x32_bf16(a, b[0], acc[m][0], 0, 0, 0);
            acc[m][1] = __builtin_amdgcn_mfma_f32_16x16x32_bf16(a, b[1], acc[m][1], 0, 0, 0);
          }
        }
      }
#pragma unroll
      for (int n = 0; n < 2; ++n) {
        const int cl = wave * 32 + n * 16 + fr, ch = ch0 + cl;
        const float ba = p.in[12][d * DR + ch], bx = p.in[14][d * DR + ch], lam = p.in[15][d * DR + ch];
        const float nl = -lam;
        const float sp = nl > 20.f ? nl : log1pf(__expf(nl));
        const float c8 = -8.f * sp;
#pragma unroll
        for (int m = 0; m < RG_MT; ++m)
#pragma unroll
          for (int j = 0; j < 4; ++j) {
            const int row = m * 16 + fq * 4 + j;
            const float r = sigmoidf_(accA[m][n][j] + ba), ig = sigmoidf_(accX[m][n][j] + bx);
            const float la = c8 * r;
            const float a = __expf(la);
            const float x2 = 2.f * la;
            const float om = x2 > -0.1f ? -x2 * (1.f + x2 * (0.5f + x2 * (0.16666667f + x2 * 0.041666668f))) : 1.f - a * a;
            const float mult = sqrtf(om);
            const float uu = bf2f(*(const bf16_t*)(As + row * RG_AS_STRIDE + cl * 2));
            accA[m][n][j] = a; accX[m][n][j] = mult * ig * uu;
            if (j == 3) __builtin_amdgcn_sched_barrier(0);
          }
      }
      float aggP[2], aggH[2];
      if (d == 0) rg_scan<false>(accA, accX, aggP, aggH); else rg_scan<true>(accA, accX, aggP, aggH);
      if (fq == 0) {
#pragma unroll
        for (int n = 0; n < 2; ++n) {
          const int ch = ch0 + wave * 32 + n * 16 + fr;
          float* ag = agg + ((size_t)(d * NRT + tile) * DR + ch) * 2;
          ag[0] = aggP[n]; ag[1] = aggH[n];
        }
      }
      bf16_t* Pout = d ? Pbb : Pfb;
#pragma unroll
      for (int m = 0; m < RG_MT; ++m)
#pragma unroll
        for (int n = 0; n < 2; ++n) {
          if (d == 0) { hfk[m][n].x = pk2(accX[m][n][0], accX[m][n][1]); hfk[m][n].y = pk2(accX[m][n][2], accX[m][n][3]); }
          else { accX[m][n][0] += bflo(hfk[m][n].x); accX[m][n][1] += bfhi(hfk[m][n].x); accX[m][n][2] += bflo(hfk[m][n].y); accX[m][n][3] += bfhi(hfk[m][n].y); }
#pragma unroll
          for (int j = 0; j < 4; ++j) {
            const unsigned o = (unsigned)(r0 + m * 16 + fq * 4 + j) * DR + ch0 + wave * 32 + n * 16 + fr;
            Pout[o] = f2bf(accA[m][n][j]);
            if (d == 1) Sb[o] = f2bf(accX[m][n][j]);
          }
          __builtin_amdgcn_sched_barrier(0);
        }
    }
  }
}

DEV void ph_rg_carry(const Params& p, int bid, int nb) {
  const float* agg = (const float*)(p.ws + WS_AGG); float* carry = (float*)(p.ws + WS_CARRY);
  for (int i = bid * 256 + tidx(); i < 2 * DR; i += nb * 256) {
    const int d = i / DR, ch = i % DR;
    float st = 0.f;
    for (int s = 0; s < NRT; ++s) {
      int tile;
      if (d == 0) tile = s < (NRT - NRT_LAT) ? NRT_LAT + s : s - (NRT - NRT_LAT);
      else tile = NRT - 1 - s;
      const float* ag = agg + ((size_t)(d * NRT + tile) * DR + ch) * 2;
      carry[(size_t)(d * NRT + tile) * DR + ch] = st;
      st = ag[0] * st + ag[1];
    }
  }
}

DEV void ph_rg_final(const Params& p, int bid, int nb) {
  const bf16_t* gg = (const bf16_t*)(p.ws + WS_GG); const bf16_t* Sb = (const bf16_t*)(p.ws + WS_S);
  const bf16_t* Pfb = (const bf16_t*)(p.ws + WS_PF); const bf16_t* Pbb = (const bf16_t*)(p.ws + WS_PB);
  const float* carry = (const float*)(p.ws + WS_CARRY);
  bf16_t* y = (bf16_t*)(p.ws + WS_PR);
  const int total = T * (DR / 8);
  for (int i = bid * 256 + tidx(); i < total; i += nb * 256) {
    const int r = i / 160, c = (i % 160) * 8, tile = r / RGT;
    const size_t o = (size_t)r * DR + c;
    const u32x4 g = *(const u32x4*)(gg + o), s = *(const u32x4*)(Sb + o), pf = *(const u32x4*)(Pfb + o), pb = *(const u32x4*)(Pbb + o);
    const float* cf = carry + (size_t)tile * DR + c; const float* cb = carry + (size_t)(NRT + tile) * DR + c;
    const f32x4 cf0 = *(const f32x4*)cf, cf1 = *(const f32x4*)(cf + 4), cb0 = *(const f32x4*)cb, cb1 = *(const f32x4*)(cb + 4);
    u32x4 o4;
    o4.x = pk2(bflo(g.x) * (bflo(s.x) + bflo(pf.x) * cf0.x + bflo(pb.x) * cb0.x), bfhi(g.x) * (bfhi(s.x) + bfhi(pf.x) * cf0.y + bfhi(pb.x) * cb0.y));
    o4.y = pk2(bflo(g.y) * (bflo(s.y) + bflo(pf.y) * cf0.z + bflo(pb.y) * cb0.z), bfhi(g.y) * (bfhi(s.y) + bfhi(pf.y) * cf0.w + bfhi(pb.y) * cb0.w));
    o4.z = pk2(bflo(g.z) * (bflo(s.z) + bflo(pf.z) * cf1.x + bflo(pb.z) * cb1.x), bfhi(g.z) * (bfhi(s.z) + bfhi(pf.z) * cf1.y + bfhi(pb.z) * cb1.y));
    o4.w = pk2(bflo(g.w) * (bflo(s.w) + bflo(pf.w) * cf1.z + bflo(pb.w) * cb1.z), bfhi(g.w) * (bfhi(s.w) + bfhi(pf.w) * cf1.w + bfhi(pb.w) * cb1.w));
    *(u32x4*)(y + o) = o4;
  }
}

template <int LAYER>
DEV void ph_outproj(const Params& p, char* smem, int bid, int nb) {
  const int tid = tidx(), lane = tid & 63, wave = tid >> 6, wr = wave >> 1, wc = wave & 1, fr = lane & 15, fq = lane >> 4;
  const float* mods = (const float*)(p.ws + WS_MODS) + LAYER * 2 * 6144;
  float* x1 = (float*)(p.ws + WS_X1);
  const float* x2 = (const float*)(p.ws + WS_X2);
  const int KD = LAYER == 0 ? DR : D, MT = LAYER == 0 ? NTILE : 128;
  const bf16_t* A = (const bf16_t*)(p.ws + (LAYER == 0 ? WS_PR : WS_HA));
  const float* W = p.in[LAYER == 0 ? 16 : 31];
  for (int u = bid; u < MT * 8; u += nb) {
    const int nt = u % 8, mt = u / 8, r0 = mt * 128, n0 = nt * 128;
    const bf16_t* ap[4];
#pragma unroll
    for (int i = 0; i < 4; ++i) ap[i] = A + (size_t)(r0 + (tid >> 3) + 32 * i) * KD + (tid & 7) * 8;
    f32x4 acc[4][4];
    gemm128(smem, KD / 64, ap, W + (size_t)(tid >> 5) * D + n0 + 4 * (tid & 31), D, true, acc);
#pragma unroll
    for (int m = 0; m < 4; ++m)
#pragma unroll
      for (int j = 0; j < 4; ++j) {
        const int row = r0 + wr * 64 + m * 16 + fq * 4 + j;
        const int trow = LAYER == 0 ? row : token_of_seqrow(row);
        const float* xin = LAYER == 0 ? (row < NL ? p.in[0] + (size_t)row * D : p.in[2] + (size_t)(row - NL) * D) : x2 + (size_t)trow * D;
        const float* gt = mods + ((LAYER == 0 && row >= NL) ? 6144 : 0) + 2048;
#pragma unroll
        for (int n = 0; n < 4; ++n) {
          const int col = n0 + wc * 64 + n * 16 + fr;
          x1[(size_t)trow * D + col] = xin[col] + gt[col] * acc[m][n][j];
        }
      }
  }
}

constexpr int RT_STRIDE = 1028;
constexpr int RT_H2 = 0, RT_RED = 16 * RT_STRIDE * 4, RT_SMEM = RT_RED + 4 * 16 * 48 * 4;
template <int LAYER>
DEV void ph_router(const Params& p, char* smem, int bid, int nb) {
  const int tid = tidx(), lane = tid & 63, wave = tid >> 6;
  constexpr int NTOK = LAYER == 0 ? T : NL;
  const float* mods = (const float*)(p.ws + WS_MODS) + LAYER * 2 * 6144;
  const float* x1 = (const float*)(p.ws + WS_X1);
  bf16_t* hA = (bf16_t*)(p.ws + WS_HA);
  const float* g2 = p.in[LAYER == 0 ? 7 : 27];
  const float* Wg = p.in[LAYER == 0 ? 17 : 32]; const float* Bg = p.in[LAYER == 0 ? 18 : 33];
  const float* We = p.in[LAYER == 0 ? 19 : 34]; const float* Be = p.in[LAYER == 0 ? 20 : 35];
  int* cnt = (int*)(p.ws + WS_CNT) + LAYER * 32;
  int* list = (int*)(p.ws + WS_LIST) + (size_t)LAYER * 32 * T;
  float* aw = (float*)(p.ws + WS_AW);
  float* h2s = (float*)(smem + RT_H2); float* red = (float*)(smem + RT_RED);
  for (int u = bid; u < NTOK / 16; u += nb) {
    const int t0 = u * 16;
    __syncthreads();
#pragma unroll
    for (int rr = 0; rr < 4; ++rr) {
      const int lr = wave * 4 + rr, t = t0 + lr;
      const float* md = mods + ((LAYER == 0 && t >= NL) ? 6144 : 0);
      const float* src = x1 + (size_t)t * D;
      f32x4 v[4]; float ss = 0.f;
#pragma unroll
      for (int i = 0; i < 4; ++i) { v[i] = *(const f32x4*)(src + 4 * lane + 256 * i); ss += v[i].x * v[i].x + v[i].y * v[i].y + v[i].z * v[i].z + v[i].w * v[i].w; }
      const float rstd = rsqrtf(wave_sum(ss) * (1.f / D) + EPS);
#pragma unroll
      for (int i = 0; i < 4; ++i) {
        const int c = 4 * lane + 256 * i;
        const f32x4 g = *(const f32x4*)(g2 + c), sh = *(const f32x4*)(md + 3072 + c), sc = *(const f32x4*)(md + 4096 + c);
        const f32x4 h = v[i] * rstd * g * (1.f + sc) + sh;
        *(f32x4*)(h2s + lr * RT_STRIDE + c) = h;
        u32x2 o; o.x = pk2(h.x, h.y); o.y = pk2(h.z, h.w);
        *(u32x2*)(hA + (size_t)t * D + c) = o;
      }
    }
    __syncthreads();
    {
      f32x4 a0 = {0.f, 0.f, 0.f, 0.f}, a1 = a0, a2 = a0;
      const int tok = lane & 15, kk = lane >> 4;
#pragma unroll 4
      for (int s = 0; s < 64; ++s) {
        const int k = wave * 256 + s * 4 + kk;
        const float a = h2s[tok * RT_STRIDE + k];
        const float b0 = We[k * 32 + tok], b1 = We[k * 32 + 16 + tok];
        const float b2 = tok < 4 ? Wg[k * 4 + tok] : 0.f;
        a0 = __builtin_amdgcn_mfma_f32_16x16x4f32(a, b0, a0, 0, 0, 0);
        a1 = __builtin_amdgcn_mfma_f32_16x16x4f32(a, b1, a1, 0, 0, 0);
        a2 = __builtin_amdgcn_mfma_f32_16x16x4f32(a, b2, a2, 0, 0, 0);
      }
#pragma unroll
      for (int j = 0; j < 4; ++j) {
        float* rp = red + ((wave * 16) + kk * 4 + j) * 48;
        rp[tok] = a0[j]; rp[16 + tok] = a1[j]; rp[32 + tok] = a2[j];
      }
    }
    __syncthreads();
    if (tid < 16) {
      const int t = t0 + tid;
      auto lg = [&](int c) { return red[(0 * 16 + tid) * 48 + c] + red[(1 * 16 + tid) * 48 + c] + red[(2 * 16 + tid) * 48 + c] + red[(3 * 16 + tid) * 48 + c]; };
      float gl[4];
#pragma unroll
      for (int i = 0; i < 4; ++i) gl[i] = lg(32 + i) + Bg[i];
      int grp = 0; float gm = gl[0];
#pragma unroll
      for (int i = 1; i < 4; ++i) if (gl[i] > gm) { gm = gl[i]; grp = i; }
      float den = 0.f;
#pragma unroll
      for (int i = 0; i < 4; ++i) den += __expf(gl[i] - gm);
      const float psel = 1.f / den;
      float v0 = -INFINITY, v1 = -INFINITY; int i0 = 0, i1 = 0;
      for (int i = 0; i < 8; ++i) {
        const float v = lg(grp * 8 + i) + Be[grp * 8 + i];
        if (v > v0) { v1 = v0; i1 = i0; v0 = v; i0 = i; }
        else if (v > v1) { v1 = v; i1 = i; }
      }
      const float e1 = __expf(v1 - v0);
      const float w0 = psel / (1.f + e1), w1 = psel * e1 / (1.f + e1);
      const int ea = grp * 8 + i0, eb = grp * 8 + i1;
      const int pa = atomicAdd(&cnt[ea], 1); list[(size_t)ea * T + pa] = 2 * t;
      const int pb = atomicAdd(&cnt[eb], 1); list[(size_t)eb * T + pb] = 2 * t + 1;
      aw[2 * t] = w0; aw[2 * t + 1] = w1;
    }
  }
}

DEV int moe_find(const int* cnt, int u, int ntile_n, int& e, int& mt, int& nt, int& ce) {
  int base = 0;
  for (int i = 0; i < NEXP; ++i) {
    const int c = cnt[i], m = (c + 127) >> 7, tot = m * ntile_n;
    if (u < base + tot) { const int r = u - base; e = i; nt = r / m; mt = r % m; ce = c; return 1; }
    base += tot;
  }
  return 0;
}
template <int LAYER>
DEV void ph_moe1(const Params& p, char* smem, int bid, int nb) {
  const int tid = tidx(), lane = tid & 63, wave = tid >> 6, wr = wave >> 1, wc = wave & 1, fr = lane & 15, fq = lane >> 4;
  const int* cnt = (const int*)(p.ws + WS_CNT) + LAYER * 32;
  const int* list = (const int*)(p.ws + WS_LIST) + (size_t)LAYER * 32 * T;
  const bf16_t* hA = (const bf16_t*)(p.ws + WS_HA);
  bf16_t* Hm = (bf16_t*)(p.ws + WS_HM);
  const float* Wgate = p.in[LAYER == 0 ? 21 : 36]; const float* Wup = p.in[LAYER == 0 ? 22 : 37];
  for (int u = bid;; u += nb) {
    int e, mt, nt, ce;
    if (!moe_find(cnt, u, 8, e, mt, nt, ce)) break;
    const int* le = list + (size_t)e * T + mt * 128;
    const int nrow = min(128, ce - mt * 128);
    const bf16_t* ap[4];
#pragma unroll
    for (int i = 0; i < 4; ++i) { const int m = (tid >> 3) + 32 * i; const int ent = le[m < nrow ? m : 0]; ap[i] = hA + (size_t)(ent >> 1) * D + (tid & 7) * 8; }
    const int c = 4 * (tid & 31), wcc = c >> 6, nn = (c >> 4) & 3;
    const float* bp = (nn < 2 ? Wgate : Wup) + (size_t)e * D * DE + (size_t)(tid >> 5) * DE + nt * 64 + wcc * 32 + (nn & 1) * 16 + (c & 15);
    f32x4 acc[4][4];
    gemm128(smem, 16, ap, bp, DE, true, acc);
#pragma unroll
    for (int m = 0; m < 4; ++m)
#pragma unroll
      for (int j = 0; j < 4; ++j) {
        const int row = wr * 64 + m * 16 + fq * 4 + j;
        if (row < nrow) {
          const int ent = le[row];
#pragma unroll
          for (int n = 0; n < 2; ++n) {
            const float g = acc[m][n][j], uu = acc[m][n + 2][j];
            Hm[(size_t)ent * DE + nt * 64 + wc * 32 + n * 16 + fr] = f2bf(siluf_(g) * uu);
          }
        }
      }
  }
}
template <int LAYER>
DEV void ph_moe2(const Params& p, char* smem, int bid, int nb) {
  const int tid = tidx(), lane = tid & 63, wave = tid >> 6, wr = wave >> 1, wc = wave & 1, fr = lane & 15, fq = lane >> 4;
  const int* cnt = (const int*)(p.ws + WS_CNT) + LAYER * 32;
  const int* list = (const int*)(p.ws + WS_LIST) + (size_t)LAYER * 32 * T;
  const bf16_t* Hm = (const bf16_t*)(p.ws + WS_HM);
  const float* aw = (const float*)(p.ws + WS_AW);
  bf16_t* Y = (bf16_t*)(p.ws + WS_Y);
  const float* Wd = p.in[LAYER == 0 ? 23 : 38];
  for (int u = bid;; u += nb) {
    int e, mt, nt, ce;
    if (!moe_find(cnt, u, 8, e, mt, nt, ce)) break;
    const int* le = list + (size_t)e * T + mt * 128;
    const int nrow = min(128, ce - mt * 128);
    const bf16_t* ap[4];
#pragma unroll
    for (int i = 0; i < 4; ++i) { const int m = (tid >> 3) + 32 * i; const int ent = le[m < nrow ? m : 0]; ap[i] = Hm + (size_t)ent * DE + (tid & 7) * 8; }
    const float* bp = Wd + (size_t)e * DE * D + (size_t)(tid >> 5) * D + nt * 128 + 4 * (tid & 31);
    f32x4 acc[4][4];
    gemm128(smem, 8, ap, bp, D, true, acc);
#pragma unroll
    for (int m = 0; m < 4; ++m)
#pragma unroll
      for (int j = 0; j < 4; ++j) {
        const int row = wr * 64 + m * 16 + fq * 4 + j;
        if (row < nrow) {
          const int ent = le[row]; const float w = aw[ent];
#pragma unroll
          for (int n = 0; n < 4; ++n) Y[(size_t)ent * D + nt * 128 + wc * 64 + n * 16 + fr] = f2bf(w * acc[m][n][j]);
        }
      }
  }
}

DEV void ph_combine0(const Params& p, int bid, int nb) {
  const int lane = tidx() & 63, wave = tidx() >> 6;
  const float* mods0 = (const float*)(p.ws + WS_MODS); const float* mods1 = mods0 + 2 * 6144;
  const float* x1 = (const float*)(p.ws + WS_X1); float* x2 = (float*)(p.ws + WS_X2);
  const bf16_t* Y = (const bf16_t*)(p.ws + WS_Y);
  bf16_t* hA = (bf16_t*)(p.ws + WS_HA);
  const float* g1 = p.in[26];
  for (int t = bid * 4 + wave; t < T; t += nb * 4) {
    const float* m0 = mods0 + (t < NL ? 0 : 6144); const float* m1 = mods1 + (t < NL ? 0 : 6144);
    const int orow = t < NL ? seqrow_of_token(t) : t;
    f32x4 v[4]; float ss = 0.f;
#pragma unroll
    for (int i = 0; i < 4; ++i) {
      const int c = 4 * lane + 256 * i;
      const f32x4 xv = *(const f32x4*)(x1 + (size_t)t * D + c), gt = *(const f32x4*)(m0 + 5120 + c);
      const u32x2 ya = *(const u32x2*)(Y + (size_t)(2 * t) * D + c), yb = *(const u32x2*)(Y + (size_t)(2 * t + 1) * D + c);
      f32x4 f; f.x = bflo(ya.x) + bflo(yb.x); f.y = bfhi(ya.x) + bfhi(yb.x); f.z = bflo(ya.y) + bflo(yb.y); f.w = bfhi(ya.y) + bfhi(yb.y);
      v[i] = xv + gt * f;
      *(f32x4*)(x2 + (size_t)t * D + c) = v[i];
      ss += v[i].x * v[i].x + v[i].y * v[i].y + v[i].z * v[i].z + v[i].w * v[i].w;
    }
    const float rstd = rsqrtf(wave_sum(ss) * (1.f / D) + EPS);
#pragma unroll
    for (int i = 0; i < 4; ++i) {
      const int c = 4 * lane + 256 * i;
      const f32x4 g = *(const f32x4*)(g1 + c), sh = *(const f32x4*)(m1 + c), sc = *(const f32x4*)(m1 + 1024 + c);
      const f32x4 h = v[i] * rstd * g * (1.f + sc) + sh;
      u32x2 o; o.x = pk2(h.x, h.y); o.y = pk2(h.z, h.w);
      *(u32x2*)(hA + (size_t)orow * D + c) = o;
    }
  }
}

DEV void ph_ml_inproj(const Params& p, char* smem, int bid, int nb) {
  const int tid = tidx(), lane = tid & 63, wave = tid >> 6, wr = wave >> 1, wc = wave & 1, fr = lane & 15, fq = lane >> 4;
  const bf16_t* hA = (const bf16_t*)(p.ws + WS_HA);
  bf16_t* qb = (bf16_t*)(p.ws + WS_Q); bf16_t* kb = (bf16_t*)(p.ws + WS_K); bf16_t* kT = (bf16_t*)(p.ws + WS_KT);
  bf16_t* vT = (bf16_t*)(p.ws + WS_VT); bf16_t* og = (bf16_t*)(p.ws + WS_OG); float* gl = (float*)(p.ws + WS_GL);
  const float* W = p.in[28]; const float* bgt = p.in[29];
  for (int u = bid; u < NTILE * 25; u += nb) {
    const int nt = u % 25, mt = u / 25, r0 = mt * 128, n0 = nt * 128;
    const bf16_t* ap[4];
#pragma unroll
    for (int i = 0; i < 4; ++i) ap[i] = hA + (size_t)(r0 + (tid >> 3) + 32 * i) * D + (tid & 7) * 8;
    const int bc = n0 + 4 * (tid & 31);
    const bool bvalid = bc < MLW;
    f32x4 acc[4][4];
    gemm128(smem, 16, ap, W + (size_t)(tid >> 5) * MLW + (bvalid ? bc : 0), MLW, bvalid, acc);
#pragma unroll
    for (int n = 0; n < 4; ++n) {
      const int col = n0 + wc * 64 + n * 16 + fr;
      if (col >= MLW) continue;
#pragma unroll
      for (int m = 0; m < 4; ++m) {
        const int rowb = r0 + wr * 64 + m * 16 + fq * 4;
        const f32x4 v = acc[m][n];
        if (col < 512) {
#pragma unroll
          for (int j = 0; j < 4; ++j) qb[(size_t)(rowb + j) * 512 + col] = f2bf(v[j] * 0.125f);
        } else if (col < 1024) {
#pragma unroll
          for (int j = 0; j < 4; ++j) kb[(size_t)(rowb + j) * 512 + col - 512] = f2bf(v[j]);
          u32x2 o; o.x = pk2(v[0], v[1]); o.y = pk2(v[2], v[3]);
          *(u32x2*)(kT + (size_t)(col - 512) * T + rowb) = o;
        } else if (col < 2048) {
          u32x2 o; o.x = pk2(v[0], v[1]); o.y = pk2(v[2], v[3]);
          *(u32x2*)(vT + (size_t)(col - 1024) * T + rowb) = o;
        } else if (col < 3072) {
#pragma unroll
          for (int j = 0; j < 4; ++j) og[(size_t)(rowb + j) * D + col - 2048] = f2bf(sigmoidf_(v[j]));
        } else {
          const int jj = col - 3072; const float bb = bgt[jj];
#pragma unroll
          for (int j = 0; j < 4; ++j) {
            const float g = v[j] + bb;
            gl[(size_t)(rowb + j) * 32 + jj] = ((jj >> 3) & 1) ? (fminf(g, 0.f) - log1pf(__expf(-fabsf(g)))) : g;
          }
        }
      }
    }
  }
}

DEV void ml_gate_scans(const float* gl, int r0, int h, float* li_f, float* cf, float* li_b, float* cb) {
  const int tid = tidx(), lane = tid & 63, wave = tid >> 6;
  if (tid < 128) { li_f[tid] = gl[(size_t)(r0 + tid) * 32 + h]; li_b[tid] = gl[(size_t)(r0 + tid) * 32 + 16 + h]; }
  if (wave == 0) {
    const float v0 = gl[(size_t)(r0 + 2 * lane) * 32 + 8 + h], v1 = gl[(size_t)(r0 + 2 * lane + 1) * 32 + 8 + h];
    const float s = v0 + v1; float inc = s;
#pragma unroll
    for (int o = 1; o < 64; o <<= 1) { const float t = __shfl_up(inc, o); if (lane >= o) inc += t; }
    const float ex = inc - s;
    cf[2 * lane] = ex + v0; cf[2 * lane + 1] = ex + s;
  } else if (wave == 1) {
    const float v0 = gl[(size_t)(r0 + 127 - 2 * lane) * 32 + 24 + h], v1 = gl[(size_t)(r0 + 126 - 2 * lane) * 32 + 24 + h];
    const float s = v0 + v1; float inc = s;
#pragma unroll
    for (int o = 1; o < 64; o <<= 1) { const float t = __shfl_up(inc, o); if (lane >= o) inc += t; }
    const float ex = inc - s;
    cb[127 - 2 * lane] = ex + v0; cb[126 - 2 * lane] = ex + s;
  }
}

constexpr int MLA_STRIDE = 272;
constexpr int MLA_AW = 0, MLA_BV = 2 * 64 * MLA_STRIDE, MLA_G = MLA_BV + 128 * MLA_STRIDE, MLA_SMEM = MLA_G + 6 * 128 * 4;
DEV void ph_ml_state(const Params& p, char* smem, int bid, int nb) {
  const int tid = tidx(), lane = tid & 63, wave = tid >> 6, fr = lane & 15, fq = lane >> 4;
  const float* gl = (const float*)(p.ws + WS_GL);
  const bf16_t* kT = (const bf16_t*)(p.ws + WS_KT); const bf16_t* vT = (const bf16_t*)(p.ws + WS_VT);
  float* UT = (float*)(p.ws + WS_UT); float* nvec = (float*)(p.ws + WS_NVEC); float* dec = (float*)(p.ws + WS_DEC);
  char* Aw = smem + MLA_AW; char* Bv = smem + MLA_BV;
  float* li_f = (float*)(smem + MLA_G); float* cf = li_f + 128; float* li_b = cf + 128; float* cb = li_b + 128; float* wf = cb + 128; float* wb = wf + 128;
  for (int u = bid; u < NTILE * 8; u += nb) {
    const int h = u % 8, c = u / 8, r0 = c * 128;
    __syncthreads();
    ml_gate_scans(gl, r0, h, li_f, cf, li_b, cb);
    __syncthreads();
    if (tid < 128) { wf[tid] = __expf(cf[127] - cf[tid] + li_f[tid]); wb[tid] = __expf(cb[0] - cb[tid] + li_b[tid]); }
    if (tid == 0) { dec[(c * 8 + h) * 2] = __expf(cf[127]); dec[(c * 8 + h) * 2 + 1] = __expf(cb[0]); }
#pragma unroll
    for (int i = 0; i < 8; ++i) {
      const int f = tid + 256 * i, e = f >> 4, pc = f & 15;
      *(u32x4*)(Bv + e * MLA_STRIDE + pc * 16) = *(const u32x4*)(vT + (size_t)(h * 128 + e) * T + r0 + pc * 8);
    }
    __syncthreads();
#pragma unroll
    for (int i = 0; i < 4; ++i) {
      const int f = tid + 256 * i, d = f >> 4, pc = f & 15;
      const u32x4 kv = *(const u32x4*)(kT + (size_t)(h * 64 + d) * T + r0 + pc * 8);
      float k8[8] = {bflo(kv.x), bfhi(kv.x), bflo(kv.y), bfhi(kv.y), bflo(kv.z), bfhi(kv.z), bflo(kv.w), bfhi(kv.w)};
      u32x4 of, ob;
      of.x = pk2(k8[0] * wf[pc * 8 + 0], k8[1] * wf[pc * 8 + 1]); of.y = pk2(k8[2] * wf[pc * 8 + 2], k8[3] * wf[pc * 8 + 3]);
      of.z = pk2(k8[4] * wf[pc * 8 + 4], k8[5] * wf[pc * 8 + 5]); of.w = pk2(k8[6] * wf[pc * 8 + 6], k8[7] * wf[pc * 8 + 7]);
      ob.x = pk2(k8[0] * wb[pc * 8 + 0], k8[1] * wb[pc * 8 + 1]); ob.y = pk2(k8[2] * wb[pc * 8 + 2], k8[3] * wb[pc * 8 + 3]);
      ob.z = pk2(k8[4] * wb[pc * 8 + 4], k8[5] * wb[pc * 8 + 5]); ob.w = pk2(k8[6] * wb[pc * 8 + 6], k8[7] * wb[pc * 8 + 7]);
      *(u32x4*)(Aw + d * MLA_STRIDE + pc * 16) = of;
      *(u32x4*)(Aw + (64 + d) * MLA_STRIDE + pc * 16) = ob;
    }
    __syncthreads();
    if (tid < 128) {
      float s = 0.f;
      for (int pc = 0; pc < 16; ++pc) { const u32x4 v = *(const u32x4*)(Aw + tid * MLA_STRIDE + pc * 16);
        s += (bflo(v.x) + bfhi(v.x)) + (bflo(v.y) + bfhi(v.y)) + (bflo(v.z) + bfhi(v.z)) + (bflo(v.w) + bfhi(v.w)); }
      nvec[(size_t)((c * 8 + h) * 2 + (tid >> 6)) * 64 + (tid & 63)] = s;
    }
#pragma unroll
    for (int dir = 0; dir < 2; ++dir) {
      f32x4 acc[4][2];
#pragma unroll
      for (int m = 0; m < 4; ++m) { acc[m][0] = (f32x4){0.f, 0.f, 0.f, 0.f}; acc[m][1] = (f32x4){0.f, 0.f, 0.f, 0.f}; }
#pragma unroll
      for (int ks = 0; ks < 4; ++ks) {
        bf16x8 b[2];
#pragma unroll
        for (int n = 0; n < 2; ++n) b[n] = *(const bf16x8*)(Bv + (wave * 32 + n * 16 + fr) * MLA_STRIDE + (ks * 32 + fq * 8) * 2);
#pragma unroll
        for (int m = 0; m < 4; ++m) {
          const bf16x8 a = *(const bf16x8*)(Aw + (dir * 64 + m * 16 + fr) * MLA_STRIDE + (ks * 32 + fq * 8) * 2);
          acc[m][0] = __builtin_amdgcn_mfma_f32_16x16x32_bf16(a, b[0], acc[m][0], 0, 0, 0);
          acc[m][1] = __builtin_amdgcn_mfma_f32_16x16x32_bf16(a, b[1], acc[m][1], 0, 0, 0);
        }
      }
      float* Uo = UT + (size_t)((c * 8 + h) * 2 + dir) * 8192;
#pragma unroll
      for (int m = 0; m < 4; ++m)
#pragma unroll
        for (int n = 0; n < 2; ++n) *(f32x4*)(Uo + (wave * 32 + n * 16 + fr) * 64 + m * 16 + fq * 4) = acc[m][n];
    }
  }
}

DEV void ph_ml_chain(const Params& p, int bid, int nb) {
  float* UT = (float*)(p.ws + WS_UT); float* nvec = (float*)(p.ws + WS_NVEC); const float* dec = (const float*)(p.ws + WS_DEC);
  const int total = 16 * (8192 + 64);
  for (int i = bid * 256 + tidx(); i < total; i += nb * 256) {
    const int hd = i / 8256, idx = i % 8256;
    const int dir = hd & 1;
    float st = 0.f;
    for (int s = 0; s < NTILE; ++s) {
      int c;
      if (dir == 0) c = s < 2 ? 128 + s : s - 2; else c = 129 - s;
      float* ptr = idx < 8192 ? UT + (size_t)(c * 16 + hd) * 8192 + idx : nvec + (size_t)(c * 16 + hd) * 64 + (idx - 8192);
      const float uv = *ptr; const float dc = dec[c * 16 + hd];
      *ptr = st;
      st = dc * st + uv;
    }
  }
}

constexpr int MLC_QS = 0;
constexpr int MLC_KS = 9216;
constexpr int MLC_Q2 = MLC_KS + 18432;
constexpr int MLC_BS = MLC_Q2 + 17408;
constexpr int MLC_G  = MLC_BS + 18432;
constexpr int MLC_SMEM = MLC_G + (4 * 128 + 6 * 64) * 4;
DEV void ph_ml_out(const Params& p, char* smem, int bid, int nb) {
  const int tid = tidx(), lane = tid & 63, wave = tid >> 6, fr = lane & 15, fq = lane >> 4;
  const float* gl = (const float*)(p.ws + WS_GL);
  const bf16_t* qb = (const bf16_t*)(p.ws + WS_Q); const bf16_t* kb = (const bf16_t*)(p.ws + WS_K); const bf16_t* vT = (const bf16_t*)(p.ws + WS_VT);
  const bf16_t* og = (const bf16_t*)(p.ws + WS_OG);
  const float* UT = (const float*)(p.ws + WS_UT); const float* nvec = (const float*)(p.ws + WS_NVEC);
  bf16_t* yA = (bf16_t*)(p.ws + WS_HA);
  const float* ng = p.in[30];
  char* Qs = smem + MLC_QS; char* Ks = smem + MLC_KS; char* Ps = Ks; char* Q2 = smem + MLC_Q2; char* Bs = smem + MLC_BS;
  float* li_f = (float*)(smem + MLC_G); float* cf = li_f + 128; float* li_b = cf + 128; float* cb = li_b + 128;
  float* qn = cb + 128; float* sfq = qn + 128; float* sbq = sfq + 64; float* nv = sbq + 64;
  for (int u = bid; u < 128 * 2 * 8; u += nb) {
    const int h = u % 8, th = (u / 8) & 1, c = u / 16, r0 = c * 128, rt = r0 + th * 64;
    __syncthreads();
    ml_gate_scans(gl, r0, h, li_f, cf, li_b, cb);
    if (tid >= 128) nv[tid - 128] = nvec[(size_t)((c * 8 + h) * 2 + ((tid - 128) >> 6)) * 64 + (tid & 63)];
#pragma unroll
    for (int i = 0; i < 2; ++i) { const int f = tid + 256 * i, r = f >> 3, pc = f & 7;
      *(u32x4*)(Qs + r * 144 + pc * 16) = *(const u32x4*)(qb + (size_t)(rt + r) * 512 + h * 64 + pc * 8); }
#pragma unroll
    for (int i = 0; i < 4; ++i) { const int f = tid + 256 * i, r = f >> 3, pc = f & 7;
      *(u32x4*)(Ks + r * 144 + pc * 16) = *(const u32x4*)(kb + (size_t)(r0 + r) * 512 + h * 64 + pc * 8); }
    __syncthreads();
    if (tid < 128) {
      const int t = tid & 63, dir = tid >> 6; float s = 0.f;
      for (int pc = 0; pc < 8; ++pc) { const u32x4 v = *(const u32x4*)(Qs + t * 144 + pc * 16); const float* nn = nv + dir * 64 + pc * 8;
        s += bflo(v.x) * nn[0] + bfhi(v.x) * nn[1] + bflo(v.y) * nn[2] + bfhi(v.y) * nn[3] + bflo(v.z) * nn[4] + bfhi(v.z) * nn[5] + bflo(v.w) * nn[6] + bfhi(v.w) * nn[7]; }
      qn[dir * 64 + t] = s;
    }
    f32x4 S[8];
#pragma unroll
    for (int n = 0; n < 8; ++n) S[n] = (f32x4){0.f, 0.f, 0.f, 0.f};
#pragma unroll
    for (int ks = 0; ks < 2; ++ks) {
      const bf16x8 a = *(const bf16x8*)(Qs + (wave * 16 + fr) * 144 + (ks * 32 + fq * 8) * 2);
#pragma unroll
      for (int n = 0; n < 8; ++n) {
        const bf16x8 b = *(const bf16x8*)(Ks + (n * 16 + fr) * 144 + (ks * 32 + fq * 8) * 2);
        S[n] = __builtin_amdgcn_mfma_f32_16x16x32_bf16(a, b, S[n], 0, 0, 0);
      }
    }
    __syncthreads();
    float rfv[4], rbv[4];
    {
      float sumf[4] = {0.f, 0.f, 0.f, 0.f}, sumb[4] = {0.f, 0.f, 0.f, 0.f};
      float Sf[8][4], Sb_[8][4];
#pragma unroll
      for (int j = 0; j < 4; ++j) {
        const int tl = wave * 16 + fq * 4 + j, tc = th * 64 + tl;
        const float cft = cf[tc], cbt = cb[tc];
#pragma unroll
        for (int n = 0; n < 8; ++n) {
          const int s = n * 16 + fr;
          const float df = s <= tc ? __expf(cft - cf[s] + li_f[s]) : 0.f;
          const float db = s >= tc ? __expf(cbt - cb[s] + li_b[s]) : 0.f;
          Sf[n][j] = S[n][j] * df; Sb_[n][j] = S[n][j] * db;
          sumf[j] += Sf[n][j]; sumb[j] += Sb_[n][j];
        }
      }
#pragma unroll
      for (int j = 0; j < 4; ++j) {
#pragma unroll
        for (int o = 1; o < 16; o <<= 1) { sumf[j] += __shfl_xor(sumf[j], o); sumb[j] += __shfl_xor(sumb[j], o); }
        const int tl = wave * 16 + fq * 4 + j, tc = th * 64 + tl;
        const float ef = __expf(cf[tc]), eb = __expf(cb[tc]);
        const float denf = ef * qn[tl] + sumf[j], denb = eb * qn[64 + tl] + sumb[j];
        rfv[j] = 1.f / fmaxf(fabsf(denf), 1.f); rbv[j] = 1.f / fmaxf(fabsf(denb), 1.f);
        if (fr == 0) { sfq[tl] = ef * rfv[j]; sbq[tl] = eb * rbv[j]; }
      }
#pragma unroll
      for (int n = 0; n < 8; ++n)
#pragma unroll
        for (int j = 0; j < 4; ++j) {
          const int tl = wave * 16 + fq * 4 + j;
          *(bf16_t*)(Ps + tl * MLA_STRIDE + (n * 16 + fr) * 2) = f2bf(Sf[n][j] * rfv[j] + Sb_[n][j] * rbv[j]);
        }
    }
    __syncthreads();
#pragma unroll
    for (int i = 0; i < 2; ++i) { const int f = tid + 256 * i, r = f >> 3, pc = f & 7;
      const u32x4 v = *(const u32x4*)(Qs + r * 144 + pc * 16); const float a = sfq[r], b = sbq[r];
      u32x4 o1, o2;
      o1.x = pk2(bflo(v.x) * a, bfhi(v.x) * a); o1.y = pk2(bflo(v.y) * a, bfhi(v.y) * a); o1.z = pk2(bflo(v.z) * a, bfhi(v.z) * a); o1.w = pk2(bflo(v.w) * a, bfhi(v.w) * a);
      o2.x = pk2(bflo(v.x) * b, bfhi(v.x) * b); o2.y = pk2(bflo(v.y) * b, bfhi(v.y) * b); o2.z = pk2(bflo(v.z) * b, bfhi(v.z) * b); o2.w = pk2(bflo(v.w) * b, bfhi(v.w) * b);
      *(u32x4*)(Q2 + r * MLA_STRIDE + pc * 16) = o1; *(u32x4*)(Q2 + r * MLA_STRIDE + 128 + pc * 16) = o2; }
    f32x4 Hh[8];
#pragma unroll
    for (int n = 0; n < 8; ++n) Hh[n] = (f32x4){0.f, 0.f, 0.f, 0.f};
#pragma unroll
    for (int kc = 0; kc < 4; ++kc) {
      __syncthreads();
      if (kc < 2) {
#pragma unroll
        for (int i = 0; i < 4; ++i) { const int f = tid + 256 * i, e = f >> 3, pc = f & 7;
          *(u32x4*)(Bs + e * 144 + pc * 16) = *(const u32x4*)(vT + (size_t)(h * 128 + e) * T + r0 + kc * 64 + pc * 8); }
      } else {
        const float* Cs = UT + (size_t)((c * 8 + h) * 2 + (kc - 2)) * 8192;
#pragma unroll
        for (int i = 0; i < 4; ++i) { const int f = tid + 256 * i, e = f >> 3, pc = f & 7;
          const f32x4 a = *(const f32x4*)(Cs + e * 64 + pc * 8), b = *(const f32x4*)(Cs + e * 64 + pc * 8 + 4);
          u32x4 o; o.x = pk2(a.x, a.y); o.y = pk2(a.z, a.w); o.z = pk2(b.x, b.y); o.w = pk2(b.z, b.w);
          *(u32x4*)(Bs + e * 144 + pc * 16) = o; }
      }
      __syncthreads();
      const char* Asrc = kc < 2 ? Ps + kc * 128 : Q2 + (kc - 2) * 128;
#pragma unroll
      for (int ks = 0; ks < 2; ++ks) {
        const bf16x8 a = *(const bf16x8*)(Asrc + (wave * 16 + fr) * MLA_STRIDE + (ks * 32 + fq * 8) * 2);
#pragma unroll
        for (int n = 0; n < 8; ++n) {
          const bf16x8 b = *(const bf16x8*)(Bs + (n * 16 + fr) * 144 + (ks * 32 + fq * 8) * 2);
          Hh[n] = __builtin_amdgcn_mfma_f32_16x16x32_bf16(a, b, Hh[n], 0, 0, 0);
        }
      }
    }
#pragma unroll
    for (int j = 0; j < 4; ++j) {
      float ss = 0.f;
#pragma unroll
      for (int n = 0; n < 8; ++n) ss += Hh[n][j] * Hh[n][j];
#pragma unroll
      for (int o = 1; o < 16; o <<= 1) ss += __shfl_xor(ss, o);
      const float rstd = rsqrtf(ss * (1.f / 128.f) + EPS);
      const size_t row = (size_t)(rt + wave * 16 + fq * 4 + j);
#pragma unroll
      for (int n = 0; n < 8; ++n) {
        const int col = h * 128 + n * 16 + fr;
        yA[row * D + col] = f2bf(Hh[n][j] * rstd * ng[col] * bf2f(og[row * D + col]));
      }
    }
  }
}

DEV void ph_final(const Params& p, int bid, int nb) {
  const int lane = tidx() & 63, wave = tidx() >> 6;
  const float* mods1 = (const float*)(p.ws + WS_MODS) + 2 * 6144;
  const float* x1 = (const float*)(p.ws + WS_X1);
  const bf16_t* Y = (const bf16_t*)(p.ws + WS_Y);
  const float* gf = p.in[39];
  for (int t = bid * 4 + wave; t < NL; t += nb * 4) {
    f32x4 v[4]; float ss = 0.f;
#pragma unroll
    for (int i = 0; i < 4; ++i) {
      const int c = 4 * lane + 256 * i;
      const f32x4 xv = *(const f32x4*)(x1 + (size_t)t * D + c), gt = *(const f32x4*)(mods1 + 5120 + c);
      const u32x2 ya = *(const u32x2*)(Y + (size_t)(2 * t) * D + c), yb = *(const u32x2*)(Y + (size_t)(2 * t + 1) * D + c);
      f32x4 f; f.x = bflo(ya.x) + bflo(yb.x); f.y = bfhi(ya.x) + bfhi(yb.x); f.z = bflo(ya.y) + bflo(yb.y); f.w = bfhi(ya.y) + bfhi(yb.y);
      v[i] = xv + gt * f;
      ss += v[i].x * v[i].x + v[i].y * v[i].y + v[i].z * v[i].z + v[i].w * v[i].w;
    }
    const float rstd = rsqrtf(wave_sum(ss) * (1.f / D) + EPS);
#pragma unroll
    for (int i = 0; i < 4; ++i) {
      const int c = 4 * lane + 256 * i;
      *(f32x4*)(p.out + (size_t)t * D + c) = v[i] * rstd * *(const f32x4*)(gf + c);
    }
  }
}

constexpr int NPHASE = 21;
constexpr int SMEM_BYTES = 79872;
static_assert(RT_SMEM <= SMEM_BYTES && RG_SMEM <= SMEM_BYTES && MLA_SMEM <= SMEM_BYTES && MLC_SMEM <= SMEM_BYTES && GEMM_SMEM <= SMEM_BYTES, "smem");

template <int PH>
DEV void run_phase(const Params& p, char* smem, int bid, int nb) {
  if constexpr (PH == 0) ph_adaln(p, smem, bid, nb);
  else if constexpr (PH == 1) ph_norm0(p, bid, nb);
  else if constexpr (PH == 2) ph_rg_inproj(p, smem, bid, nb);
  else if constexpr (PH == 3) ph_rg_scan(p, smem, bid, nb);
  else if constexpr (PH == 4) ph_rg_carry(p, bid, nb);
  else if constexpr (PH == 5) ph_rg_final(p, bid, nb);
  else if constexpr (PH == 6) ph_outproj<0>(p, smem, bid, nb);
  else if constexpr (PH == 7) ph_router<0>(p, smem, bid, nb);
  else if constexpr (PH == 8) ph_moe1<0>(p, smem, bid, nb);
  else if constexpr (PH == 9) ph_moe2<0>(p, smem, bid, nb);
  else if constexpr (PH == 10) ph_combine0(p, bid, nb);
  else if constexpr (PH == 11) ph_ml_inproj(p, smem, bid, nb);
  else if constexpr (PH == 12) ph_ml_state(p, smem, bid, nb);
  else if constexpr (PH == 13) ph_ml_chain(p, bid, nb);
  else if constexpr (PH == 14) ph_ml_out(p, smem, bid, nb);
  else if constexpr (PH == 15) ph_outproj<1>(p, smem, bid, nb);
  else if constexpr (PH == 16) ph_router<1>(p, smem, bid, nb);
  else if constexpr (PH == 17) ph_moe1<1>(p, smem, bid, nb);
  else if constexpr (PH == 18) ph_moe2<1>(p, smem, bid, nb);
  else if constexpr (PH == 19) ph_final(p, bid, nb);
}

#define XB_TMO      128
#define XB_XCNT(j)  (256  + 64 * (j))
#define XB_XSUB(j)  (1280 + 64 * (j))
#define XB_XGEN(j)  (2304 + 64 * (j))
#define XB_TOP      3328
#define XB_TOPGEN   3392
#define XCD_BAR_WORDS 3456
#define XB_SPIN_CAP (1u << 22)
DEV unsigned xb_ld(unsigned* p)              { return __hip_atomic_load(p, __ATOMIC_RELAXED, __HIP_MEMORY_SCOPE_AGENT); }
DEV unsigned xb_add(unsigned* p, unsigned v) { return __hip_atomic_fetch_add(p, v, __ATOMIC_RELAXED, __HIP_MEMORY_SCOPE_AGENT); }
DEV unsigned xb_xcc_id() { return (unsigned)__builtin_amdgcn_s_getreg((3 << 11) | 20) & 0xFu; }
#define XB_SPIN(cond, bar) do { unsigned _sp = 0; while (cond) { __builtin_amdgcn_s_sleep(1); \
    if ((++_sp & 255u) == 0u) { if (xb_ld(&(bar)[XB_TMO])) break; if (_sp > XB_SPIN_CAP) { atomicAdd(&(bar)[XB_TMO], 1u); break; } } } } while (0)
struct XcdBarrier { unsigned* bar; unsigned x; volatile LAS unsigned* st; };
DEV XcdBarrier xcd_barrier_post(unsigned* bar, volatile LAS unsigned* st) {
  XcdBarrier b; b.bar = bar; b.x = xb_xcc_id(); b.st = st;
  if (threadIdx.x == 0) (void)xb_add(&bar[XB_XCNT(b.x)], 1u);
  return b;
}
DEV void xcd_barrier_complete(unsigned* bar, unsigned x, unsigned& nloc, unsigned& nx) {
  const unsigned G = gridDim.x * gridDim.y * gridDim.z;
  unsigned sum, cnt, mine, sp = 0u;
  for (;;) {
    sum = 0u; cnt = 0u; mine = 0u;
#pragma unroll
    for (unsigned j = 0; j < 16; ++j) { const unsigned c = xb_ld(&bar[XB_XCNT(j)]); sum += c; cnt += (c > 0u) ? 1u : 0u; mine = (j == x) ? c : mine; }
    if (sum == G) break;
    __builtin_amdgcn_s_sleep(1);
    if ((++sp & 255u) == 0u) { if (xb_ld(&bar[XB_TMO])) break; if (sp > XB_SPIN_CAP) { atomicAdd(&bar[XB_TMO], 1u); break; } }
  }
  nloc = mine > 0u ? mine : 1u; nx = cnt > 0u ? cnt : 1u;
}
DEV void xcd_barrier(const XcdBarrier& b) {
  asm volatile("s_waitcnt vmcnt(0)" ::: "memory");
  __syncthreads();
  if (threadIdx.x == 0) {
    unsigned* bar = b.bar;
    __builtin_amdgcn_s_waitcnt(0);
    unsigned nloc = b.st[0], nx = b.st[1];
    if (nloc == 0u) { xcd_barrier_complete(bar, b.x, nloc, nx); b.st[0] = nloc; b.st[1] = nx; }
    const unsigned old = xb_add(&bar[XB_XSUB(b.x)], 1u);
    const unsigned gen = old / nloc;
    if (old + 1u == (gen + 1u) * nloc) {
      __builtin_amdgcn_fence(__ATOMIC_RELEASE, "agent");
      asm volatile("s_waitcnt vmcnt(0)" ::: "memory");
      const unsigned og = xb_add(&bar[XB_TOP], 1u);
      const unsigned tg = og / nx;
      if (og + 1u == (tg + 1u) * nx) xb_add(&bar[XB_TOPGEN], 1u);
      else XB_SPIN(xb_ld(&bar[XB_TOPGEN]) == tg, bar);
      __builtin_amdgcn_fence(__ATOMIC_ACQUIRE, "agent");
      xb_add(&bar[XB_XGEN(b.x)], 1u);
      asm volatile("s_waitcnt vmcnt(0)" ::: "memory");
    } else {
      XB_SPIN(xb_ld(&bar[XB_XGEN(b.x)]) == gen, bar);
      __builtin_amdgcn_fence(__ATOMIC_ACQUIRE, "agent");
      asm volatile("s_waitcnt vmcnt(0)" ::: "memory");
    }
  }
  __syncthreads();
}

template <int PH>
DEV void run_from(const Params& p, char* smem) {
  run_phase<PH>(p, smem, blockIdx.x, gridDim.x);
  if constexpr (PH + 1 < NPHASE - 1) {
    XcdBarrier xb; xb.bar = (unsigned*)(p.ws + WS_BAR); xb.x = xb_xcc_id(); xb.st = (volatile LAS unsigned*)(LAS char*)(smem + SMEM_BYTES);
    xcd_barrier(xb);
    run_from<PH + 1>(p, smem);
  }
}

__global__ void __launch_bounds__(256, 2) mega_kernel(Params p) {
  extern __shared__ __attribute__((aligned(16))) char smem[];
  volatile LAS unsigned* st = (volatile LAS unsigned*)(LAS char*)(smem + SMEM_BYTES);
  if (threadIdx.x == 0) { st[0] = 0u; st[1] = 0u; st[2] = 0u; st[3] = 0u; }
  __syncthreads();
  (void)xcd_barrier_post((unsigned*)(p.ws + WS_BAR), st);
  run_from<0>(p, smem);
}

extern "C" void kernel_launch(void* const* d_in, const int* in_sizes, int n_in, void* d_out, int out_size, void* d_ws, size_t ws_size, hipStream_t stream) {
  static int grid = 0;
  constexpr int LDS_BYTES = SMEM_BYTES + 16;
  if (grid == 0) {
    if (n_in != 40 || ws_size < WS_END) { fprintf(stderr, "kernel_launch: unexpected inputs (n_in %d, ws %zu, need %zu)\n", n_in, ws_size, (size_t)WS_END); grid = -1; return; }
    int dev = 0, cus = 0, per_cu = 0;
    if (hipGetDevice(&dev) != hipSuccess || hipDeviceGetAttribute(&cus, hipDeviceAttributeMultiprocessorCount, dev) != hipSuccess) { grid = -1; return; }
    if (hipFuncSetAttribute((const void*)mega_kernel, hipFuncAttributeMaxDynamicSharedMemorySize, LDS_BYTES) != hipSuccess) { fprintf(stderr, "kernel_launch: hipFuncSetAttribute failed\n"); grid = -1; return; }
    if (hipOccupancyMaxActiveBlocksPerMultiprocessor(&per_cu, (const void*)mega_kernel, 256, LDS_BYTES) != hipSuccess || per_cu < 1) { fprintf(stderr, "kernel_launch: occupancy query failed (%d)\n", per_cu); grid = -1; return; }
    if (per_cu > 2) per_cu = 2;
    grid = cus * per_cu;
    fprintf(stderr, "kernel_launch: %d CUs x %d blocks\n", cus, per_cu);
  }
  if (grid < 0) return;
  Params p{};
  for (int i = 0; i < 40; ++i) p.in[i] = (const float*)d_in[i];
  p.out = (float*)d_out; p.ws = (char*)d_ws;
  if (hipMemsetAsync((char*)d_ws, 0, WS_ZERO_BYTES, stream) != hipSuccess) return;
  void* args[] = {&p};
  hipError_t e = hipLaunchCooperativeKernel((const void*)mega_kernel, dim3(grid), dim3(256), args, LDS_BYTES, stream);
  if (e != hipSuccess) fprintf(stderr, "cooperative launch failed: %s (grid %d)\n", hipGetErrorString(e), grid);
}
```

```cpp
#include <hip/hip_runtime.h>
#include <cstdio>
#include <cstdint>

#define DEV __device__ __forceinline__
typedef unsigned short bf16_t;
typedef short bf16x8 __attribute__((ext_vector_type(8)));
typedef short s16x4 __attribute__((ext_vector_type(4)));
typedef float f32x4 __attribute__((ext_vector_type(4)));
typedef unsigned u32x4 __attribute__((ext_vector_type(4)));
typedef unsigned u32x2 __attribute__((ext_vector_type(2)));
#define LAS __attribute__((address_space(3)))

constexpr int D = 1024, NL = 16384, NC = 256, T = NL + NC, NTILE = T / 128;
constexpr int DR = 1280, NEXP = 32, DE = 512;
constexpr int RGT = 64, NRT = T / RGT, NRT_LAT = NL / RGT;
constexpr int MLW = 3104, MLWP = 3328;
constexpr int MOE_ROWS = 41472;
constexpr float EPS = 1e-6f;

constexpr size_t al256(size_t x) { return (x + 255) & ~(size_t)255; }
constexpr size_t WS_BAR   = 0;
constexpr size_t WS_CNT   = 16384;
constexpr size_t WS_ZERO_BYTES = 16384 + 256;
constexpr size_t WS_MODS  = 32768;
constexpr size_t WS_LIST  = WS_MODS + al256(2 * 2 * 6144 * 4);
constexpr size_t WS_AW    = WS_LIST + al256((size_t)2 * 32 * T * 4);
constexpr size_t WS_POS   = WS_AW + al256((size_t)2 * T * 4);
constexpr size_t WS_AWP   = WS_POS + al256((size_t)2 * T * 4);
constexpr size_t WS_AGG   = WS_AWP + al256((size_t)MOE_ROWS * 4);
constexpr size_t WS_CARRY = WS_AGG + al256((size_t)2 * NRT * DR * 2 * 4);
constexpr size_t WS_GL    = WS_CARRY + al256((size_t)2 * NRT * DR * 4);
constexpr size_t WS_NVEC  = WS_GL + al256((size_t)T * 32 * 4);
constexpr size_t WS_DEC   = WS_NVEC + al256((size_t)NTILE * 16 * 64 * 4);
constexpr size_t WS_WIN   = WS_DEC + al256((size_t)NTILE * 16 * 4);
constexpr size_t WS_WOUT  = WS_WIN + al256((size_t)2560 * 1024 * 2);
constexpr size_t WS_WML   = WS_WOUT + al256((size_t)1024 * 1280 * 2);
constexpr size_t WS_WMO   = WS_WML + al256((size_t)MLWP * 1024 * 2);
constexpr size_t WS_WGU   = WS_WMO + al256((size_t)1024 * 1024 * 2);
constexpr size_t WS_WD    = WS_WGU + al256((size_t)32 * 1024 * 1024 * 2);
constexpr size_t WS_HA    = WS_WD + al256((size_t)32 * 1024 * 512 * 2);
constexpr size_t WS_X1    = WS_HA + al256((size_t)T * D * 2);
constexpr size_t WS_X2    = WS_X1 + al256((size_t)T * D * 4);
constexpr size_t WS_R0    = WS_X2 + al256((size_t)T * D * 4);
constexpr size_t WS_GG    = WS_R0;
constexpr size_t WS_PR    = WS_GG + al256((size_t)T * DR * 2);
constexpr size_t WS_S     = WS_PR + al256((size_t)T * DR * 2);
constexpr size_t WS_PF    = WS_S + al256((size_t)T * DR * 2);
constexpr size_t WS_PB    = WS_PF + al256((size_t)T * DR * 2);
constexpr size_t WS_R0END = WS_PB + al256((size_t)T * DR * 2);
constexpr size_t WS_ABUF  = WS_R0;
constexpr size_t WS_HM    = WS_ABUF + al256((size_t)MOE_ROWS * D * 2);
constexpr size_t WS_Y     = WS_HM + al256((size_t)MOE_ROWS * DE * 2);
constexpr size_t WS_MOEEND = WS_Y + al256((size_t)MOE_ROWS * D * 2);
constexpr size_t WS_Q     = WS_R0;
constexpr size_t WS_K     = WS_Q + al256((size_t)T * 512 * 2);
constexpr size_t WS_KT    = WS_K + al256((size_t)T * 512 * 2);
constexpr size_t WS_VT    = WS_KT + al256((size_t)T * 512 * 2);
constexpr size_t WS_OG    = WS_VT + al256((size_t)T * D * 2);
constexpr size_t WS_UT    = WS_OG + al256((size_t)T * D * 2);
constexpr size_t WS_L1END = WS_UT + al256((size_t)NTILE * 16 * 8192 * 4);
constexpr size_t cmax(size_t a, size_t b) { return a > b ? a : b; }
constexpr size_t WS_END   = cmax(cmax(WS_R0END, WS_L1END), WS_MOEEND);

struct Params {
  const float* in[40];
  float* out;
  char* ws;
};

DEV unsigned pk2(float lo, float hi) { unsigned r; asm("v_cvt_pk_bf16_f32 %0, %1, %2" : "=v"(r) : "v"(lo), "v"(hi)); return r; }
DEV float bflo(unsigned u) { return __uint_as_float(u << 16); }
DEV float bfhi(unsigned u) { return __uint_as_float(u & 0xffff0000u); }
DEV float bf2f(bf16_t b) { return __uint_as_float((unsigned)b << 16); }
DEV bf16_t f2bf(float f) { return (bf16_t)(pk2(f, 0.f) & 0xffffu); }
DEV float sigmoidf_(float x) { return 1.f / (1.f + __expf(-x)); }
DEV float siluf_(float x) { return x / (1.f + __expf(-x)); }
DEV float gelu_tanh(float x) { const float u = 0.7978845608028654f * (x + 0.044715f * x * x * x); return 0.5f * x * (1.f + tanhf(u)); }
DEV float wave_sum(float v) {
#pragma unroll
  for (int o = 1; o < 64; o <<= 1) v += __shfl_xor(v, o);
  return v;
}
DEV s16x4 ldtr(const char* p) { return __builtin_bit_cast(s16x4, __builtin_amdgcn_ds_read_tr16_b64_v4i16((LAS s16x4*)p)); }
DEV int tidx() { int t = threadIdx.x & 255; asm volatile("" : "+v"(t)); return t; }
DEV int seqrow_of_token(int t) { return (t & 63) * 256 + (t >> 6); }
DEV int token_of_seqrow(int s) { return (s & 255) * 64 + (s >> 8); }

constexpr int BS_STRIDE = 320;
DEV int bs_off(int k, int n) { return k * BS_STRIDE + ((((n >> 4) ^ ((k >> 3) & 1))) << 5) + (n & 15) * 2; }

namespace pg8 {
#define PG8_LAS __attribute__((address_space(3)))
typedef unsigned short bf16_t;
typedef short bf16x8 __attribute__((ext_vector_type(8)));
typedef float f32x4 __attribute__((ext_vector_type(4)));
typedef unsigned u32x4 __attribute__((ext_vector_type(4)));
constexpr int BM = 256, BK = 64, HALF = 128, HTB = HALF * BK * 2  , STAGE_BYTES = 8 * HTB, NXCD = 8, WGM = 8;

__host__ __device__ __forceinline__ int lds_byte(int r, int c) { const int st = (r >> 4) * 2 + (c >> 5), rr = r & 15, cc = c & 31, ob = rr * 64 + cc * 2; return st * 1024 + (ob ^ (((ob >> 9) & 1) << 5)); }
__host__ __device__ __forceinline__ void stage_rc(int b, int& R, int& C) { const int st = b / 1024, sb = b % 1024, swz = sb ^ (((sb >> 9) & 1) << 5); R = (st >> 1) * 16 + swz / 64; C = (st & 1) * 32 + (swz % 64) / 2; }
__host__ __device__ __forceinline__ int perm32(int rho) { const int n = rho >> 4, i = rho & 15; return 8 * (i >> 2) + 4 * n + (i & 3); }

struct Unit { int pm, pn; };
struct Gemm { const bf16_t* A; const bf16_t* Bt; int M, N, K; };

struct StaticOrder {
    int nM, nN, nwg, G, c;
    __host__ __device__ void init(int M, int N, int G_, int c_) { nM = M / BM; nN = N / BM; nwg = nM * nN; G = G_; c = c_; }
    __host__ __device__ bool next(int i, Unit& u) const {
        const long L = (long)i * G + c; if (L >= nwg) return false;
        int wgid = (int)L; { const int q = nwg / NXCD, r = nwg % NXCD, xcd = wgid % NXCD, off = wgid / NXCD; wgid = (xcd < r ? xcd * (q + 1) : r * (q + 1) + (xcd - r) * q) + off; }
        const int nig = WGM * nN, gid = wgid / nig, fm = gid * WGM, gsz = (nM - fm) < WGM ? (nM - fm) : WGM;
        u.pm = fm + ((wgid % nig) % gsz); u.pn = (wgid % nig) / gsz; return true;
    }
    __device__ __forceinline__ void a_ready(const Unit&) const {}
    __device__ __forceinline__ void done(const Unit&) const {}
};
template <class Epi, class Sched, bool STAMP = false>
__device__ __forceinline__ void gemm_phase(PG8_LAS unsigned char* lds, const Gemm g, const Sched& S, const Epi& E, unsigned long long* stamps) {
    int tid = threadIdx.x; asm volatile("" : "+v"(tid));
    const int wid = __builtin_amdgcn_readfirstlane(tid >> 6), lane = tid & 63, wr = wid >> 2, wc = wid & 3, fr = lane & 15, fq = lane >> 4;
    const int K = g.K, nt = K / BK;
    int ts_lo = 0, ts_hi = 0, nts = 0; const unsigned long long rt_entry = STAMP ? (unsigned long long)wall_clock64() : 0ull;
#define PG8_STAMP() do { if (STAMP && wid == 0 && nts < 64) { const unsigned long long _c = (unsigned long long)clock64(); \
        ts_lo = (lane == nts) ? (int)(unsigned)_c : ts_lo; ts_hi = (lane == nts) ? (int)(unsigned)(_c >> 32) : ts_hi; ++nts; } } while (0)
    PG8_STAMP();
    unsigned voffA[2], voffB[2];
#pragma unroll
    for (int i = 0; i < 2; ++i) { int R, C; stage_rc(tid * 16 + i * 8192, R, C); const int Rb = Epi::PERM ? ((R & ~31) + perm32(R & 31)) : R;
        voffA[i] = (unsigned)(R * K + C) * 2u; voffB[i] = (unsigned)(Rb * K + C) * 2u; }
    const size_t kstep = (size_t)(BK * 2);
    const size_t hstep = (size_t)HALF * K * 2;
    const size_t tstep = 2 * hstep;
    const unsigned ldsw = (unsigned)wid * 1024u;
    const int aoff = lds_byte(wr * 64 + fr, fq * 8), boff = lds_byte(wc * 32 + fr, fq * 8);
#define PG8_SA(b, h) (((b) * 2 + (h)) * HTB)
#define PG8_SB(b, h) ((4 + (b) * 2 + (h)) * HTB)
#define PG8_STAGE(bufoff, gbase, voff) do { _Pragma("unroll") for (int _i = 0; _i < 2; ++_i) \
        __builtin_amdgcn_global_load_lds((const unsigned*)((const char*)(gbase) + (voff)[_i]), (PG8_LAS unsigned*)(lds + (bufoff) + ldsw + _i * 8192), 16, 0, 0); } while (0)
#define PG8_LDA(dst, b, h) do { _Pragma("unroll") for (int m = 0; m < 4; ++m) _Pragma("unroll") for (int k = 0; k < 2; ++k) dst[m][k] = *(const PG8_LAS bf16x8*)(lds + PG8_SA(b, h) + aoff + m * 2048 + k * 1024); } while (0)
#define PG8_LDB(dst, b, h) do { _Pragma("unroll") for (int n = 0; n < 2; ++n) _Pragma("unroll") for (int k = 0; k < 2; ++k) dst[n][k] = *(const PG8_LAS bf16x8*)(lds + PG8_SB(b, h) + boff + n * 2048 + k * 1024); } while (0)
#define PG8_MMA(ai, bj, At, Bt) do { __builtin_amdgcn_s_setprio(1); _Pragma("unroll") for (int m = 0; m < 4; ++m) _Pragma("unroll") for (int n = 0; n < 2; ++n) _Pragma("unroll") for (int k = 0; k < 2; ++k) \
        acc[ai][bj][m][n] = __builtin_amdgcn_mfma_f32_16x16x32_bf16(Bt[n][k], At[m][k], acc[ai][bj][m][n], 0, 0, 0); __builtin_amdgcn_s_setprio(0); } while (0)
#define PG8_WAIT_V(n) asm volatile("s_waitcnt vmcnt(" #n ")" ::: "memory")
#define PG8_WAIT_L(n) asm volatile("s_waitcnt lgkmcnt(" #n ")" ::: "memory")
#define PG8_BAR __builtin_amdgcn_s_barrier()
#define PG8_SCHED __builtin_amdgcn_sched_barrier(0)
    Unit cur, nxt; int ui = 0;
    if (!S.next(0, cur)) return;
    f32x4 acc[2][2][4][2];
#pragma unroll
    for (int a = 0; a < 2; ++a)
#pragma unroll
        for (int b = 0; b < 2; ++b)
#pragma unroll
            for (int m = 0; m < 4; ++m)
#pragma unroll
                for (int n = 0; n < 2; ++n) acc[a][b][m][n] = (f32x4){0.f, 0.f, 0.f, 0.f};
    bf16x8 At[4][2], B0[2][2], B1[2][2];
    const char* cA = (const char*)g.A + (size_t)cur.pm * tstep; const char* cB = (const char*)g.Bt + (size_t)cur.pn * tstep;
    S.a_ready(cur);
    PG8_STAGE(PG8_SB(0, 0), cB, voffB); PG8_STAGE(PG8_SA(0, 0), cA, voffA); PG8_STAGE(PG8_SB(0, 1), cB + hstep, voffB); PG8_STAGE(PG8_SA(0, 1), cA + hstep, voffA);
    if (wr == 1) PG8_BAR;
    PG8_WAIT_V(4); PG8_BAR;
    PG8_STAGE(PG8_SB(1, 0), cB + kstep, voffB); PG8_STAGE(PG8_SA(1, 0), cA + kstep, voffA); PG8_STAGE(PG8_SB(1, 1), cB + hstep + kstep, voffB);
    PG8_WAIT_V(6); PG8_BAR;
    PG8_STAMP();
    for (;;) {
        const bool has_next = S.next(ui + 1, nxt);
        const char* nA = has_next ? (const char*)g.A + (size_t)nxt.pm * tstep : cA; const char* nB = has_next ? (const char*)g.Bt + (size_t)nxt.pn * tstep : cB;
        for (int t = 0; t < nt; t += 2) {
            const bool last = (t == nt - 2);
            const char* a1 = cA + (size_t)(t + 1) * kstep;
            const char* a2 = last ? nA : cA + (size_t)(t + 2) * kstep; const char* b2 = last ? nB : cB + (size_t)(t + 2) * kstep;
            const char* a3 = a2 + kstep; const char* b3 = b2 + kstep;
            if (last && has_next) S.a_ready(nxt);
            PG8_LDB(B0, 0, 0); PG8_SCHED; PG8_LDA(At, 0, 0); PG8_STAGE(PG8_SA(1, 1), a1 + hstep, voffA);
            PG8_WAIT_L(8); PG8_BAR; PG8_WAIT_L(0); PG8_MMA(0, 0, At, B0); PG8_BAR; PG8_SCHED;
            PG8_LDB(B1, 0, 1); PG8_STAGE(PG8_SB(0, 0), b2, voffB);
            PG8_BAR; PG8_WAIT_L(0); PG8_MMA(0, 1, At, B1); PG8_BAR;
            PG8_LDA(At, 0, 1); PG8_STAGE(PG8_SA(0, 0), a2, voffA);
            PG8_BAR; PG8_WAIT_L(0); PG8_MMA(1, 0, At, B0); PG8_BAR; PG8_SCHED;
            PG8_STAGE(PG8_SB(0, 1), b2 + hstep, voffB);
            PG8_WAIT_V(6); PG8_BAR; PG8_MMA(1, 1, At, B1); PG8_BAR;
            PG8_LDB(B0, 1, 0); PG8_SCHED; PG8_LDA(At, 1, 0); PG8_STAGE(PG8_SA(0, 1), a2 + hstep, voffA);
            PG8_WAIT_L(8); PG8_BAR; PG8_WAIT_L(0); PG8_MMA(0, 0, At, B0); PG8_BAR; PG8_SCHED;
            PG8_LDB(B1, 1, 1); PG8_STAGE(PG8_SB(1, 0), b3, voffB);
            PG8_BAR; PG8_WAIT_L(0); PG8_MMA(0, 1, At, B1); PG8_BAR;
            PG8_LDA(At, 1, 1); PG8_STAGE(PG8_SA(1, 0), a3, voffA);
            PG8_BAR; PG8_WAIT_L(0); PG8_MMA(1, 0, At, B0); PG8_BAR; PG8_SCHED;
            PG8_STAGE(PG8_SB(1, 1), b3 + hstep, voffB);
            PG8_WAIT_V(6); PG8_BAR; PG8_MMA(1, 1, At, B1); PG8_BAR;
        }
        PG8_STAMP();
        if constexpr (!Epi::AFTER_DRAIN) { E(acc, cur, wr, wc, fr, fq); S.done(cur); }
        PG8_STAMP();
        if (!has_next) break;
#pragma unroll
        for (int a = 0; a < 2; ++a)
#pragma unroll
            for (int b = 0; b < 2; ++b)
#pragma unroll
                for (int m = 0; m < 4; ++m)
#pragma unroll
                    for (int n = 0; n < 2; ++n) acc[a][b][m][n] = (f32x4){0.f, 0.f, 0.f, 0.f};
        cur = nxt; cA = nA; cB = nB; ++ui;
    }
    PG8_WAIT_V(0);
    if (wr == 0) PG8_BAR;
    PG8_BAR;
    if constexpr (Epi::AFTER_DRAIN) { E.fused(acc, cur, wr, wc, fr, fq, lds, wid, lane); S.done(cur); }
    PG8_STAMP();
    if (STAMP && wid == 0) { stamps[lane] = lane < nts ? (((unsigned long long)(unsigned)ts_hi << 32) | (unsigned)ts_lo) : 0ull;
        if (lane == 62) stamps[62] = rt_entry; if (lane == 63) stamps[63] = (unsigned long long)wall_clock64(); }
#undef PG8_STAMP
#undef PG8_SA
#undef PG8_SB
#undef PG8_STAGE
#undef PG8_LDA
#undef PG8_LDB
#undef PG8_MMA
#undef PG8_WAIT_V
#undef PG8_WAIT_L
#undef PG8_BAR
#undef PG8_SCHED
}
}

DEV void ph_adaln(const Params& p, char* smem, int bid, int nb) {
  float* sc = (float*)smem; float* sx = sc + 1024; f32x4* red = (f32x4*)(sx + 1024);
  const int tid = tidx();
  for (int i = tid; i < 1024; i += 256) { sc[i] = siluf_(p.in[1][i]); sx[i] = siluf_(p.in[3][i]); }
  __syncthreads();
  float* mods = (float*)(p.ws + WS_MODS);
  const int cl = tid & 15, kg = tid >> 4;
  for (int it = 0, iters = (192 + nb - 1) / nb; it < iters; ++it) {
    const int u = bid + it * nb; const bool active = u < 192;
    const int l = u / 96, c0 = (u % 96) * 64;
    const float* W = p.in[l ? 24 : 4]; const float* B = p.in[l ? 25 : 5];
    if (active) {
      f32x4 ac = {0.f, 0.f, 0.f, 0.f}, ax = {0.f, 0.f, 0.f, 0.f};
      const float* wp = W + (size_t)(kg * 64) * 6144 + c0 + 4 * cl;
#pragma unroll 8
      for (int kk = 0; kk < 64; ++kk) {
        const f32x4 w = *(const f32x4*)(wp + (size_t)kk * 6144);
        const float a = sc[kg * 64 + kk], b = sx[kg * 64 + kk];
        ac += a * w; ax += b * w;
      }
      red[kg * 16 + cl] = ac; red[256 + kg * 16 + cl] = ax;
    }
    __syncthreads();
    if (active && tid < 32) {
      const int which = tid >> 4, c = tid & 15;
      f32x4 s = {0.f, 0.f, 0.f, 0.f};
      for (int g = 0; g < 16; ++g) s += red[which * 256 + g * 16 + c];
      const f32x4 bb = *(const f32x4*)(B + c0 + 4 * c);
      *(f32x4*)(mods + (size_t)(l * 2 + which) * 6144 + c0 + 4 * c) = s + bb;
    }
    __syncthreads();
  }
}

DEV void transpose_item(const float* W, int N, int K, bf16_t* WT, float* scr, int k0, int n0, int lane) {
#pragma unroll 8
  for (int i = 0; i < 32; ++i) { const int kk = 2 * i + (lane >> 5); scr[kk * 33 + (lane & 31)] = W[(size_t)(k0 + kk) * N + n0 + (lane & 31)]; }
  asm volatile("s_waitcnt lgkmcnt(0)" ::: "memory");
  const int c = lane & 7;
#pragma unroll
  for (int j = 0; j < 4; ++j) { const int n = (lane >> 3) + 8 * j; const float* s = scr + (8 * c) * 33 + n;
    u32x4 o; o.x = pk2(s[0 * 33], s[1 * 33]); o.y = pk2(s[2 * 33], s[3 * 33]); o.z = pk2(s[4 * 33], s[5 * 33]); o.w = pk2(s[6 * 33], s[7 * 33]);
    *(u32x4*)(WT + (size_t)n * K + k0 + 8 * c) = o; }
  asm volatile("s_waitcnt lgkmcnt(0)" ::: "memory");
}
constexpr int CI_WIN = 16 * 80, CI_WOUT = 20 * 32, CI_WML = 16 * 97, CI_WMO = 16 * 32, CI_DENSE = CI_WIN + CI_WOUT + CI_WML + CI_WMO;
constexpr int CI_MOE = 32 * 768;
DEV void ph_convert_dense(const Params& p, char* smem) {
  const int lane = threadIdx.x & 63, wv = threadIdx.x >> 6;
  float* scr = (float*)(smem + wv * 8448);
  const int gw = blockIdx.x * 8 + wv, ngw = gridDim.x * 8;
  for (int it = gw; it < CI_DENSE; it += ngw) {
    int r = it;
    if (r < CI_WIN) { const int kb = r / 80, nb_ = r % 80; transpose_item(p.in[8], 2560, 1024, (bf16_t*)(p.ws + WS_WIN) + (size_t)(nb_ * 32) * 1024, scr, kb * 64, nb_ * 32, lane); continue; } r -= CI_WIN;
    if (r < CI_WOUT) { const int kb = r / 32, nb_ = r % 32; transpose_item(p.in[16], 1024, 1280, (bf16_t*)(p.ws + WS_WOUT) + (size_t)(nb_ * 32) * 1280, scr, kb * 64, nb_ * 32, lane); continue; } r -= CI_WOUT;
    if (r < CI_WML) { const int kb = r / 97, nb_ = r % 97; transpose_item(p.in[28], MLW, 1024, (bf16_t*)(p.ws + WS_WML) + (size_t)(nb_ * 32) * 1024, scr, kb * 64, nb_ * 32, lane); continue; } r -= CI_WML;
    { const int kb = r / 32, nb_ = r % 32; transpose_item(p.in[31], 1024, 1024, (bf16_t*)(p.ws + WS_WMO) + (size_t)(nb_ * 32) * 1024, scr, kb * 64, nb_ * 32, lane); }
  }
  { u32x4* z = (u32x4*)((bf16_t*)(p.ws + WS_WML) + (size_t)MLW * 1024); const int n16 = (MLWP - MLW) * 1024 * 2 / 16;
    for (int i = blockIdx.x * 512 + threadIdx.x; i < n16; i += gridDim.x * 512) z[i] = (u32x4){0u, 0u, 0u, 0u}; }
}
template <int LAYER>
DEV void ph_convert_moe(const Params& p, char* smem) {
  const int lane = threadIdx.x & 63, wv = threadIdx.x >> 6;
  float* scr = (float*)(smem + wv * 8448);
  const int gw = blockIdx.x * 8 + wv, ngw = gridDim.x * 8;
  const float* Wg = p.in[LAYER == 0 ? 21 : 36]; const float* Wu = p.in[LAYER == 0 ? 22 : 37]; const float* Wd = p.in[LAYER == 0 ? 23 : 38];
  bf16_t* WGU = (bf16_t*)(p.ws + WS_WGU); bf16_t* WD = (bf16_t*)(p.ws + WS_WD);
  for (int it = gw; it < CI_MOE; it += ngw) {
    const int e = it / 768, r = it % 768;
    if (r < 512) {
      const int up = r >> 8, rr = r & 255, kb = rr >> 4, nb_ = rr & 15, n0 = nb_ * 32;
      bf16_t* dst = WGU + ((size_t)e * 1024 + (n0 >> 7) * 256 + up * 128 + (n0 & 127)) * 1024;
      transpose_item((up ? Wu : Wg) + (size_t)e * 1024 * 512, 512, 1024, dst, scr, kb * 64, n0, lane);
    } else {
      const int rr = r - 512, kb = rr >> 5, nb_ = rr & 31, n0 = nb_ * 32;
      transpose_item(Wd + (size_t)e * 512 * 1024, 1024, 512, WD + ((size_t)e * 1024 + n0) * 512, scr, kb * 64, n0, lane);
    }
  }
}

DEV void ph_norm0(const Params& p, int bid, int nb) {
  const int lane = tidx() & 63, wave = tidx() >> 6;
  const float* mods = (const float*)(p.ws + WS_MODS);
  bf16_t* hA = (bf16_t*)(p.ws + WS_HA);
  const float* g1 = p.in[6];
  for (int r = bid * 4 + wave; r < T; r += nb * 4) {
    const float* src = r < NL ? p.in[0] + (size_t)r * D : p.in[2] + (size_t)(r - NL) * D;
    const float* md = mods + (r < NL ? 0 : 6144);
    f32x4 v[4]; float ss = 0.f;
#pragma unroll
    for (int i = 0; i < 4; ++i) { v[i] = *(const f32x4*)(src + 4 * lane + 256 * i); ss += v[i].x * v[i].x + v[i].y * v[i].y + v[i].z * v[i].z + v[i].w * v[i].w; }
    const float rstd = rsqrtf(wave_sum(ss) * (1.f / D) + EPS);
#pragma unroll
    for (int i = 0; i < 4; ++i) {
      const int c = 4 * lane + 256 * i;
      const f32x4 g = *(const f32x4*)(g1 + c), sh = *(const f32x4*)(md + c), sc = *(const f32x4*)(md + 1024 + c);
      const f32x4 h = v[i] * rstd * g * (1.f + sc) + sh;
      u32x2 o; o.x = pk2(h.x, h.y); o.y = pk2(h.z, h.w);
      *(u32x2*)(hA + (size_t)r * D + c) = o;
    }
  }
}

constexpr int RG_AS_STRIDE = 272;
constexpr int RG_MT = RGT / 16;
constexpr int RG_AS = 0, RG_BS = RGT * RG_AS_STRIDE, RG_SMEM = RG_BS + 128 * BS_STRIDE;

template <bool REV>
DEV void rg_scan(f32x4 (&A)[RG_MT][2], f32x4 (&B)[RG_MT][2], float (&aggP)[2], float (&aggH)[2]) {
  const int lane = tidx() & 63, fq = lane >> 4, fr = lane & 15;
#pragma unroll
  for (int n = 0; n < 2; ++n) {
    float cP = 1.f, cH = 0.f;
#pragma unroll
    for (int mm = 0; mm < RG_MT; ++mm) {
      const int m = REV ? RG_MT - 1 - mm : mm;
      float P[4], H[4];
      if (!REV) {
        P[0] = A[m][n][0]; H[0] = B[m][n][0];
#pragma unroll
        for (int j = 1; j < 4; ++j) { P[j] = A[m][n][j] * P[j - 1]; H[j] = A[m][n][j] * H[j - 1] + B[m][n][j]; }
      } else {
        P[3] = A[m][n][3]; H[3] = B[m][n][3];
#pragma unroll
        for (int j = 2; j >= 0; --j) { P[j] = A[m][n][j] * P[j + 1]; H[j] = A[m][n][j] * H[j + 1] + B[m][n][j]; }
      }
      float IP = REV ? P[0] : P[3], IH = REV ? H[0] : H[3];
      float tP, tH;
      tP = REV ? __shfl_down(IP, 16) : __shfl_up(IP, 16); tH = REV ? __shfl_down(IH, 16) : __shfl_up(IH, 16);
      if (REV ? (fq <= 2) : (fq >= 1)) { IH = IP * tH + IH; IP = IP * tP; }
      tP = REV ? __shfl_down(IP, 32) : __shfl_up(IP, 32); tH = REV ? __shfl_down(IH, 32) : __shfl_up(IH, 32);
      if (REV ? (fq <= 1) : (fq >= 2)) { IH = IP * tH + IH; IP = IP * tP; }
      float EP = REV ? __shfl_down(IP, 16) : __shfl_up(IP, 16), EH = REV ? __shfl_down(IH, 16) : __shfl_up(IH, 16);
      if (REV ? (fq == 3) : (fq == 0)) { EP = 1.f; EH = 0.f; }
      const float hin = EP * cH + EH, pin = EP * cP;
#pragma unroll
      for (int j = 0; j < 4; ++j) { B[m][n][j] = H[j] + P[j] * hin; A[m][n][j] = P[j] * pin; }
      const float TP = __shfl(IP, (REV ? 0 : 48) + fr), TH = __shfl(IH, (REV ? 0 : 48) + fr);
      cH = TP * cH + TH; cP = TP * cP;
    }
    aggP[n] = cP; aggH[n] = cH;
  }
}

DEV void ph_rg_scan(const Params& p, char* smem, int bid, int nb) {
  char* As = smem + RG_AS; char* Bs = smem + RG_BS;
  const bf16_t* pr = (const bf16_t*)(p.ws + WS_PR);
  bf16_t* Sb = (bf16_t*)(p.ws + WS_S); bf16_t* Pfb = (bf16_t*)(p.ws + WS_PF); bf16_t* Pbb = (bf16_t*)(p.ws + WS_PB);
  float* agg = (float*)(p.ws + WS_AGG);
  const float* conv_w = p.in[9]; const float* conv_b = p.in[10];
  for (int it = 0, iters = (NRT * 10 + nb - 1) / nb; it < iters; ++it) {
    int u = bid + it * nb; const bool active = u < NRT * 10; if (!active) u = NRT * 10 - 1;
    const int tid = tidx();
    const int lane = tid & 63, wave = tid >> 6, fr = lane & 15, fq = lane >> 4, q4 = fr >> 2, p4 = lane & 3;
    const int hb = u % 10, tile = u / 10, r0 = tile * RGT, ch0 = hb * 128;
    const int seg_lo = tile < NRT_LAT ? 0 : NL, seg_hi = tile < NRT_LAT ? NL : T;
    __syncthreads();
    {
      const int cg8 = tid & 15, rg = tid >> 4, c = ch0 + 8 * cg8;
      float w[4][8], bias[8];
#pragma unroll
      for (int j = 0; j < 4; ++j) { const f32x4 a = *(const f32x4*)(conv_w + j * DR + c), b = *(const f32x4*)(conv_w + j * DR + c + 4);
        w[j][0] = a.x; w[j][1] = a.y; w[j][2] = a.z; w[j][3] = a.w; w[j][4] = b.x; w[j][5] = b.y; w[j][6] = b.z; w[j][7] = b.w; }
      { const f32x4 a = *(const f32x4*)(conv_b + c), b = *(const f32x4*)(conv_b + c + 4);
        bias[0] = a.x; bias[1] = a.y; bias[2] = a.z; bias[3] = a.w; bias[4] = b.x; bias[5] = b.y; bias[6] = b.z; bias[7] = b.w; }
      float win[4][8];
      auto ldrow = [&](int r, float (&dst)[8]) {
        if (r >= seg_lo && r < seg_hi) { const u32x4 v = *(const u32x4*)(pr + (size_t)r * DR + c);
          dst[0] = bflo(v.x); dst[1] = bfhi(v.x); dst[2] = bflo(v.y); dst[3] = bfhi(v.y); dst[4] = bflo(v.z); dst[5] = bfhi(v.z); dst[6] = bflo(v.w); dst[7] = bfhi(v.w); }
        else {
#pragma unroll
          for (int e = 0; e < 8; ++e) dst[e] = 0.f; }
      };
      const int rb = r0 + rg * 4;
      ldrow(rb - 2, win[0]); ldrow(rb - 1, win[1]); ldrow(rb, win[2]);
#pragma unroll
      for (int t = 0; t < 4; ++t) {
        ldrow(rb + t + 1, win[(t + 3) & 3]);
        float o[8];
#pragma unroll
        for (int e = 0; e < 8; ++e) o[e] = bias[e] + w[0][e] * win[t & 3][e] + w[1][e] * win[(t + 1) & 3][e] + w[2][e] * win[(t + 2) & 3][e] + w[3][e] * win[(t + 3) & 3][e];
        u32x4 ov; ov.x = pk2(o[0], o[1]); ov.y = pk2(o[2], o[3]); ov.z = pk2(o[4], o[5]); ov.w = pk2(o[6], o[7]);
        *(u32x4*)(As + (rg * 4 + t) * RG_AS_STRIDE + cg8 * 16) = ov;
      }
    }
    u32x2 hfk[RG_MT][2];
#pragma unroll
    for (int d = 0; d < 2; ++d) {
      f32x4 accA[RG_MT][2], accX[RG_MT][2];
#pragma unroll
      for (int which = 0; which < 2; ++which) {
        const float* W = (which ? p.in[13] : p.in[11]) + (size_t)(d * 10 + hb) * 16384;
        __syncthreads();
#pragma unroll 1
        for (int ib = 0; ib < 4; ++ib) {
#pragma unroll
          for (int ii = 0; ii < 4; ++ii) {
            const int f = tid + 256 * (ib * 4 + ii), k = f >> 5, n = 4 * (f & 31);
            const f32x4 v = *(const f32x4*)(W + k * 128 + n);
            u32x2 o; o.x = pk2(v.x, v.y); o.y = pk2(v.z, v.w);
            *(u32x2*)(Bs + bs_off(k, n)) = o;
          }
        }
        __syncthreads();
        f32x4 (&acc)[RG_MT][2] = which ? accX : accA;
#pragma unroll
        for (int m = 0; m < RG_MT; ++m) { acc[m][0] = (f32x4){0.f, 0.f, 0.f, 0.f}; acc[m][1] = (f32x4){0.f, 0.f, 0.f, 0.f}; }
#pragma unroll
        for (int ks = 0; ks < 4; ++ks) {
          bf16x8 b[2];
#pragma unroll
          for (int n = 0; n < 2; ++n) {
            const int ncol = wave * 32 + n * 16 + 4 * p4;
            const s16x4 lo = ldtr(Bs + bs_off(ks * 32 + fq * 8 + q4, ncol));
            const s16x4 hi = ldtr(Bs + bs_off(ks * 32 + fq * 8 + 4 + q4, ncol));
            b[n] = (bf16x8){lo.x, lo.y, lo.z, lo.w, hi.x, hi.y, hi.z, hi.w};
          }
#pragma unroll
          for (int m = 0; m < RG_MT; ++m) {
            const bf16x8 a = *(const bf16x8*)(As + (m * 16 + fr) * RG_AS_STRIDE + (ks * 32 + fq * 8) * 2);
            acc[m][0] = __builtin_amdgcn_mfma_f32_16x16x32_bf16(a, b[0], acc[m][0], 0, 0, 0);
            acc[m][1] = __builtin_amdgcn_mfma_f32_16x16x32_bf16(a, b[1], acc[m][1], 0, 0, 0);
          }
        }
      }
#pragma unroll
      for (int n = 0; n < 2; ++n) {
        const int cl = wave * 32 + n * 16 + fr, ch = ch0 + cl;
        const float ba = p.in[12][d * DR + ch], bx = p.in[14][d * DR + ch], lam = p.in[15][d * DR + ch];
        const float nl = -lam;
        const float sp = nl > 20.f ? nl : log1pf(__expf(nl));
        const float c8 = -8.f * sp;
#pragma unroll
        for (int m = 0; m < RG_MT; ++m)
#pragma unroll
          for (int j = 0; j < 4; ++j) {
            const int row = m * 16 + fq * 4 + j;
            const float r = sigmoidf_(accA[m][n][j] + ba), ig = sigmoidf_(accX[m][n][j] + bx);
            const float la = c8 * r;
            const float a = __expf(la);
            const float x2 = 2.f * la;
            const float om = x2 > -0.1f ? -x2 * (1.f + x2 * (0.5f + x2 * (0.16666667f + x2 * 0.041666668f))) : 1.f - a * a;
            const float mult = sqrtf(om);
            const float uu = bf2f(*(const bf16_t*)(As + row * RG_AS_STRIDE + cl * 2));
            accA[m][n][j] = a; accX[m][n][j] = mult * ig * uu;
            if (j == 3) __builtin_amdgcn_sched_barrier(0);
          }
      }
      float aggP[2], aggH[2];
      if (d == 0) rg_scan<false>(accA, accX, aggP, aggH); else rg_scan<true>(accA, accX, aggP, aggH);
      if (fq == 0) {
#pragma unroll
        for (int n = 0; n < 2; ++n) {
          const int ch = ch0 + wave * 32 + n * 16 + fr;
          float* ag = agg + ((size_t)(d * NRT + tile) * DR + ch) * 2;
          ag[0] = aggP[n]; ag[1] = aggH[n];
        }
      }
      bf16_t* Pout = d ? Pbb : Pfb;
#pragma unroll
      for (int m = 0; m < RG_MT; ++m)
#pragma unroll
        for (int n = 0; n < 2; ++n) {
          if (d == 0) { hfk[m][n].x = pk2(accX[m][n][0], accX[m][n][1]); hfk[m][n].y = pk2(accX[m][n][2], accX[m][n][3]); }
          else { accX[m][n][0] += bflo(hfk[m][n].x); accX[m][n][1] += bfhi(hfk[m][n].x); accX[m][n][2] += bflo(hfk[m][n].y); accX[m][n][3] += bfhi(hfk[m][n].y); }
#pragma unroll
          for (int j = 0; j < 4; ++j) {
            const unsigned o = (unsigned)(r0 + m * 16 + fq * 4 + j) * DR + ch0 + wave * 32 + n * 16 + fr;
            Pout[o] = f2bf(accA[m][n][j]);
            if (d == 1) Sb[o] = f2bf(accX[m][n][j]);
          }
          __builtin_amdgcn_sched_barrier(0);
        }
    }
  }
}

DEV void ph_rg_carry(const Params& p, int bid, int nb) {
  const float* agg = (const float*)(p.ws + WS_AGG); float* carry = (float*)(p.ws + WS_CARRY);
  for (int i = bid * 256 + tidx(); i < 2 * DR; i += nb * 256) {
    const int d = i / DR, ch = i % DR;
    float st = 0.f;
    for (int s = 0; s < NRT; ++s) {
      int tile;
      if (d == 0) tile = s < (NRT - NRT_LAT) ? NRT_LAT + s : s - (NRT - NRT_LAT);
      else tile = NRT - 1 - s;
      const float* ag = agg + ((size_t)(d * NRT + tile) * DR + ch) * 2;
      carry[(size_t)(d * NRT + tile) * DR + ch] = st;
      st = ag[0] * st + ag[1];
    }
  }
}

DEV void ph_rg_final(const Params& p, int bid, int nb) {
  const bf16_t* gg = (const bf16_t*)(p.ws + WS_GG); const bf16_t* Sb = (const bf16_t*)(p.ws + WS_S);
  const bf16_t* Pfb = (const bf16_t*)(p.ws + WS_PF); const bf16_t* Pbb = (const bf16_t*)(p.ws + WS_PB);
  const float* carry = (const float*)(p.ws + WS_CARRY);
  bf16_t* y = (bf16_t*)(p.ws + WS_PR);
  const int total = T * (DR / 8);
  for (int i = bid * 256 + tidx(); i < total; i += nb * 256) {
    const int r = i / 160, c = (i % 160) * 8, tile = r / RGT;
    const size_t o = (size_t)r * DR + c;
    const u32x4 g = *(const u32x4*)(gg + o), s = *(const u32x4*)(Sb + o), pf = *(const u32x4*)(Pfb + o), pb = *(const u32x4*)(Pbb + o);
    const float* cf = carry + (size_t)tile * DR + c; const float* cb = carry + (size_t)(NRT + tile) * DR + c;
    const f32x4 cf0 = *(const f32x4*)cf, cf1 = *(const f32x4*)(cf + 4), cb0 = *(const f32x4*)cb, cb1 = *(const f32x4*)(cb + 4);
    u32x4 o4;
    o4.x = pk2(bflo(g.x) * (bflo(s.x) + bflo(pf.x) * cf0.x + bflo(pb.x) * cb0.x), bfhi(g.x) * (bfhi(s.x) + bfhi(pf.x) * cf0.y + bfhi(pb.x) * cb0.y));
    o4.y = pk2(bflo(g.y) * (bflo(s.y) + bflo(pf.y) * cf0.z + bflo(pb.y) * cb0.z), bfhi(g.y) * (bfhi(s.y) + bfhi(pf.y) * cf0.w + bfhi(pb.y) * cb0.w));
    o4.z = pk2(bflo(g.z) * (bflo(s.z) + bflo(pf.z) * cf1.x + bflo(pb.z) * cb1.x), bfhi(g.z) * (bfhi(s.z) + bfhi(pf.z) * cf1.y + bfhi(pb.z) * cb1.y));
    o4.w = pk2(bflo(g.w) * (bflo(s.w) + bflo(pf.w) * cf1.z + bflo(pb.w) * cb1.z), bfhi(g.w) * (bfhi(s.w) + bfhi(pf.w) * cf1.w + bfhi(pb.w) * cb1.w));
    *(u32x4*)(y + o) = o4;
  }
}

using pg8::Unit;
struct EpiRgIn {
  static constexpr bool PERM = true, AFTER_DRAIN = false;
  bf16_t* gg; bf16_t* pr;
  DEV void operator()(const f32x4 (&acc)[2][2][4][2], const Unit& u, int wr, int wc, int fr, int fq) const {
    const int row0 = u.pm * 256 + wr * 64 + fr, c0 = u.pn * 256 + wc * 32 + 8 * fq;
    const bool gate = u.pn < 5;
#pragma unroll
    for (int ai = 0; ai < 2; ++ai)
#pragma unroll
      for (int m = 0; m < 4; ++m) {
        const unsigned row = row0 + ai * 128 + m * 16;
#pragma unroll
        for (int bj = 0; bj < 2; ++bj) {
          f32x4 v0 = acc[ai][bj][m][0], v1 = acc[ai][bj][m][1];
          const int col = c0 + bj * 128;
          if (gate) {
#pragma unroll
            for (int j = 0; j < 4; ++j) { v0[j] = gelu_tanh(v0[j]); v1[j] = gelu_tanh(v1[j]); }
          }
          u32x4 w; w.x = pk2(v0[0], v0[1]); w.y = pk2(v0[2], v0[3]); w.z = pk2(v1[0], v1[1]); w.w = pk2(v1[2], v1[3]);
          if (gate) *(u32x4*)(gg + row * DR + col) = w; else *(u32x4*)(pr + row * DR + col - DR) = w;
        }
      }
  }
};
template <int LAYER> struct EpiOut {
  static constexpr bool PERM = false, AFTER_DRAIN = false;
  const float* x; const float* ctx; const float* x2; const float* mods; float* x1;
  DEV void operator()(const f32x4 (&acc)[2][2][4][2], const Unit& u, int wr, int wc, int fr, int fq) const {
    const int row0 = u.pm * 256 + wr * 64 + fr, c0 = u.pn * 256 + wc * 32 + 4 * fq;
#pragma unroll
    for (int ai = 0; ai < 2; ++ai)
#pragma unroll
      for (int m = 0; m < 4; ++m) {
        const int row = row0 + ai * 128 + m * 16;
        const int trow = LAYER == 0 ? row : token_of_seqrow(row);
        const float* xin = LAYER == 0 ? (row < NL ? x + (size_t)row * D : ctx + (size_t)(row - NL) * D) : x2 + (size_t)trow * D;
        const float* gt = mods + ((LAYER == 0 && row >= NL) ? 6144 : 0) + 2048;
        float* xo = x1 + (size_t)trow * D;
#pragma unroll
        for (int bj = 0; bj < 2; ++bj)
#pragma unroll
          for (int n = 0; n < 2; ++n) {
            const int col = c0 + bj * 128 + n * 16;
            *(f32x4*)(xo + col) = *(const f32x4*)(xin + col) + *(const f32x4*)(gt + col) * acc[ai][bj][m][n];
          }
      }
  }
};
struct EpiMoe1 {
  static constexpr bool PERM = true, AFTER_DRAIN = false;
  bf16_t* Hm;
  DEV void operator()(const f32x4 (&acc)[2][2][4][2], const Unit& u, int wr, int wc, int fr, int fq) const {
    const int row0 = u.pm * 256 + wr * 64 + fr, c0 = (u.pn & 3) * 128 + wc * 32 + 8 * fq;
#pragma unroll
    for (int ai = 0; ai < 2; ++ai)
#pragma unroll
      for (int m = 0; m < 4; ++m) {
        const unsigned row = row0 + ai * 128 + m * 16;
        float h[8];
#pragma unroll
        for (int n = 0; n < 2; ++n)
#pragma unroll
          for (int j = 0; j < 4; ++j) h[n * 4 + j] = siluf_(acc[ai][0][m][n][j]) * acc[ai][1][m][n][j];
        u32x4 w; w.x = pk2(h[0], h[1]); w.y = pk2(h[2], h[3]); w.z = pk2(h[4], h[5]); w.w = pk2(h[6], h[7]);
        *(u32x4*)(Hm + row * DE + c0) = w;
      }
  }
};
struct EpiMoe2 {
  static constexpr bool PERM = true, AFTER_DRAIN = false;
  bf16_t* Y; const float* awp;
  DEV void operator()(const f32x4 (&acc)[2][2][4][2], const Unit& u, int wr, int wc, int fr, int fq) const {
    const int row0 = u.pm * 256 + wr * 64 + fr, c0 = (u.pn & 3) * 256 + wc * 32 + 8 * fq;
#pragma unroll
    for (int ai = 0; ai < 2; ++ai)
#pragma unroll
      for (int m = 0; m < 4; ++m) {
        const unsigned row = row0 + ai * 128 + m * 16;
        const float w8 = awp[row];
#pragma unroll
        for (int bj = 0; bj < 2; ++bj) {
          const f32x4 v0 = acc[ai][bj][m][0] * w8, v1 = acc[ai][bj][m][1] * w8;
          u32x4 w; w.x = pk2(v0[0], v0[1]); w.y = pk2(v0[2], v0[3]); w.z = pk2(v1[0], v1[1]); w.w = pk2(v1[2], v1[3]);
          *(u32x4*)(Y + row * D + c0 + bj * 128) = w;
        }
      }
  }
};
struct EpiMlIn {
  static constexpr bool PERM = false, AFTER_DRAIN = false;
  bf16_t* qb; bf16_t* kb; bf16_t* kT; bf16_t* vT; bf16_t* og; float* gl; const float* bgt;
  DEV void operator()(const f32x4 (&acc)[2][2][4][2], const Unit& u, int wr, int wc, int fr, int fq) const {
    const unsigned row0 = u.pm * 256 + wr * 64 + fr, c0 = u.pn * 256 + wc * 32 + 4 * fq;
    const int pn = u.pn;
#define MLIN_LOOP(BODY) _Pragma("unroll") for (int ai = 0; ai < 2; ++ai) _Pragma("unroll") for (int m = 0; m < 4; ++m) { const unsigned row = row0 + ai * 128 + m * 16; \
      _Pragma("unroll") for (int bj = 0; bj < 2; ++bj) _Pragma("unroll") for (int n = 0; n < 2; ++n) { const f32x4 v = acc[ai][bj][m][n]; const unsigned col = c0 + bj * 128 + n * 16; BODY } }
    if (pn < 2) {
      MLIN_LOOP({ u32x2 o; o.x = pk2(v[0] * 0.125f, v[1] * 0.125f); o.y = pk2(v[2] * 0.125f, v[3] * 0.125f); *(u32x2*)(qb + row * 512 + col) = o; })
    } else if (pn < 4) {
      MLIN_LOOP({ u32x2 o; o.x = pk2(v[0], v[1]); o.y = pk2(v[2], v[3]); *(u32x2*)(kb + row * 512 + col - 512) = o;
        bf16_t* kp = kT + (col - 512) * T + row;
        kp[0] = (bf16_t)(o.x & 0xffffu); kp[T] = (bf16_t)(o.x >> 16); kp[2 * T] = (bf16_t)(o.y & 0xffffu); kp[3 * T] = (bf16_t)(o.y >> 16); })
    } else if (pn < 8) {
      MLIN_LOOP({ u32x2 o; o.x = pk2(v[0], v[1]); o.y = pk2(v[2], v[3]);
        bf16_t* vp = vT + (col - 1024) * T + row;
        vp[0] = (bf16_t)(o.x & 0xffffu); vp[T] = (bf16_t)(o.x >> 16); vp[2 * T] = (bf16_t)(o.y & 0xffffu); vp[3 * T] = (bf16_t)(o.y >> 16); })
    } else if (pn < 12) {
      MLIN_LOOP({ u32x2 o; o.x = pk2(sigmoidf_(v[0]), sigmoidf_(v[1])); o.y = pk2(sigmoidf_(v[2]), sigmoidf_(v[3])); *(u32x2*)(og + row * D + col - 2048) = o; })
    } else if (wc == 0) {
#pragma unroll
      for (int ai = 0; ai < 2; ++ai)
#pragma unroll
        for (int m = 0; m < 4; ++m) {
          const unsigned row = row0 + ai * 128 + m * 16;
#pragma unroll
          for (int n = 0; n < 2; ++n) {
            const int jj = 16 * n + 4 * fq;
            f32x4 g = acc[ai][0][m][n] + *(const f32x4*)(bgt + jj);
            if ((jj >> 3) & 1) {
#pragma unroll
              for (int j = 0; j < 4; ++j) g[j] = fminf(g[j], 0.f) - log1pf(__expf(-fabsf(g[j])));
            }
            *(f32x4*)(gl + row * 32 + jj) = g;
          }
        }
    }
#undef MLIN_LOOP
  }
};

struct MoeOrder {
  const int* tb; int ntn, G, c;
  DEV bool next(int i, Unit& u) const {
    const int L = i * G + c; if (L >= tb[32]) return false;
    int e = 0;
#pragma unroll 1
    for (int k = 1; k < 32; ++k) e = (L >= tb[k]) ? k : e;
    const int r = L - tb[e], mt = (tb[e + 1] - tb[e]) / ntn;
    u.pm = tb[33 + e] + r % mt; u.pn = e * ntn + r / mt; return true;
  }
  DEV void a_ready(const Unit&) const {}
  DEV void done(const Unit&) const {}
};
constexpr int LDS_TB = 131072;
DEV void moe_tables(const int* cnt, char* smem, int ntn) {
  int* tb = (int*)(smem + LDS_TB);
  if (threadIdx.x == 0) {
    int ub = 0, rb = 0;
    for (int e = 0; e < 32; ++e) { const int m = (cnt[e] + 255) >> 8; tb[e] = ub; tb[33 + e] = rb; ub += m * ntn; rb += m; }
    tb[32] = ub; tb[65] = rb;
  }
  __syncthreads();
}

template <int WHICH>
DEV void ph_gemm_dense(const Params& p, char* smem) {
  pg8::StaticOrder S;
  LAS unsigned char* lds = (LAS unsigned char*)smem;
  if constexpr (WHICH == 0) {
    S.init(T, 2560, gridDim.x, blockIdx.x);
    EpiRgIn E{(bf16_t*)(p.ws + WS_GG), (bf16_t*)(p.ws + WS_PR)};
    pg8::gemm_phase<EpiRgIn, pg8::StaticOrder>(lds, pg8::Gemm{(const bf16_t*)(p.ws + WS_HA), (const bf16_t*)(p.ws + WS_WIN), T, 2560, 1024}, S, E, nullptr);
  } else if constexpr (WHICH == 1) {
    S.init(T, 1024, gridDim.x, blockIdx.x);
    EpiOut<0> E{p.in[0], p.in[2], nullptr, (const float*)(p.ws + WS_MODS), (float*)(p.ws + WS_X1)};
    pg8::gemm_phase<EpiOut<0>, pg8::StaticOrder>(lds, pg8::Gemm{(const bf16_t*)(p.ws + WS_PR), (const bf16_t*)(p.ws + WS_WOUT), T, 1024, 1280}, S, E, nullptr);
  } else if constexpr (WHICH == 2) {
    S.init(T, MLWP, gridDim.x, blockIdx.x);
    EpiMlIn E{(bf16_t*)(p.ws + WS_Q), (bf16_t*)(p.ws + WS_K), (bf16_t*)(p.ws + WS_KT), (bf16_t*)(p.ws + WS_VT), (bf16_t*)(p.ws + WS_OG), (float*)(p.ws + WS_GL), p.in[29]};
    pg8::gemm_phase<EpiMlIn, pg8::StaticOrder>(lds, pg8::Gemm{(const bf16_t*)(p.ws + WS_HA), (const bf16_t*)(p.ws + WS_WML), T, MLWP, 1024}, S, E, nullptr);
  } else {
    S.init(NL, 1024, gridDim.x, blockIdx.x);
    EpiOut<1> E{nullptr, nullptr, (const float*)(p.ws + WS_X2), (const float*)(p.ws + WS_MODS) + 2 * 6144, (float*)(p.ws + WS_X1)};
    pg8::gemm_phase<EpiOut<1>, pg8::StaticOrder>(lds, pg8::Gemm{(const bf16_t*)(p.ws + WS_HA), (const bf16_t*)(p.ws + WS_WMO), NL, 1024, 1024}, S, E, nullptr);
  }
}
template <int LAYER, int STAGE>
DEV void ph_gemm_moe(const Params& p, char* smem) {
  const int* cnt = (const int*)(p.ws + WS_CNT) + LAYER * 32;
  moe_tables(cnt, smem, 4);
  MoeOrder S{(const int*)(smem + LDS_TB), 4, (int)gridDim.x, (int)blockIdx.x};
  LAS unsigned char* lds = (LAS unsigned char*)smem;
  if constexpr (STAGE == 0) {
    EpiMoe1 E{(bf16_t*)(p.ws + WS_HM)};
    pg8::gemm_phase<EpiMoe1, MoeOrder>(lds, pg8::Gemm{(const bf16_t*)(p.ws + WS_ABUF), (const bf16_t*)(p.ws + WS_WGU), MOE_ROWS, 32 * 1024, 1024}, S, E, nullptr);
  } else {
    EpiMoe2 E{(bf16_t*)(p.ws + WS_Y), (const float*)(p.ws + WS_AWP)};
    pg8::gemm_phase<EpiMoe2, MoeOrder>(lds, pg8::Gemm{(const bf16_t*)(p.ws + WS_HM), (const bf16_t*)(p.ws + WS_WD), MOE_ROWS, 32 * 1024, 512}, S, E, nullptr);
  }
}

template <int LAYER>
DEV void ph_scatter(const Params& p, char* smem, int bid, int nb) {
  const int tid = tidx(), lane = tid & 63, wave = tid >> 6;
  constexpr int NTOK = LAYER == 0 ? T : NL;
  const int* cnt = (const int*)(p.ws + WS_CNT) + LAYER * 32;
  const int* list = (const int*)(p.ws + WS_LIST) + (size_t)LAYER * 32 * T;
  const float* aw = (const float*)(p.ws + WS_AW);
  int* pos = (int*)(p.ws + WS_POS); float* awp = (float*)(p.ws + WS_AWP);
  const bf16_t* hA = (const bf16_t*)(p.ws + WS_HA); bf16_t* Ab = (bf16_t*)(p.ws + WS_ABUF);
  int* base = (int*)smem; int* off = base + 40;
  if (tid == 0) { int b = 0, o = 0; for (int e = 0; e < 32; ++e) { base[e] = b; off[e] = o; b += cnt[e]; o += ((cnt[e] + 255) >> 8) << 8; } base[32] = b; }
  __syncthreads();
  for (int a = bid * 4 + wave; a < 2 * NTOK; a += nb * 4) {
    int e = 0;
#pragma unroll 1
    for (int k = 1; k < 32; ++k) e = (a >= base[k]) ? k : e;
    const int i = a - base[e], ent = list[(size_t)e * T + i], dst = off[e] + i;
    const u32x4* src = (const u32x4*)(hA + (size_t)(ent >> 1) * D); u32x4* d = (u32x4*)(Ab + (size_t)dst * D);
    const u32x4 v0 = src[lane], v1 = src[lane + 64];
    d[lane] = v0; d[lane + 64] = v1;
    if (lane == 0) { pos[ent] = dst; awp[dst] = aw[ent]; }
  }
  __syncthreads();
}

constexpr int RT_STRIDE = 1028;
constexpr int RT_H2 = 0, RT_RED = 16 * RT_STRIDE * 4, RT_SMEM = RT_RED + 4 * 16 * 48 * 4;
template <int LAYER>
DEV void ph_router(const Params& p, char* smem, int bid, int nb) {
  const int tid = tidx(), lane = tid & 63, wave = tid >> 6;
  constexpr int NTOK = LAYER == 0 ? T : NL;
  const float* mods = (const float*)(p.ws + WS_MODS) + LAYER * 2 * 6144;
  const float* x1 = (const float*)(p.ws + WS_X1);
  bf16_t* hA = (bf16_t*)(p.ws + WS_HA);
  const float* g2 = p.in[LAYER == 0 ? 7 : 27];
  const float* Wg = p.in[LAYER == 0 ? 17 : 32]; const float* Bg = p.in[LAYER == 0 ? 18 : 33];
  const float* We = p.in[LAYER == 0 ? 19 : 34]; const float* Be = p.in[LAYER == 0 ? 20 : 35];
  int* cnt = (int*)(p.ws + WS_CNT) + LAYER * 32;
  int* list = (int*)(p.ws + WS_LIST) + (size_t)LAYER * 32 * T;
  float* aw = (float*)(p.ws + WS_AW);
  float* h2s = (float*)(smem + RT_H2); float* red = (float*)(smem + RT_RED);
  for (int it = 0, iters = ((NTOK / 16) + nb - 1) / nb; it < iters; ++it) {
    int u = bid + it * nb; const bool active = u < (NTOK / 16); if (!active) u = (NTOK / 16) - 1;
    const int t0 = u * 16;
    __syncthreads();
#pragma unroll
    for (int rr = 0; rr < 4; ++rr) {
      const int lr = wave * 4 + rr, t = t0 + lr;
      const float* md = mods + ((LAYER == 0 && t >= NL) ? 6144 : 0);
      const float* src = x1 + (size_t)t * D;
      f32x4 v[4]; float ss = 0.f;
#pragma unroll
      for (int i = 0; i < 4; ++i) { v[i] = *(const f32x4*)(src + 4 * lane + 256 * i); ss += v[i].x * v[i].x + v[i].y * v[i].y + v[i].z * v[i].z + v[i].w * v[i].w; }
      const float rstd = rsqrtf(wave_sum(ss) * (1.f / D) + EPS);
#pragma unroll
      for (int i = 0; i < 4; ++i) {
        const int c = 4 * lane + 256 * i;
        const f32x4 g = *(const f32x4*)(g2 + c), sh = *(const f32x4*)(md + 3072 + c), sc = *(const f32x4*)(md + 4096 + c);
        const f32x4 h = v[i] * rstd * g * (1.f + sc) + sh;
        *(f32x4*)(h2s + lr * RT_STRIDE + c) = h;
        u32x2 o; o.x = pk2(h.x, h.y); o.y = pk2(h.z, h.w);
        *(u32x2*)(hA + (size_t)t * D + c) = o;
      }
    }
    __syncthreads();
    {
      f32x4 a0 = {0.f, 0.f, 0.f, 0.f}, a1 = a0, a2 = a0;
      const int tok = lane & 15, kk = lane >> 4;
#pragma unroll 4
      for (int s = 0; s < 64; ++s) {
        const int k = wave * 256 + s * 4 + kk;
        const float a = h2s[tok * RT_STRIDE + k];
        const float b0 = We[k * 32 + tok], b1 = We[k * 32 + 16 + tok];
        const float b2 = tok < 4 ? Wg[k * 4 + tok] : 0.f;
        a0 = __builtin_amdgcn_mfma_f32_16x16x4f32(a, b0, a0, 0, 0, 0);
        a1 = __builtin_amdgcn_mfma_f32_16x16x4f32(a, b1, a1, 0, 0, 0);
        a2 = __builtin_amdgcn_mfma_f32_16x16x4f32(a, b2, a2, 0, 0, 0);
      }
#pragma unroll
      for (int j = 0; j < 4; ++j) {
        float* rp = red + ((wave * 16) + kk * 4 + j) * 48;
        rp[tok] = a0[j]; rp[16 + tok] = a1[j]; rp[32 + tok] = a2[j];
      }
    }
    __syncthreads();
    if (active && tid < 16) {
      const int t = t0 + tid;
      auto lg = [&](int c) { return red[(0 * 16 + tid) * 48 + c] + red[(1 * 16 + tid) * 48 + c] + red[(2 * 16 + tid) * 48 + c] + red[(3 * 16 + tid) * 48 + c]; };
      float gl[4];
#pragma unroll
      for (int i = 0; i < 4; ++i) gl[i] = lg(32 + i) + Bg[i];
      int grp = 0; float gm = gl[0];
#pragma unroll
      for (int i = 1; i < 4; ++i) if (gl[i] > gm) { gm = gl[i]; grp = i; }
      float den = 0.f;
#pragma unroll
      for (int i = 0; i < 4; ++i) den += __expf(gl[i] - gm);
      const float psel = 1.f / den;
      float v0 = -INFINITY, v1 = -INFINITY; int i0 = 0, i1 = 0;
      for (int i = 0; i < 8; ++i) {
        const float v = lg(grp * 8 + i) + Be[grp * 8 + i];
        if (v > v0) { v1 = v0; i1 = i0; v0 = v; i0 = i; }
        else if (v > v1) { v1 = v; i1 = i; }
      }
      const float e1 = __expf(v1 - v0);
      const float w0 = psel / (1.f + e1), w1 = psel * e1 / (1.f + e1);
      const int ea = grp * 8 + i0, eb = grp * 8 + i1;
      const int pa = atomicAdd(&cnt[ea], 1); list[(size_t)ea * T + pa] = 2 * t;
      const int pb = atomicAdd(&cnt[eb], 1); list[(size_t)eb * T + pb] = 2 * t + 1;
      aw[2 * t] = w0; aw[2 * t + 1] = w1;
    }
  }
}

DEV void ph_combine0(const Params& p, int bid, int nb) {
  const int lane = tidx() & 63, wave = tidx() >> 6;
  const float* mods0 = (const float*)(p.ws + WS_MODS); const float* mods1 = mods0 + 2 * 6144;
  const float* x1 = (const float*)(p.ws + WS_X1); float* x2 = (float*)(p.ws + WS_X2);
  const bf16_t* Y = (const bf16_t*)(p.ws + WS_Y); const int* pos = (const int*)(p.ws + WS_POS);
  bf16_t* hA = (bf16_t*)(p.ws + WS_HA);
  const float* g1 = p.in[26];
  for (int t = bid * 4 + wave; t < T; t += nb * 4) {
    const float* m0 = mods0 + (t < NL ? 0 : 6144); const float* m1 = mods1 + (t < NL ? 0 : 6144);
    const int orow = t < NL ? seqrow_of_token(t) : t;
    const bf16_t* Ya = Y + (size_t)pos[2 * t] * D; const bf16_t* Yb = Y + (size_t)pos[2 * t + 1] * D;
    f32x4 v[4]; float ss = 0.f;
#pragma unroll
    for (int i = 0; i < 4; ++i) {
      const int c = 4 * lane + 256 * i;
      const f32x4 xv = *(const f32x4*)(x1 + (size_t)t * D + c), gt = *(const f32x4*)(m0 + 5120 + c);
      const u32x2 ya = *(const u32x2*)(Ya + c), yb = *(const u32x2*)(Yb + c);
      f32x4 f; f.x = bflo(ya.x) + bflo(yb.x); f.y = bfhi(ya.x) + bfhi(yb.x); f.z = bflo(ya.y) + bflo(yb.y); f.w = bfhi(ya.y) + bfhi(yb.y);
      v[i] = xv + gt * f;
      *(f32x4*)(x2 + (size_t)t * D + c) = v[i];
      ss += v[i].x * v[i].x + v[i].y * v[i].y + v[i].z * v[i].z + v[i].w * v[i].w;
    }
    const float rstd = rsqrtf(wave_sum(ss) * (1.f / D) + EPS);
#pragma unroll
    for (int i = 0; i < 4; ++i) {
      const int c = 4 * lane + 256 * i;
      const f32x4 g = *(const f32x4*)(g1 + c), sh = *(const f32x4*)(m1 + c), sc = *(const f32x4*)(m1 + 1024 + c);
      const f32x4 h = v[i] * rstd * g * (1.f + sc) + sh;
      u32x2 o; o.x = pk2(h.x, h.y); o.y = pk2(h.z, h.w);
      *(u32x2*)(hA + (size_t)orow * D + c) = o;
    }
  }
}

DEV void ml_gate_scans(const float* gl, int r0, int h, float* li_f, float* cf, float* li_b, float* cb) {
  const int tid = tidx(), lane = tid & 63, wave = tid >> 6;
  if (tid < 128) { li_f[tid] = gl[(size_t)(r0 + tid) * 32 + h]; li_b[tid] = gl[(size_t)(r0 + tid) * 32 + 16 + h]; }
  if (wave == 0) {
    const float v0 = gl[(size_t)(r0 + 2 * lane) * 32 + 8 + h], v1 = gl[(size_t)(r0 + 2 * lane + 1) * 32 + 8 + h];
    const float s = v0 + v1; float inc = s;
#pragma unroll
    for (int o = 1; o < 64; o <<= 1) { const float t = __shfl_up(inc, o); if (lane >= o) inc += t; }
    const float ex = inc - s;
    cf[2 * lane] = ex + v0; cf[2 * lane + 1] = ex + s;
  } else if (wave == 1) {
    const float v0 = gl[(size_t)(r0 + 127 - 2 * lane) * 32 + 24 + h], v1 = gl[(size_t)(r0 + 126 - 2 * lane) * 32 + 24 + h];
    const float s = v0 + v1; float inc = s;
#pragma unroll
    for (int o = 1; o < 64; o <<= 1) { const float t = __shfl_up(inc, o); if (lane >= o) inc += t; }
    const float ex = inc - s;
    cb[127 - 2 * lane] = ex + v0; cb[126 - 2 * lane] = ex + s;
  }
}

constexpr int MLA_STRIDE = 272;
constexpr int MLA_AW = 0, MLA_BV = 2 * 64 * MLA_STRIDE, MLA_G = MLA_BV + 128 * MLA_STRIDE, MLA_SMEM = MLA_G + 6 * 128 * 4;
DEV void ph_ml_state(const Params& p, char* smem, int bid, int nb) {
  const int tid = tidx(), lane = tid & 63, wave = tid >> 6, fr = lane & 15, fq = lane >> 4;
  const float* gl = (const float*)(p.ws + WS_GL);
  const bf16_t* kT = (const bf16_t*)(p.ws + WS_KT); const bf16_t* vT = (const bf16_t*)(p.ws + WS_VT);
  float* UT = (float*)(p.ws + WS_UT); float* nvec = (float*)(p.ws + WS_NVEC); float* dec = (float*)(p.ws + WS_DEC);
  char* Aw = smem + MLA_AW; char* Bv = smem + MLA_BV;
  float* li_f = (float*)(smem + MLA_G); float* cf = li_f + 128; float* li_b = cf + 128; float* cb = li_b + 128; float* wf = cb + 128; float* wb = wf + 128;
  for (int it = 0, iters = (NTILE * 8 + nb - 1) / nb; it < iters; ++it) {
    int u = bid + it * nb; const bool active = u < NTILE * 8; if (!active) u = NTILE * 8 - 1;
    const int h = u % 8, c = u / 8, r0 = c * 128;
    __syncthreads();
    ml_gate_scans(gl, r0, h, li_f, cf, li_b, cb);
    __syncthreads();
    if (tid < 128) { wf[tid] = __expf(cf[127] - cf[tid] + li_f[tid]); wb[tid] = __expf(cb[0] - cb[tid] + li_b[tid]); }
    if (tid == 0) { dec[(c * 8 + h) * 2] = __expf(cf[127]); dec[(c * 8 + h) * 2 + 1] = __expf(cb[0]); }
#pragma unroll
    for (int i = 0; i < 8; ++i) {
      const int f = tid + 256 * i, e = f >> 4, pc = f & 15;
      *(u32x4*)(Bv + e * MLA_STRIDE + pc * 16) = *(const u32x4*)(vT + (size_t)(h * 128 + e) * T + r0 + pc * 8);
    }
    __syncthreads();
#pragma unroll
    for (int i = 0; i < 4; ++i) {
      const int f = tid + 256 * i, d = f >> 4, pc = f & 15;
      const u32x4 kv = *(const u32x4*)(kT + (size_t)(h * 64 + d) * T + r0 + pc * 8);
      float k8[8] = {bflo(kv.x), bfhi(kv.x), bflo(kv.y), bfhi(kv.y), bflo(kv.z), bfhi(kv.z), bflo(kv.w), bfhi(kv.w)};
      u32x4 of, ob;
      of.x = pk2(k8[0] * wf[pc * 8 + 0], k8[1] * wf[pc * 8 + 1]); of.y = pk2(k8[2] * wf[pc * 8 + 2], k8[3] * wf[pc * 8 + 3]);
      of.z = pk2(k8[4] * wf[pc * 8 + 4], k8[5] * wf[pc * 8 + 5]); of.w = pk2(k8[6] * wf[pc * 8 + 6], k8[7] * wf[pc * 8 + 7]);
      ob.x = pk2(k8[0] * wb[pc * 8 + 0], k8[1] * wb[pc * 8 + 1]); ob.y = pk2(k8[2] * wb[pc * 8 + 2], k8[3] * wb[pc * 8 + 3]);
      ob.z = pk2(k8[4] * wb[pc * 8 + 4], k8[5] * wb[pc * 8 + 5]); ob.w = pk2(k8[6] * wb[pc * 8 + 6], k8[7] * wb[pc * 8 + 7]);
      *(u32x4*)(Aw + d * MLA_STRIDE + pc * 16) = of;
      *(u32x4*)(Aw + (64 + d) * MLA_STRIDE + pc * 16) = ob;
    }
    __syncthreads();
    if (tid < 128) {
      float s = 0.f;
      for (int pc = 0; pc < 16; ++pc) { const u32x4 v = *(const u32x4*)(Aw + tid * MLA_STRIDE + pc * 16);
        s += (bflo(v.x) + bfhi(v.x)) + (bflo(v.y) + bfhi(v.y)) + (bflo(v.z) + bfhi(v.z)) + (bflo(v.w) + bfhi(v.w)); }
      nvec[(size_t)((c * 8 + h) * 2 + (tid >> 6)) * 64 + (tid & 63)] = s;
    }
#pragma unroll
    for (int dir = 0; dir < 2; ++dir) {
      f32x4 acc[4][2];
#pragma unroll
      for (int m = 0; m < 4; ++m) { acc[m][0] = (f32x4){0.f, 0.f, 0.f, 0.f}; acc[m][1] = (f32x4){0.f, 0.f, 0.f, 0.f}; }
#pragma unroll
      for (int ks = 0; ks < 4; ++ks) {
        bf16x8 b[2];
#pragma unroll
        for (int n = 0; n < 2; ++n) b[n] = *(const bf16x8*)(Bv + (wave * 32 + n * 16 + fr) * MLA_STRIDE + (ks * 32 + fq * 8) * 2);
#pragma unroll
        for (int m = 0; m < 4; ++m) {
          const bf16x8 a = *(const bf16x8*)(Aw + (dir * 64 + m * 16 + fr) * MLA_STRIDE + (ks * 32 + fq * 8) * 2);
          acc[m][0] = __builtin_amdgcn_mfma_f32_16x16x32_bf16(a, b[0], acc[m][0], 0, 0, 0);
          acc[m][1] = __builtin_amdgcn_mfma_f32_16x16x32_bf16(a, b[1], acc[m][1], 0, 0, 0);
        }
      }
      float* Uo = UT + (size_t)((c * 8 + h) * 2 + dir) * 8192;
#pragma unroll
      for (int m = 0; m < 4; ++m)
#pragma unroll
        for (int n = 0; n < 2; ++n) *(f32x4*)(Uo + (wave * 32 + n * 16 + fr) * 64 + m * 16 + fq * 4) = acc[m][n];
    }
  }
}

DEV void ph_ml_chain(const Params& p, int bid, int nb) {
  float* UT = (float*)(p.ws + WS_UT); float* nvec = (float*)(p.ws + WS_NVEC); const float* dec = (const float*)(p.ws + WS_DEC);
  const int total = 16 * (8192 + 64);
  for (int i = bid * 256 + tidx(); i < total; i += nb * 256) {
    const int hd = i / 8256, idx = i % 8256;
    const int dir = hd & 1;
    float st = 0.f;
    for (int s = 0; s < NTILE; ++s) {
      int c;
      if (dir == 0) c = s < 2 ? 128 + s : s - 2; else c = 129 - s;
      float* ptr = idx < 8192 ? UT + (size_t)(c * 16 + hd) * 8192 + idx : nvec + (size_t)(c * 16 + hd) * 64 + (idx - 8192);
      const float uv = *ptr; const float dc = dec[c * 16 + hd];
      *ptr = st;
      st = dc * st + uv;
    }
  }
}

constexpr int MLC_QS = 0;
constexpr int MLC_KS = 9216;
constexpr int MLC_Q2 = MLC_KS + 18432;
constexpr int MLC_BS = MLC_Q2 + 17408;
constexpr int MLC_G  = MLC_BS + 18432;
constexpr int MLC_SMEM = MLC_G + (4 * 128 + 6 * 64) * 4;
DEV void ph_ml_out(const Params& p, char* smem, int bid, int nb) {
  const int tid = tidx(), lane = tid & 63, wave = tid >> 6, fr = lane & 15, fq = lane >> 4;
  const float* gl = (const float*)(p.ws + WS_GL);
  const bf16_t* qb = (const bf16_t*)(p.ws + WS_Q); const bf16_t* kb = (const bf16_t*)(p.ws + WS_K); const bf16_t* vT = (const bf16_t*)(p.ws + WS_VT);
  const bf16_t* og = (const bf16_t*)(p.ws + WS_OG);
  const float* UT = (const float*)(p.ws + WS_UT); const float* nvec = (const float*)(p.ws + WS_NVEC);
  bf16_t* yA = (bf16_t*)(p.ws + WS_HA);
  const float* ng = p.in[30];
  char* Qs = smem + MLC_QS; char* Ks = smem + MLC_KS; char* Ps = Ks; char* Q2 = smem + MLC_Q2; char* Bs = smem + MLC_BS;
  float* li_f = (float*)(smem + MLC_G); float* cf = li_f + 128; float* li_b = cf + 128; float* cb = li_b + 128;
  float* qn = cb + 128; float* sfq = qn + 128; float* sbq = sfq + 64; float* nv = sbq + 64;
  for (int it = 0, iters = ((128 * 2 * 8) + nb - 1) / nb; it < iters; ++it) {
    int u = bid + it * nb; const bool active = u < (128 * 2 * 8); if (!active) u = (128 * 2 * 8) - 1;
    const int h = u % 8, th = (u / 8) & 1, c = u / 16, r0 = c * 128, rt = r0 + th * 64;
    __syncthreads();
    ml_gate_scans(gl, r0, h, li_f, cf, li_b, cb);
    if (tid >= 128) nv[tid - 128] = nvec[(size_t)((c * 8 + h) * 2 + ((tid - 128) >> 6)) * 64 + (tid & 63)];
#pragma unroll
    for (int i = 0; i < 2; ++i) { const int f = tid + 256 * i, r = f >> 3, pc = f & 7;
      *(u32x4*)(Qs + r * 144 + pc * 16) = *(const u32x4*)(qb + (size_t)(rt + r) * 512 + h * 64 + pc * 8); }
#pragma unroll
    for (int i = 0; i < 4; ++i) { const int f = tid + 256 * i, r = f >> 3, pc = f & 7;
      *(u32x4*)(Ks + r * 144 + pc * 16) = *(const u32x4*)(kb + (size_t)(r0 + r) * 512 + h * 64 + pc * 8); }
    __syncthreads();
    if (tid < 128) {
      const int t = tid & 63, dir = tid >> 6; float s = 0.f;
      for (int pc = 0; pc < 8; ++pc) { const u32x4 v = *(const u32x4*)(Qs + t * 144 + pc * 16); const float* nn = nv + dir * 64 + pc * 8;
        s += bflo(v.x) * nn[0] + bfhi(v.x) * nn[1] + bflo(v.y) * nn[2] + bfhi(v.y) * nn[3] + bflo(v.z) * nn[4] + bfhi(v.z) * nn[5] + bflo(v.w) * nn[6] + bfhi(v.w) * nn[7]; }
      qn[dir * 64 + t] = s;
    }
    f32x4 S[8];
#pragma unroll
    for (int n = 0; n < 8; ++n) S[n] = (f32x4){0.f, 0.f, 0.f, 0.f};
#pragma unroll
    for (int ks = 0; ks < 2; ++ks) {
      const bf16x8 a = *(const bf16x8*)(Qs + (wave * 16 + fr) * 144 + (ks * 32 + fq * 8) * 2);
#pragma unroll
      for (int n = 0; n < 8; ++n) {
        const bf16x8 b = *(const bf16x8*)(Ks + (n * 16 + fr) * 144 + (ks * 32 + fq * 8) * 2);
        S[n] = __builtin_amdgcn_mfma_f32_16x16x32_bf16(a, b, S[n], 0, 0, 0);
      }
    }
    __syncthreads();
    float rfv[4], rbv[4];
    {
      float sumf[4] = {0.f, 0.f, 0.f, 0.f}, sumb[4] = {0.f, 0.f, 0.f, 0.f};
      float Sf[8][4], Sb_[8][4];
#pragma unroll
      for (int j = 0; j < 4; ++j) {
        const int tl = wave * 16 + fq * 4 + j, tc = th * 64 + tl;
        const float cft = cf[tc], cbt = cb[tc];
#pragma unroll
        for (int n = 0; n < 8; ++n) {
          const int s = n * 16 + fr;
          const float df = s <= tc ? __expf(cft - cf[s] + li_f[s]) : 0.f;
          const float db = s >= tc ? __expf(cbt - cb[s] + li_b[s]) : 0.f;
          Sf[n][j] = S[n][j] * df; Sb_[n][j] = S[n][j] * db;
          sumf[j] += Sf[n][j]; sumb[j] += Sb_[n][j];
        }
      }
#pragma unroll
      for (int j = 0; j < 4; ++j) {
#pragma unroll
        for (int o = 1; o < 16; o <<= 1) { sumf[j] += __shfl_xor(sumf[j], o); sumb[j] += __shfl_xor(sumb[j], o); }
        const int tl = wave * 16 + fq * 4 + j, tc = th * 64 + tl;
        const float ef = __expf(cf[tc]), eb = __expf(cb[tc]);
        const float denf = ef * qn[tl] + sumf[j], denb = eb * qn[64 + tl] + sumb[j];
        rfv[j] = 1.f / fmaxf(fabsf(denf), 1.f); rbv[j] = 1.f / fmaxf(fabsf(denb), 1.f);
        if (fr == 0) { sfq[tl] = ef * rfv[j]; sbq[tl] = eb * rbv[j]; }
      }
#pragma unroll
      for (int n = 0; n < 8; ++n)
#pragma unroll
        for (int j = 0; j < 4; ++j) {
          const int tl = wave * 16 + fq * 4 + j;
          *(bf16_t*)(Ps + tl * MLA_STRIDE + (n * 16 + fr) * 2) = f2bf(Sf[n][j] * rfv[j] + Sb_[n][j] * rbv[j]);
        }
    }
    __syncthreads();
#pragma unroll
    for (int i = 0; i < 2; ++i) { const int f = tid + 256 * i, r = f >> 3, pc = f & 7;
      const u32x4 v = *(const u32x4*)(Qs + r * 144 + pc * 16); const float a = sfq[r], b = sbq[r];
      u32x4 o1, o2;
      o1.x = pk2(bflo(v.x) * a, bfhi(v.x) * a); o1.y = pk2(bflo(v.y) * a, bfhi(v.y) * a); o1.z = pk2(bflo(v.z) * a, bfhi(v.z) * a); o1.w = pk2(bflo(v.w) * a, bfhi(v.w) * a);
      o2.x = pk2(bflo(v.x) * b, bfhi(v.x) * b); o2.y = pk2(bflo(v.y) * b, bfhi(v.y) * b); o2.z = pk2(bflo(v.z) * b, bfhi(v.z) * b); o2.w = pk2(bflo(v.w) * b, bfhi(v.w) * b);
      *(u32x4*)(Q2 + r * MLA_STRIDE + pc * 16) = o1; *(u32x4*)(Q2 + r * MLA_STRIDE + 128 + pc * 16) = o2; }
    f32x4 Hh[8];
#pragma unroll
    for (int n = 0; n < 8; ++n) Hh[n] = (f32x4){0.f, 0.f, 0.f, 0.f};
#pragma unroll
    for (int kc = 0; kc < 4; ++kc) {
      __syncthreads();
      if (kc < 2) {
#pragma unroll
        for (int i = 0; i < 4; ++i) { const int f = tid + 256 * i, e = f >> 3, pc = f & 7;
          *(u32x4*)(Bs + e * 144 + pc * 16) = *(const u32x4*)(vT + (size_t)(h * 128 + e) * T + r0 + kc * 64 + pc * 8); }
      } else {
        const float* Cs = UT + (size_t)((c * 8 + h) * 2 + (kc - 2)) * 8192;
#pragma unroll
        for (int i = 0; i < 4; ++i) { const int f = tid + 256 * i, e = f >> 3, pc = f & 7;
          const f32x4 a = *(const f32x4*)(Cs + e * 64 + pc * 8), b = *(const f32x4*)(Cs + e * 64 + pc * 8 + 4);
          u32x4 o; o.x = pk2(a.x, a.y); o.y = pk2(a.z, a.w); o.z = pk2(b.x, b.y); o.w = pk2(b.z, b.w);
          *(u32x4*)(Bs + e * 144 + pc * 16) = o; }
      }
      __syncthreads();
      const char* Asrc = kc < 2 ? Ps + kc * 128 : Q2 + (kc - 2) * 128;
#pragma unroll
      for (int ks = 0; ks < 2; ++ks) {
        const bf16x8 a = *(const bf16x8*)(Asrc + (wave * 16 + fr) * MLA_STRIDE + (ks * 32 + fq * 8) * 2);
#pragma unroll
        for (int n = 0; n < 8; ++n) {
          const bf16x8 b = *(const bf16x8*)(Bs + (n * 16 + fr) * 144 + (ks * 32 + fq * 8) * 2);
          Hh[n] = __builtin_amdgcn_mfma_f32_16x16x32_bf16(a, b, Hh[n], 0, 0, 0);
        }
      }
    }
#pragma unroll
    for (int j = 0; j < 4; ++j) {
      float ss = 0.f;
#pragma unroll
      for (int n = 0; n < 8; ++n) ss += Hh[n][j] * Hh[n][j];
#pragma unroll
      for (int o = 1; o < 16; o <<= 1) ss += __shfl_xor(ss, o);
      const float rstd = rsqrtf(ss * (1.f / 128.f) + EPS);
      const size_t row = (size_t)(rt + wave * 16 + fq * 4 + j);
#pragma unroll
      for (int n = 0; n < 8; ++n) {
        const int col = h * 128 + n * 16 + fr;
        yA[row * D + col] = f2bf(Hh[n][j] * rstd * ng[col] * bf2f(og[row * D + col]));
      }
    }
  }
}

DEV void ph_final(const Params& p, int bid, int nb) {
  const int lane = tidx() & 63, wave = tidx() >> 6;
  const float* mods1 = (const float*)(p.ws + WS_MODS) + 2 * 6144;
  const float* x1 = (const float*)(p.ws + WS_X1);
  const bf16_t* Y = (const bf16_t*)(p.ws + WS_Y); const int* pos = (const int*)(p.ws + WS_POS);
  const float* gf = p.in[39];
  for (int t = bid * 4 + wave; t < NL; t += nb * 4) {
    const bf16_t* Ya = Y + (size_t)pos[2 * t] * D; const bf16_t* Yb = Y + (size_t)pos[2 * t + 1] * D;
    f32x4 v[4]; float ss = 0.f;
#pragma unroll
    for (int i = 0; i < 4; ++i) {
      const int c = 4 * lane + 256 * i;
      const f32x4 xv = *(const f32x4*)(x1 + (size_t)t * D + c), gt = *(const f32x4*)(mods1 + 5120 + c);
      const u32x2 ya = *(const u32x2*)(Ya + c), yb = *(const u32x2*)(Yb + c);
      f32x4 f; f.x = bflo(ya.x) + bflo(yb.x); f.y = bfhi(ya.x) + bfhi(yb.x); f.z = bflo(ya.y) + bflo(yb.y); f.w = bfhi(ya.y) + bfhi(yb.y);
      v[i] = xv + gt * f;
      ss += v[i].x * v[i].x + v[i].y * v[i].y + v[i].z * v[i].z + v[i].w * v[i].w;
    }
    const float rstd = rsqrtf(wave_sum(ss) * (1.f / D) + EPS);
#pragma unroll
    for (int i = 0; i < 4; ++i) {
      const int c = 4 * lane + 256 * i;
      *(f32x4*)(p.out + (size_t)t * D + c) = v[i] * rstd * *(const f32x4*)(gf + c);
    }
  }
}

#define XB_TMO      128
#define XB_XCNT(j)  (256  + 64 * (j))
#define XB_XSUB(j)  (1280 + 64 * (j))
#define XB_XGEN(j)  (2304 + 64 * (j))
#define XB_TOP      3328
#define XB_TOPGEN   3392
#define XCD_BAR_WORDS 3456
#define XB_SPIN_CAP (1u << 22)
DEV unsigned xb_ld(unsigned* p)              { return __hip_atomic_load(p, __ATOMIC_RELAXED, __HIP_MEMORY_SCOPE_AGENT); }
DEV unsigned xb_add(unsigned* p, unsigned v) { return __hip_atomic_fetch_add(p, v, __ATOMIC_RELAXED, __HIP_MEMORY_SCOPE_AGENT); }
DEV unsigned xb_xcc_id() { return (unsigned)__builtin_amdgcn_s_getreg((3 << 11) | 20) & 0xFu; }
#define XB_SPIN(cond, bar) do { unsigned _sp = 0; while (cond) { __builtin_amdgcn_s_sleep(1); \
    if ((++_sp & 255u) == 0u) { if (xb_ld(&(bar)[XB_TMO])) break; if (_sp > XB_SPIN_CAP) { atomicAdd(&(bar)[XB_TMO], 1u); break; } } } } while (0)
struct XcdBarrier { unsigned* bar; unsigned x; volatile LAS unsigned* st; };
DEV XcdBarrier xcd_barrier_post(unsigned* bar, volatile LAS unsigned* st) {
  XcdBarrier b; b.bar = bar; b.x = xb_xcc_id(); b.st = st;
  if (threadIdx.x == 0) (void)xb_add(&bar[XB_XCNT(b.x)], 1u);
  return b;
}
DEV void xcd_barrier_complete(unsigned* bar, unsigned x, unsigned& nloc, unsigned& nx) {
  const unsigned G = gridDim.x * gridDim.y * gridDim.z;
  unsigned sum, cnt, mine, sp = 0u;
  for (;;) {
    sum = 0u; cnt = 0u; mine = 0u;
#pragma unroll
    for (unsigned j = 0; j < 16; ++j) { const unsigned c = xb_ld(&bar[XB_XCNT(j)]); sum += c; cnt += (c > 0u) ? 1u : 0u; mine = (j == x) ? c : mine; }
    if (sum == G) break;
    __builtin_amdgcn_s_sleep(1);
    if ((++sp & 255u) == 0u) { if (xb_ld(&bar[XB_TMO])) break; if (sp > XB_SPIN_CAP) { atomicAdd(&bar[XB_TMO], 1u); break; } }
  }
  nloc = mine > 0u ? mine : 1u; nx = cnt > 0u ? cnt : 1u;
}
DEV void xcd_barrier(const XcdBarrier& b) {
  asm volatile("s_waitcnt vmcnt(0)" ::: "memory");
  __syncthreads();
  if (threadIdx.x == 0) {
    unsigned* bar = b.bar;
    __builtin_amdgcn_s_waitcnt(0);
    unsigned nloc = b.st[0], nx = b.st[1];
    if (nloc == 0u) { xcd_barrier_complete(bar, b.x, nloc, nx); b.st[0] = nloc; b.st[1] = nx; }
    const unsigned old = xb_add(&bar[XB_XSUB(b.x)], 1u);
    const unsigned gen = old / nloc;
    if (old + 1u == (gen + 1u) * nloc) {
      __builtin_amdgcn_fence(__ATOMIC_RELEASE, "agent");
      asm volatile("s_waitcnt vmcnt(0)" ::: "memory");
      const unsigned og = xb_add(&bar[XB_TOP], 1u);
      const unsigned tg = og / nx;
      if (og + 1u == (tg + 1u) * nx) xb_add(&bar[XB_TOPGEN], 1u);
      else XB_SPIN(xb_ld(&bar[XB_TOPGEN]) == tg, bar);
      __builtin_amdgcn_fence(__ATOMIC_ACQUIRE, "agent");
      xb_add(&bar[XB_XGEN(b.x)], 1u);
      asm volatile("s_waitcnt vmcnt(0)" ::: "memory");
    } else {
      XB_SPIN(xb_ld(&bar[XB_XGEN(b.x)]) == gen, bar);
      __builtin_amdgcn_fence(__ATOMIC_ACQUIRE, "agent");
      asm volatile("s_waitcnt vmcnt(0)" ::: "memory");
    }
  }
  __syncthreads();
}

constexpr int NPHASE = 22;
constexpr int HALF_SMEM = 78336;
constexpr int LDS_ST = 2 * HALF_SMEM;
constexpr int LDS_BYTES = LDS_ST + 16;
static_assert(RT_SMEM <= HALF_SMEM && RG_SMEM <= HALF_SMEM && MLA_SMEM <= HALF_SMEM && MLC_SMEM <= HALF_SMEM, "smem");
static_assert(LDS_TB + 66 * 4 <= LDS_ST && 8 * 8448 <= LDS_ST, "smem");

template <int PH>
DEV void run_phase(const Params& p, char* smem) {
  int half = threadIdx.x >> 8; asm volatile("" : "+v"(half)); half = __builtin_amdgcn_readfirstlane(half);
  char* hs = smem + half * HALF_SMEM;
  const int vb = blockIdx.x * 2 + half, nvb = gridDim.x * 2;
  if constexpr (PH == 0) { ph_adaln(p, hs, vb, nvb); __syncthreads(); ph_convert_dense(p, smem); ph_convert_moe<0>(p, smem); }
  else if constexpr (PH == 1) ph_norm0(p, vb, nvb);
  else if constexpr (PH == 2) ph_gemm_dense<0>(p, smem);
  else if constexpr (PH == 3) ph_rg_scan(p, hs, vb, nvb);
  else if constexpr (PH == 4) ph_rg_carry(p, vb, nvb);
  else if constexpr (PH == 5) ph_rg_final(p, vb, nvb);
  else if constexpr (PH == 6) ph_gemm_dense<1>(p, smem);
  else if constexpr (PH == 7) ph_router<0>(p, hs, vb, nvb);
  else if constexpr (PH == 8) ph_scatter<0>(p, hs, vb, nvb);
  else if constexpr (PH == 9) ph_gemm_moe<0, 0>(p, smem);
  else if constexpr (PH == 10) ph_gemm_moe<0, 1>(p, smem);
  else if constexpr (PH == 11) { ph_combine0(p, vb, nvb); ph_convert_moe<1>(p, smem); }
  else if constexpr (PH == 12) ph_gemm_dense<2>(p, smem);
  else if constexpr (PH == 13) ph_ml_state(p, hs, vb, nvb);
  else if constexpr (PH == 14) ph_ml_chain(p, vb, nvb);
  else if constexpr (PH == 15) ph_ml_out(p, hs, vb, nvb);
  else if constexpr (PH == 16) ph_gemm_dense<3>(p, smem);
  else if constexpr (PH == 17) ph_router<1>(p, hs, vb, nvb);
  else if constexpr (PH == 18) ph_scatter<1>(p, hs, vb, nvb);
  else if constexpr (PH == 19) ph_gemm_moe<1, 0>(p, smem);
  else if constexpr (PH == 20) ph_gemm_moe<1, 1>(p, smem);
  else if constexpr (PH == 21) ph_final(p, vb, nvb);
}

template <int PH>
DEV void run_from(const Params& p, char* smem) {
  run_phase<PH>(p, smem);
  if constexpr (PH + 1 < NPHASE) {
    XcdBarrier xb; xb.bar = (unsigned*)(p.ws + WS_BAR); xb.x = xb_xcc_id(); xb.st = (volatile LAS unsigned*)(LAS char*)(smem + LDS_ST);
    xcd_barrier(xb);
    run_from<PH + 1>(p, smem);
  }
}

__global__ void __launch_bounds__(512) mega_kernel(Params p) {
  extern __shared__ __attribute__((aligned(16))) char smem[];
  volatile LAS unsigned* st = (volatile LAS unsigned*)(LAS char*)(smem + LDS_ST);
  if (threadIdx.x == 0) { st[0] = 0u; st[1] = 0u; st[2] = 0u; st[3] = 0u; }
  __syncthreads();
  (void)xcd_barrier_post((unsigned*)(p.ws + WS_BAR), st);
  run_from<0>(p, smem);
}

extern "C" void kernel_launch(void* const* d_in, const int* in_sizes, int n_in, void* d_out, int out_size, void* d_ws, size_t ws_size, hipStream_t stream) {
  static int grid = 0;
  if (grid == 0) {
    if (n_in != 40 || ws_size < WS_END) { fprintf(stderr, "kernel_launch: unexpected inputs (n_in %d, ws %zu, need %zu)\n", n_in, ws_size, (size_t)WS_END); grid = -1; return; }
    int dev = 0, cus = 0, per_cu = 0;
    if (hipGetDevice(&dev) != hipSuccess || hipDeviceGetAttribute(&cus, hipDeviceAttributeMultiprocessorCount, dev) != hipSuccess) { grid = -1; return; }
    if (hipFuncSetAttribute((const void*)mega_kernel, hipFuncAttributeMaxDynamicSharedMemorySize, LDS_BYTES) != hipSuccess) { fprintf(stderr, "kernel_launch: hipFuncSetAttribute failed\n"); grid = -1; return; }
    if (hipOccupancyMaxActiveBlocksPerMultiprocessor(&per_cu, (const void*)mega_kernel, 512, LDS_BYTES) != hipSuccess || per_cu < 1) { fprintf(stderr, "kernel_launch: occupancy query failed (%d)\n", per_cu); grid = -1; return; }
    grid = cus;
    fprintf(stderr, "kernel_launch: %d CUs, occupancy %d\n", cus, per_cu);
  }
  if (grid < 0) return;
  Params p{};
  for (int i = 0; i < 40; ++i) p.in[i] = (const float*)d_in[i];
  p.out = (float*)d_out; p.ws = (char*)d_ws;
  if (hipMemsetAsync((char*)d_ws, 0, WS_ZERO_BYTES, stream) != hipSuccess) return;
  void* args[] = {&p};
  hipError_t e = hipLaunchCooperativeKernel((const void*)mega_kernel, dim3(grid), dim3(512), args, LDS_BYTES, stream);
  if (e != hipSuccess) fprintf(stderr, "cooperative launch failed: %s (grid %d)\n", hipGetErrorString(e), grid);
}
```

```cpp
#include <hip/hip_runtime.h>
#include <cstdio>
#include <cstdint>

#define DEV __device__ __forceinline__
typedef unsigned short bf16_t;
typedef short bf16x8 __attribute__((ext_vector_type(8)));
typedef short s16x4 __attribute__((ext_vector_type(4)));
typedef float f32x4 __attribute__((ext_vector_type(4)));
typedef unsigned u32x4 __attribute__((ext_vector_type(4)));
typedef unsigned u32x2 __attribute__((ext_vector_type(2)));
#define LAS __attribute__((address_space(3)))

constexpr int D = 1024, NL = 16384, NC = 256, T = NL + NC, NTILE = T / 128;
constexpr int DR = 1280, NEXP = 32, DE = 512;
constexpr int RGT = 64, NRT = T / RGT, NRT_LAT = NL / RGT;
constexpr int MLW = 3104, MLWP = 3328;
constexpr int MOE_ROWS = 41472;
constexpr float EPS = 1e-6f;

constexpr size_t al256(size_t x) { return (x + 255) & ~(size_t)255; }
constexpr size_t WS_BAR   = 0;
constexpr size_t WS_CNT   = 16384;
constexpr size_t WS_ZERO_BYTES = 16384 + 256;
constexpr size_t WS_MODS  = 32768;
constexpr size_t WS_LIST  = WS_MODS + al256(2 * 2 * 6144 * 4);
constexpr size_t WS_AW    = WS_LIST + al256((size_t)2 * 32 * T * 4);
constexpr size_t WS_POS   = WS_AW + al256((size_t)2 * T * 4);
constexpr size_t WS_AWP   = WS_POS + al256((size_t)2 * T * 4);
constexpr size_t WS_AGG   = WS_AWP + al256((size_t)MOE_ROWS * 4);
constexpr size_t WS_CARRY = WS_AGG + al256((size_t)2 * NRT * DR * 2 * 4);
constexpr size_t WS_GL    = WS_CARRY + al256((size_t)2 * NRT * DR * 4);
constexpr size_t WS_NVEC  = WS_GL + al256((size_t)T * 32 * 4);
constexpr size_t WS_DEC   = WS_NVEC + al256((size_t)NTILE * 16 * 64 * 4);
constexpr size_t WS_WIN   = WS_DEC + al256((size_t)NTILE * 16 * 4);
constexpr size_t WS_WOUT  = WS_WIN + al256((size_t)2560 * 1024 * 2);
constexpr size_t WS_WML   = WS_WOUT + al256((size_t)1024 * 1280 * 2);
constexpr size_t WS_WMO   = WS_WML + al256((size_t)MLWP * 1024 * 2);
constexpr size_t WS_WGU   = WS_WMO + al256((size_t)1024 * 1024 * 2);
constexpr size_t WS_WD    = WS_WGU + al256((size_t)32 * 1024 * 1024 * 2);
constexpr size_t WS_WAXT  = WS_WD + al256((size_t)32 * 1024 * 512 * 2);
constexpr size_t WS_HA    = WS_WAXT + al256((size_t)40 * 16384 * 2);
constexpr size_t WS_X1    = WS_HA + al256((size_t)T * D * 2);
constexpr size_t WS_X2    = WS_X1 + al256((size_t)T * D * 4);
constexpr size_t WS_R0    = WS_X2 + al256((size_t)T * D * 4);
constexpr size_t WS_GG    = WS_R0;
constexpr size_t WS_PR    = WS_GG + al256((size_t)T * DR * 2);
constexpr size_t WS_S     = WS_PR + al256((size_t)T * DR * 2);
constexpr size_t WS_PF    = WS_S + al256((size_t)T * DR * 2);
constexpr size_t WS_PB    = WS_PF + al256((size_t)T * DR * 2);
constexpr size_t WS_R0END = WS_PB + al256((size_t)T * DR * 2);
constexpr size_t WS_ABUF  = WS_R0;
constexpr size_t WS_HM    = WS_ABUF + al256((size_t)MOE_ROWS * D * 2);
constexpr size_t WS_Y     = WS_HM + al256((size_t)MOE_ROWS * DE * 2);
constexpr size_t WS_MOEEND = WS_Y + al256((size_t)MOE_ROWS * D * 2);
constexpr size_t WS_Q     = WS_R0;
constexpr size_t WS_K     = WS_Q + al256((size_t)T * 512 * 2);
constexpr size_t WS_KT    = WS_K + al256((size_t)T * 512 * 2);
constexpr size_t WS_VT    = WS_KT + al256((size_t)T * 512 * 2);
constexpr size_t WS_OG    = WS_VT + al256((size_t)T * D * 2);
constexpr size_t WS_UT    = WS_OG + al256((size_t)T * D * 2);
constexpr size_t WS_L1END = WS_UT + al256((size_t)NTILE * 16 * 8192 * 4);
constexpr size_t cmax(size_t a, size_t b) { return a > b ? a : b; }
constexpr size_t WS_END   = cmax(cmax(WS_R0END, WS_L1END), WS_MOEEND);

struct Params {
  const float* in[40];
  float* out;
  char* ws;
};

typedef __bf16 bf16v2_t __attribute__((ext_vector_type(2)));
typedef float f32x2_t __attribute__((ext_vector_type(2)));
DEV unsigned pk2(float lo, float hi) { const f32x2_t v = {lo, hi}; return __builtin_bit_cast(unsigned, __builtin_convertvector(v, bf16v2_t)); }
DEV float bflo(unsigned u) { return __uint_as_float(u << 16); }
DEV float bfhi(unsigned u) { return __uint_as_float(u & 0xffff0000u); }
DEV float bf2f(bf16_t b) { return __uint_as_float((unsigned)b << 16); }
DEV bf16_t f2bf(float f) { return (bf16_t)(pk2(f, 0.f) & 0xffffu); }
DEV float fexp_(float x) { return __builtin_amdgcn_exp2f(x * 1.4426950408889634f); }
DEV float sigmoidf_(float x) { return __builtin_amdgcn_rcpf(1.f + __builtin_amdgcn_exp2f(x * -1.4426950408889634f)); }
DEV float siluf_(float x) { return x * sigmoidf_(x); }
DEV float gelu_tanh(float x) { const float u = 0.7978845608028654f * (x + 0.044715f * x * x * x); return x * sigmoidf_(2.f * u); }
DEV float wave_sum(float v) {
#pragma unroll
  for (int o = 1; o < 64; o <<= 1) v += __shfl_xor(v, o);
  return v;
}
DEV s16x4 ldtr(const char* p) { return __builtin_bit_cast(s16x4, __builtin_amdgcn_ds_read_tr16_b64_v4i16((LAS s16x4*)p)); }
DEV int tidx() { int t = threadIdx.x & 255; asm volatile("" : "+v"(t)); return t; }
DEV int seqrow_of_token(int t) { return (t & 63) * 256 + (t >> 6); }
DEV int token_of_seqrow(int s) { return (s & 255) * 64 + (s >> 8); }

constexpr int BS_STRIDE = 320;
DEV int bs_off(int k, int n) { return k * BS_STRIDE + ((((n >> 4) ^ ((k >> 3) & 1))) << 5) + (n & 15) * 2; }

namespace pg8 {
#define PG8_LAS __attribute__((address_space(3)))
typedef unsigned short bf16_t;
typedef short bf16x8 __attribute__((ext_vector_type(8)));
typedef float f32x4 __attribute__((ext_vector_type(4)));
typedef unsigned u32x4 __attribute__((ext_vector_type(4)));
constexpr int BM = 256, BK = 64, HALF = 128, HTB = HALF * BK * 2  , STAGE_BYTES = 8 * HTB, NXCD = 8, WGM = 8;

__host__ __device__ __forceinline__ int lds_byte(int r, int c) { const int st = (r >> 4) * 2 + (c >> 5), rr = r & 15, cc = c & 31, ob = rr * 64 + cc * 2; return st * 1024 + (ob ^ (((ob >> 9) & 1) << 5)); }
__host__ __device__ __forceinline__ void stage_rc(int b, int& R, int& C) { const int st = b / 1024, sb = b % 1024, swz = sb ^ (((sb >> 9) & 1) << 5); R = (st >> 1) * 16 + swz / 64; C = (st & 1) * 32 + (swz % 64) / 2; }
__host__ __device__ __forceinline__ int perm32(int rho) { const int n = rho >> 4, i = rho & 15; return 8 * (i >> 2) + 4 * n + (i & 3); }

struct Unit { int pm, pn; };
struct Gemm { const bf16_t* A; const bf16_t* Bt; int M, N, K; };

struct StaticOrder {
    int nM, nN, nwg, G, c;
    __host__ __device__ void init(int M, int N, int G_, int c_) { nM = M / BM; nN = N / BM; nwg = nM * nN; G = G_; c = c_; }
    __host__ __device__ bool next(int i, Unit& u) const {
        const long L = (long)i * G + c; if (L >= nwg) return false;
        int wgid = (int)L; { const int q = nwg / NXCD, r = nwg % NXCD, xcd = wgid % NXCD, off = wgid / NXCD; wgid = (xcd < r ? xcd * (q + 1) : r * (q + 1) + (xcd - r) * q) + off; }
        const int nig = WGM * nN, gid = wgid / nig, fm = gid * WGM, gsz = (nM - fm) < WGM ? (nM - fm) : WGM;
        u.pm = fm + ((wgid % nig) % gsz); u.pn = (wgid % nig) / gsz; return true;
    }
    __device__ __forceinline__ void a_ready(const Unit&) const {}
    __device__ __forceinline__ void done(const Unit&) const {}
};
template <class Epi, class Sched, bool STAMP = false>
__device__ __forceinline__ void gemm_phase(PG8_LAS unsigned char* lds, const Gemm g, const Sched& S, const Epi& E, unsigned long long* stamps) {
    int tid = threadIdx.x; asm volatile("" : "+v"(tid));
    const int wid = __builtin_amdgcn_readfirstlane(tid >> 6), lane = tid & 63, wr = wid >> 2, wc = wid & 3, fr = lane & 15, fq = lane >> 4;
    const int K = g.K, nt = K / BK;
    int ts_lo = 0, ts_hi = 0, nts = 0; const unsigned long long rt_entry = STAMP ? (unsigned long long)wall_clock64() : 0ull;
#define PG8_STAMP() do { if (STAMP && wid == 0 && nts < 64) { const unsigned long long _c = (unsigned long long)clock64(); \
        ts_lo = (lane == nts) ? (int)(unsigned)_c : ts_lo; ts_hi = (lane == nts) ? (int)(unsigned)(_c >> 32) : ts_hi; ++nts; } } while (0)
    PG8_STAMP();
    unsigned voffA[2], voffB[2];
#pragma unroll
    for (int i = 0; i < 2; ++i) { int R, C; stage_rc(tid * 16 + i * 8192, R, C); const int Rb = Epi::PERM ? ((R & ~31) + perm32(R & 31)) : R;
        voffA[i] = (unsigned)(R * K + C) * 2u; voffB[i] = (unsigned)(Rb * K + C) * 2u; }
    const size_t kstep = (size_t)(BK * 2);
    const size_t hstep = (size_t)HALF * K * 2;
    const size_t tstep = 2 * hstep;
    const unsigned ldsw = (unsigned)wid * 1024u;
    const int aoff = lds_byte(wr * 64 + fr, fq * 8), boff = lds_byte(wc * 32 + fr, fq * 8);
#define PG8_SA(b, h) (((b) * 2 + (h)) * HTB)
#define PG8_SB(b, h) ((4 + (b) * 2 + (h)) * HTB)
#define PG8_STAGE(bufoff, gbase, voff) do { _Pragma("unroll") for (int _i = 0; _i < 2; ++_i) \
        __builtin_amdgcn_global_load_lds((const unsigned*)((const char*)(gbase) + (voff)[_i]), (PG8_LAS unsigned*)(lds + (bufoff) + ldsw + _i * 8192), 16, 0, 0); } while (0)
#define PG8_LDA(dst, b, h) do { _Pragma("unroll") for (int m = 0; m < 4; ++m) _Pragma("unroll") for (int k = 0; k < 2; ++k) dst[m][k] = *(const PG8_LAS bf16x8*)(lds + PG8_SA(b, h) + aoff + m * 2048 + k * 1024); } while (0)
#define PG8_LDB(dst, b, h) do { _Pragma("unroll") for (int n = 0; n < 2; ++n) _Pragma("unroll") for (int k = 0; k < 2; ++k) dst[n][k] = *(const PG8_LAS bf16x8*)(lds + PG8_SB(b, h) + boff + n * 2048 + k * 1024); } while (0)
#define PG8_MMA(ai, bj, At, Bt) do { __builtin_amdgcn_s_setprio(1); _Pragma("unroll") for (int m = 0; m < 4; ++m) _Pragma("unroll") for (int n = 0; n < 2; ++n) _Pragma("unroll") for (int k = 0; k < 2; ++k) \
        acc[ai][bj][m][n] = __builtin_amdgcn_mfma_f32_16x16x32_bf16(Bt[n][k], At[m][k], acc[ai][bj][m][n], 0, 0, 0); __builtin_amdgcn_s_setprio(0); } while (0)
#define PG8_WAIT_V(n) asm volatile("s_waitcnt vmcnt(" #n ")" ::: "memory")
#define PG8_WAIT_L(n) asm volatile("s_waitcnt lgkmcnt(" #n ")" ::: "memory")
#define PG8_BAR __builtin_amdgcn_s_barrier()
#define PG8_SCHED __builtin_amdgcn_sched_barrier(0)
    Unit cur, nxt; int ui = 0;
    if (!S.next(0, cur)) return;
    f32x4 acc[2][2][4][2];
#pragma unroll
    for (int a = 0; a < 2; ++a)
#pragma unroll
        for (int b = 0; b < 2; ++b)
#pragma unroll
            for (int m = 0; m < 4; ++m)
#pragma unroll
                for (int n = 0; n < 2; ++n) acc[a][b][m][n] = (f32x4){0.f, 0.f, 0.f, 0.f};
    bf16x8 At[4][2], B0[2][2], B1[2][2];
    const char* cA = (const char*)g.A + (size_t)cur.pm * tstep; const char* cB = (const char*)g.Bt + (size_t)cur.pn * tstep;
    S.a_ready(cur);
    PG8_STAGE(PG8_SB(0, 0), cB, voffB); PG8_STAGE(PG8_SA(0, 0), cA, voffA); PG8_STAGE(PG8_SB(0, 1), cB + hstep, voffB); PG8_STAGE(PG8_SA(0, 1), cA + hstep, voffA);
    if (wr == 1) PG8_BAR;
    PG8_WAIT_V(4); PG8_BAR;
    PG8_STAGE(PG8_SB(1, 0), cB + kstep, voffB); PG8_STAGE(PG8_SA(1, 0), cA + kstep, voffA); PG8_STAGE(PG8_SB(1, 1), cB + hstep + kstep, voffB);
    PG8_WAIT_V(6); PG8_BAR;
    PG8_STAMP();
    for (;;) {
        const bool has_next = S.next(ui + 1, nxt);
        const char* nA = has_next ? (const char*)g.A + (size_t)nxt.pm * tstep : cA; const char* nB = has_next ? (const char*)g.Bt + (size_t)nxt.pn * tstep : cB;
        for (int t = 0; t < nt; t += 2) {
            const bool last = (t == nt - 2);
            const char* a1 = cA + (size_t)(t + 1) * kstep;
            const char* a2 = last ? nA : cA + (size_t)(t + 2) * kstep; const char* b2 = last ? nB : cB + (size_t)(t + 2) * kstep;
            const char* a3 = a2 + kstep; const char* b3 = b2 + kstep;
            if (last && has_next) S.a_ready(nxt);
            PG8_LDB(B0, 0, 0); PG8_SCHED; PG8_LDA(At, 0, 0); PG8_STAGE(PG8_SA(1, 1), a1 + hstep, voffA);
            PG8_WAIT_L(8); PG8_BAR; PG8_WAIT_L(0); PG8_MMA(0, 0, At, B0); PG8_BAR; PG8_SCHED;
            PG8_LDB(B1, 0, 1); PG8_STAGE(PG8_SB(0, 0), b2, voffB);
            PG8_BAR; PG8_WAIT_L(0); PG8_MMA(0, 1, At, B1); PG8_BAR;
            PG8_LDA(At, 0, 1); PG8_STAGE(PG8_SA(0, 0), a2, voffA);
            PG8_BAR; PG8_WAIT_L(0); PG8_MMA(1, 0, At, B0); PG8_BAR; PG8_SCHED;
            PG8_STAGE(PG8_SB(0, 1), b2 + hstep, voffB);
            PG8_WAIT_V(6); PG8_BAR; PG8_MMA(1, 1, At, B1); PG8_BAR;
            PG8_LDB(B0, 1, 0); PG8_SCHED; PG8_LDA(At, 1, 0); PG8_STAGE(PG8_SA(0, 1), a2 + hstep, voffA);
            PG8_WAIT_L(8); PG8_BAR; PG8_WAIT_L(0); PG8_MMA(0, 0, At, B0); PG8_BAR; PG8_SCHED;
            PG8_LDB(B1, 1, 1); PG8_STAGE(PG8_SB(1, 0), b3, voffB);
            PG8_BAR; PG8_WAIT_L(0); PG8_MMA(0, 1, At, B1); PG8_BAR;
            PG8_LDA(At, 1, 1); PG8_STAGE(PG8_SA(1, 0), a3, voffA);
            PG8_BAR; PG8_WAIT_L(0); PG8_MMA(1, 0, At, B0); PG8_BAR; PG8_SCHED;
            PG8_STAGE(PG8_SB(1, 1), b3 + hstep, voffB);
            PG8_WAIT_V(6); PG8_BAR; PG8_MMA(1, 1, At, B1); PG8_BAR;
        }
        PG8_STAMP();
        if constexpr (!Epi::AFTER_DRAIN) { E(acc, cur, wr, wc, fr, fq); S.done(cur); }
        PG8_STAMP();
        if (!has_next) break;
#pragma unroll
        for (int a = 0; a < 2; ++a)
#pragma unroll
            for (int b = 0; b < 2; ++b)
#pragma unroll
                for (int m = 0; m < 4; ++m)
#pragma unroll
                    for (int n = 0; n < 2; ++n) acc[a][b][m][n] = (f32x4){0.f, 0.f, 0.f, 0.f};
        cur = nxt; cA = nA; cB = nB; ++ui;
    }
    PG8_WAIT_V(0);
    if (wr == 0) PG8_BAR;
    PG8_BAR;
    if constexpr (Epi::AFTER_DRAIN) { E.fused(acc, cur, wr, wc, fr, fq, lds, wid, lane); S.done(cur); }
    PG8_STAMP();
    if (STAMP && wid == 0) { stamps[lane] = lane < nts ? (((unsigned long long)(unsigned)ts_hi << 32) | (unsigned)ts_lo) : 0ull;
        if (lane == 62) stamps[62] = rt_entry; if (lane == 63) stamps[63] = (unsigned long long)wall_clock64(); }
#undef PG8_STAMP
#undef PG8_SA
#undef PG8_SB
#undef PG8_STAGE
#undef PG8_LDA
#undef PG8_LDB
#undef PG8_MMA
#undef PG8_WAIT_V
#undef PG8_WAIT_L
#undef PG8_BAR
#undef PG8_SCHED
}
}

DEV void ph_adaln(const Params& p, char* smem, int bid, int nb) {
  float* sc = (float*)smem; float* sx = sc + 1024; f32x4* red = (f32x4*)(sx + 1024);
  const int tid = tidx();
  for (int i = tid; i < 1024; i += 256) { sc[i] = siluf_(p.in[1][i]); sx[i] = siluf_(p.in[3][i]); }
  __syncthreads();
  float* mods = (float*)(p.ws + WS_MODS);
  const int cl = tid & 15, kg = tid >> 4;
  for (int it = 0, iters = (192 + nb - 1) / nb; it < iters; ++it) {
    const int u = bid + it * nb; const bool active = u < 192;
    const int l = u / 96, c0 = (u % 96) * 64;
    const float* W = p.in[l ? 24 : 4]; const float* B = p.in[l ? 25 : 5];
    if (active) {
      f32x4 ac = {0.f, 0.f, 0.f, 0.f}, ax = {0.f, 0.f, 0.f, 0.f};
      const float* wp = W + (size_t)(kg * 64) * 6144 + c0 + 4 * cl;
#pragma unroll 8
      for (int kk = 0; kk < 64; ++kk) {
        const f32x4 w = *(const f32x4*)(wp + (size_t)kk * 6144);
        const float a = sc[kg * 64 + kk], b = sx[kg * 64 + kk];
        ac += a * w; ax += b * w;
      }
      red[kg * 16 + cl] = ac; red[256 + kg * 16 + cl] = ax;
    }
    __syncthreads();
    if (active && tid < 32) {
      const int which = tid >> 4, c = tid & 15;
      f32x4 s = {0.f, 0.f, 0.f, 0.f};
      for (int g = 0; g < 16; ++g) s += red[which * 256 + g * 16 + c];
      const f32x4 bb = *(const f32x4*)(B + c0 + 4 * c);
      *(f32x4*)(mods + (size_t)(l * 2 + which) * 6144 + c0 + 4 * c) = s + bb;
    }
    __syncthreads();
  }
}

DEV void transpose_item(const float* W, int N, int K, bf16_t* WT, float* scr, int k0, int n0, int lane) {
#pragma unroll 8
  for (int i = 0; i < 32; ++i) { const int kk = 2 * i + (lane >> 5); scr[kk * 33 + (lane & 31)] = W[(size_t)(k0 + kk) * N + n0 + (lane & 31)]; }
  asm volatile("s_waitcnt lgkmcnt(0)" ::: "memory");
  const int c = lane & 7;
#pragma unroll
  for (int j = 0; j < 4; ++j) { const int n = (lane >> 3) + 8 * j; const float* s = scr + (8 * c) * 33 + n;
    u32x4 o; o.x = pk2(s[0 * 33], s[1 * 33]); o.y = pk2(s[2 * 33], s[3 * 33]); o.z = pk2(s[4 * 33], s[5 * 33]); o.w = pk2(s[6 * 33], s[7 * 33]);
    *(u32x4*)(WT + (size_t)n * K + k0 + 8 * c) = o; }
  asm volatile("s_waitcnt lgkmcnt(0)" ::: "memory");
}
constexpr int CI_WIN = 16 * 80, CI_WOUT = 20 * 32, CI_WML = 16 * 97, CI_WMO = 16 * 32, CI_WAX = 40 * 8, CI_DENSE = CI_WIN + CI_WOUT + CI_WML + CI_WMO + CI_WAX;
constexpr int CI_MOE = 32 * 768;
DEV void ph_convert_dense(const Params& p, char* smem) {
  const int lane = threadIdx.x & 63, wv = threadIdx.x >> 6;
  float* scr = (float*)(smem + wv * 8448);
  const int gw = blockIdx.x * 8 + wv, ngw = gridDim.x * 8;
  for (int it = gw; it < CI_DENSE; it += ngw) {
    int r = it;
    if (r < CI_WIN) { const int kb = r / 80, nb_ = r % 80; transpose_item(p.in[8], 2560, 1024, (bf16_t*)(p.ws + WS_WIN) + (size_t)(nb_ * 32) * 1024, scr, kb * 64, nb_ * 32, lane); continue; } r -= CI_WIN;
    if (r < CI_WOUT) { const int kb = r / 32, nb_ = r % 32; transpose_item(p.in[16], 1024, 1280, (bf16_t*)(p.ws + WS_WOUT) + (size_t)(nb_ * 32) * 1280, scr, kb * 64, nb_ * 32, lane); continue; } r -= CI_WOUT;
    if (r < CI_WML) { const int kb = r / 97, nb_ = r % 97; transpose_item(p.in[28], MLW, 1024, (bf16_t*)(p.ws + WS_WML) + (size_t)(nb_ * 32) * 1024, scr, kb * 64, nb_ * 32, lane); continue; } r -= CI_WML;
    if (r < CI_WMO) { const int kb = r / 32, nb_ = r % 32; transpose_item(p.in[31], 1024, 1024, (bf16_t*)(p.ws + WS_WMO) + (size_t)(nb_ * 32) * 1024, scr, kb * 64, nb_ * 32, lane); continue; } r -= CI_WMO;
    { const int mi = r >> 3, rr = r & 7, kb = rr >> 2, nb_ = rr & 3, dh = mi >> 1, which = mi & 1;
      transpose_item((which ? p.in[13] : p.in[11]) + (size_t)dh * 16384, 128, 128, (bf16_t*)(p.ws + WS_WAXT) + (size_t)mi * 16384 + (size_t)(nb_ * 32) * 128, scr, kb * 64, nb_ * 32, lane); }
  }
  { u32x4* z = (u32x4*)((bf16_t*)(p.ws + WS_WML) + (size_t)MLW * 1024); const int n16 = (MLWP - MLW) * 1024 * 2 / 16;
    for (int i = blockIdx.x * 512 + threadIdx.x; i < n16; i += gridDim.x * 512) z[i] = (u32x4){0u, 0u, 0u, 0u}; }
}
template <int LAYER>
DEV void ph_convert_moe(const Params& p, char* smem) {
  const int lane = threadIdx.x & 63, wv = threadIdx.x >> 6;
  float* scr = (float*)(smem + wv * 8448);
  const int gw = blockIdx.x * 8 + wv, ngw = gridDim.x * 8;
  const float* Wg = p.in[LAYER == 0 ? 21 : 36]; const float* Wu = p.in[LAYER == 0 ? 22 : 37]; const float* Wd = p.in[LAYER == 0 ? 23 : 38];
  bf16_t* WGU = (bf16_t*)(p.ws + WS_WGU); bf16_t* WD = (bf16_t*)(p.ws + WS_WD);
  for (int it = gw; it < CI_MOE; it += ngw) {
    const int e = it / 768, r = it % 768;
    if (r < 512) {
      const int up = r >> 8, rr = r & 255, kb = rr >> 4, nb_ = rr & 15, n0 = nb_ * 32;
      bf16_t* dst = WGU + ((size_t)e * 1024 + (n0 >> 7) * 256 + up * 128 + (n0 & 127)) * 1024;
      transpose_item((up ? Wu : Wg) + (size_t)e * 1024 * 512, 512, 1024, dst, scr, kb * 64, n0, lane);
    } else {
      const int rr = r - 512, kb = rr >> 5, nb_ = rr & 31, n0 = nb_ * 32;
      transpose_item(Wd + (size_t)e * 512 * 1024, 1024, 512, WD + ((size_t)e * 1024 + n0) * 512, scr, kb * 64, n0, lane);
    }
  }
}

DEV void ph_norm0(const Params& p, int bid, int nb) {
  const int lane = tidx() & 63, wave = tidx() >> 6;
  const float* mods = (const float*)(p.ws + WS_MODS);
  bf16_t* hA = (bf16_t*)(p.ws + WS_HA);
  const float* g1 = p.in[6];
  for (int r = bid * 4 + wave; r < T; r += nb * 4) {
    const float* src = r < NL ? p.in[0] + (size_t)r * D : p.in[2] + (size_t)(r - NL) * D;
    const float* md = mods + (r < NL ? 0 : 6144);
    f32x4 v[4]; float ss = 0.f;
#pragma unroll
    for (int i = 0; i < 4; ++i) { v[i] = *(const f32x4*)(src + 4 * lane + 256 * i); ss += v[i].x * v[i].x + v[i].y * v[i].y + v[i].z * v[i].z + v[i].w * v[i].w; }
    const float rstd = rsqrtf(wave_sum(ss) * (1.f / D) + EPS);
#pragma unroll
    for (int i = 0; i < 4; ++i) {
      const int c = 4 * lane + 256 * i;
      const f32x4 g = *(const f32x4*)(g1 + c), sh = *(const f32x4*)(md + c), sc = *(const f32x4*)(md + 1024 + c);
      const f32x4 h = v[i] * rstd * g * (1.f + sc) + sh;
      u32x2 o; o.x = pk2(h.x, h.y); o.y = pk2(h.z, h.w);
      *(u32x2*)(hA + (size_t)r * D + c) = o;
    }
  }
}

constexpr int RG_AS_STRIDE = 272;
constexpr int RG_MT = RGT / 16;
constexpr int RG_AS = 0, RG_BS = RGT * RG_AS_STRIDE, RG_SMEM = RG_BS + 128 * BS_STRIDE;

template <bool REV, int NT>
DEV void rg_scan(f32x4 (&A)[RG_MT][NT], f32x4 (&B)[RG_MT][NT], float (&aggP)[NT], float (&aggH)[NT]) {
  const int lane = tidx() & 63, fq = lane >> 4, fr = lane & 15;
#pragma unroll
  for (int n = 0; n < NT; ++n) {
    float cP = 1.f, cH = 0.f;
#pragma unroll
    for (int mm = 0; mm < RG_MT; ++mm) {
      const int m = REV ? RG_MT - 1 - mm : mm;
      float P[4], H[4];
      if (!REV) {
        P[0] = A[m][n][0]; H[0] = B[m][n][0];
#pragma unroll
        for (int j = 1; j < 4; ++j) { P[j] = A[m][n][j] * P[j - 1]; H[j] = A[m][n][j] * H[j - 1] + B[m][n][j]; }
      } else {
        P[3] = A[m][n][3]; H[3] = B[m][n][3];
#pragma unroll
        for (int j = 2; j >= 0; --j) { P[j] = A[m][n][j] * P[j + 1]; H[j] = A[m][n][j] * H[j + 1] + B[m][n][j]; }
      }
      float IP = REV ? P[0] : P[3], IH = REV ? H[0] : H[3];
      float tP, tH;
      tP = REV ? __shfl_down(IP, 16) : __shfl_up(IP, 16); tH = REV ? __shfl_down(IH, 16) : __shfl_up(IH, 16);
      if (REV ? (fq <= 2) : (fq >= 1)) { IH = IP * tH + IH; IP = IP * tP; }
      tP = REV ? __shfl_down(IP, 32) : __shfl_up(IP, 32); tH = REV ? __shfl_down(IH, 32) : __shfl_up(IH, 32);
      if (REV ? (fq <= 1) : (fq >= 2)) { IH = IP * tH + IH; IP = IP * tP; }
      float EP = REV ? __shfl_down(IP, 16) : __shfl_up(IP, 16), EH = REV ? __shfl_down(IH, 16) : __shfl_up(IH, 16);
      if (REV ? (fq == 3) : (fq == 0)) { EP = 1.f; EH = 0.f; }
      const float hin = EP * cH + EH, pin = EP * cP;
#pragma unroll
      for (int j = 0; j < 4; ++j) { B[m][n][j] = H[j] + P[j] * hin; A[m][n][j] = P[j] * pin; }
      const float TP = __shfl(IP, (REV ? 0 : 48) + fr), TH = __shfl(IH, (REV ? 0 : 48) + fr);
      cH = TP * cH + TH; cP = TP * cP;
    }
    aggP[n] = cP; aggH[n] = cH;
  }
}

DEV void ph_rg_scan(const Params& p, char* smem, int bid, int nb) {
  char* As = smem + RG_AS; char* Bs = smem + RG_BS;
  const bf16_t* pr = (const bf16_t*)(p.ws + WS_PR);
  bf16_t* Sb = (bf16_t*)(p.ws + WS_S); bf16_t* Pfb = (bf16_t*)(p.ws + WS_PF); bf16_t* Pbb = (bf16_t*)(p.ws + WS_PB);
  float* agg = (float*)(p.ws + WS_AGG);
  const float* conv_w = p.in[9]; const float* conv_b = p.in[10];
  for (int it = 0, iters = (NRT * 10 + nb - 1) / nb; it < iters; ++it) {
    int u = bid + it * nb; const bool active = u < NRT * 10; if (!active) u = NRT * 10 - 1;
    const int tid = tidx();
    const int lane = tid & 63, wave = tid >> 6, fr = lane & 15, fq = lane >> 4, q4 = fr >> 2, p4 = lane & 3;
    const int hb = u % 10, tile = u / 10, r0 = tile * RGT, ch0 = hb * 128;
    const int seg_lo = tile < NRT_LAT ? 0 : NL, seg_hi = tile < NRT_LAT ? NL : T;
    __syncthreads();
    {
      const int cg8 = tid & 15, rg = tid >> 4, c = ch0 + 8 * cg8;
      float w[4][8], bias[8];
#pragma unroll
      for (int j = 0; j < 4; ++j) { const f32x4 a = *(const f32x4*)(conv_w + j * DR + c), b = *(const f32x4*)(conv_w + j * DR + c + 4);
        w[j][0] = a.x; w[j][1] = a.y; w[j][2] = a.z; w[j][3] = a.w; w[j][4] = b.x; w[j][5] = b.y; w[j][6] = b.z; w[j][7] = b.w; }
      { const f32x4 a = *(const f32x4*)(conv_b + c), b = *(const f32x4*)(conv_b + c + 4);
        bias[0] = a.x; bias[1] = a.y; bias[2] = a.z; bias[3] = a.w; bias[4] = b.x; bias[5] = b.y; bias[6] = b.z; bias[7] = b.w; }
      float win[4][8];
      auto ldrow = [&](int r, float (&dst)[8]) {
        if (r >= seg_lo && r < seg_hi) { const u32x4 v = *(const u32x4*)(pr + (size_t)r * DR + c);
          dst[0] = bflo(v.x); dst[1] = bfhi(v.x); dst[2] = bflo(v.y); dst[3] = bfhi(v.y); dst[4] = bflo(v.z); dst[5] = bfhi(v.z); dst[6] = bflo(v.w); dst[7] = bfhi(v.w); }
        else {
#pragma unroll
          for (int e = 0; e < 8; ++e) dst[e] = 0.f; }
      };
      const int rb = r0 + rg * 4;
      ldrow(rb - 2, win[0]); ldrow(rb - 1, win[1]); ldrow(rb, win[2]);
#pragma unroll
      for (int t = 0; t < 4; ++t) {
        ldrow(rb + t + 1, win[(t + 3) & 3]);
        float o[8];
#pragma unroll
        for (int e = 0; e < 8; ++e) o[e] = bias[e] + w[0][e] * win[t & 3][e] + w[1][e] * win[(t + 1) & 3][e] + w[2][e] * win[(t + 2) & 3][e] + w[3][e] * win[(t + 3) & 3][e];
        u32x4 ov; ov.x = pk2(o[0], o[1]); ov.y = pk2(o[2], o[3]); ov.z = pk2(o[4], o[5]); ov.w = pk2(o[6], o[7]);
        *(u32x4*)(As + (rg * 4 + t) * RG_AS_STRIDE + cg8 * 16) = ov;
      }
    }
    u32x2 hfk[RG_MT][2];
#pragma unroll
    for (int d = 0; d < 2; ++d) {
      f32x4 accA[RG_MT][2], accX[RG_MT][2];
#pragma unroll
      for (int which = 0; which < 2; ++which) {
        const float* W = (which ? p.in[13] : p.in[11]) + (size_t)(d * 10 + hb) * 16384;
        __syncthreads();
#pragma unroll 1
        for (int ib = 0; ib < 4; ++ib) {
#pragma unroll
          for (int ii = 0; ii < 4; ++ii) {
            const int f = tid + 256 * (ib * 4 + ii), k = f >> 5, n = 4 * (f & 31);
            const f32x4 v = *(const f32x4*)(W + k * 128 + n);
            u32x2 o; o.x = pk2(v.x, v.y); o.y = pk2(v.z, v.w);
            *(u32x2*)(Bs + bs_off(k, n)) = o;
          }
        }
        __syncthreads();
        f32x4 (&acc)[RG_MT][2] = which ? accX : accA;
#pragma unroll
        for (int m = 0; m < RG_MT; ++m) { acc[m][0] = (f32x4){0.f, 0.f, 0.f, 0.f}; acc[m][1] = (f32x4){0.f, 0.f, 0.f, 0.f}; }
#pragma unroll
        for (int ks = 0; ks < 4; ++ks) {
          bf16x8 b[2];
#pragma unroll
          for (int n = 0; n < 2; ++n) {
            const int ncol = wave * 32 + n * 16 + 4 * p4;
            const s16x4 lo = ldtr(Bs + bs_off(ks * 32 + fq * 8 + q4, ncol));
            const s16x4 hi = ldtr(Bs + bs_off(ks * 32 + fq * 8 + 4 + q4, ncol));
            b[n] = (bf16x8){lo.x, lo.y, lo.z, lo.w, hi.x, hi.y, hi.z, hi.w};
          }
#pragma unroll
          for (int m = 0; m < RG_MT; ++m) {
            const bf16x8 a = *(const bf16x8*)(As + (m * 16 + fr) * RG_AS_STRIDE + (ks * 32 + fq * 8) * 2);
            acc[m][0] = __builtin_amdgcn_mfma_f32_16x16x32_bf16(a, b[0], acc[m][0], 0, 0, 0);
            acc[m][1] = __builtin_amdgcn_mfma_f32_16x16x32_bf16(a, b[1], acc[m][1], 0, 0, 0);
          }
        }
      }
#pragma unroll
      for (int n = 0; n < 2; ++n) {
        const int cl = wave * 32 + n * 16 + fr, ch = ch0 + cl;
        const float ba = p.in[12][d * DR + ch], bx = p.in[14][d * DR + ch], lam = p.in[15][d * DR + ch];
        const float nl = -lam;
        const float sp = nl > 20.f ? nl : log1pf(__expf(nl));
        const float c8 = -8.f * sp;
#pragma unroll
        for (int m = 0; m < RG_MT; ++m)
#pragma unroll
          for (int j = 0; j < 4; ++j) {
            const int row = m * 16 + fq * 4 + j;
            const float r = sigmoidf_(accA[m][n][j] + ba), ig = sigmoidf_(accX[m][n][j] + bx);
            const float la = c8 * r;
            const float a = __expf(la);
            const float x2 = 2.f * la;
            const float om = x2 > -0.1f ? -x2 * (1.f + x2 * (0.5f + x2 * (0.16666667f + x2 * 0.041666668f))) : 1.f - a * a;
            const float mult = sqrtf(om);
            const float uu = bf2f(*(const bf16_t*)(As + row * RG_AS_STRIDE + cl * 2));
            accA[m][n][j] = a; accX[m][n][j] = mult * ig * uu;
            if (j == 3) __builtin_amdgcn_sched_barrier(0);
          }
      }
      float aggP[2], aggH[2];
      if (d == 0) rg_scan<false, 2>(accA, accX, aggP, aggH); else rg_scan<true, 2>(accA, accX, aggP, aggH);
      if (fq == 0) {
#pragma unroll
        for (int n = 0; n < 2; ++n) {
          const int ch = ch0 + wave * 32 + n * 16 + fr;
          float* ag = agg + ((size_t)(d * NRT + tile) * DR + ch) * 2;
          ag[0] = aggP[n]; ag[1] = aggH[n];
        }
      }
      bf16_t* Pout = d ? Pbb : Pfb;
#pragma unroll
      for (int m = 0; m < RG_MT; ++m)
#pragma unroll
        for (int n = 0; n < 2; ++n) {
          if (d == 0) { hfk[m][n].x = pk2(accX[m][n][0], accX[m][n][1]); hfk[m][n].y = pk2(accX[m][n][2], accX[m][n][3]); }
          else { accX[m][n][0] += bflo(hfk[m][n].x); accX[m][n][1] += bfhi(hfk[m][n].x); accX[m][n][2] += bflo(hfk[m][n].y); accX[m][n][3] += bfhi(hfk[m][n].y); }
#pragma unroll
          for (int j = 0; j < 4; ++j) {
            const unsigned o = (unsigned)(r0 + m * 16 + fq * 4 + j) * DR + ch0 + wave * 32 + n * 16 + fr;
            Pout[o] = f2bf(accA[m][n][j]);
            if (d == 1) Sb[o] = f2bf(accX[m][n][j]);
          }
          __builtin_amdgcn_sched_barrier(0);
        }
    }
  }
}

DEV void ph_rg_scan2(const Params& p, char* smem) {
  int tid = threadIdx.x; asm volatile("" : "+v"(tid));
  const int lane = tid & 63, wave = tid >> 6, fr = lane & 15, fq = lane >> 4;
  const bf16_t* pr = (const bf16_t*)(p.ws + WS_PR);
  bf16_t* Sb = (bf16_t*)(p.ws + WS_S); bf16_t* Pfb = (bf16_t*)(p.ws + WS_PF); bf16_t* Pbb = (bf16_t*)(p.ws + WS_PB);
  float* agg = (float*)(p.ws + WS_AGG);
  const bf16_t* WAX = (const bf16_t*)(p.ws + WS_WAXT);
  const float* conv_w = p.in[9]; const float* conv_b = p.in[10];
  const int NU = NRT * 10;
  const int u0 = (int)((long)blockIdx.x * NU / gridDim.x), u1 = (int)((long)(blockIdx.x + 1) * NU / gridDim.x);
  int cur_hb = -1;
  bf16x8 bfr[4][4];
  float cba[2], cbx[2], cc8[2];
#pragma unroll 1
  for (int u = u0; u < u1; ++u) {
    const int hb = u / NRT, tile = u - hb * NRT, r0 = tile * RGT, ch0 = hb * 128;
    const int seg_lo = tile < NRT_LAT ? 0 : NL, seg_hi = tile < NRT_LAT ? NL : T;
    char* As = smem + ((u - u0) & 1) * (RGT * RG_AS_STRIDE);
    if (hb != cur_hb) {
      cur_hb = hb;
#pragma unroll
      for (int mat = 0; mat < 4; ++mat)
#pragma unroll
        for (int ks = 0; ks < 4; ++ks)
          bfr[mat][ks] = *(const bf16x8*)(WAX + (size_t)(((mat >> 1) * 10 + hb) * 2 + (mat & 1)) * 16384 + (16 * wave + fr) * 128 + ks * 32 + fq * 8);
#pragma unroll
      for (int d = 0; d < 2; ++d) {
        const int ch = ch0 + 16 * wave + fr;
        cba[d] = p.in[12][d * DR + ch]; cbx[d] = p.in[14][d * DR + ch];
        const float nl = -p.in[15][d * DR + ch];
        cc8[d] = -8.f * (nl > 20.f ? nl : log1pf(__expf(nl)));
      }
    }
    {
      const int cg8 = tid & 15, rg = tid >> 4, c = ch0 + 8 * cg8;
      float w[4][8], bias[8];
#pragma unroll
      for (int j = 0; j < 4; ++j) { const f32x4 a = *(const f32x4*)(conv_w + j * DR + c), b = *(const f32x4*)(conv_w + j * DR + c + 4);
        w[j][0] = a.x; w[j][1] = a.y; w[j][2] = a.z; w[j][3] = a.w; w[j][4] = b.x; w[j][5] = b.y; w[j][6] = b.z; w[j][7] = b.w; }
      { const f32x4 a = *(const f32x4*)(conv_b + c), b = *(const f32x4*)(conv_b + c + 4);
        bias[0] = a.x; bias[1] = a.y; bias[2] = a.z; bias[3] = a.w; bias[4] = b.x; bias[5] = b.y; bias[6] = b.z; bias[7] = b.w; }
      float win[5][8];
      const int rb = r0 + rg * 2;
#pragma unroll
      for (int t = 0; t < 5; ++t) {
        const int r = rb - 2 + t;
        if (r >= seg_lo && r < seg_hi) { const u32x4 v = *(const u32x4*)(pr + (size_t)r * DR + c);
          win[t][0] = bflo(v.x); win[t][1] = bfhi(v.x); win[t][2] = bflo(v.y); win[t][3] = bfhi(v.y); win[t][4] = bflo(v.z); win[t][5] = bfhi(v.z); win[t][6] = bflo(v.w); win[t][7] = bfhi(v.w); }
        else {
#pragma unroll
          for (int e = 0; e < 8; ++e) win[t][e] = 0.f; }
      }
#pragma unroll
      for (int t = 0; t < 2; ++t) {
        float o[8];
#pragma unroll
        for (int e = 0; e < 8; ++e) o[e] = bias[e] + w[0][e] * win[t][e] + w[1][e] * win[t + 1][e] + w[2][e] * win[t + 2][e] + w[3][e] * win[t + 3][e];
        u32x4 ov; ov.x = pk2(o[0], o[1]); ov.y = pk2(o[2], o[3]); ov.z = pk2(o[4], o[5]); ov.w = pk2(o[6], o[7]);
        *(u32x4*)(As + (rg * 2 + t) * RG_AS_STRIDE + cg8 * 16) = ov;
      }
    }
    __syncthreads();
    f32x4 acc[4][RG_MT][1];
#pragma unroll
    for (int mat = 0; mat < 4; ++mat)
#pragma unroll
      for (int m = 0; m < RG_MT; ++m) acc[mat][m][0] = (f32x4){0.f, 0.f, 0.f, 0.f};
#pragma unroll
    for (int ks = 0; ks < 4; ++ks)
#pragma unroll
      for (int m = 0; m < RG_MT; ++m) {
        const bf16x8 a = *(const bf16x8*)(As + (m * 16 + fr) * RG_AS_STRIDE + (ks * 32 + fq * 8) * 2);
#pragma unroll
        for (int mat = 0; mat < 4; ++mat) acc[mat][m][0] = __builtin_amdgcn_mfma_f32_16x16x32_bf16(a, bfr[mat][ks], acc[mat][m][0], 0, 0, 0);
      }
    const int cl = 16 * wave + fr;
#pragma unroll
    for (int d = 0; d < 2; ++d) {
      f32x4 (&accA)[RG_MT][1] = acc[d * 2]; f32x4 (&accX)[RG_MT][1] = acc[d * 2 + 1];
#pragma unroll
      for (int m = 0; m < RG_MT; ++m) {
#pragma unroll
        for (int j = 0; j < 4; ++j) {
          const int row = m * 16 + fq * 4 + j;
          const float r = sigmoidf_(accA[m][0][j] + cba[d]), ig = sigmoidf_(accX[m][0][j] + cbx[d]);
          const float la = cc8[d] * r;
          const float a = fexp_(la);
          const float x2 = 2.f * la;
          const float om = x2 > -0.1f ? -x2 * (1.f + x2 * (0.5f + x2 * (0.16666667f + x2 * 0.041666668f))) : 1.f - a * a;
          const float uu = bf2f(*(const bf16_t*)(As + row * RG_AS_STRIDE + cl * 2));
          accA[m][0][j] = a; accX[m][0][j] = __builtin_amdgcn_sqrtf(om) * ig * uu;
        }
        __builtin_amdgcn_sched_barrier(0);
      }
      float aggP[1], aggH[1];
      if (d == 0) rg_scan<false, 1>(accA, accX, aggP, aggH); else rg_scan<true, 1>(accA, accX, aggP, aggH);
      if (fq == 0) { float* ag = agg + ((size_t)(d * NRT + tile) * DR + ch0 + cl) * 2; ag[0] = aggP[0]; ag[1] = aggH[0]; }
      bf16_t* Pout = d ? Pbb : Pfb;
#pragma unroll
      for (int m = 0; m < RG_MT; ++m) {
        if (d == 1) accX[m][0] += acc[1][m][0];
#pragma unroll
        for (int j = 0; j < 4; ++j) {
          const unsigned o = (unsigned)(r0 + m * 16 + fq * 4 + j) * DR + ch0 + cl;
          Pout[o] = f2bf(accA[m][0][j]);
          if (d == 1) Sb[o] = f2bf(accX[m][0][j]);
        }
      }
    }
  }
  __syncthreads();
}

DEV void ph_rg_carry(const Params& p, int bid, int nb) {
  const float* agg = (const float*)(p.ws + WS_AGG); float* carry = (float*)(p.ws + WS_CARRY);
  for (int i = bid * 256 + tidx(); i < 2 * DR; i += nb * 256) {
    const int d = i / DR, ch = i % DR;
    float st = 0.f;
#pragma unroll 1
    for (int sb = 0; sb < NRT; sb += 26) {
      float ap[26], ah[26];
#pragma unroll
      for (int j = 0; j < 26; ++j) {
        const int s = sb + j;
        const int tile = d == 0 ? (s < (NRT - NRT_LAT) ? NRT_LAT + s : s - (NRT - NRT_LAT)) : NRT - 1 - s;
        const float* ag = agg + ((size_t)(d * NRT + tile) * DR + ch) * 2;
        ap[j] = ag[0]; ah[j] = ag[1];
      }
#pragma unroll
      for (int j = 0; j < 26; ++j) {
        const int s = sb + j;
        const int tile = d == 0 ? (s < (NRT - NRT_LAT) ? NRT_LAT + s : s - (NRT - NRT_LAT)) : NRT - 1 - s;
        carry[(size_t)(d * NRT + tile) * DR + ch] = st;
        st = ap[j] * st + ah[j];
      }
    }
  }
}

DEV void ph_rg_final(const Params& p, int bid, int nb) {
  const bf16_t* gg = (const bf16_t*)(p.ws + WS_GG); const bf16_t* Sb = (const bf16_t*)(p.ws + WS_S);
  const bf16_t* Pfb = (const bf16_t*)(p.ws + WS_PF); const bf16_t* Pbb = (const bf16_t*)(p.ws + WS_PB);
  const float* carry = (const float*)(p.ws + WS_CARRY);
  bf16_t* y = (bf16_t*)(p.ws + WS_PR);
  const int total = T * (DR / 8);
  for (int i = bid * 256 + tidx(); i < total; i += nb * 256) {
    const int r = i / 160, c = (i % 160) * 8, tile = r / RGT;
    const size_t o = (size_t)r * DR + c;
    const u32x4 g = *(const u32x4*)(gg + o), s = *(const u32x4*)(Sb + o), pf = *(const u32x4*)(Pfb + o), pb = *(const u32x4*)(Pbb + o);
    const float* cf = carry + (size_t)tile * DR + c; const float* cb = carry + (size_t)(NRT + tile) * DR + c;
    const f32x4 cf0 = *(const f32x4*)cf, cf1 = *(const f32x4*)(cf + 4), cb0 = *(const f32x4*)cb, cb1 = *(const f32x4*)(cb + 4);
    u32x4 o4;
    o4.x = pk2(bflo(g.x) * (bflo(s.x) + bflo(pf.x) * cf0.x + bflo(pb.x) * cb0.x), bfhi(g.x) * (bfhi(s.x) + bfhi(pf.x) * cf0.y + bfhi(pb.x) * cb0.y));
    o4.y = pk2(bflo(g.y) * (bflo(s.y) + bflo(pf.y) * cf0.z + bflo(pb.y) * cb0.z), bfhi(g.y) * (bfhi(s.y) + bfhi(pf.y) * cf0.w + bfhi(pb.y) * cb0.w));
    o4.z = pk2(bflo(g.z) * (bflo(s.z) + bflo(pf.z) * cf1.x + bflo(pb.z) * cb1.x), bfhi(g.z) * (bfhi(s.z) + bfhi(pf.z) * cf1.y + bfhi(pb.z) * cb1.y));
    o4.w = pk2(bflo(g.w) * (bflo(s.w) + bflo(pf.w) * cf1.z + bflo(pb.w) * cb1.z), bfhi(g.w) * (bfhi(s.w) + bfhi(pf.w) * cf1.w + bfhi(pb.w) * cb1.w));
    *(u32x4*)(y + o) = o4;
  }
}

using pg8::Unit;
struct EpiRgIn {
  static constexpr bool PERM = true, AFTER_DRAIN = false;
  bf16_t* gg; bf16_t* pr;
  DEV void operator()(const f32x4 (&acc)[2][2][4][2], const Unit& u, int wr, int wc, int fr, int fq) const {
    const int row0 = u.pm * 256 + wr * 64 + fr, c0 = u.pn * 256 + wc * 32 + 8 * fq;
    const bool gate = u.pn < 5;
#pragma unroll
    for (int ai = 0; ai < 2; ++ai)
#pragma unroll
      for (int m = 0; m < 4; ++m) {
        const unsigned row = row0 + ai * 128 + m * 16;
#pragma unroll
        for (int bj = 0; bj < 2; ++bj) {
          f32x4 v0 = acc[ai][bj][m][0], v1 = acc[ai][bj][m][1];
          const int col = c0 + bj * 128;
          if (gate) {
#pragma unroll
            for (int j = 0; j < 4; ++j) { v0[j] = gelu_tanh(v0[j]); v1[j] = gelu_tanh(v1[j]); }
          }
          u32x4 w; w.x = pk2(v0[0], v0[1]); w.y = pk2(v0[2], v0[3]); w.z = pk2(v1[0], v1[1]); w.w = pk2(v1[2], v1[3]);
          if (gate) *(u32x4*)(gg + row * DR + col) = w; else *(u32x4*)(pr + row * DR + col - DR) = w;
        }
      }
  }
};
template <int LAYER> struct EpiOut {
  static constexpr bool PERM = false, AFTER_DRAIN = false;
  const float* x; const float* ctx; const float* x2; const float* mods; float* x1;
  DEV void operator()(const f32x4 (&acc)[2][2][4][2], const Unit& u, int wr, int wc, int fr, int fq) const {
    const int row0 = u.pm * 256 + wr * 64 + fr, c0 = u.pn * 256 + wc * 32 + 4 * fq;
#pragma unroll
    for (int ai = 0; ai < 2; ++ai)
#pragma unroll
      for (int m = 0; m < 4; ++m) {
        const int row = row0 + ai * 128 + m * 16;
        const int trow = LAYER == 0 ? row : token_of_seqrow(row);
        const float* xin = LAYER == 0 ? (row < NL ? x + (size_t)row * D : ctx + (size_t)(row - NL) * D) : x2 + (size_t)trow * D;
        const float* gt = mods + ((LAYER == 0 && row >= NL) ? 6144 : 0) + 2048;
        float* xo = x1 + (size_t)trow * D;
#pragma unroll
        for (int bj = 0; bj < 2; ++bj)
#pragma unroll
          for (int n = 0; n < 2; ++n) {
            const int col = c0 + bj * 128 + n * 16;
            *(f32x4*)(xo + col) = *(const f32x4*)(xin + col) + *(const f32x4*)(gt + col) * acc[ai][bj][m][n];
          }
      }
  }
};
struct EpiMoe1 {
  static constexpr bool PERM = true, AFTER_DRAIN = false;
  bf16_t* Hm;
  DEV void operator()(const f32x4 (&acc)[2][2][4][2], const Unit& u, int wr, int wc, int fr, int fq) const {
    const int row0 = u.pm * 256 + wr * 64 + fr, c0 = (u.pn & 3) * 128 + wc * 32 + 8 * fq;
#pragma unroll
    for (int ai = 0; ai < 2; ++ai)
#pragma unroll
      for (int m = 0; m < 4; ++m) {
        const unsigned row = row0 + ai * 128 + m * 16;
        float h[8];
#pragma unroll
        for (int n = 0; n < 2; ++n)
#pragma unroll
          for (int j = 0; j < 4; ++j) h[n * 4 + j] = siluf_(acc[ai][0][m][n][j]) * acc[ai][1][m][n][j];
        u32x4 w; w.x = pk2(h[0], h[1]); w.y = pk2(h[2], h[3]); w.z = pk2(h[4], h[5]); w.w = pk2(h[6], h[7]);
        *(u32x4*)(Hm + row * DE + c0) = w;
      }
  }
};
struct EpiMoe2 {
  static constexpr bool PERM = true, AFTER_DRAIN = false;
  bf16_t* Y; const float* awp;
  DEV void operator()(const f32x4 (&acc)[2][2][4][2], const Unit& u, int wr, int wc, int fr, int fq) const {
    const int row0 = u.pm * 256 + wr * 64 + fr, c0 = (u.pn & 3) * 256 + wc * 32 + 8 * fq;
#pragma unroll
    for (int ai = 0; ai < 2; ++ai)
#pragma unroll
      for (int m = 0; m < 4; ++m) {
        const unsigned row = row0 + ai * 128 + m * 16;
        const float w8 = awp[row];
#pragma unroll
        for (int bj = 0; bj < 2; ++bj) {
          const f32x4 v0 = acc[ai][bj][m][0] * w8, v1 = acc[ai][bj][m][1] * w8;
          u32x4 w; w.x = pk2(v0[0], v0[1]); w.y = pk2(v0[2], v0[3]); w.z = pk2(v1[0], v1[1]); w.w = pk2(v1[2], v1[3]);
          *(u32x4*)(Y + row * D + c0 + bj * 128) = w;
        }
      }
  }
};
struct EpiMlIn {
  static constexpr bool PERM = false, AFTER_DRAIN = false;
  bf16_t* qb; bf16_t* kb; bf16_t* kT; bf16_t* vT; bf16_t* og; float* gl; const float* bgt;
  DEV void operator()(const f32x4 (&acc)[2][2][4][2], const Unit& u, int wr, int wc, int fr, int fq) const {
    const unsigned row0 = u.pm * 256 + wr * 64 + fr, c0 = u.pn * 256 + wc * 32 + 4 * fq;
    const int pn = u.pn;
#define MLIN_LOOP(BODY) _Pragma("unroll") for (int ai = 0; ai < 2; ++ai) _Pragma("unroll") for (int m = 0; m < 4; ++m) { const unsigned row = row0 + ai * 128 + m * 16; \
      _Pragma("unroll") for (int bj = 0; bj < 2; ++bj) _Pragma("unroll") for (int n = 0; n < 2; ++n) { const f32x4 v = acc[ai][bj][m][n]; const unsigned col = c0 + bj * 128 + n * 16; BODY } }
    if (pn < 2) {
      MLIN_LOOP({ u32x2 o; o.x = pk2(v[0] * 0.125f, v[1] * 0.125f); o.y = pk2(v[2] * 0.125f, v[3] * 0.125f); *(u32x2*)(qb + row * 512 + col) = o; })
    } else if (pn < 4) {
      MLIN_LOOP({ u32x2 o; o.x = pk2(v[0], v[1]); o.y = pk2(v[2], v[3]); *(u32x2*)(kb + row * 512 + col - 512) = o;
        bf16_t* kp = kT + (col - 512) * T + row;
        kp[0] = (bf16_t)(o.x & 0xffffu); kp[T] = (bf16_t)(o.x >> 16); kp[2 * T] = (bf16_t)(o.y & 0xffffu); kp[3 * T] = (bf16_t)(o.y >> 16); })
    } else if (pn < 8) {
      MLIN_LOOP({ u32x2 o; o.x = pk2(v[0], v[1]); o.y = pk2(v[2], v[3]);
        bf16_t* vp = vT + (col - 1024) * T + row;
        vp[0] = (bf16_t)(o.x & 0xffffu); vp[T] = (bf16_t)(o.x >> 16); vp[2 * T] = (bf16_t)(o.y & 0xffffu); vp[3 * T] = (bf16_t)(o.y >> 16); })
    } else if (pn < 12) {
      MLIN_LOOP({ u32x2 o; o.x = pk2(sigmoidf_(v[0]), sigmoidf_(v[1])); o.y = pk2(sigmoidf_(v[2]), sigmoidf_(v[3])); *(u32x2*)(og + row * D + col - 2048) = o; })
    } else if (wc == 0) {
#pragma unroll
      for (int ai = 0; ai < 2; ++ai)
#pragma unroll
        for (int m = 0; m < 4; ++m) {
          const unsigned row = row0 + ai * 128 + m * 16;
#pragma unroll
          for (int n = 0; n < 2; ++n) {
            const int jj = 16 * n + 4 * fq;
            f32x4 g = acc[ai][0][m][n] + *(const f32x4*)(bgt + jj);
            if ((jj >> 3) & 1) {
#pragma unroll
              for (int j = 0; j < 4; ++j) g[j] = fminf(g[j], 0.f) - log1pf(__expf(-fabsf(g[j])));
            }
            *(f32x4*)(gl + row * 32 + jj) = g;
          }
        }
    }
#undef MLIN_LOOP
  }
};

struct MoeOrder {
  const int* tb; int ntn, G, c;
  DEV bool next(int i, Unit& u) const {
    const int L = i * G + c; if (L >= tb[32]) return false;
    int e = 0;
#pragma unroll 1
    for (int k = 1; k < 32; ++k) e = (L >= tb[k]) ? k : e;
    const int r = L - tb[e], mt = (tb[e + 1] - tb[e]) / ntn;
    u.pm = tb[33 + e] + r % mt; u.pn = e * ntn + r / mt; return true;
  }
  DEV void a_ready(const Unit&) const {}
  DEV void done(const Unit&) const {}
};
constexpr int LDS_TB = 131072;
DEV void moe_tables(const int* cnt, char* smem, int ntn) {
  int* tb = (int*)(smem + LDS_TB);
  if (threadIdx.x == 0) {
    int ub = 0, rb = 0;
    for (int e = 0; e < 32; ++e) { const int m = (cnt[e] + 255) >> 8; tb[e] = ub; tb[33 + e] = rb; ub += m * ntn; rb += m; }
    tb[32] = ub; tb[65] = rb;
  }
  __syncthreads();
}

template <int WHICH>
DEV void ph_gemm_dense(const Params& p, char* smem) {
  pg8::StaticOrder S;
  LAS unsigned char* lds = (LAS unsigned char*)smem;
  if constexpr (WHICH == 0) {
    S.init(T, 2560, gridDim.x, blockIdx.x);
    EpiRgIn E{(bf16_t*)(p.ws + WS_GG), (bf16_t*)(p.ws + WS_PR)};
    pg8::gemm_phase<EpiRgIn, pg8::StaticOrder>(lds, pg8::Gemm{(const bf16_t*)(p.ws + WS_HA), (const bf16_t*)(p.ws + WS_WIN), T, 2560, 1024}, S, E, nullptr);
  } else if constexpr (WHICH == 1) {
    S.init(T, 1024, gridDim.x, blockIdx.x);
    EpiOut<0> E{p.in[0], p.in[2], nullptr, (const float*)(p.ws + WS_MODS), (float*)(p.ws + WS_X1)};
    pg8::gemm_phase<EpiOut<0>, pg8::StaticOrder>(lds, pg8::Gemm{(const bf16_t*)(p.ws + WS_PR), (const bf16_t*)(p.ws + WS_WOUT), T, 1024, 1280}, S, E, nullptr);
  } else if constexpr (WHICH == 2) {
    S.init(T, MLWP, gridDim.x, blockIdx.x);
    EpiMlIn E{(bf16_t*)(p.ws + WS_Q), (bf16_t*)(p.ws + WS_K), (bf16_t*)(p.ws + WS_KT), (bf16_t*)(p.ws + WS_VT), (bf16_t*)(p.ws + WS_OG), (float*)(p.ws + WS_GL), p.in[29]};
    pg8::gemm_phase<EpiMlIn, pg8::StaticOrder>(lds, pg8::Gemm{(const bf16_t*)(p.ws + WS_HA), (const bf16_t*)(p.ws + WS_WML), T, MLWP, 1024}, S, E, nullptr);
  } else {
    S.init(NL, 1024, gridDim.x, blockIdx.x);
    EpiOut<1> E{nullptr, nullptr, (const float*)(p.ws + WS_X2), (const float*)(p.ws + WS_MODS) + 2 * 6144, (float*)(p.ws + WS_X1)};
    pg8::gemm_phase<EpiOut<1>, pg8::StaticOrder>(lds, pg8::Gemm{(const bf16_t*)(p.ws + WS_HA), (const bf16_t*)(p.ws + WS_WMO), NL, 1024, 1024}, S, E, nullptr);
  }
}
template <int LAYER, int STAGE>
DEV void ph_gemm_moe(const Params& p, char* smem) {
  const int* cnt = (const int*)(p.ws + WS_CNT) + LAYER * 32;
  moe_tables(cnt, smem, 4);
  MoeOrder S{(const int*)(smem + LDS_TB), 4, (int)gridDim.x, (int)blockIdx.x};
  LAS unsigned char* lds = (LAS unsigned char*)smem;
  if constexpr (STAGE == 0) {
    EpiMoe1 E{(bf16_t*)(p.ws + WS_HM)};
    pg8::gemm_phase<EpiMoe1, MoeOrder>(lds, pg8::Gemm{(const bf16_t*)(p.ws + WS_ABUF), (const bf16_t*)(p.ws + WS_WGU), MOE_ROWS, 32 * 1024, 1024}, S, E, nullptr);
  } else {
    EpiMoe2 E{(bf16_t*)(p.ws + WS_Y), (const float*)(p.ws + WS_AWP)};
    pg8::gemm_phase<EpiMoe2, MoeOrder>(lds, pg8::Gemm{(const bf16_t*)(p.ws + WS_HM), (const bf16_t*)(p.ws + WS_WD), MOE_ROWS, 32 * 1024, 512}, S, E, nullptr);
  }
}

template <int LAYER>
DEV void ph_scatter(const Params& p, char* smem, int bid, int nb) {
  const int tid = tidx(), lane = tid & 63, wave = tid >> 6;
  constexpr int NTOK = LAYER == 0 ? T : NL;
  const int* cnt = (const int*)(p.ws + WS_CNT) + LAYER * 32;
  const int* list = (const int*)(p.ws + WS_LIST) + (size_t)LAYER * 32 * T;
  const float* aw = (const float*)(p.ws + WS_AW);
  int* pos = (int*)(p.ws + WS_POS); float* awp = (float*)(p.ws + WS_AWP);
  const bf16_t* hA = (const bf16_t*)(p.ws + WS_HA); bf16_t* Ab = (bf16_t*)(p.ws + WS_ABUF);
  int* base = (int*)smem; int* off = base + 40;
  if (tid == 0) { int b = 0, o = 0; for (int e = 0; e < 32; ++e) { base[e] = b; off[e] = o; b += cnt[e]; o += ((cnt[e] + 255) >> 8) << 8; } base[32] = b; }
  __syncthreads();
  for (int a = bid * 4 + wave; a < 2 * NTOK; a += nb * 4) {
    int e = 0;
#pragma unroll 1
    for (int k = 1; k < 32; ++k) e = (a >= base[k]) ? k : e;
    const int i = a - base[e], ent = list[(size_t)e * T + i], dst = off[e] + i;
    const u32x4* src = (const u32x4*)(hA + (size_t)(ent >> 1) * D); u32x4* d = (u32x4*)(Ab + (size_t)dst * D);
    const u32x4 v0 = src[lane], v1 = src[lane + 64];
    d[lane] = v0; d[lane + 64] = v1;
    if (lane == 0) { pos[ent] = dst; awp[dst] = aw[ent]; }
  }
  __syncthreads();
}

constexpr int RT_STRIDE = 1028;
constexpr int RT_H2 = 0, RT_RED = 16 * RT_STRIDE * 4, RT_SMEM = RT_RED + 4 * 16 * 48 * 4;
template <int LAYER, bool DRY = false>
DEV void ph_router(const Params& p, char* smem, int bid, int nb) {
  const int tid = tidx(), lane = tid & 63, wave = tid >> 6;
  constexpr int NTOK = LAYER == 0 ? T : NL;
  const float* mods = (const float*)(p.ws + WS_MODS) + LAYER * 2 * 6144;
  const float* x1 = (const float*)(p.ws + WS_X1);
  bf16_t* hA = (bf16_t*)(p.ws + WS_HA);
  const float* g2 = p.in[LAYER == 0 ? 7 : 27];
  const float* Wg = p.in[LAYER == 0 ? 17 : 32]; const float* Bg = p.in[LAYER == 0 ? 18 : 33];
  const float* We = p.in[LAYER == 0 ? 19 : 34]; const float* Be = p.in[LAYER == 0 ? 20 : 35];
  int* cnt = (int*)(p.ws + WS_CNT) + LAYER * 32;
  int* list = (int*)(p.ws + WS_LIST) + (size_t)LAYER * 32 * T;
  float* aw = (float*)(p.ws + WS_AW);
  float* h2s = (float*)(smem + RT_H2); float* red = (float*)(smem + RT_RED);
  for (int it = 0, iters = ((NTOK / 16) + nb - 1) / nb; it < iters; ++it) {
    int u = bid + it * nb; const bool active = u < (NTOK / 16); if (!active) u = (NTOK / 16) - 1;
    const int t0 = u * 16;
    __syncthreads();
#pragma unroll
    for (int rr = 0; rr < 4; ++rr) {
      const int lr = wave * 4 + rr, t = t0 + lr;
      const float* md = mods + ((LAYER == 0 && t >= NL) ? 6144 : 0);
      const float* src = x1 + (size_t)t * D;
      f32x4 v[4]; float ss = 0.f;
#pragma unroll
      for (int i = 0; i < 4; ++i) { v[i] = *(const f32x4*)(src + 4 * lane + 256 * i); ss += v[i].x * v[i].x + v[i].y * v[i].y + v[i].z * v[i].z + v[i].w * v[i].w; }
      const float rstd = rsqrtf(wave_sum(ss) * (1.f / D) + EPS);
#pragma unroll
      for (int i = 0; i < 4; ++i) {
        const int c = 4 * lane + 256 * i;
        const f32x4 g = *(const f32x4*)(g2 + c), sh = *(const f32x4*)(md + 3072 + c), sc = *(const f32x4*)(md + 4096 + c);
        const f32x4 h = v[i] * rstd * g * (1.f + sc) + sh;
        *(f32x4*)(h2s + lr * RT_STRIDE + c) = h;
        u32x2 o; o.x = pk2(h.x, h.y); o.y = pk2(h.z, h.w);
        *(u32x2*)(hA + (size_t)t * D + c) = o;
      }
    }
    __syncthreads();
    {
      f32x4 a0 = {0.f, 0.f, 0.f, 0.f}, a1 = a0, a2 = a0;
      const int tok = lane & 15, kk = lane >> 4;
#pragma unroll 4
      for (int s = 0; s < 64; ++s) {
        const int k = wave * 256 + s * 4 + kk;
        const float a = h2s[tok * RT_STRIDE + k];
        const float b0 = We[k * 32 + tok], b1 = We[k * 32 + 16 + tok];
        const float b2 = tok < 4 ? Wg[k * 4 + tok] : 0.f;
        a0 = __builtin_amdgcn_mfma_f32_16x16x4f32(a, b0, a0, 0, 0, 0);
        a1 = __builtin_amdgcn_mfma_f32_16x16x4f32(a, b1, a1, 0, 0, 0);
        a2 = __builtin_amdgcn_mfma_f32_16x16x4f32(a, b2, a2, 0, 0, 0);
      }
#pragma unroll
      for (int j = 0; j < 4; ++j) {
        float* rp = red + ((wave * 16) + kk * 4 + j) * 48;
        rp[tok] = a0[j]; rp[16 + tok] = a1[j]; rp[32 + tok] = a2[j];
      }
    }
    __syncthreads();
    if (!DRY && active && tid < 16) {
      const int t = t0 + tid;
      auto lg = [&](int c) { return red[(0 * 16 + tid) * 48 + c] + red[(1 * 16 + tid) * 48 + c] + red[(2 * 16 + tid) * 48 + c] + red[(3 * 16 + tid) * 48 + c]; };
      float gl[4];
#pragma unroll
      for (int i = 0; i < 4; ++i) gl[i] = lg(32 + i) + Bg[i];
      int grp = 0; float gm = gl[0];
#pragma unroll
      for (int i = 1; i < 4; ++i) if (gl[i] > gm) { gm = gl[i]; grp = i; }
      float den = 0.f;
#pragma unroll
      for (int i = 0; i < 4; ++i) den += __expf(gl[i] - gm);
      const float psel = 1.f / den;
      float v0 = -INFINITY, v1 = -INFINITY; int i0 = 0, i1 = 0;
      for (int i = 0; i < 8; ++i) {
        const float v = lg(grp * 8 + i) + Be[grp * 8 + i];
        if (v > v0) { v1 = v0; i1 = i0; v0 = v; i0 = i; }
        else if (v > v1) { v1 = v; i1 = i; }
      }
      const float e1 = __expf(v1 - v0);
      const float w0 = psel / (1.f + e1), w1 = psel * e1 / (1.f + e1);
      const int ea = grp * 8 + i0, eb = grp * 8 + i1;
      const int pa = atomicAdd(&cnt[ea], 1); list[(size_t)ea * T + pa] = 2 * t;
      const int pb = atomicAdd(&cnt[eb], 1); list[(size_t)eb * T + pb] = 2 * t + 1;
      aw[2 * t] = w0; aw[2 * t + 1] = w1;
    }
  }
}

DEV void ph_combine0(const Params& p, int bid, int nb) {
  const int lane = tidx() & 63, wave = tidx() >> 6;
  const float* mods0 = (const float*)(p.ws + WS_MODS); const float* mods1 = mods0 + 2 * 6144;
  const float* x1 = (const float*)(p.ws + WS_X1); float* x2 = (float*)(p.ws + WS_X2);
  const bf16_t* Y = (const bf16_t*)(p.ws + WS_Y); const int* pos = (const int*)(p.ws + WS_POS);
  bf16_t* hA = (bf16_t*)(p.ws + WS_HA);
  const float* g1 = p.in[26];
  for (int t = bid * 4 + wave; t < T; t += nb * 4) {
    const float* m0 = mods0 + (t < NL ? 0 : 6144); const float* m1 = mods1 + (t < NL ? 0 : 6144);
    const int orow = t < NL ? seqrow_of_token(t) : t;
    const bf16_t* Ya = Y + (size_t)pos[2 * t] * D; const bf16_t* Yb = Y + (size_t)pos[2 * t + 1] * D;
    f32x4 v[4]; float ss = 0.f;
#pragma unroll
    for (int i = 0; i < 4; ++i) {
      const int c = 4 * lane + 256 * i;
      const f32x4 xv = *(const f32x4*)(x1 + (size_t)t * D + c), gt = *(const f32x4*)(m0 + 5120 + c);
      const u32x2 ya = *(const u32x2*)(Ya + c), yb = *(const u32x2*)(Yb + c);
      f32x4 f; f.x = bflo(ya.x) + bflo(yb.x); f.y = bfhi(ya.x) + bfhi(yb.x); f.z = bflo(ya.y) + bflo(yb.y); f.w = bfhi(ya.y) + bfhi(yb.y);
      v[i] = xv + gt * f;
      *(f32x4*)(x2 + (size_t)t * D + c) = v[i];
      ss += v[i].x * v[i].x + v[i].y * v[i].y + v[i].z * v[i].z + v[i].w * v[i].w;
    }
    const float rstd = rsqrtf(wave_sum(ss) * (1.f / D) + EPS);
#pragma unroll
    for (int i = 0; i < 4; ++i) {
      const int c = 4 * lane + 256 * i;
      const f32x4 g = *(const f32x4*)(g1 + c), sh = *(const f32x4*)(m1 + c), sc = *(const f32x4*)(m1 + 1024 + c);
      const f32x4 h = v[i] * rstd * g * (1.f + sc) + sh;
      u32x2 o; o.x = pk2(h.x, h.y); o.y = pk2(h.z, h.w);
      *(u32x2*)(hA + (size_t)orow * D + c) = o;
    }
  }
}

DEV void ml_gate_scans(const float* gl, int r0, int h, float* li_f, float* cf, float* li_b, float* cb) {
  const int tid = tidx(), lane = tid & 63, wave = tid >> 6;
  if (tid < 128) { li_f[tid] = gl[(size_t)(r0 + tid) * 32 + h]; li_b[tid] = gl[(size_t)(r0 + tid) * 32 + 16 + h]; }
  if (wave == 0) {
    const float v0 = gl[(size_t)(r0 + 2 * lane) * 32 + 8 + h], v1 = gl[(size_t)(r0 + 2 * lane + 1) * 32 + 8 + h];
    const float s = v0 + v1; float inc = s;
#pragma unroll
    for (int o = 1; o < 64; o <<= 1) { const float t = __shfl_up(inc, o); if (lane >= o) inc += t; }
    const float ex = inc - s;
    cf[2 * lane] = ex + v0; cf[2 * lane + 1] = ex + s;
  } else if (wave == 1) {
    const float v0 = gl[(size_t)(r0 + 127 - 2 * lane) * 32 + 24 + h], v1 = gl[(size_t)(r0 + 126 - 2 * lane) * 32 + 24 + h];
    const float s = v0 + v1; float inc = s;
#pragma unroll
    for (int o = 1; o < 64; o <<= 1) { const float t = __shfl_up(inc, o); if (lane >= o) inc += t; }
    const float ex = inc - s;
    cb[127 - 2 * lane] = ex + v0; cb[126 - 2 * lane] = ex + s;
  }
}

constexpr int MLA_STRIDE = 272;
constexpr int MLA_AW = 0, MLA_BV = 2 * 64 * MLA_STRIDE, MLA_G = MLA_BV + 128 * MLA_STRIDE, MLA_SMEM = MLA_G + 6 * 128 * 4;
DEV void ph_ml_state(const Params& p, char* smem, int bid, int nb) {
  const int tid = tidx(), lane = tid & 63, wave = tid >> 6, fr = lane & 15, fq = lane >> 4;
  const float* gl = (const float*)(p.ws + WS_GL);
  const bf16_t* kT = (const bf16_t*)(p.ws + WS_KT); const bf16_t* vT = (const bf16_t*)(p.ws + WS_VT);
  float* UT = (float*)(p.ws + WS_UT); float* nvec = (float*)(p.ws + WS_NVEC); float* dec = (float*)(p.ws + WS_DEC);
  char* Aw = smem + MLA_AW; char* Bv = smem + MLA_BV;
  float* li_f = (float*)(smem + MLA_G); float* cf = li_f + 128; float* li_b = cf + 128; float* cb = li_b + 128; float* wf = cb + 128; float* wb = wf + 128;
  for (int it = 0, iters = (NTILE * 8 + nb - 1) / nb; it < iters; ++it) {
    int u = bid + it * nb; const bool active = u < NTILE * 8; if (!active) u = NTILE * 8 - 1;
    const int h = u % 8, c = u / 8, r0 = c * 128;
    __syncthreads();
    ml_gate_scans(gl, r0, h, li_f, cf, li_b, cb);
    __syncthreads();
    if (tid < 128) { wf[tid] = __expf(cf[127] - cf[tid] + li_f[tid]); wb[tid] = __expf(cb[0] - cb[tid] + li_b[tid]); }
    if (tid == 0) { dec[(c * 8 + h) * 2] = __expf(cf[127]); dec[(c * 8 + h) * 2 + 1] = __expf(cb[0]); }
#pragma unroll
    for (int i = 0; i < 8; ++i) {
      const int f = tid + 256 * i, e = f >> 4, pc = f & 15;
      *(u32x4*)(Bv + e * MLA_STRIDE + pc * 16) = *(const u32x4*)(vT + (size_t)(h * 128 + e) * T + r0 + pc * 8);
    }
    __syncthreads();
#pragma unroll
    for (int i = 0; i < 4; ++i) {
      const int f = tid + 256 * i, d = f >> 4, pc = f & 15;
      const u32x4 kv = *(const u32x4*)(kT + (size_t)(h * 64 + d) * T + r0 + pc * 8);
      float k8[8] = {bflo(kv.x), bfhi(kv.x), bflo(kv.y), bfhi(kv.y), bflo(kv.z), bfhi(kv.z), bflo(kv.w), bfhi(kv.w)};
      u32x4 of, ob;
      of.x = pk2(k8[0] * wf[pc * 8 + 0], k8[1] * wf[pc * 8 + 1]); of.y = pk2(k8[2] * wf[pc * 8 + 2], k8[3] * wf[pc * 8 + 3]);
      of.z = pk2(k8[4] * wf[pc * 8 + 4], k8[5] * wf[pc * 8 + 5]); of.w = pk2(k8[6] * wf[pc * 8 + 6], k8[7] * wf[pc * 8 + 7]);
      ob.x = pk2(k8[0] * wb[pc * 8 + 0], k8[1] * wb[pc * 8 + 1]); ob.y = pk2(k8[2] * wb[pc * 8 + 2], k8[3] * wb[pc * 8 + 3]);
      ob.z = pk2(k8[4] * wb[pc * 8 + 4], k8[5] * wb[pc * 8 + 5]); ob.w = pk2(k8[6] * wb[pc * 8 + 6], k8[7] * wb[pc * 8 + 7]);
      *(u32x4*)(Aw + d * MLA_STRIDE + pc * 16) = of;
      *(u32x4*)(Aw + (64 + d) * MLA_STRIDE + pc * 16) = ob;
    }
    __syncthreads();
    if (tid < 128) {
      float s = 0.f;
      for (int pc = 0; pc < 16; ++pc) { const u32x4 v = *(const u32x4*)(Aw + tid * MLA_STRIDE + pc * 16);
        s += (bflo(v.x) + bfhi(v.x)) + (bflo(v.y) + bfhi(v.y)) + (bflo(v.z) + bfhi(v.z)) + (bflo(v.w) + bfhi(v.w)); }
      nvec[(size_t)((c * 8 + h) * 2 + (tid >> 6)) * 64 + (tid & 63)] = s;
    }
#pragma unroll
    for (int dir = 0; dir < 2; ++dir) {
      f32x4 acc[4][2];
#pragma unroll
      for (int m = 0; m < 4; ++m) { acc[m][0] = (f32x4){0.f, 0.f, 0.f, 0.f}; acc[m][1] = (f32x4){0.f, 0.f, 0.f, 0.f}; }
#pragma unroll
      for (int ks = 0; ks < 4; ++ks) {
        bf16x8 b[2];
#pragma unroll
        for (int n = 0; n < 2; ++n) b[n] = *(const bf16x8*)(Bv + (wave * 32 + n * 16 + fr) * MLA_STRIDE + (ks * 32 + fq * 8) * 2);
#pragma unroll
        for (int m = 0; m < 4; ++m) {
          const bf16x8 a = *(const bf16x8*)(Aw + (dir * 64 + m * 16 + fr) * MLA_STRIDE + (ks * 32 + fq * 8) * 2);
          acc[m][0] = __builtin_amdgcn_mfma_f32_16x16x32_bf16(a, b[0], acc[m][0], 0, 0, 0);
          acc[m][1] = __builtin_amdgcn_mfma_f32_16x16x32_bf16(a, b[1], acc[m][1], 0, 0, 0);
        }
      }
      float* Uo = UT + (size_t)((c * 8 + h) * 2 + dir) * 8192;
#pragma unroll
      for (int m = 0; m < 4; ++m)
#pragma unroll
        for (int n = 0; n < 2; ++n) *(f32x4*)(Uo + (wave * 32 + n * 16 + fr) * 64 + m * 16 + fq * 4) = acc[m][n];
    }
  }
}

DEV void ph_ml_chain(const Params& p, int bid, int nb) {
  float* UT = (float*)(p.ws + WS_UT); float* nvec = (float*)(p.ws + WS_NVEC); const float* dec = (const float*)(p.ws + WS_DEC);
  const int total = 16 * (8192 + 64);
  for (int i = bid * 256 + tidx(); i < total; i += nb * 256) {
    const int hd = i / 8256, idx = i % 8256;
    const int dir = hd & 1;
    float* base = idx < 8192 ? UT + (size_t)hd * 8192 + idx : nvec + (size_t)hd * 64 + (idx - 8192);
    const size_t cstride = idx < 8192 ? (size_t)16 * 8192 : (size_t)16 * 64;
    float st = 0.f;
#pragma unroll 1
    for (int sb = 0; sb < NTILE; sb += 13) {
      float uv[13], dc[13];
#pragma unroll
      for (int j = 0; j < 13; ++j) {
        const int s = sb + j; const int c = dir == 0 ? (s < 2 ? 128 + s : s - 2) : 129 - s;
        uv[j] = base[(size_t)c * cstride]; dc[j] = dec[c * 16 + hd];
      }
#pragma unroll
      for (int j = 0; j < 13; ++j) {
        const int s = sb + j; const int c = dir == 0 ? (s < 2 ? 128 + s : s - 2) : 129 - s;
        base[(size_t)c * cstride] = st;
        st = dc[j] * st + uv[j];
      }
    }
  }
}

constexpr int MLC_QS = 0;
constexpr int MLC_KS = 9216;
constexpr int MLC_Q2 = MLC_KS + 18432;
constexpr int MLC_BS = MLC_Q2 + 17408;
constexpr int MLC_G  = MLC_BS + 18432;
constexpr int MLC_SMEM = MLC_G + (4 * 128 + 6 * 64) * 4;
DEV void ph_ml_out(const Params& p, char* smem, int bid, int nb) {
  const int tid = tidx(), lane = tid & 63, wave = tid >> 6, fr = lane & 15, fq = lane >> 4;
  const float* gl = (const float*)(p.ws + WS_GL);
  const bf16_t* qb = (const bf16_t*)(p.ws + WS_Q); const bf16_t* kb = (const bf16_t*)(p.ws + WS_K); const bf16_t* vT = (const bf16_t*)(p.ws + WS_VT);
  const bf16_t* og = (const bf16_t*)(p.ws + WS_OG);
  const float* UT = (const float*)(p.ws + WS_UT); const float* nvec = (const float*)(p.ws + WS_NVEC);
  bf16_t* yA = (bf16_t*)(p.ws + WS_HA);
  const float* ng = p.in[30];
  char* Qs = smem + MLC_QS; char* Ks = smem + MLC_KS; char* Ps = Ks; char* Q2 = smem + MLC_Q2; char* Bs = smem + MLC_BS;
  float* li_f = (float*)(smem + MLC_G); float* cf = li_f + 128; float* li_b = cf + 128; float* cb = li_b + 128;
  float* qn = cb + 128; float* sfq = qn + 128; float* sbq = sfq + 64; float* nv = sbq + 64;
  for (int it = 0, iters = ((128 * 2 * 8) + nb - 1) / nb; it < iters; ++it) {
    int u = bid + it * nb; const bool active = u < (128 * 2 * 8); if (!active) u = (128 * 2 * 8) - 1;
    const int h = u % 8, th = (u / 8) & 1, c = u / 16, r0 = c * 128, rt = r0 + th * 64;
    __syncthreads();
    ml_gate_scans(gl, r0, h, li_f, cf, li_b, cb);
    if (tid >= 128) nv[tid - 128] = nvec[(size_t)((c * 8 + h) * 2 + ((tid - 128) >> 6)) * 64 + (tid & 63)];
#pragma unroll
    for (int i = 0; i < 2; ++i) { const int f = tid + 256 * i, r = f >> 3, pc = f & 7;
      *(u32x4*)(Qs + r * 144 + pc * 16) = *(const u32x4*)(qb + (size_t)(rt + r) * 512 + h * 64 + pc * 8); }
#pragma unroll
    for (int i = 0; i < 4; ++i) { const int f = tid + 256 * i, r = f >> 3, pc = f & 7;
      *(u32x4*)(Ks + r * 144 + pc * 16) = *(const u32x4*)(kb + (size_t)(r0 + r) * 512 + h * 64 + pc * 8); }
    __syncthreads();
    if (tid < 128) {
      const int t = tid & 63, dir = tid >> 6; float s = 0.f;
      for (int pc = 0; pc < 8; ++pc) { const u32x4 v = *(const u32x4*)(Qs + t * 144 + pc * 16); const float* nn = nv + dir * 64 + pc * 8;
        s += bflo(v.x) * nn[0] + bfhi(v.x) * nn[1] + bflo(v.y) * nn[2] + bfhi(v.y) * nn[3] + bflo(v.z) * nn[4] + bfhi(v.z) * nn[5] + bflo(v.w) * nn[6] + bfhi(v.w) * nn[7]; }
      qn[dir * 64 + t] = s;
    }
    f32x4 S[8];
#pragma unroll
    for (int n = 0; n < 8; ++n) S[n] = (f32x4){0.f, 0.f, 0.f, 0.f};
#pragma unroll
    for (int ks = 0; ks < 2; ++ks) {
      const bf16x8 a = *(const bf16x8*)(Qs + (wave * 16 + fr) * 144 + (ks * 32 + fq * 8) * 2);
#pragma unroll
      for (int n = 0; n < 8; ++n) {
        const bf16x8 b = *(const bf16x8*)(Ks + (n * 16 + fr) * 144 + (ks * 32 + fq * 8) * 2);
        S[n] = __builtin_amdgcn_mfma_f32_16x16x32_bf16(a, b, S[n], 0, 0, 0);
      }
    }
    __syncthreads();
    float rfv[4], rbv[4];
    {
      float sumf[4] = {0.f, 0.f, 0.f, 0.f}, sumb[4] = {0.f, 0.f, 0.f, 0.f};
      float Sf[8][4], Sb_[8][4];
#pragma unroll
      for (int j = 0; j < 4; ++j) {
        const int tl = wave * 16 + fq * 4 + j, tc = th * 64 + tl;
        const float cft = cf[tc], cbt = cb[tc];
#pragma unroll
        for (int n = 0; n < 8; ++n) {
          const int s = n * 16 + fr;
          const float df = s <= tc ? fexp_(cft - cf[s] + li_f[s]) : 0.f;
          const float db = s >= tc ? fexp_(cbt - cb[s] + li_b[s]) : 0.f;
          Sf[n][j] = S[n][j] * df; Sb_[n][j] = S[n][j] * db;
          sumf[j] += Sf[n][j]; sumb[j] += Sb_[n][j];
        }
      }
#pragma unroll
      for (int j = 0; j < 4; ++j) {
#pragma unroll
        for (int o = 1; o < 16; o <<= 1) { sumf[j] += __shfl_xor(sumf[j], o); sumb[j] += __shfl_xor(sumb[j], o); }
        const int tl = wave * 16 + fq * 4 + j, tc = th * 64 + tl;
        const float ef = __expf(cf[tc]), eb = __expf(cb[tc]);
        const float denf = ef * qn[tl] + sumf[j], denb = eb * qn[64 + tl] + sumb[j];
        rfv[j] = __builtin_amdgcn_rcpf(fmaxf(fabsf(denf), 1.f)); rbv[j] = __builtin_amdgcn_rcpf(fmaxf(fabsf(denb), 1.f));
        if (fr == 0) { sfq[tl] = ef * rfv[j]; sbq[tl] = eb * rbv[j]; }
      }
#pragma unroll
      for (int n = 0; n < 8; ++n)
#pragma unroll
        for (int j = 0; j < 4; ++j) {
          const int tl = wave * 16 + fq * 4 + j;
          *(bf16_t*)(Ps + tl * MLA_STRIDE + (n * 16 + fr) * 2) = f2bf(Sf[n][j] * rfv[j] + Sb_[n][j] * rbv[j]);
        }
    }
    __syncthreads();
#pragma unroll
    for (int i = 0; i < 2; ++i) { const int f = tid + 256 * i, r = f >> 3, pc = f & 7;
      const u32x4 v = *(const u32x4*)(Qs + r * 144 + pc * 16); const float a = sfq[r], b = sbq[r];
      u32x4 o1, o2;
      o1.x = pk2(bflo(v.x) * a, bfhi(v.x) * a); o1.y = pk2(bflo(v.y) * a, bfhi(v.y) * a); o1.z = pk2(bflo(v.z) * a, bfhi(v.z) * a); o1.w = pk2(bflo(v.w) * a, bfhi(v.w) * a);
      o2.x = pk2(bflo(v.x) * b, bfhi(v.x) * b); o2.y = pk2(bflo(v.y) * b, bfhi(v.y) * b); o2.z = pk2(bflo(v.z) * b, bfhi(v.z) * b); o2.w = pk2(bflo(v.w) * b, bfhi(v.w) * b);
      *(u32x4*)(Q2 + r * MLA_STRIDE + pc * 16) = o1; *(u32x4*)(Q2 + r * MLA_STRIDE + 128 + pc * 16) = o2; }
    f32x4 Hh[8];
#pragma unroll
    for (int n = 0; n < 8; ++n) Hh[n] = (f32x4){0.f, 0.f, 0.f, 0.f};
#pragma unroll
    for (int kc = 0; kc < 4; ++kc) {
      __syncthreads();
      if (kc < 2) {
#pragma unroll
        for (int i = 0; i < 4; ++i) { const int f = tid + 256 * i, e = f >> 3, pc = f & 7;
          *(u32x4*)(Bs + e * 144 + pc * 16) = *(const u32x4*)(vT + (size_t)(h * 128 + e) * T + r0 + kc * 64 + pc * 8); }
      } else {
        const float* Cs = UT + (size_t)((c * 8 + h) * 2 + (kc - 2)) * 8192;
#pragma unroll
        for (int i = 0; i < 4; ++i) { const int f = tid + 256 * i, e = f >> 3, pc = f & 7;
          const f32x4 a = *(const f32x4*)(Cs + e * 64 + pc * 8), b = *(const f32x4*)(Cs + e * 64 + pc * 8 + 4);
          u32x4 o; o.x = pk2(a.x, a.y); o.y = pk2(a.z, a.w); o.z = pk2(b.x, b.y); o.w = pk2(b.z, b.w);
          *(u32x4*)(Bs + e * 144 + pc * 16) = o; }
      }
      __syncthreads();
      const char* Asrc = kc < 2 ? Ps + kc * 128 : Q2 + (kc - 2) * 128;
#pragma unroll
      for (int ks = 0; ks < 2; ++ks) {
        const bf16x8 a = *(const bf16x8*)(Asrc + (wave * 16 + fr) * MLA_STRIDE + (ks * 32 + fq * 8) * 2);
#pragma unroll
        for (int n = 0; n < 8; ++n) {
          const bf16x8 b = *(const bf16x8*)(Bs + (n * 16 + fr) * 144 + (ks * 32 + fq * 8) * 2);
          Hh[n] = __builtin_amdgcn_mfma_f32_16x16x32_bf16(a, b, Hh[n], 0, 0, 0);
        }
      }
    }
#pragma unroll
    for (int j = 0; j < 4; ++j) {
      float ss = 0.f;
#pragma unroll
      for (int n = 0; n < 8; ++n) ss += Hh[n][j] * Hh[n][j];
#pragma unroll
      for (int o = 1; o < 16; o <<= 1) ss += __shfl_xor(ss, o);
      const float rstd = rsqrtf(ss * (1.f / 128.f) + EPS);
      const size_t row = (size_t)(rt + wave * 16 + fq * 4 + j);
#pragma unroll
      for (int n = 0; n < 8; ++n) {
        const int col = h * 128 + n * 16 + fr;
        yA[row * D + col] = f2bf(Hh[n][j] * rstd * ng[col] * bf2f(og[row * D + col]));
      }
    }
  }
}

DEV void ph_final(const Params& p, int bid, int nb) {
  const int lane = tidx() & 63, wave = tidx() >> 6;
  const float* mods1 = (const float*)(p.ws + WS_MODS) + 2 * 6144;
  const float* x1 = (const float*)(p.ws + WS_X1);
  const bf16_t* Y = (const bf16_t*)(p.ws + WS_Y); const int* pos = (const int*)(p.ws + WS_POS);
  const float* gf = p.in[39];
  for (int t = bid * 4 + wave; t < NL; t += nb * 4) {
    const bf16_t* Ya = Y + (size_t)pos[2 * t] * D; const bf16_t* Yb = Y + (size_t)pos[2 * t + 1] * D;
    f32x4 v[4]; float ss = 0.f;
#pragma unroll
    for (int i = 0; i < 4; ++i) {
      const int c = 4 * lane + 256 * i;
      const f32x4 xv = *(const f32x4*)(x1 + (size_t)t * D + c), gt = *(const f32x4*)(mods1 + 5120 + c);
      const u32x2 ya = *(const u32x2*)(Ya + c), yb = *(const u32x2*)(Yb + c);
      f32x4 f; f.x = bflo(ya.x) + bflo(yb.x); f.y = bfhi(ya.x) + bfhi(yb.x); f.z = bflo(ya.y) + bflo(yb.y); f.w = bfhi(ya.y) + bfhi(yb.y);
      v[i] = xv + gt * f;
      ss += v[i].x * v[i].x + v[i].y * v[i].y + v[i].z * v[i].z + v[i].w * v[i].w;
    }
    const float rstd = rsqrtf(wave_sum(ss) * (1.f / D) + EPS);
#pragma unroll
    for (int i = 0; i < 4; ++i) {
      const int c = 4 * lane + 256 * i;
      *(f32x4*)(p.out + (size_t)t * D + c) = v[i] * rstd * *(const f32x4*)(gf + c);
    }
  }
}

#define XB_TMO      128
#define XB_XCNT(j)  (256  + 64 * (j))
#define XB_XSUB(j)  (1280 + 64 * (j))
#define XB_XGEN(j)  (2304 + 64 * (j))
#define XB_TOP      3328
#define XB_TOPGEN   3392
#define XCD_BAR_WORDS 3456
#define XB_SPIN_CAP (1u << 22)
DEV unsigned xb_ld(unsigned* p)              { return __hip_atomic_load(p, __ATOMIC_RELAXED, __HIP_MEMORY_SCOPE_AGENT); }
DEV unsigned xb_add(unsigned* p, unsigned v) { return __hip_atomic_fetch_add(p, v, __ATOMIC_RELAXED, __HIP_MEMORY_SCOPE_AGENT); }
DEV unsigned xb_xcc_id() { return (unsigned)__builtin_amdgcn_s_getreg((3 << 11) | 20) & 0xFu; }
#define XB_SPIN(cond, bar) do { unsigned _sp = 0; while (cond) { __builtin_amdgcn_s_sleep(1); \
    if ((++_sp & 255u) == 0u) { if (xb_ld(&(bar)[XB_TMO])) break; if (_sp > XB_SPIN_CAP) { atomicAdd(&(bar)[XB_TMO], 1u); break; } } } } while (0)
struct XcdBarrier { unsigned* bar; unsigned x; volatile LAS unsigned* st; };
DEV XcdBarrier xcd_barrier_post(unsigned* bar, volatile LAS unsigned* st) {
  XcdBarrier b; b.bar = bar; b.x = xb_xcc_id(); b.st = st;
  if (threadIdx.x == 0) (void)xb_add(&bar[XB_XCNT(b.x)], 1u);
  return b;
}
DEV void xcd_barrier_complete(unsigned* bar, unsigned x, unsigned& nloc, unsigned& nx) {
  const unsigned G = gridDim.x * gridDim.y * gridDim.z;
  unsigned sum, cnt, mine, sp = 0u;
  for (;;) {
    sum = 0u; cnt = 0u; mine = 0u;
#pragma unroll
    for (unsigned j = 0; j < 16; ++j) { const unsigned c = xb_ld(&bar[XB_XCNT(j)]); sum += c; cnt += (c > 0u) ? 1u : 0u; mine = (j == x) ? c : mine; }
    if (sum == G) break;
    __builtin_amdgcn_s_sleep(1);
    if ((++sp & 255u) == 0u) { if (xb_ld(&bar[XB_TMO])) break; if (sp > XB_SPIN_CAP) { atomicAdd(&bar[XB_TMO], 1u); break; } }
  }
  nloc = mine > 0u ? mine : 1u; nx = cnt > 0u ? cnt : 1u;
}
DEV void xcd_barrier(const XcdBarrier& b) {
  asm volatile("s_waitcnt vmcnt(0)" ::: "memory");
  __syncthreads();
  if (threadIdx.x == 0) {
    unsigned* bar = b.bar;
    __builtin_amdgcn_s_waitcnt(0);
    unsigned nloc = b.st[0], nx = b.st[1];
    if (nloc == 0u) { xcd_barrier_complete(bar, b.x, nloc, nx); b.st[0] = nloc; b.st[1] = nx; }
    const unsigned old = xb_add(&bar[XB_XSUB(b.x)], 1u);
    const unsigned gen = old / nloc;
    if (old + 1u == (gen + 1u) * nloc) {
      __builtin_amdgcn_fence(__ATOMIC_RELEASE, "agent");
      asm volatile("s_waitcnt vmcnt(0)" ::: "memory");
      const unsigned og = xb_add(&bar[XB_TOP], 1u);
      const unsigned tg = og / nx;
      if (og + 1u == (tg + 1u) * nx) xb_add(&bar[XB_TOPGEN], 1u);
      else XB_SPIN(xb_ld(&bar[XB_TOPGEN]) == tg, bar);
      __builtin_amdgcn_fence(__ATOMIC_ACQUIRE, "agent");
      xb_add(&bar[XB_XGEN(b.x)], 1u);
      asm volatile("s_waitcnt vmcnt(0)" ::: "memory");
    } else {
      XB_SPIN(xb_ld(&bar[XB_XGEN(b.x)]) == gen, bar);
      __builtin_amdgcn_fence(__ATOMIC_ACQUIRE, "agent");
      asm volatile("s_waitcnt vmcnt(0)" ::: "memory");
    }
  }
  __syncthreads();
}

#ifndef REP_MASK
#define REP_MASK 0u
#endif
#ifndef XBAR
#define XBAR 0
#endif
constexpr int NPHASE = 22;
constexpr int HALF_SMEM = 78336;
constexpr int LDS_ST = 2 * HALF_SMEM;
constexpr int LDS_BYTES = LDS_ST + 16;
static_assert(RT_SMEM <= HALF_SMEM && RG_SMEM <= HALF_SMEM && MLA_SMEM <= HALF_SMEM && MLC_SMEM <= HALF_SMEM, "smem");
static_assert(LDS_TB + 66 * 4 <= LDS_ST && 8 * 8448 <= LDS_ST, "smem");

template <int PH>
DEV void run_phase(const Params& p, char* smem) {
  int half = threadIdx.x >> 8; asm volatile("" : "+v"(half)); half = __builtin_amdgcn_readfirstlane(half);
  char* hs = smem + half * HALF_SMEM;
  const int vb = blockIdx.x * 2 + half, nvb = gridDim.x * 2;
  if constexpr (PH == 0) { ph_adaln(p, hs, vb, nvb); __syncthreads(); ph_convert_dense(p, smem); ph_convert_moe<0>(p, smem); }
  else if constexpr (PH == 1) ph_norm0(p, vb, nvb);
  else if constexpr (PH == 2) ph_gemm_dense<0>(p, smem);
  else if constexpr (PH == 3) ph_rg_scan2(p, smem);
  else if constexpr (PH == 4) ph_rg_carry(p, vb, nvb);
  else if constexpr (PH == 5) ph_rg_final(p, vb, nvb);
  else if constexpr (PH == 6) ph_gemm_dense<1>(p, smem);
  else if constexpr (PH == 7) ph_router<0>(p, hs, vb, nvb);
  else if constexpr (PH == 8) ph_scatter<0>(p, hs, vb, nvb);
  else if constexpr (PH == 9) ph_gemm_moe<0, 0>(p, smem);
  else if constexpr (PH == 10) ph_gemm_moe<0, 1>(p, smem);
  else if constexpr (PH == 11) { ph_combine0(p, vb, nvb); ph_convert_moe<1>(p, smem); }
  else if constexpr (PH == 12) ph_gemm_dense<2>(p, smem);
  else if constexpr (PH == 13) ph_ml_state(p, hs, vb, nvb);
  else if constexpr (PH == 14) ph_ml_chain(p, vb, nvb);
  else if constexpr (PH == 15) ph_ml_out(p, hs, vb, nvb);
  else if constexpr (PH == 16) ph_gemm_dense<3>(p, smem);
  else if constexpr (PH == 17) ph_router<1>(p, hs, vb, nvb);
  else if constexpr (PH == 18) ph_scatter<1>(p, hs, vb, nvb);
  else if constexpr (PH == 19) ph_gemm_moe<1, 0>(p, smem);
  else if constexpr (PH == 20) ph_gemm_moe<1, 1>(p, smem);
  else if constexpr (PH == 21) ph_final(p, vb, nvb);
}

template <int PH>
DEV void run_from(const Params& p, char* smem) {
  run_phase<PH>(p, smem);
  if constexpr ((REP_MASK >> PH) & 1u) {
    __syncthreads();
    if constexpr (PH == 7 || PH == 17) { const int half = __builtin_amdgcn_readfirstlane(threadIdx.x >> 8); if constexpr (PH == 7) ph_router<0, true>(p, smem + half * HALF_SMEM, blockIdx.x * 2 + half, gridDim.x * 2); else ph_router<1, true>(p, smem + half * HALF_SMEM, blockIdx.x * 2 + half, gridDim.x * 2); }
    else run_phase<PH>(p, smem);
  }
  if constexpr (XBAR > 0 && PH + 1 < NPHASE) {
#pragma unroll 1
    for (int xi = 0; xi < XBAR; ++xi) { XcdBarrier xb; xb.bar = (unsigned*)(p.ws + WS_BAR); xb.x = xb_xcc_id(); xb.st = (volatile LAS unsigned*)(LAS char*)(smem + LDS_ST); xcd_barrier(xb); }
  }
  if constexpr (PH + 1 < NPHASE) {
    XcdBarrier xb; xb.bar = (unsigned*)(p.ws + WS_BAR); xb.x = xb_xcc_id(); xb.st = (volatile LAS unsigned*)(LAS char*)(smem + LDS_ST);
    xcd_barrier(xb);
    run_from<PH + 1>(p, smem);
  }
}

__global__ void __launch_bounds__(512) mega_kernel(Params p) {
  extern __shared__ __attribute__((aligned(16))) char smem[];
  volatile LAS unsigned* st = (volatile LAS unsigned*)(LAS char*)(smem + LDS_ST);
  if (threadIdx.x == 0) { st[0] = 0u; st[1] = 0u; st[2] = 0u; st[3] = 0u; }
  __syncthreads();
  (void)xcd_barrier_post((unsigned*)(p.ws + WS_BAR), st);
  run_from<0>(p, smem);
}

extern "C" void kernel_launch(void* const* d_in, const int* in_sizes, int n_in, void* d_out, int out_size, void* d_ws, size_t ws_size, hipStream_t stream) {
  static int grid = 0;
  if (grid == 0) {
    if (n_in != 40 || ws_size < WS_END) { fprintf(stderr, "kernel_launch: unexpected inputs (n_in %d, ws %zu, need %zu)\n", n_in, ws_size, (size_t)WS_END); grid = -1; return; }
    int dev = 0, cus = 0, per_cu = 0;
    if (hipGetDevice(&dev) != hipSuccess || hipDeviceGetAttribute(&cus, hipDeviceAttributeMultiprocessorCount, dev) != hipSuccess) { grid = -1; return; }
    if (hipFuncSetAttribute((const void*)mega_kernel, hipFuncAttributeMaxDynamicSharedMemorySize, LDS_BYTES) != hipSuccess) { fprintf(stderr, "kernel_launch: hipFuncSetAttribute failed\n"); grid = -1; return; }
    if (hipOccupancyMaxActiveBlocksPerMultiprocessor(&per_cu, (const void*)mega_kernel, 512, LDS_BYTES) != hipSuccess || per_cu < 1) { fprintf(stderr, "kernel_launch: occupancy query failed (%d)\n", per_cu); grid = -1; return; }
    grid = cus;
    fprintf(stderr, "kernel_launch: %d CUs, occupancy %d\n", cus, per_cu);
  }
  if (grid < 0) return;
  Params p{};
  for (int i = 0; i < 40; ++i) p.in[i] = (const float*)d_in[i];
  p.out = (float*)d_out; p.ws = (char*)d_ws;
  if (hipMemsetAsync((char*)d_ws, 0, WS_ZERO_BYTES, stream) != hipSuccess) return;
  void* args[] = {&p};
  hipError_t e = hipLaunchCooperativeKernel((const void*)mega_kernel, dim3(grid), dim3(512), args, LDS_BYTES, stream);
  if (e != hipSuccess) fprintf(stderr, "cooperative launch failed: %s (grid %d)\n", hipGetErrorString(e), grid);
}
```

```cpp
#include <hip/hip_runtime.h>
#include <cstdio>
#include <cstdint>

#define DEV __device__ __forceinline__
typedef unsigned short bf16_t;
typedef short bf16x8 __attribute__((ext_vector_type(8)));
typedef short s16x4 __attribute__((ext_vector_type(4)));
typedef float f32x4 __attribute__((ext_vector_type(4)));
typedef unsigned u32x4 __attribute__((ext_vector_type(4)));
typedef unsigned u32x2 __attribute__((ext_vector_type(2)));
#define LAS __attribute__((address_space(3)))

constexpr int D = 1024, NL = 16384, NC = 256, T = NL + NC, NTILE = T / 128;
constexpr int DR = 1280, NEXP = 32, DE = 512;
constexpr int RGT = 64, NRT = T / RGT, NRT_LAT = NL / RGT;
constexpr int MLW = 3104, MLWP = 3328;
constexpr int MOE_ROWS = 41472;
constexpr float EPS = 1e-6f;

constexpr size_t al256(size_t x) { return (x + 255) & ~(size_t)255; }
constexpr size_t WS_BAR   = 0;
constexpr size_t WS_CNT   = 16384;
constexpr int CNT_STRIDE = 64;
constexpr size_t WS_ZERO_BYTES = 16384 + 2 * 32 * CNT_STRIDE * 4;
constexpr size_t WS_MODS  = 32768;
constexpr size_t WS_LIST  = WS_MODS + al256(2 * 2 * 6144 * 4);
constexpr size_t WS_AW    = WS_LIST + al256((size_t)2 * 32 * T * 4);
constexpr size_t WS_POS   = WS_AW + al256((size_t)2 * T * 4);
constexpr size_t WS_AWP   = WS_POS + al256((size_t)2 * T * 4);
constexpr size_t WS_AGG   = WS_AWP + al256((size_t)MOE_ROWS * 4);
constexpr size_t WS_CARRY = WS_AGG + al256((size_t)2 * NRT * DR * 2 * 4);
constexpr size_t WS_GL    = WS_CARRY + al256((size_t)2 * NRT * DR * 4);
constexpr size_t WS_NVEC  = WS_GL + al256((size_t)T * 32 * 4);
constexpr size_t WS_DEC   = WS_NVEC + al256((size_t)NTILE * 16 * 64 * 4);
constexpr size_t WS_WIN   = WS_DEC + al256((size_t)NTILE * 16 * 4);
constexpr size_t WS_WOUT  = WS_WIN + al256((size_t)2560 * 1024 * 2);
constexpr size_t WS_WML   = WS_WOUT + al256((size_t)1024 * 1280 * 2);
constexpr size_t WS_WMO   = WS_WML + al256((size_t)MLWP * 1024 * 2);
constexpr size_t WS_WGU   = WS_WMO + al256((size_t)1024 * 1024 * 2);
constexpr size_t WS_WD    = WS_WGU + al256((size_t)32 * 1024 * 1024 * 2);
constexpr size_t WS_WAXT  = WS_WD + al256((size_t)32 * 1024 * 512 * 2);
constexpr size_t WS_WR    = WS_WAXT + al256((size_t)40 * 16384 * 2);
constexpr size_t WS_HA    = WS_WR + al256((size_t)2 * 64 * 64 * 12 * 4);
constexpr size_t WS_X1    = WS_HA + al256((size_t)T * D * 2);
constexpr size_t WS_X2    = WS_X1 + al256((size_t)T * D * 4);
constexpr size_t WS_R0    = WS_X2 + al256((size_t)T * D * 4);
constexpr size_t WS_GG    = WS_R0;
constexpr size_t WS_PR    = WS_GG + al256((size_t)T * DR * 2);
constexpr size_t WS_S     = WS_PR + al256((size_t)T * DR * 2);
constexpr size_t WS_PF    = WS_S + al256((size_t)T * DR * 2);
constexpr size_t WS_PB    = WS_PF + al256((size_t)T * DR * 2);
constexpr size_t WS_R0END = WS_PB + al256((size_t)T * DR * 2);
constexpr size_t WS_ABUF  = WS_R0;
constexpr size_t WS_HM    = WS_ABUF + al256((size_t)MOE_ROWS * D * 2);
constexpr size_t WS_Y     = WS_HM + al256((size_t)MOE_ROWS * DE * 2);
constexpr size_t WS_MOEEND = WS_Y + al256((size_t)MOE_ROWS * D * 2);
constexpr size_t WS_Q     = WS_R0;
constexpr size_t WS_K     = WS_Q + al256((size_t)T * 512 * 2);
constexpr size_t WS_KT    = WS_K + al256((size_t)T * 512 * 2);
constexpr size_t WS_VT    = WS_KT + al256((size_t)T * 512 * 2);
constexpr size_t WS_OG    = WS_VT + al256((size_t)T * D * 2);
constexpr size_t WS_UT    = WS_OG + al256((size_t)T * D * 2);
constexpr size_t WS_L1END = WS_UT + al256((size_t)NTILE * 16 * 8192 * 4);
constexpr size_t cmax(size_t a, size_t b) { return a > b ? a : b; }
constexpr size_t WS_END   = cmax(cmax(WS_R0END, WS_L1END), WS_MOEEND);

struct Params {
  const float* in[40];
  float* out;
  char* ws;
};

typedef __bf16 bf16v2_t __attribute__((ext_vector_type(2)));
typedef float f32x2_t __attribute__((ext_vector_type(2)));
DEV unsigned pk2(float lo, float hi) { const f32x2_t v = {lo, hi}; return __builtin_bit_cast(unsigned, __builtin_convertvector(v, bf16v2_t)); }
DEV float bflo(unsigned u) { return __uint_as_float(u << 16); }
DEV float bfhi(unsigned u) { return __uint_as_float(u & 0xffff0000u); }
DEV float bf2f(bf16_t b) { return __uint_as_float((unsigned)b << 16); }
DEV bf16_t f2bf(float f) { return (bf16_t)(pk2(f, 0.f) & 0xffffu); }
DEV float fexp_(float x) { return __builtin_amdgcn_exp2f(x * 1.4426950408889634f); }
DEV float sigmoidf_(float x) { return __builtin_amdgcn_rcpf(1.f + __builtin_amdgcn_exp2f(x * -1.4426950408889634f)); }
DEV float siluf_(float x) { return x * sigmoidf_(x); }
DEV float gelu_tanh(float x) { const float u = 0.7978845608028654f * (x + 0.044715f * x * x * x); return x * sigmoidf_(2.f * u); }
DEV float wave_sum(float v) {
#pragma unroll
  for (int o = 1; o < 64; o <<= 1) v += __shfl_xor(v, o);
  return v;
}
DEV s16x4 ldtr(const char* p) { return __builtin_bit_cast(s16x4, __builtin_amdgcn_ds_read_tr16_b64_v4i16((LAS s16x4*)p)); }
DEV int tidx() { int t = threadIdx.x & 255; asm volatile("" : "+v"(t)); return t; }
DEV int tidf() { int t = threadIdx.x; asm volatile("" : "+v"(t)); return t; }
DEV int seqrow_of_token(int t) { return (t & 63) * 256 + (t >> 6); }
DEV int token_of_seqrow(int s) { return (s & 255) * 64 + (s >> 8); }

constexpr int BS_STRIDE = 320;
DEV int bs_off(int k, int n) { return k * BS_STRIDE + ((((n >> 4) ^ ((k >> 3) & 1))) << 5) + (n & 15) * 2; }

namespace pg8 {
#define PG8_LAS __attribute__((address_space(3)))
typedef unsigned short bf16_t;
typedef short bf16x8 __attribute__((ext_vector_type(8)));
typedef float f32x4 __attribute__((ext_vector_type(4)));
typedef unsigned u32x4 __attribute__((ext_vector_type(4)));
constexpr int BM = 256, BK = 64, HALF = 128, HTB = HALF * BK * 2  , STAGE_BYTES = 8 * HTB, NXCD = 8, WGM = 8;

__host__ __device__ __forceinline__ int lds_byte(int r, int c) { const int st = (r >> 4) * 2 + (c >> 5), rr = r & 15, cc = c & 31, ob = rr * 64 + cc * 2; return st * 1024 + (ob ^ (((ob >> 9) & 1) << 5)); }
__host__ __device__ __forceinline__ void stage_rc(int b, int& R, int& C) { const int st = b / 1024, sb = b % 1024, swz = sb ^ (((sb >> 9) & 1) << 5); R = (st >> 1) * 16 + swz / 64; C = (st & 1) * 32 + (swz % 64) / 2; }
__host__ __device__ __forceinline__ int perm32(int rho) { const int n = rho >> 4, i = rho & 15; return 8 * (i >> 2) + 4 * n + (i & 3); }

struct Unit { int pm, pn; };
struct Gemm { const bf16_t* A; const bf16_t* Bt; int M, N, K; };

struct StaticOrder {
    int nM, nN, nwg, G, c;
    __host__ __device__ void init(int M, int N, int G_, int c_) { nM = M / BM; nN = N / BM; nwg = nM * nN; G = G_; c = c_; }
    __host__ __device__ bool next(int i, Unit& u) const {
        const long L = (long)i * G + c; if (L >= nwg) return false;
        int wgid = (int)L; { const int q = nwg / NXCD, r = nwg % NXCD, xcd = wgid % NXCD, off = wgid / NXCD; wgid = (xcd < r ? xcd * (q + 1) : r * (q + 1) + (xcd - r) * q) + off; }
        const int nig = WGM * nN, gid = wgid / nig, fm = gid * WGM, gsz = (nM - fm) < WGM ? (nM - fm) : WGM;
        u.pm = fm + ((wgid % nig) % gsz); u.pn = (wgid % nig) / gsz; return true;
    }
    __device__ __forceinline__ void a_ready(const Unit&) const {}
    __device__ __forceinline__ void done(const Unit&) const {}
};
template <class Epi, class Sched, bool STAMP = false>
__device__ __forceinline__ void gemm_phase(PG8_LAS unsigned char* lds, const Gemm g, const Sched& S, const Epi& E, unsigned long long* stamps) {
    int tid = threadIdx.x; asm volatile("" : "+v"(tid));
    const int wid = __builtin_amdgcn_readfirstlane(tid >> 6), lane = tid & 63, wr = wid >> 2, wc = wid & 3, fr = lane & 15, fq = lane >> 4;
    const int K = g.K, nt = K / BK;
    int ts_lo = 0, ts_hi = 0, nts = 0; const unsigned long long rt_entry = STAMP ? (unsigned long long)wall_clock64() : 0ull;
#define PG8_STAMP() do { if (STAMP && wid == 0 && nts < 64) { const unsigned long long _c = (unsigned long long)clock64(); \
        ts_lo = (lane == nts) ? (int)(unsigned)_c : ts_lo; ts_hi = (lane == nts) ? (int)(unsigned)(_c >> 32) : ts_hi; ++nts; } } while (0)
    PG8_STAMP();
    unsigned voffA[2], voffB[2];
#pragma unroll
    for (int i = 0; i < 2; ++i) { int R, C; stage_rc(tid * 16 + i * 8192, R, C); const int Rb = Epi::PERM ? ((R & ~31) + perm32(R & 31)) : R;
        voffA[i] = (unsigned)(R * K + C) * 2u; voffB[i] = (unsigned)(Rb * K + C) * 2u; }
    const size_t kstep = (size_t)(BK * 2);
    const size_t hstep = (size_t)HALF * K * 2;
    const size_t tstep = 2 * hstep;
    const unsigned ldsw = (unsigned)wid * 1024u;
    const int aoff = lds_byte(wr * 64 + fr, fq * 8), boff = lds_byte(wc * 32 + fr, fq * 8);
#define PG8_SA(b, h) (((b) * 2 + (h)) * HTB)
#define PG8_SB(b, h) ((4 + (b) * 2 + (h)) * HTB)
#define PG8_STAGE(bufoff, gbase, voff) do { _Pragma("unroll") for (int _i = 0; _i < 2; ++_i) \
        __builtin_amdgcn_global_load_lds((const unsigned*)((const char*)(gbase) + (voff)[_i]), (PG8_LAS unsigned*)(lds + (bufoff) + ldsw + _i * 8192), 16, 0, 0); } while (0)
#define PG8_LDA(dst, b, h) do { _Pragma("unroll") for (int m = 0; m < 4; ++m) _Pragma("unroll") for (int k = 0; k < 2; ++k) dst[m][k] = *(const PG8_LAS bf16x8*)(lds + PG8_SA(b, h) + aoff + m * 2048 + k * 1024); } while (0)
#define PG8_LDB(dst, b, h) do { _Pragma("unroll") for (int n = 0; n < 2; ++n) _Pragma("unroll") for (int k = 0; k < 2; ++k) dst[n][k] = *(const PG8_LAS bf16x8*)(lds + PG8_SB(b, h) + boff + n * 2048 + k * 1024); } while (0)
#define PG8_MMA(ai, bj, At, Bt) do { __builtin_amdgcn_s_setprio(1); _Pragma("unroll") for (int m = 0; m < 4; ++m) _Pragma("unroll") for (int n = 0; n < 2; ++n) _Pragma("unroll") for (int k = 0; k < 2; ++k) \
        acc[ai][bj][m][n] = __builtin_amdgcn_mfma_f32_16x16x32_bf16(Bt[n][k], At[m][k], acc[ai][bj][m][n], 0, 0, 0); __builtin_amdgcn_s_setprio(0); } while (0)
#define PG8_WAIT_V(n) asm volatile("s_waitcnt vmcnt(" #n ")" ::: "memory")
#define PG8_WAIT_L(n) asm volatile("s_waitcnt lgkmcnt(" #n ")" ::: "memory")
#define PG8_BAR __builtin_amdgcn_s_barrier()
#define PG8_SCHED __builtin_amdgcn_sched_barrier(0)
    Unit cur, nxt; int ui = 0;
    if (!S.next(0, cur)) return;
    f32x4 acc[2][2][4][2];
#pragma unroll
    for (int a = 0; a < 2; ++a)
#pragma unroll
        for (int b = 0; b < 2; ++b)
#pragma unroll
            for (int m = 0; m < 4; ++m)
#pragma unroll
                for (int n = 0; n < 2; ++n) acc[a][b][m][n] = (f32x4){0.f, 0.f, 0.f, 0.f};
    bf16x8 At[4][2], B0[2][2], B1[2][2];
    const char* cA = (const char*)g.A + (size_t)cur.pm * tstep; const char* cB = (const char*)g.Bt + (size_t)cur.pn * tstep;
    S.a_ready(cur);
    PG8_STAGE(PG8_SB(0, 0), cB, voffB); PG8_STAGE(PG8_SA(0, 0), cA, voffA); PG8_STAGE(PG8_SB(0, 1), cB + hstep, voffB); PG8_STAGE(PG8_SA(0, 1), cA + hstep, voffA);
    if (wr == 1) PG8_BAR;
    PG8_WAIT_V(4); PG8_BAR;
    PG8_STAGE(PG8_SB(1, 0), cB + kstep, voffB); PG8_STAGE(PG8_SA(1, 0), cA + kstep, voffA); PG8_STAGE(PG8_SB(1, 1), cB + hstep + kstep, voffB);
    PG8_WAIT_V(6); PG8_BAR;
    PG8_STAMP();
    for (;;) {
        const bool has_next = S.next(ui + 1, nxt);
        const char* nA = has_next ? (const char*)g.A + (size_t)nxt.pm * tstep : cA; const char* nB = has_next ? (const char*)g.Bt + (size_t)nxt.pn * tstep : cB;
        for (int t = 0; t < nt; t += 2) {
            const bool last = (t == nt - 2);
            const char* a1 = cA + (size_t)(t + 1) * kstep;
            const char* a2 = last ? nA : cA + (size_t)(t + 2) * kstep; const char* b2 = last ? nB : cB + (size_t)(t + 2) * kstep;
            const char* a3 = a2 + kstep; const char* b3 = b2 + kstep;
            if (last && has_next) S.a_ready(nxt);
            PG8_LDB(B0, 0, 0); PG8_SCHED; PG8_LDA(At, 0, 0); PG8_STAGE(PG8_SA(1, 1), a1 + hstep, voffA);
            PG8_WAIT_L(8); PG8_BAR; PG8_WAIT_L(0); PG8_MMA(0, 0, At, B0); PG8_BAR; PG8_SCHED;
            PG8_LDB(B1, 0, 1); PG8_STAGE(PG8_SB(0, 0), b2, voffB);
            PG8_BAR; PG8_WAIT_L(0); PG8_MMA(0, 1, At, B1); PG8_BAR;
            PG8_LDA(At, 0, 1); PG8_STAGE(PG8_SA(0, 0), a2, voffA);
            PG8_BAR; PG8_WAIT_L(0); PG8_MMA(1, 0, At, B0); PG8_BAR; PG8_SCHED;
            PG8_STAGE(PG8_SB(0, 1), b2 + hstep, voffB);
            PG8_WAIT_V(6); PG8_BAR; PG8_MMA(1, 1, At, B1); PG8_BAR;
            PG8_LDB(B0, 1, 0); PG8_SCHED; PG8_LDA(At, 1, 0); PG8_STAGE(PG8_SA(0, 1), a2 + hstep, voffA);
            PG8_WAIT_L(8); PG8_BAR; PG8_WAIT_L(0); PG8_MMA(0, 0, At, B0); PG8_BAR; PG8_SCHED;
            PG8_LDB(B1, 1, 1); PG8_STAGE(PG8_SB(1, 0), b3, voffB);
            PG8_BAR; PG8_WAIT_L(0); PG8_MMA(0, 1, At, B1); PG8_BAR;
            PG8_LDA(At, 1, 1); PG8_STAGE(PG8_SA(1, 0), a3, voffA);
            PG8_BAR; PG8_WAIT_L(0); PG8_MMA(1, 0, At, B0); PG8_BAR; PG8_SCHED;
            PG8_STAGE(PG8_SB(1, 1), b3 + hstep, voffB);
            PG8_WAIT_V(6); PG8_BAR; PG8_MMA(1, 1, At, B1); PG8_BAR;
        }
        PG8_STAMP();
        if constexpr (!Epi::AFTER_DRAIN) { E(acc, cur, wr, wc, fr, fq); S.done(cur); }
        PG8_STAMP();
        if (!has_next) break;
#pragma unroll
        for (int a = 0; a < 2; ++a)
#pragma unroll
            for (int b = 0; b < 2; ++b)
#pragma unroll
                for (int m = 0; m < 4; ++m)
#pragma unroll
                    for (int n = 0; n < 2; ++n) acc[a][b][m][n] = (f32x4){0.f, 0.f, 0.f, 0.f};
        cur = nxt; cA = nA; cB = nB; ++ui;
    }
    PG8_WAIT_V(0);
    if (wr == 0) PG8_BAR;
    PG8_BAR;
    if constexpr (Epi::AFTER_DRAIN) { E.fused(acc, cur, wr, wc, fr, fq, lds, wid, lane); S.done(cur); }
    PG8_STAMP();
    if (STAMP && wid == 0) { stamps[lane] = lane < nts ? (((unsigned long long)(unsigned)ts_hi << 32) | (unsigned)ts_lo) : 0ull;
        if (lane == 62) stamps[62] = rt_entry; if (lane == 63) stamps[63] = (unsigned long long)wall_clock64(); }
#undef PG8_STAMP
#undef PG8_SA
#undef PG8_SB
#undef PG8_STAGE
#undef PG8_LDA
#undef PG8_LDB
#undef PG8_MMA
#undef PG8_WAIT_V
#undef PG8_WAIT_L
#undef PG8_BAR
#undef PG8_SCHED
}
}

DEV void ph_adaln(const Params& p, char* smem, int bid, int nb) {
  float* sc = (float*)smem; float* sx = sc + 1024; f32x4* red = (f32x4*)(sx + 1024);
  const int tid = tidx();
  for (int i = tid; i < 1024; i += 256) { sc[i] = siluf_(p.in[1][i]); sx[i] = siluf_(p.in[3][i]); }
  __syncthreads();
  float* mods = (float*)(p.ws + WS_MODS);
  const int cl = tid & 15, kg = tid >> 4;
  for (int it = 0, iters = (192 + nb - 1) / nb; it < iters; ++it) {
    const int u = bid + it * nb; const bool active = u < 192;
    const int l = u / 96, c0 = (u % 96) * 64;
    const float* W = p.in[l ? 24 : 4]; const float* B = p.in[l ? 25 : 5];
    if (active) {
      f32x4 ac = {0.f, 0.f, 0.f, 0.f}, ax = {0.f, 0.f, 0.f, 0.f};
      const float* wp = W + (size_t)(kg * 64) * 6144 + c0 + 4 * cl;
#pragma unroll 8
      for (int kk = 0; kk < 64; ++kk) {
        const f32x4 w = *(const f32x4*)(wp + (size_t)kk * 6144);
        const float a = sc[kg * 64 + kk], b = sx[kg * 64 + kk];
        ac += a * w; ax += b * w;
      }
      red[kg * 16 + cl] = ac; red[256 + kg * 16 + cl] = ax;
    }
    __syncthreads();
    if (active && tid < 32) {
      const int which = tid >> 4, c = tid & 15;
      f32x4 s = {0.f, 0.f, 0.f, 0.f};
      for (int g = 0; g < 16; ++g) s += red[which * 256 + g * 16 + c];
      const f32x4 bb = *(const f32x4*)(B + c0 + 4 * c);
      *(f32x4*)(mods + (size_t)(l * 2 + which) * 6144 + c0 + 4 * c) = s + bb;
    }
    __syncthreads();
  }
}

DEV void transpose_item(const float* W, int N, int K, bf16_t* WT, float* scr, int k0, int n0, int lane) {
#pragma unroll 8
  for (int i = 0; i < 32; ++i) { const int kk = 2 * i + (lane >> 5); scr[kk * 33 + (lane & 31)] = W[(size_t)(k0 + kk) * N + n0 + (lane & 31)]; }
  asm volatile("s_waitcnt lgkmcnt(0)" ::: "memory");
  const int c = lane & 7;
#pragma unroll
  for (int j = 0; j < 4; ++j) { const int n = (lane >> 3) + 8 * j; const float* s = scr + (8 * c) * 33 + n;
    u32x4 o; o.x = pk2(s[0 * 33], s[1 * 33]); o.y = pk2(s[2 * 33], s[3 * 33]); o.z = pk2(s[4 * 33], s[5 * 33]); o.w = pk2(s[6 * 33], s[7 * 33]);
    *(u32x4*)(WT + (size_t)n * K + k0 + 8 * c) = o; }
  asm volatile("s_waitcnt lgkmcnt(0)" ::: "memory");
}
constexpr int CI_WIN = 16 * 80, CI_WOUT = 20 * 32, CI_WML = 16 * 97, CI_WMO = 16 * 32, CI_WAX = 40 * 8, CI_DENSE = CI_WIN + CI_WOUT + CI_WML + CI_WMO + CI_WAX;
constexpr int CI_MOE = 32 * 768;
DEV void ph_convert_dense(const Params& p, char* smem) {
  const int tf = tidf(), lane = tf & 63, wv = tf >> 6;
  float* scr = (float*)(smem + wv * 8448);
  const int gw = blockIdx.x * 8 + wv, ngw = gridDim.x * 8;
  for (int it = gw; it < CI_DENSE; it += ngw) {
    int r = it;
    if (r < CI_WIN) { const int kb = r / 80, nb_ = r % 80; transpose_item(p.in[8], 2560, 1024, (bf16_t*)(p.ws + WS_WIN) + (size_t)(nb_ * 32) * 1024, scr, kb * 64, nb_ * 32, lane); continue; } r -= CI_WIN;
    if (r < CI_WOUT) { const int kb = r / 32, nb_ = r % 32; transpose_item(p.in[16], 1024, 1280, (bf16_t*)(p.ws + WS_WOUT) + (size_t)(nb_ * 32) * 1280, scr, kb * 64, nb_ * 32, lane); continue; } r -= CI_WOUT;
    if (r < CI_WML) { const int kb = r / 97, nb_ = r % 97; transpose_item(p.in[28], MLW, 1024, (bf16_t*)(p.ws + WS_WML) + (size_t)(nb_ * 32) * 1024, scr, kb * 64, nb_ * 32, lane); continue; } r -= CI_WML;
    if (r < CI_WMO) { const int kb = r / 32, nb_ = r % 32; transpose_item(p.in[31], 1024, 1024, (bf16_t*)(p.ws + WS_WMO) + (size_t)(nb_ * 32) * 1024, scr, kb * 64, nb_ * 32, lane); continue; } r -= CI_WMO;
    { const int mi = r >> 3, rr = r & 7, kb = rr >> 2, nb_ = rr & 3, dh = mi >> 1, which = mi & 1;
      transpose_item((which ? p.in[13] : p.in[11]) + (size_t)dh * 16384, 128, 128, (bf16_t*)(p.ws + WS_WAXT) + (size_t)mi * 16384 + (size_t)(nb_ * 32) * 128, scr, kb * 64, nb_ * 32, lane); }
  }
  { float* Wr = (float*)(p.ws + WS_WR);
    for (int i = blockIdx.x * 512 + tf; i < 2 * 64 * 64 * 12; i += gridDim.x * 512) {
      const int l = i / (64 * 64 * 12), r = i % (64 * 64 * 12), g = r / 768, ln = (r % 768) / 12, jc = r % 12, j = jc / 3, c = jc % 3;
      const int k = 16 * g + 4 * (ln >> 4) + j, col = ln & 15;
      const float* We = p.in[l ? 34 : 19]; const float* Wg = p.in[l ? 32 : 17];
      Wr[i] = c < 2 ? We[k * 32 + 16 * c + col] : (col < 4 ? Wg[k * 4 + col] : 0.f);
    } }
  { u32x4* z = (u32x4*)((bf16_t*)(p.ws + WS_WML) + (size_t)MLW * 1024); const int n16 = (MLWP - MLW) * 1024 * 2 / 16;
    for (int i = blockIdx.x * 512 + tf; i < n16; i += gridDim.x * 512) z[i] = (u32x4){0u, 0u, 0u, 0u}; }
}
template <int LAYER>
DEV void ph_convert_moe(const Params& p, char* smem) {
  const int tf = tidf(), lane = tf & 63, wv = tf >> 6;
  float* scr = (float*)(smem + wv * 8448);
  const int gw = blockIdx.x * 8 + wv, ngw = gridDim.x * 8;
  const float* Wg = p.in[LAYER == 0 ? 21 : 36]; const float* Wu = p.in[LAYER == 0 ? 22 : 37]; const float* Wd = p.in[LAYER == 0 ? 23 : 38];
  bf16_t* WGU = (bf16_t*)(p.ws + WS_WGU); bf16_t* WD = (bf16_t*)(p.ws + WS_WD);
  for (int it = gw; it < CI_MOE; it += ngw) {
    const int e = it / 768, r = it % 768;
    if (r < 512) {
      const int up = r >> 8, rr = r & 255, kb = rr >> 4, nb_ = rr & 15, n0 = nb_ * 32;
      bf16_t* dst = WGU + ((size_t)e * 1024 + (n0 >> 7) * 256 + up * 128 + (n0 & 127)) * 1024;
      transpose_item((up ? Wu : Wg) + (size_t)e * 1024 * 512, 512, 1024, dst, scr, kb * 64, n0, lane);
    } else {
      const int rr = r - 512, kb = rr >> 5, nb_ = rr & 31, n0 = nb_ * 32;
      transpose_item(Wd + (size_t)e * 512 * 1024, 1024, 512, WD + ((size_t)e * 1024 + n0) * 512, scr, kb * 64, n0, lane);
    }
  }
}

DEV void ph_norm0(const Params& p, int bid, int nb) {
  const int lane = tidx() & 63, wave = tidx() >> 6;
  const float* mods = (const float*)(p.ws + WS_MODS);
  bf16_t* hA = (bf16_t*)(p.ws + WS_HA);
  const float* g1 = p.in[6];
  for (int r = bid * 4 + wave; r < T; r += nb * 4) {
    const float* src = r < NL ? p.in[0] + (size_t)r * D : p.in[2] + (size_t)(r - NL) * D;
    const float* md = mods + (r < NL ? 0 : 6144);
    f32x4 v[4]; float ss = 0.f;
#pragma unroll
    for (int i = 0; i < 4; ++i) { v[i] = *(const f32x4*)(src + 4 * lane + 256 * i); ss += v[i].x * v[i].x + v[i].y * v[i].y + v[i].z * v[i].z + v[i].w * v[i].w; }
    const float rstd = rsqrtf(wave_sum(ss) * (1.f / D) + EPS);
#pragma unroll
    for (int i = 0; i < 4; ++i) {
      const int c = 4 * lane + 256 * i;
      const f32x4 g = *(const f32x4*)(g1 + c), sh = *(const f32x4*)(md + c), sc = *(const f32x4*)(md + 1024 + c);
      const f32x4 h = v[i] * rstd * g * (1.f + sc) + sh;
      u32x2 o; o.x = pk2(h.x, h.y); o.y = pk2(h.z, h.w);
      *(u32x2*)(hA + (size_t)r * D + c) = o;
    }
  }
}

constexpr int RG_AS_STRIDE = 272;
constexpr int RG_MT = RGT / 16;
constexpr int RG_AS = 0, RG_BS = RGT * RG_AS_STRIDE, RG_SMEM = RG_BS + 128 * BS_STRIDE;

template <bool REV, int NT>
DEV void rg_scan(f32x4 (&A)[RG_MT][NT], f32x4 (&B)[RG_MT][NT], float (&aggP)[NT], float (&aggH)[NT]) {
  const int lane = tidx() & 63, fq = lane >> 4, fr = lane & 15;
#pragma unroll
  for (int n = 0; n < NT; ++n) {
    float cP = 1.f, cH = 0.f;
#pragma unroll
    for (int mm = 0; mm < RG_MT; ++mm) {
      const int m = REV ? RG_MT - 1 - mm : mm;
      float P[4], H[4];
      if (!REV) {
        P[0] = A[m][n][0]; H[0] = B[m][n][0];
#pragma unroll
        for (int j = 1; j < 4; ++j) { P[j] = A[m][n][j] * P[j - 1]; H[j] = A[m][n][j] * H[j - 1] + B[m][n][j]; }
      } else {
        P[3] = A[m][n][3]; H[3] = B[m][n][3];
#pragma unroll
        for (int j = 2; j >= 0; --j) { P[j] = A[m][n][j] * P[j + 1]; H[j] = A[m][n][j] * H[j + 1] + B[m][n][j]; }
      }
      float IP = REV ? P[0] : P[3], IH = REV ? H[0] : H[3];
      float tP, tH;
      tP = REV ? __shfl_down(IP, 16) : __shfl_up(IP, 16); tH = REV ? __shfl_down(IH, 16) : __shfl_up(IH, 16);
      if (REV ? (fq <= 2) : (fq >= 1)) { IH = IP * tH + IH; IP = IP * tP; }
      tP = REV ? __shfl_down(IP, 32) : __shfl_up(IP, 32); tH = REV ? __shfl_down(IH, 32) : __shfl_up(IH, 32);
      if (REV ? (fq <= 1) : (fq >= 2)) { IH = IP * tH + IH; IP = IP * tP; }
      float EP = REV ? __shfl_down(IP, 16) : __shfl_up(IP, 16), EH = REV ? __shfl_down(IH, 16) : __shfl_up(IH, 16);
      if (REV ? (fq == 3) : (fq == 0)) { EP = 1.f; EH = 0.f; }
      const float hin = EP * cH + EH, pin = EP * cP;
#pragma unroll
      for (int j = 0; j < 4; ++j) { B[m][n][j] = H[j] + P[j] * hin; A[m][n][j] = P[j] * pin; }
      const float TP = __shfl(IP, (REV ? 0 : 48) + fr), TH = __shfl(IH, (REV ? 0 : 48) + fr);
      cH = TP * cH + TH; cP = TP * cP;
    }
    aggP[n] = cP; aggH[n] = cH;
  }
}

DEV void ph_rg_scan(const Params& p, char* smem, int bid, int nb) {
  char* As = smem + RG_AS; char* Bs = smem + RG_BS;
  const bf16_t* pr = (const bf16_t*)(p.ws + WS_PR);
  bf16_t* Sb = (bf16_t*)(p.ws + WS_S); bf16_t* Pfb = (bf16_t*)(p.ws + WS_PF); bf16_t* Pbb = (bf16_t*)(p.ws + WS_PB);
  float* agg = (float*)(p.ws + WS_AGG);
  const float* conv_w = p.in[9]; const float* conv_b = p.in[10];
  for (int it = 0, iters = (NRT * 10 + nb - 1) / nb; it < iters; ++it) {
    int u = bid + it * nb; const bool active = u < NRT * 10; if (!active) u = NRT * 10 - 1;
    const int tid = tidx();
    const int lane = tid & 63, wave = tid >> 6, fr = lane & 15, fq = lane >> 4, q4 = fr >> 2, p4 = lane & 3;
    const int hb = u % 10, tile = u / 10, r0 = tile * RGT, ch0 = hb * 128;
    const int seg_lo = tile < NRT_LAT ? 0 : NL, seg_hi = tile < NRT_LAT ? NL : T;
    __syncthreads();
    {
      const int cg8 = tid & 15, rg = tid >> 4, c = ch0 + 8 * cg8;
      float w[4][8], bias[8];
#pragma unroll
      for (int j = 0; j < 4; ++j) { const f32x4 a = *(const f32x4*)(conv_w + j * DR + c), b = *(const f32x4*)(conv_w + j * DR + c + 4);
        w[j][0] = a.x; w[j][1] = a.y; w[j][2] = a.z; w[j][3] = a.w; w[j][4] = b.x; w[j][5] = b.y; w[j][6] = b.z; w[j][7] = b.w; }
      { const f32x4 a = *(const f32x4*)(conv_b + c), b = *(const f32x4*)(conv_b + c + 4);
        bias[0] = a.x; bias[1] = a.y; bias[2] = a.z; bias[3] = a.w; bias[4] = b.x; bias[5] = b.y; bias[6] = b.z; bias[7] = b.w; }
      float win[4][8];
      auto ldrow = [&](int r, float (&dst)[8]) {
        if (r >= seg_lo && r < seg_hi) { const u32x4 v = *(const u32x4*)(pr + (size_t)r * DR + c);
          dst[0] = bflo(v.x); dst[1] = bfhi(v.x); dst[2] = bflo(v.y); dst[3] = bfhi(v.y); dst[4] = bflo(v.z); dst[5] = bfhi(v.z); dst[6] = bflo(v.w); dst[7] = bfhi(v.w); }
        else {
#pragma unroll
          for (int e = 0; e < 8; ++e) dst[e] = 0.f; }
      };
      const int rb = r0 + rg * 4;
      ldrow(rb - 2, win[0]); ldrow(rb - 1, win[1]); ldrow(rb, win[2]);
#pragma unroll
      for (int t = 0; t < 4; ++t) {
        ldrow(rb + t + 1, win[(t + 3) & 3]);
        float o[8];
#pragma unroll
        for (int e = 0; e < 8; ++e) o[e] = bias[e] + w[0][e] * win[t & 3][e] + w[1][e] * win[(t + 1) & 3][e] + w[2][e] * win[(t + 2) & 3][e] + w[3][e] * win[(t + 3) & 3][e];
        u32x4 ov; ov.x = pk2(o[0], o[1]); ov.y = pk2(o[2], o[3]); ov.z = pk2(o[4], o[5]); ov.w = pk2(o[6], o[7]);
        *(u32x4*)(As + (rg * 4 + t) * RG_AS_STRIDE + cg8 * 16) = ov;
      }
    }
    u32x2 hfk[RG_MT][2];
#pragma unroll
    for (int d = 0; d < 2; ++d) {
      f32x4 accA[RG_MT][2], accX[RG_MT][2];
#pragma unroll
      for (int which = 0; which < 2; ++which) {
        const float* W = (which ? p.in[13] : p.in[11]) + (size_t)(d * 10 + hb) * 16384;
        __syncthreads();
#pragma unroll 1
        for (int ib = 0; ib < 4; ++ib) {
#pragma unroll
          for (int ii = 0; ii < 4; ++ii) {
            const int f = tid + 256 * (ib * 4 + ii), k = f >> 5, n = 4 * (f & 31);
            const f32x4 v = *(const f32x4*)(W + k * 128 + n);
            u32x2 o; o.x = pk2(v.x, v.y); o.y = pk2(v.z, v.w);
            *(u32x2*)(Bs + bs_off(k, n)) = o;
          }
        }
        __syncthreads();
        f32x4 (&acc)[RG_MT][2] = which ? accX : accA;
#pragma unroll
        for (int m = 0; m < RG_MT; ++m) { acc[m][0] = (f32x4){0.f, 0.f, 0.f, 0.f}; acc[m][1] = (f32x4){0.f, 0.f, 0.f, 0.f}; }
#pragma unroll
        for (int ks = 0; ks < 4; ++ks) {
          bf16x8 b[2];
#pragma unroll
          for (int n = 0; n < 2; ++n) {
            const int ncol = wave * 32 + n * 16 + 4 * p4;
            const s16x4 lo = ldtr(Bs + bs_off(ks * 32 + fq * 8 + q4, ncol));
            const s16x4 hi = ldtr(Bs + bs_off(ks * 32 + fq * 8 + 4 + q4, ncol));
            b[n] = (bf16x8){lo.x, lo.y, lo.z, lo.w, hi.x, hi.y, hi.z, hi.w};
          }
#pragma unroll
          for (int m = 0; m < RG_MT; ++m) {
            const bf16x8 a = *(const bf16x8*)(As + (m * 16 + fr) * RG_AS_STRIDE + (ks * 32 + fq * 8) * 2);
            acc[m][0] = __builtin_amdgcn_mfma_f32_16x16x32_bf16(a, b[0], acc[m][0], 0, 0, 0);
            acc[m][1] = __builtin_amdgcn_mfma_f32_16x16x32_bf16(a, b[1], acc[m][1], 0, 0, 0);
          }
        }
      }
#pragma unroll
      for (int n = 0; n < 2; ++n) {
        const int cl = wave * 32 + n * 16 + fr, ch = ch0 + cl;
        const float ba = p.in[12][d * DR + ch], bx = p.in[14][d * DR + ch], lam = p.in[15][d * DR + ch];
        const float nl = -lam;
        const float sp = nl > 20.f ? nl : log1pf(__expf(nl));
        const float c8 = -8.f * sp;
#pragma unroll
        for (int m = 0; m < RG_MT; ++m)
#pragma unroll
          for (int j = 0; j < 4; ++j) {
            const int row = m * 16 + fq * 4 + j;
            const float r = sigmoidf_(accA[m][n][j] + ba), ig = sigmoidf_(accX[m][n][j] + bx);
            const float la = c8 * r;
            const float a = __expf(la);
            const float x2 = 2.f * la;
            const float om = x2 > -0.1f ? -x2 * (1.f + x2 * (0.5f + x2 * (0.16666667f + x2 * 0.041666668f))) : 1.f - a * a;
            const float mult = sqrtf(om);
            const float uu = bf2f(*(const bf16_t*)(As + row * RG_AS_STRIDE + cl * 2));
            accA[m][n][j] = a; accX[m][n][j] = mult * ig * uu;
            if (j == 3) __builtin_amdgcn_sched_barrier(0);
          }
      }
      float aggP[2], aggH[2];
      if (d == 0) rg_scan<false, 2>(accA, accX, aggP, aggH); else rg_scan<true, 2>(accA, accX, aggP, aggH);
      if (fq == 0) {
#pragma unroll
        for (int n = 0; n < 2; ++n) {
          const int ch = ch0 + wave * 32 + n * 16 + fr;
          float* ag = agg + ((size_t)(d * NRT + tile) * DR + ch) * 2;
          ag[0] = aggP[n]; ag[1] = aggH[n];
        }
      }
      bf16_t* Pout = d ? Pbb : Pfb;
#pragma unroll
      for (int m = 0; m < RG_MT; ++m)
#pragma unroll
        for (int n = 0; n < 2; ++n) {
          if (d == 0) { hfk[m][n].x = pk2(accX[m][n][0], accX[m][n][1]); hfk[m][n].y = pk2(accX[m][n][2], accX[m][n][3]); }
          else { accX[m][n][0] += bflo(hfk[m][n].x); accX[m][n][1] += bfhi(hfk[m][n].x); accX[m][n][2] += bflo(hfk[m][n].y); accX[m][n][3] += bfhi(hfk[m][n].y); }
#pragma unroll
          for (int j = 0; j < 4; ++j) {
            const unsigned o = (unsigned)(r0 + m * 16 + fq * 4 + j) * DR + ch0 + wave * 32 + n * 16 + fr;
            Pout[o] = f2bf(accA[m][n][j]);
            if (d == 1) Sb[o] = f2bf(accX[m][n][j]);
          }
          __builtin_amdgcn_sched_barrier(0);
        }
    }
  }
}

DEV void ph_rg_scan2(const Params& p, char* smem) {
  int tid = threadIdx.x; asm volatile("" : "+v"(tid));
  const int lane = tid & 63, wave = tid >> 6, fr = lane & 15, fq = lane >> 4;
  const bf16_t* pr = (const bf16_t*)(p.ws + WS_PR);
  bf16_t* Sb = (bf16_t*)(p.ws + WS_S); bf16_t* Pfb = (bf16_t*)(p.ws + WS_PF); bf16_t* Pbb = (bf16_t*)(p.ws + WS_PB);
  float* agg = (float*)(p.ws + WS_AGG);
  const bf16_t* WAX = (const bf16_t*)(p.ws + WS_WAXT);
  const float* conv_w = p.in[9]; const float* conv_b = p.in[10];
  const int NU = NRT * 10;
  const int u0 = (int)((long)blockIdx.x * NU / gridDim.x), u1 = (int)((long)(blockIdx.x + 1) * NU / gridDim.x);
  int cur_hb = -1;
  bf16x8 bfr[4][4];
  float cba[2], cbx[2], cc8[2];
#pragma unroll 1
  for (int u = u0; u < u1; ++u) {
    const int hb = u / NRT, tile = u - hb * NRT, r0 = tile * RGT, ch0 = hb * 128;
    const int seg_lo = tile < NRT_LAT ? 0 : NL, seg_hi = tile < NRT_LAT ? NL : T;
    char* As = smem + ((u - u0) & 1) * (RGT * RG_AS_STRIDE);
    if (hb != cur_hb) {
      cur_hb = hb;
#pragma unroll
      for (int mat = 0; mat < 4; ++mat)
#pragma unroll
        for (int ks = 0; ks < 4; ++ks)
          bfr[mat][ks] = *(const bf16x8*)(WAX + (size_t)(((mat >> 1) * 10 + hb) * 2 + (mat & 1)) * 16384 + (16 * wave + fr) * 128 + ks * 32 + fq * 8);
#pragma unroll
      for (int d = 0; d < 2; ++d) {
        const int ch = ch0 + 16 * wave + fr;
        cba[d] = p.in[12][d * DR + ch]; cbx[d] = p.in[14][d * DR + ch];
        const float nl = -p.in[15][d * DR + ch];
        cc8[d] = -8.f * (nl > 20.f ? nl : log1pf(__expf(nl)));
      }
    }
    {
      const int cg8 = tid & 15, rg = tid >> 4, c = ch0 + 8 * cg8;
      float w[4][8], bias[8];
#pragma unroll
      for (int j = 0; j < 4; ++j) { const f32x4 a = *(const f32x4*)(conv_w + j * DR + c), b = *(const f32x4*)(conv_w + j * DR + c + 4);
        w[j][0] = a.x; w[j][1] = a.y; w[j][2] = a.z; w[j][3] = a.w; w[j][4] = b.x; w[j][5] = b.y; w[j][6] = b.z; w[j][7] = b.w; }
      { const f32x4 a = *(const f32x4*)(conv_b + c), b = *(const f32x4*)(conv_b + c + 4);
        bias[0] = a.x; bias[1] = a.y; bias[2] = a.z; bias[3] = a.w; bias[4] = b.x; bias[5] = b.y; bias[6] = b.z; bias[7] = b.w; }
      float win[5][8];
      const int rb = r0 + rg * 2;
#pragma unroll
      for (int t = 0; t < 5; ++t) {
        const int r = rb - 2 + t;
        if (r >= seg_lo && r < seg_hi) { const u32x4 v = *(const u32x4*)(pr + (size_t)r * DR + c);
          win[t][0] = bflo(v.x); win[t][1] = bfhi(v.x); win[t][2] = bflo(v.y); win[t][3] = bfhi(v.y); win[t][4] = bflo(v.z); win[t][5] = bfhi(v.z); win[t][6] = bflo(v.w); win[t][7] = bfhi(v.w); }
        else {
#pragma unroll
          for (int e = 0; e < 8; ++e) win[t][e] = 0.f; }
      }
#pragma unroll
      for (int t = 0; t < 2; ++t) {
        float o[8];
#pragma unroll
        for (int e = 0; e < 8; ++e) o[e] = bias[e] + w[0][e] * win[t][e] + w[1][e] * win[t + 1][e] + w[2][e] * win[t + 2][e] + w[3][e] * win[t + 3][e];
        u32x4 ov; ov.x = pk2(o[0], o[1]); ov.y = pk2(o[2], o[3]); ov.z = pk2(o[4], o[5]); ov.w = pk2(o[6], o[7]);
        *(u32x4*)(As + (rg * 2 + t) * RG_AS_STRIDE + cg8 * 16) = ov;
      }
    }
    __syncthreads();
    f32x4 acc[4][RG_MT][1];
#pragma unroll
    for (int mat = 0; mat < 4; ++mat)
#pragma unroll
      for (int m = 0; m < RG_MT; ++m) acc[mat][m][0] = (f32x4){0.f, 0.f, 0.f, 0.f};
#pragma unroll
    for (int ks = 0; ks < 4; ++ks)
#pragma unroll
      for (int m = 0; m < RG_MT; ++m) {
        const bf16x8 a = *(const bf16x8*)(As + (m * 16 + fr) * RG_AS_STRIDE + (ks * 32 + fq * 8) * 2);
#pragma unroll
        for (int mat = 0; mat < 4; ++mat) acc[mat][m][0] = __builtin_amdgcn_mfma_f32_16x16x32_bf16(a, bfr[mat][ks], acc[mat][m][0], 0, 0, 0);
      }
    const int cl = 16 * wave + fr;
#pragma unroll
    for (int d = 0; d < 2; ++d) {
      f32x4 (&accA)[RG_MT][1] = acc[d * 2]; f32x4 (&accX)[RG_MT][1] = acc[d * 2 + 1];
#pragma unroll
      for (int m = 0; m < RG_MT; ++m) {
#pragma unroll
        for (int j = 0; j < 4; ++j) {
          const int row = m * 16 + fq * 4 + j;
          const float r = sigmoidf_(accA[m][0][j] + cba[d]), ig = sigmoidf_(accX[m][0][j] + cbx[d]);
          const float la = cc8[d] * r;
          const float a = fexp_(la);
          const float x2 = 2.f * la;
          const float om = x2 > -0.1f ? -x2 * (1.f + x2 * (0.5f + x2 * (0.16666667f + x2 * 0.041666668f))) : 1.f - a * a;
          const float uu = bf2f(*(const bf16_t*)(As + row * RG_AS_STRIDE + cl * 2));
          accA[m][0][j] = a; accX[m][0][j] = __builtin_amdgcn_sqrtf(om) * ig * uu;
        }
        __builtin_amdgcn_sched_barrier(0);
      }
      float aggP[1], aggH[1];
      if (d == 0) rg_scan<false, 1>(accA, accX, aggP, aggH); else rg_scan<true, 1>(accA, accX, aggP, aggH);
      if (fq == 0) { float* ag = agg + ((size_t)(d * NRT + tile) * DR + ch0 + cl) * 2; ag[0] = aggP[0]; ag[1] = aggH[0]; }
      bf16_t* Pout = d ? Pbb : Pfb;
#pragma unroll
      for (int m = 0; m < RG_MT; ++m) {
        if (d == 1) accX[m][0] += acc[1][m][0];
#pragma unroll
        for (int j = 0; j < 4; ++j) {
          const unsigned o = (unsigned)(r0 + m * 16 + fq * 4 + j) * DR + ch0 + cl;
          Pout[o] = f2bf(accA[m][0][j]);
          if (d == 1) Sb[o] = f2bf(accX[m][0][j]);
        }
      }
    }
  }
  __syncthreads();
}

DEV void ph_rg_carry(const Params& p, int bid, int nb) {
  const float* agg = (const float*)(p.ws + WS_AGG); float* carry = (float*)(p.ws + WS_CARRY);
  for (int i = bid * 256 + tidx(); i < 2 * DR; i += nb * 256) {
    const int d = i / DR, ch = i % DR;
    float st = 0.f;
#pragma unroll 1
    for (int sb = 0; sb < NRT; sb += 26) {
      float ap[26], ah[26];
#pragma unroll
      for (int j = 0; j < 26; ++j) {
        const int s = sb + j;
        const int tile = d == 0 ? (s < (NRT - NRT_LAT) ? NRT_LAT + s : s - (NRT - NRT_LAT)) : NRT - 1 - s;
        const float* ag = agg + ((size_t)(d * NRT + tile) * DR + ch) * 2;
        ap[j] = ag[0]; ah[j] = ag[1];
      }
#pragma unroll
      for (int j = 0; j < 26; ++j) {
        const int s = sb + j;
        const int tile = d == 0 ? (s < (NRT - NRT_LAT) ? NRT_LAT + s : s - (NRT - NRT_LAT)) : NRT - 1 - s;
        carry[(size_t)(d * NRT + tile) * DR + ch] = st;
        st = ap[j] * st + ah[j];
      }
    }
  }
}

DEV void ph_rg_final(const Params& p, int bid, int nb) {
  const bf16_t* gg = (const bf16_t*)(p.ws + WS_GG); const bf16_t* Sb = (const bf16_t*)(p.ws + WS_S);
  const bf16_t* Pfb = (const bf16_t*)(p.ws + WS_PF); const bf16_t* Pbb = (const bf16_t*)(p.ws + WS_PB);
  const float* carry = (const float*)(p.ws + WS_CARRY);
  bf16_t* y = (bf16_t*)(p.ws + WS_PR);
  const int total = T * (DR / 8);
  for (int i = bid * 256 + tidx(); i < total; i += nb * 256) {
    const int r = i / 160, c = (i % 160) * 8, tile = r / RGT;
    const size_t o = (size_t)r * DR + c;
    const u32x4 g = *(const u32x4*)(gg + o), s = *(const u32x4*)(Sb + o), pf = *(const u32x4*)(Pfb + o), pb = *(const u32x4*)(Pbb + o);
    const float* cf = carry + (size_t)tile * DR + c; const float* cb = carry + (size_t)(NRT + tile) * DR + c;
    const f32x4 cf0 = *(const f32x4*)cf, cf1 = *(const f32x4*)(cf + 4), cb0 = *(const f32x4*)cb, cb1 = *(const f32x4*)(cb + 4);
    u32x4 o4;
    o4.x = pk2(bflo(g.x) * (bflo(s.x) + bflo(pf.x) * cf0.x + bflo(pb.x) * cb0.x), bfhi(g.x) * (bfhi(s.x) + bfhi(pf.x) * cf0.y + bfhi(pb.x) * cb0.y));
    o4.y = pk2(bflo(g.y) * (bflo(s.y) + bflo(pf.y) * cf0.z + bflo(pb.y) * cb0.z), bfhi(g.y) * (bfhi(s.y) + bfhi(pf.y) * cf0.w + bfhi(pb.y) * cb0.w));
    o4.z = pk2(bflo(g.z) * (bflo(s.z) + bflo(pf.z) * cf1.x + bflo(pb.z) * cb1.x), bfhi(g.z) * (bfhi(s.z) + bfhi(pf.z) * cf1.y + bfhi(pb.z) * cb1.y));
    o4.w = pk2(bflo(g.w) * (bflo(s.w) + bflo(pf.w) * cf1.z + bflo(pb.w) * cb1.z), bfhi(g.w) * (bfhi(s.w) + bfhi(pf.w) * cf1.w + bfhi(pb.w) * cb1.w));
    *(u32x4*)(y + o) = o4;
  }
}

using pg8::Unit;
struct EpiRgIn {
  static constexpr bool PERM = true, AFTER_DRAIN = false;
  bf16_t* gg; bf16_t* pr;
  DEV void operator()(const f32x4 (&acc)[2][2][4][2], const Unit& u, int wr, int wc, int fr, int fq) const {
    const int row0 = u.pm * 256 + wr * 64 + fr, c0 = u.pn * 256 + wc * 32 + 8 * fq;
    const bool gate = u.pn < 5;
#pragma unroll
    for (int ai = 0; ai < 2; ++ai)
#pragma unroll
      for (int m = 0; m < 4; ++m) {
        const unsigned row = row0 + ai * 128 + m * 16;
#pragma unroll
        for (int bj = 0; bj < 2; ++bj) {
          f32x4 v0 = acc[ai][bj][m][0], v1 = acc[ai][bj][m][1];
          const int col = c0 + bj * 128;
          if (gate) {
#pragma unroll
            for (int j = 0; j < 4; ++j) { v0[j] = gelu_tanh(v0[j]); v1[j] = gelu_tanh(v1[j]); }
          }
          u32x4 w; w.x = pk2(v0[0], v0[1]); w.y = pk2(v0[2], v0[3]); w.z = pk2(v1[0], v1[1]); w.w = pk2(v1[2], v1[3]);
          if (gate) *(u32x4*)(gg + row * DR + col) = w; else *(u32x4*)(pr + row * DR + col - DR) = w;
        }
      }
  }
};
template <int LAYER> struct EpiOut {
  static constexpr bool PERM = false, AFTER_DRAIN = false;
  const float* x; const float* ctx; const float* x2; const float* mods; float* x1;
  DEV void operator()(const f32x4 (&acc)[2][2][4][2], const Unit& u, int wr, int wc, int fr, int fq) const {
    const int row0 = u.pm * 256 + wr * 64 + fr, c0 = u.pn * 256 + wc * 32 + 4 * fq;
#pragma unroll
    for (int ai = 0; ai < 2; ++ai)
#pragma unroll
      for (int m = 0; m < 4; ++m) {
        const int row = row0 + ai * 128 + m * 16;
        const int trow = LAYER == 0 ? row : token_of_seqrow(row);
        const float* xin = LAYER == 0 ? (row < NL ? x + (size_t)row * D : ctx + (size_t)(row - NL) * D) : x2 + (size_t)trow * D;
        const float* gt = mods + ((LAYER == 0 && row >= NL) ? 6144 : 0) + 2048;
        float* xo = x1 + (size_t)trow * D;
#pragma unroll
        for (int bj = 0; bj < 2; ++bj)
#pragma unroll
          for (int n = 0; n < 2; ++n) {
            const int col = c0 + bj * 128 + n * 16;
            *(f32x4*)(xo + col) = *(const f32x4*)(xin + col) + *(const f32x4*)(gt + col) * acc[ai][bj][m][n];
          }
      }
  }
};
struct EpiMoe1 {
  static constexpr bool PERM = true, AFTER_DRAIN = false;
  bf16_t* Hm;
  DEV void operator()(const f32x4 (&acc)[2][2][4][2], const Unit& u, int wr, int wc, int fr, int fq) const {
    const int row0 = u.pm * 256 + wr * 64 + fr, c0 = (u.pn & 3) * 128 + wc * 32 + 8 * fq;
#pragma unroll
    for (int ai = 0; ai < 2; ++ai)
#pragma unroll
      for (int m = 0; m < 4; ++m) {
        const unsigned row = row0 + ai * 128 + m * 16;
        float h[8];
#pragma unroll
        for (int n = 0; n < 2; ++n)
#pragma unroll
          for (int j = 0; j < 4; ++j) h[n * 4 + j] = siluf_(acc[ai][0][m][n][j]) * acc[ai][1][m][n][j];
        u32x4 w; w.x = pk2(h[0], h[1]); w.y = pk2(h[2], h[3]); w.z = pk2(h[4], h[5]); w.w = pk2(h[6], h[7]);
        *(u32x4*)(Hm + row * DE + c0) = w;
      }
  }
};
struct EpiMoe2 {
  static constexpr bool PERM = true, AFTER_DRAIN = false;
  bf16_t* Y; const float* awp;
  DEV void operator()(const f32x4 (&acc)[2][2][4][2], const Unit& u, int wr, int wc, int fr, int fq) const {
    const int row0 = u.pm * 256 + wr * 64 + fr, c0 = (u.pn & 3) * 256 + wc * 32 + 8 * fq;
#pragma unroll
    for (int ai = 0; ai < 2; ++ai)
#pragma unroll
      for (int m = 0; m < 4; ++m) {
        const unsigned row = row0 + ai * 128 + m * 16;
        const float w8 = awp[row];
#pragma unroll
        for (int bj = 0; bj < 2; ++bj) {
          const f32x4 v0 = acc[ai][bj][m][0] * w8, v1 = acc[ai][bj][m][1] * w8;
          u32x4 w; w.x = pk2(v0[0], v0[1]); w.y = pk2(v0[2], v0[3]); w.z = pk2(v1[0], v1[1]); w.w = pk2(v1[2], v1[3]);
          *(u32x4*)(Y + row * D + c0 + bj * 128) = w;
        }
      }
  }
};
struct EpiMlIn {
  static constexpr bool PERM = false, AFTER_DRAIN = false;
  bf16_t* qb; bf16_t* kb; bf16_t* kT; bf16_t* vT; bf16_t* og;
  DEV void operator()(const f32x4 (&acc)[2][2][4][2], const Unit& u, int wr, int wc, int fr, int fq) const {
    const unsigned row0 = u.pm * 256 + wr * 64 + fr, c0 = u.pn * 256 + wc * 32 + 4 * fq;
    const int pn = u.pn;
#define MLIN_LOOP(BODY) _Pragma("unroll") for (int ai = 0; ai < 2; ++ai) _Pragma("unroll") for (int m = 0; m < 4; ++m) { const unsigned row = row0 + ai * 128 + m * 16; \
      _Pragma("unroll") for (int bj = 0; bj < 2; ++bj) _Pragma("unroll") for (int n = 0; n < 2; ++n) { const f32x4 v = acc[ai][bj][m][n]; const unsigned col = c0 + bj * 128 + n * 16; BODY } }
    if (pn < 2) {
      MLIN_LOOP({ u32x2 o; o.x = pk2(v[0] * 0.125f, v[1] * 0.125f); o.y = pk2(v[2] * 0.125f, v[3] * 0.125f); *(u32x2*)(qb + row * 512 + col) = o; })
    } else if (pn < 4) {
      MLIN_LOOP({ u32x2 o; o.x = pk2(v[0], v[1]); o.y = pk2(v[2], v[3]); *(u32x2*)(kb + row * 512 + col - 512) = o;
        bf16_t* kp = kT + (col - 512) * T + row;
        kp[0] = (bf16_t)(o.x & 0xffffu); kp[T] = (bf16_t)(o.x >> 16); kp[2 * T] = (bf16_t)(o.y & 0xffffu); kp[3 * T] = (bf16_t)(o.y >> 16); })
    } else if (pn < 8) {
      MLIN_LOOP({ u32x2 o; o.x = pk2(v[0], v[1]); o.y = pk2(v[2], v[3]);
        bf16_t* vp = vT + (col - 1024) * T + row;
        vp[0] = (bf16_t)(o.x & 0xffffu); vp[T] = (bf16_t)(o.x >> 16); vp[2 * T] = (bf16_t)(o.y & 0xffffu); vp[3 * T] = (bf16_t)(o.y >> 16); })
    } else {
      MLIN_LOOP({ u32x2 o; o.x = pk2(sigmoidf_(v[0]), sigmoidf_(v[1])); o.y = pk2(sigmoidf_(v[2]), sigmoidf_(v[3])); *(u32x2*)(og + row * D + col - 2048) = o; })
    }
#undef MLIN_LOOP
  }
};

struct MoeOrder {
  const int* tb; int ntn, G, c;
  DEV bool next(int i, Unit& u) const {
    const int L = i * G + c; if (L >= tb[32]) return false;
    int e = 0;
#pragma unroll 1
    for (int k = 1; k < 32; ++k) e = (L >= tb[k]) ? k : e;
    const int r = L - tb[e], mt = (tb[e + 1] - tb[e]) / ntn;
    u.pm = tb[33 + e] + r % mt; u.pn = e * ntn + r / mt; return true;
  }
  DEV void a_ready(const Unit&) const {}
  DEV void done(const Unit&) const {}
};
constexpr int LDS_TB = 131072;
DEV void moe_tables(const int* cnt, char* smem, int ntn) {
  int* tb = (int*)(smem + LDS_TB);
  if (threadIdx.x == 0) {
    int ub = 0, rb = 0;
    for (int e = 0; e < 32; ++e) { const int m = (cnt[e * CNT_STRIDE] + 255) >> 8; tb[e] = ub; tb[33 + e] = rb; ub += m * ntn; rb += m; }
    tb[32] = ub; tb[65] = rb;
  }
  __syncthreads();
}

template <int NT>
DEV void wave_gemm16(const bf16_t* A, int lda, const bf16_t* Bt, int ldb, int ks0, int ks1, f32x4 (&acc)[NT]) {
  const int lane = tidf() & 63, fr = lane & 15, fq = lane >> 4;
  const bf16_t* ap = A + (size_t)fr * lda + fq * 8; const bf16_t* bp = Bt + (size_t)fr * ldb + fq * 8;
#pragma unroll 4
  for (int ks = ks0; ks < ks1; ++ks) {
    const bf16x8 a = *(const bf16x8*)(ap + ks * 32);
#pragma unroll
    for (int n = 0; n < NT; ++n) {
      const bf16x8 b = *(const bf16x8*)(bp + (size_t)n * 16 * ldb + ks * 32);
      acc[n] = __builtin_amdgcn_mfma_f32_16x16x32_bf16(a, b, acc[n], 0, 0, 0);
    }
  }
}
DEV void ph_out0_ctx(const Params& p, char* smem) {
  const int tf = tidf(), lane = tf & 63, wv = tf >> 6, fr = lane & 15, fq = lane >> 4;
  const int b = blockIdx.x;
  f32x4* red = (f32x4*)smem;
  if (b < 256) {
    const int rt = b >> 4, cg = b & 15, nt = wv & 3, kh = wv >> 2;
    f32x4 acc[1] = {(f32x4){0.f, 0.f, 0.f, 0.f}};
    wave_gemm16<1>((const bf16_t*)(p.ws + WS_PR) + (size_t)(NL + rt * 16) * DR, DR, (const bf16_t*)(p.ws + WS_WOUT) + (size_t)(cg * 64 + nt * 16) * DR, DR, kh * 20, kh * 20 + 20, acc);
    if (kh == 1) red[nt * 64 + lane] = acc[0];
    __syncthreads();
    if (kh == 0) {
      const f32x4 v = acc[0] + red[nt * 64 + lane];
      const int col = cg * 64 + nt * 16 + fr;
      const float gt = ((const float*)(p.ws + WS_MODS))[6144 + 2048 + col];
      float* x1 = (float*)(p.ws + WS_X1);
#pragma unroll
      for (int j = 0; j < 4; ++j) { const int r = rt * 16 + fq * 4 + j; x1[(size_t)(NL + r) * D + col] = p.in[2][(size_t)r * D + col] + gt * v[j]; }
    }
  } else __syncthreads();
  __syncthreads();
}
DEV void ph_mlin_small(const Params& p) {
  const int tf = tidf(), lane = tf & 63, wv = tf >> 6, fr = lane & 15, fq = lane >> 4;
  const bf16_t* hA = (const bf16_t*)(p.ws + WS_HA); const bf16_t* W = (const bf16_t*)(p.ws + WS_WML);
  bf16_t* kb = (bf16_t*)(p.ws + WS_K); bf16_t* kT = (bf16_t*)(p.ws + WS_KT); bf16_t* vT = (bf16_t*)(p.ws + WS_VT); float* gl = (float*)(p.ws + WS_GL);
  const int b = blockIdx.x;
  if (b < 192) {
    const int rt = b / 12, cg = b % 12, col0 = 512 + cg * 128 + wv * 16;
    f32x4 acc[1] = {(f32x4){0.f, 0.f, 0.f, 0.f}};
    wave_gemm16<1>(hA + (size_t)(NL + rt * 16) * D, D, W + (size_t)col0 * D, D, 0, 32, acc);
    const unsigned col = col0 + fr, row = NL + rt * 16 + fq * 4;
    u32x2 o; o.x = pk2(acc[0][0], acc[0][1]); o.y = pk2(acc[0][2], acc[0][3]);
    if (col < 1024) {
      *(u32x2*)(kT + (col - 512) * T + row) = o;
      kb[(row + 0) * 512 + col - 512] = (bf16_t)(o.x & 0xffffu); kb[(row + 1) * 512 + col - 512] = (bf16_t)(o.x >> 16);
      kb[(row + 2) * 512 + col - 512] = (bf16_t)(o.y & 0xffffu); kb[(row + 3) * 512 + col - 512] = (bf16_t)(o.y >> 16);
    } else *(u32x2*)(vT + (col - 1024) * T + row) = o;
  }
  const float* bgt = p.in[29];
  for (int u = blockIdx.x * 8 + wv; u < T / 16; u += gridDim.x * 8) {
    f32x4 acc[2] = {(f32x4){0.f, 0.f, 0.f, 0.f}, (f32x4){0.f, 0.f, 0.f, 0.f}};
    wave_gemm16<2>(hA + (size_t)(u * 16) * D, D, W + (size_t)3072 * D, D, 0, 32, acc);
#pragma unroll
    for (int n = 0; n < 2; ++n) {
      const int jj = n * 16 + fr; const float bb = bgt[jj];
#pragma unroll
      for (int j = 0; j < 4; ++j) {
        const float g = acc[n][j] + bb;
        gl[(size_t)(u * 16 + fq * 4 + j) * 32 + jj] = ((jj >> 3) & 1) ? (fminf(g, 0.f) - log1pf(__expf(-fabsf(g)))) : g;
      }
    }
  }
}

template <int WHICH>
DEV void ph_gemm_dense(const Params& p, char* smem) {
  pg8::StaticOrder S;
  LAS unsigned char* lds = (LAS unsigned char*)smem;
  if constexpr (WHICH == 0) {
    S.init(T, 2560, gridDim.x, blockIdx.x);
    EpiRgIn E{(bf16_t*)(p.ws + WS_GG), (bf16_t*)(p.ws + WS_PR)};
    pg8::gemm_phase<EpiRgIn, pg8::StaticOrder>(lds, pg8::Gemm{(const bf16_t*)(p.ws + WS_HA), (const bf16_t*)(p.ws + WS_WIN), T, 2560, 1024}, S, E, nullptr);
  } else if constexpr (WHICH == 1) {
    S.init(NL, 1024, gridDim.x, blockIdx.x);
    EpiOut<0> E{p.in[0], p.in[2], nullptr, (const float*)(p.ws + WS_MODS), (float*)(p.ws + WS_X1)};
    pg8::gemm_phase<EpiOut<0>, pg8::StaticOrder>(lds, pg8::Gemm{(const bf16_t*)(p.ws + WS_PR), (const bf16_t*)(p.ws + WS_WOUT), NL, 1024, 1280}, S, E, nullptr);
  } else if constexpr (WHICH == 2) {
    S.init(NL, 3072, gridDim.x, blockIdx.x);
    EpiMlIn E{(bf16_t*)(p.ws + WS_Q), (bf16_t*)(p.ws + WS_K), (bf16_t*)(p.ws + WS_KT), (bf16_t*)(p.ws + WS_VT), (bf16_t*)(p.ws + WS_OG)};
    pg8::gemm_phase<EpiMlIn, pg8::StaticOrder>(lds, pg8::Gemm{(const bf16_t*)(p.ws + WS_HA), (const bf16_t*)(p.ws + WS_WML), NL, 3072, 1024}, S, E, nullptr);
  } else {
    S.init(NL, 1024, gridDim.x, blockIdx.x);
    EpiOut<1> E{nullptr, nullptr, (const float*)(p.ws + WS_X2), (const float*)(p.ws + WS_MODS) + 2 * 6144, (float*)(p.ws + WS_X1)};
    pg8::gemm_phase<EpiOut<1>, pg8::StaticOrder>(lds, pg8::Gemm{(const bf16_t*)(p.ws + WS_HA), (const bf16_t*)(p.ws + WS_WMO), NL, 1024, 1024}, S, E, nullptr);
  }
}
template <int LAYER, int STAGE>
DEV void ph_gemm_moe(const Params& p, char* smem) {
  const int* cnt = (const int*)(p.ws + WS_CNT) + LAYER * 32 * CNT_STRIDE;
  moe_tables(cnt, smem, 4);
  MoeOrder S{(const int*)(smem + LDS_TB), 4, (int)gridDim.x, (int)blockIdx.x};
  LAS unsigned char* lds = (LAS unsigned char*)smem;
  if constexpr (STAGE == 0) {
    EpiMoe1 E{(bf16_t*)(p.ws + WS_HM)};
    pg8::gemm_phase<EpiMoe1, MoeOrder>(lds, pg8::Gemm{(const bf16_t*)(p.ws + WS_ABUF), (const bf16_t*)(p.ws + WS_WGU), MOE_ROWS, 32 * 1024, 1024}, S, E, nullptr);
  } else {
    EpiMoe2 E{(bf16_t*)(p.ws + WS_Y), (const float*)(p.ws + WS_AWP)};
    pg8::gemm_phase<EpiMoe2, MoeOrder>(lds, pg8::Gemm{(const bf16_t*)(p.ws + WS_HM), (const bf16_t*)(p.ws + WS_WD), MOE_ROWS, 32 * 1024, 512}, S, E, nullptr);
  }
}

template <int LAYER>
DEV void ph_scatter(const Params& p, char* smem, int bid, int nb) {
  const int tid = tidx(), lane = tid & 63, wave = tid >> 6;
  constexpr int NTOK = LAYER == 0 ? T : NL;
  const int* cnt = (const int*)(p.ws + WS_CNT) + LAYER * 32 * CNT_STRIDE;
  const int* list = (const int*)(p.ws + WS_LIST) + (size_t)LAYER * 32 * T;
  const float* aw = (const float*)(p.ws + WS_AW);
  int* pos = (int*)(p.ws + WS_POS); float* awp = (float*)(p.ws + WS_AWP);
  const bf16_t* hA = (const bf16_t*)(p.ws + WS_HA); bf16_t* Ab = (bf16_t*)(p.ws + WS_ABUF);
  int* base = (int*)smem; int* off = base + 40;
  if (tid == 0) { int b = 0, o = 0; for (int e = 0; e < 32; ++e) { base[e] = b; off[e] = o; b += cnt[e * CNT_STRIDE]; o += ((cnt[e * CNT_STRIDE] + 255) >> 8) << 8; } base[32] = b; }
  __syncthreads();
  for (int a0 = (bid * 4 + wave) * 4; a0 < 2 * NTOK; a0 += nb * 16) {
    u32x4 v0[4], v1[4]; int dsts[4], ents[4];
#pragma unroll
    for (int q = 0; q < 4; ++q) {
      const int a = a0 + q;
      int e = 0;
#pragma unroll 1
      for (int k = 1; k < 32; ++k) e = (a >= base[k]) ? k : e;
      const int i = a - base[e]; ents[q] = list[(size_t)e * T + i]; dsts[q] = off[e] + i;
    }
#pragma unroll
    for (int q = 0; q < 4; ++q) { const u32x4* src = (const u32x4*)(hA + (size_t)(ents[q] >> 1) * D); v0[q] = src[lane]; v1[q] = src[lane + 64]; }
#pragma unroll
    for (int q = 0; q < 4; ++q) {
      u32x4* d = (u32x4*)(Ab + (size_t)dsts[q] * D); d[lane] = v0[q]; d[lane + 64] = v1[q];
      if (lane == 0) { pos[ents[q]] = dsts[q]; awp[dsts[q]] = aw[ents[q]]; }
    }
  }
  __syncthreads();
}

constexpr int RT_STRIDE = 1028;
constexpr int RT_H2 = 0, RT_RED = 16 * RT_STRIDE * 4, RT_SMEM = RT_RED + 4 * 16 * 48 * 4;
template <int LAYER, bool DRY = false>
DEV void ph_router(const Params& p, char* smem, int bid, int nb) {
  const int tid = tidx(), lane = tid & 63, wave = tid >> 6;
  constexpr int NTOK = LAYER == 0 ? T : NL;
  const float* mods = (const float*)(p.ws + WS_MODS) + LAYER * 2 * 6144;
  const float* x1 = (const float*)(p.ws + WS_X1);
  bf16_t* hA = (bf16_t*)(p.ws + WS_HA);
  const float* g2 = p.in[LAYER == 0 ? 7 : 27];
  const float* Wg = p.in[LAYER == 0 ? 17 : 32]; const float* Bg = p.in[LAYER == 0 ? 18 : 33];
  const float* We = p.in[LAYER == 0 ? 19 : 34]; const float* Be = p.in[LAYER == 0 ? 20 : 35];
  int* cnt = (int*)(p.ws + WS_CNT) + LAYER * 32 * CNT_STRIDE;
  int* list = (int*)(p.ws + WS_LIST) + (size_t)LAYER * 32 * T;
  float* aw = (float*)(p.ws + WS_AW);
  float* h2s = (float*)(smem + RT_H2); float* red = (float*)(smem + RT_RED);
  for (int it = 0, iters = ((NTOK / 16) + nb - 1) / nb; it < iters; ++it) {
    int u = bid + it * nb; const bool active = u < (NTOK / 16); if (!active) u = (NTOK / 16) - 1;
    const int t0 = u * 16;
    __syncthreads();
    if (active) {
#pragma unroll
    for (int rr = 0; rr < 4; ++rr) {
      const int lr = wave * 4 + rr, t = t0 + lr;
      const float* md = mods + ((LAYER == 0 && t >= NL) ? 6144 : 0);
      const float* src = x1 + (size_t)t * D;
      f32x4 v[4]; float ss = 0.f;
#pragma unroll
      for (int i = 0; i < 4; ++i) { v[i] = *(const f32x4*)(src + 4 * lane + 256 * i); ss += v[i].x * v[i].x + v[i].y * v[i].y + v[i].z * v[i].z + v[i].w * v[i].w; }
      const float rstd = rsqrtf(wave_sum(ss) * (1.f / D) + EPS);
#pragma unroll
      for (int i = 0; i < 4; ++i) {
        const int c = 4 * lane + 256 * i;
        const f32x4 g = *(const f32x4*)(g2 + c), sh = *(const f32x4*)(md + 3072 + c), sc = *(const f32x4*)(md + 4096 + c);
        const f32x4 h = v[i] * rstd * g * (1.f + sc) + sh;
        *(f32x4*)(h2s + lr * RT_STRIDE + c) = h;
        u32x2 o; o.x = pk2(h.x, h.y); o.y = pk2(h.z, h.w);
        *(u32x2*)(hA + (size_t)t * D + c) = o;
      }
    }
    }
    __syncthreads();
    if (active) {
      f32x4 a0 = {0.f, 0.f, 0.f, 0.f}, a1 = a0, a2 = a0;
      const int tok = lane & 15, kk = lane >> 4;
      const f32x4* wr = (const f32x4*)((const float*)(p.ws + WS_WR) + (size_t)LAYER * 64 * 64 * 12) + (size_t)(wave * 16 * 64 + lane) * 3;
#pragma unroll 4
      for (int g = 0; g < 16; ++g) {
        const f32x4 w0 = wr[g * 192], w1 = wr[g * 192 + 1], w2 = wr[g * 192 + 2];
        const f32x4 a = *(const f32x4*)(h2s + tok * RT_STRIDE + (wave * 16 + g) * 16 + 4 * kk);
        a0 = __builtin_amdgcn_mfma_f32_16x16x4f32(a[0], w0[0], a0, 0, 0, 0); a1 = __builtin_amdgcn_mfma_f32_16x16x4f32(a[0], w0[1], a1, 0, 0, 0); a2 = __builtin_amdgcn_mfma_f32_16x16x4f32(a[0], w0[2], a2, 0, 0, 0);
        a0 = __builtin_amdgcn_mfma_f32_16x16x4f32(a[1], w0[3], a0, 0, 0, 0); a1 = __builtin_amdgcn_mfma_f32_16x16x4f32(a[1], w1[0], a1, 0, 0, 0); a2 = __builtin_amdgcn_mfma_f32_16x16x4f32(a[1], w1[1], a2, 0, 0, 0);
        a0 = __builtin_amdgcn_mfma_f32_16x16x4f32(a[2], w1[2], a0, 0, 0, 0); a1 = __builtin_amdgcn_mfma_f32_16x16x4f32(a[2], w1[3], a1, 0, 0, 0); a2 = __builtin_amdgcn_mfma_f32_16x16x4f32(a[2], w2[0], a2, 0, 0, 0);
        a0 = __builtin_amdgcn_mfma_f32_16x16x4f32(a[3], w2[1], a0, 0, 0, 0); a1 = __builtin_amdgcn_mfma_f32_16x16x4f32(a[3], w2[2], a1, 0, 0, 0); a2 = __builtin_amdgcn_mfma_f32_16x16x4f32(a[3], w2[3], a2, 0, 0, 0);
      }
#pragma unroll
      for (int j = 0; j < 4; ++j) {
        float* rp = red + ((wave * 16) + kk * 4 + j) * 48;
        rp[tok] = a0[j]; rp[16 + tok] = a1[j]; rp[32 + tok] = a2[j];
      }
    }
    __syncthreads();
    if (!DRY && active && tid < 16) {
      const int t = t0 + tid;
      auto lg = [&](int c) { return red[(0 * 16 + tid) * 48 + c] + red[(1 * 16 + tid) * 48 + c] + red[(2 * 16 + tid) * 48 + c] + red[(3 * 16 + tid) * 48 + c]; };
      float gl[4];
#pragma unroll
      for (int i = 0; i < 4; ++i) gl[i] = lg(32 + i) + Bg[i];
      int grp = 0; float gm = gl[0];
#pragma unroll
      for (int i = 1; i < 4; ++i) if (gl[i] > gm) { gm = gl[i]; grp = i; }
      float den = 0.f;
#pragma unroll
      for (int i = 0; i < 4; ++i) den += __expf(gl[i] - gm);
      const float psel = 1.f / den;
      float v0 = -INFINITY, v1 = -INFINITY; int i0 = 0, i1 = 0;
      for (int i = 0; i < 8; ++i) {
        const float v = lg(grp * 8 + i) + Be[grp * 8 + i];
        if (v > v0) { v1 = v0; i1 = i0; v0 = v; i0 = i; }
        else if (v > v1) { v1 = v; i1 = i; }
      }
      const float e1 = __expf(v1 - v0);
      const float w0 = psel / (1.f + e1), w1 = psel * e1 / (1.f + e1);
      const int ea = grp * 8 + i0, eb = grp * 8 + i1;
      const int pa = atomicAdd(&cnt[ea * CNT_STRIDE], 1); list[(size_t)ea * T + pa] = 2 * t;
      const int pb = atomicAdd(&cnt[eb * CNT_STRIDE], 1); list[(size_t)eb * T + pb] = 2 * t + 1;
      aw[2 * t] = w0; aw[2 * t + 1] = w1;
    }
  }
}

DEV void ph_combine0(const Params& p, int bid, int nb) {
  const int lane = tidx() & 63, wave = tidx() >> 6;
  const float* mods0 = (const float*)(p.ws + WS_MODS); const float* mods1 = mods0 + 2 * 6144;
  const float* x1 = (const float*)(p.ws + WS_X1); float* x2 = (float*)(p.ws + WS_X2);
  const bf16_t* Y = (const bf16_t*)(p.ws + WS_Y); const int* pos = (const int*)(p.ws + WS_POS);
  bf16_t* hA = (bf16_t*)(p.ws + WS_HA);
  const float* g1 = p.in[26];
  for (int t = bid * 4 + wave; t < T; t += nb * 4) {
    const float* m0 = mods0 + (t < NL ? 0 : 6144); const float* m1 = mods1 + (t < NL ? 0 : 6144);
    const int orow = t < NL ? seqrow_of_token(t) : t;
    const bf16_t* Ya = Y + (size_t)pos[2 * t] * D; const bf16_t* Yb = Y + (size_t)pos[2 * t + 1] * D;
    f32x4 v[4]; float ss = 0.f;
#pragma unroll
    for (int i = 0; i < 4; ++i) {
      const int c = 4 * lane + 256 * i;
      const f32x4 xv = *(const f32x4*)(x1 + (size_t)t * D + c), gt = *(const f32x4*)(m0 + 5120 + c);
      const u32x2 ya = *(const u32x2*)(Ya + c), yb = *(const u32x2*)(Yb + c);
      f32x4 f; f.x = bflo(ya.x) + bflo(yb.x); f.y = bfhi(ya.x) + bfhi(yb.x); f.z = bflo(ya.y) + bflo(yb.y); f.w = bfhi(ya.y) + bfhi(yb.y);
      v[i] = xv + gt * f;
      *(f32x4*)(x2 + (size_t)t * D + c) = v[i];
      ss += v[i].x * v[i].x + v[i].y * v[i].y + v[i].z * v[i].z + v[i].w * v[i].w;
    }
    const float rstd = rsqrtf(wave_sum(ss) * (1.f / D) + EPS);
#pragma unroll
    for (int i = 0; i < 4; ++i) {
      const int c = 4 * lane + 256 * i;
      const f32x4 g = *(const f32x4*)(g1 + c), sh = *(const f32x4*)(m1 + c), sc = *(const f32x4*)(m1 + 1024 + c);
      const f32x4 h = v[i] * rstd * g * (1.f + sc) + sh;
      u32x2 o; o.x = pk2(h.x, h.y); o.y = pk2(h.z, h.w);
      *(u32x2*)(hA + (size_t)orow * D + c) = o;
    }
  }
}

DEV void ml_gate_scans(const float* gl, int r0, int h, float* li_f, float* cf, float* li_b, float* cb) {
  const int tid = tidx(), lane = tid & 63, wave = tid >> 6;
  if (tid < 128) { li_f[tid] = gl[(size_t)(r0 + tid) * 32 + h]; li_b[tid] = gl[(size_t)(r0 + tid) * 32 + 16 + h]; }
  if (wave == 0) {
    const float v0 = gl[(size_t)(r0 + 2 * lane) * 32 + 8 + h], v1 = gl[(size_t)(r0 + 2 * lane + 1) * 32 + 8 + h];
    const float s = v0 + v1; float inc = s;
#pragma unroll
    for (int o = 1; o < 64; o <<= 1) { const float t = __shfl_up(inc, o); if (lane >= o) inc += t; }
    const float ex = inc - s;
    cf[2 * lane] = ex + v0; cf[2 * lane + 1] = ex + s;
  } else if (wave == 1) {
    const float v0 = gl[(size_t)(r0 + 127 - 2 * lane) * 32 + 24 + h], v1 = gl[(size_t)(r0 + 126 - 2 * lane) * 32 + 24 + h];
    const float s = v0 + v1; float inc = s;
#pragma unroll
    for (int o = 1; o < 64; o <<= 1) { const float t = __shfl_up(inc, o); if (lane >= o) inc += t; }
    const float ex = inc - s;
    cb[127 - 2 * lane] = ex + v0; cb[126 - 2 * lane] = ex + s;
  }
}

constexpr int MLA_STRIDE = 272;
constexpr int MLA_AW = 0, MLA_BV = 2 * 64 * MLA_STRIDE, MLA_G = MLA_BV + 128 * MLA_STRIDE, MLA_SMEM = MLA_G + 6 * 128 * 4;
DEV void ph_ml_state(const Params& p, char* smem, int bid, int nb) {
  const int tid = tidx(), lane = tid & 63, wave = tid >> 6, fr = lane & 15, fq = lane >> 4;
  const float* gl = (const float*)(p.ws + WS_GL);
  const bf16_t* kT = (const bf16_t*)(p.ws + WS_KT); const bf16_t* vT = (const bf16_t*)(p.ws + WS_VT);
  float* UT = (float*)(p.ws + WS_UT); float* nvec = (float*)(p.ws + WS_NVEC); float* dec = (float*)(p.ws + WS_DEC);
  char* Aw = smem + MLA_AW; char* Bv = smem + MLA_BV;
  float* li_f = (float*)(smem + MLA_G); float* cf = li_f + 128; float* li_b = cf + 128; float* cb = li_b + 128; float* wf = cb + 128; float* wb = wf + 128;
  for (int it = 0, iters = (NTILE * 8 + nb - 1) / nb; it < iters; ++it) {
    int u = bid + it * nb; const bool active = u < NTILE * 8; if (!active) u = NTILE * 8 - 1;
    const int h = u % 8, c = u / 8, r0 = c * 128;
    __syncthreads();
    if (active) {
    ml_gate_scans(gl, r0, h, li_f, cf, li_b, cb);
    }
    __syncthreads();
    if (active) {
    if (tid < 128) { wf[tid] = __expf(cf[127] - cf[tid] + li_f[tid]); wb[tid] = __expf(cb[0] - cb[tid] + li_b[tid]); }
    if (tid == 0) { dec[(c * 8 + h) * 2] = __expf(cf[127]); dec[(c * 8 + h) * 2 + 1] = __expf(cb[0]); }
#pragma unroll
    for (int i = 0; i < 8; ++i) {
      const int f = tid + 256 * i, e = f >> 4, pc = f & 15;
      *(u32x4*)(Bv + e * MLA_STRIDE + pc * 16) = *(const u32x4*)(vT + (size_t)(h * 128 + e) * T + r0 + pc * 8);
    }
    }
    __syncthreads();
    if (active) {
#pragma unroll
    for (int i = 0; i < 4; ++i) {
      const int f = tid + 256 * i, d = f >> 4, pc = f & 15;
      const u32x4 kv = *(const u32x4*)(kT + (size_t)(h * 64 + d) * T + r0 + pc * 8);
      float k8[8] = {bflo(kv.x), bfhi(kv.x), bflo(kv.y), bfhi(kv.y), bflo(kv.z), bfhi(kv.z), bflo(kv.w), bfhi(kv.w)};
      u32x4 of, ob;
      of.x = pk2(k8[0] * wf[pc * 8 + 0], k8[1] * wf[pc * 8 + 1]); of.y = pk2(k8[2] * wf[pc * 8 + 2], k8[3] * wf[pc * 8 + 3]);
      of.z = pk2(k8[4] * wf[pc * 8 + 4], k8[5] * wf[pc * 8 + 5]); of.w = pk2(k8[6] * wf[pc * 8 + 6], k8[7] * wf[pc * 8 + 7]);
      ob.x = pk2(k8[0] * wb[pc * 8 + 0], k8[1] * wb[pc * 8 + 1]); ob.y = pk2(k8[2] * wb[pc * 8 + 2], k8[3] * wb[pc * 8 + 3]);
      ob.z = pk2(k8[4] * wb[pc * 8 + 4], k8[5] * wb[pc * 8 + 5]); ob.w = pk2(k8[6] * wb[pc * 8 + 6], k8[7] * wb[pc * 8 + 7]);
      *(u32x4*)(Aw + d * MLA_STRIDE + pc * 16) = of;
      *(u32x4*)(Aw + (64 + d) * MLA_STRIDE + pc * 16) = ob;
    }
    }
    __syncthreads();
    if (active) {
    if (tid < 128) {
      float s = 0.f;
      for (int pc = 0; pc < 16; ++pc) { const u32x4 v = *(const u32x4*)(Aw + tid * MLA_STRIDE + pc * 16);
        s += (bflo(v.x) + bfhi(v.x)) + (bflo(v.y) + bfhi(v.y)) + (bflo(v.z) + bfhi(v.z)) + (bflo(v.w) + bfhi(v.w)); }
      nvec[(size_t)((c * 8 + h) * 2 + (tid >> 6)) * 64 + (tid & 63)] = s;
    }
#pragma unroll
    for (int dir = 0; dir < 2; ++dir) {
      f32x4 acc[4][2];
#pragma unroll
      for (int m = 0; m < 4; ++m) { acc[m][0] = (f32x4){0.f, 0.f, 0.f, 0.f}; acc[m][1] = (f32x4){0.f, 0.f, 0.f, 0.f}; }
#pragma unroll
      for (int ks = 0; ks < 4; ++ks) {
        bf16x8 b[2];
#pragma unroll
        for (int n = 0; n < 2; ++n) b[n] = *(const bf16x8*)(Bv + (wave * 32 + n * 16 + fr) * MLA_STRIDE + (ks * 32 + fq * 8) * 2);
#pragma unroll
        for (int m = 0; m < 4; ++m) {
          const bf16x8 a = *(const bf16x8*)(Aw + (dir * 64 + m * 16 + fr) * MLA_STRIDE + (ks * 32 + fq * 8) * 2);
          acc[m][0] = __builtin_amdgcn_mfma_f32_16x16x32_bf16(a, b[0], acc[m][0], 0, 0, 0);
          acc[m][1] = __builtin_amdgcn_mfma_f32_16x16x32_bf16(a, b[1], acc[m][1], 0, 0, 0);
        }
      }
      float* Uo = UT + (size_t)((c * 8 + h) * 2 + dir) * 8192;
#pragma unroll
      for (int m = 0; m < 4; ++m)
#pragma unroll
        for (int n = 0; n < 2; ++n) *(f32x4*)(Uo + (wave * 32 + n * 16 + fr) * 64 + m * 16 + fq * 4) = acc[m][n];
    }
    }
  }
}

DEV void ph_ml_chain(const Params& p, int bid, int nb) {
  float* UT = (float*)(p.ws + WS_UT); float* nvec = (float*)(p.ws + WS_NVEC); const float* dec = (const float*)(p.ws + WS_DEC);
  const int total = 16 * (8192 + 64);
  for (int i = bid * 256 + tidx(); i < total; i += nb * 256) {
    const int hd = i / 8256, idx = i % 8256;
    const int dir = hd & 1;
    float* base = idx < 8192 ? UT + (size_t)hd * 8192 + idx : nvec + (size_t)hd * 64 + (idx - 8192);
    const size_t cstride = idx < 8192 ? (size_t)16 * 8192 : (size_t)16 * 64;
    float st = 0.f;
#pragma unroll 1
    for (int sb = 0; sb < NTILE; sb += 13) {
      float uv[13], dc[13];
#pragma unroll
      for (int j = 0; j < 13; ++j) {
        const int s = sb + j; const int c = dir == 0 ? (s < 2 ? 128 + s : s - 2) : 129 - s;
        uv[j] = base[(size_t)c * cstride]; dc[j] = dec[c * 16 + hd];
      }
#pragma unroll
      for (int j = 0; j < 13; ++j) {
        const int s = sb + j; const int c = dir == 0 ? (s < 2 ? 128 + s : s - 2) : 129 - s;
        base[(size_t)c * cstride] = st;
        st = dc[j] * st + uv[j];
      }
    }
  }
}

constexpr int MLC_QS = 0;
constexpr int MLC_KS = 9216;
constexpr int MLC_Q2 = MLC_KS + 18432;
constexpr int MLC_BS = MLC_Q2 + 17408;
constexpr int MLC_G  = MLC_BS + 18432;
constexpr int MLC_SMEM = MLC_G + (4 * 128 + 6 * 64) * 4;
DEV void ph_ml_out(const Params& p, char* smem, int bid, int nb) {
  const int tid = tidx(), lane = tid & 63, wave = tid >> 6, fr = lane & 15, fq = lane >> 4;
  const float* gl = (const float*)(p.ws + WS_GL);
  const bf16_t* qb = (const bf16_t*)(p.ws + WS_Q); const bf16_t* kb = (const bf16_t*)(p.ws + WS_K); const bf16_t* vT = (const bf16_t*)(p.ws + WS_VT);
  const bf16_t* og = (const bf16_t*)(p.ws + WS_OG);
  const float* UT = (const float*)(p.ws + WS_UT); const float* nvec = (const float*)(p.ws + WS_NVEC);
  bf16_t* yA = (bf16_t*)(p.ws + WS_HA);
  const float* ng = p.in[30];
  char* Qs = smem + MLC_QS; char* Ks = smem + MLC_KS; char* Ps = Ks; char* Q2 = smem + MLC_Q2; char* Bs = smem + MLC_BS;
  float* li_f = (float*)(smem + MLC_G); float* cf = li_f + 128; float* li_b = cf + 128; float* cb = li_b + 128;
  float* qn = cb + 128; float* sfq = qn + 128; float* sbq = sfq + 64; float* nv = sbq + 64;
  for (int it = 0, iters = ((128 * 2 * 8) + nb - 1) / nb; it < iters; ++it) {
    int u = bid + it * nb; const bool active = u < (128 * 2 * 8); if (!active) u = (128 * 2 * 8) - 1;
    const int h = u % 8, th = (u / 8) & 1, c = u / 16, r0 = c * 128, rt = r0 + th * 64;
    __syncthreads();
    ml_gate_scans(gl, r0, h, li_f, cf, li_b, cb);
    if (tid >= 128) nv[tid - 128] = nvec[(size_t)((c * 8 + h) * 2 + ((tid - 128) >> 6)) * 64 + (tid & 63)];
#pragma unroll
    for (int i = 0; i < 2; ++i) { const int f = tid + 256 * i, r = f >> 3, pc = f & 7;
      *(u32x4*)(Qs + r * 144 + pc * 16) = *(const u32x4*)(qb + (size_t)(rt + r) * 512 + h * 64 + pc * 8); }
#pragma unroll
    for (int i = 0; i < 4; ++i) { const int f = tid + 256 * i, r = f >> 3, pc = f & 7;
      *(u32x4*)(Ks + r * 144 + pc * 16) = *(const u32x4*)(kb + (size_t)(r0 + r) * 512 + h * 64 + pc * 8); }
    __syncthreads();
    if (tid < 128) {
      const int t = tid & 63, dir = tid >> 6; float s = 0.f;
      for (int pc = 0; pc < 8; ++pc) { const u32x4 v = *(const u32x4*)(Qs + t * 144 + pc * 16); const float* nn = nv + dir * 64 + pc * 8;
        s += bflo(v.x) * nn[0] + bfhi(v.x) * nn[1] + bflo(v.y) * nn[2] + bfhi(v.y) * nn[3] + bflo(v.z) * nn[4] + bfhi(v.z) * nn[5] + bflo(v.w) * nn[6] + bfhi(v.w) * nn[7]; }
      qn[dir * 64 + t] = s;
    }
    f32x4 S[8];
#pragma unroll
    for (int n = 0; n < 8; ++n) S[n] = (f32x4){0.f, 0.f, 0.f, 0.f};
#pragma unroll
    for (int ks = 0; ks < 2; ++ks) {
      const bf16x8 a = *(const bf16x8*)(Qs + (wave * 16 + fr) * 144 + (ks * 32 + fq * 8) * 2);
#pragma unroll
      for (int n = 0; n < 8; ++n) {
        const bf16x8 b = *(const bf16x8*)(Ks + (n * 16 + fr) * 144 + (ks * 32 + fq * 8) * 2);
        S[n] = __builtin_amdgcn_mfma_f32_16x16x32_bf16(a, b, S[n], 0, 0, 0);
      }
    }
    __syncthreads();
    float rfv[4], rbv[4];
    {
      float sumf[4] = {0.f, 0.f, 0.f, 0.f}, sumb[4] = {0.f, 0.f, 0.f, 0.f};
      float Sf[8][4], Sb_[8][4];
#pragma unroll
      for (int j = 0; j < 4; ++j) {
        const int tl = wave * 16 + fq * 4 + j, tc = th * 64 + tl;
        const float cft = cf[tc], cbt = cb[tc];
#pragma unroll
        for (int n = 0; n < 8; ++n) {
          const int s = n * 16 + fr;
          const float df = s <= tc ? fexp_(cft - cf[s] + li_f[s]) : 0.f;
          const float db = s >= tc ? fexp_(cbt - cb[s] + li_b[s]) : 0.f;
          Sf[n][j] = S[n][j] * df; Sb_[n][j] = S[n][j] * db;
          sumf[j] += Sf[n][j]; sumb[j] += Sb_[n][j];
        }
      }
#pragma unroll
      for (int j = 0; j < 4; ++j) {
#pragma unroll
        for (int o = 1; o < 16; o <<= 1) { sumf[j] += __shfl_xor(sumf[j], o); sumb[j] += __shfl_xor(sumb[j], o); }
        const int tl = wave * 16 + fq * 4 + j, tc = th * 64 + tl;
        const float ef = __expf(cf[tc]), eb = __expf(cb[tc]);
        const float denf = ef * qn[tl] + sumf[j], denb = eb * qn[64 + tl] + sumb[j];
        rfv[j] = __builtin_amdgcn_rcpf(fmaxf(fabsf(denf), 1.f)); rbv[j] = __builtin_amdgcn_rcpf(fmaxf(fabsf(denb), 1.f));
        if (fr == 0) { sfq[tl] = ef * rfv[j]; sbq[tl] = eb * rbv[j]; }
      }
#pragma unroll
      for (int n = 0; n < 8; ++n)
#pragma unroll
        for (int j = 0; j < 4; ++j) {
          const int tl = wave * 16 + fq * 4 + j;
          *(bf16_t*)(Ps + tl * MLA_STRIDE + (n * 16 + fr) * 2) = f2bf(Sf[n][j] * rfv[j] + Sb_[n][j] * rbv[j]);
        }
    }
    __syncthreads();
#pragma unroll
    for (int i = 0; i < 2; ++i) { const int f = tid + 256 * i, r = f >> 3, pc = f & 7;
      const u32x4 v = *(const u32x4*)(Qs + r * 144 + pc * 16); const float a = sfq[r], b = sbq[r];
      u32x4 o1, o2;
      o1.x = pk2(bflo(v.x) * a, bfhi(v.x) * a); o1.y = pk2(bflo(v.y) * a, bfhi(v.y) * a); o1.z = pk2(bflo(v.z) * a, bfhi(v.z) * a); o1.w = pk2(bflo(v.w) * a, bfhi(v.w) * a);
      o2.x = pk2(bflo(v.x) * b, bfhi(v.x) * b); o2.y = pk2(bflo(v.y) * b, bfhi(v.y) * b); o2.z = pk2(bflo(v.z) * b, bfhi(v.z) * b); o2.w = pk2(bflo(v.w) * b, bfhi(v.w) * b);
      *(u32x4*)(Q2 + r * MLA_STRIDE + pc * 16) = o1; *(u32x4*)(Q2 + r * MLA_STRIDE + 128 + pc * 16) = o2; }
    f32x4 Hh[8];
#pragma unroll
    for (int n = 0; n < 8; ++n) Hh[n] = (f32x4){0.f, 0.f, 0.f, 0.f};
#pragma unroll
    for (int kc = 0; kc < 4; ++kc) {
      __syncthreads();
      if (kc < 2) {
#pragma unroll
        for (int i = 0; i < 4; ++i) { const int f = tid + 256 * i, e = f >> 3, pc = f & 7;
          *(u32x4*)(Bs + e * 144 + pc * 16) = *(const u32x4*)(vT + (size_t)(h * 128 + e) * T + r0 + kc * 64 + pc * 8); }
      } else {
        const float* Cs = UT + (size_t)((c * 8 + h) * 2 + (kc - 2)) * 8192;
#pragma unroll
        for (int i = 0; i < 4; ++i) { const int f = tid + 256 * i, e = f >> 3, pc = f & 7;
          const f32x4 a = *(const f32x4*)(Cs + e * 64 + pc * 8), b = *(const f32x4*)(Cs + e * 64 + pc * 8 + 4);
          u32x4 o; o.x = pk2(a.x, a.y); o.y = pk2(a.z, a.w); o.z = pk2(b.x, b.y); o.w = pk2(b.z, b.w);
          *(u32x4*)(Bs + e * 144 + pc * 16) = o; }
      }
      __syncthreads();
      const char* Asrc = kc < 2 ? Ps + kc * 128 : Q2 + (kc - 2) * 128;
#pragma unroll
      for (int ks = 0; ks < 2; ++ks) {
        const bf16x8 a = *(const bf16x8*)(Asrc + (wave * 16 + fr) * MLA_STRIDE + (ks * 32 + fq * 8) * 2);
#pragma unroll
        for (int n = 0; n < 8; ++n) {
          const bf16x8 b = *(const bf16x8*)(Bs + (n * 16 + fr) * 144 + (ks * 32 + fq * 8) * 2);
          Hh[n] = __builtin_amdgcn_mfma_f32_16x16x32_bf16(a, b, Hh[n], 0, 0, 0);
        }
      }
    }
#pragma unroll
    for (int j = 0; j < 4; ++j) {
      float ss = 0.f;
#pragma unroll
      for (int n = 0; n < 8; ++n) ss += Hh[n][j] * Hh[n][j];
#pragma unroll
      for (int o = 1; o < 16; o <<= 1) ss += __shfl_xor(ss, o);
      const float rstd = rsqrtf(ss * (1.f / 128.f) + EPS);
      const size_t row = (size_t)(rt + wave * 16 + fq * 4 + j);
#pragma unroll
      for (int n = 0; n < 8; ++n) {
        const int col = h * 128 + n * 16 + fr;
        yA[row * D + col] = f2bf(Hh[n][j] * rstd * ng[col] * bf2f(og[row * D + col]));
      }
    }
  }
}

DEV void ph_final(const Params& p, int bid, int nb) {
  const int lane = tidx() & 63, wave = tidx() >> 6;
  const float* mods1 = (const float*)(p.ws + WS_MODS) + 2 * 6144;
  const float* x1 = (const float*)(p.ws + WS_X1);
  const bf16_t* Y = (const bf16_t*)(p.ws + WS_Y); const int* pos = (const int*)(p.ws + WS_POS);
  const float* gf = p.in[39];
  for (int t = bid * 4 + wave; t < NL; t += nb * 4) {
    const bf16_t* Ya = Y + (size_t)pos[2 * t] * D; const bf16_t* Yb = Y + (size_t)pos[2 * t + 1] * D;
    f32x4 v[4]; float ss = 0.f;
#pragma unroll
    for (int i = 0; i < 4; ++i) {
      const int c = 4 * lane + 256 * i;
      const f32x4 xv = *(const f32x4*)(x1 + (size_t)t * D + c), gt = *(const f32x4*)(mods1 + 5120 + c);
      const u32x2 ya = *(const u32x2*)(Ya + c), yb = *(const u32x2*)(Yb + c);
      f32x4 f; f.x = bflo(ya.x) + bflo(yb.x); f.y = bfhi(ya.x) + bfhi(yb.x); f.z = bflo(ya.y) + bflo(yb.y); f.w = bfhi(ya.y) + bfhi(yb.y);
      v[i] = xv + gt * f;
      ss += v[i].x * v[i].x + v[i].y * v[i].y + v[i].z * v[i].z + v[i].w * v[i].w;
    }
    const float rstd = rsqrtf(wave_sum(ss) * (1.f / D) + EPS);
#pragma unroll
    for (int i = 0; i < 4; ++i) {
      const int c = 4 * lane + 256 * i;
      *(f32x4*)(p.out + (size_t)t * D + c) = v[i] * rstd * *(const f32x4*)(gf + c);
    }
  }
}

#define XB_TMO      128
#define XB_XCNT(j)  (256  + 64 * (j))
#define XB_XSUB(j)  (1280 + 64 * (j))
#define XB_XGEN(j)  (2304 + 64 * (j))
#define XB_TOP      3328
#define XB_TOPGEN   3392
#define XCD_BAR_WORDS 3456
#define XB_SPIN_CAP (1u << 22)
DEV unsigned xb_ld(unsigned* p)              { return __hip_atomic_load(p, __ATOMIC_RELAXED, __HIP_MEMORY_SCOPE_AGENT); }
DEV unsigned xb_add(unsigned* p, unsigned v) { return __hip_atomic_fetch_add(p, v, __ATOMIC_RELAXED, __HIP_MEMORY_SCOPE_AGENT); }
DEV unsigned xb_xcc_id() { return (unsigned)__builtin_amdgcn_s_getreg((3 << 11) | 20) & 0xFu; }
#define XB_SPIN(cond, bar) do { unsigned _sp = 0; while (cond) { __builtin_amdgcn_s_sleep(1); \
    if ((++_sp & 255u) == 0u) { if (xb_ld(&(bar)[XB_TMO])) break; if (_sp > XB_SPIN_CAP) { atomicAdd(&(bar)[XB_TMO], 1u); break; } } } } while (0)
struct XcdBarrier { unsigned* bar; unsigned x; volatile LAS unsigned* st; };
DEV XcdBarrier xcd_barrier_post(unsigned* bar, volatile LAS unsigned* st) {
  XcdBarrier b; b.bar = bar; b.x = xb_xcc_id(); b.st = st;
  if (threadIdx.x == 0) (void)xb_add(&bar[XB_XCNT(b.x)], 1u);
  return b;
}
DEV void xcd_barrier_complete(unsigned* bar, unsigned x, unsigned& nloc, unsigned& nx) {
  const unsigned G = gridDim.x * gridDim.y * gridDim.z;
  unsigned sum, cnt, mine, sp = 0u;
  for (;;) {
    sum = 0u; cnt = 0u; mine = 0u;
#pragma unroll
    for (unsigned j = 0; j < 16; ++j) { const unsigned c = xb_ld(&bar[XB_XCNT(j)]); sum += c; cnt += (c > 0u) ? 1u : 0u; mine = (j == x) ? c : mine; }
    if (sum == G) break;
    __builtin_amdgcn_s_sleep(1);
    if ((++sp & 255u) == 0u) { if (xb_ld(&bar[XB_TMO])) break; if (sp > XB_SPIN_CAP) { atomicAdd(&bar[XB_TMO], 1u); break; } }
  }
  nloc = mine > 0u ? mine : 1u; nx = cnt > 0u ? cnt : 1u;
}
DEV void xcd_barrier(const XcdBarrier& b) {
  asm volatile("s_waitcnt vmcnt(0)" ::: "memory");
  __syncthreads();
  if (threadIdx.x == 0) {
    unsigned* bar = b.bar;
    __builtin_amdgcn_s_waitcnt(0);
    unsigned nloc = b.st[0], nx = b.st[1];
    if (nloc == 0u) { xcd_barrier_complete(bar, b.x, nloc, nx); b.st[0] = nloc; b.st[1] = nx; }
    const unsigned old = xb_add(&bar[XB_XSUB(b.x)], 1u);
    const unsigned gen = old / nloc;
    if (old + 1u == (gen + 1u) * nloc) {
      __builtin_amdgcn_fence(__ATOMIC_RELEASE, "agent");
      asm volatile("s_waitcnt vmcnt(0)" ::: "memory");
      const unsigned og = xb_add(&bar[XB_TOP], 1u);
      const unsigned tg = og / nx;
      if (og + 1u == (tg + 1u) * nx) xb_add(&bar[XB_TOPGEN], 1u);
      else XB_SPIN(xb_ld(&bar[XB_TOPGEN]) == tg, bar);
      __builtin_amdgcn_fence(__ATOMIC_ACQUIRE, "agent");
      xb_add(&bar[XB_XGEN(b.x)], 1u);
      asm volatile("s_waitcnt vmcnt(0)" ::: "memory");
    } else {
      XB_SPIN(xb_ld(&bar[XB_XGEN(b.x)]) == gen, bar);
      __builtin_amdgcn_fence(__ATOMIC_ACQUIRE, "agent");
      asm volatile("s_waitcnt vmcnt(0)" ::: "memory");
    }
  }
  __syncthreads();
}

#ifndef REP_MASK
#define REP_MASK 0u
#endif
#ifndef PROBE_PH
#define PROBE_PH -1
#endif
#ifndef PROBE_M
#define PROBE_M 4
#endif
#ifndef XBAR
#define XBAR 0
#endif
constexpr int NPHASE = 22;
constexpr int HALF_SMEM = 78336;
constexpr int LDS_ST = 2 * HALF_SMEM;
constexpr int LDS_BYTES = LDS_ST + 16 + 32;
static_assert(RT_SMEM <= HALF_SMEM && RG_SMEM <= HALF_SMEM && MLA_SMEM <= HALF_SMEM && MLC_SMEM <= HALF_SMEM, "smem");
static_assert(LDS_TB + 66 * 4 <= LDS_ST && 8 * 8448 <= LDS_ST, "smem");

template <int PH>
DEV void run_phase(const Params& p, char* smem) {
  int half = threadIdx.x >> 8; asm volatile("" : "+v"(half)); half = __builtin_amdgcn_readfirstlane(half);
  char* hs = smem + half * HALF_SMEM;
  const int vb = blockIdx.x * 2 + half, nvb = gridDim.x * 2;
  if constexpr (PH == 0) { ph_adaln(p, hs, vb, nvb); __syncthreads(); ph_convert_dense(p, smem); ph_convert_moe<0>(p, smem); }
  else if constexpr (PH == 1) ph_norm0(p, vb, nvb);
  else if constexpr (PH == 2) ph_gemm_dense<0>(p, smem);
  else if constexpr (PH == 3) ph_rg_scan2(p, smem);
  else if constexpr (PH == 4) ph_rg_carry(p, vb, nvb);
  else if constexpr (PH == 5) ph_rg_final(p, vb, nvb);
  else if constexpr (PH == 6) { ph_out0_ctx(p, smem); ph_gemm_dense<1>(p, smem); }
  else if constexpr (PH == 7) ph_router<0>(p, hs, vb, nvb);
  else if constexpr (PH == 8) ph_scatter<0>(p, hs, vb, nvb);
  else if constexpr (PH == 9) ph_gemm_moe<0, 0>(p, smem);
  else if constexpr (PH == 10) ph_gemm_moe<0, 1>(p, smem);
  else if constexpr (PH == 11) { ph_combine0(p, vb, nvb); ph_convert_moe<1>(p, smem); }
  else if constexpr (PH == 12) { ph_mlin_small(p); ph_gemm_dense<2>(p, smem); }
  else if constexpr (PH == 13) ph_ml_state(p, hs, vb, nvb);
  else if constexpr (PH == 14) ph_ml_chain(p, vb, nvb);
  else if constexpr (PH == 15) ph_ml_out(p, hs, vb, nvb);
  else if constexpr (PH == 16) ph_gemm_dense<3>(p, smem);
  else if constexpr (PH == 17) ph_router<1>(p, hs, vb, nvb);
  else if constexpr (PH == 18) ph_scatter<1>(p, hs, vb, nvb);
  else if constexpr (PH == 19) ph_gemm_moe<1, 0>(p, smem);
  else if constexpr (PH == 20) ph_gemm_moe<1, 1>(p, smem);
  else if constexpr (PH == 21) ph_final(p, vb, nvb);
}

template <int PH>
DEV void run_from(const Params& p, char* smem) {
  run_phase<PH>(p, smem);
  if constexpr ((REP_MASK >> PH) & 1u) {
    __syncthreads();
    if constexpr (PH == 7 || PH == 17) { const int half = __builtin_amdgcn_readfirstlane(threadIdx.x >> 8); if constexpr (PH == 7) ph_router<0, true>(p, smem + half * HALF_SMEM, blockIdx.x * 2 + half, gridDim.x * 2); else ph_router<1, true>(p, smem + half * HALF_SMEM, blockIdx.x * 2 + half, gridDim.x * 2); }
    else run_phase<PH>(p, smem);
  }
  if constexpr (XBAR > 0 && PH + 1 < NPHASE) {
#pragma unroll 1
    for (int xi = 0; xi < XBAR; ++xi) { XcdBarrier xb; xb.bar = (unsigned*)(p.ws + WS_BAR); xb.x = xb_xcc_id(); xb.st = (volatile LAS unsigned*)(LAS char*)(smem + LDS_ST); xcd_barrier(xb); }
  }
  if constexpr (PH + 1 < NPHASE) {
    XcdBarrier xb; xb.bar = (unsigned*)(p.ws + WS_BAR); xb.x = xb_xcc_id(); xb.st = (volatile LAS unsigned*)(LAS char*)(smem + LDS_ST);
    xcd_barrier(xb);
    if constexpr (PROBE_PH >= 0 && (PH == PROBE_PH || PH + 1 == PROBE_PH)) {
      if (blockIdx.x == 0 && threadIdx.x == 0) { volatile LAS unsigned long long* ts = (volatile LAS unsigned long long*)(LAS char*)(smem + LDS_ST + 16); ts[PH == PROBE_PH ? 1 : 0] = __builtin_amdgcn_s_memrealtime(); }
    }
    run_from<PH + 1>(p, smem);
  } else if constexpr (PROBE_PH >= 0) {
    if (blockIdx.x == 0 && threadIdx.x == 0) {
      volatile LAS unsigned long long* ts = (volatile LAS unsigned long long*)(LAS char*)(smem + LDS_ST + 16);
      const unsigned long long now = __builtin_amdgcn_s_memrealtime();
      const unsigned long long t1 = PROBE_PH == NPHASE - 1 ? now : ts[1];
      const unsigned long long span = (t1 - ts[0]) * PROBE_M;
      while (__builtin_amdgcn_s_memrealtime() - now < span) __builtin_amdgcn_s_sleep(8);
    }
  }
}

__global__ void __launch_bounds__(512) mega_kernel(Params p) {
  extern __shared__ __attribute__((aligned(16))) char smem[];
  volatile LAS unsigned* st = (volatile LAS unsigned*)(LAS char*)(smem + LDS_ST);
  if (threadIdx.x == 0) { st[0] = 0u; st[1] = 0u; st[2] = 0u; st[3] = 0u; }
  __syncthreads();
  (void)xcd_barrier_post((unsigned*)(p.ws + WS_BAR), st);
  if (PROBE_PH == 0 && blockIdx.x == 0 && threadIdx.x == 0) { volatile LAS unsigned long long* ts = (volatile LAS unsigned long long*)(LAS char*)(smem + LDS_ST + 16); ts[0] = __builtin_amdgcn_s_memrealtime(); }
  run_from<0>(p, smem);
}

extern "C" void kernel_launch(void* const* d_in, const int* in_sizes, int n_in, void* d_out, int out_size, void* d_ws, size_t ws_size, hipStream_t stream) {
  static int grid = 0;
  if (grid == 0) {
    if (n_in != 40 || ws_size < WS_END) { fprintf(stderr, "kernel_launch: unexpected inputs (n_in %d, ws %zu, need %zu)\n", n_in, ws_size, (size_t)WS_END); grid = -1; return; }
    int dev = 0, cus = 0, per_cu = 0;
    if (hipGetDevice(&dev) != hipSuccess || hipDeviceGetAttribute(&cus, hipDeviceAttributeMultiprocessorCount, dev) != hipSuccess) { grid = -1; return; }
    if (hipFuncSetAttribute((const void*)mega_kernel, hipFuncAttributeMaxDynamicSharedMemorySize, LDS_BYTES) != hipSuccess) { fprintf(stderr, "kernel_launch: hipFuncSetAttribute failed\n"); grid = -1; return; }
    if (hipOccupancyMaxActiveBlocksPerMultiprocessor(&per_cu, (const void*)mega_kernel, 512, LDS_BYTES) != hipSuccess || per_cu < 1) { fprintf(stderr, "kernel_launch: occupancy query failed (%d)\n", per_cu); grid = -1; return; }
    grid = cus;
    fprintf(stderr, "kernel_launch: %d CUs, occupancy %d\n", cus, per_cu);
  }
  if (grid < 0) return;
  Params p{};
  for (int i = 0; i < 40; ++i) p.in[i] = (const float*)d_in[i];
  p.out = (float*)d_out; p.ws = (char*)d_ws;
  if (hipMemsetAsync((char*)d_ws, 0, WS_ZERO_BYTES, stream) != hipSuccess) return;
  void* args[] = {&p};
  hipError_t e = hipLaunchCooperativeKernel((const void*)mega_kernel, dim3(grid), dim3(512), args, LDS_BYTES, stream);
  if (e != hipSuccess) fprintf(stderr, "cooperative launch failed: %s (grid %d)\n", hipGetErrorString(e), grid);
}
```

```cpp
#include <hip/hip_runtime.h>
#include <cstdio>
#include <cstdint>

#define DEV __device__ __forceinline__
typedef unsigned short bf16_t;
typedef short bf16x8 __attribute__((ext_vector_type(8)));
typedef short s16x4 __attribute__((ext_vector_type(4)));
typedef float f32x4 __attribute__((ext_vector_type(4)));
typedef unsigned u32x4 __attribute__((ext_vector_type(4)));
typedef unsigned u32x2 __attribute__((ext_vector_type(2)));
#define LAS __attribute__((address_space(3)))

constexpr int D = 1024, NL = 16384, NC = 256, T = NL + NC, NTILE = T / 128;
constexpr int DR = 1280, NEXP = 32, DE = 512;
constexpr int RGT = 64, NRT = T / RGT, NRT_LAT = NL / RGT;
constexpr int MLW = 3104, MLWP = 3328;
constexpr int MOE_ROWS = 41472;
constexpr float EPS = 1e-6f;

constexpr size_t al256(size_t x) { return (x + 255) & ~(size_t)255; }
constexpr size_t WS_BAR   = 0;
constexpr size_t WS_CNT   = 16384;
constexpr int CNT_STRIDE = 64;
constexpr size_t WS_ZERO_BYTES = 16384 + 2 * 32 * CNT_STRIDE * 4;
constexpr size_t WS_MODS  = 32768;
constexpr size_t WS_LIST  = WS_MODS + al256(2 * 2 * 6144 * 4);
constexpr size_t WS_AW    = WS_LIST + al256((size_t)2 * 32 * T * 4);
constexpr size_t WS_POS   = WS_AW + al256((size_t)2 * T * 4);
constexpr size_t WS_AWP   = WS_POS + al256((size_t)2 * T * 4);
constexpr size_t WS_AGG   = WS_AWP + al256((size_t)MOE_ROWS * 4);
constexpr size_t WS_CARRY = WS_AGG + al256((size_t)2 * NRT * DR * 2 * 4);
constexpr size_t WS_GL    = WS_CARRY + al256((size_t)2 * NRT * DR * 4);
constexpr size_t WS_NVEC  = WS_GL + al256((size_t)T * 32 * 4);
constexpr size_t WS_DEC   = WS_NVEC + al256((size_t)NTILE * 16 * 64 * 4);
constexpr size_t WS_WIN   = WS_DEC + al256((size_t)NTILE * 16 * 4);
constexpr size_t WS_WOUT  = WS_WIN + al256((size_t)2560 * 1024 * 2);
constexpr size_t WS_WML   = WS_WOUT + al256((size_t)1024 * 1280 * 2);
constexpr size_t WS_WMO   = WS_WML + al256((size_t)MLWP * 1024 * 2);
constexpr size_t WS_WGU   = WS_WMO + al256((size_t)1024 * 1024 * 2);
constexpr size_t WS_WD    = WS_WGU + al256((size_t)32 * 1024 * 1024 * 2);
constexpr size_t WS_WAXT  = WS_WD + al256((size_t)32 * 1024 * 512 * 2);
constexpr size_t WS_WR    = WS_WAXT + al256((size_t)40 * 16384 * 2);
constexpr size_t WS_HA    = WS_WR + al256((size_t)2 * 64 * 64 * 12 * 4);
constexpr size_t WS_X1    = WS_HA + al256((size_t)T * D * 2);
constexpr size_t WS_X2    = WS_X1 + al256((size_t)T * D * 2);
constexpr size_t WS_R0    = WS_X2 + al256((size_t)T * D * 2);
constexpr size_t WS_GG    = WS_R0;
constexpr size_t WS_PR    = WS_GG + al256((size_t)T * DR * 2);
constexpr size_t WS_S     = WS_PR + al256((size_t)T * DR * 2);
constexpr size_t WS_PF    = WS_S + al256((size_t)T * DR * 2);
constexpr size_t WS_PB    = WS_PF + al256((size_t)T * DR * 2);
constexpr size_t WS_R0END = WS_PB + al256((size_t)T * DR * 2);
constexpr size_t WS_ABUF  = WS_R0;
constexpr size_t WS_HM    = WS_ABUF + al256((size_t)MOE_ROWS * D * 2);
constexpr size_t WS_Y     = WS_HM + al256((size_t)MOE_ROWS * DE * 2);
constexpr size_t WS_MOEEND = WS_Y + al256((size_t)MOE_ROWS * D * 2);
constexpr size_t WS_Q     = WS_R0;
constexpr size_t WS_K     = WS_Q + al256((size_t)T * 512 * 2);
constexpr size_t WS_KT    = WS_K + al256((size_t)T * 512 * 2);
constexpr size_t WS_VT    = WS_KT + al256((size_t)T * 512 * 2);
constexpr size_t WS_OG    = WS_VT + al256((size_t)T * D * 2);
constexpr size_t WS_UT    = WS_OG + al256((size_t)T * D * 2);
constexpr size_t WS_L1END = WS_UT + al256((size_t)NTILE * 16 * 8192 * 4);
constexpr size_t cmax(size_t a, size_t b) { return a > b ? a : b; }
constexpr size_t WS_END   = cmax(cmax(WS_R0END, WS_L1END), WS_MOEEND);

struct Params {
  const float* in[40];
  float* out;
  char* ws;
};

typedef __bf16 bf16v2_t __attribute__((ext_vector_type(2)));
typedef float f32x2_t __attribute__((ext_vector_type(2)));
DEV unsigned pk2(float lo, float hi) { const f32x2_t v = {lo, hi}; return __builtin_bit_cast(unsigned, __builtin_convertvector(v, bf16v2_t)); }
DEV float bflo(unsigned u) { return __uint_as_float(u << 16); }
DEV float bfhi(unsigned u) { return __uint_as_float(u & 0xffff0000u); }
DEV float bf2f(bf16_t b) { return __uint_as_float((unsigned)b << 16); }
DEV bf16_t f2bf(float f) { return (bf16_t)(pk2(f, 0.f) & 0xffffu); }
DEV float fexp_(float x) { return __builtin_amdgcn_exp2f(x * 1.4426950408889634f); }
DEV float sigmoidf_(float x) { return __builtin_amdgcn_rcpf(1.f + __builtin_amdgcn_exp2f(x * -1.4426950408889634f)); }
DEV float siluf_(float x) { return x * sigmoidf_(x); }
DEV float gelu_tanh(float x) { const float u = 0.7978845608028654f * (x + 0.044715f * x * x * x); return x * sigmoidf_(2.f * u); }
DEV float wave_sum(float v) {
#pragma unroll
  for (int o = 1; o < 64; o <<= 1) v += __shfl_xor(v, o);
  return v;
}
DEV s16x4 ldtr(const char* p) { return __builtin_bit_cast(s16x4, __builtin_amdgcn_ds_read_tr16_b64_v4i16((LAS s16x4*)p)); }
DEV f32x4 ld_bf4(const bf16_t* p) { const u32x2 v = *(const u32x2*)p; return (f32x4){bflo(v.x), bfhi(v.x), bflo(v.y), bfhi(v.y)}; }
DEV void st_bf4(bf16_t* p, const f32x4 v) { u32x2 o; o.x = pk2(v.x, v.y); o.y = pk2(v.z, v.w); *(u32x2*)p = o; }
DEV int tidx() { int t = threadIdx.x & 255; asm volatile("" : "+v"(t)); return t; }
DEV int tidf() { int t = threadIdx.x; asm volatile("" : "+v"(t)); return t; }
DEV int seqrow_of_token(int t) { return (t & 63) * 256 + (t >> 6); }
DEV int token_of_seqrow(int s) { return (s & 255) * 64 + (s >> 8); }

constexpr int BS_STRIDE = 320;
DEV int bs_off(int k, int n) { return k * BS_STRIDE + ((((n >> 4) ^ ((k >> 3) & 1))) << 5) + (n & 15) * 2; }

namespace pg8 {
#define PG8_LAS __attribute__((address_space(3)))
typedef unsigned short bf16_t;
typedef short bf16x8 __attribute__((ext_vector_type(8)));
typedef float f32x4 __attribute__((ext_vector_type(4)));
typedef unsigned u32x4 __attribute__((ext_vector_type(4)));
constexpr int BM = 256, BK = 64, HALF = 128, HTB = HALF * BK * 2  , STAGE_BYTES = 8 * HTB, NXCD = 8, WGM = 8;

__host__ __device__ __forceinline__ int lds_byte(int r, int c) { const int st = (r >> 4) * 2 + (c >> 5), rr = r & 15, cc = c & 31, ob = rr * 64 + cc * 2; return st * 1024 + (ob ^ (((ob >> 9) & 1) << 5)); }
__host__ __device__ __forceinline__ void stage_rc(int b, int& R, int& C) { const int st = b / 1024, sb = b % 1024, swz = sb ^ (((sb >> 9) & 1) << 5); R = (st >> 1) * 16 + swz / 64; C = (st & 1) * 32 + (swz % 64) / 2; }
__host__ __device__ __forceinline__ int perm32(int rho) { const int n = rho >> 4, i = rho & 15; return 8 * (i >> 2) + 4 * n + (i & 3); }

struct Unit { int pm, pn; };
struct Gemm { const bf16_t* A; const bf16_t* Bt; int M, N, K; };

struct StaticOrder {
    int nM, nN, nwg, G, c;
    __host__ __device__ void init(int M, int N, int G_, int c_) { nM = M / BM; nN = N / BM; nwg = nM * nN; G = G_; c = c_; }
    __host__ __device__ bool next(int i, Unit& u) const {
        const long L = (long)i * G + c; if (L >= nwg) return false;
        int wgid = (int)L; { const int q = nwg / NXCD, r = nwg % NXCD, xcd = wgid % NXCD, off = wgid / NXCD; wgid = (xcd < r ? xcd * (q + 1) : r * (q + 1) + (xcd - r) * q) + off; }
        const int nig = WGM * nN, gid = wgid / nig, fm = gid * WGM, gsz = (nM - fm) < WGM ? (nM - fm) : WGM;
        u.pm = fm + ((wgid % nig) % gsz); u.pn = (wgid % nig) / gsz; return true;
    }
    __device__ __forceinline__ void a_ready(const Unit&) const {}
    __device__ __forceinline__ void done(const Unit&) const {}
};
template <class Epi, class Sched, bool STAMP = false>
__device__ __forceinline__ void gemm_phase(PG8_LAS unsigned char* lds, const Gemm g, const Sched& S, const Epi& E, unsigned long long* stamps) {
    int tid = threadIdx.x; asm volatile("" : "+v"(tid));
    const int wid = __builtin_amdgcn_readfirstlane(tid >> 6), lane = tid & 63, wr = wid >> 2, wc = wid & 3, fr = lane & 15, fq = lane >> 4;
    const int K = g.K, nt = K / BK;
    int ts_lo = 0, ts_hi = 0, nts = 0; const unsigned long long rt_entry = STAMP ? (unsigned long long)wall_clock64() : 0ull;
#define PG8_STAMP() do { if (STAMP && wid == 0 && nts < 64) { const unsigned long long _c = (unsigned long long)clock64(); \
        ts_lo = (lane == nts) ? (int)(unsigned)_c : ts_lo; ts_hi = (lane == nts) ? (int)(unsigned)(_c >> 32) : ts_hi; ++nts; } } while (0)
    PG8_STAMP();
    unsigned voffA[2], voffB[2];
#pragma unroll
    for (int i = 0; i < 2; ++i) { int R, C; stage_rc(tid * 16 + i * 8192, R, C); const int Rb = Epi::PERM ? ((R & ~31) + perm32(R & 31)) : R;
        voffA[i] = (unsigned)(R * K + C) * 2u; voffB[i] = (unsigned)(Rb * K + C) * 2u; }
    const size_t kstep = (size_t)(BK * 2);
    const size_t hstep = (size_t)HALF * K * 2;
    const size_t tstep = 2 * hstep;
    const unsigned ldsw = (unsigned)wid * 1024u;
    const int aoff = lds_byte(wr * 64 + fr, fq * 8), boff = lds_byte(wc * 32 + fr, fq * 8);
#define PG8_SA(b, h) (((b) * 2 + (h)) * HTB)
#define PG8_SB(b, h) ((4 + (b) * 2 + (h)) * HTB)
#define PG8_STAGE(bufoff, gbase, voff) do { _Pragma("unroll") for (int _i = 0; _i < 2; ++_i) \
        __builtin_amdgcn_global_load_lds((const unsigned*)((const char*)(gbase) + (voff)[_i]), (PG8_LAS unsigned*)(lds + (bufoff) + ldsw + _i * 8192), 16, 0, 0); } while (0)
#define PG8_LDA(dst, b, h) do { _Pragma("unroll") for (int m = 0; m < 4; ++m) _Pragma("unroll") for (int k = 0; k < 2; ++k) dst[m][k] = *(const PG8_LAS bf16x8*)(lds + PG8_SA(b, h) + aoff + m * 2048 + k * 1024); } while (0)
#define PG8_LDB(dst, b, h) do { _Pragma("unroll") for (int n = 0; n < 2; ++n) _Pragma("unroll") for (int k = 0; k < 2; ++k) dst[n][k] = *(const PG8_LAS bf16x8*)(lds + PG8_SB(b, h) + boff + n * 2048 + k * 1024); } while (0)
#define PG8_MMA(ai, bj, At, Bt) do { __builtin_amdgcn_s_setprio(1); _Pragma("unroll") for (int m = 0; m < 4; ++m) _Pragma("unroll") for (int n = 0; n < 2; ++n) _Pragma("unroll") for (int k = 0; k < 2; ++k) \
        acc[ai][bj][m][n] = __builtin_amdgcn_mfma_f32_16x16x32_bf16(Bt[n][k], At[m][k], acc[ai][bj][m][n], 0, 0, 0); __builtin_amdgcn_s_setprio(0); } while (0)
#define PG8_WAIT_V(n) asm volatile("s_waitcnt vmcnt(" #n ")" ::: "memory")
#define PG8_WAIT_L(n) asm volatile("s_waitcnt lgkmcnt(" #n ")" ::: "memory")
#define PG8_BAR __builtin_amdgcn_s_barrier()
#define PG8_SCHED __builtin_amdgcn_sched_barrier(0)
    Unit cur, nxt; int ui = 0;
    if (!S.next(0, cur)) return;
    f32x4 acc[2][2][4][2];
#pragma unroll
    for (int a = 0; a < 2; ++a)
#pragma unroll
        for (int b = 0; b < 2; ++b)
#pragma unroll
            for (int m = 0; m < 4; ++m)
#pragma unroll
                for (int n = 0; n < 2; ++n) acc[a][b][m][n] = (f32x4){0.f, 0.f, 0.f, 0.f};
    bf16x8 At[4][2], B0[2][2], B1[2][2];
    const char* cA = (const char*)g.A + (size_t)cur.pm * tstep; const char* cB = (const char*)g.Bt + (size_t)cur.pn * tstep;
    S.a_ready(cur);
    PG8_STAGE(PG8_SB(0, 0), cB, voffB); PG8_STAGE(PG8_SA(0, 0), cA, voffA); PG8_STAGE(PG8_SB(0, 1), cB + hstep, voffB); PG8_STAGE(PG8_SA(0, 1), cA + hstep, voffA);
    if (wr == 1) PG8_BAR;
    PG8_WAIT_V(4); PG8_BAR;
    PG8_STAGE(PG8_SB(1, 0), cB + kstep, voffB); PG8_STAGE(PG8_SA(1, 0), cA + kstep, voffA); PG8_STAGE(PG8_SB(1, 1), cB + hstep + kstep, voffB);
    PG8_WAIT_V(6); PG8_BAR;
    PG8_STAMP();
    for (;;) {
        const bool has_next = S.next(ui + 1, nxt);
        const char* nA = has_next ? (const char*)g.A + (size_t)nxt.pm * tstep : cA; const char* nB = has_next ? (const char*)g.Bt + (size_t)nxt.pn * tstep : cB;
        for (int t = 0; t < nt; t += 2) {
            const bool last = (t == nt - 2);
            const char* a1 = cA + (size_t)(t + 1) * kstep;
            const char* a2 = last ? nA : cA + (size_t)(t + 2) * kstep; const char* b2 = last ? nB : cB + (size_t)(t + 2) * kstep;
            const char* a3 = a2 + kstep; const char* b3 = b2 + kstep;
            if (last && has_next) S.a_ready(nxt);
            PG8_LDB(B0, 0, 0); PG8_SCHED; PG8_LDA(At, 0, 0); PG8_STAGE(PG8_SA(1, 1), a1 + hstep, voffA);
            PG8_WAIT_L(8); PG8_BAR; PG8_WAIT_L(0); PG8_MMA(0, 0, At, B0); PG8_BAR; PG8_SCHED;
            PG8_LDB(B1, 0, 1); PG8_STAGE(PG8_SB(0, 0), b2, voffB);
            PG8_BAR; PG8_WAIT_L(0); PG8_MMA(0, 1, At, B1); PG8_BAR;
            PG8_LDA(At, 0, 1); PG8_STAGE(PG8_SA(0, 0), a2, voffA);
            PG8_BAR; PG8_WAIT_L(0); PG8_MMA(1, 0, At, B0); PG8_BAR; PG8_SCHED;
            PG8_STAGE(PG8_SB(0, 1), b2 + hstep, voffB);
            PG8_WAIT_V(6); PG8_BAR; PG8_MMA(1, 1, At, B1); PG8_BAR;
            PG8_LDB(B0, 1, 0); PG8_SCHED; PG8_LDA(At, 1, 0); PG8_STAGE(PG8_SA(0, 1), a2 + hstep, voffA);
            PG8_WAIT_L(8); PG8_BAR; PG8_WAIT_L(0); PG8_MMA(0, 0, At, B0); PG8_BAR; PG8_SCHED;
            PG8_LDB(B1, 1, 1); PG8_STAGE(PG8_SB(1, 0), b3, voffB);
            PG8_BAR; PG8_WAIT_L(0); PG8_MMA(0, 1, At, B1); PG8_BAR;
            PG8_LDA(At, 1, 1); PG8_STAGE(PG8_SA(1, 0), a3, voffA);
            PG8_BAR; PG8_WAIT_L(0); PG8_MMA(1, 0, At, B0); PG8_BAR; PG8_SCHED;
            PG8_STAGE(PG8_SB(1, 1), b3 + hstep, voffB);
            PG8_WAIT_V(6); PG8_BAR; PG8_MMA(1, 1, At, B1); PG8_BAR;
        }
        PG8_STAMP();
        if constexpr (!Epi::AFTER_DRAIN) { E(acc, cur, wr, wc, fr, fq); S.done(cur); }
        PG8_STAMP();
        if (!has_next) break;
#pragma unroll
        for (int a = 0; a < 2; ++a)
#pragma unroll
            for (int b = 0; b < 2; ++b)
#pragma unroll
                for (int m = 0; m < 4; ++m)
#pragma unroll
                    for (int n = 0; n < 2; ++n) acc[a][b][m][n] = (f32x4){0.f, 0.f, 0.f, 0.f};
        cur = nxt; cA = nA; cB = nB; ++ui;
    }
    PG8_WAIT_V(0);
    if (wr == 0) PG8_BAR;
    PG8_BAR;
    if constexpr (Epi::AFTER_DRAIN) { E.fused(acc, cur, wr, wc, fr, fq, lds, wid, lane); S.done(cur); }
    PG8_STAMP();
    if (STAMP && wid == 0) { stamps[lane] = lane < nts ? (((unsigned long long)(unsigned)ts_hi << 32) | (unsigned)ts_lo) : 0ull;
        if (lane == 62) stamps[62] = rt_entry; if (lane == 63) stamps[63] = (unsigned long long)wall_clock64(); }
#undef PG8_STAMP
#undef PG8_SA
#undef PG8_SB
#undef PG8_STAGE
#undef PG8_LDA
#undef PG8_LDB
#undef PG8_MMA
#undef PG8_WAIT_V
#undef PG8_WAIT_L
#undef PG8_BAR
#undef PG8_SCHED
}
}

DEV void ph_adaln(const Params& p, char* smem, int bid, int nb) {
  float* sc = (float*)smem; float* sx = sc + 1024; f32x4* red = (f32x4*)(sx + 1024);
  const int tid = tidx();
  for (int i = tid; i < 1024; i += 256) { sc[i] = siluf_(p.in[1][i]); sx[i] = siluf_(p.in[3][i]); }
  __syncthreads();
  float* mods = (float*)(p.ws + WS_MODS);
  const int cl = tid & 15, kg = tid >> 4;
  for (int it = 0, iters = (192 + nb - 1) / nb; it < iters; ++it) {
    const int u = bid + it * nb; const bool active = u < 192;
    const int l = u / 96, c0 = (u % 96) * 64;
    const float* W = p.in[l ? 24 : 4]; const float* B = p.in[l ? 25 : 5];
    if (active) {
      f32x4 ac = {0.f, 0.f, 0.f, 0.f}, ax = {0.f, 0.f, 0.f, 0.f};
      const float* wp = W + (size_t)(kg * 64) * 6144 + c0 + 4 * cl;
#pragma unroll 8
      for (int kk = 0; kk < 64; ++kk) {
        const f32x4 w = *(const f32x4*)(wp + (size_t)kk * 6144);
        const float a = sc[kg * 64 + kk], b = sx[kg * 64 + kk];
        ac += a * w; ax += b * w;
      }
      red[kg * 16 + cl] = ac; red[256 + kg * 16 + cl] = ax;
    }
    __syncthreads();
    if (active && tid < 32) {
      const int which = tid >> 4, c = tid & 15;
      f32x4 s = {0.f, 0.f, 0.f, 0.f};
      for (int g = 0; g < 16; ++g) s += red[which * 256 + g * 16 + c];
      const f32x4 bb = *(const f32x4*)(B + c0 + 4 * c);
      *(f32x4*)(mods + (size_t)(l * 2 + which) * 6144 + c0 + 4 * c) = s + bb;
    }
    __syncthreads();
  }
}

DEV void transpose_item(const float* W, int N, int K, bf16_t* WT, float* scr, int k0, int n0, int lane) {
#pragma unroll 8
  for (int i = 0; i < 32; ++i) { const int kk = 2 * i + (lane >> 5); scr[kk * 33 + (lane & 31)] = W[(size_t)(k0 + kk) * N + n0 + (lane & 31)]; }
  asm volatile("s_waitcnt lgkmcnt(0)" ::: "memory");
  const int c = lane & 7;
#pragma unroll
  for (int j = 0; j < 4; ++j) { const int n = (lane >> 3) + 8 * j; const float* s = scr + (8 * c) * 33 + n;
    u32x4 o; o.x = pk2(s[0 * 33], s[1 * 33]); o.y = pk2(s[2 * 33], s[3 * 33]); o.z = pk2(s[4 * 33], s[5 * 33]); o.w = pk2(s[6 * 33], s[7 * 33]);
    *(u32x4*)(WT + (size_t)n * K + k0 + 8 * c) = o; }
  asm volatile("s_waitcnt lgkmcnt(0)" ::: "memory");
}
constexpr int CI_WIN = 16 * 80, CI_WOUT = 20 * 32, CI_WML = 16 * 97, CI_WMO = 16 * 32, CI_WAX = 40 * 8, CI_DENSE = CI_WIN + CI_WOUT + CI_WML + CI_WMO + CI_WAX;
constexpr int CI_MOE = 32 * 768;
DEV void ph_convert_dense(const Params& p, char* smem) {
  const int tf = tidf(), lane = tf & 63, wv = tf >> 6;
  float* scr = (float*)(smem + wv * 8448);
  const int gw = blockIdx.x * 8 + wv, ngw = gridDim.x * 8;
  for (int it = gw; it < CI_DENSE; it += ngw) {
    int r = it;
    if (r < CI_WIN) { const int kb = r / 80, nb_ = r % 80; transpose_item(p.in[8], 2560, 1024, (bf16_t*)(p.ws + WS_WIN) + (size_t)(nb_ * 32) * 1024, scr, kb * 64, nb_ * 32, lane); continue; } r -= CI_WIN;
    if (r < CI_WOUT) { const int kb = r / 32, nb_ = r % 32; transpose_item(p.in[16], 1024, 1280, (bf16_t*)(p.ws + WS_WOUT) + (size_t)(nb_ * 32) * 1280, scr, kb * 64, nb_ * 32, lane); continue; } r -= CI_WOUT;
    if (r < CI_WML) { const int kb = r / 97, nb_ = r % 97; transpose_item(p.in[28], MLW, 1024, (bf16_t*)(p.ws + WS_WML) + (size_t)(nb_ * 32) * 1024, scr, kb * 64, nb_ * 32, lane); continue; } r -= CI_WML;
    if (r < CI_WMO) { const int kb = r / 32, nb_ = r % 32; transpose_item(p.in[31], 1024, 1024, (bf16_t*)(p.ws + WS_WMO) + (size_t)(nb_ * 32) * 1024, scr, kb * 64, nb_ * 32, lane); continue; } r -= CI_WMO;
    { const int mi = r >> 3, rr = r & 7, kb = rr >> 2, nb_ = rr & 3, dh = mi >> 1, which = mi & 1;
      transpose_item((which ? p.in[13] : p.in[11]) + (size_t)dh * 16384, 128, 128, (bf16_t*)(p.ws + WS_WAXT) + (size_t)mi * 16384 + (size_t)(nb_ * 32) * 128, scr, kb * 64, nb_ * 32, lane); }
  }
  { bf16_t* Wr = (bf16_t*)(p.ws + WS_WR);
    for (int i = blockIdx.x * 512 + tf; i < 2 * 48 * 1024; i += gridDim.x * 512) {
      const int l = i / (48 * 1024), r = i % (48 * 1024), n = r >> 10, k = r & 1023;
      const float* We = p.in[l ? 34 : 19]; const float* Wg = p.in[l ? 32 : 17];
      const float w = n < 32 ? We[k * 32 + n] : (n < 36 ? Wg[k * 4 + n - 32] : 0.f);
      const bf16_t hi = f2bf(w); const bf16_t lo = f2bf(w - bf2f(hi));
      Wr[(size_t)(l * 2) * 48 * 1024 + r] = hi; Wr[(size_t)(l * 2 + 1) * 48 * 1024 + r] = lo;
    } }
  { u32x4* z = (u32x4*)((bf16_t*)(p.ws + WS_WML) + (size_t)MLW * 1024); const int n16 = (MLWP - MLW) * 1024 * 2 / 16;
    for (int i = blockIdx.x * 512 + tf; i < n16; i += gridDim.x * 512) z[i] = (u32x4){0u, 0u, 0u, 0u}; }
}
template <int LAYER>
DEV void ph_convert_moe(const Params& p, char* smem) {
  const int tf = tidf(), lane = tf & 63, wv = tf >> 6;
  float* scr = (float*)(smem + wv * 8448);
  const int gw = blockIdx.x * 8 + wv, ngw = gridDim.x * 8;
  const float* Wg = p.in[LAYER == 0 ? 21 : 36]; const float* Wu = p.in[LAYER == 0 ? 22 : 37]; const float* Wd = p.in[LAYER == 0 ? 23 : 38];
  bf16_t* WGU = (bf16_t*)(p.ws + WS_WGU); bf16_t* WD = (bf16_t*)(p.ws + WS_WD);
  for (int it = gw; it < CI_MOE; it += ngw) {
    const int e = it / 768, r = it % 768;
    if (r < 512) {
      const int up = r >> 8, rr = r & 255, kb = rr >> 4, nb_ = rr & 15, n0 = nb_ * 32;
      bf16_t* dst = WGU + ((size_t)e * 1024 + (n0 >> 7) * 256 + up * 128 + (n0 & 127)) * 1024;
      transpose_item((up ? Wu : Wg) + (size_t)e * 1024 * 512, 512, 1024, dst, scr, kb * 64, n0, lane);
    } else {
      const int rr = r - 512, kb = rr >> 5, nb_ = rr & 31, n0 = nb_ * 32;
      transpose_item(Wd + (size_t)e * 512 * 1024, 1024, 512, WD + ((size_t)e * 1024 + n0) * 512, scr, kb * 64, n0, lane);
    }
  }
}

DEV void ph_norm0(const Params& p, int bid, int nb) {
  const int lane = tidx() & 63, wave = tidx() >> 6;
  const float* mods = (const float*)(p.ws + WS_MODS);
  bf16_t* hA = (bf16_t*)(p.ws + WS_HA);
  const float* g1 = p.in[6];
  for (int r0 = (bid * 4 + wave) * 4; r0 < T; r0 += nb * 16) {
    f32x4 v[4][4]; float rs[4];
#pragma unroll
    for (int q = 0; q < 4; ++q) {
      const int r = r0 + q;
      const float* src = r < NL ? p.in[0] + (size_t)r * D : p.in[2] + (size_t)(r - NL) * D;
#pragma unroll
      for (int i = 0; i < 4; ++i) v[q][i] = *(const f32x4*)(src + 4 * lane + 256 * i);
    }
#pragma unroll
    for (int q = 0; q < 4; ++q) {
      float ss = 0.f;
#pragma unroll
      for (int i = 0; i < 4; ++i) ss += v[q][i].x * v[q][i].x + v[q][i].y * v[q][i].y + v[q][i].z * v[q][i].z + v[q][i].w * v[q][i].w;
      rs[q] = rsqrtf(wave_sum(ss) * (1.f / D) + EPS);
    }
#pragma unroll
    for (int i = 0; i < 4; ++i) {
      const int c = 4 * lane + 256 * i;
      const f32x4 g = *(const f32x4*)(g1 + c);
#pragma unroll
      for (int q = 0; q < 4; ++q) {
        const int r = r0 + q;
        const float* md = mods + (r < NL ? 0 : 6144);
        const f32x4 sh = *(const f32x4*)(md + c), sc = *(const f32x4*)(md + 1024 + c);
        const f32x4 h = v[q][i] * rs[q] * g * (1.f + sc) + sh;
        u32x2 o; o.x = pk2(h.x, h.y); o.y = pk2(h.z, h.w);
        *(u32x2*)(hA + (size_t)r * D + c) = o;
      }
    }
  }
}

constexpr int RG_AS_STRIDE = 272;
constexpr int RG_MT = RGT / 16;
constexpr int RG_AS = 0, RG_BS = RGT * RG_AS_STRIDE, RG_SMEM = RG_BS + 128 * BS_STRIDE;

template <bool REV, int NT>
DEV void rg_scan(f32x4 (&A)[RG_MT][NT], f32x4 (&B)[RG_MT][NT], float (&aggP)[NT], float (&aggH)[NT]) {
  const int lane = tidx() & 63, fq = lane >> 4, fr = lane & 15;
#pragma unroll
  for (int n = 0; n < NT; ++n) {
    float cP = 1.f, cH = 0.f;
#pragma unroll
    for (int mm = 0; mm < RG_MT; ++mm) {
      const int m = REV ? RG_MT - 1 - mm : mm;
      float P[4], H[4];
      if (!REV) {
        P[0] = A[m][n][0]; H[0] = B[m][n][0];
#pragma unroll
        for (int j = 1; j < 4; ++j) { P[j] = A[m][n][j] * P[j - 1]; H[j] = A[m][n][j] * H[j - 1] + B[m][n][j]; }
      } else {
        P[3] = A[m][n][3]; H[3] = B[m][n][3];
#pragma unroll
        for (int j = 2; j >= 0; --j) { P[j] = A[m][n][j] * P[j + 1]; H[j] = A[m][n][j] * H[j + 1] + B[m][n][j]; }
      }
      float IP = REV ? P[0] : P[3], IH = REV ? H[0] : H[3];
      float tP, tH;
      tP = REV ? __shfl_down(IP, 16) : __shfl_up(IP, 16); tH = REV ? __shfl_down(IH, 16) : __shfl_up(IH, 16);
      if (REV ? (fq <= 2) : (fq >= 1)) { IH = IP * tH + IH; IP = IP * tP; }
      tP = REV ? __shfl_down(IP, 32) : __shfl_up(IP, 32); tH = REV ? __shfl_down(IH, 32) : __shfl_up(IH, 32);
      if (REV ? (fq <= 1) : (fq >= 2)) { IH = IP * tH + IH; IP = IP * tP; }
      float EP = REV ? __shfl_down(IP, 16) : __shfl_up(IP, 16), EH = REV ? __shfl_down(IH, 16) : __shfl_up(IH, 16);
      if (REV ? (fq == 3) : (fq == 0)) { EP = 1.f; EH = 0.f; }
      const float hin = EP * cH + EH, pin = EP * cP;
#pragma unroll
      for (int j = 0; j < 4; ++j) { B[m][n][j] = H[j] + P[j] * hin; A[m][n][j] = P[j] * pin; }
      const float TP = __shfl(IP, (REV ? 0 : 48) + fr), TH = __shfl(IH, (REV ? 0 : 48) + fr);
      cH = TP * cH + TH; cP = TP * cP;
    }
    aggP[n] = cP; aggH[n] = cH;
  }
}

DEV void ph_rg_scan(const Params& p, char* smem, int bid, int nb) {
  char* As = smem + RG_AS; char* Bs = smem + RG_BS;
  const bf16_t* pr = (const bf16_t*)(p.ws + WS_PR);
  bf16_t* Sb = (bf16_t*)(p.ws + WS_S); bf16_t* Pfb = (bf16_t*)(p.ws + WS_PF); bf16_t* Pbb = (bf16_t*)(p.ws + WS_PB);
  float* agg = (float*)(p.ws + WS_AGG);
  const float* conv_w = p.in[9]; const float* conv_b = p.in[10];
  for (int it = 0, iters = (NRT * 10 + nb - 1) / nb; it < iters; ++it) {
    int u = bid + it * nb; const bool active = u < NRT * 10; if (!active) u = NRT * 10 - 1;
    const int tid = tidx();
    const int lane = tid & 63, wave = tid >> 6, fr = lane & 15, fq = lane >> 4, q4 = fr >> 2, p4 = lane & 3;
    const int hb = u % 10, tile = u / 10, r0 = tile * RGT, ch0 = hb * 128;
    const int seg_lo = tile < NRT_LAT ? 0 : NL, seg_hi = tile < NRT_LAT ? NL : T;
    __syncthreads();
    {
      const int cg8 = tid & 15, rg = tid >> 4, c = ch0 + 8 * cg8;
      float w[4][8], bias[8];
#pragma unroll
      for (int j = 0; j < 4; ++j) { const f32x4 a = *(const f32x4*)(conv_w + j * DR + c), b = *(const f32x4*)(conv_w + j * DR + c + 4);
        w[j][0] = a.x; w[j][1] = a.y; w[j][2] = a.z; w[j][3] = a.w; w[j][4] = b.x; w[j][5] = b.y; w[j][6] = b.z; w[j][7] = b.w; }
      { const f32x4 a = *(const f32x4*)(conv_b + c), b = *(const f32x4*)(conv_b + c + 4);
        bias[0] = a.x; bias[1] = a.y; bias[2] = a.z; bias[3] = a.w; bias[4] = b.x; bias[5] = b.y; bias[6] = b.z; bias[7] = b.w; }
      float win[4][8];
      auto ldrow = [&](int r, float (&dst)[8]) {
        if (r >= seg_lo && r < seg_hi) { const u32x4 v = *(const u32x4*)(pr + (size_t)r * DR + c);
          dst[0] = bflo(v.x); dst[1] = bfhi(v.x); dst[2] = bflo(v.y); dst[3] = bfhi(v.y); dst[4] = bflo(v.z); dst[5] = bfhi(v.z); dst[6] = bflo(v.w); dst[7] = bfhi(v.w); }
        else {
#pragma unroll
          for (int e = 0; e < 8; ++e) dst[e] = 0.f; }
      };
      const int rb = r0 + rg * 4;
      ldrow(rb - 2, win[0]); ldrow(rb - 1, win[1]); ldrow(rb, win[2]);
#pragma unroll
      for (int t = 0; t < 4; ++t) {
        ldrow(rb + t + 1, win[(t + 3) & 3]);
        float o[8];
#pragma unroll
        for (int e = 0; e < 8; ++e) o[e] = bias[e] + w[0][e] * win[t & 3][e] + w[1][e] * win[(t + 1) & 3][e] + w[2][e] * win[(t + 2) & 3][e] + w[3][e] * win[(t + 3) & 3][e];
        u32x4 ov; ov.x = pk2(o[0], o[1]); ov.y = pk2(o[2], o[3]); ov.z = pk2(o[4], o[5]); ov.w = pk2(o[6], o[7]);
        *(u32x4*)(As + (rg * 4 + t) * RG_AS_STRIDE + cg8 * 16) = ov;
      }
    }
    u32x2 hfk[RG_MT][2];
#pragma unroll
    for (int d = 0; d < 2; ++d) {
      f32x4 accA[RG_MT][2], accX[RG_MT][2];
#pragma unroll
      for (int which = 0; which < 2; ++which) {
        const float* W = (which ? p.in[13] : p.in[11]) + (size_t)(d * 10 + hb) * 16384;
        __syncthreads();
#pragma unroll 1
        for (int ib = 0; ib < 4; ++ib) {
#pragma unroll
          for (int ii = 0; ii < 4; ++ii) {
            const int f = tid + 256 * (ib * 4 + ii), k = f >> 5, n = 4 * (f & 31);
            const f32x4 v = *(const f32x4*)(W + k * 128 + n);
            u32x2 o; o.x = pk2(v.x, v.y); o.y = pk2(v.z, v.w);
            *(u32x2*)(Bs + bs_off(k, n)) = o;
          }
        }
        __syncthreads();
        f32x4 (&acc)[RG_MT][2] = which ? accX : accA;
#pragma unroll
        for (int m = 0; m < RG_MT; ++m) { acc[m][0] = (f32x4){0.f, 0.f, 0.f, 0.f}; acc[m][1] = (f32x4){0.f, 0.f, 0.f, 0.f}; }
#pragma unroll
        for (int ks = 0; ks < 4; ++ks) {
          bf16x8 b[2];
#pragma unroll
          for (int n = 0; n < 2; ++n) {
            const int ncol = wave * 32 + n * 16 + 4 * p4;
            const s16x4 lo = ldtr(Bs + bs_off(ks * 32 + fq * 8 + q4, ncol));
            const s16x4 hi = ldtr(Bs + bs_off(ks * 32 + fq * 8 + 4 + q4, ncol));
            b[n] = (bf16x8){lo.x, lo.y, lo.z, lo.w, hi.x, hi.y, hi.z, hi.w};
          }
#pragma unroll
          for (int m = 0; m < RG_MT; ++m) {
            const bf16x8 a = *(const bf16x8*)(As + (m * 16 + fr) * RG_AS_STRIDE + (ks * 32 + fq * 8) * 2);
            acc[m][0] = __builtin_amdgcn_mfma_f32_16x16x32_bf16(a, b[0], acc[m][0], 0, 0, 0);
            acc[m][1] = __builtin_amdgcn_mfma_f32_16x16x32_bf16(a, b[1], acc[m][1], 0, 0, 0);
          }
        }
      }
#pragma unroll
      for (int n = 0; n < 2; ++n) {
        const int cl = wave * 32 + n * 16 + fr, ch = ch0 + cl;
        const float ba = p.in[12][d * DR + ch], bx = p.in[14][d * DR + ch], lam = p.in[15][d * DR + ch];
        const float nl = -lam;
        const float sp = nl > 20.f ? nl : log1pf(__expf(nl));
        const float c8 = -8.f * sp;
#pragma unroll
        for (int m = 0; m < RG_MT; ++m)
#pragma unroll
          for (int j = 0; j < 4; ++j) {
            const int row = m * 16 + fq * 4 + j;
            const float r = sigmoidf_(accA[m][n][j] + ba), ig = sigmoidf_(accX[m][n][j] + bx);
            const float la = c8 * r;
            const float a = __expf(la);
            const float x2 = 2.f * la;
            const float om = x2 > -0.1f ? -x2 * (1.f + x2 * (0.5f + x2 * (0.16666667f + x2 * 0.041666668f))) : 1.f - a * a;
            const float mult = sqrtf(om);
            const float uu = bf2f(*(const bf16_t*)(As + row * RG_AS_STRIDE + cl * 2));
            accA[m][n][j] = a; accX[m][n][j] = mult * ig * uu;
            if (j == 3) __builtin_amdgcn_sched_barrier(0);
          }
      }
      float aggP[2], aggH[2];
      if (d == 0) rg_scan<false, 2>(accA, accX, aggP, aggH); else rg_scan<true, 2>(accA, accX, aggP, aggH);
      if (fq == 0) {
#pragma unroll
        for (int n = 0; n < 2; ++n) {
          const int ch = ch0 + wave * 32 + n * 16 + fr;
          float* ag = agg + ((size_t)(d * NRT + tile) * DR + ch) * 2;
          ag[0] = aggP[n]; ag[1] = aggH[n];
        }
      }
      bf16_t* Pout = d ? Pbb : Pfb;
#pragma unroll
      for (int m = 0; m < RG_MT; ++m)
#pragma unroll
        for (int n = 0; n < 2; ++n) {
          if (d == 0) { hfk[m][n].x = pk2(accX[m][n][0], accX[m][n][1]); hfk[m][n].y = pk2(accX[m][n][2], accX[m][n][3]); }
          else { accX[m][n][0] += bflo(hfk[m][n].x); accX[m][n][1] += bfhi(hfk[m][n].x); accX[m][n][2] += bflo(hfk[m][n].y); accX[m][n][3] += bfhi(hfk[m][n].y); }
#pragma unroll
          for (int j = 0; j < 4; ++j) {
            const unsigned o = (unsigned)(r0 + m * 16 + fq * 4 + j) * DR + ch0 + wave * 32 + n * 16 + fr;
            Pout[o] = f2bf(accA[m][n][j]);
            if (d == 1) Sb[o] = f2bf(accX[m][n][j]);
          }
          __builtin_amdgcn_sched_barrier(0);
        }
    }
  }
}

DEV void ph_rg_scan2(const Params& p, char* smem) {
  int tid = threadIdx.x; asm volatile("" : "+v"(tid));
  const int lane = tid & 63, wave = tid >> 6, fr = lane & 15, fq = lane >> 4;
  const bf16_t* pr = (const bf16_t*)(p.ws + WS_PR);
  bf16_t* Sb = (bf16_t*)(p.ws + WS_S); bf16_t* Pfb = (bf16_t*)(p.ws + WS_PF); bf16_t* Pbb = (bf16_t*)(p.ws + WS_PB);
  float* agg = (float*)(p.ws + WS_AGG);
  const bf16_t* WAX = (const bf16_t*)(p.ws + WS_WAXT);
  const float* conv_w = p.in[9]; const float* conv_b = p.in[10];
  const int NU = NRT * 10;
  const int u0 = (int)((long)blockIdx.x * NU / gridDim.x), u1 = (int)((long)(blockIdx.x + 1) * NU / gridDim.x);
  int cur_hb = -1;
  bf16x8 bfr[4][4];
  float cba[2], cbx[2], cc8[2];
#pragma unroll 1
  for (int u = u0; u < u1; ++u) {
    const int hb = u / NRT, tile = u - hb * NRT, r0 = tile * RGT, ch0 = hb * 128;
    const int seg_lo = tile < NRT_LAT ? 0 : NL, seg_hi = tile < NRT_LAT ? NL : T;
    char* As = smem + ((u - u0) & 1) * (RGT * RG_AS_STRIDE);
    if (hb != cur_hb) {
      cur_hb = hb;
#pragma unroll
      for (int mat = 0; mat < 4; ++mat)
#pragma unroll
        for (int ks = 0; ks < 4; ++ks)
          bfr[mat][ks] = *(const bf16x8*)(WAX + (size_t)(((mat >> 1) * 10 + hb) * 2 + (mat & 1)) * 16384 + (16 * wave + fr) * 128 + ks * 32 + fq * 8);
#pragma unroll
      for (int d = 0; d < 2; ++d) {
        const int ch = ch0 + 16 * wave + fr;
        cba[d] = p.in[12][d * DR + ch]; cbx[d] = p.in[14][d * DR + ch];
        const float nl = -p.in[15][d * DR + ch];
        cc8[d] = -8.f * (nl > 20.f ? nl : log1pf(__expf(nl)));
      }
    }
    {
      const int cg8 = tid & 15, rg = tid >> 4, c = ch0 + 8 * cg8;
      float w[4][8], bias[8];
#pragma unroll
      for (int j = 0; j < 4; ++j) { const f32x4 a = *(const f32x4*)(conv_w + j * DR + c), b = *(const f32x4*)(conv_w + j * DR + c + 4);
        w[j][0] = a.x; w[j][1] = a.y; w[j][2] = a.z; w[j][3] = a.w; w[j][4] = b.x; w[j][5] = b.y; w[j][6] = b.z; w[j][7] = b.w; }
      { const f32x4 a = *(const f32x4*)(conv_b + c), b = *(const f32x4*)(conv_b + c + 4);
        bias[0] = a.x; bias[1] = a.y; bias[2] = a.z; bias[3] = a.w; bias[4] = b.x; bias[5] = b.y; bias[6] = b.z; bias[7] = b.w; }
      float win[5][8];
      const int rb = r0 + rg * 2;
#pragma unroll
      for (int t = 0; t < 5; ++t) {
        const int r = rb - 2 + t;
        if (r >= seg_lo && r < seg_hi) { const u32x4 v = *(const u32x4*)(pr + (size_t)r * DR + c);
          win[t][0] = bflo(v.x); win[t][1] = bfhi(v.x); win[t][2] = bflo(v.y); win[t][3] = bfhi(v.y); win[t][4] = bflo(v.z); win[t][5] = bfhi(v.z); win[t][6] = bflo(v.w); win[t][7] = bfhi(v.w); }
        else {
#pragma unroll
          for (int e = 0; e < 8; ++e) win[t][e] = 0.f; }
      }
#pragma unroll
      for (int t = 0; t < 2; ++t) {
        float o[8];
#pragma unroll
        for (int e = 0; e < 8; ++e) o[e] = bias[e] + w[0][e] * win[t][e] + w[1][e] * win[t + 1][e] + w[2][e] * win[t + 2][e] + w[3][e] * win[t + 3][e];
        u32x4 ov; ov.x = pk2(o[0], o[1]); ov.y = pk2(o[2], o[3]); ov.z = pk2(o[4], o[5]); ov.w = pk2(o[6], o[7]);
        *(u32x4*)(As + (rg * 2 + t) * RG_AS_STRIDE + cg8 * 16) = ov;
      }
    }
    __syncthreads();
    f32x4 acc[4][RG_MT][1];
#pragma unroll
    for (int mat = 0; mat < 4; ++mat)
#pragma unroll
      for (int m = 0; m < RG_MT; ++m) acc[mat][m][0] = (f32x4){0.f, 0.f, 0.f, 0.f};
#pragma unroll
    for (int ks = 0; ks < 4; ++ks)
#pragma unroll
      for (int m = 0; m < RG_MT; ++m) {
        const bf16x8 a = *(const bf16x8*)(As + (m * 16 + fr) * RG_AS_STRIDE + (ks * 32 + fq * 8) * 2);
#pragma unroll
        for (int mat = 0; mat < 4; ++mat) acc[mat][m][0] = __builtin_amdgcn_mfma_f32_16x16x32_bf16(a, bfr[mat][ks], acc[mat][m][0], 0, 0, 0);
      }
    const int cl = 16 * wave + fr;
#pragma unroll
    for (int d = 0; d < 2; ++d) {
      f32x4 (&accA)[RG_MT][1] = acc[d * 2]; f32x4 (&accX)[RG_MT][1] = acc[d * 2 + 1];
#pragma unroll
      for (int m = 0; m < RG_MT; ++m) {
#pragma unroll
        for (int j = 0; j < 4; ++j) {
          const int row = m * 16 + fq * 4 + j;
          const float r = sigmoidf_(accA[m][0][j] + cba[d]), ig = sigmoidf_(accX[m][0][j] + cbx[d]);
          const float la = cc8[d] * r;
          const float a = fexp_(la);
          const float x2 = 2.f * la;
          const float om = x2 > -0.1f ? -x2 * (1.f + x2 * (0.5f + x2 * (0.16666667f + x2 * 0.041666668f))) : 1.f - a * a;
          const float uu = bf2f(*(const bf16_t*)(As + row * RG_AS_STRIDE + cl * 2));
          accA[m][0][j] = a; accX[m][0][j] = __builtin_amdgcn_sqrtf(om) * ig * uu;
        }
        __builtin_amdgcn_sched_barrier(0);
      }
      float aggP[1], aggH[1];
      if (d == 0) rg_scan<false, 1>(accA, accX, aggP, aggH); else rg_scan<true, 1>(accA, accX, aggP, aggH);
      if (fq == 0) { float* ag = agg + ((size_t)(d * NRT + tile) * DR + ch0 + cl) * 2; ag[0] = aggP[0]; ag[1] = aggH[0]; }
      bf16_t* Pout = d ? Pbb : Pfb;
#pragma unroll
      for (int m = 0; m < RG_MT; ++m) {
        if (d == 1) accX[m][0] += acc[1][m][0];
#pragma unroll
        for (int j = 0; j < 4; ++j) {
          const unsigned o = (unsigned)(r0 + m * 16 + fq * 4 + j) * DR + ch0 + cl;
          Pout[o] = f2bf(accA[m][0][j]);
          if (d == 1) Sb[o] = f2bf(accX[m][0][j]);
        }
      }
    }
  }
  __syncthreads();
}

DEV void ph_rg_carry(const Params& p, char* smem, int bid, int nb) {
  const float* agg = (const float*)(p.ws + WS_AGG); float* carry = (float*)(p.ws + WS_CARRY);
  const int tid = tidx();
  float* sP = (float*)smem; float* sH = sP + 256;
  constexpr int NCH = 2 * DR, CPB = 25, NB = (NCH + CPB - 1) / CPB;
  for (int it = 0, iters = (NB + nb - 1) / nb; it < iters; ++it) {
    const int blk = bid + it * nb;
    const int lc = tid / 10, seg = tid % 10, chain = blk * CPB + lc;
    const bool on = blk < NB && tid < 250 && chain < NCH;
    const int d = on ? chain / DR : 0, ch = on ? chain % DR : 0;
    float ap[26], ah[26];
    if (on) {
#pragma unroll
      for (int j = 0; j < 26; ++j) {
        const int s = seg * 26 + j;
        const int tile = d == 0 ? (s < (NRT - NRT_LAT) ? NRT_LAT + s : s - (NRT - NRT_LAT)) : NRT - 1 - s;
        const float* ag = agg + ((size_t)(d * NRT + tile) * DR + ch) * 2;
        ap[j] = ag[0]; ah[j] = ag[1];
      }
      float P = 1.f, H = 0.f;
#pragma unroll
      for (int j = 0; j < 26; ++j) { H = ap[j] * H + ah[j]; P = ap[j] * P; }
      sP[tid] = P; sH[tid] = H;
    }
    __syncthreads();
    if (on) {
      float st = 0.f;
      for (int k = 0; k < seg; ++k) st = sP[lc * 10 + k] * st + sH[lc * 10 + k];
#pragma unroll
      for (int j = 0; j < 26; ++j) {
        const int s = seg * 26 + j;
        const int tile = d == 0 ? (s < (NRT - NRT_LAT) ? NRT_LAT + s : s - (NRT - NRT_LAT)) : NRT - 1 - s;
        carry[(size_t)(d * NRT + tile) * DR + ch] = st;
        st = ap[j] * st + ah[j];
      }
    }
    __syncthreads();
  }
}

DEV void ph_rg_final(const Params& p, int bid, int nb) {
  const bf16_t* gg = (const bf16_t*)(p.ws + WS_GG); const bf16_t* Sb = (const bf16_t*)(p.ws + WS_S);
  const bf16_t* Pfb = (const bf16_t*)(p.ws + WS_PF); const bf16_t* Pbb = (const bf16_t*)(p.ws + WS_PB);
  const float* carry = (const float*)(p.ws + WS_CARRY);
  bf16_t* y = (bf16_t*)(p.ws + WS_PR);
  const int total = T * (DR / 8);
  for (int i = bid * 256 + tidx(); i < total; i += nb * 256) {
    const int r = i / 160, c = (i % 160) * 8, tile = r / RGT;
    const size_t o = (size_t)r * DR + c;
    const u32x4 g = *(const u32x4*)(gg + o), s = *(const u32x4*)(Sb + o), pf = *(const u32x4*)(Pfb + o), pb = *(const u32x4*)(Pbb + o);
    const float* cf = carry + (size_t)tile * DR + c; const float* cb = carry + (size_t)(NRT + tile) * DR + c;
    const f32x4 cf0 = *(const f32x4*)cf, cf1 = *(const f32x4*)(cf + 4), cb0 = *(const f32x4*)cb, cb1 = *(const f32x4*)(cb + 4);
    u32x4 o4;
    o4.x = pk2(bflo(g.x) * (bflo(s.x) + bflo(pf.x) * cf0.x + bflo(pb.x) * cb0.x), bfhi(g.x) * (bfhi(s.x) + bfhi(pf.x) * cf0.y + bfhi(pb.x) * cb0.y));
    o4.y = pk2(bflo(g.y) * (bflo(s.y) + bflo(pf.y) * cf0.z + bflo(pb.y) * cb0.z), bfhi(g.y) * (bfhi(s.y) + bfhi(pf.y) * cf0.w + bfhi(pb.y) * cb0.w));
    o4.z = pk2(bflo(g.z) * (bflo(s.z) + bflo(pf.z) * cf1.x + bflo(pb.z) * cb1.x), bfhi(g.z) * (bfhi(s.z) + bfhi(pf.z) * cf1.y + bfhi(pb.z) * cb1.y));
    o4.w = pk2(bflo(g.w) * (bflo(s.w) + bflo(pf.w) * cf1.z + bflo(pb.w) * cb1.z), bfhi(g.w) * (bfhi(s.w) + bfhi(pf.w) * cf1.w + bfhi(pb.w) * cb1.w));
    *(u32x4*)(y + o) = o4;
  }
}

using pg8::Unit;
struct EpiRgIn {
  static constexpr bool PERM = true, AFTER_DRAIN = false;
  bf16_t* gg; bf16_t* pr;
  DEV void operator()(const f32x4 (&acc)[2][2][4][2], const Unit& u, int wr, int wc, int fr, int fq) const {
    const int row0 = u.pm * 256 + wr * 64 + fr, c0 = u.pn * 256 + wc * 32 + 8 * fq;
    const bool gate = u.pn < 5;
#pragma unroll
    for (int ai = 0; ai < 2; ++ai)
#pragma unroll
      for (int m = 0; m < 4; ++m) {
        const unsigned row = row0 + ai * 128 + m * 16;
#pragma unroll
        for (int bj = 0; bj < 2; ++bj) {
          f32x4 v0 = acc[ai][bj][m][0], v1 = acc[ai][bj][m][1];
          const int col = c0 + bj * 128;
          if (gate) {
#pragma unroll
            for (int j = 0; j < 4; ++j) { v0[j] = gelu_tanh(v0[j]); v1[j] = gelu_tanh(v1[j]); }
          }
          u32x4 w; w.x = pk2(v0[0], v0[1]); w.y = pk2(v0[2], v0[3]); w.z = pk2(v1[0], v1[1]); w.w = pk2(v1[2], v1[3]);
          if (gate) *(u32x4*)(gg + row * DR + col) = w; else *(u32x4*)(pr + row * DR + col - DR) = w;
        }
      }
  }
};
template <int LAYER> struct EpiOut {
  static constexpr bool PERM = false, AFTER_DRAIN = false;
  const float* x; const float* ctx; const bf16_t* x2; const float* mods; bf16_t* x1;
  DEV void operator()(const f32x4 (&acc)[2][2][4][2], const Unit& u, int wr, int wc, int fr, int fq) const {
    const int row0 = u.pm * 256 + wr * 64 + fr, c0 = u.pn * 256 + wc * 32 + 4 * fq;
#pragma unroll
    for (int ai = 0; ai < 2; ++ai)
#pragma unroll
      for (int m = 0; m < 4; ++m) {
        const int row = row0 + ai * 128 + m * 16;
        const int trow = LAYER == 0 ? row : token_of_seqrow(row);
        const float* xin = LAYER == 0 ? (row < NL ? x + (size_t)row * D : ctx + (size_t)(row - NL) * D) : nullptr;
        const float* gt = mods + ((LAYER == 0 && row >= NL) ? 6144 : 0) + 2048;
        bf16_t* xo = x1 + (size_t)trow * D;
#pragma unroll
        for (int bj = 0; bj < 2; ++bj)
#pragma unroll
          for (int n = 0; n < 2; ++n) {
            const int col = c0 + bj * 128 + n * 16;
            const f32x4 xi = LAYER == 0 ? *(const f32x4*)(xin + col) : ld_bf4(x2 + (size_t)trow * D + col);
            st_bf4(xo + col, xi + *(const f32x4*)(gt + col) * acc[ai][bj][m][n]);
          }
      }
  }
};
struct EpiMoe1 {
  static constexpr bool PERM = true, AFTER_DRAIN = false;
  bf16_t* Hm;
  DEV void operator()(const f32x4 (&acc)[2][2][4][2], const Unit& u, int wr, int wc, int fr, int fq) const {
    const int row0 = u.pm * 256 + wr * 64 + fr, c0 = (u.pn & 3) * 128 + wc * 32 + 8 * fq;
#pragma unroll
    for (int ai = 0; ai < 2; ++ai)
#pragma unroll
      for (int m = 0; m < 4; ++m) {
        const unsigned row = row0 + ai * 128 + m * 16;
        float h[8];
#pragma unroll
        for (int n = 0; n < 2; ++n)
#pragma unroll
          for (int j = 0; j < 4; ++j) h[n * 4 + j] = siluf_(acc[ai][0][m][n][j]) * acc[ai][1][m][n][j];
        u32x4 w; w.x = pk2(h[0], h[1]); w.y = pk2(h[2], h[3]); w.z = pk2(h[4], h[5]); w.w = pk2(h[6], h[7]);
        *(u32x4*)(Hm + row * DE + c0) = w;
      }
  }
};
struct EpiMoe2 {
  static constexpr bool PERM = true, AFTER_DRAIN = false;
  bf16_t* Y; const float* awp;
  DEV void operator()(const f32x4 (&acc)[2][2][4][2], const Unit& u, int wr, int wc, int fr, int fq) const {
    const int row0 = u.pm * 256 + wr * 64 + fr, c0 = (u.pn & 3) * 256 + wc * 32 + 8 * fq;
#pragma unroll
    for (int ai = 0; ai < 2; ++ai)
#pragma unroll
      for (int m = 0; m < 4; ++m) {
        const unsigned row = row0 + ai * 128 + m * 16;
        const float w8 = awp[row];
#pragma unroll
        for (int bj = 0; bj < 2; ++bj) {
          const f32x4 v0 = acc[ai][bj][m][0] * w8, v1 = acc[ai][bj][m][1] * w8;
          u32x4 w; w.x = pk2(v0[0], v0[1]); w.y = pk2(v0[2], v0[3]); w.z = pk2(v1[0], v1[1]); w.w = pk2(v1[2], v1[3]);
          *(u32x4*)(Y + row * D + c0 + bj * 128) = w;
        }
      }
  }
};
struct EpiMlIn {
  static constexpr bool PERM = false, AFTER_DRAIN = false;
  bf16_t* qb; bf16_t* kb; bf16_t* kT; bf16_t* vT; bf16_t* og;
  DEV void operator()(const f32x4 (&acc)[2][2][4][2], const Unit& u, int wr, int wc, int fr, int fq) const {
    const unsigned row0 = u.pm * 256 + wr * 64 + fr, c0 = u.pn * 256 + wc * 32 + 4 * fq;
    const int pn = u.pn;
#define MLIN_LOOP(BODY) _Pragma("unroll") for (int ai = 0; ai < 2; ++ai) _Pragma("unroll") for (int m = 0; m < 4; ++m) { const unsigned row = row0 + ai * 128 + m * 16; \
      _Pragma("unroll") for (int bj = 0; bj < 2; ++bj) _Pragma("unroll") for (int n = 0; n < 2; ++n) { const f32x4 v = acc[ai][bj][m][n]; const unsigned col = c0 + bj * 128 + n * 16; BODY } }
    if (pn < 2) {
      MLIN_LOOP({ u32x2 o; o.x = pk2(v[0] * 0.125f, v[1] * 0.125f); o.y = pk2(v[2] * 0.125f, v[3] * 0.125f); *(u32x2*)(qb + row * 512 + col) = o; })
    } else if (pn < 4) {
      MLIN_LOOP({ u32x2 o; o.x = pk2(v[0], v[1]); o.y = pk2(v[2], v[3]); *(u32x2*)(kb + row * 512 + col - 512) = o;
        bf16_t* kp = kT + (col - 512) * T + row;
        kp[0] = (bf16_t)(o.x & 0xffffu); kp[T] = (bf16_t)(o.x >> 16); kp[2 * T] = (bf16_t)(o.y & 0xffffu); kp[3 * T] = (bf16_t)(o.y >> 16); })
    } else if (pn < 8) {
      MLIN_LOOP({ u32x2 o; o.x = pk2(v[0], v[1]); o.y = pk2(v[2], v[3]);
        bf16_t* vp = vT + (col - 1024) * T + row;
        vp[0] = (bf16_t)(o.x & 0xffffu); vp[T] = (bf16_t)(o.x >> 16); vp[2 * T] = (bf16_t)(o.y & 0xffffu); vp[3 * T] = (bf16_t)(o.y >> 16); })
    } else {
      MLIN_LOOP({ u32x2 o; o.x = pk2(sigmoidf_(v[0]), sigmoidf_(v[1])); o.y = pk2(sigmoidf_(v[2]), sigmoidf_(v[3])); *(u32x2*)(og + row * D + col - 2048) = o; })
    }
#undef MLIN_LOOP
  }
};

struct MoeOrder {
  const int* tb; int ntn, G, c;
  DEV bool next(int i, Unit& u) const {
    const int U = tb[32], per = (U + 7) >> 3, xcd = c & 7, lo = xcd * per, hi = min(lo + per, U);
    const int L = lo + i * (G >> 3) + (c >> 3); if (L >= hi) return false;
    int e = 0;
#pragma unroll 1
    for (int k = 1; k < 32; ++k) e = (L >= tb[k]) ? k : e;
    const int r = L - tb[e], mt = (tb[e + 1] - tb[e]) / ntn;
    u.pm = tb[33 + e] + r % mt; u.pn = e * ntn + r / mt; return true;
  }
  DEV void a_ready(const Unit&) const {}
  DEV void done(const Unit&) const {}
};
constexpr int LDS_TB = 131072;
DEV void moe_tables(const int* cnt, char* smem, int ntn) {
  int* tb = (int*)(smem + LDS_TB);
  if (threadIdx.x == 0) {
    int ub = 0, rb = 0;
    for (int e = 0; e < 32; ++e) { const int m = (cnt[e * CNT_STRIDE] + 255) >> 8; tb[e] = ub; tb[33 + e] = rb; ub += m * ntn; rb += m; }
    tb[32] = ub; tb[65] = rb;
  }
  __syncthreads();
}

template <int NT>
DEV void wave_gemm16(const bf16_t* A, int lda, const bf16_t* Bt, int ldb, int ks0, int ks1, f32x4 (&acc)[NT]) {
  const int lane = tidf() & 63, fr = lane & 15, fq = lane >> 4;
  const bf16_t* ap = A + (size_t)fr * lda + fq * 8; const bf16_t* bp = Bt + (size_t)fr * ldb + fq * 8;
#pragma unroll 4
  for (int ks = ks0; ks < ks1; ++ks) {
    const bf16x8 a = *(const bf16x8*)(ap + ks * 32);
#pragma unroll
    for (int n = 0; n < NT; ++n) {
      const bf16x8 b = *(const bf16x8*)(bp + (size_t)n * 16 * ldb + ks * 32);
      acc[n] = __builtin_amdgcn_mfma_f32_16x16x32_bf16(a, b, acc[n], 0, 0, 0);
    }
  }
}
DEV void ph_out0_ctx(const Params& p, char* smem) {
  const int tf = tidf(), lane = tf & 63, wv = tf >> 6, fr = lane & 15, fq = lane >> 4;
  const int b = blockIdx.x;
  f32x4* red = (f32x4*)smem;
  if (b < 256) {
    const int rt = b >> 4, cg = b & 15, nt = wv & 3, kh = wv >> 2;
    f32x4 acc[1] = {(f32x4){0.f, 0.f, 0.f, 0.f}};
    wave_gemm16<1>((const bf16_t*)(p.ws + WS_PR) + (size_t)(NL + rt * 16) * DR, DR, (const bf16_t*)(p.ws + WS_WOUT) + (size_t)(cg * 64 + nt * 16) * DR, DR, kh * 20, kh * 20 + 20, acc);
    if (kh == 1) red[nt * 64 + lane] = acc[0];
    __syncthreads();
    if (kh == 0) {
      const f32x4 v = acc[0] + red[nt * 64 + lane];
      const int col = cg * 64 + nt * 16 + fr;
      const float gt = ((const float*)(p.ws + WS_MODS))[6144 + 2048 + col];
      bf16_t* x1 = (bf16_t*)(p.ws + WS_X1);
#pragma unroll
      for (int j = 0; j < 4; ++j) { const int r = rt * 16 + fq * 4 + j; x1[(size_t)(NL + r) * D + col] = f2bf(p.in[2][(size_t)r * D + col] + gt * v[j]); }
    }
  } else __syncthreads();
  __syncthreads();
}
DEV void ph_mlin_small(const Params& p) {
  const int tf = tidf(), lane = tf & 63, wv = tf >> 6, fr = lane & 15, fq = lane >> 4;
  const bf16_t* hA = (const bf16_t*)(p.ws + WS_HA); const bf16_t* W = (const bf16_t*)(p.ws + WS_WML);
  bf16_t* kb = (bf16_t*)(p.ws + WS_K); bf16_t* kT = (bf16_t*)(p.ws + WS_KT); bf16_t* vT = (bf16_t*)(p.ws + WS_VT); float* gl = (float*)(p.ws + WS_GL);
  const int b = blockIdx.x;
  if (b < 192) {
    const int rt = b / 12, cg = b % 12, col0 = 512 + cg * 128 + wv * 16;
    f32x4 acc[1] = {(f32x4){0.f, 0.f, 0.f, 0.f}};
    wave_gemm16<1>(hA + (size_t)(NL + rt * 16) * D, D, W + (size_t)col0 * D, D, 0, 32, acc);
    const unsigned col = col0 + fr, row = NL + rt * 16 + fq * 4;
    u32x2 o; o.x = pk2(acc[0][0], acc[0][1]); o.y = pk2(acc[0][2], acc[0][3]);
    if (col < 1024) {
      *(u32x2*)(kT + (col - 512) * T + row) = o;
      kb[(row + 0) * 512 + col - 512] = (bf16_t)(o.x & 0xffffu); kb[(row + 1) * 512 + col - 512] = (bf16_t)(o.x >> 16);
      kb[(row + 2) * 512 + col - 512] = (bf16_t)(o.y & 0xffffu); kb[(row + 3) * 512 + col - 512] = (bf16_t)(o.y >> 16);
    } else *(u32x2*)(vT + (col - 1024) * T + row) = o;
  }
  const float* bgt = p.in[29];
  for (int u = blockIdx.x * 8 + wv; u < T / 16; u += gridDim.x * 8) {
    f32x4 acc[2] = {(f32x4){0.f, 0.f, 0.f, 0.f}, (f32x4){0.f, 0.f, 0.f, 0.f}};
    wave_gemm16<2>(hA + (size_t)(u * 16) * D, D, W + (size_t)3072 * D, D, 0, 32, acc);
#pragma unroll
    for (int n = 0; n < 2; ++n) {
      const int jj = n * 16 + fr; const float bb = bgt[jj];
#pragma unroll
      for (int j = 0; j < 4; ++j) {
        const float g = acc[n][j] + bb;
        gl[(size_t)(u * 16 + fq * 4 + j) * 32 + jj] = ((jj >> 3) & 1) ? (fminf(g, 0.f) - log1pf(__expf(-fabsf(g)))) : g;
      }
    }
  }
}

template <int WHICH>
DEV void ph_gemm_dense(const Params& p, char* smem) {
  pg8::StaticOrder S;
  LAS unsigned char* lds = (LAS unsigned char*)smem;
  if constexpr (WHICH == 0) {
    S.init(T, 2560, gridDim.x, blockIdx.x);
    EpiRgIn E{(bf16_t*)(p.ws + WS_GG), (bf16_t*)(p.ws + WS_PR)};
    pg8::gemm_phase<EpiRgIn, pg8::StaticOrder>(lds, pg8::Gemm{(const bf16_t*)(p.ws + WS_HA), (const bf16_t*)(p.ws + WS_WIN), T, 2560, 1024}, S, E, nullptr);
  } else if constexpr (WHICH == 1) {
    S.init(NL, 1024, gridDim.x, blockIdx.x);
    EpiOut<0> E{p.in[0], p.in[2], nullptr, (const float*)(p.ws + WS_MODS), (bf16_t*)(p.ws + WS_X1)};
    pg8::gemm_phase<EpiOut<0>, pg8::StaticOrder>(lds, pg8::Gemm{(const bf16_t*)(p.ws + WS_PR), (const bf16_t*)(p.ws + WS_WOUT), NL, 1024, 1280}, S, E, nullptr);
  } else if constexpr (WHICH == 2) {
    S.init(NL, 3072, gridDim.x, blockIdx.x);
    EpiMlIn E{(bf16_t*)(p.ws + WS_Q), (bf16_t*)(p.ws + WS_K), (bf16_t*)(p.ws + WS_KT), (bf16_t*)(p.ws + WS_VT), (bf16_t*)(p.ws + WS_OG)};
    pg8::gemm_phase<EpiMlIn, pg8::StaticOrder>(lds, pg8::Gemm{(const bf16_t*)(p.ws + WS_HA), (const bf16_t*)(p.ws + WS_WML), NL, 3072, 1024}, S, E, nullptr);
  } else {
    S.init(NL, 1024, gridDim.x, blockIdx.x);
    EpiOut<1> E{nullptr, nullptr, (const bf16_t*)(p.ws + WS_X2), (const float*)(p.ws + WS_MODS) + 2 * 6144, (bf16_t*)(p.ws + WS_X1)};
    pg8::gemm_phase<EpiOut<1>, pg8::StaticOrder>(lds, pg8::Gemm{(const bf16_t*)(p.ws + WS_HA), (const bf16_t*)(p.ws + WS_WMO), NL, 1024, 1024}, S, E, nullptr);
  }
}
template <int LAYER, int STAGE>
DEV void ph_gemm_moe(const Params& p, char* smem) {
  const int* cnt = (const int*)(p.ws + WS_CNT) + LAYER * 32 * CNT_STRIDE;
  moe_tables(cnt, smem, 4);
  MoeOrder S{(const int*)(smem + LDS_TB), 4, (int)gridDim.x, (int)blockIdx.x};
  LAS unsigned char* lds = (LAS unsigned char*)smem;
  if constexpr (STAGE == 0) {
    EpiMoe1 E{(bf16_t*)(p.ws + WS_HM)};
    pg8::gemm_phase<EpiMoe1, MoeOrder>(lds, pg8::Gemm{(const bf16_t*)(p.ws + WS_ABUF), (const bf16_t*)(p.ws + WS_WGU), MOE_ROWS, 32 * 1024, 1024}, S, E, nullptr);
  } else {
    EpiMoe2 E{(bf16_t*)(p.ws + WS_Y), (const float*)(p.ws + WS_AWP)};
    pg8::gemm_phase<EpiMoe2, MoeOrder>(lds, pg8::Gemm{(const bf16_t*)(p.ws + WS_HM), (const bf16_t*)(p.ws + WS_WD), MOE_ROWS, 32 * 1024, 512}, S, E, nullptr);
  }
}

template <int LAYER>
DEV void ph_scatter(const Params& p, char* smem, int bid, int nb) {
  const int tid = tidx(), lane = tid & 63, wave = tid >> 6;
  constexpr int NTOK = LAYER == 0 ? T : NL;
  constexpr int NU = NTOK / 16;
  int* cnt = (int*)(p.ws + WS_CNT) + LAYER * 32 * CNT_STRIDE;
  const int* eid = (const int*)(p.ws + WS_LIST); const int* hstg = eid + T;
  const float* aw = (const float*)(p.ws + WS_AW);
  int* pos = (int*)(p.ws + WS_POS); float* awp = (float*)(p.ws + WS_AWP);
  const bf16_t* hA = (const bf16_t*)(p.ws + WS_HA); bf16_t* Ab = (bf16_t*)(p.ws + WS_ABUF);
  int* part = (int*)smem;
  int* base = part + 512;
  int* dstl = base + 32;
  {
    const int e = tid & 31, pt = tid >> 5; int tot = 0, below = 0;
    for (int v = pt * (nb / 8); v < (pt + 1) * (nb / 8); ++v) { const int h = hstg[v * 32 + e]; tot += h; below += v < bid ? h : 0; }
    part[(pt * 32 + e) * 2] = tot; part[(pt * 32 + e) * 2 + 1] = below;
  }
  __syncthreads();
  if (tid == 0) {
    int o = 0;
    for (int e = 0; e < 32; ++e) {
      int tot = 0, below = 0;
      for (int pt = 0; pt < 8; ++pt) { tot += part[(pt * 32 + e) * 2]; below += part[(pt * 32 + e) * 2 + 1]; }
      base[e] = o + below; o += ((tot + 255) >> 8) << 8;
      if (bid == 0) cnt[e * CNT_STRIDE] = tot;
    }
    for (int it = 0; bid + it * nb < NU; ++it) {
      const int t0 = (bid + it * nb) * 16;
      for (int i = 0; i < 16; ++i) {
        const int ee = eid[t0 + i], ea = ee & 255, eb = ee >> 8;
        const int da = base[ea]++, db = base[eb]++;
        dstl[it * 32 + 2 * i] = da; dstl[it * 32 + 2 * i + 1] = db;
      }
    }
  }
  __syncthreads();
  for (int it = 0; bid + it * nb < NU; ++it) {
    const int t0 = (bid + it * nb) * 16;
    if (tid < 32) { const int d = dstl[it * 32 + tid]; pos[2 * t0 + tid] = d; awp[d] = aw[2 * t0 + tid]; }
#pragma unroll
    for (int hh = 0; hh < 2; ++hh) {
      u32x4 v0[4], v1[4];
#pragma unroll
      for (int q = 0; q < 4; ++q) { const int a = wave * 8 + hh * 4 + q; const u32x4* src = (const u32x4*)(hA + (size_t)(t0 + (a >> 1)) * D); v0[q] = src[lane]; v1[q] = src[lane + 64]; }
#pragma unroll
      for (int q = 0; q < 4; ++q) { const int a = wave * 8 + hh * 4 + q; u32x4* d = (u32x4*)(Ab + (size_t)dstl[it * 32 + a] * D); d[lane] = v0[q]; d[lane + 64] = v1[q]; }
    }
  }
  __syncthreads();
}

constexpr int RT_STRIDE = 2064;
constexpr int RT_H2 = 0, RT_LO = 16 * RT_STRIDE, RT_RED = 2 * 16 * RT_STRIDE, RT_SMEM = RT_RED + 4 * 16 * 48 * 4;
constexpr int R2_ASTR = 528;
constexpr int R2_AH = 0, R2_AL = 80 * R2_ASTR, R2_RSTD = 2 * 80 * R2_ASTR;
constexpr int R2_RED = 0, R2_LG = 8 * 80 * 48 * 4, R2_HIST = R2_LG + 80 * 48 * 4, R2_SMEM = R2_HIST + 128;
template <int LAYER>
DEV void ph_router2(const Params& p, char* smem) {
  const int tf = tidf(), lane = tf & 63, wv = tf >> 6, fr = lane & 15, fq = lane >> 4;
  const int b = blockIdx.x;
  const bool has_ctx = LAYER == 0 && b < 16;
  const int nrow = has_ctx ? 80 : 64, nmt = has_ctx ? 5 : 4;
  const float* mods = (const float*)(p.ws + WS_MODS) + LAYER * 2 * 6144;
  const bf16_t* x1 = (const bf16_t*)(p.ws + WS_X1);
  bf16_t* hA = (bf16_t*)(p.ws + WS_HA);
  const float* g2 = p.in[LAYER == 0 ? 7 : 27];
  const float* Bg = p.in[LAYER == 0 ? 18 : 33]; const float* Be = p.in[LAYER == 0 ? 20 : 35];
  int* eid = (int*)(p.ws + WS_LIST); int* hstg = eid + T; float* aw = (float*)(p.ws + WS_AW);
  char* AH = smem + R2_AH; char* AL = smem + R2_AL; float* rstd_s = (float*)(smem + R2_RSTD);
  float* red = (float*)(smem + R2_RED); float* lgt = (float*)(smem + R2_LG); int* hist = (int*)(smem + R2_HIST);
  auto tok_of = [&](int r) { return r < 64 ? b * 64 + r : NL + b * 16 + (r - 64); };
  if (tf < 32) hist[tf] = 0;
  for (int rb = 0; rb < nrow; rb += 32) {
    f32x4 v[4][4]; float ss[4];
#pragma unroll
    for (int q = 0; q < 4; ++q) {
      const int r = rb + wv + 8 * q; const int t = tok_of(r < nrow ? r : 0);
      const bf16_t* src = x1 + (size_t)t * D;
#pragma unroll
      for (int i = 0; i < 4; ++i) v[q][i] = ld_bf4(src + 4 * lane + 256 * i);
    }
#pragma unroll
    for (int q = 0; q < 4; ++q) {
      ss[q] = 0.f;
#pragma unroll
      for (int i = 0; i < 4; ++i) ss[q] += v[q][i].x * v[q][i].x + v[q][i].y * v[q][i].y + v[q][i].z * v[q][i].z + v[q][i].w * v[q][i].w;
      ss[q] = rsqrtf(wave_sum(ss[q]) * (1.f / D) + EPS);
    }
#pragma unroll
    for (int q = 0; q < 4; ++q) {
      const int r = rb + wv + 8 * q;
      if (r < nrow) {
        const int t = tok_of(r);
        const float* md = mods + ((LAYER == 0 && t >= NL) ? 6144 : 0);
        if (lane == 0) rstd_s[r] = ss[q];
#pragma unroll
        for (int i = 0; i < 4; ++i) {
          const int c = 4 * lane + 256 * i;
          const f32x4 g = *(const f32x4*)(g2 + c), sh = *(const f32x4*)(md + 3072 + c), sc = *(const f32x4*)(md + 4096 + c);
          const f32x4 h = v[q][i] * ss[q] * g * (1.f + sc) + sh;
          u32x2 o; o.x = pk2(h.x, h.y); o.y = pk2(h.z, h.w);
          *(u32x2*)(hA + (size_t)t * D + c) = o;
        }
      }
    }
  }
  __syncthreads();
  f32x4 acc[5][3];
#pragma unroll
  for (int m = 0; m < 5; ++m)
#pragma unroll
    for (int n = 0; n < 3; ++n) acc[m][n] = (f32x4){0.f, 0.f, 0.f, 0.f};
  const bf16_t* Wh = (const bf16_t*)(p.ws + WS_WR) + (size_t)(LAYER * 2) * 48 * 1024 + (size_t)fr * 1024 + fq * 8;
  const bf16_t* Wl = Wh + 48 * 1024;
#pragma unroll 1
  for (int c = 0; c < 4; ++c) {
    const int k = 256 * c + 4 * lane;
    const f32x4 g = *(const f32x4*)(g2 + k);
    f32x4 xv[10];
#pragma unroll
    for (int q = 0; q < 10; ++q) { const int r = wv + 8 * q; if (r < nrow) xv[q] = ld_bf4(x1 + (size_t)tok_of(r) * D + k); }
#pragma unroll
    for (int q = 0; q < 10; ++q) {
      const int r = wv + 8 * q;
      if (r < nrow) {
        const float* md = mods + ((LAYER == 0 && r >= 64) ? 6144 : 0);
        const f32x4 sh = *(const f32x4*)(md + 3072 + k), sc = *(const f32x4*)(md + 4096 + k);
        const f32x4 h = xv[q] * rstd_s[r] * g * (1.f + sc) + sh;
        u32x2 o; o.x = pk2(h.x, h.y); o.y = pk2(h.z, h.w);
        u32x2 l; l.x = pk2(h.x - bflo(o.x), h.y - bfhi(o.x)); l.y = pk2(h.z - bflo(o.y), h.w - bfhi(o.y));
        *(u32x2*)(AH + r * R2_ASTR + lane * 8) = o; *(u32x2*)(AL + r * R2_ASTR + lane * 8) = l;
      }
    }
    __syncthreads();
    bf16x8 bh[3], bl[3];
#pragma unroll
    for (int n = 0; n < 3; ++n) { bh[n] = *(const bf16x8*)(Wh + (size_t)n * 16 * 1024 + c * 256 + wv * 32); bl[n] = *(const bf16x8*)(Wl + (size_t)n * 16 * 1024 + c * 256 + wv * 32); }
#pragma unroll
    for (int m = 0; m < 5; ++m) {
      if (m < nmt) {
        const bf16x8 ah = *(const bf16x8*)(AH + (m * 16 + fr) * R2_ASTR + (wv * 32 + fq * 8) * 2), al = *(const bf16x8*)(AL + (m * 16 + fr) * R2_ASTR + (wv * 32 + fq * 8) * 2);
#pragma unroll
        for (int n = 0; n < 3; ++n) {
          acc[m][n] = __builtin_amdgcn_mfma_f32_16x16x32_bf16(al, bh[n], acc[m][n], 0, 0, 0);
          acc[m][n] = __builtin_amdgcn_mfma_f32_16x16x32_bf16(ah, bl[n], acc[m][n], 0, 0, 0);
          acc[m][n] = __builtin_amdgcn_mfma_f32_16x16x32_bf16(ah, bh[n], acc[m][n], 0, 0, 0);
        }
      }
    }
    __syncthreads();
  }
#pragma unroll
  for (int m = 0; m < 5; ++m)
    if (m < nmt) {
#pragma unroll
      for (int n = 0; n < 3; ++n)
#pragma unroll
        for (int j = 0; j < 4; ++j) red[(wv * 80 + m * 16 + fq * 4 + j) * 48 + n * 16 + fr] = acc[m][n][j];
    }
  __syncthreads();
  for (int i = tf; i < nrow * 48; i += 512) {
    float sm = 0.f;
#pragma unroll
    for (int w = 0; w < 8; ++w) sm += red[w * 80 * 48 + i];
    lgt[i] = sm;
  }
  __syncthreads();
  if (tf < nrow) {
    const int t = tok_of(tf);
    const float* lg = lgt + tf * 48;
    float gl[4];
#pragma unroll
    for (int i = 0; i < 4; ++i) gl[i] = lg[32 + i] + Bg[i];
    int grp = 0; float gm = gl[0];
#pragma unroll
    for (int i = 1; i < 4; ++i) if (gl[i] > gm) { gm = gl[i]; grp = i; }
    float den = 0.f;
#pragma unroll
    for (int i = 0; i < 4; ++i) den += __expf(gl[i] - gm);
    const float psel = 1.f / den;
    float v0 = -INFINITY, v1 = -INFINITY; int i0 = 0, i1 = 0;
    for (int i = 0; i < 8; ++i) {
      const float v = lg[grp * 8 + i] + Be[grp * 8 + i];
      if (v > v0) { v1 = v0; i1 = i0; v0 = v; i0 = i; }
      else if (v > v1) { v1 = v; i1 = i; }
    }
    const float e1 = __expf(v1 - v0);
    const float w0 = psel / (1.f + e1), w1 = psel * e1 / (1.f + e1);
    const int ea = grp * 8 + i0, eb = grp * 8 + i1;
    eid[t] = ea | (eb << 8);
    aw[2 * t] = w0; aw[2 * t + 1] = w1;
    atomicAdd(&hist[ea], 1); atomicAdd(&hist[eb], 1);
  }
  __syncthreads();
  if (tf < 32) hstg[b * 32 + tf] = hist[tf];
}

template <int LAYER>
DEV void ph_scatter2(const Params& p, char* smem) {
  const int tf = tidf(), lane = tf & 63, wv = tf >> 6;
  const int b = blockIdx.x, G = gridDim.x;
  const bool has_ctx = LAYER == 0 && b < 16;
  const int nrow = has_ctx ? 80 : 64;
  int* cnt = (int*)(p.ws + WS_CNT) + LAYER * 32 * CNT_STRIDE;
  const int* eid = (const int*)(p.ws + WS_LIST); const int* hstg = eid + T;
  const float* aw = (const float*)(p.ws + WS_AW);
  int* pos = (int*)(p.ws + WS_POS); float* awp = (float*)(p.ws + WS_AWP);
  const bf16_t* hA = (const bf16_t*)(p.ws + WS_HA); bf16_t* Ab = (bf16_t*)(p.ws + WS_ABUF);
  int* part = (int*)smem;
  int* base = part + 1024;
  int* dstl = base + 32;
  auto tok_of = [&](int r) { return r < 64 ? b * 64 + r : NL + b * 16 + (r - 64); };
  { const int e = tf & 31, pt = tf >> 5, per = (G + 15) / 16; int tot = 0, below = 0;
    for (int v = pt * per; v < (pt + 1) * per && v < G; ++v) { const int h = hstg[v * 32 + e]; tot += h; below += v < b ? h : 0; }
    part[(pt * 32 + e) * 2] = tot; part[(pt * 32 + e) * 2 + 1] = below; }
  __syncthreads();
  if (tf == 0) {
    int o = 0;
    for (int e = 0; e < 32; ++e) {
      int tot = 0, below = 0;
      for (int pt = 0; pt < 16; ++pt) { tot += part[(pt * 32 + e) * 2]; below += part[(pt * 32 + e) * 2 + 1]; }
      base[e] = o + below; o += ((tot + 255) >> 8) << 8;
      if (b == 0) cnt[e * CNT_STRIDE] = tot;
    }
    for (int r = 0; r < nrow; ++r) {
      const int ee = eid[tok_of(r)], ea = ee & 255, eb = ee >> 8;
      dstl[2 * r] = base[ea]++; dstl[2 * r + 1] = base[eb]++;
    }
  }
  __syncthreads();
  if (tf < 2 * nrow) { const int t = tok_of(tf >> 1), d = dstl[tf]; pos[2 * t + (tf & 1)] = d; awp[d] = aw[2 * t + (tf & 1)]; }
  for (int a0 = wv * 4; a0 < 2 * nrow; a0 += 32) {
    u32x4 v0[4], v1[4];
#pragma unroll
    for (int q = 0; q < 4; ++q) { const u32x4* src = (const u32x4*)(hA + (size_t)tok_of((a0 + q) >> 1) * D); v0[q] = src[lane]; v1[q] = src[lane + 64]; }
#pragma unroll
    for (int q = 0; q < 4; ++q) { u32x4* d = (u32x4*)(Ab + (size_t)dstl[a0 + q] * D); d[lane] = v0[q]; d[lane + 64] = v1[q]; }
  }
  __syncthreads();
}

DEV void ph_combine0(const Params& p, int bid, int nb) {
  const int lane = tidx() & 63, wave = tidx() >> 6;
  const float* mods0 = (const float*)(p.ws + WS_MODS); const float* mods1 = mods0 + 2 * 6144;
  const bf16_t* x1 = (const bf16_t*)(p.ws + WS_X1); bf16_t* x2 = (bf16_t*)(p.ws + WS_X2);
  const bf16_t* Y = (const bf16_t*)(p.ws + WS_Y); const int* pos = (const int*)(p.ws + WS_POS);
  bf16_t* hA = (bf16_t*)(p.ws + WS_HA);
  const float* g1 = p.in[26];
  for (int t0 = (bid * 4 + wave) * 2; t0 < T; t0 += nb * 8) {
    f32x4 xv[2][4]; u32x2 ya[2][4], yb[2][4];
#pragma unroll
    for (int q = 0; q < 2; ++q) {
      const int t = t0 + q;
      const bf16_t* Ya = Y + (size_t)pos[2 * t] * D; const bf16_t* Yb = Y + (size_t)pos[2 * t + 1] * D;
#pragma unroll
      for (int i = 0; i < 4; ++i) { const int c = 4 * lane + 256 * i; xv[q][i] = ld_bf4(x1 + (size_t)t * D + c); ya[q][i] = *(const u32x2*)(Ya + c); yb[q][i] = *(const u32x2*)(Yb + c); }
    }
#pragma unroll
    for (int q = 0; q < 2; ++q) {
      const int t = t0 + q;
      const float* m0 = mods0 + (t < NL ? 0 : 6144); const float* m1 = mods1 + (t < NL ? 0 : 6144);
      const int orow = t < NL ? seqrow_of_token(t) : t;
      float ss = 0.f;
#pragma unroll
      for (int i = 0; i < 4; ++i) {
        const int c = 4 * lane + 256 * i;
        const f32x4 gt = *(const f32x4*)(m0 + 5120 + c);
        f32x4 f; f.x = bflo(ya[q][i].x) + bflo(yb[q][i].x); f.y = bfhi(ya[q][i].x) + bfhi(yb[q][i].x); f.z = bflo(ya[q][i].y) + bflo(yb[q][i].y); f.w = bfhi(ya[q][i].y) + bfhi(yb[q][i].y);
        xv[q][i] = xv[q][i] + gt * f;
        st_bf4(x2 + (size_t)t * D + c, xv[q][i]);
        ss += xv[q][i].x * xv[q][i].x + xv[q][i].y * xv[q][i].y + xv[q][i].z * xv[q][i].z + xv[q][i].w * xv[q][i].w;
      }
      const float rstd = rsqrtf(wave_sum(ss) * (1.f / D) + EPS);
#pragma unroll
      for (int i = 0; i < 4; ++i) {
        const int c = 4 * lane + 256 * i;
        const f32x4 g = *(const f32x4*)(g1 + c), sh = *(const f32x4*)(m1 + c), sc = *(const f32x4*)(m1 + 1024 + c);
        const f32x4 h = xv[q][i] * rstd * g * (1.f + sc) + sh;
        u32x2 o; o.x = pk2(h.x, h.y); o.y = pk2(h.z, h.w);
        *(u32x2*)(hA + (size_t)orow * D + c) = o;
      }
    }
  }
}

DEV void ml_gate_scans(const float* gl, int r0, int h, float* li_f, float* cf, float* li_b, float* cb) {
  const int tid = tidx(), lane = tid & 63, wave = tid >> 6;
  if (tid < 128) { li_f[tid] = gl[(size_t)(r0 + tid) * 32 + h]; li_b[tid] = gl[(size_t)(r0 + tid) * 32 + 16 + h]; }
  if (wave == 0) {
    const float v0 = gl[(size_t)(r0 + 2 * lane) * 32 + 8 + h], v1 = gl[(size_t)(r0 + 2 * lane + 1) * 32 + 8 + h];
    const float s = v0 + v1; float inc = s;
#pragma unroll
    for (int o = 1; o < 64; o <<= 1) { const float t = __shfl_up(inc, o); if (lane >= o) inc += t; }
    const float ex = inc - s;
    cf[2 * lane] = ex + v0; cf[2 * lane + 1] = ex + s;
  } else if (wave == 1) {
    const float v0 = gl[(size_t)(r0 + 127 - 2 * lane) * 32 + 24 + h], v1 = gl[(size_t)(r0 + 126 - 2 * lane) * 32 + 24 + h];
    const float s = v0 + v1; float inc = s;
#pragma unroll
    for (int o = 1; o < 64; o <<= 1) { const float t = __shfl_up(inc, o); if (lane >= o) inc += t; }
    const float ex = inc - s;
    cb[127 - 2 * lane] = ex + v0; cb[126 - 2 * lane] = ex + s;
  }
}

constexpr int MLA_STRIDE = 272;
constexpr int MLA_AW = 0, MLA_BV = 2 * 64 * MLA_STRIDE, MLA_G = MLA_BV + 128 * MLA_STRIDE, MLA_SMEM = MLA_G + 6 * 128 * 4;
DEV void ph_ml_state(const Params& p, char* smem, int bid, int nb) {
  const int tid = tidx(), lane = tid & 63, wave = tid >> 6, fr = lane & 15, fq = lane >> 4;
  const float* gl = (const float*)(p.ws + WS_GL);
  const bf16_t* kT = (const bf16_t*)(p.ws + WS_KT); const bf16_t* vT = (const bf16_t*)(p.ws + WS_VT);
  float* UT = (float*)(p.ws + WS_UT); float* nvec = (float*)(p.ws + WS_NVEC); float* dec = (float*)(p.ws + WS_DEC);
  char* Aw = smem + MLA_AW; char* Bv = smem + MLA_BV;
  float* li_f = (float*)(smem + MLA_G); float* cf = li_f + 128; float* li_b = cf + 128; float* cb = li_b + 128; float* wf = cb + 128; float* wb = wf + 128;
  for (int it = 0, iters = (NTILE * 8 + nb - 1) / nb; it < iters; ++it) {
    int u = bid + it * nb; const bool active = u < NTILE * 8; if (!active) u = NTILE * 8 - 1;
    const int h = u % 8, c = u / 8, r0 = c * 128;
    __syncthreads();
    if (active) {
    ml_gate_scans(gl, r0, h, li_f, cf, li_b, cb);
    }
    __syncthreads();
    if (active) {
    if (tid < 128) { wf[tid] = __expf(cf[127] - cf[tid] + li_f[tid]); wb[tid] = __expf(cb[0] - cb[tid] + li_b[tid]); }
    if (tid == 0) { dec[(c * 8 + h) * 2] = __expf(cf[127]); dec[(c * 8 + h) * 2 + 1] = __expf(cb[0]); }
#pragma unroll
    for (int i = 0; i < 8; ++i) {
      const int f = tid + 256 * i, e = f >> 4, pc = f & 15;
      *(u32x4*)(Bv + e * MLA_STRIDE + pc * 16) = *(const u32x4*)(vT + (size_t)(h * 128 + e) * T + r0 + pc * 8);
    }
    }
    __syncthreads();
    if (active) {
#pragma unroll
    for (int i = 0; i < 4; ++i) {
      const int f = tid + 256 * i, d = f >> 4, pc = f & 15;
      const u32x4 kv = *(const u32x4*)(kT + (size_t)(h * 64 + d) * T + r0 + pc * 8);
      float k8[8] = {bflo(kv.x), bfhi(kv.x), bflo(kv.y), bfhi(kv.y), bflo(kv.z), bfhi(kv.z), bflo(kv.w), bfhi(kv.w)};
      u32x4 of, ob;
      of.x = pk2(k8[0] * wf[pc * 8 + 0], k8[1] * wf[pc * 8 + 1]); of.y = pk2(k8[2] * wf[pc * 8 + 2], k8[3] * wf[pc * 8 + 3]);
      of.z = pk2(k8[4] * wf[pc * 8 + 4], k8[5] * wf[pc * 8 + 5]); of.w = pk2(k8[6] * wf[pc * 8 + 6], k8[7] * wf[pc * 8 + 7]);
      ob.x = pk2(k8[0] * wb[pc * 8 + 0], k8[1] * wb[pc * 8 + 1]); ob.y = pk2(k8[2] * wb[pc * 8 + 2], k8[3] * wb[pc * 8 + 3]);
      ob.z = pk2(k8[4] * wb[pc * 8 + 4], k8[5] * wb[pc * 8 + 5]); ob.w = pk2(k8[6] * wb[pc * 8 + 6], k8[7] * wb[pc * 8 + 7]);
      *(u32x4*)(Aw + d * MLA_STRIDE + pc * 16) = of;
      *(u32x4*)(Aw + (64 + d) * MLA_STRIDE + pc * 16) = ob;
    }
    }
    __syncthreads();
    if (active) {
    if (tid < 128) {
      float s = 0.f;
      for (int pc = 0; pc < 16; ++pc) { const u32x4 v = *(const u32x4*)(Aw + tid * MLA_STRIDE + pc * 16);
        s += (bflo(v.x) + bfhi(v.x)) + (bflo(v.y) + bfhi(v.y)) + (bflo(v.z) + bfhi(v.z)) + (bflo(v.w) + bfhi(v.w)); }
      nvec[(size_t)((c * 8 + h) * 2 + (tid >> 6)) * 64 + (tid & 63)] = s;
    }
#pragma unroll
    for (int dir = 0; dir < 2; ++dir) {
      f32x4 acc[4][2];
#pragma unroll
      for (int m = 0; m < 4; ++m) { acc[m][0] = (f32x4){0.f, 0.f, 0.f, 0.f}; acc[m][1] = (f32x4){0.f, 0.f, 0.f, 0.f}; }
#pragma unroll
      for (int ks = 0; ks < 4; ++ks) {
        bf16x8 b[2];
#pragma unroll
        for (int n = 0; n < 2; ++n) b[n] = *(const bf16x8*)(Bv + (wave * 32 + n * 16 + fr) * MLA_STRIDE + (ks * 32 + fq * 8) * 2);
#pragma unroll
        for (int m = 0; m < 4; ++m) {
          const bf16x8 a = *(const bf16x8*)(Aw + (dir * 64 + m * 16 + fr) * MLA_STRIDE + (ks * 32 + fq * 8) * 2);
          acc[m][0] = __builtin_amdgcn_mfma_f32_16x16x32_bf16(a, b[0], acc[m][0], 0, 0, 0);
          acc[m][1] = __builtin_amdgcn_mfma_f32_16x16x32_bf16(a, b[1], acc[m][1], 0, 0, 0);
        }
      }
      float* Uo = UT + (size_t)((c * 8 + h) * 2 + dir) * 8192;
#pragma unroll
      for (int m = 0; m < 4; ++m)
#pragma unroll
        for (int n = 0; n < 2; ++n) *(f32x4*)(Uo + (wave * 32 + n * 16 + fr) * 64 + m * 16 + fq * 4) = acc[m][n];
    }
    }
  }
}

DEV void ph_ml_chain(const Params& p, int bid, int nb) {
  float* UT = (float*)(p.ws + WS_UT); float* nvec = (float*)(p.ws + WS_NVEC); const float* dec = (const float*)(p.ws + WS_DEC);
  const int total = 16 * (8192 + 64);
  for (int i = bid * 256 + tidx(); i < total; i += nb * 256) {
    const int hd = i / 8256, idx = i % 8256;
    const int dir = hd & 1;
    float* base = idx < 8192 ? UT + (size_t)hd * 8192 + idx : nvec + (size_t)hd * 64 + (idx - 8192);
    const size_t cstride = idx < 8192 ? (size_t)16 * 8192 : (size_t)16 * 64;
    float st = 0.f;
#pragma unroll 1
    for (int sb = 0; sb < NTILE; sb += 13) {
      float uv[13], dc[13];
#pragma unroll
      for (int j = 0; j < 13; ++j) {
        const int s = sb + j; const int c = dir == 0 ? (s < 2 ? 128 + s : s - 2) : 129 - s;
        uv[j] = base[(size_t)c * cstride]; dc[j] = dec[c * 16 + hd];
      }
#pragma unroll
      for (int j = 0; j < 13; ++j) {
        const int s = sb + j; const int c = dir == 0 ? (s < 2 ? 128 + s : s - 2) : 129 - s;
        base[(size_t)c * cstride] = st;
        st = dc[j] * st + uv[j];
      }
    }
  }
}

constexpr int MLC_QS = 0;
constexpr int MLC_KS = 9216;
constexpr int MLC_Q2 = MLC_KS + 18432;
constexpr int MLC_BS = MLC_Q2 + 17408;
constexpr int MLC_G  = MLC_BS + 18432;
constexpr int MLC_SMEM = MLC_G + (4 * 128 + 6 * 64) * 4;
DEV void ph_ml_out(const Params& p, char* smem, int bid, int nb) {
  const int tid = tidx(), lane = tid & 63, wave = tid >> 6, fr = lane & 15, fq = lane >> 4;
  const float* gl = (const float*)(p.ws + WS_GL);
  const bf16_t* qb = (const bf16_t*)(p.ws + WS_Q); const bf16_t* kb = (const bf16_t*)(p.ws + WS_K); const bf16_t* vT = (const bf16_t*)(p.ws + WS_VT);
  const bf16_t* og = (const bf16_t*)(p.ws + WS_OG);
  const float* UT = (const float*)(p.ws + WS_UT); const float* nvec = (const float*)(p.ws + WS_NVEC);
  bf16_t* yA = (bf16_t*)(p.ws + WS_HA);
  const float* ng = p.in[30];
  char* Qs = smem + MLC_QS; char* Ks = smem + MLC_KS; char* Ps = Ks; char* Q2 = smem + MLC_Q2; char* Bs = smem + MLC_BS;
  float* li_f = (float*)(smem + MLC_G); float* cf = li_f + 128; float* li_b = cf + 128; float* cb = li_b + 128;
  float* qn = cb + 128; float* sfq = qn + 128; float* sbq = sfq + 64; float* nv = sbq + 64;
  for (int it = 0, iters = ((128 * 2 * 8) + nb - 1) / nb; it < iters; ++it) {
    int u = bid + it * nb; const bool active = u < (128 * 2 * 8); if (!active) u = (128 * 2 * 8) - 1;
    const int h = u % 8, th = (u / 8) & 1, c = u / 16, r0 = c * 128, rt = r0 + th * 64;
    __syncthreads();
    ml_gate_scans(gl, r0, h, li_f, cf, li_b, cb);
    if (tid >= 128) nv[tid - 128] = nvec[(size_t)((c * 8 + h) * 2 + ((tid - 128) >> 6)) * 64 + (tid & 63)];
#pragma unroll
    for (int i = 0; i < 2; ++i) { const int f = tid + 256 * i, r = f >> 3, pc = f & 7;
      *(u32x4*)(Qs + r * 144 + pc * 16) = *(const u32x4*)(qb + (size_t)(rt + r) * 512 + h * 64 + pc * 8); }
#pragma unroll
    for (int i = 0; i < 4; ++i) { const int f = tid + 256 * i, r = f >> 3, pc = f & 7;
      *(u32x4*)(Ks + r * 144 + pc * 16) = *(const u32x4*)(kb + (size_t)(r0 + r) * 512 + h * 64 + pc * 8); }
    __syncthreads();
    if (tid < 128) {
      const int t = tid & 63, dir = tid >> 6; float s = 0.f;
      for (int pc = 0; pc < 8; ++pc) { const u32x4 v = *(const u32x4*)(Qs + t * 144 + pc * 16); const float* nn = nv + dir * 64 + pc * 8;
        s += bflo(v.x) * nn[0] + bfhi(v.x) * nn[1] + bflo(v.y) * nn[2] + bfhi(v.y) * nn[3] + bflo(v.z) * nn[4] + bfhi(v.z) * nn[5] + bflo(v.w) * nn[6] + bfhi(v.w) * nn[7]; }
      qn[dir * 64 + t] = s;
    }
    f32x4 S[8];
#pragma unroll
    for (int n = 0; n < 8; ++n) S[n] = (f32x4){0.f, 0.f, 0.f, 0.f};
#pragma unroll
    for (int ks = 0; ks < 2; ++ks) {
      const bf16x8 a = *(const bf16x8*)(Qs + (wave * 16 + fr) * 144 + (ks * 32 + fq * 8) * 2);
#pragma unroll
      for (int n = 0; n < 8; ++n) {
        const bf16x8 b = *(const bf16x8*)(Ks + (n * 16 + fr) * 144 + (ks * 32 + fq * 8) * 2);
        S[n] = __builtin_amdgcn_mfma_f32_16x16x32_bf16(a, b, S[n], 0, 0, 0);
      }
    }
    __syncthreads();
    float rfv[4], rbv[4];
    {
      float sumf[4] = {0.f, 0.f, 0.f, 0.f}, sumb[4] = {0.f, 0.f, 0.f, 0.f};
      float Sf[8][4], Sb_[8][4];
#pragma unroll
      for (int j = 0; j < 4; ++j) {
        const int tl = wave * 16 + fq * 4 + j, tc = th * 64 + tl;
        const float cft = cf[tc], cbt = cb[tc];
#pragma unroll
        for (int n = 0; n < 8; ++n) {
          const int s = n * 16 + fr;
          const float df = s <= tc ? fexp_(cft - cf[s] + li_f[s]) : 0.f;
          const float db = s >= tc ? fexp_(cbt - cb[s] + li_b[s]) : 0.f;
          Sf[n][j] = S[n][j] * df; Sb_[n][j] = S[n][j] * db;
          sumf[j] += Sf[n][j]; sumb[j] += Sb_[n][j];
        }
      }
#pragma unroll
      for (int j = 0; j < 4; ++j) {
#pragma unroll
        for (int o = 1; o < 16; o <<= 1) { sumf[j] += __shfl_xor(sumf[j], o); sumb[j] += __shfl_xor(sumb[j], o); }
        const int tl = wave * 16 + fq * 4 + j, tc = th * 64 + tl;
        const float ef = __expf(cf[tc]), eb = __expf(cb[tc]);
        const float denf = ef * qn[tl] + sumf[j], denb = eb * qn[64 + tl] + sumb[j];
        rfv[j] = __builtin_amdgcn_rcpf(fmaxf(fabsf(denf), 1.f)); rbv[j] = __builtin_amdgcn_rcpf(fmaxf(fabsf(denb), 1.f));
        if (fr == 0) { sfq[tl] = ef * rfv[j]; sbq[tl] = eb * rbv[j]; }
      }
#pragma unroll
      for (int n = 0; n < 8; ++n)
#pragma unroll
        for (int j = 0; j < 4; ++j) {
          const int tl = wave * 16 + fq * 4 + j;
          *(bf16_t*)(Ps + tl * MLA_STRIDE + (n * 16 + fr) * 2) = f2bf(Sf[n][j] * rfv[j] + Sb_[n][j] * rbv[j]);
        }
    }
    __syncthreads();
#pragma unroll
    for (int i = 0; i < 2; ++i) { const int f = tid + 256 * i, r = f >> 3, pc = f & 7;
      const u32x4 v = *(const u32x4*)(Qs + r * 144 + pc * 16); const float a = sfq[r], b = sbq[r];
      u32x4 o1, o2;
      o1.x = pk2(bflo(v.x) * a, bfhi(v.x) * a); o1.y = pk2(bflo(v.y) * a, bfhi(v.y) * a); o1.z = pk2(bflo(v.z) * a, bfhi(v.z) * a); o1.w = pk2(bflo(v.w) * a, bfhi(v.w) * a);
      o2.x = pk2(bflo(v.x) * b, bfhi(v.x) * b); o2.y = pk2(bflo(v.y) * b, bfhi(v.y) * b); o2.z = pk2(bflo(v.z) * b, bfhi(v.z) * b); o2.w = pk2(bflo(v.w) * b, bfhi(v.w) * b);
      *(u32x4*)(Q2 + r * MLA_STRIDE + pc * 16) = o1; *(u32x4*)(Q2 + r * MLA_STRIDE + 128 + pc * 16) = o2; }
    f32x4 Hh[8];
#pragma unroll
    for (int n = 0; n < 8; ++n) Hh[n] = (f32x4){0.f, 0.f, 0.f, 0.f};
#pragma unroll
    for (int kc = 0; kc < 4; ++kc) {
      __syncthreads();
      if (kc < 2) {
#pragma unroll
        for (int i = 0; i < 4; ++i) { const int f = tid + 256 * i, e = f >> 3, pc = f & 7;
          *(u32x4*)(Bs + e * 144 + pc * 16) = *(const u32x4*)(vT + (size_t)(h * 128 + e) * T + r0 + kc * 64 + pc * 8); }
      } else {
        const float* Cs = UT + (size_t)((c * 8 + h) * 2 + (kc - 2)) * 8192;
#pragma unroll
        for (int i = 0; i < 4; ++i) { const int f = tid + 256 * i, e = f >> 3, pc = f & 7;
          const f32x4 a = *(const f32x4*)(Cs + e * 64 + pc * 8), b = *(const f32x4*)(Cs + e * 64 + pc * 8 + 4);
          u32x4 o; o.x = pk2(a.x, a.y); o.y = pk2(a.z, a.w); o.z = pk2(b.x, b.y); o.w = pk2(b.z, b.w);
          *(u32x4*)(Bs + e * 144 + pc * 16) = o; }
      }
      __syncthreads();
      const char* Asrc = kc < 2 ? Ps + kc * 128 : Q2 + (kc - 2) * 128;
#pragma unroll
      for (int ks = 0; ks < 2; ++ks) {
        const bf16x8 a = *(const bf16x8*)(Asrc + (wave * 16 + fr) * MLA_STRIDE + (ks * 32 + fq * 8) * 2);
#pragma unroll
        for (int n = 0; n < 8; ++n) {
          const bf16x8 b = *(const bf16x8*)(Bs + (n * 16 + fr) * 144 + (ks * 32 + fq * 8) * 2);
          Hh[n] = __builtin_amdgcn_mfma_f32_16x16x32_bf16(a, b, Hh[n], 0, 0, 0);
        }
      }
    }
#pragma unroll
    for (int j = 0; j < 4; ++j) {
      float ss = 0.f;
#pragma unroll
      for (int n = 0; n < 8; ++n) ss += Hh[n][j] * Hh[n][j];
#pragma unroll
      for (int o = 1; o < 16; o <<= 1) ss += __shfl_xor(ss, o);
      const float rstd = rsqrtf(ss * (1.f / 128.f) + EPS);
      const size_t row = (size_t)(rt + wave * 16 + fq * 4 + j);
#pragma unroll
      for (int n = 0; n < 8; ++n) {
        const int col = h * 128 + n * 16 + fr;
        yA[row * D + col] = f2bf(Hh[n][j] * rstd * ng[col] * bf2f(og[row * D + col]));
      }
    }
  }
}

DEV void ph_final(const Params& p, int bid, int nb) {
  const int lane = tidx() & 63, wave = tidx() >> 6;
  const float* mods1 = (const float*)(p.ws + WS_MODS) + 2 * 6144;
  const bf16_t* x1 = (const bf16_t*)(p.ws + WS_X1);
  const bf16_t* Y = (const bf16_t*)(p.ws + WS_Y); const int* pos = (const int*)(p.ws + WS_POS);
  const float* gf = p.in[39];
  for (int t0 = (bid * 4 + wave) * 2; t0 < NL; t0 += nb * 8) {
    f32x4 xv[2][4]; u32x2 ya[2][4], yb[2][4];
#pragma unroll
    for (int q = 0; q < 2; ++q) {
      const int t = t0 + q;
      const bf16_t* Ya = Y + (size_t)pos[2 * t] * D; const bf16_t* Yb = Y + (size_t)pos[2 * t + 1] * D;
#pragma unroll
      for (int i = 0; i < 4; ++i) { const int c = 4 * lane + 256 * i; xv[q][i] = ld_bf4(x1 + (size_t)t * D + c); ya[q][i] = *(const u32x2*)(Ya + c); yb[q][i] = *(const u32x2*)(Yb + c); }
    }
#pragma unroll
    for (int q = 0; q < 2; ++q) {
      const int t = t0 + q;
      float ss = 0.f;
#pragma unroll
      for (int i = 0; i < 4; ++i) {
        const int c = 4 * lane + 256 * i;
        const f32x4 gt = *(const f32x4*)(mods1 + 5120 + c);
        f32x4 f; f.x = bflo(ya[q][i].x) + bflo(yb[q][i].x); f.y = bfhi(ya[q][i].x) + bfhi(yb[q][i].x); f.z = bflo(ya[q][i].y) + bflo(yb[q][i].y); f.w = bfhi(ya[q][i].y) + bfhi(yb[q][i].y);
        xv[q][i] = xv[q][i] + gt * f;
        ss += xv[q][i].x * xv[q][i].x + xv[q][i].y * xv[q][i].y + xv[q][i].z * xv[q][i].z + xv[q][i].w * xv[q][i].w;
      }
      const float rstd = rsqrtf(wave_sum(ss) * (1.f / D) + EPS);
#pragma unroll
      for (int i = 0; i < 4; ++i) {
        const int c = 4 * lane + 256 * i;
        *(f32x4*)(p.out + (size_t)t * D + c) = xv[q][i] * rstd * *(const f32x4*)(gf + c);
      }
    }
  }
}

#define XB_TMO      128
#define XB_XCNT(j)  (256  + 64 * (j))
#define XB_XSUB(j)  (1280 + 64 * (j))
#define XB_XGEN(j)  (2304 + 64 * (j))
#define XB_TOP      3328
#define XB_TOPGEN   3392
#define XCD_BAR_WORDS 3456
#define XB_SPIN_CAP (1u << 22)
DEV unsigned xb_ld(unsigned* p)              { return __hip_atomic_load(p, __ATOMIC_RELAXED, __HIP_MEMORY_SCOPE_AGENT); }
DEV unsigned xb_add(unsigned* p, unsigned v) { return __hip_atomic_fetch_add(p, v, __ATOMIC_RELAXED, __HIP_MEMORY_SCOPE_AGENT); }
DEV unsigned xb_xcc_id() { return (unsigned)__builtin_amdgcn_s_getreg((3 << 11) | 20) & 0xFu; }
#define XB_SPIN(cond, bar) do { unsigned _sp = 0; while (cond) { __builtin_amdgcn_s_sleep(1); \
    if ((++_sp & 255u) == 0u) { if (xb_ld(&(bar)[XB_TMO])) break; if (_sp > XB_SPIN_CAP) { atomicAdd(&(bar)[XB_TMO], 1u); break; } } } } while (0)
struct XcdBarrier { unsigned* bar; unsigned x; volatile LAS unsigned* st; };
DEV XcdBarrier xcd_barrier_post(unsigned* bar, volatile LAS unsigned* st) {
  XcdBarrier b; b.bar = bar; b.x = xb_xcc_id(); b.st = st;
  if (threadIdx.x == 0) (void)xb_add(&bar[XB_XCNT(b.x)], 1u);
  return b;
}
DEV void xcd_barrier_complete(unsigned* bar, unsigned x, unsigned& nloc, unsigned& nx) {
  const unsigned G = gridDim.x * gridDim.y * gridDim.z;
  unsigned sum, cnt, mine, sp = 0u;
  for (;;) {
    sum = 0u; cnt = 0u; mine = 0u;
#pragma unroll
    for (unsigned j = 0; j < 16; ++j) { const unsigned c = xb_ld(&bar[XB_XCNT(j)]); sum += c; cnt += (c > 0u) ? 1u : 0u; mine = (j == x) ? c : mine; }
    if (sum == G) break;
    __builtin_amdgcn_s_sleep(1);
    if ((++sp & 255u) == 0u) { if (xb_ld(&bar[XB_TMO])) break; if (sp > XB_SPIN_CAP) { atomicAdd(&bar[XB_TMO], 1u); break; } }
  }
  nloc = mine > 0u ? mine : 1u; nx = cnt > 0u ? cnt : 1u;
}
DEV void xcd_barrier(const XcdBarrier& b) {
  asm volatile("s_waitcnt vmcnt(0)" ::: "memory");
  __syncthreads();
  if (threadIdx.x == 0) {
    unsigned* bar = b.bar;
    __builtin_amdgcn_s_waitcnt(0);
    unsigned nloc = b.st[0], nx = b.st[1];
    if (nloc == 0u) { xcd_barrier_complete(bar, b.x, nloc, nx); b.st[0] = nloc; b.st[1] = nx; }
    const unsigned old = xb_add(&bar[XB_XSUB(b.x)], 1u);
    const unsigned gen = old / nloc;
    if (old + 1u == (gen + 1u) * nloc) {
      __builtin_amdgcn_fence(__ATOMIC_RELEASE, "agent");
      asm volatile("s_waitcnt vmcnt(0)" ::: "memory");
      const unsigned og = xb_add(&bar[XB_TOP], 1u);
      const unsigned tg = og / nx;
      if (og + 1u == (tg + 1u) * nx) xb_add(&bar[XB_TOPGEN], 1u);
      else XB_SPIN(xb_ld(&bar[XB_TOPGEN]) == tg, bar);
      __builtin_amdgcn_fence(__ATOMIC_ACQUIRE, "agent");
      xb_add(&bar[XB_XGEN(b.x)], 1u);
      asm volatile("s_waitcnt vmcnt(0)" ::: "memory");
    } else {
      XB_SPIN(xb_ld(&bar[XB_XGEN(b.x)]) == gen, bar);
      __builtin_amdgcn_fence(__ATOMIC_ACQUIRE, "agent");
      asm volatile("s_waitcnt vmcnt(0)" ::: "memory");
    }
  }
  __syncthreads();
}

#ifndef REP_MASK
#define REP_MASK 0u
#endif
#ifndef PROBE_PH
#define PROBE_PH -1
#endif
#ifndef PROBE_M
#define PROBE_M 4
#endif
#ifndef XBAR
#define XBAR 0
#endif
constexpr int NPHASE = 22;
constexpr int HALF_SMEM = 78592;
constexpr int LDS_ST = 2 * HALF_SMEM;
constexpr int LDS_BYTES = LDS_ST + 16 + 32;
static_assert(RT_SMEM + 128 <= HALF_SMEM && RG_SMEM <= HALF_SMEM && MLA_SMEM <= HALF_SMEM && MLC_SMEM <= HALF_SMEM, "smem");
static_assert(LDS_TB + 66 * 4 <= LDS_ST && 8 * 8448 <= LDS_ST, "smem");

template <int PH>
DEV void run_phase(const Params& p, char* smem) {
  int half = threadIdx.x >> 8; asm volatile("" : "+v"(half)); half = __builtin_amdgcn_readfirstlane(half);
  char* hs = smem + half * HALF_SMEM;
  const int vb = blockIdx.x * 2 + half, nvb = gridDim.x * 2;
  if constexpr (PH == 0) { ph_adaln(p, hs, vb, nvb); __syncthreads(); ph_convert_dense(p, smem); ph_convert_moe<0>(p, smem); }
  else if constexpr (PH == 1) ph_norm0(p, vb, nvb);
  else if constexpr (PH == 2) ph_gemm_dense<0>(p, smem);
  else if constexpr (PH == 3) ph_rg_scan2(p, smem);
  else if constexpr (PH == 4) ph_rg_carry(p, hs, vb, nvb);
  else if constexpr (PH == 5) ph_rg_final(p, vb, nvb);
  else if constexpr (PH == 6) { ph_out0_ctx(p, smem); ph_gemm_dense<1>(p, smem); }
  else if constexpr (PH == 7) ph_router2<0>(p, smem);
  else if constexpr (PH == 8) ph_scatter2<0>(p, smem);
  else if constexpr (PH == 9) ph_gemm_moe<0, 0>(p, smem);
  else if constexpr (PH == 10) ph_gemm_moe<0, 1>(p, smem);
  else if constexpr (PH == 11) { ph_combine0(p, vb, nvb); ph_convert_moe<1>(p, smem); }
  else if constexpr (PH == 12) { ph_mlin_small(p); ph_gemm_dense<2>(p, smem); }
  else if constexpr (PH == 13) ph_ml_state(p, hs, vb, nvb);
  else if constexpr (PH == 14) ph_ml_chain(p, vb, nvb);
  else if constexpr (PH == 15) ph_ml_out(p, hs, vb, nvb);
  else if constexpr (PH == 16) ph_gemm_dense<3>(p, smem);
  else if constexpr (PH == 17) ph_router2<1>(p, smem);
  else if constexpr (PH == 18) ph_scatter2<1>(p, smem);
  else if constexpr (PH == 19) ph_gemm_moe<1, 0>(p, smem);
  else if constexpr (PH == 20) ph_gemm_moe<1, 1>(p, smem);
  else if constexpr (PH == 21) ph_final(p, vb, nvb);
}

template <int PH>
DEV void run_from(const Params& p, char* smem) {
  run_phase<PH>(p, smem);
  if constexpr ((REP_MASK >> PH) & 1u) {
    __syncthreads();
    run_phase<PH>(p, smem);
  }
  if constexpr (XBAR > 0 && PH + 1 < NPHASE) {
#pragma unroll 1
    for (int xi = 0; xi < XBAR; ++xi) { XcdBarrier xb; xb.bar = (unsigned*)(p.ws + WS_BAR); xb.x = xb_xcc_id(); xb.st = (volatile LAS unsigned*)(LAS char*)(smem + LDS_ST); xcd_barrier(xb); }
  }
  if constexpr (PH + 1 < NPHASE) {
    XcdBarrier xb; xb.bar = (unsigned*)(p.ws + WS_BAR); xb.x = xb_xcc_id(); xb.st = (volatile LAS unsigned*)(LAS char*)(smem + LDS_ST);
    xcd_barrier(xb);
    if constexpr (PROBE_PH >= 0 && (PH == PROBE_PH || PH + 1 == PROBE_PH)) {
      if (blockIdx.x == 0 && threadIdx.x == 0) { volatile LAS unsigned long long* ts = (volatile LAS unsigned long long*)(LAS char*)(smem + LDS_ST + 16); ts[PH == PROBE_PH ? 1 : 0] = __builtin_amdgcn_s_memrealtime(); }
    }
    run_from<PH + 1>(p, smem);
  } else if constexpr (PROBE_PH >= 0) {
    if (blockIdx.x == 0 && threadIdx.x == 0) {
      volatile LAS unsigned long long* ts = (volatile LAS unsigned long long*)(LAS char*)(smem + LDS_ST + 16);
      const unsigned long long now = __builtin_amdgcn_s_memrealtime();
      const unsigned long long t1 = PROBE_PH == NPHASE - 1 ? now : ts[1];
      const unsigned long long span = (t1 - ts[0]) * PROBE_M;
      while (__builtin_amdgcn_s_memrealtime() - now < span) __builtin_amdgcn_s_sleep(8);
    }
  }
}

__global__ void __launch_bounds__(512) mega_kernel(Params p) {
  extern __shared__ __attribute__((aligned(16))) char smem[];
  volatile LAS unsigned* st = (volatile LAS unsigned*)(LAS char*)(smem + LDS_ST);
  if (threadIdx.x == 0) { st[0] = 0u; st[1] = 0u; st[2] = 0u; st[3] = 0u; }
  __syncthreads();
  (void)xcd_barrier_post((unsigned*)(p.ws + WS_BAR), st);
  if (PROBE_PH == 0 && blockIdx.x == 0 && threadIdx.x == 0) { volatile LAS unsigned long long* ts = (volatile LAS unsigned long long*)(LAS char*)(smem + LDS_ST + 16); ts[0] = __builtin_amdgcn_s_memrealtime(); }
  run_from<0>(p, smem);
}

extern "C" void kernel_launch(void* const* d_in, const int* in_sizes, int n_in, void* d_out, int out_size, void* d_ws, size_t ws_size, hipStream_t stream) {
  static int grid = 0;
  if (grid == 0) {
    if (n_in != 40 || ws_size < WS_END) { fprintf(stderr, "kernel_launch: unexpected inputs (n_in %d, ws %zu, need %zu)\n", n_in, ws_size, (size_t)WS_END); grid = -1; return; }
    int dev = 0, cus = 0, per_cu = 0;
    if (hipGetDevice(&dev) != hipSuccess || hipDeviceGetAttribute(&cus, hipDeviceAttributeMultiprocessorCount, dev) != hipSuccess) { grid = -1; return; }
    if (hipFuncSetAttribute((const void*)mega_kernel, hipFuncAttributeMaxDynamicSharedMemorySize, LDS_BYTES) != hipSuccess) { fprintf(stderr, "kernel_launch: hipFuncSetAttribute failed\n"); grid = -1; return; }
    if (hipOccupancyMaxActiveBlocksPerMultiprocessor(&per_cu, (const void*)mega_kernel, 512, LDS_BYTES) != hipSuccess || per_cu < 1) { fprintf(stderr, "kernel_launch: occupancy query failed (%d)\n", per_cu); grid = -1; return; }
    grid = cus;
    fprintf(stderr, "kernel_launch: %d CUs, occupancy %d\n", cus, per_cu);
  }
  if (grid < 0) return;
  Params p{};
  for (int i = 0; i < 40; ++i) p.in[i] = (const float*)d_in[i];
  p.out = (float*)d_out; p.ws = (char*)d_ws;
  if (hipMemsetAsync((char*)d_ws, 0, WS_ZERO_BYTES, stream) != hipSuccess) return;
  void* args[] = {&p};
  hipError_t e = hipLaunchCooperativeKernel((const void*)mega_kernel, dim3(grid), dim3(512), args, LDS_BYTES, stream);
  if (e != hipSuccess) fprintf(stderr, "cooperative launch failed: %s (grid %d)\n", hipGetErrorString(e), grid);
}
```

```cpp
#include <hip/hip_runtime.h>
#include <cstdio>
#include <cstdint>

#define DEV __device__ __forceinline__
typedef unsigned short bf16_t;
typedef short bf16x8 __attribute__((ext_vector_type(8)));
typedef short s16x4 __attribute__((ext_vector_type(4)));
typedef float f32x4 __attribute__((ext_vector_type(4)));
typedef unsigned u32x4 __attribute__((ext_vector_type(4)));
typedef unsigned u32x2 __attribute__((ext_vector_type(2)));
#define LAS __attribute__((address_space(3)))

constexpr int D = 1024, NL = 16384, NC = 256, T = NL + NC, NTILE = T / 128;
constexpr int DR = 1280, NEXP = 32, DE = 512;
constexpr int RGT = 64, NRT = T / RGT, NRT_LAT = NL / RGT;
constexpr int MLW = 3104, MLWP = 3328;
constexpr int MOE_ROWS = 41472;
constexpr float EPS = 1e-6f;

constexpr size_t al256(size_t x) { return (x + 255) & ~(size_t)255; }
constexpr size_t WS_BAR   = 0;
constexpr size_t WS_CNT   = 16384;
constexpr int CNT_STRIDE = 64;
constexpr size_t WS_ZERO_BYTES = 16384 + 2 * 32 * CNT_STRIDE * 4;
constexpr size_t WS_MODS  = 32768;
constexpr size_t WS_LIST  = WS_MODS + al256(2 * 2 * 6144 * 4);
constexpr size_t WS_AW    = WS_LIST + al256((size_t)2 * 32 * T * 4);
constexpr size_t WS_POS   = WS_AW + al256((size_t)2 * T * 4);
constexpr size_t WS_AWP   = WS_POS + al256((size_t)2 * T * 4);
constexpr size_t WS_AGG   = WS_AWP + al256((size_t)MOE_ROWS * 4);
constexpr size_t WS_CARRY = WS_AGG + al256((size_t)2 * NRT * DR * 2 * 4);
constexpr size_t WS_GL    = WS_CARRY + al256((size_t)2 * NRT * DR * 4);
constexpr size_t WS_NVEC  = WS_GL + al256((size_t)T * 32 * 4);
constexpr size_t WS_DEC   = WS_NVEC + al256((size_t)NTILE * 16 * 64 * 4);
constexpr size_t WS_WIN   = WS_DEC + al256((size_t)NTILE * 16 * 4);
constexpr size_t WS_WOUT  = WS_WIN + al256((size_t)2560 * 1024 * 2);
constexpr size_t WS_WML   = WS_WOUT + al256((size_t)1024 * 1280 * 2);
constexpr size_t WS_WMO   = WS_WML + al256((size_t)MLWP * 1024 * 2);
constexpr size_t WS_WGU   = WS_WMO + al256((size_t)1024 * 1024 * 2);
constexpr size_t WS_WD    = WS_WGU + al256((size_t)32 * 1024 * 1024 * 2);
constexpr size_t WS_WAXT  = WS_WD + al256((size_t)32 * 1024 * 512 * 2);
constexpr size_t WS_WR    = WS_WAXT + al256((size_t)40 * 16384 * 2);
constexpr size_t WS_HA    = WS_WR + al256((size_t)2 * 64 * 64 * 12 * 4);
constexpr size_t WS_X1    = WS_HA + al256((size_t)T * D * 2);
constexpr size_t WS_X2    = WS_X1 + al256((size_t)T * D * 2);
constexpr size_t WS_R0    = WS_X2 + al256((size_t)T * D * 2);
constexpr size_t WS_GG    = WS_R0;
constexpr size_t WS_PR    = WS_GG + al256((size_t)T * DR * 2);
constexpr size_t WS_S     = WS_PR + al256((size_t)T * DR * 2);
constexpr size_t WS_PF    = WS_S + al256((size_t)T * DR * 2);
constexpr size_t WS_PB    = WS_PF + al256((size_t)T * DR * 2);
constexpr size_t WS_R0END = WS_PB + al256((size_t)T * DR * 2);
constexpr size_t WS_ABUF  = WS_R0;
constexpr size_t WS_HM    = WS_ABUF + al256((size_t)MOE_ROWS * D * 2);
constexpr size_t WS_Y     = WS_HM + al256((size_t)MOE_ROWS * DE * 2);
constexpr size_t WS_MOEEND = WS_Y + al256((size_t)MOE_ROWS * D * 2);
constexpr size_t WS_Q     = WS_R0;
constexpr size_t WS_K     = WS_Q + al256((size_t)T * 512 * 2);
constexpr size_t WS_KT    = WS_K + al256((size_t)T * 512 * 2);
constexpr size_t WS_VT    = WS_KT + al256((size_t)T * 512 * 2);
constexpr size_t WS_OG    = WS_VT + al256((size_t)T * D * 2);
constexpr size_t WS_UT    = WS_OG + al256((size_t)T * D * 2);
constexpr size_t WS_L1END = WS_UT + al256((size_t)NTILE * 16 * 8192 * 4);
constexpr size_t cmax(size_t a, size_t b) { return a > b ? a : b; }
constexpr size_t WS_END   = cmax(cmax(WS_R0END, WS_L1END), WS_MOEEND);

struct Params {
  const float* in[40];
  float* out;
  char* ws;
};

typedef __bf16 bf16v2_t __attribute__((ext_vector_type(2)));
typedef float f32x2_t __attribute__((ext_vector_type(2)));
DEV unsigned pk2(float lo, float hi) { const f32x2_t v = {lo, hi}; return __builtin_bit_cast(unsigned, __builtin_convertvector(v, bf16v2_t)); }
DEV float bflo(unsigned u) { return __uint_as_float(u << 16); }
DEV float bfhi(unsigned u) { return __uint_as_float(u & 0xffff0000u); }
DEV float bf2f(bf16_t b) { return __uint_as_float((unsigned)b << 16); }
DEV bf16_t f2bf(float f) { return (bf16_t)(pk2(f, 0.f) & 0xffffu); }
DEV float fexp_(float x) { return __builtin_amdgcn_exp2f(x * 1.4426950408889634f); }
DEV float sigmoidf_(float x) { return __builtin_amdgcn_rcpf(1.f + __builtin_amdgcn_exp2f(x * -1.4426950408889634f)); }
DEV float siluf_(float x) { return x * sigmoidf_(x); }
DEV float gelu_tanh(float x) { const float u = 0.7978845608028654f * (x + 0.044715f * x * x * x); return x * sigmoidf_(2.f * u); }
DEV float wave_sum(float v) {
#pragma unroll
  for (int o = 1; o < 64; o <<= 1) v += __shfl_xor(v, o);
  return v;
}
DEV s16x4 ldtr(const char* p) { return __builtin_bit_cast(s16x4, __builtin_amdgcn_ds_read_tr16_b64_v4i16((LAS s16x4*)p)); }
DEV f32x4 ld_bf4(const bf16_t* p) { const u32x2 v = *(const u32x2*)p; return (f32x4){bflo(v.x), bfhi(v.x), bflo(v.y), bfhi(v.y)}; }
DEV void st_bf4(bf16_t* p, const f32x4 v) { u32x2 o; o.x = pk2(v.x, v.y); o.y = pk2(v.z, v.w); *(u32x2*)p = o; }
DEV int tidx() { int t = threadIdx.x & 255; asm volatile("" : "+v"(t)); return t; }
DEV int tidf() { int t = threadIdx.x; asm volatile("" : "+v"(t)); return t; }
DEV int seqrow_of_token(int t) { return (t & 63) * 256 + (t >> 6); }
DEV int token_of_seqrow(int s) { return (s & 255) * 64 + (s >> 8); }

constexpr int BS_STRIDE = 320;
DEV int bs_off(int k, int n) { return k * BS_STRIDE + ((((n >> 4) ^ ((k >> 3) & 1))) << 5) + (n & 15) * 2; }

namespace pg8 {
#define PG8_LAS __attribute__((address_space(3)))
typedef unsigned short bf16_t;
typedef short bf16x8 __attribute__((ext_vector_type(8)));
typedef float f32x4 __attribute__((ext_vector_type(4)));
typedef unsigned u32x4 __attribute__((ext_vector_type(4)));
constexpr int BM = 256, BK = 64, HALF = 128, HTB = HALF * BK * 2  , STAGE_BYTES = 8 * HTB, NXCD = 8, WGM = 8;

__host__ __device__ __forceinline__ int lds_byte(int r, int c) { const int st = (r >> 4) * 2 + (c >> 5), rr = r & 15, cc = c & 31, ob = rr * 64 + cc * 2; return st * 1024 + (ob ^ (((ob >> 9) & 1) << 5)); }
__host__ __device__ __forceinline__ void stage_rc(int b, int& R, int& C) { const int st = b / 1024, sb = b % 1024, swz = sb ^ (((sb >> 9) & 1) << 5); R = (st >> 1) * 16 + swz / 64; C = (st & 1) * 32 + (swz % 64) / 2; }
__host__ __device__ __forceinline__ int perm32(int rho) { const int n = rho >> 4, i = rho & 15; return 8 * (i >> 2) + 4 * n + (i & 3); }

struct Unit { int pm, pn; };
struct Gemm { const bf16_t* A; const bf16_t* Bt; int M, N, K; };

struct StaticOrder {
    int nM, nN, nwg, G, c;
    __host__ __device__ void init(int M, int N, int G_, int c_) { nM = M / BM; nN = N / BM; nwg = nM * nN; G = G_; c = c_; }
    __host__ __device__ bool next(int i, Unit& u) const {
        const long L = (long)i * G + c; if (L >= nwg) return false;
        int wgid = (int)L; { const int q = nwg / NXCD, r = nwg % NXCD, xcd = wgid % NXCD, off = wgid / NXCD; wgid = (xcd < r ? xcd * (q + 1) : r * (q + 1) + (xcd - r) * q) + off; }
        const int nig = WGM * nN, gid = wgid / nig, fm = gid * WGM, gsz = (nM - fm) < WGM ? (nM - fm) : WGM;
        u.pm = fm + ((wgid % nig) % gsz); u.pn = (wgid % nig) / gsz; return true;
    }
    __device__ __forceinline__ void a_ready(const Unit&) const {}
    __device__ __forceinline__ void done(const Unit&) const {}
};
template <class Epi, class Sched, bool STAMP = false>
__device__ __forceinline__ void gemm_phase(PG8_LAS unsigned char* lds, const Gemm g, const Sched& S, const Epi& E, unsigned long long* stamps) {
    int tid = threadIdx.x; asm volatile("" : "+v"(tid));
    const int wid = __builtin_amdgcn_readfirstlane(tid >> 6), lane = tid & 63, wr = wid >> 2, wc = wid & 3, fr = lane & 15, fq = lane >> 4;
    const int K = g.K, nt = K / BK;
    int ts_lo = 0, ts_hi = 0, nts = 0; const unsigned long long rt_entry = STAMP ? (unsigned long long)wall_clock64() : 0ull;
#define PG8_STAMP() do { if (STAMP && wid == 0 && nts < 64) { const unsigned long long _c = (unsigned long long)clock64(); \
        ts_lo = (lane == nts) ? (int)(unsigned)_c : ts_lo; ts_hi = (lane == nts) ? (int)(unsigned)(_c >> 32) : ts_hi; ++nts; } } while (0)
    PG8_STAMP();
    unsigned voffA[2], voffB[2];
#pragma unroll
    for (int i = 0; i < 2; ++i) { int R, C; stage_rc(tid * 16 + i * 8192, R, C); const int Rb = Epi::PERM ? ((R & ~31) + perm32(R & 31)) : R;
        voffA[i] = (unsigned)(R * K + C) * 2u; voffB[i] = (unsigned)(Rb * K + C) * 2u; }
    const size_t kstep = (size_t)(BK * 2);
    const size_t hstep = (size_t)HALF * K * 2;
    const size_t tstep = 2 * hstep;
    const unsigned ldsw = (unsigned)wid * 1024u;
    const int aoff = lds_byte(wr * 64 + fr, fq * 8), boff = lds_byte(wc * 32 + fr, fq * 8);
#define PG8_SA(b, h) (((b) * 2 + (h)) * HTB)
#define PG8_SB(b, h) ((4 + (b) * 2 + (h)) * HTB)
#define PG8_STAGE(bufoff, gbase, voff) do { _Pragma("unroll") for (int _i = 0; _i < 2; ++_i) \
        __builtin_amdgcn_global_load_lds((const unsigned*)((const char*)(gbase) + (voff)[_i]), (PG8_LAS unsigned*)(lds + (bufoff) + ldsw + _i * 8192), 16, 0, 0); } while (0)
#define PG8_LDA(dst, b, h) do { _Pragma("unroll") for (int m = 0; m < 4; ++m) _Pragma("unroll") for (int k = 0; k < 2; ++k) dst[m][k] = *(const PG8_LAS bf16x8*)(lds + PG8_SA(b, h) + aoff + m * 2048 + k * 1024); } while (0)
#define PG8_LDB(dst, b, h) do { _Pragma("unroll") for (int n = 0; n < 2; ++n) _Pragma("unroll") for (int k = 0; k < 2; ++k) dst[n][k] = *(const PG8_LAS bf16x8*)(lds + PG8_SB(b, h) + boff + n * 2048 + k * 1024); } while (0)
#define PG8_MMA(ai, bj, At, Bt) do { __builtin_amdgcn_s_setprio(1); _Pragma("unroll") for (int m = 0; m < 4; ++m) _Pragma("unroll") for (int n = 0; n < 2; ++n) _Pragma("unroll") for (int k = 0; k < 2; ++k) \
        acc[ai][bj][m][n] = __builtin_amdgcn_mfma_f32_16x16x32_bf16(Bt[n][k], At[m][k], acc[ai][bj][m][n], 0, 0, 0); __builtin_amdgcn_s_setprio(0); } while (0)
#define PG8_WAIT_V(n) asm volatile("s_waitcnt vmcnt(" #n ")" ::: "memory")
#define PG8_WAIT_L(n) asm volatile("s_waitcnt lgkmcnt(" #n ")" ::: "memory")
#define PG8_BAR __builtin_amdgcn_s_barrier()
#define PG8_SCHED __builtin_amdgcn_sched_barrier(0)
    Unit cur, nxt; int ui = 0;
    if (!S.next(0, cur)) return;
    f32x4 acc[2][2][4][2];
#pragma unroll
    for (int a = 0; a < 2; ++a)
#pragma unroll
        for (int b = 0; b < 2; ++b)
#pragma unroll
            for (int m = 0; m < 4; ++m)
#pragma unroll
                for (int n = 0; n < 2; ++n) acc[a][b][m][n] = (f32x4){0.f, 0.f, 0.f, 0.f};
    bf16x8 At[4][2], B0[2][2], B1[2][2];
    const char* cA = (const char*)g.A + (size_t)cur.pm * tstep; const char* cB = (const char*)g.Bt + (size_t)cur.pn * tstep;
    S.a_ready(cur);
    PG8_STAGE(PG8_SB(0, 0), cB, voffB); PG8_STAGE(PG8_SA(0, 0), cA, voffA); PG8_STAGE(PG8_SB(0, 1), cB + hstep, voffB); PG8_STAGE(PG8_SA(0, 1), cA + hstep, voffA);
    if (wr == 1) PG8_BAR;
    PG8_WAIT_V(4); PG8_BAR;
    PG8_STAGE(PG8_SB(1, 0), cB + kstep, voffB); PG8_STAGE(PG8_SA(1, 0), cA + kstep, voffA); PG8_STAGE(PG8_SB(1, 1), cB + hstep + kstep, voffB);
    PG8_WAIT_V(6); PG8_BAR;
    PG8_STAMP();
    for (;;) {
        const bool has_next = S.next(ui + 1, nxt);
        const char* nA = has_next ? (const char*)g.A + (size_t)nxt.pm * tstep : cA; const char* nB = has_next ? (const char*)g.Bt + (size_t)nxt.pn * tstep : cB;
        for (int t = 0; t < nt; t += 2) {
            const bool last = (t == nt - 2);
            const char* a1 = cA + (size_t)(t + 1) * kstep;
            const char* a2 = last ? nA : cA + (size_t)(t + 2) * kstep; const char* b2 = last ? nB : cB + (size_t)(t + 2) * kstep;
            const char* a3 = a2 + kstep; const char* b3 = b2 + kstep;
            if (last && has_next) S.a_ready(nxt);
            PG8_LDB(B0, 0, 0); PG8_SCHED; PG8_LDA(At, 0, 0); PG8_STAGE(PG8_SA(1, 1), a1 + hstep, voffA);
            PG8_WAIT_L(8); PG8_BAR; PG8_WAIT_L(0); PG8_MMA(0, 0, At, B0); PG8_BAR; PG8_SCHED;
            PG8_LDB(B1, 0, 1); PG8_STAGE(PG8_SB(0, 0), b2, voffB);
            PG8_BAR; PG8_WAIT_L(0); PG8_MMA(0, 1, At, B1); PG8_BAR;
            PG8_LDA(At, 0, 1); PG8_STAGE(PG8_SA(0, 0), a2, voffA);
            PG8_BAR; PG8_WAIT_L(0); PG8_MMA(1, 0, At, B0); PG8_BAR; PG8_SCHED;
            PG8_STAGE(PG8_SB(0, 1), b2 + hstep, voffB);
            PG8_WAIT_V(6); PG8_BAR; PG8_MMA(1, 1, At, B1); PG8_BAR;
            PG8_LDB(B0, 1, 0); PG8_SCHED; PG8_LDA(At, 1, 0); PG8_STAGE(PG8_SA(0, 1), a2 + hstep, voffA);
            PG8_WAIT_L(8); PG8_BAR; PG8_WAIT_L(0); PG8_MMA(0, 0, At, B0); PG8_BAR; PG8_SCHED;
            PG8_LDB(B1, 1, 1); PG8_STAGE(PG8_SB(1, 0), b3, voffB);
            PG8_BAR; PG8_WAIT_L(0); PG8_MMA(0, 1, At, B1); PG8_BAR;
            PG8_LDA(At, 1, 1); PG8_STAGE(PG8_SA(1, 0), a3, voffA);
            PG8_BAR; PG8_WAIT_L(0); PG8_MMA(1, 0, At, B0); PG8_BAR; PG8_SCHED;
            PG8_STAGE(PG8_SB(1, 1), b3 + hstep, voffB);
            PG8_WAIT_V(6); PG8_BAR; PG8_MMA(1, 1, At, B1); PG8_BAR;
        }
        PG8_STAMP();
        if constexpr (!Epi::AFTER_DRAIN) { E(acc, cur, wr, wc, fr, fq); S.done(cur); }
        PG8_STAMP();
        if (!has_next) break;
#pragma unroll
        for (int a = 0; a < 2; ++a)
#pragma unroll
            for (int b = 0; b < 2; ++b)
#pragma unroll
                for (int m = 0; m < 4; ++m)
#pragma unroll
                    for (int n = 0; n < 2; ++n) acc[a][b][m][n] = (f32x4){0.f, 0.f, 0.f, 0.f};
        cur = nxt; cA = nA; cB = nB; ++ui;
    }
    PG8_WAIT_V(0);
    if (wr == 0) PG8_BAR;
    PG8_BAR;
    if constexpr (Epi::AFTER_DRAIN) { E.fused(acc, cur, wr, wc, fr, fq, lds, wid, lane); S.done(cur); }
    PG8_STAMP();
    if (STAMP && wid == 0) { stamps[lane] = lane < nts ? (((unsigned long long)(unsigned)ts_hi << 32) | (unsigned)ts_lo) : 0ull;
        if (lane == 62) stamps[62] = rt_entry; if (lane == 63) stamps[63] = (unsigned long long)wall_clock64(); }
#undef PG8_STAMP
#undef PG8_SA
#undef PG8_SB
#undef PG8_STAGE
#undef PG8_LDA
#undef PG8_LDB
#undef PG8_MMA
#undef PG8_WAIT_V
#undef PG8_WAIT_L
#undef PG8_BAR
#undef PG8_SCHED
}
}

DEV void ph_adaln(const Params& p, char* smem, int bid, int nb) {
  float* sc = (float*)smem; float* sx = sc + 1024; f32x4* red = (f32x4*)(sx + 1024);
  const int tid = tidx();
  for (int i = tid; i < 1024; i += 256) { sc[i] = siluf_(p.in[1][i]); sx[i] = siluf_(p.in[3][i]); }
  __syncthreads();
  float* mods = (float*)(p.ws + WS_MODS);
  const int cl = tid & 7, kg = tid >> 3;
  constexpr int NU = 2 * 192;
  for (int it = 0, iters = (NU + nb - 1) / nb; it < iters; ++it) {
    const int u = bid + it * nb; const bool active = u < NU;
    const int l = u / 192, c0 = (u % 192) * 32;
    const float* W = p.in[l ? 24 : 4]; const float* B = p.in[l ? 25 : 5];
    if (active) {
      f32x4 ac = {0.f, 0.f, 0.f, 0.f}, ax = {0.f, 0.f, 0.f, 0.f};
      const float* wp = W + (size_t)(kg * 32) * 6144 + c0 + 4 * cl;
#pragma unroll 16
      for (int kk = 0; kk < 32; ++kk) {
        const f32x4 w = *(const f32x4*)(wp + (size_t)kk * 6144);
        const float a = sc[kg * 32 + kk], b = sx[kg * 32 + kk];
        ac += a * w; ax += b * w;
      }
      red[kg * 8 + cl] = ac; red[256 + kg * 8 + cl] = ax;
    }
    __syncthreads();
    if (active && tid < 16) {
      const int which = tid >> 3, c = tid & 7;
      f32x4 sm = {0.f, 0.f, 0.f, 0.f};
      for (int g = 0; g < 32; ++g) sm += red[which * 256 + g * 8 + c];
      const f32x4 bb = *(const f32x4*)(B + c0 + 4 * c);
      *(f32x4*)(mods + (size_t)(l * 2 + which) * 6144 + c0 + 4 * c) = sm + bb;
    }
    __syncthreads();
  }
}

DEV void transpose_item(const float* W, int N, int K, bf16_t* WT, float* scr, int k0, int n0, int lane) {
  float wreg[32];
#pragma unroll
  for (int i = 0; i < 32; ++i) { const int kk = 2 * i + (lane >> 5); wreg[i] = W[(size_t)(k0 + kk) * N + n0 + (lane & 31)]; }
#pragma unroll
  for (int i = 0; i < 32; ++i) { const int kk = 2 * i + (lane >> 5); scr[kk * 33 + (lane & 31)] = wreg[i]; }
  asm volatile("s_waitcnt lgkmcnt(0)" ::: "memory");
  const int c = lane & 7;
#pragma unroll
  for (int j = 0; j < 4; ++j) { const int n = (lane >> 3) + 8 * j; const float* s = scr + (8 * c) * 33 + n;
    u32x4 o; o.x = pk2(s[0 * 33], s[1 * 33]); o.y = pk2(s[2 * 33], s[3 * 33]); o.z = pk2(s[4 * 33], s[5 * 33]); o.w = pk2(s[6 * 33], s[7 * 33]);
    *(u32x4*)(WT + (size_t)n * K + k0 + 8 * c) = o; }
  asm volatile("s_waitcnt lgkmcnt(0)" ::: "memory");
}
constexpr int CI_WIN = 16 * 80, CI_WOUT = 20 * 32, CI_WML = 16 * 97, CI_WMO = 16 * 32, CI_WAX = 40 * 8, CI_DENSE = CI_WIN + CI_WOUT + CI_WML + CI_WMO + CI_WAX;
constexpr int CI_MOE = 32 * 768;
DEV void ph_convert_dense(const Params& p, char* smem) {
  const int tf = tidf(), lane = tf & 63, wv = tf >> 6;
  float* scr = (float*)(smem + wv * 8448);
  const int gw = blockIdx.x * 8 + wv, ngw = gridDim.x * 8;
  for (int it = gw; it < CI_DENSE; it += ngw) {
    int r = it;
    if (r < CI_WIN) { const int kb = r / 80, nb_ = r % 80; transpose_item(p.in[8], 2560, 1024, (bf16_t*)(p.ws + WS_WIN) + (size_t)(nb_ * 32) * 1024, scr, kb * 64, nb_ * 32, lane); continue; } r -= CI_WIN;
    if (r < CI_WOUT) { const int kb = r / 32, nb_ = r % 32; transpose_item(p.in[16], 1024, 1280, (bf16_t*)(p.ws + WS_WOUT) + (size_t)(nb_ * 32) * 1280, scr, kb * 64, nb_ * 32, lane); continue; } r -= CI_WOUT;
    if (r < CI_WML) { const int kb = r / 97, nb_ = r % 97; transpose_item(p.in[28], MLW, 1024, (bf16_t*)(p.ws + WS_WML) + (size_t)(nb_ * 32) * 1024, scr, kb * 64, nb_ * 32, lane); continue; } r -= CI_WML;
    if (r < CI_WMO) { const int kb = r / 32, nb_ = r % 32; transpose_item(p.in[31], 1024, 1024, (bf16_t*)(p.ws + WS_WMO) + (size_t)(nb_ * 32) * 1024, scr, kb * 64, nb_ * 32, lane); continue; } r -= CI_WMO;
    { const int mi = r >> 3, rr = r & 7, kb = rr >> 2, nb_ = rr & 3, dh = mi >> 1, which = mi & 1;
      transpose_item((which ? p.in[13] : p.in[11]) + (size_t)dh * 16384, 128, 128, (bf16_t*)(p.ws + WS_WAXT) + (size_t)mi * 16384 + (size_t)(nb_ * 32) * 128, scr, kb * 64, nb_ * 32, lane); }
  }
  { bf16_t* Wr = (bf16_t*)(p.ws + WS_WR);
    for (int i = blockIdx.x * 512 + tf; i < 2 * 48 * 1024; i += gridDim.x * 512) {
      const int l = i / (48 * 1024), r = i % (48 * 1024), n = r >> 10, k = r & 1023;
      const float* We = p.in[l ? 34 : 19]; const float* Wg = p.in[l ? 32 : 17];
      const float w = n < 32 ? We[k * 32 + n] : (n < 36 ? Wg[k * 4 + n - 32] : 0.f);
      const bf16_t hi = f2bf(w); const bf16_t lo = f2bf(w - bf2f(hi));
      Wr[(size_t)(l * 2) * 48 * 1024 + r] = hi; Wr[(size_t)(l * 2 + 1) * 48 * 1024 + r] = lo;
    } }
  { u32x4* z = (u32x4*)((bf16_t*)(p.ws + WS_WML) + (size_t)MLW * 1024); const int n16 = (MLWP - MLW) * 1024 * 2 / 16;
    for (int i = blockIdx.x * 512 + tf; i < n16; i += gridDim.x * 512) z[i] = (u32x4){0u, 0u, 0u, 0u}; }
}
template <int LAYER>
DEV void ph_convert_moe(const Params& p, char* smem) {
  const int tf = tidf(), lane = tf & 63, wv = tf >> 6;
  float* scr = (float*)(smem + wv * 8448);
  const int gw = blockIdx.x * 8 + wv, ngw = gridDim.x * 8;
  const float* Wg = p.in[LAYER == 0 ? 21 : 36]; const float* Wu = p.in[LAYER == 0 ? 22 : 37]; const float* Wd = p.in[LAYER == 0 ? 23 : 38];
  bf16_t* WGU = (bf16_t*)(p.ws + WS_WGU); bf16_t* WD = (bf16_t*)(p.ws + WS_WD);
  for (int it = gw; it < CI_MOE; it += ngw) {
    const int e = it / 768, r = it % 768;
    if (r < 512) {
      const int up = r >> 8, rr = r & 255, kb = rr >> 4, nb_ = rr & 15, n0 = nb_ * 32;
      bf16_t* dst = WGU + ((size_t)e * 1024 + (n0 >> 7) * 256 + up * 128 + (n0 & 127)) * 1024;
      transpose_item((up ? Wu : Wg) + (size_t)e * 1024 * 512, 512, 1024, dst, scr, kb * 64, n0, lane);
    } else {
      const int rr = r - 512, kb = rr >> 5, nb_ = rr & 31, n0 = nb_ * 32;
      transpose_item(Wd + (size_t)e * 512 * 1024, 1024, 512, WD + ((size_t)e * 1024 + n0) * 512, scr, kb * 64, n0, lane);
    }
  }
}

DEV void ph_norm0(const Params& p, int bid, int nb) {
  const int lane = tidx() & 63, wave = tidx() >> 6;
  const float* mods = (const float*)(p.ws + WS_MODS);
  bf16_t* hA = (bf16_t*)(p.ws + WS_HA);
  const float* g1 = p.in[6];
  for (int r0 = (bid * 4 + wave) * 4; r0 < T; r0 += nb * 16) {
    f32x4 v[4][4]; float rs[4];
#pragma unroll
    for (int q = 0; q < 4; ++q) {
      const int r = r0 + q;
      const float* src = r < NL ? p.in[0] + (size_t)r * D : p.in[2] + (size_t)(r - NL) * D;
#pragma unroll
      for (int i = 0; i < 4; ++i) v[q][i] = *(const f32x4*)(src + 4 * lane + 256 * i);
    }
#pragma unroll
    for (int q = 0; q < 4; ++q) {
      float ss = 0.f;
#pragma unroll
      for (int i = 0; i < 4; ++i) ss += v[q][i].x * v[q][i].x + v[q][i].y * v[q][i].y + v[q][i].z * v[q][i].z + v[q][i].w * v[q][i].w;
      rs[q] = rsqrtf(wave_sum(ss) * (1.f / D) + EPS);
    }
#pragma unroll
    for (int i = 0; i < 4; ++i) {
      const int c = 4 * lane + 256 * i;
      const f32x4 g = *(const f32x4*)(g1 + c);
#pragma unroll
      for (int q = 0; q < 4; ++q) {
        const int r = r0 + q;
        const float* md = mods + (r < NL ? 0 : 6144);
        const f32x4 sh = *(const f32x4*)(md + c), sc = *(const f32x4*)(md + 1024 + c);
        const f32x4 h = v[q][i] * rs[q] * g * (1.f + sc) + sh;
        u32x2 o; o.x = pk2(h.x, h.y); o.y = pk2(h.z, h.w);
        *(u32x2*)(hA + (size_t)r * D + c) = o;
      }
    }
  }
}

constexpr int RG_AS_STRIDE = 272;
constexpr int RG_MT = RGT / 16;
constexpr int RG_AS = 0, RG_BS = RGT * RG_AS_STRIDE, RG_SMEM = RG_BS + 128 * BS_STRIDE;

template <bool REV, int NT>
DEV void rg_scan(f32x4 (&A)[RG_MT][NT], f32x4 (&B)[RG_MT][NT], float (&aggP)[NT], float (&aggH)[NT]) {
  const int lane = tidx() & 63, fq = lane >> 4, fr = lane & 15;
#pragma unroll
  for (int n = 0; n < NT; ++n) {
    float cP = 1.f, cH = 0.f;
#pragma unroll
    for (int mm = 0; mm < RG_MT; ++mm) {
      const int m = REV ? RG_MT - 1 - mm : mm;
      float P[4], H[4];
      if (!REV) {
        P[0] = A[m][n][0]; H[0] = B[m][n][0];
#pragma unroll
        for (int j = 1; j < 4; ++j) { P[j] = A[m][n][j] * P[j - 1]; H[j] = A[m][n][j] * H[j - 1] + B[m][n][j]; }
      } else {
        P[3] = A[m][n][3]; H[3] = B[m][n][3];
#pragma unroll
        for (int j = 2; j >= 0; --j) { P[j] = A[m][n][j] * P[j + 1]; H[j] = A[m][n][j] * H[j + 1] + B[m][n][j]; }
      }
      float IP = REV ? P[0] : P[3], IH = REV ? H[0] : H[3];
      float tP, tH;
      tP = REV ? __shfl_down(IP, 16) : __shfl_up(IP, 16); tH = REV ? __shfl_down(IH, 16) : __shfl_up(IH, 16);
      if (REV ? (fq <= 2) : (fq >= 1)) { IH = IP * tH + IH; IP = IP * tP; }
      tP = REV ? __shfl_down(IP, 32) : __shfl_up(IP, 32); tH = REV ? __shfl_down(IH, 32) : __shfl_up(IH, 32);
      if (REV ? (fq <= 1) : (fq >= 2)) { IH = IP * tH + IH; IP = IP * tP; }
      float EP = REV ? __shfl_down(IP, 16) : __shfl_up(IP, 16), EH = REV ? __shfl_down(IH, 16) : __shfl_up(IH, 16);
      if (REV ? (fq == 3) : (fq == 0)) { EP = 1.f; EH = 0.f; }
      const float hin = EP * cH + EH, pin = EP * cP;
#pragma unroll
      for (int j = 0; j < 4; ++j) { B[m][n][j] = H[j] + P[j] * hin; A[m][n][j] = P[j] * pin; }
      const float TP = __shfl(IP, (REV ? 0 : 48) + fr), TH = __shfl(IH, (REV ? 0 : 48) + fr);
      cH = TP * cH + TH; cP = TP * cP;
    }
    aggP[n] = cP; aggH[n] = cH;
  }
}

DEV void ph_rg_scan(const Params& p, char* smem, int bid, int nb) {
  char* As = smem + RG_AS; char* Bs = smem + RG_BS;
  const bf16_t* pr = (const bf16_t*)(p.ws + WS_PR);
  bf16_t* Sb = (bf16_t*)(p.ws + WS_S); bf16_t* Pfb = (bf16_t*)(p.ws + WS_PF); bf16_t* Pbb = (bf16_t*)(p.ws + WS_PB);
  float* agg = (float*)(p.ws + WS_AGG);
  const float* conv_w = p.in[9]; const float* conv_b = p.in[10];
  for (int it = 0, iters = (NRT * 10 + nb - 1) / nb; it < iters; ++it) {
    int u = bid + it * nb; const bool active = u < NRT * 10; if (!active) u = NRT * 10 - 1;
    const int tid = tidx();
    const int lane = tid & 63, wave = tid >> 6, fr = lane & 15, fq = lane >> 4, q4 = fr >> 2, p4 = lane & 3;
    const int hb = u % 10, tile = u / 10, r0 = tile * RGT, ch0 = hb * 128;
    const int seg_lo = tile < NRT_LAT ? 0 : NL, seg_hi = tile < NRT_LAT ? NL : T;
    __syncthreads();
    {
      const int cg8 = tid & 15, rg = tid >> 4, c = ch0 + 8 * cg8;
      float w[4][8], bias[8];
#pragma unroll
      for (int j = 0; j < 4; ++j) { const f32x4 a = *(const f32x4*)(conv_w + j * DR + c), b = *(const f32x4*)(conv_w + j * DR + c + 4);
        w[j][0] = a.x; w[j][1] = a.y; w[j][2] = a.z; w[j][3] = a.w; w[j][4] = b.x; w[j][5] = b.y; w[j][6] = b.z; w[j][7] = b.w; }
      { const f32x4 a = *(const f32x4*)(conv_b + c), b = *(const f32x4*)(conv_b + c + 4);
        bias[0] = a.x; bias[1] = a.y; bias[2] = a.z; bias[3] = a.w; bias[4] = b.x; bias[5] = b.y; bias[6] = b.z; bias[7] = b.w; }
      float win[4][8];
      auto ldrow = [&](int r, float (&dst)[8]) {
        if (r >= seg_lo && r < seg_hi) { const u32x4 v = *(const u32x4*)(pr + (size_t)r * DR + c);
          dst[0] = bflo(v.x); dst[1] = bfhi(v.x); dst[2] = bflo(v.y); dst[3] = bfhi(v.y); dst[4] = bflo(v.z); dst[5] = bfhi(v.z); dst[6] = bflo(v.w); dst[7] = bfhi(v.w); }
        else {
#pragma unroll
          for (int e = 0; e < 8; ++e) dst[e] = 0.f; }
      };
      const int rb = r0 + rg * 4;
      ldrow(rb - 2, win[0]); ldrow(rb - 1, win[1]); ldrow(rb, win[2]);
#pragma unroll
      for (int t = 0; t < 4; ++t) {
        ldrow(rb + t + 1, win[(t + 3) & 3]);
        float o[8];
#pragma unroll
        for (int e = 0; e < 8; ++e) o[e] = bias[e] + w[0][e] * win[t & 3][e] + w[1][e] * win[(t + 1) & 3][e] + w[2][e] * win[(t + 2) & 3][e] + w[3][e] * win[(t + 3) & 3][e];
        u32x4 ov; ov.x = pk2(o[0], o[1]); ov.y = pk2(o[2], o[3]); ov.z = pk2(o[4], o[5]); ov.w = pk2(o[6], o[7]);
        *(u32x4*)(As + (rg * 4 + t) * RG_AS_STRIDE + cg8 * 16) = ov;
      }
    }
    u32x2 hfk[RG_MT][2];
#pragma unroll
    for (int d = 0; d < 2; ++d) {
      f32x4 accA[RG_MT][2], accX[RG_MT][2];
#pragma unroll
      for (int which = 0; which < 2; ++which) {
        const float* W = (which ? p.in[13] : p.in[11]) + (size_t)(d * 10 + hb) * 16384;
        __syncthreads();
#pragma unroll 1
        for (int ib = 0; ib < 4; ++ib) {
#pragma unroll
          for (int ii = 0; ii < 4; ++ii) {
            const int f = tid + 256 * (ib * 4 + ii), k = f >> 5, n = 4 * (f & 31);
            const f32x4 v = *(const f32x4*)(W + k * 128 + n);
            u32x2 o; o.x = pk2(v.x, v.y); o.y = pk2(v.z, v.w);
            *(u32x2*)(Bs + bs_off(k, n)) = o;
          }
        }
        __syncthreads();
        f32x4 (&acc)[RG_MT][2] = which ? accX : accA;
#pragma unroll
        for (int m = 0; m < RG_MT; ++m) { acc[m][0] = (f32x4){0.f, 0.f, 0.f, 0.f}; acc[m][1] = (f32x4){0.f, 0.f, 0.f, 0.f}; }
#pragma unroll
        for (int ks = 0; ks < 4; ++ks) {
          bf16x8 b[2];
#pragma unroll
          for (int n = 0; n < 2; ++n) {
            const int ncol = wave * 32 + n * 16 + 4 * p4;
            const s16x4 lo = ldtr(Bs + bs_off(ks * 32 + fq * 8 + q4, ncol));
            const s16x4 hi = ldtr(Bs + bs_off(ks * 32 + fq * 8 + 4 + q4, ncol));
            b[n] = (bf16x8){lo.x, lo.y, lo.z, lo.w, hi.x, hi.y, hi.z, hi.w};
          }
#pragma unroll
          for (int m = 0; m < RG_MT; ++m) {
            const bf16x8 a = *(const bf16x8*)(As + (m * 16 + fr) * RG_AS_STRIDE + (ks * 32 + fq * 8) * 2);
            acc[m][0] = __builtin_amdgcn_mfma_f32_16x16x32_bf16(a, b[0], acc[m][0], 0, 0, 0);
            acc[m][1] = __builtin_amdgcn_mfma_f32_16x16x32_bf16(a, b[1], acc[m][1], 0, 0, 0);
          }
        }
      }
#pragma unroll
      for (int n = 0; n < 2; ++n) {
        const int cl = wave * 32 + n * 16 + fr, ch = ch0 + cl;
        const float ba = p.in[12][d * DR + ch], bx = p.in[14][d * DR + ch], lam = p.in[15][d * DR + ch];
        const float nl = -lam;
        const float sp = nl > 20.f ? nl : log1pf(__expf(nl));
        const float c8 = -8.f * sp;
#pragma unroll
        for (int m = 0; m < RG_MT; ++m)
#pragma unroll
          for (int j = 0; j < 4; ++j) {
            const int row = m * 16 + fq * 4 + j;
            const float r = sigmoidf_(accA[m][n][j] + ba), ig = sigmoidf_(accX[m][n][j] + bx);
            const float la = c8 * r;
            const float a = __expf(la);
            const float x2 = 2.f * la;
            const float om = x2 > -0.1f ? -x2 * (1.f + x2 * (0.5f + x2 * (0.16666667f + x2 * 0.041666668f))) : 1.f - a * a;
            const float mult = sqrtf(om);
            const float uu = bf2f(*(const bf16_t*)(As + row * RG_AS_STRIDE + cl * 2));
            accA[m][n][j] = a; accX[m][n][j] = mult * ig * uu;
            if (j == 3) __builtin_amdgcn_sched_barrier(0);
          }
      }
      float aggP[2], aggH[2];
      if (d == 0) rg_scan<false, 2>(accA, accX, aggP, aggH); else rg_scan<true, 2>(accA, accX, aggP, aggH);
      if (fq == 0) {
#pragma unroll
        for (int n = 0; n < 2; ++n) {
          const int ch = ch0 + wave * 32 + n * 16 + fr;
          float* ag = agg + ((size_t)(d * NRT + tile) * DR + ch) * 2;
          ag[0] = aggP[n]; ag[1] = aggH[n];
        }
      }
      bf16_t* Pout = d ? Pbb : Pfb;
#pragma unroll
      for (int m = 0; m < RG_MT; ++m)
#pragma unroll
        for (int n = 0; n < 2; ++n) {
          if (d == 0) { hfk[m][n].x = pk2(accX[m][n][0], accX[m][n][1]); hfk[m][n].y = pk2(accX[m][n][2], accX[m][n][3]); }
          else { accX[m][n][0] += bflo(hfk[m][n].x); accX[m][n][1] += bfhi(hfk[m][n].x); accX[m][n][2] += bflo(hfk[m][n].y); accX[m][n][3] += bfhi(hfk[m][n].y); }
#pragma unroll
          for (int j = 0; j < 4; ++j) {
            const unsigned o = (unsigned)(r0 + m * 16 + fq * 4 + j) * DR + ch0 + wave * 32 + n * 16 + fr;
            Pout[o] = f2bf(accA[m][n][j]);
            if (d == 1) Sb[o] = f2bf(accX[m][n][j]);
          }
          __builtin_amdgcn_sched_barrier(0);
        }
    }
  }
}

DEV void ph_rg_scan2(const Params& p, char* smem) {
  int tid = threadIdx.x; asm volatile("" : "+v"(tid));
  const int lane = tid & 63, wave = tid >> 6, fr = lane & 15, fq = lane >> 4;
  const bf16_t* pr = (const bf16_t*)(p.ws + WS_PR);
  bf16_t* Sb = (bf16_t*)(p.ws + WS_S); bf16_t* Pfb = (bf16_t*)(p.ws + WS_PF); bf16_t* Pbb = (bf16_t*)(p.ws + WS_PB);
  float* agg = (float*)(p.ws + WS_AGG);
  const bf16_t* WAX = (const bf16_t*)(p.ws + WS_WAXT);
  const float* conv_w = p.in[9]; const float* conv_b = p.in[10];
  const int NU = NRT * 10;
  const int u0 = (int)((long)blockIdx.x * NU / gridDim.x), u1 = (int)((long)(blockIdx.x + 1) * NU / gridDim.x);
  int cur_hb = -1;
  bf16x8 bfr[4][4];
  float cba[2], cbx[2], cc8[2];
#pragma unroll 1
  for (int u = u0; u < u1; ++u) {
    const int hb = u / NRT, tile = u - hb * NRT, r0 = tile * RGT, ch0 = hb * 128;
    const int seg_lo = tile < NRT_LAT ? 0 : NL, seg_hi = tile < NRT_LAT ? NL : T;
    char* As = smem + ((u - u0) & 1) * (RGT * RG_AS_STRIDE);
    if (hb != cur_hb) {
      cur_hb = hb;
#pragma unroll
      for (int mat = 0; mat < 4; ++mat)
#pragma unroll
        for (int ks = 0; ks < 4; ++ks)
          bfr[mat][ks] = *(const bf16x8*)(WAX + (size_t)(((mat >> 1) * 10 + hb) * 2 + (mat & 1)) * 16384 + (16 * wave + fr) * 128 + ks * 32 + fq * 8);
#pragma unroll
      for (int d = 0; d < 2; ++d) {
        const int ch = ch0 + 16 * wave + fr;
        cba[d] = p.in[12][d * DR + ch]; cbx[d] = p.in[14][d * DR + ch];
        const float nl = -p.in[15][d * DR + ch];
        cc8[d] = -8.f * (nl > 20.f ? nl : log1pf(__expf(nl)));
      }
    }
    {
      const int cg8 = tid & 15, rg = tid >> 4, c = ch0 + 8 * cg8;
      float w[4][8], bias[8];
#pragma unroll
      for (int j = 0; j < 4; ++j) { const f32x4 a = *(const f32x4*)(conv_w + j * DR + c), b = *(const f32x4*)(conv_w + j * DR + c + 4);
        w[j][0] = a.x; w[j][1] = a.y; w[j][2] = a.z; w[j][3] = a.w; w[j][4] = b.x; w[j][5] = b.y; w[j][6] = b.z; w[j][7] = b.w; }
      { const f32x4 a = *(const f32x4*)(conv_b + c), b = *(const f32x4*)(conv_b + c + 4);
        bias[0] = a.x; bias[1] = a.y; bias[2] = a.z; bias[3] = a.w; bias[4] = b.x; bias[5] = b.y; bias[6] = b.z; bias[7] = b.w; }
      float win[5][8];
      const int rb = r0 + rg * 2;
#pragma unroll
      for (int t = 0; t < 5; ++t) {
        const int r = rb - 2 + t;
        if (r >= seg_lo && r < seg_hi) { const u32x4 v = *(const u32x4*)(pr + (size_t)r * DR + c);
          win[t][0] = bflo(v.x); win[t][1] = bfhi(v.x); win[t][2] = bflo(v.y); win[t][3] = bfhi(v.y); win[t][4] = bflo(v.z); win[t][5] = bfhi(v.z); win[t][6] = bflo(v.w); win[t][7] = bfhi(v.w); }
        else {
#pragma unroll
          for (int e = 0; e < 8; ++e) win[t][e] = 0.f; }
      }
#pragma unroll
      for (int t = 0; t < 2; ++t) {
        float o[8];
#pragma unroll
        for (int e = 0; e < 8; ++e) o[e] = bias[e] + w[0][e] * win[t][e] + w[1][e] * win[t + 1][e] + w[2][e] * win[t + 2][e] + w[3][e] * win[t + 3][e];
        u32x4 ov; ov.x = pk2(o[0], o[1]); ov.y = pk2(o[2], o[3]); ov.z = pk2(o[4], o[5]); ov.w = pk2(o[6], o[7]);
        *(u32x4*)(As + (rg * 2 + t) * RG_AS_STRIDE + cg8 * 16) = ov;
      }
    }
    __syncthreads();
    f32x4 acc[4][RG_MT][1];
#pragma unroll
    for (int mat = 0; mat < 4; ++mat)
#pragma unroll
      for (int m = 0; m < RG_MT; ++m) acc[mat][m][0] = (f32x4){0.f, 0.f, 0.f, 0.f};
#pragma unroll
    for (int ks = 0; ks < 4; ++ks)
#pragma unroll
      for (int m = 0; m < RG_MT; ++m) {
        const bf16x8 a = *(const bf16x8*)(As + (m * 16 + fr) * RG_AS_STRIDE + (ks * 32 + fq * 8) * 2);
#pragma unroll
        for (int mat = 0; mat < 4; ++mat) acc[mat][m][0] = __builtin_amdgcn_mfma_f32_16x16x32_bf16(a, bfr[mat][ks], acc[mat][m][0], 0, 0, 0);
      }
    const int cl = 16 * wave + fr;
#pragma unroll
    for (int d = 0; d < 2; ++d) {
      f32x4 (&accA)[RG_MT][1] = acc[d * 2]; f32x4 (&accX)[RG_MT][1] = acc[d * 2 + 1];
#pragma unroll
      for (int m = 0; m < RG_MT; ++m) {
#pragma unroll
        for (int j = 0; j < 4; ++j) {
          const int row = m * 16 + fq * 4 + j;
          const float r = sigmoidf_(accA[m][0][j] + cba[d]), ig = sigmoidf_(accX[m][0][j] + cbx[d]);
          const float la = cc8[d] * r;
          const float a = fexp_(la);
          const float x2 = 2.f * la;
          const float om = x2 > -0.1f ? -x2 * (1.f + x2 * (0.5f + x2 * (0.16666667f + x2 * 0.041666668f))) : 1.f - a * a;
          const float uu = bf2f(*(const bf16_t*)(As + row * RG_AS_STRIDE + cl * 2));
          accA[m][0][j] = a; accX[m][0][j] = __builtin_amdgcn_sqrtf(om) * ig * uu;
        }
        __builtin_amdgcn_sched_barrier(0);
      }
      float aggP[1], aggH[1];
      if (d == 0) rg_scan<false, 1>(accA, accX, aggP, aggH); else rg_scan<true, 1>(accA, accX, aggP, aggH);
      if (fq == 0) { float* ag = agg + ((size_t)(d * NRT + tile) * DR + ch0 + cl) * 2; ag[0] = aggP[0]; ag[1] = aggH[0]; }
      bf16_t* Pout = d ? Pbb : Pfb;
#pragma unroll
      for (int m = 0; m < RG_MT; ++m) {
        if (d == 1) accX[m][0] += acc[1][m][0];
#pragma unroll
        for (int j = 0; j < 4; ++j) {
          const unsigned o = (unsigned)(r0 + m * 16 + fq * 4 + j) * DR + ch0 + cl;
          Pout[o] = f2bf(accA[m][0][j]);
          if (d == 1) Sb[o] = f2bf(accX[m][0][j]);
        }
      }
    }
  }
  __syncthreads();
}

DEV void ph_rg_carry(const Params& p, char* smem, int bid, int nb) {
  const float* agg = (const float*)(p.ws + WS_AGG); float* carry = (float*)(p.ws + WS_CARRY);
  const int tid = tidx();
  float* sP = (float*)smem; float* sH = sP + 256;
  constexpr int NCH = 2 * DR, CPB = 25, NB = (NCH + CPB - 1) / CPB;
  for (int it = 0, iters = (NB + nb - 1) / nb; it < iters; ++it) {
    const int blk = bid + it * nb;
    const int lc = tid / 10, seg = tid % 10, chain = blk * CPB + lc;
    const bool on = blk < NB && tid < 250 && chain < NCH;
    const int d = on ? chain / DR : 0, ch = on ? chain % DR : 0;
    float ap[26], ah[26];
    if (on) {
#pragma unroll
      for (int j = 0; j < 26; ++j) {
        const int s = seg * 26 + j;
        const int tile = d == 0 ? (s < (NRT - NRT_LAT) ? NRT_LAT + s : s - (NRT - NRT_LAT)) : NRT - 1 - s;
        const float* ag = agg + ((size_t)(d * NRT + tile) * DR + ch) * 2;
        ap[j] = ag[0]; ah[j] = ag[1];
      }
      float P = 1.f, H = 0.f;
#pragma unroll
      for (int j = 0; j < 26; ++j) { H = ap[j] * H + ah[j]; P = ap[j] * P; }
      sP[tid] = P; sH[tid] = H;
    }
    __syncthreads();
    if (on) {
      float st = 0.f;
      for (int k = 0; k < seg; ++k) st = sP[lc * 10 + k] * st + sH[lc * 10 + k];
#pragma unroll
      for (int j = 0; j < 26; ++j) {
        const int s = seg * 26 + j;
        const int tile = d == 0 ? (s < (NRT - NRT_LAT) ? NRT_LAT + s : s - (NRT - NRT_LAT)) : NRT - 1 - s;
        carry[(size_t)(d * NRT + tile) * DR + ch] = st;
        st = ap[j] * st + ah[j];
      }
    }
    __syncthreads();
  }
}

DEV void ph_rg_final(const Params& p, int bid, int nb) {
  const bf16_t* gg = (const bf16_t*)(p.ws + WS_GG); const bf16_t* Sb = (const bf16_t*)(p.ws + WS_S);
  const bf16_t* Pfb = (const bf16_t*)(p.ws + WS_PF); const bf16_t* Pbb = (const bf16_t*)(p.ws + WS_PB);
  const float* carry = (const float*)(p.ws + WS_CARRY);
  bf16_t* y = (bf16_t*)(p.ws + WS_PR);
  const int total = T * (DR / 8);
  for (int i = bid * 256 + tidx(); i < total; i += nb * 256) {
    const int r = i / 160, c = (i % 160) * 8, tile = r / RGT;
    const size_t o = (size_t)r * DR + c;
    const u32x4 g = *(const u32x4*)(gg + o), s = *(const u32x4*)(Sb + o), pf = *(const u32x4*)(Pfb + o), pb = *(const u32x4*)(Pbb + o);
    const float* cf = carry + (size_t)tile * DR + c; const float* cb = carry + (size_t)(NRT + tile) * DR + c;
    const f32x4 cf0 = *(const f32x4*)cf, cf1 = *(const f32x4*)(cf + 4), cb0 = *(const f32x4*)cb, cb1 = *(const f32x4*)(cb + 4);
    u32x4 o4;
    o4.x = pk2(bflo(g.x) * (bflo(s.x) + bflo(pf.x) * cf0.x + bflo(pb.x) * cb0.x), bfhi(g.x) * (bfhi(s.x) + bfhi(pf.x) * cf0.y + bfhi(pb.x) * cb0.y));
    o4.y = pk2(bflo(g.y) * (bflo(s.y) + bflo(pf.y) * cf0.z + bflo(pb.y) * cb0.z), bfhi(g.y) * (bfhi(s.y) + bfhi(pf.y) * cf0.w + bfhi(pb.y) * cb0.w));
    o4.z = pk2(bflo(g.z) * (bflo(s.z) + bflo(pf.z) * cf1.x + bflo(pb.z) * cb1.x), bfhi(g.z) * (bfhi(s.z) + bfhi(pf.z) * cf1.y + bfhi(pb.z) * cb1.y));
    o4.w = pk2(bflo(g.w) * (bflo(s.w) + bflo(pf.w) * cf1.z + bflo(pb.w) * cb1.z), bfhi(g.w) * (bfhi(s.w) + bfhi(pf.w) * cf1.w + bfhi(pb.w) * cb1.w));
    *(u32x4*)(y + o) = o4;
  }
}

using pg8::Unit;
struct EpiRgIn {
  static constexpr bool PERM = true, AFTER_DRAIN = false;
  bf16_t* gg; bf16_t* pr;
  DEV void operator()(const f32x4 (&acc)[2][2][4][2], const Unit& u, int wr, int wc, int fr, int fq) const {
    const int row0 = u.pm * 256 + wr * 64 + fr, c0 = u.pn * 256 + wc * 32 + 8 * fq;
    const bool gate = u.pn < 5;
#pragma unroll
    for (int ai = 0; ai < 2; ++ai)
#pragma unroll
      for (int m = 0; m < 4; ++m) {
        const unsigned row = row0 + ai * 128 + m * 16;
#pragma unroll
        for (int bj = 0; bj < 2; ++bj) {
          f32x4 v0 = acc[ai][bj][m][0], v1 = acc[ai][bj][m][1];
          const int col = c0 + bj * 128;
          if (gate) {
#pragma unroll
            for (int j = 0; j < 4; ++j) { v0[j] = gelu_tanh(v0[j]); v1[j] = gelu_tanh(v1[j]); }
          }
          u32x4 w; w.x = pk2(v0[0], v0[1]); w.y = pk2(v0[2], v0[3]); w.z = pk2(v1[0], v1[1]); w.w = pk2(v1[2], v1[3]);
          if (gate) *(u32x4*)(gg + row * DR + col) = w; else *(u32x4*)(pr + row * DR + col - DR) = w;
        }
      }
  }
};
template <int LAYER> struct EpiOut {
  static constexpr bool PERM = false, AFTER_DRAIN = false;
  const float* x; const float* ctx; const bf16_t* x2; const float* mods; bf16_t* x1;
  DEV void operator()(const f32x4 (&acc)[2][2][4][2], const Unit& u, int wr, int wc, int fr, int fq) const {
    const int row0 = u.pm * 256 + wr * 64 + fr, c0 = u.pn * 256 + wc * 32 + 4 * fq;
#pragma unroll
    for (int ai = 0; ai < 2; ++ai)
#pragma unroll
      for (int m = 0; m < 4; ++m) {
        const int row = row0 + ai * 128 + m * 16;
        const int trow = LAYER == 0 ? row : token_of_seqrow(row);
        const float* xin = LAYER == 0 ? (row < NL ? x + (size_t)row * D : ctx + (size_t)(row - NL) * D) : nullptr;
        const float* gt = mods + ((LAYER == 0 && row >= NL) ? 6144 : 0) + 2048;
        bf16_t* xo = x1 + (size_t)trow * D;
#pragma unroll
        for (int bj = 0; bj < 2; ++bj)
#pragma unroll
          for (int n = 0; n < 2; ++n) {
            const int col = c0 + bj * 128 + n * 16;
            const f32x4 xi = LAYER == 0 ? *(const f32x4*)(xin + col) : ld_bf4(x2 + (size_t)trow * D + col);
            st_bf4(xo + col, xi + *(const f32x4*)(gt + col) * acc[ai][bj][m][n]);
          }
      }
  }
};
struct EpiMoe1 {
  static constexpr bool PERM = true, AFTER_DRAIN = false;
  bf16_t* Hm;
  DEV void operator()(const f32x4 (&acc)[2][2][4][2], const Unit& u, int wr, int wc, int fr, int fq) const {
    const int row0 = u.pm * 256 + wr * 64 + fr, c0 = (u.pn & 3) * 128 + wc * 32 + 8 * fq;
#pragma unroll
    for (int ai = 0; ai < 2; ++ai)
#pragma unroll
      for (int m = 0; m < 4; ++m) {
        const unsigned row = row0 + ai * 128 + m * 16;
        float h[8];
#pragma unroll
        for (int n = 0; n < 2; ++n)
#pragma unroll
          for (int j = 0; j < 4; ++j) h[n * 4 + j] = siluf_(acc[ai][0][m][n][j]) * acc[ai][1][m][n][j];
        u32x4 w; w.x = pk2(h[0], h[1]); w.y = pk2(h[2], h[3]); w.z = pk2(h[4], h[5]); w.w = pk2(h[6], h[7]);
        *(u32x4*)(Hm + row * DE + c0) = w;
      }
  }
};
struct EpiMoe2 {
  static constexpr bool PERM = true, AFTER_DRAIN = false;
  bf16_t* Y; const float* awp;
  DEV void operator()(const f32x4 (&acc)[2][2][4][2], const Unit& u, int wr, int wc, int fr, int fq) const {
    const int row0 = u.pm * 256 + wr * 64 + fr, c0 = (u.pn & 3) * 256 + wc * 32 + 8 * fq;
#pragma unroll
    for (int ai = 0; ai < 2; ++ai)
#pragma unroll
      for (int m = 0; m < 4; ++m) {
        const unsigned row = row0 + ai * 128 + m * 16;
        const float w8 = awp[row];
#pragma unroll
        for (int bj = 0; bj < 2; ++bj) {
          const f32x4 v0 = acc[ai][bj][m][0] * w8, v1 = acc[ai][bj][m][1] * w8;
          u32x4 w; w.x = pk2(v0[0], v0[1]); w.y = pk2(v0[2], v0[3]); w.z = pk2(v1[0], v1[1]); w.w = pk2(v1[2], v1[3]);
          *(u32x4*)(Y + row * D + c0 + bj * 128) = w;
        }
      }
  }
};
struct EpiMlIn {
  static constexpr bool PERM = false, AFTER_DRAIN = false;
  bf16_t* qb; bf16_t* kb; bf16_t* kT; bf16_t* vT; bf16_t* og;
  DEV void operator()(const f32x4 (&acc)[2][2][4][2], const Unit& u, int wr, int wc, int fr, int fq) const {
    const unsigned row0 = u.pm * 256 + wr * 64 + fr, c0 = u.pn * 256 + wc * 32 + 4 * fq;
    const int pn = u.pn;
#define MLIN_LOOP(BODY) _Pragma("unroll") for (int ai = 0; ai < 2; ++ai) _Pragma("unroll") for (int m = 0; m < 4; ++m) { const unsigned row = row0 + ai * 128 + m * 16; \
      _Pragma("unroll") for (int bj = 0; bj < 2; ++bj) _Pragma("unroll") for (int n = 0; n < 2; ++n) { const f32x4 v = acc[ai][bj][m][n]; const unsigned col = c0 + bj * 128 + n * 16; BODY } }
    if (pn < 2) {
      MLIN_LOOP({ u32x2 o; o.x = pk2(v[0] * 0.125f, v[1] * 0.125f); o.y = pk2(v[2] * 0.125f, v[3] * 0.125f); *(u32x2*)(qb + row * 512 + col) = o; })
    } else if (pn < 4) {
      MLIN_LOOP({ u32x2 o; o.x = pk2(v[0], v[1]); o.y = pk2(v[2], v[3]); *(u32x2*)(kb + row * 512 + col - 512) = o;
        bf16_t* kp = kT + (col - 512) * T + row;
        kp[0] = (bf16_t)(o.x & 0xffffu); kp[T] = (bf16_t)(o.x >> 16); kp[2 * T] = (bf16_t)(o.y & 0xffffu); kp[3 * T] = (bf16_t)(o.y >> 16); })
    } else if (pn < 8) {
      MLIN_LOOP({ u32x2 o; o.x = pk2(v[0], v[1]); o.y = pk2(v[2], v[3]);
        bf16_t* vp = vT + (col - 1024) * T + row;
        vp[0] = (bf16_t)(o.x & 0xffffu); vp[T] = (bf16_t)(o.x >> 16); vp[2 * T] = (bf16_t)(o.y & 0xffffu); vp[3 * T] = (bf16_t)(o.y >> 16); })
    } else {
      MLIN_LOOP({ u32x2 o; o.x = pk2(sigmoidf_(v[0]), sigmoidf_(v[1])); o.y = pk2(sigmoidf_(v[2]), sigmoidf_(v[3])); *(u32x2*)(og + row * D + col - 2048) = o; })
    }
#undef MLIN_LOOP
  }
};

struct MoeOrder {
  const int* tb; int ntn, G, c;
  DEV bool next(int i, Unit& u) const {
    const int U = tb[32], per = (U + 7) >> 3, xcd = c & 7, lo = xcd * per, hi = min(lo + per, U);
    const int L = lo + i * (G >> 3) + (c >> 3); if (L >= hi) return false;
    int e = 0;
#pragma unroll 1
    for (int k = 1; k < 32; ++k) e = (L >= tb[k]) ? k : e;
    const int r = L - tb[e], mt = (tb[e + 1] - tb[e]) / ntn;
    u.pm = tb[33 + e] + r % mt; u.pn = e * ntn + r / mt; return true;
  }
  DEV void a_ready(const Unit&) const {}
  DEV void done(const Unit&) const {}
};
constexpr int LDS_TB = 131072;
DEV void moe_tables(const int* cnt, char* smem, int ntn) {
  int* tb = (int*)(smem + LDS_TB);
  if (threadIdx.x == 0) {
    int ub = 0, rb = 0;
    for (int e = 0; e < 32; ++e) { const int m = (cnt[e * CNT_STRIDE] + 255) >> 8; tb[e] = ub; tb[33 + e] = rb; ub += m * ntn; rb += m; }
    tb[32] = ub; tb[65] = rb;
  }
  __syncthreads();
}

template <int NT>
DEV void wave_gemm16(const bf16_t* A, int lda, const bf16_t* Bt, int ldb, int ks0, int ks1, f32x4 (&acc)[NT]) {
  const int lane = tidf() & 63, fr = lane & 15, fq = lane >> 4;
  const bf16_t* ap = A + (size_t)fr * lda + fq * 8; const bf16_t* bp = Bt + (size_t)fr * ldb + fq * 8;
#pragma unroll 4
  for (int ks = ks0; ks < ks1; ++ks) {
    const bf16x8 a = *(const bf16x8*)(ap + ks * 32);
#pragma unroll
    for (int n = 0; n < NT; ++n) {
      const bf16x8 b = *(const bf16x8*)(bp + (size_t)n * 16 * ldb + ks * 32);
      acc[n] = __builtin_amdgcn_mfma_f32_16x16x32_bf16(a, b, acc[n], 0, 0, 0);
    }
  }
}
DEV void ph_out0_ctx(const Params& p, char* smem) {
  const int tf = tidf(), lane = tf & 63, wv = tf >> 6, fr = lane & 15, fq = lane >> 4;
  const int b = blockIdx.x;
  f32x4* red = (f32x4*)smem;
  if (b < 256) {
    const int rt = b >> 4, cg = b & 15, nt = wv & 3, kh = wv >> 2;
    f32x4 acc[1] = {(f32x4){0.f, 0.f, 0.f, 0.f}};
    wave_gemm16<1>((const bf16_t*)(p.ws + WS_PR) + (size_t)(NL + rt * 16) * DR, DR, (const bf16_t*)(p.ws + WS_WOUT) + (size_t)(cg * 64 + nt * 16) * DR, DR, kh * 20, kh * 20 + 20, acc);
    if (kh == 1) red[nt * 64 + lane] = acc[0];
    __syncthreads();
    if (kh == 0) {
      const f32x4 v = acc[0] + red[nt * 64 + lane];
      const int col = cg * 64 + nt * 16 + fr;
      const float gt = ((const float*)(p.ws + WS_MODS))[6144 + 2048 + col];
      bf16_t* x1 = (bf16_t*)(p.ws + WS_X1);
#pragma unroll
      for (int j = 0; j < 4; ++j) { const int r = rt * 16 + fq * 4 + j; x1[(size_t)(NL + r) * D + col] = f2bf(p.in[2][(size_t)r * D + col] + gt * v[j]); }
    }
  } else __syncthreads();
  __syncthreads();
}
DEV void ph_mlin_small(const Params& p, char* smem) {
  const int tf = tidf(), lane = tf & 63, wv = tf >> 6, fr = lane & 15, fq = lane >> 4;
  const bf16_t* hA = (const bf16_t*)(p.ws + WS_HA); const bf16_t* W = (const bf16_t*)(p.ws + WS_WML);
  bf16_t* kb = (bf16_t*)(p.ws + WS_K); bf16_t* kT = (bf16_t*)(p.ws + WS_KT); bf16_t* vT = (bf16_t*)(p.ws + WS_VT); float* gl = (float*)(p.ws + WS_GL);
  const int b = blockIdx.x;
  if (b < 192) {
    const int rt = b / 12, cg = b % 12, col0 = 512 + cg * 128 + wv * 16;
    f32x4 acc[1] = {(f32x4){0.f, 0.f, 0.f, 0.f}};
    wave_gemm16<1>(hA + (size_t)(NL + rt * 16) * D, D, W + (size_t)col0 * D, D, 0, 32, acc);
    const unsigned col = col0 + fr, row = NL + rt * 16 + fq * 4;
    u32x2 o; o.x = pk2(acc[0][0], acc[0][1]); o.y = pk2(acc[0][2], acc[0][3]);
    if (col < 1024) {
      *(u32x2*)(kT + (col - 512) * T + row) = o;
      kb[(row + 0) * 512 + col - 512] = (bf16_t)(o.x & 0xffffu); kb[(row + 1) * 512 + col - 512] = (bf16_t)(o.x >> 16);
      kb[(row + 2) * 512 + col - 512] = (bf16_t)(o.y & 0xffffu); kb[(row + 3) * 512 + col - 512] = (bf16_t)(o.y >> 16);
    } else *(u32x2*)(vT + (col - 1024) * T + row) = o;
  }
  {
    char* As = smem; float* red = (float*)(smem + 16 * 2064);
    const float* bgt = p.in[29];
    for (int u = blockIdx.x; u < T / 16; u += gridDim.x) {
      __syncthreads();
#pragma unroll
      for (int rr = 0; rr < 2; ++rr) {
        const int r = wv * 2 + rr; const u32x4* src = (const u32x4*)(hA + (size_t)(u * 16 + r) * D);
        const u32x4 v0 = src[lane], v1 = src[lane + 64];
        *(u32x4*)(As + r * 2064 + lane * 16) = v0; *(u32x4*)(As + r * 2064 + 1024 + lane * 16) = v1;
      }
      __syncthreads();
      f32x4 acc[2] = {(f32x4){0.f, 0.f, 0.f, 0.f}, (f32x4){0.f, 0.f, 0.f, 0.f}};
#pragma unroll
      for (int s4 = 0; s4 < 4; ++s4) {
        const int ks = wv * 4 + s4;
        const bf16x8 a = *(const bf16x8*)(As + fr * 2064 + (ks * 32 + fq * 8) * 2);
#pragma unroll
        for (int n = 0; n < 2; ++n) {
          const bf16x8 bb = *(const bf16x8*)(W + (size_t)(3072 + n * 16 + fr) * D + ks * 32 + fq * 8);
          acc[n] = __builtin_amdgcn_mfma_f32_16x16x32_bf16(a, bb, acc[n], 0, 0, 0);
        }
      }
#pragma unroll
      for (int n = 0; n < 2; ++n)
#pragma unroll
        for (int j = 0; j < 4; ++j) red[(wv * 16 + fq * 4 + j) * 32 + n * 16 + fr] = acc[n][j];
      __syncthreads();
      {
        const int row = tf >> 5, jj = tf & 31;
        float g = bgt[jj];
#pragma unroll
        for (int w = 0; w < 8; ++w) g += red[(w * 16 + row) * 32 + jj];
        gl[(size_t)(u * 16 + row) * 32 + jj] = ((jj >> 3) & 1) ? (fminf(g, 0.f) - log1pf(__expf(-fabsf(g)))) : g;
      }
    }
    __syncthreads();
  }
}

template <int WHICH>
DEV void ph_gemm_dense(const Params& p, char* smem) {
  pg8::StaticOrder S;
  LAS unsigned char* lds = (LAS unsigned char*)smem;
  if constexpr (WHICH == 0) {
    S.init(T, 2560, gridDim.x, blockIdx.x);
    EpiRgIn E{(bf16_t*)(p.ws + WS_GG), (bf16_t*)(p.ws + WS_PR)};
    pg8::gemm_phase<EpiRgIn, pg8::StaticOrder>(lds, pg8::Gemm{(const bf16_t*)(p.ws + WS_HA), (const bf16_t*)(p.ws + WS_WIN), T, 2560, 1024}, S, E, nullptr);
  } else if constexpr (WHICH == 1) {
    S.init(NL, 1024, gridDim.x, blockIdx.x);
    EpiOut<0> E{p.in[0], p.in[2], nullptr, (const float*)(p.ws + WS_MODS), (bf16_t*)(p.ws + WS_X1)};
    pg8::gemm_phase<EpiOut<0>, pg8::StaticOrder>(lds, pg8::Gemm{(const bf16_t*)(p.ws + WS_PR), (const bf16_t*)(p.ws + WS_WOUT), NL, 1024, 1280}, S, E, nullptr);
  } else if constexpr (WHICH == 2) {
    S.init(NL, 3072, gridDim.x, blockIdx.x);
    EpiMlIn E{(bf16_t*)(p.ws + WS_Q), (bf16_t*)(p.ws + WS_K), (bf16_t*)(p.ws + WS_KT), (bf16_t*)(p.ws + WS_VT), (bf16_t*)(p.ws + WS_OG)};
    pg8::gemm_phase<EpiMlIn, pg8::StaticOrder>(lds, pg8::Gemm{(const bf16_t*)(p.ws + WS_HA), (const bf16_t*)(p.ws + WS_WML), NL, 3072, 1024}, S, E, nullptr);
  } else {
    S.init(NL, 1024, gridDim.x, blockIdx.x);
    EpiOut<1> E{nullptr, nullptr, (const bf16_t*)(p.ws + WS_X2), (const float*)(p.ws + WS_MODS) + 2 * 6144, (bf16_t*)(p.ws + WS_X1)};
    pg8::gemm_phase<EpiOut<1>, pg8::StaticOrder>(lds, pg8::Gemm{(const bf16_t*)(p.ws + WS_HA), (const bf16_t*)(p.ws + WS_WMO), NL, 1024, 1024}, S, E, nullptr);
  }
}
template <int LAYER, int STAGE>
DEV void ph_gemm_moe(const Params& p, char* smem) {
  const int* cnt = (const int*)(p.ws + WS_CNT) + LAYER * 32 * CNT_STRIDE;
  moe_tables(cnt, smem, 4);
  MoeOrder S{(const int*)(smem + LDS_TB), 4, (int)gridDim.x, (int)blockIdx.x};
  LAS unsigned char* lds = (LAS unsigned char*)smem;
  if constexpr (STAGE == 0) {
    EpiMoe1 E{(bf16_t*)(p.ws + WS_HM)};
    pg8::gemm_phase<EpiMoe1, MoeOrder>(lds, pg8::Gemm{(const bf16_t*)(p.ws + WS_ABUF), (const bf16_t*)(p.ws + WS_WGU), MOE_ROWS, 32 * 1024, 1024}, S, E, nullptr);
  } else {
    EpiMoe2 E{(bf16_t*)(p.ws + WS_Y), (const float*)(p.ws + WS_AWP)};
    pg8::gemm_phase<EpiMoe2, MoeOrder>(lds, pg8::Gemm{(const bf16_t*)(p.ws + WS_HM), (const bf16_t*)(p.ws + WS_WD), MOE_ROWS, 32 * 1024, 512}, S, E, nullptr);
  }
}

template <int LAYER>
DEV void ph_scatter(const Params& p, char* smem, int bid, int nb) {
  const int tid = tidx(), lane = tid & 63, wave = tid >> 6;
  constexpr int NTOK = LAYER == 0 ? T : NL;
  constexpr int NU = NTOK / 16;
  int* cnt = (int*)(p.ws + WS_CNT) + LAYER * 32 * CNT_STRIDE;
  const int* eid = (const int*)(p.ws + WS_LIST); const int* hstg = eid + T;
  const float* aw = (const float*)(p.ws + WS_AW);
  int* pos = (int*)(p.ws + WS_POS); float* awp = (float*)(p.ws + WS_AWP);
  const bf16_t* hA = (const bf16_t*)(p.ws + WS_HA); bf16_t* Ab = (bf16_t*)(p.ws + WS_ABUF);
  int* part = (int*)smem;
  int* base = part + 512;
  int* dstl = base + 32;
  {
    const int e = tid & 31, pt = tid >> 5; int tot = 0, below = 0;
    for (int v = pt * (nb / 8); v < (pt + 1) * (nb / 8); ++v) { const int h = hstg[v * 32 + e]; tot += h; below += v < bid ? h : 0; }
    part[(pt * 32 + e) * 2] = tot; part[(pt * 32 + e) * 2 + 1] = below;
  }
  __syncthreads();
  if (tid == 0) {
    int o = 0;
    for (int e = 0; e < 32; ++e) {
      int tot = 0, below = 0;
      for (int pt = 0; pt < 8; ++pt) { tot += part[(pt * 32 + e) * 2]; below += part[(pt * 32 + e) * 2 + 1]; }
      base[e] = o + below; o += ((tot + 255) >> 8) << 8;
      if (bid == 0) cnt[e * CNT_STRIDE] = tot;
    }
    for (int it = 0; bid + it * nb < NU; ++it) {
      const int t0 = (bid + it * nb) * 16;
      for (int i = 0; i < 16; ++i) {
        const int ee = eid[t0 + i], ea = ee & 255, eb = ee >> 8;
        const int da = base[ea]++, db = base[eb]++;
        dstl[it * 32 + 2 * i] = da; dstl[it * 32 + 2 * i + 1] = db;
      }
    }
  }
  __syncthreads();
  for (int it = 0; bid + it * nb < NU; ++it) {
    const int t0 = (bid + it * nb) * 16;
    if (tid < 32) { const int d = dstl[it * 32 + tid]; pos[2 * t0 + tid] = d; awp[d] = aw[2 * t0 + tid]; }
#pragma unroll
    for (int hh = 0; hh < 2; ++hh) {
      u32x4 v0[4], v1[4];
#pragma unroll
      for (int q = 0; q < 4; ++q) { const int a = wave * 8 + hh * 4 + q; const u32x4* src = (const u32x4*)(hA + (size_t)(t0 + (a >> 1)) * D); v0[q] = src[lane]; v1[q] = src[lane + 64]; }
#pragma unroll
      for (int q = 0; q < 4; ++q) { const int a = wave * 8 + hh * 4 + q; u32x4* d = (u32x4*)(Ab + (size_t)dstl[it * 32 + a] * D); d[lane] = v0[q]; d[lane + 64] = v1[q]; }
    }
  }
  __syncthreads();
}

constexpr int RT_STRIDE = 2064;
constexpr int RT_H2 = 0, RT_LO = 16 * RT_STRIDE, RT_RED = 2 * 16 * RT_STRIDE, RT_SMEM = RT_RED + 4 * 16 * 48 * 4;
constexpr int R2_ASTR = 528;
constexpr int R2_AH = 0, R2_AL = 80 * R2_ASTR, R2_RSTD = 2 * 80 * R2_ASTR;
constexpr int R2_RED = 0, R2_LG = 8 * 80 * 48 * 4, R2_HIST = R2_LG + 80 * 48 * 4, R2_SMEM = R2_HIST + 128;
template <int LAYER>
DEV void ph_router2(const Params& p, char* smem) {
  const int tf = tidf(), lane = tf & 63, wv = tf >> 6, fr = lane & 15, fq = lane >> 4;
  const int b = blockIdx.x;
  const bool has_ctx = LAYER == 0 && b < 16;
  const int nrow = has_ctx ? 80 : 64, nmt = has_ctx ? 5 : 4;
  const float* mods = (const float*)(p.ws + WS_MODS) + LAYER * 2 * 6144;
  const bf16_t* x1 = (const bf16_t*)(p.ws + WS_X1);
  bf16_t* hA = (bf16_t*)(p.ws + WS_HA);
  const float* g2 = p.in[LAYER == 0 ? 7 : 27];
  const float* Bg = p.in[LAYER == 0 ? 18 : 33]; const float* Be = p.in[LAYER == 0 ? 20 : 35];
  int* eid = (int*)(p.ws + WS_LIST); int* hstg = eid + T; float* aw = (float*)(p.ws + WS_AW);
  char* AH = smem + R2_AH; char* AL = smem + R2_AL; float* rstd_s = (float*)(smem + R2_RSTD);
  float* red = (float*)(smem + R2_RED); float* lgt = (float*)(smem + R2_LG); int* hist = (int*)(smem + R2_HIST);
  auto tok_of = [&](int r) { return r < 64 ? b * 64 + r : NL + b * 16 + (r - 64); };
  if (tf < 32) hist[tf] = 0;
  for (int rb = 0; rb < nrow; rb += 32) {
    f32x4 v[4][4]; float ss[4];
#pragma unroll
    for (int q = 0; q < 4; ++q) {
      const int r = rb + wv + 8 * q; const int t = tok_of(r < nrow ? r : 0);
      const bf16_t* src = x1 + (size_t)t * D;
#pragma unroll
      for (int i = 0; i < 4; ++i) v[q][i] = ld_bf4(src + 4 * lane + 256 * i);
    }
#pragma unroll
    for (int q = 0; q < 4; ++q) {
      ss[q] = 0.f;
#pragma unroll
      for (int i = 0; i < 4; ++i) ss[q] += v[q][i].x * v[q][i].x + v[q][i].y * v[q][i].y + v[q][i].z * v[q][i].z + v[q][i].w * v[q][i].w;
      ss[q] = rsqrtf(wave_sum(ss[q]) * (1.f / D) + EPS);
    }
#pragma unroll
    for (int q = 0; q < 4; ++q) {
      const int r = rb + wv + 8 * q;
      if (r < nrow) {
        const int t = tok_of(r);
        const float* md = mods + ((LAYER == 0 && t >= NL) ? 6144 : 0);
        if (lane == 0) rstd_s[r] = ss[q];
#pragma unroll
        for (int i = 0; i < 4; ++i) {
          const int c = 4 * lane + 256 * i;
          const f32x4 g = *(const f32x4*)(g2 + c), sh = *(const f32x4*)(md + 3072 + c), sc = *(const f32x4*)(md + 4096 + c);
          const f32x4 h = v[q][i] * ss[q] * g * (1.f + sc) + sh;
          u32x2 o; o.x = pk2(h.x, h.y); o.y = pk2(h.z, h.w);
          *(u32x2*)(hA + (size_t)t * D + c) = o;
        }
      }
    }
  }
  __syncthreads();
  f32x4 acc[5][3];
#pragma unroll
  for (int m = 0; m < 5; ++m)
#pragma unroll
    for (int n = 0; n < 3; ++n) acc[m][n] = (f32x4){0.f, 0.f, 0.f, 0.f};
  const bf16_t* Wh = (const bf16_t*)(p.ws + WS_WR) + (size_t)(LAYER * 2) * 48 * 1024 + (size_t)fr * 1024 + fq * 8;
  const bf16_t* Wl = Wh + 48 * 1024;
#pragma unroll 1
  for (int c = 0; c < 4; ++c) {
    const int k = 256 * c + 4 * lane;
    const f32x4 g = *(const f32x4*)(g2 + k);
    f32x4 xv[10];
#pragma unroll
    for (int q = 0; q < 10; ++q) { const int r = wv + 8 * q; if (r < nrow) xv[q] = ld_bf4(x1 + (size_t)tok_of(r) * D + k); }
#pragma unroll
    for (int q = 0; q < 10; ++q) {
      const int r = wv + 8 * q;
      if (r < nrow) {
        const float* md = mods + ((LAYER == 0 && r >= 64) ? 6144 : 0);
        const f32x4 sh = *(const f32x4*)(md + 3072 + k), sc = *(const f32x4*)(md + 4096 + k);
        const f32x4 h = xv[q] * rstd_s[r] * g * (1.f + sc) + sh;
        u32x2 o; o.x = pk2(h.x, h.y); o.y = pk2(h.z, h.w);
        u32x2 l; l.x = pk2(h.x - bflo(o.x), h.y - bfhi(o.x)); l.y = pk2(h.z - bflo(o.y), h.w - bfhi(o.y));
        *(u32x2*)(AH + r * R2_ASTR + lane * 8) = o; *(u32x2*)(AL + r * R2_ASTR + lane * 8) = l;
      }
    }
    __syncthreads();
    bf16x8 bh[3], bl[3];
#pragma unroll
    for (int n = 0; n < 3; ++n) { bh[n] = *(const bf16x8*)(Wh + (size_t)n * 16 * 1024 + c * 256 + wv * 32); bl[n] = *(const bf16x8*)(Wl + (size_t)n * 16 * 1024 + c * 256 + wv * 32); }
#pragma unroll
    for (int m = 0; m < 5; ++m) {
      if (m < nmt) {
        const bf16x8 ah = *(const bf16x8*)(AH + (m * 16 + fr) * R2_ASTR + (wv * 32 + fq * 8) * 2), al = *(const bf16x8*)(AL + (m * 16 + fr) * R2_ASTR + (wv * 32 + fq * 8) * 2);
#pragma unroll
        for (int n = 0; n < 3; ++n) {
          acc[m][n] = __builtin_amdgcn_mfma_f32_16x16x32_bf16(al, bh[n], acc[m][n], 0, 0, 0);
          acc[m][n] = __builtin_amdgcn_mfma_f32_16x16x32_bf16(ah, bl[n], acc[m][n], 0, 0, 0);
          acc[m][n] = __builtin_amdgcn_mfma_f32_16x16x32_bf16(ah, bh[n], acc[m][n], 0, 0, 0);
        }
      }
    }
    __syncthreads();
  }
#pragma unroll
  for (int m = 0; m < 5; ++m)
    if (m < nmt) {
#pragma unroll
      for (int n = 0; n < 3; ++n)
#pragma unroll
        for (int j = 0; j < 4; ++j) red[(wv * 80 + m * 16 + fq * 4 + j) * 48 + n * 16 + fr] = acc[m][n][j];
    }
  __syncthreads();
  for (int i = tf; i < nrow * 48; i += 512) {
    float sm = 0.f;
#pragma unroll
    for (int w = 0; w < 8; ++w) sm += red[w * 80 * 48 + i];
    lgt[i] = sm;
  }
  __syncthreads();
  if (tf < nrow) {
    const int t = tok_of(tf);
    const float* lg = lgt + tf * 48;
    float gl[4];
#pragma unroll
    for (int i = 0; i < 4; ++i) gl[i] = lg[32 + i] + Bg[i];
    int grp = 0; float gm = gl[0];
#pragma unroll
    for (int i = 1; i < 4; ++i) if (gl[i] > gm) { gm = gl[i]; grp = i; }
    float den = 0.f;
#pragma unroll
    for (int i = 0; i < 4; ++i) den += __expf(gl[i] - gm);
    const float psel = 1.f / den;
    float v0 = -INFINITY, v1 = -INFINITY; int i0 = 0, i1 = 0;
    for (int i = 0; i < 8; ++i) {
      const float v = lg[grp * 8 + i] + Be[grp * 8 + i];
      if (v > v0) { v1 = v0; i1 = i0; v0 = v; i0 = i; }
      else if (v > v1) { v1 = v; i1 = i; }
    }
    const float e1 = __expf(v1 - v0);
    const float w0 = psel / (1.f + e1), w1 = psel * e1 / (1.f + e1);
    const int ea = grp * 8 + i0, eb = grp * 8 + i1;
    eid[t] = ea | (eb << 8);
    aw[2 * t] = w0; aw[2 * t + 1] = w1;
    atomicAdd(&hist[ea], 1); atomicAdd(&hist[eb], 1);
  }
  __syncthreads();
  if (tf < 32) hstg[b * 32 + tf] = hist[tf];
}

template <int LAYER>
DEV void ph_scatter2(const Params& p, char* smem) {
  const int tf = tidf(), lane = tf & 63, wv = tf >> 6;
  const int b = blockIdx.x, G = gridDim.x;
  const bool has_ctx = LAYER == 0 && b < 16;
  const int nrow = has_ctx ? 80 : 64;
  int* cnt = (int*)(p.ws + WS_CNT) + LAYER * 32 * CNT_STRIDE;
  const int* eid = (const int*)(p.ws + WS_LIST); const int* hstg = eid + T;
  const float* aw = (const float*)(p.ws + WS_AW);
  int* pos = (int*)(p.ws + WS_POS); float* awp = (float*)(p.ws + WS_AWP);
  const bf16_t* hA = (const bf16_t*)(p.ws + WS_HA); bf16_t* Ab = (bf16_t*)(p.ws + WS_ABUF);
  int* part = (int*)smem;
  int* base = part + 1024;
  int* dstl = base + 32;
  auto tok_of = [&](int r) { return r < 64 ? b * 64 + r : NL + b * 16 + (r - 64); };
  { const int e = tf & 31, pt = tf >> 5, per = (G + 15) / 16; int tot = 0, below = 0;
    for (int v = pt * per; v < (pt + 1) * per && v < G; ++v) { const int h = hstg[v * 32 + e]; tot += h; below += v < b ? h : 0; }
    part[(pt * 32 + e) * 2] = tot; part[(pt * 32 + e) * 2 + 1] = below; }
  __syncthreads();
  if (tf == 0) {
    int o = 0;
    for (int e = 0; e < 32; ++e) {
      int tot = 0, below = 0;
      for (int pt = 0; pt < 16; ++pt) { tot += part[(pt * 32 + e) * 2]; below += part[(pt * 32 + e) * 2 + 1]; }
      base[e] = o + below; o += ((tot + 255) >> 8) << 8;
      if (b == 0) cnt[e * CNT_STRIDE] = tot;
    }
    for (int r = 0; r < nrow; ++r) {
      const int ee = eid[tok_of(r)], ea = ee & 255, eb = ee >> 8;
      dstl[2 * r] = base[ea]++; dstl[2 * r + 1] = base[eb]++;
    }
  }
  __syncthreads();
  if (tf < 2 * nrow) { const int t = tok_of(tf >> 1), d = dstl[tf]; pos[2 * t + (tf & 1)] = d; awp[d] = aw[2 * t + (tf & 1)]; }
  for (int a0 = wv * 4; a0 < 2 * nrow; a0 += 32) {
    u32x4 v0[4], v1[4];
#pragma unroll
    for (int q = 0; q < 4; ++q) { const u32x4* src = (const u32x4*)(hA + (size_t)tok_of((a0 + q) >> 1) * D); v0[q] = src[lane]; v1[q] = src[lane + 64]; }
#pragma unroll
    for (int q = 0; q < 4; ++q) { u32x4* d = (u32x4*)(Ab + (size_t)dstl[a0 + q] * D); d[lane] = v0[q]; d[lane + 64] = v1[q]; }
  }
  __syncthreads();
}

DEV void ph_combine0(const Params& p, int bid, int nb) {
  const int lane = tidx() & 63, wave = tidx() >> 6;
  const float* mods0 = (const float*)(p.ws + WS_MODS); const float* mods1 = mods0 + 2 * 6144;
  const bf16_t* x1 = (const bf16_t*)(p.ws + WS_X1); bf16_t* x2 = (bf16_t*)(p.ws + WS_X2);
  const bf16_t* Y = (const bf16_t*)(p.ws + WS_Y); const int* pos = (const int*)(p.ws + WS_POS);
  bf16_t* hA = (bf16_t*)(p.ws + WS_HA);
  const float* g1 = p.in[26];
  for (int t0 = (bid * 4 + wave) * 2; t0 < T; t0 += nb * 8) {
    f32x4 xv[2][4]; u32x2 ya[2][4], yb[2][4];
#pragma unroll
    for (int q = 0; q < 2; ++q) {
      const int t = t0 + q;
      const bf16_t* Ya = Y + (size_t)pos[2 * t] * D; const bf16_t* Yb = Y + (size_t)pos[2 * t + 1] * D;
#pragma unroll
      for (int i = 0; i < 4; ++i) { const int c = 4 * lane + 256 * i; xv[q][i] = ld_bf4(x1 + (size_t)t * D + c); ya[q][i] = *(const u32x2*)(Ya + c); yb[q][i] = *(const u32x2*)(Yb + c); }
    }
#pragma unroll
    for (int q = 0; q < 2; ++q) {
      const int t = t0 + q;
      const float* m0 = mods0 + (t < NL ? 0 : 6144); const float* m1 = mods1 + (t < NL ? 0 : 6144);
      const int orow = t < NL ? seqrow_of_token(t) : t;
      float ss = 0.f;
#pragma unroll
      for (int i = 0; i < 4; ++i) {
        const int c = 4 * lane + 256 * i;
        const f32x4 gt = *(const f32x4*)(m0 + 5120 + c);
        f32x4 f; f.x = bflo(ya[q][i].x) + bflo(yb[q][i].x); f.y = bfhi(ya[q][i].x) + bfhi(yb[q][i].x); f.z = bflo(ya[q][i].y) + bflo(yb[q][i].y); f.w = bfhi(ya[q][i].y) + bfhi(yb[q][i].y);
        xv[q][i] = xv[q][i] + gt * f;
        st_bf4(x2 + (size_t)t * D + c, xv[q][i]);
        ss += xv[q][i].x * xv[q][i].x + xv[q][i].y * xv[q][i].y + xv[q][i].z * xv[q][i].z + xv[q][i].w * xv[q][i].w;
      }
      const float rstd = rsqrtf(wave_sum(ss) * (1.f / D) + EPS);
#pragma unroll
      for (int i = 0; i < 4; ++i) {
        const int c = 4 * lane + 256 * i;
        const f32x4 g = *(const f32x4*)(g1 + c), sh = *(const f32x4*)(m1 + c), sc = *(const f32x4*)(m1 + 1024 + c);
        const f32x4 h = xv[q][i] * rstd * g * (1.f + sc) + sh;
        u32x2 o; o.x = pk2(h.x, h.y); o.y = pk2(h.z, h.w);
        *(u32x2*)(hA + (size_t)orow * D + c) = o;
      }
    }
  }
}

DEV void ml_gate_scans(const float* gl, int r0, int h, float* li_f, float* cf, float* li_b, float* cb) {
  const int tid = tidx(), lane = tid & 63, wave = tid >> 6;
  if (tid < 128) { li_f[tid] = gl[(size_t)(r0 + tid) * 32 + h]; li_b[tid] = gl[(size_t)(r0 + tid) * 32 + 16 + h]; }
  if (wave == 0) {
    const float v0 = gl[(size_t)(r0 + 2 * lane) * 32 + 8 + h], v1 = gl[(size_t)(r0 + 2 * lane + 1) * 32 + 8 + h];
    const float s = v0 + v1; float inc = s;
#pragma unroll
    for (int o = 1; o < 64; o <<= 1) { const float t = __shfl_up(inc, o); if (lane >= o) inc += t; }
    const float ex = inc - s;
    cf[2 * lane] = ex + v0; cf[2 * lane + 1] = ex + s;
  } else if (wave == 1) {
    const float v0 = gl[(size_t)(r0 + 127 - 2 * lane) * 32 + 24 + h], v1 = gl[(size_t)(r0 + 126 - 2 * lane) * 32 + 24 + h];
    const float s = v0 + v1; float inc = s;
#pragma unroll
    for (int o = 1; o < 64; o <<= 1) { const float t = __shfl_up(inc, o); if (lane >= o) inc += t; }
    const float ex = inc - s;
    cb[127 - 2 * lane] = ex + v0; cb[126 - 2 * lane] = ex + s;
  }
}

constexpr int MLA_STRIDE = 272;
constexpr int MLA_AW = 0, MLA_BV = 2 * 64 * MLA_STRIDE, MLA_G = MLA_BV + 128 * MLA_STRIDE, MLA_SMEM = MLA_G + 6 * 128 * 4;
DEV void ph_ml_state(const Params& p, char* smem, int bid, int nb) {
  const int tid = tidx(), lane = tid & 63, wave = tid >> 6, fr = lane & 15, fq = lane >> 4;
  const float* gl = (const float*)(p.ws + WS_GL);
  const bf16_t* kT = (const bf16_t*)(p.ws + WS_KT); const bf16_t* vT = (const bf16_t*)(p.ws + WS_VT);
  float* UT = (float*)(p.ws + WS_UT); float* nvec = (float*)(p.ws + WS_NVEC); float* dec = (float*)(p.ws + WS_DEC);
  char* Aw = smem + MLA_AW; char* Bv = smem + MLA_BV;
  float* li_f = (float*)(smem + MLA_G); float* cf = li_f + 128; float* li_b = cf + 128; float* cb = li_b + 128; float* wf = cb + 128; float* wb = wf + 128;
  for (int it = 0, iters = (NTILE * 8 + nb - 1) / nb; it < iters; ++it) {
    int u = bid + it * nb; const bool active = u < NTILE * 8; if (!active) u = NTILE * 8 - 1;
    const int h = u % 8, c = u / 8, r0 = c * 128;
    __syncthreads();
    if (active) {
    ml_gate_scans(gl, r0, h, li_f, cf, li_b, cb);
    }
    __syncthreads();
    if (active) {
    if (tid < 128) { wf[tid] = __expf(cf[127] - cf[tid] + li_f[tid]); wb[tid] = __expf(cb[0] - cb[tid] + li_b[tid]); }
    if (tid == 0) { dec[(c * 8 + h) * 2] = __expf(cf[127]); dec[(c * 8 + h) * 2 + 1] = __expf(cb[0]); }
#pragma unroll
    for (int i = 0; i < 8; ++i) {
      const int f = tid + 256 * i, e = f >> 4, pc = f & 15;
      *(u32x4*)(Bv + e * MLA_STRIDE + pc * 16) = *(const u32x4*)(vT + (size_t)(h * 128 + e) * T + r0 + pc * 8);
    }
    }
    __syncthreads();
    if (active) {
#pragma unroll
    for (int i = 0; i < 4; ++i) {
      const int f = tid + 256 * i, d = f >> 4, pc = f & 15;
      const u32x4 kv = *(const u32x4*)(kT + (size_t)(h * 64 + d) * T + r0 + pc * 8);
      float k8[8] = {bflo(kv.x), bfhi(kv.x), bflo(kv.y), bfhi(kv.y), bflo(kv.z), bfhi(kv.z), bflo(kv.w), bfhi(kv.w)};
      u32x4 of, ob;
      of.x = pk2(k8[0] * wf[pc * 8 + 0], k8[1] * wf[pc * 8 + 1]); of.y = pk2(k8[2] * wf[pc * 8 + 2], k8[3] * wf[pc * 8 + 3]);
      of.z = pk2(k8[4] * wf[pc * 8 + 4], k8[5] * wf[pc * 8 + 5]); of.w = pk2(k8[6] * wf[pc * 8 + 6], k8[7] * wf[pc * 8 + 7]);
      ob.x = pk2(k8[0] * wb[pc * 8 + 0], k8[1] * wb[pc * 8 + 1]); ob.y = pk2(k8[2] * wb[pc * 8 + 2], k8[3] * wb[pc * 8 + 3]);
      ob.z = pk2(k8[4] * wb[pc * 8 + 4], k8[5] * wb[pc * 8 + 5]); ob.w = pk2(k8[6] * wb[pc * 8 + 6], k8[7] * wb[pc * 8 + 7]);
      *(u32x4*)(Aw + d * MLA_STRIDE + pc * 16) = of;
      *(u32x4*)(Aw + (64 + d) * MLA_STRIDE + pc * 16) = ob;
    }
    }
    __syncthreads();
    if (active) {
    if (tid < 128) {
      float s = 0.f;
      for (int pc = 0; pc < 16; ++pc) { const u32x4 v = *(const u32x4*)(Aw + tid * MLA_STRIDE + pc * 16);
        s += (bflo(v.x) + bfhi(v.x)) + (bflo(v.y) + bfhi(v.y)) + (bflo(v.z) + bfhi(v.z)) + (bflo(v.w) + bfhi(v.w)); }
      nvec[(size_t)((c * 8 + h) * 2 + (tid >> 6)) * 64 + (tid & 63)] = s;
    }
#pragma unroll
    for (int dir = 0; dir < 2; ++dir) {
      f32x4 acc[4][2];
#pragma unroll
      for (int m = 0; m < 4; ++m) { acc[m][0] = (f32x4){0.f, 0.f, 0.f, 0.f}; acc[m][1] = (f32x4){0.f, 0.f, 0.f, 0.f}; }
#pragma unroll
      for (int ks = 0; ks < 4; ++ks) {
        bf16x8 b[2];
#pragma unroll
        for (int n = 0; n < 2; ++n) b[n] = *(const bf16x8*)(Bv + (wave * 32 + n * 16 + fr) * MLA_STRIDE + (ks * 32 + fq * 8) * 2);
#pragma unroll
        for (int m = 0; m < 4; ++m) {
          const bf16x8 a = *(const bf16x8*)(Aw + (dir * 64 + m * 16 + fr) * MLA_STRIDE + (ks * 32 + fq * 8) * 2);
          acc[m][0] = __builtin_amdgcn_mfma_f32_16x16x32_bf16(a, b[0], acc[m][0], 0, 0, 0);
          acc[m][1] = __builtin_amdgcn_mfma_f32_16x16x32_bf16(a, b[1], acc[m][1], 0, 0, 0);
        }
      }
      float* Uo = UT + (size_t)((c * 8 + h) * 2 + dir) * 8192;
#pragma unroll
      for (int m = 0; m < 4; ++m)
#pragma unroll
        for (int n = 0; n < 2; ++n) *(f32x4*)(Uo + (wave * 32 + n * 16 + fr) * 64 + m * 16 + fq * 4) = acc[m][n];
    }
    }
  }
}

DEV void ph_ml_chain(const Params& p, int bid, int nb) {
  float* UT = (float*)(p.ws + WS_UT); float* nvec = (float*)(p.ws + WS_NVEC); const float* dec = (const float*)(p.ws + WS_DEC);
  const int total = 16 * (8192 + 64);
  for (int i = bid * 256 + tidx(); i < total; i += nb * 256) {
    const int hd = i / 8256, idx = i % 8256;
    const int dir = hd & 1;
    float* base = idx < 8192 ? UT + (size_t)hd * 8192 + idx : nvec + (size_t)hd * 64 + (idx - 8192);
    const size_t cstride = idx < 8192 ? (size_t)16 * 8192 : (size_t)16 * 64;
    float st = 0.f;
#pragma unroll 1
    for (int sb = 0; sb < NTILE; sb += 13) {
      float uv[13], dc[13];
#pragma unroll
      for (int j = 0; j < 13; ++j) {
        const int s = sb + j; const int c = dir == 0 ? (s < 2 ? 128 + s : s - 2) : 129 - s;
        uv[j] = base[(size_t)c * cstride]; dc[j] = dec[c * 16 + hd];
      }
#pragma unroll
      for (int j = 0; j < 13; ++j) {
        const int s = sb + j; const int c = dir == 0 ? (s < 2 ? 128 + s : s - 2) : 129 - s;
        base[(size_t)c * cstride] = st;
        st = dc[j] * st + uv[j];
      }
    }
  }
}

constexpr int MLC_QS = 0;
constexpr int MLC_KS = 9216;
constexpr int MLC_Q2 = MLC_KS + 18432;
constexpr int MLC_BS = MLC_Q2 + 17408;
constexpr int MLC_G  = MLC_BS + 18432;
constexpr int MLC_SMEM = MLC_G + (4 * 128 + 6 * 64) * 4;
DEV void ph_ml_out(const Params& p, char* smem, int bid, int nb) {
  const int tid = tidx(), lane = tid & 63, wave = tid >> 6, fr = lane & 15, fq = lane >> 4;
  const float* gl = (const float*)(p.ws + WS_GL);
  const bf16_t* qb = (const bf16_t*)(p.ws + WS_Q); const bf16_t* kb = (const bf16_t*)(p.ws + WS_K); const bf16_t* vT = (const bf16_t*)(p.ws + WS_VT);
  const bf16_t* og = (const bf16_t*)(p.ws + WS_OG);
  const float* UT = (const float*)(p.ws + WS_UT); const float* nvec = (const float*)(p.ws + WS_NVEC);
  bf16_t* yA = (bf16_t*)(p.ws + WS_HA);
  const float* ng = p.in[30];
  char* Qs = smem + MLC_QS; char* Ks = smem + MLC_KS; char* Ps = Ks; char* Q2 = smem + MLC_Q2; char* Bs = smem + MLC_BS;
  float* li_f = (float*)(smem + MLC_G); float* cf = li_f + 128; float* li_b = cf + 128; float* cb = li_b + 128;
  float* qn = cb + 128; float* sfq = qn + 128; float* sbq = sfq + 64; float* nv = sbq + 64;
  for (int it = 0, iters = ((128 * 2 * 8) + nb - 1) / nb; it < iters; ++it) {
    int u = bid + it * nb; const bool active = u < (128 * 2 * 8); if (!active) u = (128 * 2 * 8) - 1;
    const int h = u % 8, th = (u / 8) & 1, c = u / 16, r0 = c * 128, rt = r0 + th * 64;
    __syncthreads();
    ml_gate_scans(gl, r0, h, li_f, cf, li_b, cb);
    if (tid >= 128) nv[tid - 128] = nvec[(size_t)((c * 8 + h) * 2 + ((tid - 128) >> 6)) * 64 + (tid & 63)];
#pragma unroll
    for (int i = 0; i < 2; ++i) { const int f = tid + 256 * i, r = f >> 3, pc = f & 7;
      *(u32x4*)(Qs + r * 144 + pc * 16) = *(const u32x4*)(qb + (size_t)(rt + r) * 512 + h * 64 + pc * 8); }
#pragma unroll
    for (int i = 0; i < 4; ++i) { const int f = tid + 256 * i, r = f >> 3, pc = f & 7;
      *(u32x4*)(Ks + r * 144 + pc * 16) = *(const u32x4*)(kb + (size_t)(r0 + r) * 512 + h * 64 + pc * 8); }
    __syncthreads();
    if (tid < 128) {
      const int t = tid & 63, dir = tid >> 6; float s = 0.f;
      for (int pc = 0; pc < 8; ++pc) { const u32x4 v = *(const u32x4*)(Qs + t * 144 + pc * 16); const float* nn = nv + dir * 64 + pc * 8;
        s += bflo(v.x) * nn[0] + bfhi(v.x) * nn[1] + bflo(v.y) * nn[2] + bfhi(v.y) * nn[3] + bflo(v.z) * nn[4] + bfhi(v.z) * nn[5] + bflo(v.w) * nn[6] + bfhi(v.w) * nn[7]; }
      qn[dir * 64 + t] = s;
    }
    f32x4 S[8];
#pragma unroll
    for (int n = 0; n < 8; ++n) S[n] = (f32x4){0.f, 0.f, 0.f, 0.f};
#pragma unroll
    for (int ks = 0; ks < 2; ++ks) {
      const bf16x8 a = *(const bf16x8*)(Qs + (wave * 16 + fr) * 144 + (ks * 32 + fq * 8) * 2);
#pragma unroll
      for (int n = 0; n < 8; ++n) {
        const bf16x8 b = *(const bf16x8*)(Ks + (n * 16 + fr) * 144 + (ks * 32 + fq * 8) * 2);
        S[n] = __builtin_amdgcn_mfma_f32_16x16x32_bf16(a, b, S[n], 0, 0, 0);
      }
    }
    __syncthreads();
    float rfv[4], rbv[4];
    {
      float sumf[4] = {0.f, 0.f, 0.f, 0.f}, sumb[4] = {0.f, 0.f, 0.f, 0.f};
      float Sf[8][4], Sb_[8][4];
#pragma unroll
      for (int j = 0; j < 4; ++j) {
        const int tl = wave * 16 + fq * 4 + j, tc = th * 64 + tl;
        const float cft = cf[tc], cbt = cb[tc];
#pragma unroll
        for (int n = 0; n < 8; ++n) {
          const int s = n * 16 + fr;
          const float df = s <= tc ? fexp_(cft - cf[s] + li_f[s]) : 0.f;
          const float db = s >= tc ? fexp_(cbt - cb[s] + li_b[s]) : 0.f;
          Sf[n][j] = S[n][j] * df; Sb_[n][j] = S[n][j] * db;
          sumf[j] += Sf[n][j]; sumb[j] += Sb_[n][j];
        }
      }
#pragma unroll
      for (int j = 0; j < 4; ++j) {
#pragma unroll
        for (int o = 1; o < 16; o <<= 1) { sumf[j] += __shfl_xor(sumf[j], o); sumb[j] += __shfl_xor(sumb[j], o); }
        const int tl = wave * 16 + fq * 4 + j, tc = th * 64 + tl;
        const float ef = __expf(cf[tc]), eb = __expf(cb[tc]);
        const float denf = ef * qn[tl] + sumf[j], denb = eb * qn[64 + tl] + sumb[j];
        rfv[j] = __builtin_amdgcn_rcpf(fmaxf(fabsf(denf), 1.f)); rbv[j] = __builtin_amdgcn_rcpf(fmaxf(fabsf(denb), 1.f));
        if (fr == 0) { sfq[tl] = ef * rfv[j]; sbq[tl] = eb * rbv[j]; }
      }
#pragma unroll
      for (int n = 0; n < 8; ++n)
#pragma unroll
        for (int j = 0; j < 4; ++j) {
          const int tl = wave * 16 + fq * 4 + j;
          *(bf16_t*)(Ps + tl * MLA_STRIDE + (n * 16 + fr) * 2) = f2bf(Sf[n][j] * rfv[j] + Sb_[n][j] * rbv[j]);
        }
    }
    __syncthreads();
#pragma unroll
    for (int i = 0; i < 2; ++i) { const int f = tid + 256 * i, r = f >> 3, pc = f & 7;
      const u32x4 v = *(const u32x4*)(Qs + r * 144 + pc * 16); const float a = sfq[r], b = sbq[r];
      u32x4 o1, o2;
      o1.x = pk2(bflo(v.x) * a, bfhi(v.x) * a); o1.y = pk2(bflo(v.y) * a, bfhi(v.y) * a); o1.z = pk2(bflo(v.z) * a, bfhi(v.z) * a); o1.w = pk2(bflo(v.w) * a, bfhi(v.w) * a);
      o2.x = pk2(bflo(v.x) * b, bfhi(v.x) * b); o2.y = pk2(bflo(v.y) * b, bfhi(v.y) * b); o2.z = pk2(bflo(v.z) * b, bfhi(v.z) * b); o2.w = pk2(bflo(v.w) * b, bfhi(v.w) * b);
      *(u32x4*)(Q2 + r * MLA_STRIDE + pc * 16) = o1; *(u32x4*)(Q2 + r * MLA_STRIDE + 128 + pc * 16) = o2; }
    f32x4 Hh[8];
#pragma unroll
    for (int n = 0; n < 8; ++n) Hh[n] = (f32x4){0.f, 0.f, 0.f, 0.f};
#pragma unroll
    for (int kc = 0; kc < 4; ++kc) {
      __syncthreads();
      if (kc < 2) {
#pragma unroll
        for (int i = 0; i < 4; ++i) { const int f = tid + 256 * i, e = f >> 3, pc = f & 7;
          *(u32x4*)(Bs + e * 144 + pc * 16) = *(const u32x4*)(vT + (size_t)(h * 128 + e) * T + r0 + kc * 64 + pc * 8); }
      } else {
        const float* Cs = UT + (size_t)((c * 8 + h) * 2 + (kc - 2)) * 8192;
#pragma unroll
        for (int i = 0; i < 4; ++i) { const int f = tid + 256 * i, e = f >> 3, pc = f & 7;
          const f32x4 a = *(const f32x4*)(Cs + e * 64 + pc * 8), b = *(const f32x4*)(Cs + e * 64 + pc * 8 + 4);
          u32x4 o; o.x = pk2(a.x, a.y); o.y = pk2(a.z, a.w); o.z = pk2(b.x, b.y); o.w = pk2(b.z, b.w);
          *(u32x4*)(Bs + e * 144 + pc * 16) = o; }
      }
      __syncthreads();
      const char* Asrc = kc < 2 ? Ps + kc * 128 : Q2 + (kc - 2) * 128;
#pragma unroll
      for (int ks = 0; ks < 2; ++ks) {
        const bf16x8 a = *(const bf16x8*)(Asrc + (wave * 16 + fr) * MLA_STRIDE + (ks * 32 + fq * 8) * 2);
#pragma unroll
        for (int n = 0; n < 8; ++n) {
          const bf16x8 b = *(const bf16x8*)(Bs + (n * 16 + fr) * 144 + (ks * 32 + fq * 8) * 2);
          Hh[n] = __builtin_amdgcn_mfma_f32_16x16x32_bf16(a, b, Hh[n], 0, 0, 0);
        }
      }
    }
#pragma unroll
    for (int j = 0; j < 4; ++j) {
      float ss = 0.f;
#pragma unroll
      for (int n = 0; n < 8; ++n) ss += Hh[n][j] * Hh[n][j];
#pragma unroll
      for (int o = 1; o < 16; o <<= 1) ss += __shfl_xor(ss, o);
      const float rstd = rsqrtf(ss * (1.f / 128.f) + EPS);
      const size_t row = (size_t)(rt + wave * 16 + fq * 4 + j);
#pragma unroll
      for (int n = 0; n < 8; ++n) {
        const int col = h * 128 + n * 16 + fr;
        yA[row * D + col] = f2bf(Hh[n][j] * rstd * ng[col] * bf2f(og[row * D + col]));
      }
    }
  }
}

DEV void ph_final(const Params& p, int bid, int nb) {
  const int lane = tidx() & 63, wave = tidx() >> 6;
  const float* mods1 = (const float*)(p.ws + WS_MODS) + 2 * 6144;
  const bf16_t* x1 = (const bf16_t*)(p.ws + WS_X1);
  const bf16_t* Y = (const bf16_t*)(p.ws + WS_Y); const int* pos = (const int*)(p.ws + WS_POS);
  const float* gf = p.in[39];
  for (int t0 = (bid * 4 + wave) * 2; t0 < NL; t0 += nb * 8) {
    f32x4 xv[2][4]; u32x2 ya[2][4], yb[2][4];
#pragma unroll
    for (int q = 0; q < 2; ++q) {
      const int t = t0 + q;
      const bf16_t* Ya = Y + (size_t)pos[2 * t] * D; const bf16_t* Yb = Y + (size_t)pos[2 * t + 1] * D;
#pragma unroll
      for (int i = 0; i < 4; ++i) { const int c = 4 * lane + 256 * i; xv[q][i] = ld_bf4(x1 + (size_t)t * D + c); ya[q][i] = *(const u32x2*)(Ya + c); yb[q][i] = *(const u32x2*)(Yb + c); }
    }
#pragma unroll
    for (int q = 0; q < 2; ++q) {
      const int t = t0 + q;
      float ss = 0.f;
#pragma unroll
      for (int i = 0; i < 4; ++i) {
        const int c = 4 * lane + 256 * i;
        const f32x4 gt = *(const f32x4*)(mods1 + 5120 + c);
        f32x4 f; f.x = bflo(ya[q][i].x) + bflo(yb[q][i].x); f.y = bfhi(ya[q][i].x) + bfhi(yb[q][i].x); f.z = bflo(ya[q][i].y) + bflo(yb[q][i].y); f.w = bfhi(ya[q][i].y) + bfhi(yb[q][i].y);
        xv[q][i] = xv[q][i] + gt * f;
        ss += xv[q][i].x * xv[q][i].x + xv[q][i].y * xv[q][i].y + xv[q][i].z * xv[q][i].z + xv[q][i].w * xv[q][i].w;
      }
      const float rstd = rsqrtf(wave_sum(ss) * (1.f / D) + EPS);
#pragma unroll
      for (int i = 0; i < 4; ++i) {
        const int c = 4 * lane + 256 * i;
        *(f32x4*)(p.out + (size_t)t * D + c) = xv[q][i] * rstd * *(const f32x4*)(gf + c);
      }
    }
  }
}

#define XB_TMO      128
#define XB_XCNT(j)  (256  + 64 * (j))
#define XB_XSUB(j)  (1280 + 64 * (j))
#define XB_XGEN(j)  (2304 + 64 * (j))
#define XB_TOP      3328
#define XB_TOPGEN   3392
#define XCD_BAR_WORDS 3456
#define XB_SPIN_CAP (1u << 22)
DEV unsigned xb_ld(unsigned* p)              { return __hip_atomic_load(p, __ATOMIC_RELAXED, __HIP_MEMORY_SCOPE_AGENT); }
DEV unsigned xb_add(unsigned* p, unsigned v) { return __hip_atomic_fetch_add(p, v, __ATOMIC_RELAXED, __HIP_MEMORY_SCOPE_AGENT); }
DEV unsigned xb_xcc_id() { return (unsigned)__builtin_amdgcn_s_getreg((3 << 11) | 20) & 0xFu; }
#define XB_SPIN(cond, bar) do { unsigned _sp = 0; while (cond) { __builtin_amdgcn_s_sleep(1); \
    if ((++_sp & 255u) == 0u) { if (xb_ld(&(bar)[XB_TMO])) break; if (_sp > XB_SPIN_CAP) { atomicAdd(&(bar)[XB_TMO], 1u); break; } } } } while (0)
struct XcdBarrier { unsigned* bar; unsigned x; volatile LAS unsigned* st; };
DEV XcdBarrier xcd_barrier_post(unsigned* bar, volatile LAS unsigned* st) {
  XcdBarrier b; b.bar = bar; b.x = xb_xcc_id(); b.st = st;
  if (threadIdx.x == 0) (void)xb_add(&bar[XB_XCNT(b.x)], 1u);
  return b;
}
DEV void xcd_barrier_complete(unsigned* bar, unsigned x, unsigned& nloc, unsigned& nx) {
  const unsigned G = gridDim.x * gridDim.y * gridDim.z;
  unsigned sum, cnt, mine, sp = 0u;
  for (;;) {
    sum = 0u; cnt = 0u; mine = 0u;
#pragma unroll
    for (unsigned j = 0; j < 16; ++j) { const unsigned c = xb_ld(&bar[XB_XCNT(j)]); sum += c; cnt += (c > 0u) ? 1u : 0u; mine = (j == x) ? c : mine; }
    if (sum == G) break;
    __builtin_amdgcn_s_sleep(1);
    if ((++sp & 255u) == 0u) { if (xb_ld(&bar[XB_TMO])) break; if (sp > XB_SPIN_CAP) { atomicAdd(&bar[XB_TMO], 1u); break; } }
  }
  nloc = mine > 0u ? mine : 1u; nx = cnt > 0u ? cnt : 1u;
}
DEV void xcd_barrier(const XcdBarrier& b) {
  asm volatile("s_waitcnt vmcnt(0)" ::: "memory");
  __syncthreads();
  if (threadIdx.x == 0) {
    unsigned* bar = b.bar;
    __builtin_amdgcn_s_waitcnt(0);
    unsigned nloc = b.st[0], nx = b.st[1];
    if (nloc == 0u) { xcd_barrier_complete(bar, b.x, nloc, nx); b.st[0] = nloc; b.st[1] = nx; }
    const unsigned old = xb_add(&bar[XB_XSUB(b.x)], 1u);
    const unsigned gen = old / nloc;
    if (old + 1u == (gen + 1u) * nloc) {
      __builtin_amdgcn_fence(__ATOMIC_RELEASE, "agent");
      asm volatile("s_waitcnt vmcnt(0)" ::: "memory");
      const unsigned og = xb_add(&bar[XB_TOP], 1u);
      const unsigned tg = og / nx;
      if (og + 1u == (tg + 1u) * nx) xb_add(&bar[XB_TOPGEN], 1u);
      else XB_SPIN(xb_ld(&bar[XB_TOPGEN]) == tg, bar);
      __builtin_amdgcn_fence(__ATOMIC_ACQUIRE, "agent");
      xb_add(&bar[XB_XGEN(b.x)], 1u);
      asm volatile("s_waitcnt vmcnt(0)" ::: "memory");
    } else {
      XB_SPIN(xb_ld(&bar[XB_XGEN(b.x)]) == gen, bar);
      __builtin_amdgcn_fence(__ATOMIC_ACQUIRE, "agent");
      asm volatile("s_waitcnt vmcnt(0)" ::: "memory");
    }
  }
  __syncthreads();
}

#ifndef REP_MASK
#define REP_MASK 0u
#endif
#ifndef PROBE_PH
#define PROBE_PH -1
#endif
#ifndef PROBE_M
#define PROBE_M 4
#endif
#ifndef XBAR
#define XBAR 0
#endif
constexpr int NPHASE = 22;
constexpr int HALF_SMEM = 78592;
constexpr int LDS_ST = 2 * HALF_SMEM;
constexpr int LDS_BYTES = LDS_ST + 16 + 32;
static_assert(RT_SMEM + 128 <= HALF_SMEM && RG_SMEM <= HALF_SMEM && MLA_SMEM <= HALF_SMEM && MLC_SMEM <= HALF_SMEM, "smem");
static_assert(LDS_TB + 66 * 4 <= LDS_ST && 8 * 8448 <= LDS_ST, "smem");

template <int PH>
DEV void run_phase(const Params& p, char* smem) {
  int half = threadIdx.x >> 8; asm volatile("" : "+v"(half)); half = __builtin_amdgcn_readfirstlane(half);
  char* hs = smem + half * HALF_SMEM;
  const int vb = blockIdx.x * 2 + half, nvb = gridDim.x * 2;
  if constexpr (PH == 0) { ph_adaln(p, hs, vb, nvb); __syncthreads(); ph_convert_dense(p, smem); ph_convert_moe<0>(p, smem); }
  else if constexpr (PH == 1) ph_norm0(p, vb, nvb);
  else if constexpr (PH == 2) ph_gemm_dense<0>(p, smem);
  else if constexpr (PH == 3) ph_rg_scan2(p, smem);
  else if constexpr (PH == 4) ph_rg_carry(p, hs, vb, nvb);
  else if constexpr (PH == 5) ph_rg_final(p, vb, nvb);
  else if constexpr (PH == 6) { ph_out0_ctx(p, smem); ph_gemm_dense<1>(p, smem); }
  else if constexpr (PH == 7) ph_router2<0>(p, smem);
  else if constexpr (PH == 8) ph_scatter2<0>(p, smem);
  else if constexpr (PH == 9) ph_gemm_moe<0, 0>(p, smem);
  else if constexpr (PH == 10) ph_gemm_moe<0, 1>(p, smem);
  else if constexpr (PH == 11) { ph_combine0(p, vb, nvb); ph_convert_moe<1>(p, smem); }
  else if constexpr (PH == 12) { ph_mlin_small(p, smem); ph_gemm_dense<2>(p, smem); }
  else if constexpr (PH == 13) ph_ml_state(p, hs, vb, nvb);
  else if constexpr (PH == 14) ph_ml_chain(p, vb, nvb);
  else if constexpr (PH == 15) ph_ml_out(p, hs, vb, nvb);
  else if constexpr (PH == 16) ph_gemm_dense<3>(p, smem);
  else if constexpr (PH == 17) ph_router2<1>(p, smem);
  else if constexpr (PH == 18) ph_scatter2<1>(p, smem);
  else if constexpr (PH == 19) ph_gemm_moe<1, 0>(p, smem);
  else if constexpr (PH == 20) ph_gemm_moe<1, 1>(p, smem);
  else if constexpr (PH == 21) ph_final(p, vb, nvb);
}

template <int PH>
DEV void run_from(const Params& p, char* smem) {
  run_phase<PH>(p, smem);
  if constexpr ((REP_MASK >> PH) & 1u) {
    __syncthreads();
    run_phase<PH>(p, smem);
  }
  if constexpr (XBAR > 0 && PH + 1 < NPHASE) {
#pragma unroll 1
    for (int xi = 0; xi < XBAR; ++xi) { XcdBarrier xb; xb.bar = (unsigned*)(p.ws + WS_BAR); xb.x = xb_xcc_id(); xb.st = (volatile LAS unsigned*)(LAS char*)(smem + LDS_ST); xcd_barrier(xb); }
  }
  if constexpr (PH + 1 < NPHASE) {
    XcdBarrier xb; xb.bar = (unsigned*)(p.ws + WS_BAR); xb.x = xb_xcc_id(); xb.st = (volatile LAS unsigned*)(LAS char*)(smem + LDS_ST);
    xcd_barrier(xb);
    if constexpr (PROBE_PH >= 0 && (PH == PROBE_PH || PH + 1 == PROBE_PH)) {
      if (blockIdx.x == 0 && threadIdx.x == 0) { volatile LAS unsigned long long* ts = (volatile LAS unsigned long long*)(LAS char*)(smem + LDS_ST + 16); ts[PH == PROBE_PH ? 1 : 0] = __builtin_amdgcn_s_memrealtime(); }
    }
    run_from<PH + 1>(p, smem);
  } else if constexpr (PROBE_PH >= 0) {
    if (blockIdx.x == 0 && threadIdx.x == 0) {
      volatile LAS unsigned long long* ts = (volatile LAS unsigned long long*)(LAS char*)(smem + LDS_ST + 16);
      const unsigned long long now = __builtin_amdgcn_s_memrealtime();
      const unsigned long long t1 = PROBE_PH == NPHASE - 1 ? now : ts[1];
      const unsigned long long span = (t1 - ts[0]) * PROBE_M;
      while (__builtin_amdgcn_s_memrealtime() - now < span) __builtin_amdgcn_s_sleep(8);
    }
  }
}

__global__ void __launch_bounds__(512) mega_kernel(Params p) {
  extern __shared__ __attribute__((aligned(16))) char smem[];
  volatile LAS unsigned* st = (volatile LAS unsigned*)(LAS char*)(smem + LDS_ST);
  if (threadIdx.x == 0) { st[0] = 0u; st[1] = 0u; st[2] = 0u; st[3] = 0u; }
  __syncthreads();
  (void)xcd_barrier_post((unsigned*)(p.ws + WS_BAR), st);
  if (PROBE_PH == 0 && blockIdx.x == 0 && threadIdx.x == 0) { volatile LAS unsigned long long* ts = (volatile LAS unsigned long long*)(LAS char*)(smem + LDS_ST + 16); ts[0] = __builtin_amdgcn_s_memrealtime(); }
  run_from<0>(p, smem);
}

extern "C" void kernel_launch(void* const* d_in, const int* in_sizes, int n_in, void* d_out, int out_size, void* d_ws, size_t ws_size, hipStream_t stream) {
  static int grid = 0;
  if (grid == 0) {
    if (n_in != 40 || ws_size < WS_END) { fprintf(stderr, "kernel_launch: unexpected inputs (n_in %d, ws %zu, need %zu)\n", n_in, ws_size, (size_t)WS_END); grid = -1; return; }
    int dev = 0, cus = 0, per_cu = 0;
    if (hipGetDevice(&dev) != hipSuccess || hipDeviceGetAttribute(&cus, hipDeviceAttributeMultiprocessorCount, dev) != hipSuccess) { grid = -1; return; }
    if (hipFuncSetAttribute((const void*)mega_kernel, hipFuncAttributeMaxDynamicSharedMemorySize, LDS_BYTES) != hipSuccess) { fprintf(stderr, "kernel_launch: hipFuncSetAttribute failed\n"); grid = -1; return; }
    if (hipOccupancyMaxActiveBlocksPerMultiprocessor(&per_cu, (const void*)mega_kernel, 512, LDS_BYTES) != hipSuccess || per_cu < 1) { fprintf(stderr, "kernel_launch: occupancy query failed (%d)\n", per_cu); grid = -1; return; }
    grid = cus;
    fprintf(stderr, "kernel_launch: %d CUs, occupancy %d\n", cus, per_cu);
  }
  if (grid < 0) return;
  Params p{};
  for (int i = 0; i < 40; ++i) p.in[i] = (const float*)d_in[i];
  p.out = (float*)d_out; p.ws = (char*)d_ws;
  if (hipMemsetAsync((char*)d_ws, 0, WS_ZERO_BYTES, stream) != hipSuccess) return;
  void* args[] = {&p};
  hipError_t e = hipLaunchCooperativeKernel((const void*)mega_kernel, dim3(grid), dim3(512), args, LDS_BYTES, stream);
  if (e != hipSuccess) fprintf(stderr, "cooperative launch failed: %s (grid %d)\n", hipGetErrorString(e), grid);
}
```

```cpp
#include <hip/hip_runtime.h>
#include <cstdio>
#include <cstdint>

#define DEV __device__ __forceinline__
typedef unsigned short bf16_t;
typedef short bf16x8 __attribute__((ext_vector_type(8)));
typedef short s16x4 __attribute__((ext_vector_type(4)));
typedef float f32x4 __attribute__((ext_vector_type(4)));
typedef unsigned u32x4 __attribute__((ext_vector_type(4)));
typedef unsigned u32x2 __attribute__((ext_vector_type(2)));
#define LAS __attribute__((address_space(3)))

constexpr int D = 1024, NL = 16384, NC = 256, T = NL + NC, NTILE = T / 128;
constexpr int DR = 1280, NEXP = 32, DE = 512;
constexpr int RGT = 64, NRT = T / RGT, NRT_LAT = NL / RGT;
constexpr int MLW = 3104, MLWP = 3328;
constexpr int MOE_ROWS = 41472;
constexpr float EPS = 1e-6f;

constexpr size_t al256(size_t x) { return (x + 255) & ~(size_t)255; }
constexpr size_t WS_BAR   = 0;
constexpr size_t WS_CNT   = 16384;
constexpr int CNT_STRIDE = 64;
constexpr size_t WS_ZERO_BYTES = 16384 + 2 * 32 * CNT_STRIDE * 4;
constexpr size_t WS_MODS  = 32768;
constexpr size_t WS_LIST  = WS_MODS + al256(2 * 2 * 6144 * 4);
constexpr size_t WS_AW    = WS_LIST + al256((size_t)2 * 32 * T * 4);
constexpr size_t WS_POS   = WS_AW + al256((size_t)2 * T * 4);
constexpr size_t WS_AWP   = WS_POS + al256((size_t)2 * T * 4);
constexpr size_t WS_ROWMAP = WS_AWP + al256((size_t)MOE_ROWS * 4);
constexpr size_t WS_AGG   = WS_ROWMAP + al256((size_t)MOE_ROWS * 4);
constexpr size_t WS_CARRY = WS_AGG + al256((size_t)2 * NRT * DR * 2 * 4);
constexpr size_t WS_GL    = WS_CARRY + al256((size_t)2 * NRT * DR * 4);
constexpr size_t WS_NVEC  = WS_GL + al256((size_t)T * 32 * 4);
constexpr size_t WS_DEC   = WS_NVEC + al256((size_t)NTILE * 16 * 64 * 4);
constexpr size_t WS_WIN   = WS_DEC + al256((size_t)NTILE * 16 * 4);
constexpr size_t WS_WOUT  = WS_WIN + al256((size_t)2560 * 1024 * 2);
constexpr size_t WS_WML   = WS_WOUT + al256((size_t)1024 * 1280 * 2);
constexpr size_t WS_WMO   = WS_WML + al256((size_t)MLWP * 1024 * 2);
constexpr size_t WS_WGU   = WS_WMO + al256((size_t)1024 * 1024 * 2);
constexpr size_t WS_WD    = WS_WGU + al256((size_t)32 * 1024 * 1024 * 2);
constexpr size_t WS_WAXT  = WS_WD + al256((size_t)32 * 1024 * 512 * 2);
constexpr size_t WS_WR    = WS_WAXT + al256((size_t)40 * 16384 * 2);
constexpr size_t WS_HA    = WS_WR + al256((size_t)2 * 64 * 64 * 12 * 4);
constexpr size_t WS_X1    = WS_HA + al256((size_t)T * D * 2);
constexpr size_t WS_X2    = WS_X1 + al256((size_t)T * D * 2);
constexpr size_t WS_R0    = WS_X2 + al256((size_t)T * D * 2);
constexpr size_t WS_GG    = WS_R0;
constexpr size_t WS_PR    = WS_GG + al256((size_t)T * DR * 2);
constexpr size_t WS_S     = WS_PR + al256((size_t)T * DR * 2);
constexpr size_t WS_PF    = WS_S + al256((size_t)T * DR * 2);
constexpr size_t WS_PB    = WS_PF + al256((size_t)T * DR * 2);
constexpr size_t WS_R0END = WS_PB + al256((size_t)T * DR * 2);
constexpr size_t WS_ABUF  = WS_R0;
constexpr size_t WS_HM    = WS_ABUF + al256((size_t)MOE_ROWS * D * 2);
constexpr size_t WS_Y     = WS_HM + al256((size_t)MOE_ROWS * DE * 2);
constexpr size_t WS_MOEEND = WS_Y + al256((size_t)MOE_ROWS * D * 2);
constexpr size_t WS_Q     = WS_R0;
constexpr size_t WS_K     = WS_Q + al256((size_t)T * 512 * 2);
constexpr size_t WS_KT    = WS_K + al256((size_t)T * 512 * 2);
constexpr size_t WS_VT    = WS_KT + al256((size_t)T * 512 * 2);
constexpr size_t WS_OG    = WS_VT + al256((size_t)T * D * 2);
constexpr size_t WS_UT    = WS_OG + al256((size_t)T * D * 2);
constexpr size_t WS_L1END = WS_UT + al256((size_t)NTILE * 16 * 8192 * 4);
constexpr size_t cmax(size_t a, size_t b) { return a > b ? a : b; }
constexpr size_t WS_END   = cmax(cmax(WS_R0END, WS_L1END), WS_MOEEND);

struct Params {
  const float* in[40];
  float* out;
  char* ws;
};

typedef __bf16 bf16v2_t __attribute__((ext_vector_type(2)));
typedef float f32x2_t __attribute__((ext_vector_type(2)));
DEV unsigned pk2(float lo, float hi) { const f32x2_t v = {lo, hi}; return __builtin_bit_cast(unsigned, __builtin_convertvector(v, bf16v2_t)); }
DEV float bflo(unsigned u) { return __uint_as_float(u << 16); }
DEV float bfhi(unsigned u) { return __uint_as_float(u & 0xffff0000u); }
DEV float bf2f(bf16_t b) { return __uint_as_float((unsigned)b << 16); }
DEV bf16_t f2bf(float f) { return (bf16_t)(pk2(f, 0.f) & 0xffffu); }
DEV float fexp_(float x) { return __builtin_amdgcn_exp2f(x * 1.4426950408889634f); }
DEV float sigmoidf_(float x) { return __builtin_amdgcn_rcpf(1.f + __builtin_amdgcn_exp2f(x * -1.4426950408889634f)); }
DEV float siluf_(float x) { return x * sigmoidf_(x); }
DEV float gelu_tanh(float x) { const float u = 0.7978845608028654f * (x + 0.044715f * x * x * x); return x * sigmoidf_(2.f * u); }
DEV float wave_sum(float v) {
#pragma unroll
  for (int o = 1; o < 64; o <<= 1) v += __shfl_xor(v, o);
  return v;
}
DEV s16x4 ldtr(const char* p) { return __builtin_bit_cast(s16x4, __builtin_amdgcn_ds_read_tr16_b64_v4i16((LAS s16x4*)p)); }
DEV f32x4 ld_bf4(const bf16_t* p) { const u32x2 v = *(const u32x2*)p; return (f32x4){bflo(v.x), bfhi(v.x), bflo(v.y), bfhi(v.y)}; }
DEV void st_bf4(bf16_t* p, const f32x4 v) { u32x2 o; o.x = pk2(v.x, v.y); o.y = pk2(v.z, v.w); *(u32x2*)p = o; }
DEV int tidx() { int t = threadIdx.x & 255; asm volatile("" : "+v"(t)); return t; }
DEV int tidf() { int t = threadIdx.x; asm volatile("" : "+v"(t)); return t; }
DEV int seqrow_of_token(int t) { return (t & 63) * 256 + (t >> 6); }
DEV int token_of_seqrow(int s) { return (s & 255) * 64 + (s >> 8); }

constexpr int BS_STRIDE = 320;
DEV int bs_off(int k, int n) { return k * BS_STRIDE + ((((n >> 4) ^ ((k >> 3) & 1))) << 5) + (n & 15) * 2; }

namespace pg8 {
#define PG8_LAS __attribute__((address_space(3)))
typedef unsigned short bf16_t;
typedef short bf16x8 __attribute__((ext_vector_type(8)));
typedef float f32x4 __attribute__((ext_vector_type(4)));
typedef unsigned u32x4 __attribute__((ext_vector_type(4)));
constexpr int BM = 256, BK = 64, HALF = 128, HTB = HALF * BK * 2  , STAGE_BYTES = 8 * HTB, NXCD = 8, WGM = 8;

__host__ __device__ __forceinline__ int lds_byte(int r, int c) { const int st = (r >> 4) * 2 + (c >> 5), rr = r & 15, cc = c & 31, ob = rr * 64 + cc * 2; return st * 1024 + (ob ^ (((ob >> 9) & 1) << 5)); }
__host__ __device__ __forceinline__ void stage_rc(int b, int& R, int& C) { const int st = b / 1024, sb = b % 1024, swz = sb ^ (((sb >> 9) & 1) << 5); R = (st >> 1) * 16 + swz / 64; C = (st & 1) * 32 + (swz % 64) / 2; }
__host__ __device__ __forceinline__ int perm32(int rho) { const int n = rho >> 4, i = rho & 15; return 8 * (i >> 2) + 4 * n + (i & 3); }

struct Unit { int pm, pn; };
struct Gemm { const bf16_t* A; const bf16_t* Bt; int M, N, K; };

struct StaticOrder {
    int nM, nN, nwg, G, c;
    __host__ __device__ void init(int M, int N, int G_, int c_) { nM = M / BM; nN = N / BM; nwg = nM * nN; G = G_; c = c_; }
    __host__ __device__ bool next(int i, Unit& u) const {
        const long L = (long)i * G + c; if (L >= nwg) return false;
        int wgid = (int)L; { const int q = nwg / NXCD, r = nwg % NXCD, xcd = wgid % NXCD, off = wgid / NXCD; wgid = (xcd < r ? xcd * (q + 1) : r * (q + 1) + (xcd - r) * q) + off; }
        const int nig = WGM * nN, gid = wgid / nig, fm = gid * WGM, gsz = (nM - fm) < WGM ? (nM - fm) : WGM;
        u.pm = fm + ((wgid % nig) % gsz); u.pn = (wgid % nig) / gsz; return true;
    }
    __device__ __forceinline__ void a_ready(const Unit&) const {}
    __device__ __forceinline__ void done(const Unit&) const {}
};
template <class Epi, class Sched, bool STAMP = false>
__device__ __forceinline__ void gemm_phase(PG8_LAS unsigned char* lds, const Gemm g, const Sched& S, const Epi& E, unsigned long long* stamps) {
    int tid = threadIdx.x; asm volatile("" : "+v"(tid));
    const int wid = __builtin_amdgcn_readfirstlane(tid >> 6), lane = tid & 63, wr = wid >> 2, wc = wid & 3, fr = lane & 15, fq = lane >> 4;
    const int K = g.K, nt = K / BK;
    int ts_lo = 0, ts_hi = 0, nts = 0; const unsigned long long rt_entry = STAMP ? (unsigned long long)wall_clock64() : 0ull;
#define PG8_STAMP() do { if (STAMP && wid == 0 && nts < 64) { const unsigned long long _c = (unsigned long long)clock64(); \
        ts_lo = (lane == nts) ? (int)(unsigned)_c : ts_lo; ts_hi = (lane == nts) ? (int)(unsigned)(_c >> 32) : ts_hi; ++nts; } } while (0)
    PG8_STAMP();
    unsigned voffA[2], voffB[2];
#pragma unroll
    for (int i = 0; i < 2; ++i) { int R, C; stage_rc(tid * 16 + i * 8192, R, C); const int Rb = Epi::PERM ? ((R & ~31) + perm32(R & 31)) : R;
        voffA[i] = (unsigned)(R * K + C) * 2u; voffB[i] = (unsigned)(Rb * K + C) * 2u; }
    const size_t kstep = (size_t)(BK * 2);
    const size_t hstep = (size_t)HALF * K * 2;
    const size_t tstep = 2 * hstep;
    const unsigned ldsw = (unsigned)wid * 1024u;
    const int aoff = lds_byte(wr * 64 + fr, fq * 8), boff = lds_byte(wc * 32 + fr, fq * 8);
#define PG8_SA(b, h) (((b) * 2 + (h)) * HTB)
#define PG8_SB(b, h) ((4 + (b) * 2 + (h)) * HTB)
#define PG8_STAGE(bufoff, gbase, voff) do { _Pragma("unroll") for (int _i = 0; _i < 2; ++_i) \
        __builtin_amdgcn_global_load_lds((const unsigned*)((const char*)(gbase) + (voff)[_i]), (PG8_LAS unsigned*)(lds + (bufoff) + ldsw + _i * 8192), 16, 0, 0); } while (0)
#define PG8_LDA(dst, b, h) do { _Pragma("unroll") for (int m = 0; m < 4; ++m) _Pragma("unroll") for (int k = 0; k < 2; ++k) dst[m][k] = *(const PG8_LAS bf16x8*)(lds + PG8_SA(b, h) + aoff + m * 2048 + k * 1024); } while (0)
#define PG8_LDB(dst, b, h) do { _Pragma("unroll") for (int n = 0; n < 2; ++n) _Pragma("unroll") for (int k = 0; k < 2; ++k) dst[n][k] = *(const PG8_LAS bf16x8*)(lds + PG8_SB(b, h) + boff + n * 2048 + k * 1024); } while (0)
#define PG8_MMA(ai, bj, At, Bt) do { __builtin_amdgcn_s_setprio(1); _Pragma("unroll") for (int m = 0; m < 4; ++m) _Pragma("unroll") for (int n = 0; n < 2; ++n) _Pragma("unroll") for (int k = 0; k < 2; ++k) \
        acc[ai][bj][m][n] = __builtin_amdgcn_mfma_f32_16x16x32_bf16(Bt[n][k], At[m][k], acc[ai][bj][m][n], 0, 0, 0); __builtin_amdgcn_s_setprio(0); } while (0)
#define PG8_WAIT_V(n) asm volatile("s_waitcnt vmcnt(" #n ")" ::: "memory")
#define PG8_WAIT_L(n) asm volatile("s_waitcnt lgkmcnt(" #n ")" ::: "memory")
#define PG8_BAR __builtin_amdgcn_s_barrier()
#define PG8_SCHED __builtin_amdgcn_sched_barrier(0)
    Unit cur, nxt; int ui = 0;
    if (!S.next(0, cur)) return;
    f32x4 acc[2][2][4][2];
#pragma unroll
    for (int a = 0; a < 2; ++a)
#pragma unroll
        for (int b = 0; b < 2; ++b)
#pragma unroll
            for (int m = 0; m < 4; ++m)
#pragma unroll
                for (int n = 0; n < 2; ++n) acc[a][b][m][n] = (f32x4){0.f, 0.f, 0.f, 0.f};
    bf16x8 At[4][2], B0[2][2], B1[2][2];
    const char* cA = (const char*)g.A + (size_t)cur.pm * tstep; const char* cB = (const char*)g.Bt + (size_t)cur.pn * tstep;
    S.a_ready(cur);
    PG8_STAGE(PG8_SB(0, 0), cB, voffB); PG8_STAGE(PG8_SA(0, 0), cA, voffA); PG8_STAGE(PG8_SB(0, 1), cB + hstep, voffB); PG8_STAGE(PG8_SA(0, 1), cA + hstep, voffA);
    if (wr == 1) PG8_BAR;
    PG8_WAIT_V(4); PG8_BAR;
    PG8_STAGE(PG8_SB(1, 0), cB + kstep, voffB); PG8_STAGE(PG8_SA(1, 0), cA + kstep, voffA); PG8_STAGE(PG8_SB(1, 1), cB + hstep + kstep, voffB);
    PG8_WAIT_V(6); PG8_BAR;
    PG8_STAMP();
    for (;;) {
        const bool has_next = S.next(ui + 1, nxt);
        const char* nA = has_next ? (const char*)g.A + (size_t)nxt.pm * tstep : cA; const char* nB = has_next ? (const char*)g.Bt + (size_t)nxt.pn * tstep : cB;
        for (int t = 0; t < nt; t += 2) {
            const bool last = (t == nt - 2);
            const char* a1 = cA + (size_t)(t + 1) * kstep;
            const char* a2 = last ? nA : cA + (size_t)(t + 2) * kstep; const char* b2 = last ? nB : cB + (size_t)(t + 2) * kstep;
            const char* a3 = a2 + kstep; const char* b3 = b2 + kstep;
            if (last && has_next) S.a_ready(nxt);
            PG8_LDB(B0, 0, 0); PG8_SCHED; PG8_LDA(At, 0, 0); PG8_STAGE(PG8_SA(1, 1), a1 + hstep, voffA);
            PG8_WAIT_L(8); PG8_BAR; PG8_WAIT_L(0); PG8_MMA(0, 0, At, B0); PG8_BAR; PG8_SCHED;
            PG8_LDB(B1, 0, 1); PG8_STAGE(PG8_SB(0, 0), b2, voffB);
            PG8_BAR; PG8_WAIT_L(0); PG8_MMA(0, 1, At, B1); PG8_BAR;
            PG8_LDA(At, 0, 1); PG8_STAGE(PG8_SA(0, 0), a2, voffA);
            PG8_BAR; PG8_WAIT_L(0); PG8_MMA(1, 0, At, B0); PG8_BAR; PG8_SCHED;
            PG8_STAGE(PG8_SB(0, 1), b2 + hstep, voffB);
            PG8_WAIT_V(6); PG8_BAR; PG8_MMA(1, 1, At, B1); PG8_BAR;
            PG8_LDB(B0, 1, 0); PG8_SCHED; PG8_LDA(At, 1, 0); PG8_STAGE(PG8_SA(0, 1), a2 + hstep, voffA);
            PG8_WAIT_L(8); PG8_BAR; PG8_WAIT_L(0); PG8_MMA(0, 0, At, B0); PG8_BAR; PG8_SCHED;
            PG8_LDB(B1, 1, 1); PG8_STAGE(PG8_SB(1, 0), b3, voffB);
            PG8_BAR; PG8_WAIT_L(0); PG8_MMA(0, 1, At, B1); PG8_BAR;
            PG8_LDA(At, 1, 1); PG8_STAGE(PG8_SA(1, 0), a3, voffA);
            PG8_BAR; PG8_WAIT_L(0); PG8_MMA(1, 0, At, B0); PG8_BAR; PG8_SCHED;
            PG8_STAGE(PG8_SB(1, 1), b3 + hstep, voffB);
            PG8_WAIT_V(6); PG8_BAR; PG8_MMA(1, 1, At, B1); PG8_BAR;
        }
        PG8_STAMP();
        if constexpr (!Epi::AFTER_DRAIN) { E(acc, cur, wr, wc, fr, fq); S.done(cur); }
        PG8_STAMP();
        if (!has_next) break;
#pragma unroll
        for (int a = 0; a < 2; ++a)
#pragma unroll
            for (int b = 0; b < 2; ++b)
#pragma unroll
                for (int m = 0; m < 4; ++m)
#pragma unroll
                    for (int n = 0; n < 2; ++n) acc[a][b][m][n] = (f32x4){0.f, 0.f, 0.f, 0.f};
        cur = nxt; cA = nA; cB = nB; ++ui;
    }
    PG8_WAIT_V(0);
    if (wr == 0) PG8_BAR;
    PG8_BAR;
    if constexpr (Epi::AFTER_DRAIN) { E.fused(acc, cur, wr, wc, fr, fq, lds, wid, lane); S.done(cur); }
    PG8_STAMP();
    if (STAMP && wid == 0) { stamps[lane] = lane < nts ? (((unsigned long long)(unsigned)ts_hi << 32) | (unsigned)ts_lo) : 0ull;
        if (lane == 62) stamps[62] = rt_entry; if (lane == 63) stamps[63] = (unsigned long long)wall_clock64(); }
#undef PG8_STAMP
#undef PG8_SA
#undef PG8_SB
#undef PG8_STAGE
#undef PG8_LDA
#undef PG8_LDB
#undef PG8_MMA
#undef PG8_WAIT_V
#undef PG8_WAIT_L
#undef PG8_BAR
#undef PG8_SCHED
}
template <class Epi, class Sched, bool STAMP = false>
__device__ __forceinline__ void gemm_phase_gather(PG8_LAS unsigned char* lds, const Gemm g, const Sched& S, const Epi& E, unsigned long long* stamps) {
    int tid = threadIdx.x; asm volatile("" : "+v"(tid));
    const int wid = __builtin_amdgcn_readfirstlane(tid >> 6), lane = tid & 63, wr = wid >> 2, wc = wid & 3, fr = lane & 15, fq = lane >> 4;
    const int K = g.K, nt = K / BK;
    int ts_lo = 0, ts_hi = 0, nts = 0; const unsigned long long rt_entry = STAMP ? (unsigned long long)wall_clock64() : 0ull;
#define PG8_STAMP() do { if (STAMP && wid == 0 && nts < 64) { const unsigned long long _c = (unsigned long long)clock64(); \
        ts_lo = (lane == nts) ? (int)(unsigned)_c : ts_lo; ts_hi = (lane == nts) ? (int)(unsigned)(_c >> 32) : ts_hi; ++nts; } } while (0)
    PG8_STAMP();
    unsigned voffA[2], voffB[2];
#pragma unroll
    for (int i = 0; i < 2; ++i) { int R, C; stage_rc(tid * 16 + i * 8192, R, C); const int Rb = Epi::PERM ? ((R & ~31) + perm32(R & 31)) : R;
        voffA[i] = (unsigned)(R * K + C) * 2u; voffB[i] = (unsigned)(Rb * K + C) * 2u; }
    const size_t kstep = (size_t)(BK * 2);
    const size_t hstep = (size_t)HALF * K * 2;
    const size_t tstep = 2 * hstep;
    const unsigned ldsw = (unsigned)wid * 1024u;
    const int aoff = lds_byte(wr * 64 + fr, fq * 8), boff = lds_byte(wc * 32 + fr, fq * 8);
#define PG8_SA(b, h) (((b) * 2 + (h)) * HTB)
#define PG8_SB(b, h) ((4 + (b) * 2 + (h)) * HTB)
#define PG8_STAGE(bufoff, gbase, voff) do { _Pragma("unroll") for (int _i = 0; _i < 2; ++_i) \
        __builtin_amdgcn_global_load_lds((const unsigned*)((const char*)(gbase) + (voff)[_i]), (PG8_LAS unsigned*)(lds + (bufoff) + ldsw + _i * 8192), 16, 0, 0); } while (0)
#define PG8_LDA(dst, b, h) do { _Pragma("unroll") for (int m = 0; m < 4; ++m) _Pragma("unroll") for (int k = 0; k < 2; ++k) dst[m][k] = *(const PG8_LAS bf16x8*)(lds + PG8_SA(b, h) + aoff + m * 2048 + k * 1024); } while (0)
#define PG8_LDB(dst, b, h) do { _Pragma("unroll") for (int n = 0; n < 2; ++n) _Pragma("unroll") for (int k = 0; k < 2; ++k) dst[n][k] = *(const PG8_LAS bf16x8*)(lds + PG8_SB(b, h) + boff + n * 2048 + k * 1024); } while (0)
#define PG8_MMA(ai, bj, At, Bt) do { __builtin_amdgcn_s_setprio(1); _Pragma("unroll") for (int m = 0; m < 4; ++m) _Pragma("unroll") for (int n = 0; n < 2; ++n) _Pragma("unroll") for (int k = 0; k < 2; ++k) \
        acc[ai][bj][m][n] = __builtin_amdgcn_mfma_f32_16x16x32_bf16(Bt[n][k], At[m][k], acc[ai][bj][m][n], 0, 0, 0); __builtin_amdgcn_s_setprio(0); } while (0)
#define PG8_WAIT_V(n) asm volatile("s_waitcnt vmcnt(" #n ")" ::: "memory")
#define PG8_WAIT_L(n) asm volatile("s_waitcnt lgkmcnt(" #n ")" ::: "memory")
#define PG8_BAR __builtin_amdgcn_s_barrier()
#define PG8_SCHED __builtin_amdgcn_sched_barrier(0)
    Unit cur, nxt; int ui = 0;
    if (!S.next(0, cur)) return;
    f32x4 acc[2][2][4][2];
#pragma unroll
    for (int a = 0; a < 2; ++a)
#pragma unroll
        for (int b = 0; b < 2; ++b)
#pragma unroll
            for (int m = 0; m < 4; ++m)
#pragma unroll
                for (int n = 0; n < 2; ++n) acc[a][b][m][n] = (f32x4){0.f, 0.f, 0.f, 0.f};
    bf16x8 At[4][2], B0[2][2], B1[2][2];
    const char* const cA = (const char*)g.A; const char* cB = (const char*)g.Bt + (size_t)cur.pn * tstep;
    unsigned co[2][2], no[2][2];
#pragma unroll
    for (int h = 0; h < 2; ++h)
#pragma unroll
        for (int i = 0; i < 2; ++i) { int R, C; stage_rc(tid * 16 + i * 8192, R, C); co[h][i] = (unsigned)S.src_row(cur, h * HALF + R) * (unsigned)(K * 2) + (unsigned)C * 2u; no[h][i] = co[h][i]; }
    S.a_ready(cur);
    PG8_STAGE(PG8_SB(0, 0), cB, voffB); PG8_STAGE(PG8_SA(0, 0), cA, co[0]); PG8_STAGE(PG8_SB(0, 1), cB + hstep, voffB); PG8_STAGE(PG8_SA(0, 1), cA, co[1]);
    if (wr == 1) PG8_BAR;
    PG8_WAIT_V(4); PG8_BAR;
    PG8_STAGE(PG8_SB(1, 0), cB + kstep, voffB); PG8_STAGE(PG8_SA(1, 0), cA + kstep, co[0]); PG8_STAGE(PG8_SB(1, 1), cB + hstep + kstep, voffB);
    PG8_WAIT_V(6); PG8_BAR;
    PG8_STAMP();
    for (;;) {
        const bool has_next = S.next(ui + 1, nxt);
        const char* nB = has_next ? (const char*)g.Bt + (size_t)nxt.pn * tstep : cB;
        if (has_next) {
#pragma unroll
            for (int h = 0; h < 2; ++h)
#pragma unroll
                for (int i = 0; i < 2; ++i) { int R, C; stage_rc(tid * 16 + i * 8192, R, C); no[h][i] = (unsigned)S.src_row(nxt, h * HALF + R) * (unsigned)(K * 2) + (unsigned)C * 2u; }
        }
        for (int t = 0; t < nt; t += 2) {
            const bool last = (t == nt - 2);
            const char* a1 = cA + (size_t)(t + 1) * kstep;
            const char* a2 = cA + (size_t)(last ? 0 : t + 2) * kstep; const char* b2 = last ? nB : cB + (size_t)(t + 2) * kstep;

            const char* a3 = a2 + kstep; const char* b3 = b2 + kstep;
            if (last && has_next) S.a_ready(nxt);
            PG8_LDB(B0, 0, 0); PG8_SCHED; PG8_LDA(At, 0, 0); PG8_STAGE(PG8_SA(1, 1), a1, co[1]);
            if (last) { co[0][0] = no[0][0]; co[0][1] = no[0][1]; co[1][0] = no[1][0]; co[1][1] = no[1][1]; }
            PG8_WAIT_L(8); PG8_BAR; PG8_WAIT_L(0); PG8_MMA(0, 0, At, B0); PG8_BAR; PG8_SCHED;
            PG8_LDB(B1, 0, 1); PG8_STAGE(PG8_SB(0, 0), b2, voffB);
            PG8_BAR; PG8_WAIT_L(0); PG8_MMA(0, 1, At, B1); PG8_BAR;
            PG8_LDA(At, 0, 1); PG8_STAGE(PG8_SA(0, 0), a2, co[0]);
            PG8_BAR; PG8_WAIT_L(0); PG8_MMA(1, 0, At, B0); PG8_BAR; PG8_SCHED;
            PG8_STAGE(PG8_SB(0, 1), b2 + hstep, voffB);
            PG8_WAIT_V(6); PG8_BAR; PG8_MMA(1, 1, At, B1); PG8_BAR;
            PG8_LDB(B0, 1, 0); PG8_SCHED; PG8_LDA(At, 1, 0); PG8_STAGE(PG8_SA(0, 1), a2, co[1]);
            PG8_WAIT_L(8); PG8_BAR; PG8_WAIT_L(0); PG8_MMA(0, 0, At, B0); PG8_BAR; PG8_SCHED;
            PG8_LDB(B1, 1, 1); PG8_STAGE(PG8_SB(1, 0), b3, voffB);
            PG8_BAR; PG8_WAIT_L(0); PG8_MMA(0, 1, At, B1); PG8_BAR;
            PG8_LDA(At, 1, 1); PG8_STAGE(PG8_SA(1, 0), a3, co[0]);
            PG8_BAR; PG8_WAIT_L(0); PG8_MMA(1, 0, At, B0); PG8_BAR; PG8_SCHED;
            PG8_STAGE(PG8_SB(1, 1), b3 + hstep, voffB);
            PG8_WAIT_V(6); PG8_BAR; PG8_MMA(1, 1, At, B1); PG8_BAR;
        }
        PG8_STAMP();
        if constexpr (!Epi::AFTER_DRAIN) { E(acc, cur, wr, wc, fr, fq); S.done(cur); }
        PG8_STAMP();
        if (!has_next) break;
#pragma unroll
        for (int a = 0; a < 2; ++a)
#pragma unroll
            for (int b = 0; b < 2; ++b)
#pragma unroll
                for (int m = 0; m < 4; ++m)
#pragma unroll
                    for (int n = 0; n < 2; ++n) acc[a][b][m][n] = (f32x4){0.f, 0.f, 0.f, 0.f};
        cur = nxt; cB = nB; ++ui;
    }
    PG8_WAIT_V(0);
    if (wr == 0) PG8_BAR;
    PG8_BAR;
    if constexpr (Epi::AFTER_DRAIN) { E.fused(acc, cur, wr, wc, fr, fq, lds, wid, lane); S.done(cur); }
    PG8_STAMP();
    if (STAMP && wid == 0) { stamps[lane] = lane < nts ? (((unsigned long long)(unsigned)ts_hi << 32) | (unsigned)ts_lo) : 0ull;
        if (lane == 62) stamps[62] = rt_entry; if (lane == 63) stamps[63] = (unsigned long long)wall_clock64(); }
#undef PG8_STAMP
#undef PG8_SA
#undef PG8_SB
#undef PG8_STAGE
#undef PG8_LDA
#undef PG8_LDB
#undef PG8_MMA
#undef PG8_WAIT_V
#undef PG8_WAIT_L
#undef PG8_BAR
#undef PG8_SCHED
}
}

DEV void ph_adaln(const Params& p, char* smem, int bid, int nb) {
  float* sc = (float*)smem; float* sx = sc + 1024; f32x4* red = (f32x4*)(sx + 1024);
  const int tid = tidx();
  for (int i = tid; i < 1024; i += 256) { sc[i] = siluf_(p.in[1][i]); sx[i] = siluf_(p.in[3][i]); }
  __syncthreads();
  float* mods = (float*)(p.ws + WS_MODS);
  const int cl = tid & 7, kg = tid >> 3;
  constexpr int NU = 2 * 192;
  for (int it = 0, iters = (NU + nb - 1) / nb; it < iters; ++it) {
    const int u = bid + it * nb; const bool active = u < NU;
    const int l = u / 192, c0 = (u % 192) * 32;
    const float* W = p.in[l ? 24 : 4]; const float* B = p.in[l ? 25 : 5];
    if (active) {
      f32x4 ac = {0.f, 0.f, 0.f, 0.f}, ax = {0.f, 0.f, 0.f, 0.f};
      const float* wp = W + (size_t)(kg * 32) * 6144 + c0 + 4 * cl;
#pragma unroll 16
      for (int kk = 0; kk < 32; ++kk) {
        const f32x4 w = *(const f32x4*)(wp + (size_t)kk * 6144);
        const float a = sc[kg * 32 + kk], b = sx[kg * 32 + kk];
        ac += a * w; ax += b * w;
      }
      red[kg * 8 + cl] = ac; red[256 + kg * 8 + cl] = ax;
    }
    __syncthreads();
    if (active && tid < 16) {
      const int which = tid >> 3, c = tid & 7;
      f32x4 sm = {0.f, 0.f, 0.f, 0.f};
      for (int g = 0; g < 32; ++g) sm += red[which * 256 + g * 8 + c];
      const f32x4 bb = *(const f32x4*)(B + c0 + 4 * c);
      *(f32x4*)(mods + (size_t)(l * 2 + which) * 6144 + c0 + 4 * c) = sm + bb;
    }
    __syncthreads();
  }
}

DEV void transpose_item(const float* W, int N, int K, bf16_t* WT, float* scr, int k0, int n0, int lane) {
  float wreg[32];
#pragma unroll
  for (int i = 0; i < 32; ++i) { const int kk = 2 * i + (lane >> 5); wreg[i] = W[(size_t)(k0 + kk) * N + n0 + (lane & 31)]; }
#pragma unroll
  for (int i = 0; i < 32; ++i) { const int kk = 2 * i + (lane >> 5); scr[kk * 33 + (lane & 31)] = wreg[i]; }
  asm volatile("s_waitcnt lgkmcnt(0)" ::: "memory");
  const int c = lane & 7;
#pragma unroll
  for (int j = 0; j < 4; ++j) { const int n = (lane >> 3) + 8 * j; const float* s = scr + (8 * c) * 33 + n;
    u32x4 o; o.x = pk2(s[0 * 33], s[1 * 33]); o.y = pk2(s[2 * 33], s[3 * 33]); o.z = pk2(s[4 * 33], s[5 * 33]); o.w = pk2(s[6 * 33], s[7 * 33]);
    *(u32x4*)(WT + (size_t)n * K + k0 + 8 * c) = o; }
  asm volatile("s_waitcnt lgkmcnt(0)" ::: "memory");
}
constexpr int CI_WIN = 16 * 80, CI_WOUT = 20 * 32, CI_WML = 16 * 97, CI_WMO = 16 * 32, CI_WAX = 40 * 8, CI_DENSE = CI_WIN + CI_WOUT + CI_WML + CI_WMO + CI_WAX;
constexpr int CI_MOE = 32 * 768;
DEV void ph_convert_dense(const Params& p, char* smem) {
  const int tf = tidf(), lane = tf & 63, wv = tf >> 6;
  float* scr = (float*)(smem + wv * 8448);
  const int gw = blockIdx.x * 8 + wv, ngw = gridDim.x * 8;
  for (int it = gw; it < CI_DENSE; it += ngw) {
    int r = it;
    if (r < CI_WIN) { const int kb = r / 80, nb_ = r % 80; transpose_item(p.in[8], 2560, 1024, (bf16_t*)(p.ws + WS_WIN) + (size_t)(nb_ * 32) * 1024, scr, kb * 64, nb_ * 32, lane); continue; } r -= CI_WIN;
    if (r < CI_WOUT) { const int kb = r / 32, nb_ = r % 32; transpose_item(p.in[16], 1024, 1280, (bf16_t*)(p.ws + WS_WOUT) + (size_t)(nb_ * 32) * 1280, scr, kb * 64, nb_ * 32, lane); continue; } r -= CI_WOUT;
    if (r < CI_WML) { const int kb = r / 97, nb_ = r % 97; transpose_item(p.in[28], MLW, 1024, (bf16_t*)(p.ws + WS_WML) + (size_t)(nb_ * 32) * 1024, scr, kb * 64, nb_ * 32, lane); continue; } r -= CI_WML;
    if (r < CI_WMO) { const int kb = r / 32, nb_ = r % 32; transpose_item(p.in[31], 1024, 1024, (bf16_t*)(p.ws + WS_WMO) + (size_t)(nb_ * 32) * 1024, scr, kb * 64, nb_ * 32, lane); continue; } r -= CI_WMO;
    { const int mi = r >> 3, rr = r & 7, kb = rr >> 2, nb_ = rr & 3, dh = mi >> 1, which = mi & 1;
      transpose_item((which ? p.in[13] : p.in[11]) + (size_t)dh * 16384, 128, 128, (bf16_t*)(p.ws + WS_WAXT) + (size_t)mi * 16384 + (size_t)(nb_ * 32) * 128, scr, kb * 64, nb_ * 32, lane); }
  }
  { bf16_t* Wr = (bf16_t*)(p.ws + WS_WR);
    for (int i = blockIdx.x * 512 + tf; i < 2 * 48 * 1024; i += gridDim.x * 512) {
      const int l = i / (48 * 1024), r = i % (48 * 1024), n = r >> 10, k = r & 1023;
      const float* We = p.in[l ? 34 : 19]; const float* Wg = p.in[l ? 32 : 17];
      const float w = n < 32 ? We[k * 32 + n] : (n < 36 ? Wg[k * 4 + n - 32] : 0.f);
      const bf16_t hi = f2bf(w); const bf16_t lo = f2bf(w - bf2f(hi));
      Wr[(size_t)(l * 2) * 48 * 1024 + r] = hi; Wr[(size_t)(l * 2 + 1) * 48 * 1024 + r] = lo;
    } }
  { u32x4* z = (u32x4*)((bf16_t*)(p.ws + WS_WML) + (size_t)MLW * 1024); const int n16 = (MLWP - MLW) * 1024 * 2 / 16;
    for (int i = blockIdx.x * 512 + tf; i < n16; i += gridDim.x * 512) z[i] = (u32x4){0u, 0u, 0u, 0u}; }
}
template <int LAYER>
DEV void ph_convert_moe(const Params& p, char* smem) {
  const int tf = tidf(), lane = tf & 63, wv = tf >> 6;
  float* scr = (float*)(smem + wv * 8448);
  const int gw = blockIdx.x * 8 + wv, ngw = gridDim.x * 8;
  const float* Wg = p.in[LAYER == 0 ? 21 : 36]; const float* Wu = p.in[LAYER == 0 ? 22 : 37]; const float* Wd = p.in[LAYER == 0 ? 23 : 38];
  bf16_t* WGU = (bf16_t*)(p.ws + WS_WGU); bf16_t* WD = (bf16_t*)(p.ws + WS_WD);
  for (int it = gw; it < CI_MOE; it += ngw) {
    const int e = it / 768, r = it % 768;
    if (r < 512) {
      const int up = r >> 8, rr = r & 255, kb = rr >> 4, nb_ = rr & 15, n0 = nb_ * 32;
      bf16_t* dst = WGU + ((size_t)e * 1024 + (n0 >> 7) * 256 + up * 128 + (n0 & 127)) * 1024;
      transpose_item((up ? Wu : Wg) + (size_t)e * 1024 * 512, 512, 1024, dst, scr, kb * 64, n0, lane);
    } else {
      const int rr = r - 512, kb = rr >> 5, nb_ = rr & 31, n0 = nb_ * 32;
      transpose_item(Wd + (size_t)e * 512 * 1024, 1024, 512, WD + ((size_t)e * 1024 + n0) * 512, scr, kb * 64, n0, lane);
    }
  }
}

DEV void ph_norm0(const Params& p, int bid, int nb) {
  const int lane = tidx() & 63, wave = tidx() >> 6;
  const float* mods = (const float*)(p.ws + WS_MODS);
  bf16_t* hA = (bf16_t*)(p.ws + WS_HA);
  const float* g1 = p.in[6];
  for (int r0 = (bid * 4 + wave) * 4; r0 < T; r0 += nb * 16) {
    f32x4 v[4][4]; float rs[4];
#pragma unroll
    for (int q = 0; q < 4; ++q) {
      const int r = r0 + q;
      const float* src = r < NL ? p.in[0] + (size_t)r * D : p.in[2] + (size_t)(r - NL) * D;
#pragma unroll
      for (int i = 0; i < 4; ++i) v[q][i] = *(const f32x4*)(src + 4 * lane + 256 * i);
    }
#pragma unroll
    for (int q = 0; q < 4; ++q) {
      float ss = 0.f;
#pragma unroll
      for (int i = 0; i < 4; ++i) ss += v[q][i].x * v[q][i].x + v[q][i].y * v[q][i].y + v[q][i].z * v[q][i].z + v[q][i].w * v[q][i].w;
      rs[q] = rsqrtf(wave_sum(ss) * (1.f / D) + EPS);
    }
#pragma unroll
    for (int i = 0; i < 4; ++i) {
      const int c = 4 * lane + 256 * i;
      const f32x4 g = *(const f32x4*)(g1 + c);
#pragma unroll
      for (int q = 0; q < 4; ++q) {
        const int r = r0 + q;
        const float* md = mods + (r < NL ? 0 : 6144);
        const f32x4 sh = *(const f32x4*)(md + c), sc = *(const f32x4*)(md + 1024 + c);
        const f32x4 h = v[q][i] * rs[q] * g * (1.f + sc) + sh;
        u32x2 o; o.x = pk2(h.x, h.y); o.y = pk2(h.z, h.w);
        *(u32x2*)(hA + (size_t)r * D + c) = o;
      }
    }
  }
}

constexpr int RG_AS_STRIDE = 272;
constexpr int RG_MT = RGT / 16;
constexpr int RG_AS = 0, RG_BS = RGT * RG_AS_STRIDE, RG_SMEM = RG_BS + 128 * BS_STRIDE;

template <bool REV, int NT>
DEV void rg_scan(f32x4 (&A)[RG_MT][NT], f32x4 (&B)[RG_MT][NT], float (&aggP)[NT], float (&aggH)[NT]) {
  const int lane = tidx() & 63, fq = lane >> 4, fr = lane & 15;
#pragma unroll
  for (int n = 0; n < NT; ++n) {
    float cP = 1.f, cH = 0.f;
#pragma unroll
    for (int mm = 0; mm < RG_MT; ++mm) {
      const int m = REV ? RG_MT - 1 - mm : mm;
      float P[4], H[4];
      if (!REV) {
        P[0] = A[m][n][0]; H[0] = B[m][n][0];
#pragma unroll
        for (int j = 1; j < 4; ++j) { P[j] = A[m][n][j] * P[j - 1]; H[j] = A[m][n][j] * H[j - 1] + B[m][n][j]; }
      } else {
        P[3] = A[m][n][3]; H[3] = B[m][n][3];
#pragma unroll
        for (int j = 2; j >= 0; --j) { P[j] = A[m][n][j] * P[j + 1]; H[j] = A[m][n][j] * H[j + 1] + B[m][n][j]; }
      }
      float IP = REV ? P[0] : P[3], IH = REV ? H[0] : H[3];
      float tP, tH;
      tP = REV ? __shfl_down(IP, 16) : __shfl_up(IP, 16); tH = REV ? __shfl_down(IH, 16) : __shfl_up(IH, 16);
      if (REV ? (fq <= 2) : (fq >= 1)) { IH = IP * tH + IH; IP = IP * tP; }
      tP = REV ? __shfl_down(IP, 32) : __shfl_up(IP, 32); tH = REV ? __shfl_down(IH, 32) : __shfl_up(IH, 32);
      if (REV ? (fq <= 1) : (fq >= 2)) { IH = IP * tH + IH; IP = IP * tP; }
      float EP = REV ? __shfl_down(IP, 16) : __shfl_up(IP, 16), EH = REV ? __shfl_down(IH, 16) : __shfl_up(IH, 16);
      if (REV ? (fq == 3) : (fq == 0)) { EP = 1.f; EH = 0.f; }
      const float hin = EP * cH + EH, pin = EP * cP;
#pragma unroll
      for (int j = 0; j < 4; ++j) { B[m][n][j] = H[j] + P[j] * hin; A[m][n][j] = P[j] * pin; }
      const float TP = __shfl(IP, (REV ? 0 : 48) + fr), TH = __shfl(IH, (REV ? 0 : 48) + fr);
      cH = TP * cH + TH; cP = TP * cP;
    }
    aggP[n] = cP; aggH[n] = cH;
  }
}

DEV void ph_rg_scan(const Params& p, char* smem, int bid, int nb) {
  char* As = smem + RG_AS; char* Bs = smem + RG_BS;
  const bf16_t* pr = (const bf16_t*)(p.ws + WS_PR);
  bf16_t* Sb = (bf16_t*)(p.ws + WS_S); bf16_t* Pfb = (bf16_t*)(p.ws + WS_PF); bf16_t* Pbb = (bf16_t*)(p.ws + WS_PB);
  float* agg = (float*)(p.ws + WS_AGG);
  const float* conv_w = p.in[9]; const float* conv_b = p.in[10];
  for (int it = 0, iters = (NRT * 10 + nb - 1) / nb; it < iters; ++it) {
    int u = bid + it * nb; const bool active = u < NRT * 10; if (!active) u = NRT * 10 - 1;
    const int tid = tidx();
    const int lane = tid & 63, wave = tid >> 6, fr = lane & 15, fq = lane >> 4, q4 = fr >> 2, p4 = lane & 3;
    const int hb = u % 10, tile = u / 10, r0 = tile * RGT, ch0 = hb * 128;
    const int seg_lo = tile < NRT_LAT ? 0 : NL, seg_hi = tile < NRT_LAT ? NL : T;
    __syncthreads();
    {
      const int cg8 = tid & 15, rg = tid >> 4, c = ch0 + 8 * cg8;
      float w[4][8], bias[8];
#pragma unroll
      for (int j = 0; j < 4; ++j) { const f32x4 a = *(const f32x4*)(conv_w + j * DR + c), b = *(const f32x4*)(conv_w + j * DR + c + 4);
        w[j][0] = a.x; w[j][1] = a.y; w[j][2] = a.z; w[j][3] = a.w; w[j][4] = b.x; w[j][5] = b.y; w[j][6] = b.z; w[j][7] = b.w; }
      { const f32x4 a = *(const f32x4*)(conv_b + c), b = *(const f32x4*)(conv_b + c + 4);
        bias[0] = a.x; bias[1] = a.y; bias[2] = a.z; bias[3] = a.w; bias[4] = b.x; bias[5] = b.y; bias[6] = b.z; bias[7] = b.w; }
      float win[4][8];
      auto ldrow = [&](int r, float (&dst)[8]) {
        if (r >= seg_lo && r < seg_hi) { const u32x4 v = *(const u32x4*)(pr + (size_t)r * DR + c);
          dst[0] = bflo(v.x); dst[1] = bfhi(v.x); dst[2] = bflo(v.y); dst[3] = bfhi(v.y); dst[4] = bflo(v.z); dst[5] = bfhi(v.z); dst[6] = bflo(v.w); dst[7] = bfhi(v.w); }
        else {
#pragma unroll
          for (int e = 0; e < 8; ++e) dst[e] = 0.f; }
      };
      const int rb = r0 + rg * 4;
      ldrow(rb - 2, win[0]); ldrow(rb - 1, win[1]); ldrow(rb, win[2]);
#pragma unroll
      for (int t = 0; t < 4; ++t) {
        ldrow(rb + t + 1, win[(t + 3) & 3]);
        float o[8];
#pragma unroll
        for (int e = 0; e < 8; ++e) o[e] = bias[e] + w[0][e] * win[t & 3][e] + w[1][e] * win[(t + 1) & 3][e] + w[2][e] * win[(t + 2) & 3][e] + w[3][e] * win[(t + 3) & 3][e];
        u32x4 ov; ov.x = pk2(o[0], o[1]); ov.y = pk2(o[2], o[3]); ov.z = pk2(o[4], o[5]); ov.w = pk2(o[6], o[7]);
        *(u32x4*)(As + (rg * 4 + t) * RG_AS_STRIDE + cg8 * 16) = ov;
      }
    }
    u32x2 hfk[RG_MT][2];
#pragma unroll
    for (int d = 0; d < 2; ++d) {
      f32x4 accA[RG_MT][2], accX[RG_MT][2];
#pragma unroll
      for (int which = 0; which < 2; ++which) {
        const float* W = (which ? p.in[13] : p.in[11]) + (size_t)(d * 10 + hb) * 16384;
        __syncthreads();
#pragma unroll 1
        for (int ib = 0; ib < 4; ++ib) {
#pragma unroll
          for (int ii = 0; ii < 4; ++ii) {
            const int f = tid + 256 * (ib * 4 + ii), k = f >> 5, n = 4 * (f & 31);
            const f32x4 v = *(const f32x4*)(W + k * 128 + n);
            u32x2 o; o.x = pk2(v.x, v.y); o.y = pk2(v.z, v.w);
            *(u32x2*)(Bs + bs_off(k, n)) = o;
          }
        }
        __syncthreads();
        f32x4 (&acc)[RG_MT][2] = which ? accX : accA;
#pragma unroll
        for (int m = 0; m < RG_MT; ++m) { acc[m][0] = (f32x4){0.f, 0.f, 0.f, 0.f}; acc[m][1] = (f32x4){0.f, 0.f, 0.f, 0.f}; }
#pragma unroll
        for (int ks = 0; ks < 4; ++ks) {
          bf16x8 b[2];
#pragma unroll
          for (int n = 0; n < 2; ++n) {
            const int ncol = wave * 32 + n * 16 + 4 * p4;
            const s16x4 lo = ldtr(Bs + bs_off(ks * 32 + fq * 8 + q4, ncol));
            const s16x4 hi = ldtr(Bs + bs_off(ks * 32 + fq * 8 + 4 + q4, ncol));
            b[n] = (bf16x8){lo.x, lo.y, lo.z, lo.w, hi.x, hi.y, hi.z, hi.w};
          }
#pragma unroll
          for (int m = 0; m < RG_MT; ++m) {
            const bf16x8 a = *(const bf16x8*)(As + (m * 16 + fr) * RG_AS_STRIDE + (ks * 32 + fq * 8) * 2);
            acc[m][0] = __builtin_amdgcn_mfma_f32_16x16x32_bf16(a, b[0], acc[m][0], 0, 0, 0);
            acc[m][1] = __builtin_amdgcn_mfma_f32_16x16x32_bf16(a, b[1], acc[m][1], 0, 0, 0);
          }
        }
      }
#pragma unroll
      for (int n = 0; n < 2; ++n) {
        const int cl = wave * 32 + n * 16 + fr, ch = ch0 + cl;
        const float ba = p.in[12][d * DR + ch], bx = p.in[14][d * DR + ch], lam = p.in[15][d * DR + ch];
        const float nl = -lam;
        const float sp = nl > 20.f ? nl : log1pf(__expf(nl));
        const float c8 = -8.f * sp;
#pragma unroll
        for (int m = 0; m < RG_MT; ++m)
#pragma unroll
          for (int j = 0; j < 4; ++j) {
            const int row = m * 16 + fq * 4 + j;
            const float r = sigmoidf_(accA[m][n][j] + ba), ig = sigmoidf_(accX[m][n][j] + bx);
            const float la = c8 * r;
            const float a = __expf(la);
            const float x2 = 2.f * la;
            const float om = x2 > -0.1f ? -x2 * (1.f + x2 * (0.5f + x2 * (0.16666667f + x2 * 0.041666668f))) : 1.f - a * a;
            const float mult = sqrtf(om);
            const float uu = bf2f(*(const bf16_t*)(As + row * RG_AS_STRIDE + cl * 2));
            accA[m][n][j] = a; accX[m][n][j] = mult * ig * uu;
            if (j == 3) __builtin_amdgcn_sched_barrier(0);
          }
      }
      float aggP[2], aggH[2];
      if (d == 0) rg_scan<false, 2>(accA, accX, aggP, aggH); else rg_scan<true, 2>(accA, accX, aggP, aggH);
      if (fq == 0) {
#pragma unroll
        for (int n = 0; n < 2; ++n) {
          const int ch = ch0 + wave * 32 + n * 16 + fr;
          float* ag = agg + ((size_t)(d * NRT + tile) * DR + ch) * 2;
          ag[0] = aggP[n]; ag[1] = aggH[n];
        }
      }
      bf16_t* Pout = d ? Pbb : Pfb;
#pragma unroll
      for (int m = 0; m < RG_MT; ++m)
#pragma unroll
        for (int n = 0; n < 2; ++n) {
          if (d == 0) { hfk[m][n].x = pk2(accX[m][n][0], accX[m][n][1]); hfk[m][n].y = pk2(accX[m][n][2], accX[m][n][3]); }
          else { accX[m][n][0] += bflo(hfk[m][n].x); accX[m][n][1] += bfhi(hfk[m][n].x); accX[m][n][2] += bflo(hfk[m][n].y); accX[m][n][3] += bfhi(hfk[m][n].y); }
#pragma unroll
          for (int j = 0; j < 4; ++j) {
            const unsigned o = (unsigned)(r0 + m * 16 + fq * 4 + j) * DR + ch0 + wave * 32 + n * 16 + fr;
            Pout[o] = f2bf(accA[m][n][j]);
            if (d == 1) Sb[o] = f2bf(accX[m][n][j]);
          }
          __builtin_amdgcn_sched_barrier(0);
        }
    }
  }
}

DEV void ph_rg_scan2(const Params& p, char* smem) {
  int tid = threadIdx.x; asm volatile("" : "+v"(tid));
  const int lane = tid & 63, wave = tid >> 6, fr = lane & 15, fq = lane >> 4;
  const bf16_t* pr = (const bf16_t*)(p.ws + WS_PR);
  bf16_t* Sb = (bf16_t*)(p.ws + WS_S); bf16_t* Pfb = (bf16_t*)(p.ws + WS_PF); bf16_t* Pbb = (bf16_t*)(p.ws + WS_PB);
  float* agg = (float*)(p.ws + WS_AGG);
  const bf16_t* WAX = (const bf16_t*)(p.ws + WS_WAXT);
  const float* conv_w = p.in[9]; const float* conv_b = p.in[10];
  const int NU = NRT * 10;
  const int u0 = (int)((long)blockIdx.x * NU / gridDim.x), u1 = (int)((long)(blockIdx.x + 1) * NU / gridDim.x);
  int cur_hb = -1;
  bf16x8 bfr[4][4];
  float cba[2], cbx[2], cc8[2];
#pragma unroll 1
  for (int u = u0; u < u1; ++u) {
    const int hb = u / NRT, tile = u - hb * NRT, r0 = tile * RGT, ch0 = hb * 128;
    const int seg_lo = tile < NRT_LAT ? 0 : NL, seg_hi = tile < NRT_LAT ? NL : T;
    char* As = smem + ((u - u0) & 1) * (RGT * RG_AS_STRIDE);
    if (hb != cur_hb) {
      cur_hb = hb;
#pragma unroll
      for (int mat = 0; mat < 4; ++mat)
#pragma unroll
        for (int ks = 0; ks < 4; ++ks)
          bfr[mat][ks] = *(const bf16x8*)(WAX + (size_t)(((mat >> 1) * 10 + hb) * 2 + (mat & 1)) * 16384 + (16 * wave + fr) * 128 + ks * 32 + fq * 8);
#pragma unroll
      for (int d = 0; d < 2; ++d) {
        const int ch = ch0 + 16 * wave + fr;
        cba[d] = p.in[12][d * DR + ch]; cbx[d] = p.in[14][d * DR + ch];
        const float nl = -p.in[15][d * DR + ch];
        cc8[d] = -8.f * (nl > 20.f ? nl : log1pf(__expf(nl)));
      }
    }
    {
      const int cg8 = tid & 15, rg = tid >> 4, c = ch0 + 8 * cg8;
      float w[4][8], bias[8];
#pragma unroll
      for (int j = 0; j < 4; ++j) { const f32x4 a = *(const f32x4*)(conv_w + j * DR + c), b = *(const f32x4*)(conv_w + j * DR + c + 4);
        w[j][0] = a.x; w[j][1] = a.y; w[j][2] = a.z; w[j][3] = a.w; w[j][4] = b.x; w[j][5] = b.y; w[j][6] = b.z; w[j][7] = b.w; }
      { const f32x4 a = *(const f32x4*)(conv_b + c), b = *(const f32x4*)(conv_b + c + 4);
        bias[0] = a.x; bias[1] = a.y; bias[2] = a.z; bias[3] = a.w; bias[4] = b.x; bias[5] = b.y; bias[6] = b.z; bias[7] = b.w; }
      float win[5][8];
      const int rb = r0 + rg * 2;
#pragma unroll
      for (int t = 0; t < 5; ++t) {
        const int r = rb - 2 + t;
        if (r >= seg_lo && r < seg_hi) { const u32x4 v = *(const u32x4*)(pr + (size_t)r * DR + c);
          win[t][0] = bflo(v.x); win[t][1] = bfhi(v.x); win[t][2] = bflo(v.y); win[t][3] = bfhi(v.y); win[t][4] = bflo(v.z); win[t][5] = bfhi(v.z); win[t][6] = bflo(v.w); win[t][7] = bfhi(v.w); }
        else {
#pragma unroll
          for (int e = 0; e < 8; ++e) win[t][e] = 0.f; }
      }
#pragma unroll
      for (int t = 0; t < 2; ++t) {
        float o[8];
#pragma unroll
        for (int e = 0; e < 8; ++e) o[e] = bias[e] + w[0][e] * win[t][e] + w[1][e] * win[t + 1][e] + w[2][e] * win[t + 2][e] + w[3][e] * win[t + 3][e];
        u32x4 ov; ov.x = pk2(o[0], o[1]); ov.y = pk2(o[2], o[3]); ov.z = pk2(o[4], o[5]); ov.w = pk2(o[6], o[7]);
        *(u32x4*)(As + (rg * 2 + t) * RG_AS_STRIDE + cg8 * 16) = ov;
      }
    }
    __syncthreads();
    f32x4 acc[4][RG_MT][1];
#pragma unroll
    for (int mat = 0; mat < 4; ++mat)
#pragma unroll
      for (int m = 0; m < RG_MT; ++m) acc[mat][m][0] = (f32x4){0.f, 0.f, 0.f, 0.f};
#pragma unroll
    for (int ks = 0; ks < 4; ++ks)
#pragma unroll
      for (int m = 0; m < RG_MT; ++m) {
        const bf16x8 a = *(const bf16x8*)(As + (m * 16 + fr) * RG_AS_STRIDE + (ks * 32 + fq * 8) * 2);
#pragma unroll
        for (int mat = 0; mat < 4; ++mat) acc[mat][m][0] = __builtin_amdgcn_mfma_f32_16x16x32_bf16(a, bfr[mat][ks], acc[mat][m][0], 0, 0, 0);
      }
    const int cl = 16 * wave + fr;
#pragma unroll
    for (int d = 0; d < 2; ++d) {
      f32x4 (&accA)[RG_MT][1] = acc[d * 2]; f32x4 (&accX)[RG_MT][1] = acc[d * 2 + 1];
#pragma unroll
      for (int m = 0; m < RG_MT; ++m) {
#pragma unroll
        for (int j = 0; j < 4; ++j) {
          const int row = m * 16 + fq * 4 + j;
          const float r = sigmoidf_(accA[m][0][j] + cba[d]), ig = sigmoidf_(accX[m][0][j] + cbx[d]);
          const float la = cc8[d] * r;
          const float a = fexp_(la);
          const float x2 = 2.f * la;
          const float om = x2 > -0.1f ? -x2 * (1.f + x2 * (0.5f + x2 * (0.16666667f + x2 * 0.041666668f))) : 1.f - a * a;
          const float uu = bf2f(*(const bf16_t*)(As + row * RG_AS_STRIDE + cl * 2));
          accA[m][0][j] = a; accX[m][0][j] = __builtin_amdgcn_sqrtf(om) * ig * uu;
        }
        __builtin_amdgcn_sched_barrier(0);
      }
      float aggP[1], aggH[1];
      if (d == 0) rg_scan<false, 1>(accA, accX, aggP, aggH); else rg_scan<true, 1>(accA, accX, aggP, aggH);
      if (fq == 0) { float* ag = agg + ((size_t)(d * NRT + tile) * DR + ch0 + cl) * 2; ag[0] = aggP[0]; ag[1] = aggH[0]; }
      bf16_t* Pout = d ? Pbb : Pfb;
#pragma unroll
      for (int m = 0; m < RG_MT; ++m) {
        if (d == 1) accX[m][0] += acc[1][m][0];
#pragma unroll
        for (int j = 0; j < 4; ++j) {
          const unsigned o = (unsigned)(r0 + m * 16 + fq * 4 + j) * DR + ch0 + cl;
          Pout[o] = f2bf(accA[m][0][j]);
          if (d == 1) Sb[o] = f2bf(accX[m][0][j]);
        }
      }
    }
  }
  __syncthreads();
}

DEV void ph_rg_carry(const Params& p, char* smem, int bid, int nb) {
  const float* agg = (const float*)(p.ws + WS_AGG); float* carry = (float*)(p.ws + WS_CARRY);
  const int tid = tidx();
  float* sP = (float*)smem; float* sH = sP + 256;
  constexpr int NCH = 2 * DR, CPB = 25, NB = (NCH + CPB - 1) / CPB;
  for (int it = 0, iters = (NB + nb - 1) / nb; it < iters; ++it) {
    const int blk = bid + it * nb;
    const int lc = tid / 10, seg = tid % 10, chain = blk * CPB + lc;
    const bool on = blk < NB && tid < 250 && chain < NCH;
    const int d = on ? chain / DR : 0, ch = on ? chain % DR : 0;
    float ap[26], ah[26];
    if (on) {
#pragma unroll
      for (int j = 0; j < 26; ++j) {
        const int s = seg * 26 + j;
        const int tile = d == 0 ? (s < (NRT - NRT_LAT) ? NRT_LAT + s : s - (NRT - NRT_LAT)) : NRT - 1 - s;
        const float* ag = agg + ((size_t)(d * NRT + tile) * DR + ch) * 2;
        ap[j] = ag[0]; ah[j] = ag[1];
      }
      float P = 1.f, H = 0.f;
#pragma unroll
      for (int j = 0; j < 26; ++j) { H = ap[j] * H + ah[j]; P = ap[j] * P; }
      sP[tid] = P; sH[tid] = H;
    }
    __syncthreads();
    if (on) {
      float st = 0.f;
      for (int k = 0; k < seg; ++k) st = sP[lc * 10 + k] * st + sH[lc * 10 + k];
#pragma unroll
      for (int j = 0; j < 26; ++j) {
        const int s = seg * 26 + j;
        const int tile = d == 0 ? (s < (NRT - NRT_LAT) ? NRT_LAT + s : s - (NRT - NRT_LAT)) : NRT - 1 - s;
        carry[(size_t)(d * NRT + tile) * DR + ch] = st;
        st = ap[j] * st + ah[j];
      }
    }
    __syncthreads();
  }
}

DEV void ph_rg_final(const Params& p, int bid, int nb) {
  const bf16_t* gg = (const bf16_t*)(p.ws + WS_GG); const bf16_t* Sb = (const bf16_t*)(p.ws + WS_S);
  const bf16_t* Pfb = (const bf16_t*)(p.ws + WS_PF); const bf16_t* Pbb = (const bf16_t*)(p.ws + WS_PB);
  const float* carry = (const float*)(p.ws + WS_CARRY);
  bf16_t* y = (bf16_t*)(p.ws + WS_PR);
  const int total = T * (DR / 8);
  for (int i = bid * 256 + tidx(); i < total; i += nb * 256) {
    const int r = i / 160, c = (i % 160) * 8, tile = r / RGT;
    const size_t o = (size_t)r * DR + c;
    const u32x4 g = *(const u32x4*)(gg + o), s = *(const u32x4*)(Sb + o), pf = *(const u32x4*)(Pfb + o), pb = *(const u32x4*)(Pbb + o);
    const float* cf = carry + (size_t)tile * DR + c; const float* cb = carry + (size_t)(NRT + tile) * DR + c;
    const f32x4 cf0 = *(const f32x4*)cf, cf1 = *(const f32x4*)(cf + 4), cb0 = *(const f32x4*)cb, cb1 = *(const f32x4*)(cb + 4);
    u32x4 o4;
    o4.x = pk2(bflo(g.x) * (bflo(s.x) + bflo(pf.x) * cf0.x + bflo(pb.x) * cb0.x), bfhi(g.x) * (bfhi(s.x) + bfhi(pf.x) * cf0.y + bfhi(pb.x) * cb0.y));
    o4.y = pk2(bflo(g.y) * (bflo(s.y) + bflo(pf.y) * cf0.z + bflo(pb.y) * cb0.z), bfhi(g.y) * (bfhi(s.y) + bfhi(pf.y) * cf0.w + bfhi(pb.y) * cb0.w));
    o4.z = pk2(bflo(g.z) * (bflo(s.z) + bflo(pf.z) * cf1.x + bflo(pb.z) * cb1.x), bfhi(g.z) * (bfhi(s.z) + bfhi(pf.z) * cf1.y + bfhi(pb.z) * cb1.y));
    o4.w = pk2(bflo(g.w) * (bflo(s.w) + bflo(pf.w) * cf1.z + bflo(pb.w) * cb1.z), bfhi(g.w) * (bfhi(s.w) + bfhi(pf.w) * cf1.w + bfhi(pb.w) * cb1.w));
    *(u32x4*)(y + o) = o4;
  }
}

using pg8::Unit;
struct EpiRgIn {
  static constexpr bool PERM = true, AFTER_DRAIN = false;
  bf16_t* gg; bf16_t* pr;
  DEV void operator()(const f32x4 (&acc)[2][2][4][2], const Unit& u, int wr, int wc, int fr, int fq) const {
    const int row0 = u.pm * 256 + wr * 64 + fr, c0 = u.pn * 256 + wc * 32 + 8 * fq;
    const bool gate = u.pn < 5;
#pragma unroll
    for (int ai = 0; ai < 2; ++ai)
#pragma unroll
      for (int m = 0; m < 4; ++m) {
        const unsigned row = row0 + ai * 128 + m * 16;
#pragma unroll
        for (int bj = 0; bj < 2; ++bj) {
          f32x4 v0 = acc[ai][bj][m][0], v1 = acc[ai][bj][m][1];
          const int col = c0 + bj * 128;
          if (gate) {
#pragma unroll
            for (int j = 0; j < 4; ++j) { v0[j] = gelu_tanh(v0[j]); v1[j] = gelu_tanh(v1[j]); }
          }
          u32x4 w; w.x = pk2(v0[0], v0[1]); w.y = pk2(v0[2], v0[3]); w.z = pk2(v1[0], v1[1]); w.w = pk2(v1[2], v1[3]);
          if (gate) *(u32x4*)(gg + row * DR + col) = w; else *(u32x4*)(pr + row * DR + col - DR) = w;
        }
      }
  }
};
template <int LAYER> struct EpiOut {
  static constexpr bool PERM = false, AFTER_DRAIN = false;
  const float* x; const float* ctx; const bf16_t* x2; const float* mods; bf16_t* x1;
  DEV void operator()(const f32x4 (&acc)[2][2][4][2], const Unit& u, int wr, int wc, int fr, int fq) const {
    const int row0 = u.pm * 256 + wr * 64 + fr, c0 = u.pn * 256 + wc * 32 + 4 * fq;
#pragma unroll
    for (int ai = 0; ai < 2; ++ai)
#pragma unroll
      for (int m = 0; m < 4; ++m) {
        const int row = row0 + ai * 128 + m * 16;
        const int trow = LAYER == 0 ? row : token_of_seqrow(row);
        const float* xin = LAYER == 0 ? (row < NL ? x + (size_t)row * D : ctx + (size_t)(row - NL) * D) : nullptr;
        const float* gt = mods + ((LAYER == 0 && row >= NL) ? 6144 : 0) + 2048;
        bf16_t* xo = x1 + (size_t)trow * D;
#pragma unroll
        for (int bj = 0; bj < 2; ++bj)
#pragma unroll
          for (int n = 0; n < 2; ++n) {
            const int col = c0 + bj * 128 + n * 16;
            const f32x4 xi = LAYER == 0 ? *(const f32x4*)(xin + col) : ld_bf4(x2 + (size_t)trow * D + col);
            st_bf4(xo + col, xi + *(const f32x4*)(gt + col) * acc[ai][bj][m][n]);
          }
      }
  }
};
struct EpiMoe1 {
  static constexpr bool PERM = true, AFTER_DRAIN = false;
  bf16_t* Hm;
  DEV void operator()(const f32x4 (&acc)[2][2][4][2], const Unit& u, int wr, int wc, int fr, int fq) const {
    const int row0 = u.pm * 256 + wr * 64 + fr, c0 = (u.pn & 3) * 128 + wc * 32 + 8 * fq;
#pragma unroll
    for (int ai = 0; ai < 2; ++ai)
#pragma unroll
      for (int m = 0; m < 4; ++m) {
        const unsigned row = row0 + ai * 128 + m * 16;
        float h[8];
#pragma unroll
        for (int n = 0; n < 2; ++n)
#pragma unroll
          for (int j = 0; j < 4; ++j) h[n * 4 + j] = siluf_(acc[ai][0][m][n][j]) * acc[ai][1][m][n][j];
        u32x4 w; w.x = pk2(h[0], h[1]); w.y = pk2(h[2], h[3]); w.z = pk2(h[4], h[5]); w.w = pk2(h[6], h[7]);
        *(u32x4*)(Hm + row * DE + c0) = w;
      }
  }
};
struct EpiMoe2 {
  static constexpr bool PERM = true, AFTER_DRAIN = false;
  bf16_t* Y; const float* awp;
  DEV void operator()(const f32x4 (&acc)[2][2][4][2], const Unit& u, int wr, int wc, int fr, int fq) const {
    const int row0 = u.pm * 256 + wr * 64 + fr, c0 = (u.pn & 3) * 256 + wc * 32 + 8 * fq;
#pragma unroll
    for (int ai = 0; ai < 2; ++ai)
#pragma unroll
      for (int m = 0; m < 4; ++m) {
        const unsigned row = row0 + ai * 128 + m * 16;
        const float w8 = awp[row];
#pragma unroll
        for (int bj = 0; bj < 2; ++bj) {
          const f32x4 v0 = acc[ai][bj][m][0] * w8, v1 = acc[ai][bj][m][1] * w8;
          u32x4 w; w.x = pk2(v0[0], v0[1]); w.y = pk2(v0[2], v0[3]); w.z = pk2(v1[0], v1[1]); w.w = pk2(v1[2], v1[3]);
          *(u32x4*)(Y + row * D + c0 + bj * 128) = w;
        }
      }
  }
};
struct EpiMlIn {
  static constexpr bool PERM = false, AFTER_DRAIN = false;
  bf16_t* qb; bf16_t* kb; bf16_t* kT; bf16_t* vT; bf16_t* og;
  DEV void operator()(const f32x4 (&acc)[2][2][4][2], const Unit& u, int wr, int wc, int fr, int fq) const {
    const unsigned row0 = u.pm * 256 + wr * 64 + fr, c0 = u.pn * 256 + wc * 32 + 4 * fq;
    const int pn = u.pn;
#define MLIN_LOOP(BODY) _Pragma("unroll") for (int ai = 0; ai < 2; ++ai) _Pragma("unroll") for (int m = 0; m < 4; ++m) { const unsigned row = row0 + ai * 128 + m * 16; \
      _Pragma("unroll") for (int bj = 0; bj < 2; ++bj) _Pragma("unroll") for (int n = 0; n < 2; ++n) { const f32x4 v = acc[ai][bj][m][n]; const unsigned col = c0 + bj * 128 + n * 16; BODY } }
    if (pn < 2) {
      MLIN_LOOP({ u32x2 o; o.x = pk2(v[0] * 0.125f, v[1] * 0.125f); o.y = pk2(v[2] * 0.125f, v[3] * 0.125f); *(u32x2*)(qb + row * 512 + col) = o; })
    } else if (pn < 4) {
      MLIN_LOOP({ u32x2 o; o.x = pk2(v[0], v[1]); o.y = pk2(v[2], v[3]); *(u32x2*)(kb + row * 512 + col - 512) = o;
        bf16_t* kp = kT + (col - 512) * T + row;
        kp[0] = (bf16_t)(o.x & 0xffffu); kp[T] = (bf16_t)(o.x >> 16); kp[2 * T] = (bf16_t)(o.y & 0xffffu); kp[3 * T] = (bf16_t)(o.y >> 16); })
    } else if (pn < 8) {
      MLIN_LOOP({ u32x2 o; o.x = pk2(v[0], v[1]); o.y = pk2(v[2], v[3]);
        bf16_t* vp = vT + (col - 1024) * T + row;
        vp[0] = (bf16_t)(o.x & 0xffffu); vp[T] = (bf16_t)(o.x >> 16); vp[2 * T] = (bf16_t)(o.y & 0xffffu); vp[3 * T] = (bf16_t)(o.y >> 16); })
    } else {
      MLIN_LOOP({ u32x2 o; o.x = pk2(sigmoidf_(v[0]), sigmoidf_(v[1])); o.y = pk2(sigmoidf_(v[2]), sigmoidf_(v[3])); *(u32x2*)(og + row * D + col - 2048) = o; })
    }
#undef MLIN_LOOP
  }
};

struct MoeOrder {
  const int* tb; int ntn, G, c;
  DEV bool next(int i, Unit& u) const {
    const int U = tb[32], per = (U + 7) >> 3, xcd = c & 7, lo = xcd * per, hi = min(lo + per, U);
    const int L = lo + i * (G >> 3) + (c >> 3); if (L >= hi) return false;
    int e = 0;
#pragma unroll 1
    for (int k = 1; k < 32; ++k) e = (L >= tb[k]) ? k : e;
    const int r = L - tb[e], mt = (tb[e + 1] - tb[e]) / ntn;
    u.pm = tb[33 + e] + r % mt; u.pn = e * ntn + r / mt; return true;
  }
  DEV void a_ready(const Unit&) const {}
  DEV void done(const Unit&) const {}
  const int* rowmap;
  DEV int src_row(const Unit& u, int r) const { return rowmap[u.pm * 256 + r]; }
};
constexpr int LDS_TB = 131072;
DEV void moe_tables(const int* cnt, char* smem, int ntn) {
  int* tb = (int*)(smem + LDS_TB);
  if (threadIdx.x == 0) {
    int ub = 0, rb = 0;
    for (int e = 0; e < 32; ++e) { const int m = (cnt[e * CNT_STRIDE] + 255) >> 8; tb[e] = ub; tb[33 + e] = rb; ub += m * ntn; rb += m; }
    tb[32] = ub; tb[65] = rb;
  }
  __syncthreads();
}

template <int NT>
DEV void wave_gemm16(const bf16_t* A, int lda, const bf16_t* Bt, int ldb, int ks0, int ks1, f32x4 (&acc)[NT]) {
  const int lane = tidf() & 63, fr = lane & 15, fq = lane >> 4;
  const bf16_t* ap = A + (size_t)fr * lda + fq * 8; const bf16_t* bp = Bt + (size_t)fr * ldb + fq * 8;
#pragma unroll 4
  for (int ks = ks0; ks < ks1; ++ks) {
    const bf16x8 a = *(const bf16x8*)(ap + ks * 32);
#pragma unroll
    for (int n = 0; n < NT; ++n) {
      const bf16x8 b = *(const bf16x8*)(bp + (size_t)n * 16 * ldb + ks * 32);
      acc[n] = __builtin_amdgcn_mfma_f32_16x16x32_bf16(a, b, acc[n], 0, 0, 0);
    }
  }
}
DEV void ph_out0_ctx(const Params& p, char* smem) {
  const int tf = tidf(), lane = tf & 63, wv = tf >> 6, fr = lane & 15, fq = lane >> 4;
  const int b = blockIdx.x;
  f32x4* red = (f32x4*)smem;
  if (b < 256) {
    const int rt = b >> 4, cg = b & 15, nt = wv & 3, kh = wv >> 2;
    f32x4 acc[1] = {(f32x4){0.f, 0.f, 0.f, 0.f}};
    wave_gemm16<1>((const bf16_t*)(p.ws + WS_PR) + (size_t)(NL + rt * 16) * DR, DR, (const bf16_t*)(p.ws + WS_WOUT) + (size_t)(cg * 64 + nt * 16) * DR, DR, kh * 20, kh * 20 + 20, acc);
    if (kh == 1) red[nt * 64 + lane] = acc[0];
    __syncthreads();
    if (kh == 0) {
      const f32x4 v = acc[0] + red[nt * 64 + lane];
      const int col = cg * 64 + nt * 16 + fr;
      const float gt = ((const float*)(p.ws + WS_MODS))[6144 + 2048 + col];
      bf16_t* x1 = (bf16_t*)(p.ws + WS_X1);
#pragma unroll
      for (int j = 0; j < 4; ++j) { const int r = rt * 16 + fq * 4 + j; x1[(size_t)(NL + r) * D + col] = f2bf(p.in[2][(size_t)r * D + col] + gt * v[j]); }
    }
  } else __syncthreads();
  __syncthreads();
}
DEV void ph_mlin_small(const Params& p, char* smem) {
  const int tf = tidf(), lane = tf & 63, wv = tf >> 6, fr = lane & 15, fq = lane >> 4;
  const bf16_t* hA = (const bf16_t*)(p.ws + WS_HA); const bf16_t* W = (const bf16_t*)(p.ws + WS_WML);
  bf16_t* kb = (bf16_t*)(p.ws + WS_K); bf16_t* kT = (bf16_t*)(p.ws + WS_KT); bf16_t* vT = (bf16_t*)(p.ws + WS_VT); float* gl = (float*)(p.ws + WS_GL);
  const int b = blockIdx.x;
  if (b < 192) {
    const int rt = b / 12, cg = b % 12, col0 = 512 + cg * 128 + wv * 16;
    f32x4 acc[1] = {(f32x4){0.f, 0.f, 0.f, 0.f}};
    wave_gemm16<1>(hA + (size_t)(NL + rt * 16) * D, D, W + (size_t)col0 * D, D, 0, 32, acc);
    const unsigned col = col0 + fr, row = NL + rt * 16 + fq * 4;
    u32x2 o; o.x = pk2(acc[0][0], acc[0][1]); o.y = pk2(acc[0][2], acc[0][3]);
    if (col < 1024) {
      *(u32x2*)(kT + (col - 512) * T + row) = o;
      kb[(row + 0) * 512 + col - 512] = (bf16_t)(o.x & 0xffffu); kb[(row + 1) * 512 + col - 512] = (bf16_t)(o.x >> 16);
      kb[(row + 2) * 512 + col - 512] = (bf16_t)(o.y & 0xffffu); kb[(row + 3) * 512 + col - 512] = (bf16_t)(o.y >> 16);
    } else *(u32x2*)(vT + (col - 1024) * T + row) = o;
  }
  {
    char* As = smem; float* red = (float*)(smem + 16 * 2064);
    const float* bgt = p.in[29];
    for (int u = blockIdx.x; u < T / 16; u += gridDim.x) {
      __syncthreads();
#pragma unroll
      for (int rr = 0; rr < 2; ++rr) {
        const int r = wv * 2 + rr; const u32x4* src = (const u32x4*)(hA + (size_t)(u * 16 + r) * D);
        const u32x4 v0 = src[lane], v1 = src[lane + 64];
        *(u32x4*)(As + r * 2064 + lane * 16) = v0; *(u32x4*)(As + r * 2064 + 1024 + lane * 16) = v1;
      }
      __syncthreads();
      f32x4 acc[2] = {(f32x4){0.f, 0.f, 0.f, 0.f}, (f32x4){0.f, 0.f, 0.f, 0.f}};
#pragma unroll
      for (int s4 = 0; s4 < 4; ++s4) {
        const int ks = wv * 4 + s4;
        const bf16x8 a = *(const bf16x8*)(As + fr * 2064 + (ks * 32 + fq * 8) * 2);
#pragma unroll
        for (int n = 0; n < 2; ++n) {
          const bf16x8 bb = *(const bf16x8*)(W + (size_t)(3072 + n * 16 + fr) * D + ks * 32 + fq * 8);
          acc[n] = __builtin_amdgcn_mfma_f32_16x16x32_bf16(a, bb, acc[n], 0, 0, 0);
        }
      }
#pragma unroll
      for (int n = 0; n < 2; ++n)
#pragma unroll
        for (int j = 0; j < 4; ++j) red[(wv * 16 + fq * 4 + j) * 32 + n * 16 + fr] = acc[n][j];
      __syncthreads();
      {
        const int row = tf >> 5, jj = tf & 31;
        float g = bgt[jj];
#pragma unroll
        for (int w = 0; w < 8; ++w) g += red[(w * 16 + row) * 32 + jj];
        gl[(size_t)(u * 16 + row) * 32 + jj] = ((jj >> 3) & 1) ? (fminf(g, 0.f) - log1pf(__expf(-fabsf(g)))) : g;
      }
    }
    __syncthreads();
  }
}

template <int WHICH>
DEV void ph_gemm_dense(const Params& p, char* smem) {
  pg8::StaticOrder S;
  LAS unsigned char* lds = (LAS unsigned char*)smem;
  if constexpr (WHICH == 0) {
    S.init(T, 2560, gridDim.x, blockIdx.x);
    EpiRgIn E{(bf16_t*)(p.ws + WS_GG), (bf16_t*)(p.ws + WS_PR)};
    pg8::gemm_phase<EpiRgIn, pg8::StaticOrder>(lds, pg8::Gemm{(const bf16_t*)(p.ws + WS_HA), (const bf16_t*)(p.ws + WS_WIN), T, 2560, 1024}, S, E, nullptr);
  } else if constexpr (WHICH == 1) {
    S.init(NL, 1024, gridDim.x, blockIdx.x);
    EpiOut<0> E{p.in[0], p.in[2], nullptr, (const float*)(p.ws + WS_MODS), (bf16_t*)(p.ws + WS_X1)};
    pg8::gemm_phase<EpiOut<0>, pg8::StaticOrder>(lds, pg8::Gemm{(const bf16_t*)(p.ws + WS_PR), (const bf16_t*)(p.ws + WS_WOUT), NL, 1024, 1280}, S, E, nullptr);
  } else if constexpr (WHICH == 2) {
    S.init(NL, 3072, gridDim.x, blockIdx.x);
    EpiMlIn E{(bf16_t*)(p.ws + WS_Q), (bf16_t*)(p.ws + WS_K), (bf16_t*)(p.ws + WS_KT), (bf16_t*)(p.ws + WS_VT), (bf16_t*)(p.ws + WS_OG)};
    pg8::gemm_phase<EpiMlIn, pg8::StaticOrder>(lds, pg8::Gemm{(const bf16_t*)(p.ws + WS_HA), (const bf16_t*)(p.ws + WS_WML), NL, 3072, 1024}, S, E, nullptr);
  } else {
    S.init(NL, 1024, gridDim.x, blockIdx.x);
    EpiOut<1> E{nullptr, nullptr, (const bf16_t*)(p.ws + WS_X2), (const float*)(p.ws + WS_MODS) + 2 * 6144, (bf16_t*)(p.ws + WS_X1)};
    pg8::gemm_phase<EpiOut<1>, pg8::StaticOrder>(lds, pg8::Gemm{(const bf16_t*)(p.ws + WS_HA), (const bf16_t*)(p.ws + WS_WMO), NL, 1024, 1024}, S, E, nullptr);
  }
}
template <int LAYER, int STAGE>
DEV void ph_gemm_moe(const Params& p, char* smem) {
  const int* cnt = (const int*)(p.ws + WS_CNT) + LAYER * 32 * CNT_STRIDE;
  moe_tables(cnt, smem, 4);
  MoeOrder S{(const int*)(smem + LDS_TB), 4, (int)gridDim.x, (int)blockIdx.x, (const int*)(p.ws + WS_ROWMAP)};
  LAS unsigned char* lds = (LAS unsigned char*)smem;
  if constexpr (STAGE == 0) {
    EpiMoe1 E{(bf16_t*)(p.ws + WS_HM)};
    pg8::gemm_phase_gather<EpiMoe1, MoeOrder>(lds, pg8::Gemm{(const bf16_t*)(p.ws + WS_HA), (const bf16_t*)(p.ws + WS_WGU), T, 32 * 1024, 1024}, S, E, nullptr);
  } else {
    EpiMoe2 E{(bf16_t*)(p.ws + WS_Y), (const float*)(p.ws + WS_AWP)};
    pg8::gemm_phase<EpiMoe2, MoeOrder>(lds, pg8::Gemm{(const bf16_t*)(p.ws + WS_HM), (const bf16_t*)(p.ws + WS_WD), MOE_ROWS, 32 * 1024, 512}, S, E, nullptr);
  }
}

template <int LAYER>
DEV void ph_scatter(const Params& p, char* smem, int bid, int nb) {
  const int tid = tidx(), lane = tid & 63, wave = tid >> 6;
  constexpr int NTOK = LAYER == 0 ? T : NL;
  constexpr int NU = NTOK / 16;
  int* cnt = (int*)(p.ws + WS_CNT) + LAYER * 32 * CNT_STRIDE;
  const int* eid = (const int*)(p.ws + WS_LIST); const int* hstg = eid + T;
  const float* aw = (const float*)(p.ws + WS_AW);
  int* pos = (int*)(p.ws + WS_POS); float* awp = (float*)(p.ws + WS_AWP);
  const bf16_t* hA = (const bf16_t*)(p.ws + WS_HA); bf16_t* Ab = (bf16_t*)(p.ws + WS_ABUF);
  int* part = (int*)smem;
  int* base = part + 512;
  int* dstl = base + 32;
  {
    const int e = tid & 31, pt = tid >> 5; int tot = 0, below = 0;
    for (int v = pt * (nb / 8); v < (pt + 1) * (nb / 8); ++v) { const int h = hstg[v * 32 + e]; tot += h; below += v < bid ? h : 0; }
    part[(pt * 32 + e) * 2] = tot; part[(pt * 32 + e) * 2 + 1] = below;
  }
  __syncthreads();
  if (tid == 0) {
    int o = 0;
    for (int e = 0; e < 32; ++e) {
      int tot = 0, below = 0;
      for (int pt = 0; pt < 8; ++pt) { tot += part[(pt * 32 + e) * 2]; below += part[(pt * 32 + e) * 2 + 1]; }
      base[e] = o + below; o += ((tot + 255) >> 8) << 8;
      if (bid == 0) cnt[e * CNT_STRIDE] = tot;
    }
    for (int it = 0; bid + it * nb < NU; ++it) {
      const int t0 = (bid + it * nb) * 16;
      for (int i = 0; i < 16; ++i) {
        const int ee = eid[t0 + i], ea = ee & 255, eb = ee >> 8;
        const int da = base[ea]++, db = base[eb]++;
        dstl[it * 32 + 2 * i] = da; dstl[it * 32 + 2 * i + 1] = db;
      }
    }
  }
  __syncthreads();
  for (int it = 0; bid + it * nb < NU; ++it) {
    const int t0 = (bid + it * nb) * 16;
    if (tid < 32) { const int d = dstl[it * 32 + tid]; pos[2 * t0 + tid] = d; awp[d] = aw[2 * t0 + tid]; }
#pragma unroll
    for (int hh = 0; hh < 2; ++hh) {
      u32x4 v0[4], v1[4];
#pragma unroll
      for (int q = 0; q < 4; ++q) { const int a = wave * 8 + hh * 4 + q; const u32x4* src = (const u32x4*)(hA + (size_t)(t0 + (a >> 1)) * D); v0[q] = src[lane]; v1[q] = src[lane + 64]; }
#pragma unroll
      for (int q = 0; q < 4; ++q) { const int a = wave * 8 + hh * 4 + q; u32x4* d = (u32x4*)(Ab + (size_t)dstl[it * 32 + a] * D); d[lane] = v0[q]; d[lane + 64] = v1[q]; }
    }
  }
  __syncthreads();
}

constexpr int RT_STRIDE = 2064;
constexpr int RT_H2 = 0, RT_LO = 16 * RT_STRIDE, RT_RED = 2 * 16 * RT_STRIDE, RT_SMEM = RT_RED + 4 * 16 * 48 * 4;
constexpr int R2_ASTR = 528;
constexpr int R2_AH = 0, R2_AL = 80 * R2_ASTR, R2_RSTD = 2 * 80 * R2_ASTR;
constexpr int R2_RED = 0, R2_LG = 8 * 80 * 48 * 4, R2_HIST = R2_LG + 80 * 48 * 4, R2_SMEM = R2_HIST + 128;
template <int LAYER>
DEV void ph_router2(const Params& p, char* smem) {
  const int tf = tidf(), lane = tf & 63, wv = tf >> 6, fr = lane & 15, fq = lane >> 4;
  const int b = blockIdx.x;
  const bool has_ctx = LAYER == 0 && b < 16;
  const int nrow = has_ctx ? 80 : 64, nmt = has_ctx ? 5 : 4;
  const float* mods = (const float*)(p.ws + WS_MODS) + LAYER * 2 * 6144;
  const bf16_t* x1 = (const bf16_t*)(p.ws + WS_X1);
  bf16_t* hA = (bf16_t*)(p.ws + WS_HA);
  const float* g2 = p.in[LAYER == 0 ? 7 : 27];
  const float* Bg = p.in[LAYER == 0 ? 18 : 33]; const float* Be = p.in[LAYER == 0 ? 20 : 35];
  int* eid = (int*)(p.ws + WS_LIST); int* hstg = eid + T; float* aw = (float*)(p.ws + WS_AW);
  char* AH = smem + R2_AH; char* AL = smem + R2_AL; float* rstd_s = (float*)(smem + R2_RSTD);
  float* red = (float*)(smem + R2_RED); float* lgt = (float*)(smem + R2_LG); int* hist = (int*)(smem + R2_HIST);
  auto tok_of = [&](int r) { return r < 64 ? b * 64 + r : NL + b * 16 + (r - 64); };
  if (tf < 32) hist[tf] = 0;
  for (int rb = 0; rb < nrow; rb += 32) {
    f32x4 v[4][4]; float ss[4];
#pragma unroll
    for (int q = 0; q < 4; ++q) {
      const int r = rb + wv + 8 * q; const int t = tok_of(r < nrow ? r : 0);
      const bf16_t* src = x1 + (size_t)t * D;
#pragma unroll
      for (int i = 0; i < 4; ++i) v[q][i] = ld_bf4(src + 4 * lane + 256 * i);
    }
#pragma unroll
    for (int q = 0; q < 4; ++q) {
      ss[q] = 0.f;
#pragma unroll
      for (int i = 0; i < 4; ++i) ss[q] += v[q][i].x * v[q][i].x + v[q][i].y * v[q][i].y + v[q][i].z * v[q][i].z + v[q][i].w * v[q][i].w;
      ss[q] = rsqrtf(wave_sum(ss[q]) * (1.f / D) + EPS);
    }
#pragma unroll
    for (int q = 0; q < 4; ++q) {
      const int r = rb + wv + 8 * q;
      if (r < nrow) {
        const int t = tok_of(r);
        const float* md = mods + ((LAYER == 0 && t >= NL) ? 6144 : 0);
        if (lane == 0) rstd_s[r] = ss[q];
#pragma unroll
        for (int i = 0; i < 4; ++i) {
          const int c = 4 * lane + 256 * i;
          const f32x4 g = *(const f32x4*)(g2 + c), sh = *(const f32x4*)(md + 3072 + c), sc = *(const f32x4*)(md + 4096 + c);
          const f32x4 h = v[q][i] * ss[q] * g * (1.f + sc) + sh;
          u32x2 o; o.x = pk2(h.x, h.y); o.y = pk2(h.z, h.w);
          *(u32x2*)(hA + (size_t)t * D + c) = o;
        }
      }
    }
  }
  __syncthreads();
  f32x4 acc[5][3];
#pragma unroll
  for (int m = 0; m < 5; ++m)
#pragma unroll
    for (int n = 0; n < 3; ++n) acc[m][n] = (f32x4){0.f, 0.f, 0.f, 0.f};
  const bf16_t* Wh = (const bf16_t*)(p.ws + WS_WR) + (size_t)(LAYER * 2) * 48 * 1024 + (size_t)fr * 1024 + fq * 8;
  const bf16_t* Wl = Wh + 48 * 1024;
#pragma unroll 1
  for (int c = 0; c < 4; ++c) {
    const int k = 256 * c + 4 * lane;
    const f32x4 g = *(const f32x4*)(g2 + k);
    f32x4 xv[10];
#pragma unroll
    for (int q = 0; q < 10; ++q) { const int r = wv + 8 * q; if (r < nrow) xv[q] = ld_bf4(x1 + (size_t)tok_of(r) * D + k); }
#pragma unroll
    for (int q = 0; q < 10; ++q) {
      const int r = wv + 8 * q;
      if (r < nrow) {
        const float* md = mods + ((LAYER == 0 && r >= 64) ? 6144 : 0);
        const f32x4 sh = *(const f32x4*)(md + 3072 + k), sc = *(const f32x4*)(md + 4096 + k);
        const f32x4 h = xv[q] * rstd_s[r] * g * (1.f + sc) + sh;
        u32x2 o; o.x = pk2(h.x, h.y); o.y = pk2(h.z, h.w);
        u32x2 l; l.x = pk2(h.x - bflo(o.x), h.y - bfhi(o.x)); l.y = pk2(h.z - bflo(o.y), h.w - bfhi(o.y));
        *(u32x2*)(AH + r * R2_ASTR + lane * 8) = o; *(u32x2*)(AL + r * R2_ASTR + lane * 8) = l;
      }
    }
    __syncthreads();
    bf16x8 bh[3], bl[3];
#pragma unroll
    for (int n = 0; n < 3; ++n) { bh[n] = *(const bf16x8*)(Wh + (size_t)n * 16 * 1024 + c * 256 + wv * 32); bl[n] = *(const bf16x8*)(Wl + (size_t)n * 16 * 1024 + c * 256 + wv * 32); }
#pragma unroll
    for (int m = 0; m < 5; ++m) {
      if (m < nmt) {
        const bf16x8 ah = *(const bf16x8*)(AH + (m * 16 + fr) * R2_ASTR + (wv * 32 + fq * 8) * 2), al = *(const bf16x8*)(AL + (m * 16 + fr) * R2_ASTR + (wv * 32 + fq * 8) * 2);
#pragma unroll
        for (int n = 0; n < 3; ++n) {
          acc[m][n] = __builtin_amdgcn_mfma_f32_16x16x32_bf16(al, bh[n], acc[m][n], 0, 0, 0);
          acc[m][n] = __builtin_amdgcn_mfma_f32_16x16x32_bf16(ah, bl[n], acc[m][n], 0, 0, 0);
          acc[m][n] = __builtin_amdgcn_mfma_f32_16x16x32_bf16(ah, bh[n], acc[m][n], 0, 0, 0);
        }
      }
    }
    __syncthreads();
  }
#pragma unroll
  for (int m = 0; m < 5; ++m)
    if (m < nmt) {
#pragma unroll
      for (int n = 0; n < 3; ++n)
#pragma unroll
        for (int j = 0; j < 4; ++j) red[(wv * 80 + m * 16 + fq * 4 + j) * 48 + n * 16 + fr] = acc[m][n][j];
    }
  __syncthreads();
  for (int i = tf; i < nrow * 48; i += 512) {
    float sm = 0.f;
#pragma unroll
    for (int w = 0; w < 8; ++w) sm += red[w * 80 * 48 + i];
    lgt[i] = sm;
  }
  __syncthreads();
  if (tf < nrow) {
    const int t = tok_of(tf);
    const float* lg = lgt + tf * 48;
    float gl[4];
#pragma unroll
    for (int i = 0; i < 4; ++i) gl[i] = lg[32 + i] + Bg[i];
    int grp = 0; float gm = gl[0];
#pragma unroll
    for (int i = 1; i < 4; ++i) if (gl[i] > gm) { gm = gl[i]; grp = i; }
    float den = 0.f;
#pragma unroll
    for (int i = 0; i < 4; ++i) den += __expf(gl[i] - gm);
    const float psel = 1.f / den;
    float v0 = -INFINITY, v1 = -INFINITY; int i0 = 0, i1 = 0;
    for (int i = 0; i < 8; ++i) {
      const float v = lg[grp * 8 + i] + Be[grp * 8 + i];
      if (v > v0) { v1 = v0; i1 = i0; v0 = v; i0 = i; }
      else if (v > v1) { v1 = v; i1 = i; }
    }
    const float e1 = __expf(v1 - v0);
    const float w0 = psel / (1.f + e1), w1 = psel * e1 / (1.f + e1);
    const int ea = grp * 8 + i0, eb = grp * 8 + i1;
    eid[t] = ea | (eb << 8);
    aw[2 * t] = w0; aw[2 * t + 1] = w1;
    atomicAdd(&hist[ea], 1); atomicAdd(&hist[eb], 1);
  }
  __syncthreads();
  if (tf < 32) hstg[b * 32 + tf] = hist[tf];
}

template <int LAYER>
DEV void ph_scatter2(const Params& p, char* smem) {
  const int tf = tidf(), lane = tf & 63, wv = tf >> 6;
  const int b = blockIdx.x, G = gridDim.x;
  const bool has_ctx = LAYER == 0 && b < 16;
  const int nrow = has_ctx ? 80 : 64;
  int* cnt = (int*)(p.ws + WS_CNT) + LAYER * 32 * CNT_STRIDE;
  const int* eid = (const int*)(p.ws + WS_LIST); const int* hstg = eid + T;
  const float* aw = (const float*)(p.ws + WS_AW);
  int* pos = (int*)(p.ws + WS_POS); float* awp = (float*)(p.ws + WS_AWP);
  const bf16_t* hA = (const bf16_t*)(p.ws + WS_HA); bf16_t* Ab = (bf16_t*)(p.ws + WS_ABUF);
  int* part = (int*)smem;
  int* base = part + 1024;
  int* dstl = base + 32;
  int* tots = dstl + 160;
  auto tok_of = [&](int r) { return r < 64 ? b * 64 + r : NL + b * 16 + (r - 64); };
  { const int e = tf & 31, pt = tf >> 5, per = (G + 15) / 16; int tot = 0, below = 0;
    for (int v = pt * per; v < (pt + 1) * per && v < G; ++v) { const int h = hstg[v * 32 + e]; tot += h; below += v < b ? h : 0; }
    part[(pt * 32 + e) * 2] = tot; part[(pt * 32 + e) * 2 + 1] = below; }
  __syncthreads();
  if (tf == 0) {
    int o = 0;
    for (int e = 0; e < 32; ++e) {
      int tot = 0, below = 0;
      for (int pt = 0; pt < 16; ++pt) { tot += part[(pt * 32 + e) * 2]; below += part[(pt * 32 + e) * 2 + 1]; }
      base[e] = o + below; tots[2 * e] = tot; o += ((tot + 255) >> 8) << 8;
      if (b == 0) cnt[e * CNT_STRIDE] = tot;
    }
    for (int r = 0; r < nrow; ++r) {
      const int ee = eid[tok_of(r)], ea = ee & 255, eb = ee >> 8;
      dstl[2 * r] = base[ea]++; dstl[2 * r + 1] = base[eb]++;
    }
  }
  __syncthreads();
  int* rowmap = (int*)(p.ws + WS_ROWMAP);
  if (tf < 2 * nrow) { const int t = tok_of(tf >> 1), d = dstl[tf]; pos[2 * t + (tf & 1)] = d; awp[d] = aw[2 * t + (tf & 1)]; rowmap[d] = t; }
  if (b < 32 && tf < 256) {
    int o = 0; for (int e = 0; e < b; ++e) o += ((tots[2 * e] + 255) >> 8) << 8;
    const int tot = tots[2 * b], r = o + tot + tf; if (r < o + (((tot + 255) >> 8) << 8)) { rowmap[r] = 0; awp[r] = 0.f; }
  }
  __syncthreads();
}

DEV void ph_combine0(const Params& p, int bid, int nb) {
  const int lane = tidx() & 63, wave = tidx() >> 6;
  const float* mods0 = (const float*)(p.ws + WS_MODS); const float* mods1 = mods0 + 2 * 6144;
  const bf16_t* x1 = (const bf16_t*)(p.ws + WS_X1); bf16_t* x2 = (bf16_t*)(p.ws + WS_X2);
  const bf16_t* Y = (const bf16_t*)(p.ws + WS_Y); const int* pos = (const int*)(p.ws + WS_POS);
  bf16_t* hA = (bf16_t*)(p.ws + WS_HA);
  const float* g1 = p.in[26];
  for (int t0 = (bid * 4 + wave) * 2; t0 < T; t0 += nb * 8) {
    f32x4 xv[2][4]; u32x2 ya[2][4], yb[2][4];
#pragma unroll
    for (int q = 0; q < 2; ++q) {
      const int t = t0 + q;
      const bf16_t* Ya = Y + (size_t)pos[2 * t] * D; const bf16_t* Yb = Y + (size_t)pos[2 * t + 1] * D;
#pragma unroll
      for (int i = 0; i < 4; ++i) { const int c = 4 * lane + 256 * i; xv[q][i] = ld_bf4(x1 + (size_t)t * D + c); ya[q][i] = *(const u32x2*)(Ya + c); yb[q][i] = *(const u32x2*)(Yb + c); }
    }
#pragma unroll
    for (int q = 0; q < 2; ++q) {
      const int t = t0 + q;
      const float* m0 = mods0 + (t < NL ? 0 : 6144); const float* m1 = mods1 + (t < NL ? 0 : 6144);
      const int orow = t < NL ? seqrow_of_token(t) : t;
      float ss = 0.f;
#pragma unroll
      for (int i = 0; i < 4; ++i) {
        const int c = 4 * lane + 256 * i;
        const f32x4 gt = *(const f32x4*)(m0 + 5120 + c);
        f32x4 f; f.x = bflo(ya[q][i].x) + bflo(yb[q][i].x); f.y = bfhi(ya[q][i].x) + bfhi(yb[q][i].x); f.z = bflo(ya[q][i].y) + bflo(yb[q][i].y); f.w = bfhi(ya[q][i].y) + bfhi(yb[q][i].y);
        xv[q][i] = xv[q][i] + gt * f;
        st_bf4(x2 + (size_t)t * D + c, xv[q][i]);
        ss += xv[q][i].x * xv[q][i].x + xv[q][i].y * xv[q][i].y + xv[q][i].z * xv[q][i].z + xv[q][i].w * xv[q][i].w;
      }
      const float rstd = rsqrtf(wave_sum(ss) * (1.f / D) + EPS);
#pragma unroll
      for (int i = 0; i < 4; ++i) {
        const int c = 4 * lane + 256 * i;
        const f32x4 g = *(const f32x4*)(g1 + c), sh = *(const f32x4*)(m1 + c), sc = *(const f32x4*)(m1 + 1024 + c);
        const f32x4 h = xv[q][i] * rstd * g * (1.f + sc) + sh;
        u32x2 o; o.x = pk2(h.x, h.y); o.y = pk2(h.z, h.w);
        *(u32x2*)(hA + (size_t)orow * D + c) = o;
      }
    }
  }
}

DEV void ml_gate_scans(const float* gl, int r0, int h, float* li_f, float* cf, float* li_b, float* cb) {
  const int tid = tidx(), lane = tid & 63, wave = tid >> 6;
  if (tid < 128) { li_f[tid] = gl[(size_t)(r0 + tid) * 32 + h]; li_b[tid] = gl[(size_t)(r0 + tid) * 32 + 16 + h]; }
  if (wave == 0) {
    const float v0 = gl[(size_t)(r0 + 2 * lane) * 32 + 8 + h], v1 = gl[(size_t)(r0 + 2 * lane + 1) * 32 + 8 + h];
    const float s = v0 + v1; float inc = s;
#pragma unroll
    for (int o = 1; o < 64; o <<= 1) { const float t = __shfl_up(inc, o); if (lane >= o) inc += t; }
    const float ex = inc - s;
    cf[2 * lane] = ex + v0; cf[2 * lane + 1] = ex + s;
  } else if (wave == 1) {
    const float v0 = gl[(size_t)(r0 + 127 - 2 * lane) * 32 + 24 + h], v1 = gl[(size_t)(r0 + 126 - 2 * lane) * 32 + 24 + h];
    const float s = v0 + v1; float inc = s;
#pragma unroll
    for (int o = 1; o < 64; o <<= 1) { const float t = __shfl_up(inc, o); if (lane >= o) inc += t; }
    const float ex = inc - s;
    cb[127 - 2 * lane] = ex + v0; cb[126 - 2 * lane] = ex + s;
  }
}

constexpr int MLA_STRIDE = 272;
constexpr int MLA_AW = 0, MLA_BV = 2 * 64 * MLA_STRIDE, MLA_G = MLA_BV + 128 * MLA_STRIDE, MLA_SMEM = MLA_G + 6 * 128 * 4;
DEV void ph_ml_state(const Params& p, char* smem, int bid, int nb) {
  const int tid = tidx(), lane = tid & 63, wave = tid >> 6, fr = lane & 15, fq = lane >> 4;
  const float* gl = (const float*)(p.ws + WS_GL);
  const bf16_t* kT = (const bf16_t*)(p.ws + WS_KT); const bf16_t* vT = (const bf16_t*)(p.ws + WS_VT);
  float* UT = (float*)(p.ws + WS_UT); float* nvec = (float*)(p.ws + WS_NVEC); float* dec = (float*)(p.ws + WS_DEC);
  char* Aw = smem + MLA_AW; char* Bv = smem + MLA_BV;
  float* li_f = (float*)(smem + MLA_G); float* cf = li_f + 128; float* li_b = cf + 128; float* cb = li_b + 128; float* wf = cb + 128; float* wb = wf + 128;
  for (int it = 0, iters = (NTILE * 8 + nb - 1) / nb; it < iters; ++it) {
    int u = bid + it * nb; const bool active = u < NTILE * 8; if (!active) u = NTILE * 8 - 1;
    const int h = u % 8, c = u / 8, r0 = c * 128;
    __syncthreads();
    if (active) {
    ml_gate_scans(gl, r0, h, li_f, cf, li_b, cb);
    }
    __syncthreads();
    if (active) {
    if (tid < 128) { wf[tid] = __expf(cf[127] - cf[tid] + li_f[tid]); wb[tid] = __expf(cb[0] - cb[tid] + li_b[tid]); }
    if (tid == 0) { dec[(c * 8 + h) * 2] = __expf(cf[127]); dec[(c * 8 + h) * 2 + 1] = __expf(cb[0]); }
#pragma unroll
    for (int i = 0; i < 8; ++i) {
      const int f = tid + 256 * i, e = f >> 4, pc = f & 15;
      *(u32x4*)(Bv + e * MLA_STRIDE + pc * 16) = *(const u32x4*)(vT + (size_t)(h * 128 + e) * T + r0 + pc * 8);
    }
    }
    __syncthreads();
    if (active) {
#pragma unroll
    for (int i = 0; i < 4; ++i) {
      const int f = tid + 256 * i, d = f >> 4, pc = f & 15;
      const u32x4 kv = *(const u32x4*)(kT + (size_t)(h * 64 + d) * T + r0 + pc * 8);
      float k8[8] = {bflo(kv.x), bfhi(kv.x), bflo(kv.y), bfhi(kv.y), bflo(kv.z), bfhi(kv.z), bflo(kv.w), bfhi(kv.w)};
      u32x4 of, ob;
      of.x = pk2(k8[0] * wf[pc * 8 + 0], k8[1] * wf[pc * 8 + 1]); of.y = pk2(k8[2] * wf[pc * 8 + 2], k8[3] * wf[pc * 8 + 3]);
      of.z = pk2(k8[4] * wf[pc * 8 + 4], k8[5] * wf[pc * 8 + 5]); of.w = pk2(k8[6] * wf[pc * 8 + 6], k8[7] * wf[pc * 8 + 7]);
      ob.x = pk2(k8[0] * wb[pc * 8 + 0], k8[1] * wb[pc * 8 + 1]); ob.y = pk2(k8[2] * wb[pc * 8 + 2], k8[3] * wb[pc * 8 + 3]);
      ob.z = pk2(k8[4] * wb[pc * 8 + 4], k8[5] * wb[pc * 8 + 5]); ob.w = pk2(k8[6] * wb[pc * 8 + 6], k8[7] * wb[pc * 8 + 7]);
      *(u32x4*)(Aw + d * MLA_STRIDE + pc * 16) = of;
      *(u32x4*)(Aw + (64 + d) * MLA_STRIDE + pc * 16) = ob;
    }
    }
    __syncthreads();
    if (active) {
    if (tid < 128) {
      float s = 0.f;
      for (int pc = 0; pc < 16; ++pc) { const u32x4 v = *(const u32x4*)(Aw + tid * MLA_STRIDE + pc * 16);
        s += (bflo(v.x) + bfhi(v.x)) + (bflo(v.y) + bfhi(v.y)) + (bflo(v.z) + bfhi(v.z)) + (bflo(v.w) + bfhi(v.w)); }
      nvec[(size_t)((c * 8 + h) * 2 + (tid >> 6)) * 64 + (tid & 63)] = s;
    }
#pragma unroll
    for (int dir = 0; dir < 2; ++dir) {
      f32x4 acc[4][2];
#pragma unroll
      for (int m = 0; m < 4; ++m) { acc[m][0] = (f32x4){0.f, 0.f, 0.f, 0.f}; acc[m][1] = (f32x4){0.f, 0.f, 0.f, 0.f}; }
#pragma unroll
      for (int ks = 0; ks < 4; ++ks) {
        bf16x8 b[2];
#pragma unroll
        for (int n = 0; n < 2; ++n) b[n] = *(const bf16x8*)(Bv + (wave * 32 + n * 16 + fr) * MLA_STRIDE + (ks * 32 + fq * 8) * 2);
#pragma unroll
        for (int m = 0; m < 4; ++m) {
          const bf16x8 a = *(const bf16x8*)(Aw + (dir * 64 + m * 16 + fr) * MLA_STRIDE + (ks * 32 + fq * 8) * 2);
          acc[m][0] = __builtin_amdgcn_mfma_f32_16x16x32_bf16(a, b[0], acc[m][0], 0, 0, 0);
          acc[m][1] = __builtin_amdgcn_mfma_f32_16x16x32_bf16(a, b[1], acc[m][1], 0, 0, 0);
        }
      }
      float* Uo = UT + (size_t)((c * 8 + h) * 2 + dir) * 8192;
#pragma unroll
      for (int m = 0; m < 4; ++m)
#pragma unroll
        for (int n = 0; n < 2; ++n) *(f32x4*)(Uo + (wave * 32 + n * 16 + fr) * 64 + m * 16 + fq * 4) = acc[m][n];
    }
    }
  }
}

DEV void ph_ml_chain(const Params& p, int bid, int nb) {
  float* UT = (float*)(p.ws + WS_UT); float* nvec = (float*)(p.ws + WS_NVEC); const float* dec = (const float*)(p.ws + WS_DEC);
  const int total = 16 * (8192 + 64);
  for (int i = bid * 256 + tidx(); i < total; i += nb * 256) {
    const int hd = i / 8256, idx = i % 8256;
    const int dir = hd & 1;
    float* base = idx < 8192 ? UT + (size_t)hd * 8192 + idx : nvec + (size_t)hd * 64 + (idx - 8192);
    const size_t cstride = idx < 8192 ? (size_t)16 * 8192 : (size_t)16 * 64;
    float st = 0.f;
#pragma unroll 1
    for (int sb = 0; sb < NTILE; sb += 13) {
      float uv[13], dc[13];
#pragma unroll
      for (int j = 0; j < 13; ++j) {
        const int s = sb + j; const int c = dir == 0 ? (s < 2 ? 128 + s : s - 2) : 129 - s;
        uv[j] = base[(size_t)c * cstride]; dc[j] = dec[c * 16 + hd];
      }
#pragma unroll
      for (int j = 0; j < 13; ++j) {
        const int s = sb + j; const int c = dir == 0 ? (s < 2 ? 128 + s : s - 2) : 129 - s;
        base[(size_t)c * cstride] = st;
        st = dc[j] * st + uv[j];
      }
    }
  }
}

constexpr int MLC_QS = 0;
constexpr int MLC_KS = 9216;
constexpr int MLC_Q2 = MLC_KS + 18432;
constexpr int MLC_BS = MLC_Q2 + 17408;
constexpr int MLC_G  = MLC_BS + 18432;
constexpr int MLC_SMEM = MLC_G + (4 * 128 + 6 * 64) * 4;
DEV void ph_ml_out(const Params& p, char* smem, int bid, int nb) {
  const int tid = tidx(), lane = tid & 63, wave = tid >> 6, fr = lane & 15, fq = lane >> 4;
  const float* gl = (const float*)(p.ws + WS_GL);
  const bf16_t* qb = (const bf16_t*)(p.ws + WS_Q); const bf16_t* kb = (const bf16_t*)(p.ws + WS_K); const bf16_t* vT = (const bf16_t*)(p.ws + WS_VT);
  const bf16_t* og = (const bf16_t*)(p.ws + WS_OG);
  const float* UT = (const float*)(p.ws + WS_UT); const float* nvec = (const float*)(p.ws + WS_NVEC);
  bf16_t* yA = (bf16_t*)(p.ws + WS_HA);
  const float* ng = p.in[30];
  char* Qs = smem + MLC_QS; char* Ks = smem + MLC_KS; char* Ps = Ks; char* Q2 = smem + MLC_Q2; char* Bs = smem + MLC_BS;
  float* li_f = (float*)(smem + MLC_G); float* cf = li_f + 128; float* li_b = cf + 128; float* cb = li_b + 128;
  float* qn = cb + 128; float* sfq = qn + 128; float* sbq = sfq + 64; float* nv = sbq + 64;
  for (int it = 0, iters = ((128 * 2 * 8) + nb - 1) / nb; it < iters; ++it) {
    int u = bid + it * nb; const bool active = u < (128 * 2 * 8); if (!active) u = (128 * 2 * 8) - 1;
    const int h = u % 8, th = (u / 8) & 1, c = u / 16, r0 = c * 128, rt = r0 + th * 64;
    __syncthreads();
    ml_gate_scans(gl, r0, h, li_f, cf, li_b, cb);
    if (tid >= 128) nv[tid - 128] = nvec[(size_t)((c * 8 + h) * 2 + ((tid - 128) >> 6)) * 64 + (tid & 63)];
#pragma unroll
    for (int i = 0; i < 2; ++i) { const int f = tid + 256 * i, r = f >> 3, pc = f & 7;
      *(u32x4*)(Qs + r * 144 + pc * 16) = *(const u32x4*)(qb + (size_t)(rt + r) * 512 + h * 64 + pc * 8); }
#pragma unroll
    for (int i = 0; i < 4; ++i) { const int f = tid + 256 * i, r = f >> 3, pc = f & 7;
      *(u32x4*)(Ks + r * 144 + pc * 16) = *(const u32x4*)(kb + (size_t)(r0 + r) * 512 + h * 64 + pc * 8); }
    __syncthreads();
    if (tid < 128) {
      const int t = tid & 63, dir = tid >> 6; float s = 0.f;
      for (int pc = 0; pc < 8; ++pc) { const u32x4 v = *(const u32x4*)(Qs + t * 144 + pc * 16); const float* nn = nv + dir * 64 + pc * 8;
        s += bflo(v.x) * nn[0] + bfhi(v.x) * nn[1] + bflo(v.y) * nn[2] + bfhi(v.y) * nn[3] + bflo(v.z) * nn[4] + bfhi(v.z) * nn[5] + bflo(v.w) * nn[6] + bfhi(v.w) * nn[7]; }
      qn[dir * 64 + t] = s;
    }
    f32x4 S[8];
#pragma unroll
    for (int n = 0; n < 8; ++n) S[n] = (f32x4){0.f, 0.f, 0.f, 0.f};
#pragma unroll
    for (int ks = 0; ks < 2; ++ks) {
      const bf16x8 a = *(const bf16x8*)(Qs + (wave * 16 + fr) * 144 + (ks * 32 + fq * 8) * 2);
#pragma unroll
      for (int n = 0; n < 8; ++n) {
        const bf16x8 b = *(const bf16x8*)(Ks + (n * 16 + fr) * 144 + (ks * 32 + fq * 8) * 2);
        S[n] = __builtin_amdgcn_mfma_f32_16x16x32_bf16(a, b, S[n], 0, 0, 0);
      }
    }
    __syncthreads();
    float rfv[4], rbv[4];
    {
      float sumf[4] = {0.f, 0.f, 0.f, 0.f}, sumb[4] = {0.f, 0.f, 0.f, 0.f};
      float Sf[8][4], Sb_[8][4];
#pragma unroll
      for (int j = 0; j < 4; ++j) {
        const int tl = wave * 16 + fq * 4 + j, tc = th * 64 + tl;
        const float cft = cf[tc], cbt = cb[tc];
#pragma unroll
        for (int n = 0; n < 8; ++n) {
          const int s = n * 16 + fr;
          const float df = s <= tc ? fexp_(cft - cf[s] + li_f[s]) : 0.f;
          const float db = s >= tc ? fexp_(cbt - cb[s] + li_b[s]) : 0.f;
          Sf[n][j] = S[n][j] * df; Sb_[n][j] = S[n][j] * db;
          sumf[j] += Sf[n][j]; sumb[j] += Sb_[n][j];
        }
      }
#pragma unroll
      for (int j = 0; j < 4; ++j) {
#pragma unroll
        for (int o = 1; o < 16; o <<= 1) { sumf[j] += __shfl_xor(sumf[j], o); sumb[j] += __shfl_xor(sumb[j], o); }
        const int tl = wave * 16 + fq * 4 + j, tc = th * 64 + tl;
        const float ef = __expf(cf[tc]), eb = __expf(cb[tc]);
        const float denf = ef * qn[tl] + sumf[j], denb = eb * qn[64 + tl] + sumb[j];
        rfv[j] = __builtin_amdgcn_rcpf(fmaxf(fabsf(denf), 1.f)); rbv[j] = __builtin_amdgcn_rcpf(fmaxf(fabsf(denb), 1.f));
        if (fr == 0) { sfq[tl] = ef * rfv[j]; sbq[tl] = eb * rbv[j]; }
      }
#pragma unroll
      for (int n = 0; n < 8; ++n)
#pragma unroll
        for (int j = 0; j < 4; ++j) {
          const int tl = wave * 16 + fq * 4 + j;
          *(bf16_t*)(Ps + tl * MLA_STRIDE + (n * 16 + fr) * 2) = f2bf(Sf[n][j] * rfv[j] + Sb_[n][j] * rbv[j]);
        }
    }
    __syncthreads();
#pragma unroll
    for (int i = 0; i < 2; ++i) { const int f = tid + 256 * i, r = f >> 3, pc = f & 7;
      const u32x4 v = *(const u32x4*)(Qs + r * 144 + pc * 16); const float a = sfq[r], b = sbq[r];
      u32x4 o1, o2;
      o1.x = pk2(bflo(v.x) * a, bfhi(v.x) * a); o1.y = pk2(bflo(v.y) * a, bfhi(v.y) * a); o1.z = pk2(bflo(v.z) * a, bfhi(v.z) * a); o1.w = pk2(bflo(v.w) * a, bfhi(v.w) * a);
      o2.x = pk2(bflo(v.x) * b, bfhi(v.x) * b); o2.y = pk2(bflo(v.y) * b, bfhi(v.y) * b); o2.z = pk2(bflo(v.z) * b, bfhi(v.z) * b); o2.w = pk2(bflo(v.w) * b, bfhi(v.w) * b);
      *(u32x4*)(Q2 + r * MLA_STRIDE + pc * 16) = o1; *(u32x4*)(Q2 + r * MLA_STRIDE + 128 + pc * 16) = o2; }
    f32x4 Hh[8];
#pragma unroll
    for (int n = 0; n < 8; ++n) Hh[n] = (f32x4){0.f, 0.f, 0.f, 0.f};
#pragma unroll
    for (int kc = 0; kc < 4; ++kc) {
      __syncthreads();
      if (kc < 2) {
#pragma unroll
        for (int i = 0; i < 4; ++i) { const int f = tid + 256 * i, e = f >> 3, pc = f & 7;
          *(u32x4*)(Bs + e * 144 + pc * 16) = *(const u32x4*)(vT + (size_t)(h * 128 + e) * T + r0 + kc * 64 + pc * 8); }
      } else {
        const float* Cs = UT + (size_t)((c * 8 + h) * 2 + (kc - 2)) * 8192;
#pragma unroll
        for (int i = 0; i < 4; ++i) { const int f = tid + 256 * i, e = f >> 3, pc = f & 7;
          const f32x4 a = *(const f32x4*)(Cs + e * 64 + pc * 8), b = *(const f32x4*)(Cs + e * 64 + pc * 8 + 4);
          u32x4 o; o.x = pk2(a.x, a.y); o.y = pk2(a.z, a.w); o.z = pk2(b.x, b.y); o.w = pk2(b.z, b.w);
          *(u32x4*)(Bs + e * 144 + pc * 16) = o; }
      }
      __syncthreads();
      const char* Asrc = kc < 2 ? Ps + kc * 128 : Q2 + (kc - 2) * 128;
#pragma unroll
      for (int ks = 0; ks < 2; ++ks) {
        const bf16x8 a = *(const bf16x8*)(Asrc + (wave * 16 + fr) * MLA_STRIDE + (ks * 32 + fq * 8) * 2);
#pragma unroll
        for (int n = 0; n < 8; ++n) {
          const bf16x8 b = *(const bf16x8*)(Bs + (n * 16 + fr) * 144 + (ks * 32 + fq * 8) * 2);
          Hh[n] = __builtin_amdgcn_mfma_f32_16x16x32_bf16(a, b, Hh[n], 0, 0, 0);
        }
      }
    }
#pragma unroll
    for (int j = 0; j < 4; ++j) {
      float ss = 0.f;
#pragma unroll
      for (int n = 0; n < 8; ++n) ss += Hh[n][j] * Hh[n][j];
#pragma unroll
      for (int o = 1; o < 16; o <<= 1) ss += __shfl_xor(ss, o);
      const float rstd = rsqrtf(ss * (1.f / 128.f) + EPS);
      const size_t row = (size_t)(rt + wave * 16 + fq * 4 + j);
#pragma unroll
      for (int n = 0; n < 8; ++n) {
        const int col = h * 128 + n * 16 + fr;
        yA[row * D + col] = f2bf(Hh[n][j] * rstd * ng[col] * bf2f(og[row * D + col]));
      }
    }
  }
}

DEV void ph_final(const Params& p, int bid, int nb) {
  const int lane = tidx() & 63, wave = tidx() >> 6;
  const float* mods1 = (const float*)(p.ws + WS_MODS) + 2 * 6144;
  const bf16_t* x1 = (const bf16_t*)(p.ws + WS_X1);
  const bf16_t* Y = (const bf16_t*)(p.ws + WS_Y); const int* pos = (const int*)(p.ws + WS_POS);
  const float* gf = p.in[39];
  for (int t0 = (bid * 4 + wave) * 2; t0 < NL; t0 += nb * 8) {
    f32x4 xv[2][4]; u32x2 ya[2][4], yb[2][4];
#pragma unroll
    for (int q = 0; q < 2; ++q) {
      const int t = t0 + q;
      const bf16_t* Ya = Y + (size_t)pos[2 * t] * D; const bf16_t* Yb = Y + (size_t)pos[2 * t + 1] * D;
#pragma unroll
      for (int i = 0; i < 4; ++i) { const int c = 4 * lane + 256 * i; xv[q][i] = ld_bf4(x1 + (size_t)t * D + c); ya[q][i] = *(const u32x2*)(Ya + c); yb[q][i] = *(const u32x2*)(Yb + c); }
    }
#pragma unroll
    for (int q = 0; q < 2; ++q) {
      const int t = t0 + q;
      float ss = 0.f;
#pragma unroll
      for (int i = 0; i < 4; ++i) {
        const int c = 4 * lane + 256 * i;
        const f32x4 gt = *(const f32x4*)(mods1 + 5120 + c);
        f32x4 f; f.x = bflo(ya[q][i].x) + bflo(yb[q][i].x); f.y = bfhi(ya[q][i].x) + bfhi(yb[q][i].x); f.z = bflo(ya[q][i].y) + bflo(yb[q][i].y); f.w = bfhi(ya[q][i].y) + bfhi(yb[q][i].y);
        xv[q][i] = xv[q][i] + gt * f;
        ss += xv[q][i].x * xv[q][i].x + xv[q][i].y * xv[q][i].y + xv[q][i].z * xv[q][i].z + xv[q][i].w * xv[q][i].w;
      }
      const float rstd = rsqrtf(wave_sum(ss) * (1.f / D) + EPS);
#pragma unroll
      for (int i = 0; i < 4; ++i) {
        const int c = 4 * lane + 256 * i;
        *(f32x4*)(p.out + (size_t)t * D + c) = xv[q][i] * rstd * *(const f32x4*)(gf + c);
      }
    }
  }
}

#define XB_TMO      128
#define XB_XCNT(j)  (256  + 64 * (j))
#define XB_XSUB(j)  (1280 + 64 * (j))
#define XB_XGEN(j)  (2304 + 64 * (j))
#define XB_TOP      3328
#define XB_TOPGEN   3392
#define XCD_BAR_WORDS 3456
#define XB_SPIN_CAP (1u << 22)
DEV unsigned xb_ld(unsigned* p)              { return __hip_atomic_load(p, __ATOMIC_RELAXED, __HIP_MEMORY_SCOPE_AGENT); }
DEV unsigned xb_add(unsigned* p, unsigned v) { return __hip_atomic_fetch_add(p, v, __ATOMIC_RELAXED, __HIP_MEMORY_SCOPE_AGENT); }
DEV unsigned xb_xcc_id() { return (unsigned)__builtin_amdgcn_s_getreg((3 << 11) | 20) & 0xFu; }
#define XB_SPIN(cond, bar) do { unsigned _sp = 0; while (cond) { __builtin_amdgcn_s_sleep(1); \
    if ((++_sp & 255u) == 0u) { if (xb_ld(&(bar)[XB_TMO])) break; if (_sp > XB_SPIN_CAP) { atomicAdd(&(bar)[XB_TMO], 1u); break; } } } } while (0)
struct XcdBarrier { unsigned* bar; unsigned x; volatile LAS unsigned* st; };
DEV XcdBarrier xcd_barrier_post(unsigned* bar, volatile LAS unsigned* st) {
  XcdBarrier b; b.bar = bar; b.x = xb_xcc_id(); b.st = st;
  if (threadIdx.x == 0) (void)xb_add(&bar[XB_XCNT(b.x)], 1u);
  return b;
}
DEV void xcd_barrier_complete(unsigned* bar, unsigned x, unsigned& nloc, unsigned& nx) {
  const unsigned G = gridDim.x * gridDim.y * gridDim.z;
  unsigned sum, cnt, mine, sp = 0u;
  for (;;) {
    sum = 0u; cnt = 0u; mine = 0u;
#pragma unroll
    for (unsigned j = 0; j < 16; ++j) { const unsigned c = xb_ld(&bar[XB_XCNT(j)]); sum += c; cnt += (c > 0u) ? 1u : 0u; mine = (j == x) ? c : mine; }
    if (sum == G) break;
    __builtin_amdgcn_s_sleep(1);
    if ((++sp & 255u) == 0u) { if (xb_ld(&bar[XB_TMO])) break; if (sp > XB_SPIN_CAP) { atomicAdd(&bar[XB_TMO], 1u); break; } }
  }
  nloc = mine > 0u ? mine : 1u; nx = cnt > 0u ? cnt : 1u;
}
DEV void xcd_barrier(const XcdBarrier& b) {
  asm volatile("s_waitcnt vmcnt(0)" ::: "memory");
  __syncthreads();
  if (threadIdx.x == 0) {
    unsigned* bar = b.bar;
    __builtin_amdgcn_s_waitcnt(0);
    unsigned nloc = b.st[0], nx = b.st[1];
    if (nloc == 0u) { xcd_barrier_complete(bar, b.x, nloc, nx); b.st[0] = nloc; b.st[1] = nx; }
    const unsigned old = xb_add(&bar[XB_XSUB(b.x)], 1u);
    const unsigned gen = old / nloc;
    if (old + 1u == (gen + 1u) * nloc) {
      __builtin_amdgcn_fence(__ATOMIC_RELEASE, "agent");
      asm volatile("s_waitcnt vmcnt(0)" ::: "memory");
      const unsigned og = xb_add(&bar[XB_TOP], 1u);
      const unsigned tg = og / nx;
      if (og + 1u == (tg + 1u) * nx) xb_add(&bar[XB_TOPGEN], 1u);
      else XB_SPIN(xb_ld(&bar[XB_TOPGEN]) == tg, bar);
      __builtin_amdgcn_fence(__ATOMIC_ACQUIRE, "agent");
      xb_add(&bar[XB_XGEN(b.x)], 1u);
      asm volatile("s_waitcnt vmcnt(0)" ::: "memory");
    } else {
      XB_SPIN(xb_ld(&bar[XB_XGEN(b.x)]) == gen, bar);
      __builtin_amdgcn_fence(__ATOMIC_ACQUIRE, "agent");
      asm volatile("s_waitcnt vmcnt(0)" ::: "memory");
    }
  }
  __syncthreads();
}

#ifndef REP_MASK
#define REP_MASK 0u
#endif
#ifndef PROBE_PH
#define PROBE_PH -1
#endif
#ifndef PROBE_M
#define PROBE_M 4
#endif
#ifndef XBAR
#define XBAR 0
#endif
constexpr int NPHASE = 22;
constexpr int HALF_SMEM = 78592;
constexpr int LDS_ST = 2 * HALF_SMEM;
constexpr int LDS_BYTES = LDS_ST + 16 + 32;
static_assert(RT_SMEM + 128 <= HALF_SMEM && RG_SMEM <= HALF_SMEM && MLA_SMEM <= HALF_SMEM && MLC_SMEM <= HALF_SMEM, "smem");
static_assert(LDS_TB + 66 * 4 <= LDS_ST && 8 * 8448 <= LDS_ST, "smem");

template <int PH>
DEV void run_phase(const Params& p, char* smem) {
  int half = threadIdx.x >> 8; asm volatile("" : "+v"(half)); half = __builtin_amdgcn_readfirstlane(half);
  char* hs = smem + half * HALF_SMEM;
  const int vb = blockIdx.x * 2 + half, nvb = gridDim.x * 2;
  if constexpr (PH == 0) { ph_adaln(p, hs, vb, nvb); __syncthreads(); ph_convert_dense(p, smem); ph_convert_moe<0>(p, smem); }
  else if constexpr (PH == 1) ph_norm0(p, vb, nvb);
  else if constexpr (PH == 2) ph_gemm_dense<0>(p, smem);
  else if constexpr (PH == 3) ph_rg_scan2(p, smem);
  else if constexpr (PH == 4) ph_rg_carry(p, hs, vb, nvb);
  else if constexpr (PH == 5) ph_rg_final(p, vb, nvb);
  else if constexpr (PH == 6) { ph_out0_ctx(p, smem); ph_gemm_dense<1>(p, smem); }
  else if constexpr (PH == 7) ph_router2<0>(p, smem);
  else if constexpr (PH == 8) ph_scatter2<0>(p, smem);
  else if constexpr (PH == 9) ph_gemm_moe<0, 0>(p, smem);
  else if constexpr (PH == 10) ph_gemm_moe<0, 1>(p, smem);
  else if constexpr (PH == 11) { ph_combine0(p, vb, nvb); ph_convert_moe<1>(p, smem); }
  else if constexpr (PH == 12) { ph_mlin_small(p, smem); ph_gemm_dense<2>(p, smem); }
  else if constexpr (PH == 13) ph_ml_state(p, hs, vb, nvb);
  else if constexpr (PH == 14) ph_ml_chain(p, vb, nvb);
  else if constexpr (PH == 15) ph_ml_out(p, hs, vb, nvb);
  else if constexpr (PH == 16) ph_gemm_dense<3>(p, smem);
  else if constexpr (PH == 17) ph_router2<1>(p, smem);
  else if constexpr (PH == 18) ph_scatter2<1>(p, smem);
  else if constexpr (PH == 19) ph_gemm_moe<1, 0>(p, smem);
  else if constexpr (PH == 20) ph_gemm_moe<1, 1>(p, smem);
  else if constexpr (PH == 21) ph_final(p, vb, nvb);
}

template <int PH>
DEV void run_from(const Params& p, char* smem) {
  run_phase<PH>(p, smem);
  if constexpr ((REP_MASK >> PH) & 1u) {
    __syncthreads();
    run_phase<PH>(p, smem);
  }
  if constexpr (XBAR > 0 && PH + 1 < NPHASE) {
#pragma unroll 1
    for (int xi = 0; xi < XBAR; ++xi) { XcdBarrier xb; xb.bar = (unsigned*)(p.ws + WS_BAR); xb.x = xb_xcc_id(); xb.st = (volatile LAS unsigned*)(LAS char*)(smem + LDS_ST); xcd_barrier(xb); }
  }
  if constexpr (PH + 1 < NPHASE) {
    XcdBarrier xb; xb.bar = (unsigned*)(p.ws + WS_BAR); xb.x = xb_xcc_id(); xb.st = (volatile LAS unsigned*)(LAS char*)(smem + LDS_ST);
    xcd_barrier(xb);
    if constexpr (PROBE_PH >= 0 && (PH == PROBE_PH || PH + 1 == PROBE_PH)) {
      if (blockIdx.x == 0 && threadIdx.x == 0) { volatile LAS unsigned long long* ts = (volatile LAS unsigned long long*)(LAS char*)(smem + LDS_ST + 16); ts[PH == PROBE_PH ? 1 : 0] = __builtin_amdgcn_s_memrealtime(); }
    }
    run_from<PH + 1>(p, smem);
  } else if constexpr (PROBE_PH >= 0) {
    if (blockIdx.x == 0 && threadIdx.x == 0) {
      volatile LAS unsigned long long* ts = (volatile LAS unsigned long long*)(LAS char*)(smem + LDS_ST + 16);
      const unsigned long long now = __builtin_amdgcn_s_memrealtime();
      const unsigned long long t1 = PROBE_PH == NPHASE - 1 ? now : ts[1];
      const unsigned long long span = (t1 - ts[0]) * PROBE_M;
      while (__builtin_amdgcn_s_memrealtime() - now < span) __builtin_amdgcn_s_sleep(8);
    }
  }
}

__global__ void __launch_bounds__(512) mega_kernel(Params p) {
  extern __shared__ __attribute__((aligned(16))) char smem[];
  volatile LAS unsigned* st = (volatile LAS unsigned*)(LAS char*)(smem + LDS_ST);
  if (threadIdx.x == 0) { st[0] = 0u; st[1] = 0u; st[2] = 0u; st[3] = 0u; }
  __syncthreads();
  (void)xcd_barrier_post((unsigned*)(p.ws + WS_BAR), st);
  if (PROBE_PH == 0 && blockIdx.x == 0 && threadIdx.x == 0) { volatile LAS unsigned long long* ts = (volatile LAS unsigned long long*)(LAS char*)(smem + LDS_ST + 16); ts[0] = __builtin_amdgcn_s_memrealtime(); }
  run_from<0>(p, smem);
}

extern "C" void kernel_launch(void* const* d_in, const int* in_sizes, int n_in, void* d_out, int out_size, void* d_ws, size_t ws_size, hipStream_t stream) {
  static int grid = 0;
  if (grid == 0) {
    if (n_in != 40 || ws_size < WS_END) { fprintf(stderr, "kernel_launch: unexpected inputs (n_in %d, ws %zu, need %zu)\n", n_in, ws_size, (size_t)WS_END); grid = -1; return; }
    int dev = 0, cus = 0, per_cu = 0;
    if (hipGetDevice(&dev) != hipSuccess || hipDeviceGetAttribute(&cus, hipDeviceAttributeMultiprocessorCount, dev) != hipSuccess) { grid = -1; return; }
    if (hipFuncSetAttribute((const void*)mega_kernel, hipFuncAttributeMaxDynamicSharedMemorySize, LDS_BYTES) != hipSuccess) { fprintf(stderr, "kernel_launch: hipFuncSetAttribute failed\n"); grid = -1; return; }
    if (hipOccupancyMaxActiveBlocksPerMultiprocessor(&per_cu, (const void*)mega_kernel, 512, LDS_BYTES) != hipSuccess || per_cu < 1) { fprintf(stderr, "kernel_launch: occupancy query failed (%d)\n", per_cu); grid = -1; return; }
    grid = cus;
    fprintf(stderr, "kernel_launch: %d CUs, occupancy %d\n", cus, per_cu);
  }
  if (grid < 0) return;
  Params p{};
  for (int i = 0; i < 40; ++i) p.in[i] = (const float*)d_in[i];
  p.out = (float*)d_out; p.ws = (char*)d_ws;
  if (hipMemsetAsync((char*)d_ws, 0, WS_ZERO_BYTES, stream) != hipSuccess) return;
  void* args[] = {&p};
  hipError_t e = hipLaunchCooperativeKernel((const void*)mega_kernel, dim3(grid), dim3(512), args, LDS_BYTES, stream);
  if (e != hipSuccess) fprintf(stderr, "cooperative launch failed: %s (grid %d)\n", hipGetErrorString(e), grid);
}
```

```cpp
#include <hip/hip_runtime.h>
#include <cstdio>
#include <cstdint>

#define DEV __device__ __forceinline__
typedef unsigned short bf16_t;
typedef short bf16x8 __attribute__((ext_vector_type(8)));
typedef short s16x4 __attribute__((ext_vector_type(4)));
typedef float f32x4 __attribute__((ext_vector_type(4)));
typedef unsigned u32x4 __attribute__((ext_vector_type(4)));
typedef unsigned u32x2 __attribute__((ext_vector_type(2)));
#define LAS __attribute__((address_space(3)))

constexpr int D = 1024, NL = 16384, NC = 256, T = NL + NC, NTILE = T / 128;
constexpr int DR = 1280, NEXP = 32, DE = 512;
constexpr int RGT = 64, NRT = T / RGT, NRT_LAT = NL / RGT;
constexpr int MLW = 3104, MLWP = 3328;
constexpr int MOE_ROWS = 41472;
constexpr float EPS = 1e-6f;

constexpr size_t al256(size_t x) { return (x + 255) & ~(size_t)255; }
constexpr size_t WS_BAR   = 0;
constexpr size_t WS_CNT   = 16384;
constexpr int CNT_STRIDE = 64;
constexpr size_t WS_CONVQ = 16384 + 2 * 32 * CNT_STRIDE * 4;
constexpr size_t WS_ZERO_BYTES = WS_CONVQ + 256;
constexpr size_t WS_MODS  = al256(WS_ZERO_BYTES);
constexpr size_t WS_LIST  = WS_MODS + al256(2 * 2 * 6144 * 4);
constexpr size_t WS_AW    = WS_LIST + al256((size_t)2 * 32 * T * 4);
constexpr size_t WS_POS   = WS_AW + al256((size_t)2 * T * 4);
constexpr size_t WS_AWP   = WS_POS + al256((size_t)2 * T * 4);
constexpr size_t WS_ROWMAP = WS_AWP + al256((size_t)MOE_ROWS * 4);
constexpr size_t WS_AGG   = WS_ROWMAP + al256((size_t)MOE_ROWS * 4);
constexpr size_t WS_CARRY = WS_AGG + al256((size_t)2 * NRT * DR * 2 * 4);
constexpr size_t WS_GL    = WS_CARRY + al256((size_t)2 * NRT * DR * 4);
constexpr size_t WS_NVEC  = WS_GL + al256((size_t)T * 32 * 4);
constexpr size_t WS_DEC   = WS_NVEC + al256((size_t)NTILE * 16 * 64 * 4);
constexpr size_t WS_WIN   = WS_DEC + al256((size_t)NTILE * 16 * 4);
constexpr size_t WS_WOUT  = WS_WIN + al256((size_t)2560 * 1024 * 2);
constexpr size_t WS_WML   = WS_WOUT + al256((size_t)1024 * 1280 * 2);
constexpr size_t WS_WMO   = WS_WML + al256((size_t)MLWP * 1024 * 2);
constexpr size_t WS_WGU   = WS_WMO + al256((size_t)1024 * 1024 * 2);
constexpr size_t WS_WD    = WS_WGU + al256((size_t)32 * 1024 * 1024 * 2);
constexpr size_t WS_WGU1  = WS_WD + al256((size_t)32 * 1024 * 512 * 2);
constexpr size_t WS_WD1   = WS_WGU1 + al256((size_t)32 * 1024 * 1024 * 2);
constexpr size_t WS_WAXT  = WS_WD1 + al256((size_t)32 * 1024 * 512 * 2);
constexpr size_t WS_WR    = WS_WAXT + al256((size_t)40 * 16384 * 2);
constexpr size_t WS_HA    = WS_WR + al256((size_t)2 * 64 * 64 * 12 * 4);
constexpr size_t WS_X1    = WS_HA + al256((size_t)T * D * 2);
constexpr size_t WS_X2    = WS_X1 + al256((size_t)T * D * 2);
constexpr size_t WS_R0    = WS_X2 + al256((size_t)T * D * 2);
constexpr size_t WS_GG    = WS_R0;
constexpr size_t WS_PR    = WS_GG + al256((size_t)T * DR * 2);
constexpr size_t WS_S     = WS_PR + al256((size_t)T * DR * 2);
constexpr size_t WS_PF    = WS_S + al256((size_t)T * DR * 2);
constexpr size_t WS_PB    = WS_PF + al256((size_t)T * DR * 2);
constexpr size_t WS_R0END = WS_PB + al256((size_t)T * DR * 2);
constexpr size_t WS_ABUF  = WS_R0;
constexpr size_t WS_HM    = WS_ABUF + al256((size_t)MOE_ROWS * D * 2);
constexpr size_t WS_Y     = WS_HM + al256((size_t)MOE_ROWS * DE * 2);
constexpr size_t WS_MOEEND = WS_Y + al256((size_t)MOE_ROWS * D * 2);
constexpr size_t WS_Q     = WS_R0;
constexpr size_t WS_K     = WS_Q + al256((size_t)T * 512 * 2);
constexpr size_t WS_KT    = WS_K + al256((size_t)T * 512 * 2);
constexpr size_t WS_VT    = WS_KT + al256((size_t)T * 512 * 2);
constexpr size_t WS_OG    = WS_VT + al256((size_t)T * D * 2);
constexpr size_t WS_UT    = WS_OG + al256((size_t)T * D * 2);
constexpr size_t WS_L1END = WS_UT + al256((size_t)NTILE * 16 * 8192 * 4);
constexpr size_t cmax(size_t a, size_t b) { return a > b ? a : b; }
constexpr size_t WS_END   = cmax(cmax(WS_R0END, WS_L1END), WS_MOEEND);

struct Params {
  const float* in[40];
  float* out;
  char* ws;
};

typedef __bf16 bf16v2_t __attribute__((ext_vector_type(2)));
typedef float f32x2_t __attribute__((ext_vector_type(2)));
DEV unsigned pk2(float lo, float hi) { const f32x2_t v = {lo, hi}; return __builtin_bit_cast(unsigned, __builtin_convertvector(v, bf16v2_t)); }
DEV float bflo(unsigned u) { return __uint_as_float(u << 16); }
DEV float bfhi(unsigned u) { return __uint_as_float(u & 0xffff0000u); }
DEV float bf2f(bf16_t b) { return __uint_as_float((unsigned)b << 16); }
DEV bf16_t f2bf(float f) { return (bf16_t)(pk2(f, 0.f) & 0xffffu); }
DEV float fexp_(float x) { return __builtin_amdgcn_exp2f(x * 1.4426950408889634f); }
DEV float sigmoidf_(float x) { return __builtin_amdgcn_rcpf(1.f + __builtin_amdgcn_exp2f(x * -1.4426950408889634f)); }
DEV float siluf_(float x) { return x * sigmoidf_(x); }
DEV float gelu_tanh(float x) { const float u = 0.7978845608028654f * (x + 0.044715f * x * x * x); return x * sigmoidf_(2.f * u); }
DEV float wave_sum(float v) {
#pragma unroll
  for (int o = 1; o < 64; o <<= 1) v += __shfl_xor(v, o);
  return v;
}
DEV s16x4 ldtr(const char* p) { return __builtin_bit_cast(s16x4, __builtin_amdgcn_ds_read_tr16_b64_v4i16((LAS s16x4*)p)); }
DEV f32x4 ld_bf4(const bf16_t* p) { const u32x2 v = *(const u32x2*)p; return (f32x4){bflo(v.x), bfhi(v.x), bflo(v.y), bfhi(v.y)}; }
DEV void st_bf4(bf16_t* p, const f32x4 v) { u32x2 o; o.x = pk2(v.x, v.y); o.y = pk2(v.z, v.w); *(u32x2*)p = o; }
DEV int tidx() { int t = threadIdx.x & 255; asm volatile("" : "+v"(t)); return t; }
DEV int tidf() { int t = threadIdx.x; asm volatile("" : "+v"(t)); return t; }
DEV int seqrow_of_token(int t) { return (t & 63) * 256 + (t >> 6); }
DEV int token_of_seqrow(int s) { return (s & 255) * 64 + (s >> 8); }

constexpr int BS_STRIDE = 320;
DEV int bs_off(int k, int n) { return k * BS_STRIDE + ((((n >> 4) ^ ((k >> 3) & 1))) << 5) + (n & 15) * 2; }

namespace pg8 {
#define PG8_LAS __attribute__((address_space(3)))
typedef unsigned short bf16_t;
typedef short bf16x8 __attribute__((ext_vector_type(8)));
typedef float f32x4 __attribute__((ext_vector_type(4)));
typedef unsigned u32x4 __attribute__((ext_vector_type(4)));
constexpr int BM = 256, BK = 64, HALF = 128, HTB = HALF * BK * 2  , STAGE_BYTES = 8 * HTB, NXCD = 8, WGM = 8;

__host__ __device__ __forceinline__ int lds_byte(int r, int c) { const int st = (r >> 4) * 2 + (c >> 5), rr = r & 15, cc = c & 31, ob = rr * 64 + cc * 2; return st * 1024 + (ob ^ (((ob >> 9) & 1) << 5)); }
__host__ __device__ __forceinline__ void stage_rc(int b, int& R, int& C) { const int st = b / 1024, sb = b % 1024, swz = sb ^ (((sb >> 9) & 1) << 5); R = (st >> 1) * 16 + swz / 64; C = (st & 1) * 32 + (swz % 64) / 2; }
__host__ __device__ __forceinline__ int perm32(int rho) { const int n = rho >> 4, i = rho & 15; return 8 * (i >> 2) + 4 * n + (i & 3); }

struct Unit { int pm, pn; };
struct Gemm { const bf16_t* A; const bf16_t* Bt; int M, N, K; };

struct StaticOrder {
    int nM, nN, nwg, G, c;
    __host__ __device__ void init(int M, int N, int G_, int c_) { nM = M / BM; nN = N / BM; nwg = nM * nN; G = G_; c = c_; }
    __host__ __device__ bool next(int i, Unit& u) const {
        const long L = (long)i * G + c; if (L >= nwg) return false;
        int wgid = (int)L; { const int q = nwg / NXCD, r = nwg % NXCD, xcd = wgid % NXCD, off = wgid / NXCD; wgid = (xcd < r ? xcd * (q + 1) : r * (q + 1) + (xcd - r) * q) + off; }
        const int nig = WGM * nN, gid = wgid / nig, fm = gid * WGM, gsz = (nM - fm) < WGM ? (nM - fm) : WGM;
        u.pm = fm + ((wgid % nig) % gsz); u.pn = (wgid % nig) / gsz; return true;
    }
    __device__ __forceinline__ void a_ready(const Unit&) const {}
    __device__ __forceinline__ void done(const Unit&) const {}
};
template <class Epi, class Sched, bool STAMP = false>
__device__ __forceinline__ void gemm_phase(PG8_LAS unsigned char* lds, const Gemm g, const Sched& S, const Epi& E, unsigned long long* stamps) {
    int tid = threadIdx.x; asm volatile("" : "+v"(tid));
    const int wid = __builtin_amdgcn_readfirstlane(tid >> 6), lane = tid & 63, wr = wid >> 2, wc = wid & 3, fr = lane & 15, fq = lane >> 4;
    const int K = g.K, nt = K / BK;
    int ts_lo = 0, ts_hi = 0, nts = 0; const unsigned long long rt_entry = STAMP ? (unsigned long long)wall_clock64() : 0ull;
#define PG8_STAMP() do { if (STAMP && wid == 0 && nts < 64) { const unsigned long long _c = (unsigned long long)clock64(); \
        ts_lo = (lane == nts) ? (int)(unsigned)_c : ts_lo; ts_hi = (lane == nts) ? (int)(unsigned)(_c >> 32) : ts_hi; ++nts; } } while (0)
    PG8_STAMP();
    unsigned voffA[2], voffB[2];
#pragma unroll
    for (int i = 0; i < 2; ++i) { int R, C; stage_rc(tid * 16 + i * 8192, R, C); const int Rb = Epi::PERM ? ((R & ~31) + perm32(R & 31)) : R;
        voffA[i] = (unsigned)(R * K + C) * 2u; voffB[i] = (unsigned)(Rb * K + C) * 2u; }
    const size_t kstep = (size_t)(BK * 2);
    const size_t hstep = (size_t)HALF * K * 2;
    const size_t tstep = 2 * hstep;
    const unsigned ldsw = (unsigned)wid * 1024u;
    const int aoff = lds_byte(wr * 64 + fr, fq * 8), boff = lds_byte(wc * 32 + fr, fq * 8);
#define PG8_SA(b, h) (((b) * 2 + (h)) * HTB)
#define PG8_SB(b, h) ((4 + (b) * 2 + (h)) * HTB)
#define PG8_STAGE(bufoff, gbase, voff) do { _Pragma("unroll") for (int _i = 0; _i < 2; ++_i) \
        __builtin_amdgcn_global_load_lds((const unsigned*)((const char*)(gbase) + (voff)[_i]), (PG8_LAS unsigned*)(lds + (bufoff) + ldsw + _i * 8192), 16, 0, 0); } while (0)
#define PG8_LDA(dst, b, h) do { _Pragma("unroll") for (int m = 0; m < 4; ++m) _Pragma("unroll") for (int k = 0; k < 2; ++k) dst[m][k] = *(const PG8_LAS bf16x8*)(lds + PG8_SA(b, h) + aoff + m * 2048 + k * 1024); } while (0)
#define PG8_LDB(dst, b, h) do { _Pragma("unroll") for (int n = 0; n < 2; ++n) _Pragma("unroll") for (int k = 0; k < 2; ++k) dst[n][k] = *(const PG8_LAS bf16x8*)(lds + PG8_SB(b, h) + boff + n * 2048 + k * 1024); } while (0)
#define PG8_MMA(ai, bj, At, Bt) do { __builtin_amdgcn_s_setprio(1); _Pragma("unroll") for (int m = 0; m < 4; ++m) _Pragma("unroll") for (int n = 0; n < 2; ++n) _Pragma("unroll") for (int k = 0; k < 2; ++k) \
        acc[ai][bj][m][n] = __builtin_amdgcn_mfma_f32_16x16x32_bf16(Bt[n][k], At[m][k], acc[ai][bj][m][n], 0, 0, 0); __builtin_amdgcn_s_setprio(0); } while (0)
#define PG8_WAIT_V(n) asm volatile("s_waitcnt vmcnt(" #n ")" ::: "memory")
#define PG8_WAIT_L(n) asm volatile("s_waitcnt lgkmcnt(" #n ")" ::: "memory")
#define PG8_BAR __builtin_amdgcn_s_barrier()
#define PG8_SCHED __builtin_amdgcn_sched_barrier(0)
    Unit cur, nxt; int ui = 0;
    if (!S.next(0, cur)) return;
    f32x4 acc[2][2][4][2];
#pragma unroll
    for (int a = 0; a < 2; ++a)
#pragma unroll
        for (int b = 0; b < 2; ++b)
#pragma unroll
            for (int m = 0; m < 4; ++m)
#pragma unroll
                for (int n = 0; n < 2; ++n) acc[a][b][m][n] = (f32x4){0.f, 0.f, 0.f, 0.f};
    bf16x8 At[4][2], B0[2][2], B1[2][2];
    const char* cA = (const char*)g.A + (size_t)cur.pm * tstep; const char* cB = (const char*)g.Bt + (size_t)cur.pn * tstep;
    S.a_ready(cur);
    PG8_STAGE(PG8_SB(0, 0), cB, voffB); PG8_STAGE(PG8_SA(0, 0), cA, voffA); PG8_STAGE(PG8_SB(0, 1), cB + hstep, voffB); PG8_STAGE(PG8_SA(0, 1), cA + hstep, voffA);
    if (wr == 1) PG8_BAR;
    PG8_WAIT_V(4); PG8_BAR;
    PG8_STAGE(PG8_SB(1, 0), cB + kstep, voffB); PG8_STAGE(PG8_SA(1, 0), cA + kstep, voffA); PG8_STAGE(PG8_SB(1, 1), cB + hstep + kstep, voffB);
    PG8_WAIT_V(6); PG8_BAR;
    PG8_STAMP();
    for (;;) {
        const bool has_next = S.next(ui + 1, nxt);
        const char* nA = has_next ? (const char*)g.A + (size_t)nxt.pm * tstep : cA; const char* nB = has_next ? (const char*)g.Bt + (size_t)nxt.pn * tstep : cB;
        for (int t = 0; t < nt; t += 2) {
            const bool last = (t == nt - 2);
            const char* a1 = cA + (size_t)(t + 1) * kstep;
            const char* a2 = last ? nA : cA + (size_t)(t + 2) * kstep; const char* b2 = last ? nB : cB + (size_t)(t + 2) * kstep;
            const char* a3 = a2 + kstep; const char* b3 = b2 + kstep;
            if (last && has_next) S.a_ready(nxt);
            PG8_LDB(B0, 0, 0); PG8_SCHED; PG8_LDA(At, 0, 0); PG8_STAGE(PG8_SA(1, 1), a1 + hstep, voffA);
            PG8_WAIT_L(8); PG8_BAR; PG8_WAIT_L(0); PG8_MMA(0, 0, At, B0); PG8_BAR; PG8_SCHED;
            PG8_LDB(B1, 0, 1); PG8_STAGE(PG8_SB(0, 0), b2, voffB);
            PG8_BAR; PG8_WAIT_L(0); PG8_MMA(0, 1, At, B1); PG8_BAR;
            PG8_LDA(At, 0, 1); PG8_STAGE(PG8_SA(0, 0), a2, voffA);
            PG8_BAR; PG8_WAIT_L(0); PG8_MMA(1, 0, At, B0); PG8_BAR; PG8_SCHED;
            PG8_STAGE(PG8_SB(0, 1), b2 + hstep, voffB);
            PG8_WAIT_V(6); PG8_BAR; PG8_MMA(1, 1, At, B1); PG8_BAR;
            PG8_LDB(B0, 1, 0); PG8_SCHED; PG8_LDA(At, 1, 0); PG8_STAGE(PG8_SA(0, 1), a2 + hstep, voffA);
            PG8_WAIT_L(8); PG8_BAR; PG8_WAIT_L(0); PG8_MMA(0, 0, At, B0); PG8_BAR; PG8_SCHED;
            PG8_LDB(B1, 1, 1); PG8_STAGE(PG8_SB(1, 0), b3, voffB);
            PG8_BAR; PG8_WAIT_L(0); PG8_MMA(0, 1, At, B1); PG8_BAR;
            PG8_LDA(At, 1, 1); PG8_STAGE(PG8_SA(1, 0), a3, voffA);
            PG8_BAR; PG8_WAIT_L(0); PG8_MMA(1, 0, At, B0); PG8_BAR; PG8_SCHED;
            PG8_STAGE(PG8_SB(1, 1), b3 + hstep, voffB);
            PG8_WAIT_V(6); PG8_BAR; PG8_MMA(1, 1, At, B1); PG8_BAR;
        }
        PG8_STAMP();
        if constexpr (!Epi::AFTER_DRAIN) { E(acc, cur, wr, wc, fr, fq); S.done(cur); }
        PG8_STAMP();
        if (!has_next) break;
#pragma unroll
        for (int a = 0; a < 2; ++a)
#pragma unroll
            for (int b = 0; b < 2; ++b)
#pragma unroll
                for (int m = 0; m < 4; ++m)
#pragma unroll
                    for (int n = 0; n < 2; ++n) acc[a][b][m][n] = (f32x4){0.f, 0.f, 0.f, 0.f};
        cur = nxt; cA = nA; cB = nB; ++ui;
    }
    PG8_WAIT_V(0);
    if (wr == 0) PG8_BAR;
    PG8_BAR;
    if constexpr (Epi::AFTER_DRAIN) { E.fused(acc, cur, wr, wc, fr, fq, lds, wid, lane); S.done(cur); }
    PG8_STAMP();
    if (STAMP && wid == 0) { stamps[lane] = lane < nts ? (((unsigned long long)(unsigned)ts_hi << 32) | (unsigned)ts_lo) : 0ull;
        if (lane == 62) stamps[62] = rt_entry; if (lane == 63) stamps[63] = (unsigned long long)wall_clock64(); }
#undef PG8_STAMP
#undef PG8_SA
#undef PG8_SB
#undef PG8_STAGE
#undef PG8_LDA
#undef PG8_LDB
#undef PG8_MMA
#undef PG8_WAIT_V
#undef PG8_WAIT_L
#undef PG8_BAR
#undef PG8_SCHED
}
template <class Epi, class Sched, bool STAMP = false>
__device__ __forceinline__ void gemm_phase_gather(PG8_LAS unsigned char* lds, const Gemm g, const Sched& S, const Epi& E, unsigned long long* stamps) {
    int tid = threadIdx.x; asm volatile("" : "+v"(tid));
    const int wid = __builtin_amdgcn_readfirstlane(tid >> 6), lane = tid & 63, wr = wid >> 2, wc = wid & 3, fr = lane & 15, fq = lane >> 4;
    const int K = g.K, nt = K / BK;
    int ts_lo = 0, ts_hi = 0, nts = 0; const unsigned long long rt_entry = STAMP ? (unsigned long long)wall_clock64() : 0ull;
#define PG8_STAMP() do { if (STAMP && wid == 0 && nts < 64) { const unsigned long long _c = (unsigned long long)clock64(); \
        ts_lo = (lane == nts) ? (int)(unsigned)_c : ts_lo; ts_hi = (lane == nts) ? (int)(unsigned)(_c >> 32) : ts_hi; ++nts; } } while (0)
    PG8_STAMP();
    unsigned voffA[2], voffB[2];
#pragma unroll
    for (int i = 0; i < 2; ++i) { int R, C; stage_rc(tid * 16 + i * 8192, R, C); const int Rb = Epi::PERM ? ((R & ~31) + perm32(R & 31)) : R;
        voffA[i] = (unsigned)(R * K + C) * 2u; voffB[i] = (unsigned)(Rb * K + C) * 2u; }
    const size_t kstep = (size_t)(BK * 2);
    const size_t hstep = (size_t)HALF * K * 2;
    const size_t tstep = 2 * hstep;
    const unsigned ldsw = (unsigned)wid * 1024u;
    const int aoff = lds_byte(wr * 64 + fr, fq * 8), boff = lds_byte(wc * 32 + fr, fq * 8);
#define PG8_SA(b, h) (((b) * 2 + (h)) * HTB)
#define PG8_SB(b, h) ((4 + (b) * 2 + (h)) * HTB)
#define PG8_STAGE(bufoff, gbase, voff) do { _Pragma("unroll") for (int _i = 0; _i < 2; ++_i) \
        __builtin_amdgcn_global_load_lds((const unsigned*)((const char*)(gbase) + (voff)[_i]), (PG8_LAS unsigned*)(lds + (bufoff) + ldsw + _i * 8192), 16, 0, 0); } while (0)
#define PG8_LDA(dst, b, h) do { _Pragma("unroll") for (int m = 0; m < 4; ++m) _Pragma("unroll") for (int k = 0; k < 2; ++k) dst[m][k] = *(const PG8_LAS bf16x8*)(lds + PG8_SA(b, h) + aoff + m * 2048 + k * 1024); } while (0)
#define PG8_LDB(dst, b, h) do { _Pragma("unroll") for (int n = 0; n < 2; ++n) _Pragma("unroll") for (int k = 0; k < 2; ++k) dst[n][k] = *(const PG8_LAS bf16x8*)(lds + PG8_SB(b, h) + boff + n * 2048 + k * 1024); } while (0)
#define PG8_MMA(ai, bj, At, Bt) do { __builtin_amdgcn_s_setprio(1); _Pragma("unroll") for (int m = 0; m < 4; ++m) _Pragma("unroll") for (int n = 0; n < 2; ++n) _Pragma("unroll") for (int k = 0; k < 2; ++k) \
        acc[ai][bj][m][n] = __builtin_amdgcn_mfma_f32_16x16x32_bf16(Bt[n][k], At[m][k], acc[ai][bj][m][n], 0, 0, 0); __builtin_amdgcn_s_setprio(0); } while (0)
#define PG8_WAIT_V(n) asm volatile("s_waitcnt vmcnt(" #n ")" ::: "memory")
#define PG8_WAIT_L(n) asm volatile("s_waitcnt lgkmcnt(" #n ")" ::: "memory")
#define PG8_BAR __builtin_amdgcn_s_barrier()
#define PG8_SCHED __builtin_amdgcn_sched_barrier(0)
    Unit cur, nxt; int ui = 0;
    if (!S.next(0, cur)) return;
    f32x4 acc[2][2][4][2];
#pragma unroll
    for (int a = 0; a < 2; ++a)
#pragma unroll
        for (int b = 0; b < 2; ++b)
#pragma unroll
            for (int m = 0; m < 4; ++m)
#pragma unroll
                for (int n = 0; n < 2; ++n) acc[a][b][m][n] = (f32x4){0.f, 0.f, 0.f, 0.f};
    bf16x8 At[4][2], B0[2][2], B1[2][2];
    const char* const cA = (const char*)g.A; const char* cB = (const char*)g.Bt + (size_t)cur.pn * tstep;
    unsigned co[2][2], no[2][2];
#pragma unroll
    for (int h = 0; h < 2; ++h)
#pragma unroll
        for (int i = 0; i < 2; ++i) { int R, C; stage_rc(tid * 16 + i * 8192, R, C); co[h][i] = (unsigned)S.src_row(cur, h * HALF + R) * (unsigned)(K * 2) + (unsigned)C * 2u; no[h][i] = co[h][i]; }
    S.a_ready(cur);
    PG8_STAGE(PG8_SB(0, 0), cB, voffB); PG8_STAGE(PG8_SA(0, 0), cA, co[0]); PG8_STAGE(PG8_SB(0, 1), cB + hstep, voffB); PG8_STAGE(PG8_SA(0, 1), cA, co[1]);
    if (wr == 1) PG8_BAR;
    PG8_WAIT_V(4); PG8_BAR;
    PG8_STAGE(PG8_SB(1, 0), cB + kstep, voffB); PG8_STAGE(PG8_SA(1, 0), cA + kstep, co[0]); PG8_STAGE(PG8_SB(1, 1), cB + hstep + kstep, voffB);
    PG8_WAIT_V(6); PG8_BAR;
    PG8_STAMP();
    for (;;) {
        const bool has_next = S.next(ui + 1, nxt);
        const char* nB = has_next ? (const char*)g.Bt + (size_t)nxt.pn * tstep : cB;
        if (has_next) {
#pragma unroll
            for (int h = 0; h < 2; ++h)
#pragma unroll
                for (int i = 0; i < 2; ++i) { int R, C; stage_rc(tid * 16 + i * 8192, R, C); no[h][i] = (unsigned)S.src_row(nxt, h * HALF + R) * (unsigned)(K * 2) + (unsigned)C * 2u; }
        }
        for (int t = 0; t < nt; t += 2) {
            const bool last = (t == nt - 2);
            const char* a1 = cA + (size_t)(t + 1) * kstep;
            const char* a2 = cA + (size_t)(last ? 0 : t + 2) * kstep; const char* b2 = last ? nB : cB + (size_t)(t + 2) * kstep;

            const char* a3 = a2 + kstep; const char* b3 = b2 + kstep;
            if (last && has_next) S.a_ready(nxt);
            PG8_LDB(B0, 0, 0); PG8_SCHED; PG8_LDA(At, 0, 0); PG8_STAGE(PG8_SA(1, 1), a1, co[1]);
            if (last) { co[0][0] = no[0][0]; co[0][1] = no[0][1]; co[1][0] = no[1][0]; co[1][1] = no[1][1]; }
            PG8_WAIT_L(8); PG8_BAR; PG8_WAIT_L(0); PG8_MMA(0, 0, At, B0); PG8_BAR; PG8_SCHED;
            PG8_LDB(B1, 0, 1); PG8_STAGE(PG8_SB(0, 0), b2, voffB);
            PG8_BAR; PG8_WAIT_L(0); PG8_MMA(0, 1, At, B1); PG8_BAR;
            PG8_LDA(At, 0, 1); PG8_STAGE(PG8_SA(0, 0), a2, co[0]);
            PG8_BAR; PG8_WAIT_L(0); PG8_MMA(1, 0, At, B0); PG8_BAR; PG8_SCHED;
            PG8_STAGE(PG8_SB(0, 1), b2 + hstep, voffB);
            PG8_WAIT_V(6); PG8_BAR; PG8_MMA(1, 1, At, B1); PG8_BAR;
            PG8_LDB(B0, 1, 0); PG8_SCHED; PG8_LDA(At, 1, 0); PG8_STAGE(PG8_SA(0, 1), a2, co[1]);
            PG8_WAIT_L(8); PG8_BAR; PG8_WAIT_L(0); PG8_MMA(0, 0, At, B0); PG8_BAR; PG8_SCHED;
            PG8_LDB(B1, 1, 1); PG8_STAGE(PG8_SB(1, 0), b3, voffB);
            PG8_BAR; PG8_WAIT_L(0); PG8_MMA(0, 1, At, B1); PG8_BAR;
            PG8_LDA(At, 1, 1); PG8_STAGE(PG8_SA(1, 0), a3, co[0]);
            PG8_BAR; PG8_WAIT_L(0); PG8_MMA(1, 0, At, B0); PG8_BAR; PG8_SCHED;
            PG8_STAGE(PG8_SB(1, 1), b3 + hstep, voffB);
            PG8_WAIT_V(6); PG8_BAR; PG8_MMA(1, 1, At, B1); PG8_BAR;
        }
        PG8_STAMP();
        if constexpr (!Epi::AFTER_DRAIN) { E(acc, cur, wr, wc, fr, fq); S.done(cur); }
        PG8_STAMP();
        if (!has_next) break;
#pragma unroll
        for (int a = 0; a < 2; ++a)
#pragma unroll
            for (int b = 0; b < 2; ++b)
#pragma unroll
                for (int m = 0; m < 4; ++m)
#pragma unroll
                    for (int n = 0; n < 2; ++n) acc[a][b][m][n] = (f32x4){0.f, 0.f, 0.f, 0.f};
        cur = nxt; cB = nB; ++ui;
    }
    PG8_WAIT_V(0);
    if (wr == 0) PG8_BAR;
    PG8_BAR;
    if constexpr (Epi::AFTER_DRAIN) { E.fused(acc, cur, wr, wc, fr, fq, lds, wid, lane); S.done(cur); }
    PG8_STAMP();
    if (STAMP && wid == 0) { stamps[lane] = lane < nts ? (((unsigned long long)(unsigned)ts_hi << 32) | (unsigned)ts_lo) : 0ull;
        if (lane == 62) stamps[62] = rt_entry; if (lane == 63) stamps[63] = (unsigned long long)wall_clock64(); }
#undef PG8_STAMP
#undef PG8_SA
#undef PG8_SB
#undef PG8_STAGE
#undef PG8_LDA
#undef PG8_LDB
#undef PG8_MMA
#undef PG8_WAIT_V
#undef PG8_WAIT_L
#undef PG8_BAR
#undef PG8_SCHED
}
}

DEV void ph_adaln(const Params& p, char* smem, int bid, int nb) {
  float* sc = (float*)smem; float* sx = sc + 1024; f32x4* red = (f32x4*)(sx + 1024);
  const int tid = tidx();
  for (int i = tid; i < 1024; i += 256) { sc[i] = siluf_(p.in[1][i]); sx[i] = siluf_(p.in[3][i]); }
  __syncthreads();
  float* mods = (float*)(p.ws + WS_MODS);
  const int cl = tid & 7, kg = tid >> 3;
  constexpr int NU = 2 * 192;
  for (int it = 0, iters = (NU + nb - 1) / nb; it < iters; ++it) {
    const int u = bid + it * nb; const bool active = u < NU;
    const int l = u / 192, c0 = (u % 192) * 32;
    const float* W = p.in[l ? 24 : 4]; const float* B = p.in[l ? 25 : 5];
    if (active) {
      f32x4 ac = {0.f, 0.f, 0.f, 0.f}, ax = {0.f, 0.f, 0.f, 0.f};
      const float* wp = W + (size_t)(kg * 32) * 6144 + c0 + 4 * cl;
#pragma unroll 16
      for (int kk = 0; kk < 32; ++kk) {
        const f32x4 w = *(const f32x4*)(wp + (size_t)kk * 6144);
        const float a = sc[kg * 32 + kk], b = sx[kg * 32 + kk];
        ac += a * w; ax += b * w;
      }
      red[kg * 8 + cl] = ac; red[256 + kg * 8 + cl] = ax;
    }
    __syncthreads();
    if (active && tid < 16) {
      const int which = tid >> 3, c = tid & 7;
      f32x4 sm = {0.f, 0.f, 0.f, 0.f};
      for (int g = 0; g < 32; ++g) sm += red[which * 256 + g * 8 + c];
      const f32x4 bb = *(const f32x4*)(B + c0 + 4 * c);
      *(f32x4*)(mods + (size_t)(l * 2 + which) * 6144 + c0 + 4 * c) = sm + bb;
    }
    __syncthreads();
  }
}

DEV void transpose_item(const float* W, int N, int K, bf16_t* WT, float* scr, int k0, int n0, int lane) {
  float wreg[32];
#pragma unroll
  for (int i = 0; i < 32; ++i) { const int kk = 2 * i + (lane >> 5); wreg[i] = W[(size_t)(k0 + kk) * N + n0 + (lane & 31)]; }
#pragma unroll
  for (int i = 0; i < 32; ++i) { const int kk = 2 * i + (lane >> 5); scr[kk * 33 + (lane & 31)] = wreg[i]; }
  asm volatile("s_waitcnt lgkmcnt(0)" ::: "memory");
  const int c = lane & 7;
#pragma unroll
  for (int j = 0; j < 4; ++j) { const int n = (lane >> 3) + 8 * j; const float* s = scr + (8 * c) * 33 + n;
    u32x4 o; o.x = pk2(s[0 * 33], s[1 * 33]); o.y = pk2(s[2 * 33], s[3 * 33]); o.z = pk2(s[4 * 33], s[5 * 33]); o.w = pk2(s[6 * 33], s[7 * 33]);
    *(u32x4*)(WT + (size_t)n * K + k0 + 8 * c) = o; }
  asm volatile("s_waitcnt lgkmcnt(0)" ::: "memory");
}
constexpr int CI_WIN = 16 * 80, CI_WOUT = 20 * 32, CI_WML = 16 * 97, CI_WMO = 16 * 32, CI_WAX = 40 * 8, CI_DENSE = CI_WIN + CI_WOUT + CI_WML + CI_WMO + CI_WAX;
constexpr int CI_MOE = 32 * 768;
DEV void ph_convert_dense(const Params& p, char* smem) {
  const int tf = tidf(), lane = tf & 63, wv = tf >> 6;
  float* scr = (float*)(smem + wv * 8448);
  const int gw = blockIdx.x * 8 + wv, ngw = gridDim.x * 8;
  for (int it = gw; it < CI_DENSE; it += ngw) {
    int r = it;
    if (r < CI_WIN) { const int kb = r / 80, nb_ = r % 80; transpose_item(p.in[8], 2560, 1024, (bf16_t*)(p.ws + WS_WIN) + (size_t)(nb_ * 32) * 1024, scr, kb * 64, nb_ * 32, lane); continue; } r -= CI_WIN;
    if (r < CI_WOUT) { const int kb = r / 32, nb_ = r % 32; transpose_item(p.in[16], 1024, 1280, (bf16_t*)(p.ws + WS_WOUT) + (size_t)(nb_ * 32) * 1280, scr, kb * 64, nb_ * 32, lane); continue; } r -= CI_WOUT;
    if (r < CI_WML) { const int kb = r / 97, nb_ = r % 97; transpose_item(p.in[28], MLW, 1024, (bf16_t*)(p.ws + WS_WML) + (size_t)(nb_ * 32) * 1024, scr, kb * 64, nb_ * 32, lane); continue; } r -= CI_WML;
    if (r < CI_WMO) { const int kb = r / 32, nb_ = r % 32; transpose_item(p.in[31], 1024, 1024, (bf16_t*)(p.ws + WS_WMO) + (size_t)(nb_ * 32) * 1024, scr, kb * 64, nb_ * 32, lane); continue; } r -= CI_WMO;
    { const int mi = r >> 3, rr = r & 7, kb = rr >> 2, nb_ = rr & 3, dh = mi >> 1, which = mi & 1;
      transpose_item((which ? p.in[13] : p.in[11]) + (size_t)dh * 16384, 128, 128, (bf16_t*)(p.ws + WS_WAXT) + (size_t)mi * 16384 + (size_t)(nb_ * 32) * 128, scr, kb * 64, nb_ * 32, lane); }
  }
  { bf16_t* Wr = (bf16_t*)(p.ws + WS_WR);
    for (int i = blockIdx.x * 512 + tf; i < 2 * 48 * 1024; i += gridDim.x * 512) {
      const int l = i / (48 * 1024), r = i % (48 * 1024), n = r >> 10, k = r & 1023;
      const float* We = p.in[l ? 34 : 19]; const float* Wg = p.in[l ? 32 : 17];
      const float w = n < 32 ? We[k * 32 + n] : (n < 36 ? Wg[k * 4 + n - 32] : 0.f);
      const bf16_t hi = f2bf(w); const bf16_t lo = f2bf(w - bf2f(hi));
      Wr[(size_t)(l * 2) * 48 * 1024 + r] = hi; Wr[(size_t)(l * 2 + 1) * 48 * 1024 + r] = lo;
    } }
  { u32x4* z = (u32x4*)((bf16_t*)(p.ws + WS_WML) + (size_t)MLW * 1024); const int n16 = (MLWP - MLW) * 1024 * 2 / 16;
    for (int i = blockIdx.x * 512 + tf; i < n16; i += gridDim.x * 512) z[i] = (u32x4){0u, 0u, 0u, 0u}; }
}
template <int LAYER>
DEV void ph_convert_moe(const Params& p, char* smem) {
  const int tf = tidf(), lane = tf & 63, wv = tf >> 6;
  float* scr = (float*)(smem + wv * 8448);
  const int gw = blockIdx.x * 8 + wv, ngw = gridDim.x * 8;
  const float* Wg = p.in[LAYER == 0 ? 21 : 36]; const float* Wu = p.in[LAYER == 0 ? 22 : 37]; const float* Wd = p.in[LAYER == 0 ? 23 : 38];
  bf16_t* WGU = (bf16_t*)(p.ws + (LAYER == 0 ? WS_WGU : WS_WGU1)); bf16_t* WD = (bf16_t*)(p.ws + (LAYER == 0 ? WS_WD : WS_WD1));
  for (int it = gw; it < CI_MOE; it += ngw) {
    const int e = it / 768, r = it % 768;
    if (r < 512) {
      const int up = r >> 8, rr = r & 255, kb = rr >> 4, nb_ = rr & 15, n0 = nb_ * 32;
      bf16_t* dst = WGU + ((size_t)e * 1024 + (n0 >> 7) * 256 + up * 128 + (n0 & 127)) * 1024;
      transpose_item((up ? Wu : Wg) + (size_t)e * 1024 * 512, 512, 1024, dst, scr, kb * 64, n0, lane);
    } else {
      const int rr = r - 512, kb = rr >> 5, nb_ = rr & 31, n0 = nb_ * 32;
      transpose_item(Wd + (size_t)e * 512 * 1024, 1024, 512, WD + ((size_t)e * 1024 + n0) * 512, scr, kb * 64, n0, lane);
    }
  }
}

DEV void conv_queue_l1(const Params& p, char* smem, int max_batches) {
  const int tf = tidf(), lane = tf & 63, wv = tf >> 6;
  float* scr = (float*)(smem + wv * 8448);
  unsigned* q = (unsigned*)(p.ws + WS_CONVQ);
  volatile int* slot = (volatile int*)(smem + 8 * 8448);
  const float* Wg = p.in[36]; const float* Wu = p.in[37]; const float* Wd = p.in[38];
  bf16_t* WGU = (bf16_t*)(p.ws + WS_WGU1); bf16_t* WD = (bf16_t*)(p.ws + WS_WD1);
  for (int bt = 0; max_batches < 0 || bt < max_batches; ++bt) {
    __syncthreads();
    if (tf == 0) *slot = (int)__hip_atomic_fetch_add(q, 8u, __ATOMIC_RELAXED, __HIP_MEMORY_SCOPE_AGENT);
    __syncthreads();
    const int base = *slot;
    if (base >= CI_MOE) break;
    const int it = base + wv;
    if (it < CI_MOE) {
      const int e = it / 768, r = it % 768;
      if (r < 512) {
        const int up = r >> 8, rr = r & 255, kb = rr >> 4, nb_ = rr & 15, n0 = nb_ * 32;
        bf16_t* dst = WGU + ((size_t)e * 1024 + (n0 >> 7) * 256 + up * 128 + (n0 & 127)) * 1024;
        transpose_item((up ? Wu : Wg) + (size_t)e * 1024 * 512, 512, 1024, dst, scr, kb * 64, n0, lane);
      } else {
        const int rr = r - 512, kb = rr >> 5, nb_ = rr & 31, n0 = nb_ * 32;
        transpose_item(Wd + (size_t)e * 512 * 1024, 1024, 512, WD + ((size_t)e * 1024 + n0) * 512, scr, kb * 64, n0, lane);
      }
    }
  }
  __syncthreads();
}

DEV void ph_norm0(const Params& p, int bid, int nb) {
  const int lane = tidx() & 63, wave = tidx() >> 6;
  const float* mods = (const float*)(p.ws + WS_MODS);
  bf16_t* hA = (bf16_t*)(p.ws + WS_HA);
  const float* g1 = p.in[6];
  for (int r0 = (bid * 4 + wave) * 4; r0 < T; r0 += nb * 16) {
    f32x4 v[4][4]; float rs[4];
#pragma unroll
    for (int q = 0; q < 4; ++q) {
      const int r = r0 + q;
      const float* src = r < NL ? p.in[0] + (size_t)r * D : p.in[2] + (size_t)(r - NL) * D;
#pragma unroll
      for (int i = 0; i < 4; ++i) v[q][i] = *(const f32x4*)(src + 4 * lane + 256 * i);
    }
#pragma unroll
    for (int q = 0; q < 4; ++q) {
      float ss = 0.f;
#pragma unroll
      for (int i = 0; i < 4; ++i) ss += v[q][i].x * v[q][i].x + v[q][i].y * v[q][i].y + v[q][i].z * v[q][i].z + v[q][i].w * v[q][i].w;
      rs[q] = rsqrtf(wave_sum(ss) * (1.f / D) + EPS);
    }
#pragma unroll
    for (int i = 0; i < 4; ++i) {
      const int c = 4 * lane + 256 * i;
      const f32x4 g = *(const f32x4*)(g1 + c);
#pragma unroll
      for (int q = 0; q < 4; ++q) {
        const int r = r0 + q;
        const float* md = mods + (r < NL ? 0 : 6144);
        const f32x4 sh = *(const f32x4*)(md + c), sc = *(const f32x4*)(md + 1024 + c);
        const f32x4 h = v[q][i] * rs[q] * g * (1.f + sc) + sh;
        u32x2 o; o.x = pk2(h.x, h.y); o.y = pk2(h.z, h.w);
        *(u32x2*)(hA + (size_t)r * D + c) = o;
      }
    }
  }
}

constexpr int RG_AS_STRIDE = 272;
constexpr int RG_MT = RGT / 16;
constexpr int RG_AS = 0, RG_BS = RGT * RG_AS_STRIDE, RG_SMEM = RG_BS + 128 * BS_STRIDE;

template <bool REV, int NT>
DEV void rg_scan(f32x4 (&A)[RG_MT][NT], f32x4 (&B)[RG_MT][NT], float (&aggP)[NT], float (&aggH)[NT]) {
  const int lane = tidx() & 63, fq = lane >> 4, fr = lane & 15;
#pragma unroll
  for (int n = 0; n < NT; ++n) {
    float cP = 1.f, cH = 0.f;
#pragma unroll
    for (int mm = 0; mm < RG_MT; ++mm) {
      const int m = REV ? RG_MT - 1 - mm : mm;
      float P[4], H[4];
      if (!REV) {
        P[0] = A[m][n][0]; H[0] = B[m][n][0];
#pragma unroll
        for (int j = 1; j < 4; ++j) { P[j] = A[m][n][j] * P[j - 1]; H[j] = A[m][n][j] * H[j - 1] + B[m][n][j]; }
      } else {
        P[3] = A[m][n][3]; H[3] = B[m][n][3];
#pragma unroll
        for (int j = 2; j >= 0; --j) { P[j] = A[m][n][j] * P[j + 1]; H[j] = A[m][n][j] * H[j + 1] + B[m][n][j]; }
      }
      float IP = REV ? P[0] : P[3], IH = REV ? H[0] : H[3];
      float tP, tH;
      tP = REV ? __shfl_down(IP, 16) : __shfl_up(IP, 16); tH = REV ? __shfl_down(IH, 16) : __shfl_up(IH, 16);
      if (REV ? (fq <= 2) : (fq >= 1)) { IH = IP * tH + IH; IP = IP * tP; }
      tP = REV ? __shfl_down(IP, 32) : __shfl_up(IP, 32); tH = REV ? __shfl_down(IH, 32) : __shfl_up(IH, 32);
      if (REV ? (fq <= 1) : (fq >= 2)) { IH = IP * tH + IH; IP = IP * tP; }
      float EP = REV ? __shfl_down(IP, 16) : __shfl_up(IP, 16), EH = REV ? __shfl_down(IH, 16) : __shfl_up(IH, 16);
      if (REV ? (fq == 3) : (fq == 0)) { EP = 1.f; EH = 0.f; }
      const float hin = EP * cH + EH, pin = EP * cP;
#pragma unroll
      for (int j = 0; j < 4; ++j) { B[m][n][j] = H[j] + P[j] * hin; A[m][n][j] = P[j] * pin; }
      const float TP = __shfl(IP, (REV ? 0 : 48) + fr), TH = __shfl(IH, (REV ? 0 : 48) + fr);
      cH = TP * cH + TH; cP = TP * cP;
    }
    aggP[n] = cP; aggH[n] = cH;
  }
}

DEV void ph_rg_scan(const Params& p, char* smem, int bid, int nb) {
  char* As = smem + RG_AS; char* Bs = smem + RG_BS;
  const bf16_t* pr = (const bf16_t*)(p.ws + WS_PR);
  bf16_t* Sb = (bf16_t*)(p.ws + WS_S); bf16_t* Pfb = (bf16_t*)(p.ws + WS_PF); bf16_t* Pbb = (bf16_t*)(p.ws + WS_PB);
  float* agg = (float*)(p.ws + WS_AGG);
  const float* conv_w = p.in[9]; const float* conv_b = p.in[10];
  for (int it = 0, iters = (NRT * 10 + nb - 1) / nb; it < iters; ++it) {
    int u = bid + it * nb; const bool active = u < NRT * 10; if (!active) u = NRT * 10 - 1;
    const int tid = tidx();
    const int lane = tid & 63, wave = tid >> 6, fr = lane & 15, fq = lane >> 4, q4 = fr >> 2, p4 = lane & 3;
    const int hb = u % 10, tile = u / 10, r0 = tile * RGT, ch0 = hb * 128;
    const int seg_lo = tile < NRT_LAT ? 0 : NL, seg_hi = tile < NRT_LAT ? NL : T;
    __syncthreads();
    {
      const int cg8 = tid & 15, rg = tid >> 4, c = ch0 + 8 * cg8;
      float w[4][8], bias[8];
#pragma unroll
      for (int j = 0; j < 4; ++j) { const f32x4 a = *(const f32x4*)(conv_w + j * DR + c), b = *(const f32x4*)(conv_w + j * DR + c + 4);
        w[j][0] = a.x; w[j][1] = a.y; w[j][2] = a.z; w[j][3] = a.w; w[j][4] = b.x; w[j][5] = b.y; w[j][6] = b.z; w[j][7] = b.w; }
      { const f32x4 a = *(const f32x4*)(conv_b + c), b = *(const f32x4*)(conv_b + c + 4);
        bias[0] = a.x; bias[1] = a.y; bias[2] = a.z; bias[3] = a.w; bias[4] = b.x; bias[5] = b.y; bias[6] = b.z; bias[7] = b.w; }
      float win[4][8];
      auto ldrow = [&](int r, float (&dst)[8]) {
        if (r >= seg_lo && r < seg_hi) { const u32x4 v = *(const u32x4*)(pr + (size_t)r * DR + c);
          dst[0] = bflo(v.x); dst[1] = bfhi(v.x); dst[2] = bflo(v.y); dst[3] = bfhi(v.y); dst[4] = bflo(v.z); dst[5] = bfhi(v.z); dst[6] = bflo(v.w); dst[7] = bfhi(v.w); }
        else {
#pragma unroll
          for (int e = 0; e < 8; ++e) dst[e] = 0.f; }
      };
      const int rb = r0 + rg * 4;
      ldrow(rb - 2, win[0]); ldrow(rb - 1, win[1]); ldrow(rb, win[2]);
#pragma unroll
      for (int t = 0; t < 4; ++t) {
        ldrow(rb + t + 1, win[(t + 3) & 3]);
        float o[8];
#pragma unroll
        for (int e = 0; e < 8; ++e) o[e] = bias[e] + w[0][e] * win[t & 3][e] + w[1][e] * win[(t + 1) & 3][e] + w[2][e] * win[(t + 2) & 3][e] + w[3][e] * win[(t + 3) & 3][e];
        u32x4 ov; ov.x = pk2(o[0], o[1]); ov.y = pk2(o[2], o[3]); ov.z = pk2(o[4], o[5]); ov.w = pk2(o[6], o[7]);
        *(u32x4*)(As + (rg * 4 + t) * RG_AS_STRIDE + cg8 * 16) = ov;
      }
    }
    u32x2 hfk[RG_MT][2];
#pragma unroll
    for (int d = 0; d < 2; ++d) {
      f32x4 accA[RG_MT][2], accX[RG_MT][2];
#pragma unroll
      for (int which = 0; which < 2; ++which) {
        const float* W = (which ? p.in[13] : p.in[11]) + (size_t)(d * 10 + hb) * 16384;
        __syncthreads();
#pragma unroll 1
        for (int ib = 0; ib < 4; ++ib) {
#pragma unroll
          for (int ii = 0; ii < 4; ++ii) {
            const int f = tid + 256 * (ib * 4 + ii), k = f >> 5, n = 4 * (f & 31);
            const f32x4 v = *(const f32x4*)(W + k * 128 + n);
            u32x2 o; o.x = pk2(v.x, v.y); o.y = pk2(v.z, v.w);
            *(u32x2*)(Bs + bs_off(k, n)) = o;
          }
        }
        __syncthreads();
        f32x4 (&acc)[RG_MT][2] = which ? accX : accA;
#pragma unroll
        for (int m = 0; m < RG_MT; ++m) { acc[m][0] = (f32x4){0.f, 0.f, 0.f, 0.f}; acc[m][1] = (f32x4){0.f, 0.f, 0.f, 0.f}; }
#pragma unroll
        for (int ks = 0; ks < 4; ++ks) {
          bf16x8 b[2];
#pragma unroll
          for (int n = 0; n < 2; ++n) {
            const int ncol = wave * 32 + n * 16 + 4 * p4;
            const s16x4 lo = ldtr(Bs + bs_off(ks * 32 + fq * 8 + q4, ncol));
            const s16x4 hi = ldtr(Bs + bs_off(ks * 32 + fq * 8 + 4 + q4, ncol));
            b[n] = (bf16x8){lo.x, lo.y, lo.z, lo.w, hi.x, hi.y, hi.z, hi.w};
          }
#pragma unroll
          for (int m = 0; m < RG_MT; ++m) {
            const bf16x8 a = *(const bf16x8*)(As + (m * 16 + fr) * RG_AS_STRIDE + (ks * 32 + fq * 8) * 2);
            acc[m][0] = __builtin_amdgcn_mfma_f32_16x16x32_bf16(a, b[0], acc[m][0], 0, 0, 0);
            acc[m][1] = __builtin_amdgcn_mfma_f32_16x16x32_bf16(a, b[1], acc[m][1], 0, 0, 0);
          }
        }
      }
#pragma unroll
      for (int n = 0; n < 2; ++n) {
        const int cl = wave * 32 + n * 16 + fr, ch = ch0 + cl;
        const float ba = p.in[12][d * DR + ch], bx = p.in[14][d * DR + ch], lam = p.in[15][d * DR + ch];
        const float nl = -lam;
        const float sp = nl > 20.f ? nl : log1pf(__expf(nl));
        const float c8 = -8.f * sp;
#pragma unroll
        for (int m = 0; m < RG_MT; ++m)
#pragma unroll
          for (int j = 0; j < 4; ++j) {
            const int row = m * 16 + fq * 4 + j;
            const float r = sigmoidf_(accA[m][n][j] + ba), ig = sigmoidf_(accX[m][n][j] + bx);
            const float la = c8 * r;
            const float a = __expf(la);
            const float x2 = 2.f * la;
            const float om = x2 > -0.1f ? -x2 * (1.f + x2 * (0.5f + x2 * (0.16666667f + x2 * 0.041666668f))) : 1.f - a * a;
            const float mult = sqrtf(om);
            const float uu = bf2f(*(const bf16_t*)(As + row * RG_AS_STRIDE + cl * 2));
            accA[m][n][j] = a; accX[m][n][j] = mult * ig * uu;
            if (j == 3) __builtin_amdgcn_sched_barrier(0);
          }
      }
      float aggP[2], aggH[2];
      if (d == 0) rg_scan<false, 2>(accA, accX, aggP, aggH); else rg_scan<true, 2>(accA, accX, aggP, aggH);
      if (fq == 0) {
#pragma unroll
        for (int n = 0; n < 2; ++n) {
          const int ch = ch0 + wave * 32 + n * 16 + fr;
          float* ag = agg + ((size_t)(d * NRT + tile) * DR + ch) * 2;
          ag[0] = aggP[n]; ag[1] = aggH[n];
        }
      }
      bf16_t* Pout = d ? Pbb : Pfb;
#pragma unroll
      for (int m = 0; m < RG_MT; ++m)
#pragma unroll
        for (int n = 0; n < 2; ++n) {
          if (d == 0) { hfk[m][n].x = pk2(accX[m][n][0], accX[m][n][1]); hfk[m][n].y = pk2(accX[m][n][2], accX[m][n][3]); }
          else { accX[m][n][0] += bflo(hfk[m][n].x); accX[m][n][1] += bfhi(hfk[m][n].x); accX[m][n][2] += bflo(hfk[m][n].y); accX[m][n][3] += bfhi(hfk[m][n].y); }
#pragma unroll
          for (int j = 0; j < 4; ++j) {
            const unsigned o = (unsigned)(r0 + m * 16 + fq * 4 + j) * DR + ch0 + wave * 32 + n * 16 + fr;
            Pout[o] = f2bf(accA[m][n][j]);
            if (d == 1) Sb[o] = f2bf(accX[m][n][j]);
          }
          __builtin_amdgcn_sched_barrier(0);
        }
    }
  }
}

DEV void ph_rg_scan2(const Params& p, char* smem) {
  int tid = threadIdx.x; asm volatile("" : "+v"(tid));
  const int lane = tid & 63, wave = tid >> 6, fr = lane & 15, fq = lane >> 4;
  const bf16_t* pr = (const bf16_t*)(p.ws + WS_PR);
  bf16_t* Sb = (bf16_t*)(p.ws + WS_S); bf16_t* Pfb = (bf16_t*)(p.ws + WS_PF); bf16_t* Pbb = (bf16_t*)(p.ws + WS_PB);
  float* agg = (float*)(p.ws + WS_AGG);
  const bf16_t* WAX = (const bf16_t*)(p.ws + WS_WAXT);
  const float* conv_w = p.in[9]; const float* conv_b = p.in[10];
  const int NU = NRT * 10;
  const int u0 = (int)((long)blockIdx.x * NU / gridDim.x), u1 = (int)((long)(blockIdx.x + 1) * NU / gridDim.x);
  int cur_hb = -1;
  bf16x8 bfr[4][4];
  float cba[2], cbx[2], cc8[2];
#pragma unroll 1
  for (int u = u0; u < u1; ++u) {
    const int hb = u / NRT, tile = u - hb * NRT, r0 = tile * RGT, ch0 = hb * 128;
    const int seg_lo = tile < NRT_LAT ? 0 : NL, seg_hi = tile < NRT_LAT ? NL : T;
    char* As = smem + ((u - u0) & 1) * (RGT * RG_AS_STRIDE);
    if (hb != cur_hb) {
      cur_hb = hb;
#pragma unroll
      for (int mat = 0; mat < 4; ++mat)
#pragma unroll
        for (int ks = 0; ks < 4; ++ks)
          bfr[mat][ks] = *(const bf16x8*)(WAX + (size_t)(((mat >> 1) * 10 + hb) * 2 + (mat & 1)) * 16384 + (16 * wave + fr) * 128 + ks * 32 + fq * 8);
#pragma unroll
      for (int d = 0; d < 2; ++d) {
        const int ch = ch0 + 16 * wave + fr;
        cba[d] = p.in[12][d * DR + ch]; cbx[d] = p.in[14][d * DR + ch];
        const float nl = -p.in[15][d * DR + ch];
        cc8[d] = -8.f * (nl > 20.f ? nl : log1pf(__expf(nl)));
      }
    }
    {
      const int cg8 = tid & 15, rg = tid >> 4, c = ch0 + 8 * cg8;
      float w[4][8], bias[8];
#pragma unroll
      for (int j = 0; j < 4; ++j) { const f32x4 a = *(const f32x4*)(conv_w + j * DR + c), b = *(const f32x4*)(conv_w + j * DR + c + 4);
        w[j][0] = a.x; w[j][1] = a.y; w[j][2] = a.z; w[j][3] = a.w; w[j][4] = b.x; w[j][5] = b.y; w[j][6] = b.z; w[j][7] = b.w; }
      { const f32x4 a = *(const f32x4*)(conv_b + c), b = *(const f32x4*)(conv_b + c + 4);
        bias[0] = a.x; bias[1] = a.y; bias[2] = a.z; bias[3] = a.w; bias[4] = b.x; bias[5] = b.y; bias[6] = b.z; bias[7] = b.w; }
      float win[5][8];
      const int rb = r0 + rg * 2;
#pragma unroll
      for (int t = 0; t < 5; ++t) {
        const int r = rb - 2 + t;
        if (r >= seg_lo && r < seg_hi) { const u32x4 v = *(const u32x4*)(pr + (size_t)r * DR + c);
          win[t][0] = bflo(v.x); win[t][1] = bfhi(v.x); win[t][2] = bflo(v.y); win[t][3] = bfhi(v.y); win[t][4] = bflo(v.z); win[t][5] = bfhi(v.z); win[t][6] = bflo(v.w); win[t][7] = bfhi(v.w); }
        else {
#pragma unroll
          for (int e = 0; e < 8; ++e) win[t][e] = 0.f; }
      }
#pragma unroll
      for (int t = 0; t < 2; ++t) {
        float o[8];
#pragma unroll
        for (int e = 0; e < 8; ++e) o[e] = bias[e] + w[0][e] * win[t][e] + w[1][e] * win[t + 1][e] + w[2][e] * win[t + 2][e] + w[3][e] * win[t + 3][e];
        u32x4 ov; ov.x = pk2(o[0], o[1]); ov.y = pk2(o[2], o[3]); ov.z = pk2(o[4], o[5]); ov.w = pk2(o[6], o[7]);
        *(u32x4*)(As + (rg * 2 + t) * RG_AS_STRIDE + cg8 * 16) = ov;
      }
    }
    __syncthreads();
    f32x4 acc[4][RG_MT][1];
#pragma unroll
    for (int mat = 0; mat < 4; ++mat)
#pragma unroll
      for (int m = 0; m < RG_MT; ++m) acc[mat][m][0] = (f32x4){0.f, 0.f, 0.f, 0.f};
#pragma unroll
    for (int ks = 0; ks < 4; ++ks)
#pragma unroll
      for (int m = 0; m < RG_MT; ++m) {
        const bf16x8 a = *(const bf16x8*)(As + (m * 16 + fr) * RG_AS_STRIDE + (ks * 32 + fq * 8) * 2);
#pragma unroll
        for (int mat = 0; mat < 4; ++mat) acc[mat][m][0] = __builtin_amdgcn_mfma_f32_16x16x32_bf16(a, bfr[mat][ks], acc[mat][m][0], 0, 0, 0);
      }
    const int cl = 16 * wave + fr;
#pragma unroll
    for (int d = 0; d < 2; ++d) {
      f32x4 (&accA)[RG_MT][1] = acc[d * 2]; f32x4 (&accX)[RG_MT][1] = acc[d * 2 + 1];
#pragma unroll
      for (int m = 0; m < RG_MT; ++m) {
#pragma unroll
        for (int j = 0; j < 4; ++j) {
          const int row = m * 16 + fq * 4 + j;
          const float r = sigmoidf_(accA[m][0][j] + cba[d]), ig = sigmoidf_(accX[m][0][j] + cbx[d]);
          const float la = cc8[d] * r;
          const float a = fexp_(la);
          const float x2 = 2.f * la;
          const float om = x2 > -0.1f ? -x2 * (1.f + x2 * (0.5f + x2 * (0.16666667f + x2 * 0.041666668f))) : 1.f - a * a;
          const float uu = bf2f(*(const bf16_t*)(As + row * RG_AS_STRIDE + cl * 2));
          accA[m][0][j] = a; accX[m][0][j] = __builtin_amdgcn_sqrtf(om) * ig * uu;
        }
        __builtin_amdgcn_sched_barrier(0);
      }
      float aggP[1], aggH[1];
      if (d == 0) rg_scan<false, 1>(accA, accX, aggP, aggH); else rg_scan<true, 1>(accA, accX, aggP, aggH);
      if (fq == 0) { float* ag = agg + ((size_t)(d * NRT + tile) * DR + ch0 + cl) * 2; ag[0] = aggP[0]; ag[1] = aggH[0]; }
      bf16_t* Pout = d ? Pbb : Pfb;
#pragma unroll
      for (int m = 0; m < RG_MT; ++m) {
        if (d == 1) accX[m][0] += acc[1][m][0];
#pragma unroll
        for (int j = 0; j < 4; ++j) {
          const unsigned o = (unsigned)(r0 + m * 16 + fq * 4 + j) * DR + ch0 + cl;
          Pout[o] = f2bf(accA[m][0][j]);
          if (d == 1) Sb[o] = f2bf(accX[m][0][j]);
        }
      }
    }
  }
  __syncthreads();
}

DEV void ph_rg_carry(const Params& p, char* smem, int bid, int nb) {
  const float* agg = (const float*)(p.ws + WS_AGG); float* carry = (float*)(p.ws + WS_CARRY);
  const int tid = tidx();
  float* sP = (float*)smem; float* sH = sP + 256;
  constexpr int NCH = 2 * DR, CPB = 25, NB = (NCH + CPB - 1) / CPB;
  for (int it = 0, iters = (NB + nb - 1) / nb; it < iters; ++it) {
    const int blk = bid + it * nb;
    const int lc = tid / 10, seg = tid % 10, chain = blk * CPB + lc;
    const bool on = blk < NB && tid < 250 && chain < NCH;
    const int d = on ? chain / DR : 0, ch = on ? chain % DR : 0;
    float ap[26], ah[26];
    if (on) {
#pragma unroll
      for (int j = 0; j < 26; ++j) {
        const int s = seg * 26 + j;
        const int tile = d == 0 ? (s < (NRT - NRT_LAT) ? NRT_LAT + s : s - (NRT - NRT_LAT)) : NRT - 1 - s;
        const float* ag = agg + ((size_t)(d * NRT + tile) * DR + ch) * 2;
        ap[j] = ag[0]; ah[j] = ag[1];
      }
      float P = 1.f, H = 0.f;
#pragma unroll
      for (int j = 0; j < 26; ++j) { H = ap[j] * H + ah[j]; P = ap[j] * P; }
      sP[tid] = P; sH[tid] = H;
    }
    __syncthreads();
    if (on) {
      float st = 0.f;
      for (int k = 0; k < seg; ++k) st = sP[lc * 10 + k] * st + sH[lc * 10 + k];
#pragma unroll
      for (int j = 0; j < 26; ++j) {
        const int s = seg * 26 + j;
        const int tile = d == 0 ? (s < (NRT - NRT_LAT) ? NRT_LAT + s : s - (NRT - NRT_LAT)) : NRT - 1 - s;
        carry[(size_t)(d * NRT + tile) * DR + ch] = st;
        st = ap[j] * st + ah[j];
      }
    }
    __syncthreads();
  }
}

DEV void ph_rg_final(const Params& p, int bid, int nb) {
  const bf16_t* gg = (const bf16_t*)(p.ws + WS_GG); const bf16_t* Sb = (const bf16_t*)(p.ws + WS_S);
  const bf16_t* Pfb = (const bf16_t*)(p.ws + WS_PF); const bf16_t* Pbb = (const bf16_t*)(p.ws + WS_PB);
  const float* carry = (const float*)(p.ws + WS_CARRY);
  bf16_t* y = (bf16_t*)(p.ws + WS_PR);
  const int total = T * (DR / 8);
  for (int i = bid * 256 + tidx(); i < total; i += nb * 256) {
    const int r = i / 160, c = (i % 160) * 8, tile = r / RGT;
    const size_t o = (size_t)r * DR + c;
    const u32x4 g = *(const u32x4*)(gg + o), s = *(const u32x4*)(Sb + o), pf = *(const u32x4*)(Pfb + o), pb = *(const u32x4*)(Pbb + o);
    const float* cf = carry + (size_t)tile * DR + c; const float* cb = carry + (size_t)(NRT + tile) * DR + c;
    const f32x4 cf0 = *(const f32x4*)cf, cf1 = *(const f32x4*)(cf + 4), cb0 = *(const f32x4*)cb, cb1 = *(const f32x4*)(cb + 4);
    u32x4 o4;
    o4.x = pk2(bflo(g.x) * (bflo(s.x) + bflo(pf.x) * cf0.x + bflo(pb.x) * cb0.x), bfhi(g.x) * (bfhi(s.x) + bfhi(pf.x) * cf0.y + bfhi(pb.x) * cb0.y));
    o4.y = pk2(bflo(g.y) * (bflo(s.y) + bflo(pf.y) * cf0.z + bflo(pb.y) * cb0.z), bfhi(g.y) * (bfhi(s.y) + bfhi(pf.y) * cf0.w + bfhi(pb.y) * cb0.w));
    o4.z = pk2(bflo(g.z) * (bflo(s.z) + bflo(pf.z) * cf1.x + bflo(pb.z) * cb1.x), bfhi(g.z) * (bfhi(s.z) + bfhi(pf.z) * cf1.y + bfhi(pb.z) * cb1.y));
    o4.w = pk2(bflo(g.w) * (bflo(s.w) + bflo(pf.w) * cf1.z + bflo(pb.w) * cb1.z), bfhi(g.w) * (bfhi(s.w) + bfhi(pf.w) * cf1.w + bfhi(pb.w) * cb1.w));
    *(u32x4*)(y + o) = o4;
  }
}

using pg8::Unit;
struct EpiRgIn {
  static constexpr bool PERM = true, AFTER_DRAIN = false;
  bf16_t* gg; bf16_t* pr;
  DEV void operator()(const f32x4 (&acc)[2][2][4][2], const Unit& u, int wr, int wc, int fr, int fq) const {
    const int row0 = u.pm * 256 + wr * 64 + fr, c0 = u.pn * 256 + wc * 32 + 8 * fq;
    const bool gate = u.pn < 5;
#pragma unroll
    for (int ai = 0; ai < 2; ++ai)
#pragma unroll
      for (int m = 0; m < 4; ++m) {
        const unsigned row = row0 + ai * 128 + m * 16;
#pragma unroll
        for (int bj = 0; bj < 2; ++bj) {
          f32x4 v0 = acc[ai][bj][m][0], v1 = acc[ai][bj][m][1];
          const int col = c0 + bj * 128;
          if (gate) {
#pragma unroll
            for (int j = 0; j < 4; ++j) { v0[j] = gelu_tanh(v0[j]); v1[j] = gelu_tanh(v1[j]); }
          }
          u32x4 w; w.x = pk2(v0[0], v0[1]); w.y = pk2(v0[2], v0[3]); w.z = pk2(v1[0], v1[1]); w.w = pk2(v1[2], v1[3]);
          if (gate) *(u32x4*)(gg + row * DR + col) = w; else *(u32x4*)(pr + row * DR + col - DR) = w;
        }
      }
  }
};
template <int LAYER> struct EpiOut {
  static constexpr bool PERM = false, AFTER_DRAIN = false;
  const float* x; const float* ctx; const bf16_t* x2; const float* mods; bf16_t* x1;
  DEV void operator()(const f32x4 (&acc)[2][2][4][2], const Unit& u, int wr, int wc, int fr, int fq) const {
    const int row0 = u.pm * 256 + wr * 64 + fr, c0 = u.pn * 256 + wc * 32 + 4 * fq;
#pragma unroll
    for (int ai = 0; ai < 2; ++ai)
#pragma unroll
      for (int m = 0; m < 4; ++m) {
        const int row = row0 + ai * 128 + m * 16;
        const int trow = LAYER == 0 ? row : token_of_seqrow(row);
        const float* xin = LAYER == 0 ? (row < NL ? x + (size_t)row * D : ctx + (size_t)(row - NL) * D) : nullptr;
        const float* gt = mods + ((LAYER == 0 && row >= NL) ? 6144 : 0) + 2048;
        bf16_t* xo = x1 + (size_t)trow * D;
#pragma unroll
        for (int bj = 0; bj < 2; ++bj)
#pragma unroll
          for (int n = 0; n < 2; ++n) {
            const int col = c0 + bj * 128 + n * 16;
            const f32x4 xi = LAYER == 0 ? *(const f32x4*)(xin + col) : ld_bf4(x2 + (size_t)trow * D + col);
            st_bf4(xo + col, xi + *(const f32x4*)(gt + col) * acc[ai][bj][m][n]);
          }
      }
  }
};
struct EpiMoe1 {
  static constexpr bool PERM = true, AFTER_DRAIN = false;
  bf16_t* Hm;
  DEV void operator()(const f32x4 (&acc)[2][2][4][2], const Unit& u, int wr, int wc, int fr, int fq) const {
    const int row0 = u.pm * 256 + wr * 64 + fr, c0 = (u.pn & 3) * 128 + wc * 32 + 8 * fq;
#pragma unroll
    for (int ai = 0; ai < 2; ++ai)
#pragma unroll
      for (int m = 0; m < 4; ++m) {
        const unsigned row = row0 + ai * 128 + m * 16;
        float h[8];
#pragma unroll
        for (int n = 0; n < 2; ++n)
#pragma unroll
          for (int j = 0; j < 4; ++j) h[n * 4 + j] = siluf_(acc[ai][0][m][n][j]) * acc[ai][1][m][n][j];
        u32x4 w; w.x = pk2(h[0], h[1]); w.y = pk2(h[2], h[3]); w.z = pk2(h[4], h[5]); w.w = pk2(h[6], h[7]);
        *(u32x4*)(Hm + row * DE + c0) = w;
      }
  }
};
struct EpiMoe2 {
  static constexpr bool PERM = true, AFTER_DRAIN = false;
  bf16_t* Y; const float* awp;
  DEV void operator()(const f32x4 (&acc)[2][2][4][2], const Unit& u, int wr, int wc, int fr, int fq) const {
    const int row0 = u.pm * 256 + wr * 64 + fr, c0 = (u.pn & 3) * 256 + wc * 32 + 8 * fq;
#pragma unroll
    for (int ai = 0; ai < 2; ++ai)
#pragma unroll
      for (int m = 0; m < 4; ++m) {
        const unsigned row = row0 + ai * 128 + m * 16;
        const float w8 = awp[row];
#pragma unroll
        for (int bj = 0; bj < 2; ++bj) {
          const f32x4 v0 = acc[ai][bj][m][0] * w8, v1 = acc[ai][bj][m][1] * w8;
          u32x4 w; w.x = pk2(v0[0], v0[1]); w.y = pk2(v0[2], v0[3]); w.z = pk2(v1[0], v1[1]); w.w = pk2(v1[2], v1[3]);
          *(u32x4*)(Y + row * D + c0 + bj * 128) = w;
        }
      }
  }
};
struct EpiMlIn {
  static constexpr bool PERM = false, AFTER_DRAIN = false;
  bf16_t* qb; bf16_t* kb; bf16_t* kT; bf16_t* vT; bf16_t* og;
  DEV void operator()(const f32x4 (&acc)[2][2][4][2], const Unit& u, int wr, int wc, int fr, int fq) const {
    const unsigned row0 = u.pm * 256 + wr * 64 + fr, c0 = u.pn * 256 + wc * 32 + 4 * fq;
    const int pn = u.pn;
#define MLIN_LOOP(BODY) _Pragma("unroll") for (int ai = 0; ai < 2; ++ai) _Pragma("unroll") for (int m = 0; m < 4; ++m) { const unsigned row = row0 + ai * 128 + m * 16; \
      _Pragma("unroll") for (int bj = 0; bj < 2; ++bj) _Pragma("unroll") for (int n = 0; n < 2; ++n) { const f32x4 v = acc[ai][bj][m][n]; const unsigned col = c0 + bj * 128 + n * 16; BODY } }
    if (pn < 2) {
      MLIN_LOOP({ u32x2 o; o.x = pk2(v[0] * 0.125f, v[1] * 0.125f); o.y = pk2(v[2] * 0.125f, v[3] * 0.125f); *(u32x2*)(qb + row * 512 + col) = o; })
    } else if (pn < 4) {
      MLIN_LOOP({ u32x2 o; o.x = pk2(v[0], v[1]); o.y = pk2(v[2], v[3]); *(u32x2*)(kb + row * 512 + col - 512) = o;
        bf16_t* kp = kT + (col - 512) * T + row;
        kp[0] = (bf16_t)(o.x & 0xffffu); kp[T] = (bf16_t)(o.x >> 16); kp[2 * T] = (bf16_t)(o.y & 0xffffu); kp[3 * T] = (bf16_t)(o.y >> 16); })
    } else if (pn < 8) {
      MLIN_LOOP({ u32x2 o; o.x = pk2(v[0], v[1]); o.y = pk2(v[2], v[3]);
        bf16_t* vp = vT + (col - 1024) * T + row;
        vp[0] = (bf16_t)(o.x & 0xffffu); vp[T] = (bf16_t)(o.x >> 16); vp[2 * T] = (bf16_t)(o.y & 0xffffu); vp[3 * T] = (bf16_t)(o.y >> 16); })
    } else {
      MLIN_LOOP({ u32x2 o; o.x = pk2(sigmoidf_(v[0]), sigmoidf_(v[1])); o.y = pk2(sigmoidf_(v[2]), sigmoidf_(v[3])); *(u32x2*)(og + row * D + col - 2048) = o; })
    }
#undef MLIN_LOOP
  }
};

struct MoeOrder {
  const int* tb; int ntn, G, c;
  DEV bool next(int i, Unit& u) const {
    const int U = tb[32], per = (U + 7) >> 3, xcd = c & 7, lo = xcd * per, hi = min(lo + per, U);
    const int L = lo + i * (G >> 3) + (c >> 3); if (L >= hi) return false;
    int e = 0;
#pragma unroll 1
    for (int k = 1; k < 32; ++k) e = (L >= tb[k]) ? k : e;
    const int r = L - tb[e], mt = (tb[e + 1] - tb[e]) / ntn;
    u.pm = tb[33 + e] + r % mt; u.pn = e * ntn + r / mt; return true;
  }
  DEV void a_ready(const Unit&) const {}
  DEV void done(const Unit&) const {}
  const int* rowmap;
  DEV int src_row(const Unit& u, int r) const { return rowmap[u.pm * 256 + r]; }
};
constexpr int LDS_TB = 131072;
DEV void moe_tables(const int* cnt, char* smem, int ntn) {
  int* tb = (int*)(smem + LDS_TB);
  if (threadIdx.x == 0) {
    int ub = 0, rb = 0;
    for (int e = 0; e < 32; ++e) { const int m = (cnt[e * CNT_STRIDE] + 255) >> 8; tb[e] = ub; tb[33 + e] = rb; ub += m * ntn; rb += m; }
    tb[32] = ub; tb[65] = rb;
  }
  __syncthreads();
}

template <int NT>
DEV void wave_gemm16(const bf16_t* A, int lda, const bf16_t* Bt, int ldb, int ks0, int ks1, f32x4 (&acc)[NT]) {
  const int lane = tidf() & 63, fr = lane & 15, fq = lane >> 4;
  const bf16_t* ap = A + (size_t)fr * lda + fq * 8; const bf16_t* bp = Bt + (size_t)fr * ldb + fq * 8;
#pragma unroll 4
  for (int ks = ks0; ks < ks1; ++ks) {
    const bf16x8 a = *(const bf16x8*)(ap + ks * 32);
#pragma unroll
    for (int n = 0; n < NT; ++n) {
      const bf16x8 b = *(const bf16x8*)(bp + (size_t)n * 16 * ldb + ks * 32);
      acc[n] = __builtin_amdgcn_mfma_f32_16x16x32_bf16(a, b, acc[n], 0, 0, 0);
    }
  }
}
DEV void ph_out0_ctx(const Params& p, char* smem) {
  const int tf = tidf(), lane = tf & 63, wv = tf >> 6, fr = lane & 15, fq = lane >> 4;
  const int b = blockIdx.x;
  f32x4* red = (f32x4*)smem;
  if (b < 256) {
    const int rt = b >> 4, cg = b & 15, nt = wv & 3, kh = wv >> 2;
    f32x4 acc[1] = {(f32x4){0.f, 0.f, 0.f, 0.f}};
    wave_gemm16<1>((const bf16_t*)(p.ws + WS_PR) + (size_t)(NL + rt * 16) * DR, DR, (const bf16_t*)(p.ws + WS_WOUT) + (size_t)(cg * 64 + nt * 16) * DR, DR, kh * 20, kh * 20 + 20, acc);
    if (kh == 1) red[nt * 64 + lane] = acc[0];
    __syncthreads();
    if (kh == 0) {
      const f32x4 v = acc[0] + red[nt * 64 + lane];
      const int col = cg * 64 + nt * 16 + fr;
      const float gt = ((const float*)(p.ws + WS_MODS))[6144 + 2048 + col];
      bf16_t* x1 = (bf16_t*)(p.ws + WS_X1);
#pragma unroll
      for (int j = 0; j < 4; ++j) { const int r = rt * 16 + fq * 4 + j; x1[(size_t)(NL + r) * D + col] = f2bf(p.in[2][(size_t)r * D + col] + gt * v[j]); }
    }
  } else __syncthreads();
  __syncthreads();
}
DEV void ph_mlin_small(const Params& p, char* smem) {
  const int tf = tidf(), lane = tf & 63, wv = tf >> 6, fr = lane & 15, fq = lane >> 4;
  const bf16_t* hA = (const bf16_t*)(p.ws + WS_HA); const bf16_t* W = (const bf16_t*)(p.ws + WS_WML);
  bf16_t* kb = (bf16_t*)(p.ws + WS_K); bf16_t* kT = (bf16_t*)(p.ws + WS_KT); bf16_t* vT = (bf16_t*)(p.ws + WS_VT); float* gl = (float*)(p.ws + WS_GL);
  const int b = blockIdx.x;
  if (b < 192) {
    const int rt = b / 12, cg = b % 12, col0 = 512 + cg * 128 + wv * 16;
    f32x4 acc[1] = {(f32x4){0.f, 0.f, 0.f, 0.f}};
    wave_gemm16<1>(hA + (size_t)(NL + rt * 16) * D, D, W + (size_t)col0 * D, D, 0, 32, acc);
    const unsigned col = col0 + fr, row = NL + rt * 16 + fq * 4;
    u32x2 o; o.x = pk2(acc[0][0], acc[0][1]); o.y = pk2(acc[0][2], acc[0][3]);
    if (col < 1024) {
      *(u32x2*)(kT + (col - 512) * T + row) = o;
      kb[(row + 0) * 512 + col - 512] = (bf16_t)(o.x & 0xffffu); kb[(row + 1) * 512 + col - 512] = (bf16_t)(o.x >> 16);
      kb[(row + 2) * 512 + col - 512] = (bf16_t)(o.y & 0xffffu); kb[(row + 3) * 512 + col - 512] = (bf16_t)(o.y >> 16);
    } else *(u32x2*)(vT + (col - 1024) * T + row) = o;
  }
  {
    char* As = smem; float* red = (float*)(smem + 16 * 2064);
    const float* bgt = p.in[29];
    for (int u = blockIdx.x; u < T / 16; u += gridDim.x) {
      __syncthreads();
#pragma unroll
      for (int rr = 0; rr < 2; ++rr) {
        const int r = wv * 2 + rr; const u32x4* src = (const u32x4*)(hA + (size_t)(u * 16 + r) * D);
        const u32x4 v0 = src[lane], v1 = src[lane + 64];
        *(u32x4*)(As + r * 2064 + lane * 16) = v0; *(u32x4*)(As + r * 2064 + 1024 + lane * 16) = v1;
      }
      __syncthreads();
      f32x4 acc[2] = {(f32x4){0.f, 0.f, 0.f, 0.f}, (f32x4){0.f, 0.f, 0.f, 0.f}};
#pragma unroll
      for (int s4 = 0; s4 < 4; ++s4) {
        const int ks = wv * 4 + s4;
        const bf16x8 a = *(const bf16x8*)(As + fr * 2064 + (ks * 32 + fq * 8) * 2);
#pragma unroll
        for (int n = 0; n < 2; ++n) {
          const bf16x8 bb = *(const bf16x8*)(W + (size_t)(3072 + n * 16 + fr) * D + ks * 32 + fq * 8);
          acc[n] = __builtin_amdgcn_mfma_f32_16x16x32_bf16(a, bb, acc[n], 0, 0, 0);
        }
      }
#pragma unroll
      for (int n = 0; n < 2; ++n)
#pragma unroll
        for (int j = 0; j < 4; ++j) red[(wv * 16 + fq * 4 + j) * 32 + n * 16 + fr] = acc[n][j];
      __syncthreads();
      {
        const int row = tf >> 5, jj = tf & 31;
        float g = bgt[jj];
#pragma unroll
        for (int w = 0; w < 8; ++w) g += red[(w * 16 + row) * 32 + jj];
        gl[(size_t)(u * 16 + row) * 32 + jj] = ((jj >> 3) & 1) ? (fminf(g, 0.f) - log1pf(__expf(-fabsf(g)))) : g;
      }
    }
    __syncthreads();
  }
}

template <int WHICH>
DEV void ph_gemm_dense(const Params& p, char* smem) {
  pg8::StaticOrder S;
  LAS unsigned char* lds = (LAS unsigned char*)smem;
  if constexpr (WHICH == 0) {
    S.init(T, 2560, gridDim.x, blockIdx.x);
    EpiRgIn E{(bf16_t*)(p.ws + WS_GG), (bf16_t*)(p.ws + WS_PR)};
    pg8::gemm_phase<EpiRgIn, pg8::StaticOrder>(lds, pg8::Gemm{(const bf16_t*)(p.ws + WS_HA), (const bf16_t*)(p.ws + WS_WIN), T, 2560, 1024}, S, E, nullptr);
  } else if constexpr (WHICH == 1) {
    S.init(NL, 1024, gridDim.x, blockIdx.x);
    EpiOut<0> E{p.in[0], p.in[2], nullptr, (const float*)(p.ws + WS_MODS), (bf16_t*)(p.ws + WS_X1)};
    pg8::gemm_phase<EpiOut<0>, pg8::StaticOrder>(lds, pg8::Gemm{(const bf16_t*)(p.ws + WS_PR), (const bf16_t*)(p.ws + WS_WOUT), NL, 1024, 1280}, S, E, nullptr);
  } else if constexpr (WHICH == 2) {
    S.init(NL, 3072, gridDim.x, blockIdx.x);
    EpiMlIn E{(bf16_t*)(p.ws + WS_Q), (bf16_t*)(p.ws + WS_K), (bf16_t*)(p.ws + WS_KT), (bf16_t*)(p.ws + WS_VT), (bf16_t*)(p.ws + WS_OG)};
    pg8::gemm_phase<EpiMlIn, pg8::StaticOrder>(lds, pg8::Gemm{(const bf16_t*)(p.ws + WS_HA), (const bf16_t*)(p.ws + WS_WML), NL, 3072, 1024}, S, E, nullptr);
  } else {
    S.init(NL, 1024, gridDim.x, blockIdx.x);
    EpiOut<1> E{nullptr, nullptr, (const bf16_t*)(p.ws + WS_X2), (const float*)(p.ws + WS_MODS) + 2 * 6144, (bf16_t*)(p.ws + WS_X1)};
    pg8::gemm_phase<EpiOut<1>, pg8::StaticOrder>(lds, pg8::Gemm{(const bf16_t*)(p.ws + WS_HA), (const bf16_t*)(p.ws + WS_WMO), NL, 1024, 1024}, S, E, nullptr);
  }
}
template <int LAYER, int STAGE>
DEV void ph_gemm_moe(const Params& p, char* smem) {
  const int* cnt = (const int*)(p.ws + WS_CNT) + LAYER * 32 * CNT_STRIDE;
  moe_tables(cnt, smem, 4);
  MoeOrder S{(const int*)(smem + LDS_TB), 4, (int)gridDim.x, (int)blockIdx.x, (const int*)(p.ws + WS_ROWMAP)};
  LAS unsigned char* lds = (LAS unsigned char*)smem;
  const bf16_t* WGU = (const bf16_t*)(p.ws + (LAYER == 0 ? WS_WGU : WS_WGU1)); const bf16_t* WD = (const bf16_t*)(p.ws + (LAYER == 0 ? WS_WD : WS_WD1));
  if constexpr (STAGE == 0) {
    EpiMoe1 E{(bf16_t*)(p.ws + WS_HM)};
    pg8::gemm_phase_gather<EpiMoe1, MoeOrder>(lds, pg8::Gemm{(const bf16_t*)(p.ws + WS_HA), WGU, T, 32 * 1024, 1024}, S, E, nullptr);
  } else {
    EpiMoe2 E{(bf16_t*)(p.ws + WS_Y), (const float*)(p.ws + WS_AWP)};
    pg8::gemm_phase<EpiMoe2, MoeOrder>(lds, pg8::Gemm{(const bf16_t*)(p.ws + WS_HM), WD, MOE_ROWS, 32 * 1024, 512}, S, E, nullptr);
  }
  if constexpr (LAYER == 0) {
    const int* tb = (const int*)(smem + LDS_TB);
    const int U = tb[32], per = (U + 7) >> 3, xcd = blockIdx.x & 7, lo = xcd * per, hi = min(lo + per, U), slot = blockIdx.x >> 3, ns = gridDim.x >> 3;
    const int n1 = max(hi - lo, 0), mine = slot < n1 ? (n1 - slot + ns - 1) / ns : 0, rounds = ((U + 7) / 8 + ns - 1) / ns;
    const int idle = rounds - mine;
    __syncthreads();
    if (idle > 0) conv_queue_l1(p, smem, idle * (STAGE == 0 ? 3 : 1));
  }
}

template <int LAYER>
DEV void ph_scatter(const Params& p, char* smem, int bid, int nb) {
  const int tid = tidx(), lane = tid & 63, wave = tid >> 6;
  constexpr int NTOK = LAYER == 0 ? T : NL;
  constexpr int NU = NTOK / 16;
  int* cnt = (int*)(p.ws + WS_CNT) + LAYER * 32 * CNT_STRIDE;
  const int* eid = (const int*)(p.ws + WS_LIST); const int* hstg = eid + T;
  const float* aw = (const float*)(p.ws + WS_AW);
  int* pos = (int*)(p.ws + WS_POS); float* awp = (float*)(p.ws + WS_AWP);
  const bf16_t* hA = (const bf16_t*)(p.ws + WS_HA); bf16_t* Ab = (bf16_t*)(p.ws + WS_ABUF);
  int* part = (int*)smem;
  int* base = part + 512;
  int* dstl = base + 32;
  {
    const int e = tid & 31, pt = tid >> 5; int tot = 0, below = 0;
    for (int v = pt * (nb / 8); v < (pt + 1) * (nb / 8); ++v) { const int h = hstg[v * 32 + e]; tot += h; below += v < bid ? h : 0; }
    part[(pt * 32 + e) * 2] = tot; part[(pt * 32 + e) * 2 + 1] = below;
  }
  __syncthreads();
  if (tid == 0) {
    int o = 0;
    for (int e = 0; e < 32; ++e) {
      int tot = 0, below = 0;
      for (int pt = 0; pt < 8; ++pt) { tot += part[(pt * 32 + e) * 2]; below += part[(pt * 32 + e) * 2 + 1]; }
      base[e] = o + below; o += ((tot + 255) >> 8) << 8;
      if (bid == 0) cnt[e * CNT_STRIDE] = tot;
    }
    for (int it = 0; bid + it * nb < NU; ++it) {
      const int t0 = (bid + it * nb) * 16;
      for (int i = 0; i < 16; ++i) {
        const int ee = eid[t0 + i], ea = ee & 255, eb = ee >> 8;
        const int da = base[ea]++, db = base[eb]++;
        dstl[it * 32 + 2 * i] = da; dstl[it * 32 + 2 * i + 1] = db;
      }
    }
  }
  __syncthreads();
  for (int it = 0; bid + it * nb < NU; ++it) {
    const int t0 = (bid + it * nb) * 16;
    if (tid < 32) { const int d = dstl[it * 32 + tid]; pos[2 * t0 + tid] = d; awp[d] = aw[2 * t0 + tid]; }
#pragma unroll
    for (int hh = 0; hh < 2; ++hh) {
      u32x4 v0[4], v1[4];
#pragma unroll
      for (int q = 0; q < 4; ++q) { const int a = wave * 8 + hh * 4 + q; const u32x4* src = (const u32x4*)(hA + (size_t)(t0 + (a >> 1)) * D); v0[q] = src[lane]; v1[q] = src[lane + 64]; }
#pragma unroll
      for (int q = 0; q < 4; ++q) { const int a = wave * 8 + hh * 4 + q; u32x4* d = (u32x4*)(Ab + (size_t)dstl[it * 32 + a] * D); d[lane] = v0[q]; d[lane + 64] = v1[q]; }
    }
  }
  __syncthreads();
}

constexpr int RT_STRIDE = 2064;
constexpr int RT_H2 = 0, RT_LO = 16 * RT_STRIDE, RT_RED = 2 * 16 * RT_STRIDE, RT_SMEM = RT_RED + 4 * 16 * 48 * 4;
constexpr int R2_ASTR = 528;
constexpr int R2_AH = 0, R2_AL = 80 * R2_ASTR, R2_RSTD = 2 * 80 * R2_ASTR;
constexpr int R2_RED = 0, R2_LG = 8 * 80 * 48 * 4, R2_HIST = R2_LG + 80 * 48 * 4, R2_SMEM = R2_HIST + 128;
template <int LAYER>
DEV void ph_router2(const Params& p, char* smem) {
  const int tf = tidf(), lane = tf & 63, wv = tf >> 6, fr = lane & 15, fq = lane >> 4;
  const int b = blockIdx.x;
  const bool has_ctx = LAYER == 0 && b < 16;
  const int nrow = has_ctx ? 80 : 64, nmt = has_ctx ? 5 : 4;
  const float* mods = (const float*)(p.ws + WS_MODS) + LAYER * 2 * 6144;
  const bf16_t* x1 = (const bf16_t*)(p.ws + WS_X1);
  bf16_t* hA = (bf16_t*)(p.ws + WS_HA);
  const float* g2 = p.in[LAYER == 0 ? 7 : 27];
  const float* Bg = p.in[LAYER == 0 ? 18 : 33]; const float* Be = p.in[LAYER == 0 ? 20 : 35];
  int* eid = (int*)(p.ws + WS_LIST); int* hstg = eid + T; float* aw = (float*)(p.ws + WS_AW);
  char* AH = smem + R2_AH; char* AL = smem + R2_AL; float* rstd_s = (float*)(smem + R2_RSTD);
  float* red = (float*)(smem + R2_RED); float* lgt = (float*)(smem + R2_LG); int* hist = (int*)(smem + R2_HIST);
  auto tok_of = [&](int r) { return r < 64 ? b * 64 + r : NL + b * 16 + (r - 64); };
  if (tf < 32) hist[tf] = 0;
  for (int rb = 0; rb < nrow; rb += 32) {
    f32x4 v[4][4]; float ss[4];
#pragma unroll
    for (int q = 0; q < 4; ++q) {
      const int r = rb + wv + 8 * q; const int t = tok_of(r < nrow ? r : 0);
      const bf16_t* src = x1 + (size_t)t * D;
#pragma unroll
      for (int i = 0; i < 4; ++i) v[q][i] = ld_bf4(src + 4 * lane + 256 * i);
    }
#pragma unroll
    for (int q = 0; q < 4; ++q) {
      ss[q] = 0.f;
#pragma unroll
      for (int i = 0; i < 4; ++i) ss[q] += v[q][i].x * v[q][i].x + v[q][i].y * v[q][i].y + v[q][i].z * v[q][i].z + v[q][i].w * v[q][i].w;
      ss[q] = rsqrtf(wave_sum(ss[q]) * (1.f / D) + EPS);
    }
#pragma unroll
    for (int q = 0; q < 4; ++q) {
      const int r = rb + wv + 8 * q;
      if (r < nrow) {
        const int t = tok_of(r);
        const float* md = mods + ((LAYER == 0 && t >= NL) ? 6144 : 0);
        if (lane == 0) rstd_s[r] = ss[q];
#pragma unroll
        for (int i = 0; i < 4; ++i) {
          const int c = 4 * lane + 256 * i;
          const f32x4 g = *(const f32x4*)(g2 + c), sh = *(const f32x4*)(md + 3072 + c), sc = *(const f32x4*)(md + 4096 + c);
          const f32x4 h = v[q][i] * ss[q] * g * (1.f + sc) + sh;
          u32x2 o; o.x = pk2(h.x, h.y); o.y = pk2(h.z, h.w);
          *(u32x2*)(hA + (size_t)t * D + c) = o;
        }
      }
    }
  }
  __syncthreads();
  f32x4 acc[5][3];
#pragma unroll
  for (int m = 0; m < 5; ++m)
#pragma unroll
    for (int n = 0; n < 3; ++n) acc[m][n] = (f32x4){0.f, 0.f, 0.f, 0.f};
  const bf16_t* Wh = (const bf16_t*)(p.ws + WS_WR) + (size_t)(LAYER * 2) * 48 * 1024 + (size_t)fr * 1024 + fq * 8;
  const bf16_t* Wl = Wh + 48 * 1024;
#pragma unroll 1
  for (int c = 0; c < 4; ++c) {
    const int k = 256 * c + 4 * lane;
    const f32x4 g = *(const f32x4*)(g2 + k);
    f32x4 xv[10];
#pragma unroll
    for (int q = 0; q < 10; ++q) { const int r = wv + 8 * q; if (r < nrow) xv[q] = ld_bf4(x1 + (size_t)tok_of(r) * D + k); }
#pragma unroll
    for (int q = 0; q < 10; ++q) {
      const int r = wv + 8 * q;
      if (r < nrow) {
        const float* md = mods + ((LAYER == 0 && r >= 64) ? 6144 : 0);
        const f32x4 sh = *(const f32x4*)(md + 3072 + k), sc = *(const f32x4*)(md + 4096 + k);
        const f32x4 h = xv[q] * rstd_s[r] * g * (1.f + sc) + sh;
        u32x2 o; o.x = pk2(h.x, h.y); o.y = pk2(h.z, h.w);
        u32x2 l; l.x = pk2(h.x - bflo(o.x), h.y - bfhi(o.x)); l.y = pk2(h.z - bflo(o.y), h.w - bfhi(o.y));
        *(u32x2*)(AH + r * R2_ASTR + lane * 8) = o; *(u32x2*)(AL + r * R2_ASTR + lane * 8) = l;
      }
    }
    __syncthreads();
    bf16x8 bh[3], bl[3];
#pragma unroll
    for (int n = 0; n < 3; ++n) { bh[n] = *(const bf16x8*)(Wh + (size_t)n * 16 * 1024 + c * 256 + wv * 32); bl[n] = *(const bf16x8*)(Wl + (size_t)n * 16 * 1024 + c * 256 + wv * 32); }
#pragma unroll
    for (int m = 0; m < 5; ++m) {
      if (m < nmt) {
        const bf16x8 ah = *(const bf16x8*)(AH + (m * 16 + fr) * R2_ASTR + (wv * 32 + fq * 8) * 2), al = *(const bf16x8*)(AL + (m * 16 + fr) * R2_ASTR + (wv * 32 + fq * 8) * 2);
#pragma unroll
        for (int n = 0; n < 3; ++n) {
          acc[m][n] = __builtin_amdgcn_mfma_f32_16x16x32_bf16(al, bh[n], acc[m][n], 0, 0, 0);
          acc[m][n] = __builtin_amdgcn_mfma_f32_16x16x32_bf16(ah, bl[n], acc[m][n], 0, 0, 0);
          acc[m][n] = __builtin_amdgcn_mfma_f32_16x16x32_bf16(ah, bh[n], acc[m][n], 0, 0, 0);
        }
      }
    }
    __syncthreads();
  }
#pragma unroll
  for (int m = 0; m < 5; ++m)
    if (m < nmt) {
#pragma unroll
      for (int n = 0; n < 3; ++n)
#pragma unroll
        for (int j = 0; j < 4; ++j) red[(wv * 80 + m * 16 + fq * 4 + j) * 48 + n * 16 + fr] = acc[m][n][j];
    }
  __syncthreads();
  for (int i = tf; i < nrow * 48; i += 512) {
    float sm = 0.f;
#pragma unroll
    for (int w = 0; w < 8; ++w) sm += red[w * 80 * 48 + i];
    lgt[i] = sm;
  }
  __syncthreads();
  if (tf < nrow) {
    const int t = tok_of(tf);
    const float* lg = lgt + tf * 48;
    float gl[4];
#pragma unroll
    for (int i = 0; i < 4; ++i) gl[i] = lg[32 + i] + Bg[i];
    int grp = 0; float gm = gl[0];
#pragma unroll
    for (int i = 1; i < 4; ++i) if (gl[i] > gm) { gm = gl[i]; grp = i; }
    float den = 0.f;
#pragma unroll
    for (int i = 0; i < 4; ++i) den += __expf(gl[i] - gm);
    const float psel = 1.f / den;
    float v0 = -INFINITY, v1 = -INFINITY; int i0 = 0, i1 = 0;
    for (int i = 0; i < 8; ++i) {
      const float v = lg[grp * 8 + i] + Be[grp * 8 + i];
      if (v > v0) { v1 = v0; i1 = i0; v0 = v; i0 = i; }
      else if (v > v1) { v1 = v; i1 = i; }
    }
    const float e1 = __expf(v1 - v0);
    const float w0 = psel / (1.f + e1), w1 = psel * e1 / (1.f + e1);
    const int ea = grp * 8 + i0, eb = grp * 8 + i1;
    eid[t] = ea | (eb << 8);
    aw[2 * t] = w0; aw[2 * t + 1] = w1;
    atomicAdd(&hist[ea], 1); atomicAdd(&hist[eb], 1);
  }
  __syncthreads();
  if (tf < 32) hstg[b * 32 + tf] = hist[tf];
}

template <int LAYER>
DEV void ph_scatter2(const Params& p, char* smem) {
  const int tf = tidf(), lane = tf & 63, wv = tf >> 6;
  const int b = blockIdx.x, G = gridDim.x;
  const bool has_ctx = LAYER == 0 && b < 16;
  const int nrow = has_ctx ? 80 : 64;
  int* cnt = (int*)(p.ws + WS_CNT) + LAYER * 32 * CNT_STRIDE;
  const int* eid = (const int*)(p.ws + WS_LIST); const int* hstg = eid + T;
  const float* aw = (const float*)(p.ws + WS_AW);
  int* pos = (int*)(p.ws + WS_POS); float* awp = (float*)(p.ws + WS_AWP);
  const bf16_t* hA = (const bf16_t*)(p.ws + WS_HA); bf16_t* Ab = (bf16_t*)(p.ws + WS_ABUF);
  int* part = (int*)smem;
  int* base = part + 1024;
  int* dstl = base + 32;
  int* tots = dstl + 160;
  auto tok_of = [&](int r) { return r < 64 ? b * 64 + r : NL + b * 16 + (r - 64); };
  { const int e = tf & 31, pt = tf >> 5, per = (G + 15) / 16; int tot = 0, below = 0;
    for (int v = pt * per; v < (pt + 1) * per && v < G; ++v) { const int h = hstg[v * 32 + e]; tot += h; below += v < b ? h : 0; }
    part[(pt * 32 + e) * 2] = tot; part[(pt * 32 + e) * 2 + 1] = below; }
  __syncthreads();
  if (tf == 0) {
    int o = 0;
    for (int e = 0; e < 32; ++e) {
      int tot = 0, below = 0;
      for (int pt = 0; pt < 16; ++pt) { tot += part[(pt * 32 + e) * 2]; below += part[(pt * 32 + e) * 2 + 1]; }
      base[e] = o + below; tots[2 * e] = tot; o += ((tot + 255) >> 8) << 8;
      if (b == 0) cnt[e * CNT_STRIDE] = tot;
    }
    for (int r = 0; r < nrow; ++r) {
      const int ee = eid[tok_of(r)], ea = ee & 255, eb = ee >> 8;
      dstl[2 * r] = base[ea]++; dstl[2 * r + 1] = base[eb]++;
    }
  }
  __syncthreads();
  int* rowmap = (int*)(p.ws + WS_ROWMAP);
  if (tf < 2 * nrow) { const int t = tok_of(tf >> 1), d = dstl[tf]; pos[2 * t + (tf & 1)] = d; awp[d] = aw[2 * t + (tf & 1)]; rowmap[d] = t; }
  if (b < 32 && tf < 256) {
    int o = 0; for (int e = 0; e < b; ++e) o += ((tots[2 * e] + 255) >> 8) << 8;
    const int tot = tots[2 * b], r = o + tot + tf; if (r < o + (((tot + 255) >> 8) << 8)) { rowmap[r] = 0; awp[r] = 0.f; }
  }
  __syncthreads();
}

DEV void ph_combine0(const Params& p, int bid, int nb) {
  const int lane = tidx() & 63, wave = tidx() >> 6;
  const float* mods0 = (const float*)(p.ws + WS_MODS); const float* mods1 = mods0 + 2 * 6144;
  const bf16_t* x1 = (const bf16_t*)(p.ws + WS_X1); bf16_t* x2 = (bf16_t*)(p.ws + WS_X2);
  const bf16_t* Y = (const bf16_t*)(p.ws + WS_Y); const int* pos = (const int*)(p.ws + WS_POS);
  bf16_t* hA = (bf16_t*)(p.ws + WS_HA);
  const float* g1 = p.in[26];
  for (int t0 = (bid * 4 + wave) * 2; t0 < T; t0 += nb * 8) {
    f32x4 xv[2][4]; u32x2 ya[2][4], yb[2][4];
#pragma unroll
    for (int q = 0; q < 2; ++q) {
      const int t = t0 + q;
      const bf16_t* Ya = Y + (size_t)pos[2 * t] * D; const bf16_t* Yb = Y + (size_t)pos[2 * t + 1] * D;
#pragma unroll
      for (int i = 0; i < 4; ++i) { const int c = 4 * lane + 256 * i; xv[q][i] = ld_bf4(x1 + (size_t)t * D + c); ya[q][i] = *(const u32x2*)(Ya + c); yb[q][i] = *(const u32x2*)(Yb + c); }
    }
#pragma unroll
    for (int q = 0; q < 2; ++q) {
      const int t = t0 + q;
      const float* m0 = mods0 + (t < NL ? 0 : 6144); const float* m1 = mods1 + (t < NL ? 0 : 6144);
      const int orow = t < NL ? seqrow_of_token(t) : t;
      float ss = 0.f;
#pragma unroll
      for (int i = 0; i < 4; ++i) {
        const int c = 4 * lane + 256 * i;
        const f32x4 gt = *(const f32x4*)(m0 + 5120 + c);
        f32x4 f; f.x = bflo(ya[q][i].x) + bflo(yb[q][i].x); f.y = bfhi(ya[q][i].x) + bfhi(yb[q][i].x); f.z = bflo(ya[q][i].y) + bflo(yb[q][i].y); f.w = bfhi(ya[q][i].y) + bfhi(yb[q][i].y);
        xv[q][i] = xv[q][i] + gt * f;
        st_bf4(x2 + (size_t)t * D + c, xv[q][i]);
        ss += xv[q][i].x * xv[q][i].x + xv[q][i].y * xv[q][i].y + xv[q][i].z * xv[q][i].z + xv[q][i].w * xv[q][i].w;
      }
      const float rstd = rsqrtf(wave_sum(ss) * (1.f / D) + EPS);
#pragma unroll
      for (int i = 0; i < 4; ++i) {
        const int c = 4 * lane + 256 * i;
        const f32x4 g = *(const f32x4*)(g1 + c), sh = *(const f32x4*)(m1 + c), sc = *(const f32x4*)(m1 + 1024 + c);
        const f32x4 h = xv[q][i] * rstd * g * (1.f + sc) + sh;
        u32x2 o; o.x = pk2(h.x, h.y); o.y = pk2(h.z, h.w);
        *(u32x2*)(hA + (size_t)orow * D + c) = o;
      }
    }
  }
}

DEV void ml_gate_scans(const float* gl, int r0, int h, float* li_f, float* cf, float* li_b, float* cb) {
  const int tid = tidx(), lane = tid & 63, wave = tid >> 6;
  if (tid < 128) { li_f[tid] = gl[(size_t)(r0 + tid) * 32 + h]; li_b[tid] = gl[(size_t)(r0 + tid) * 32 + 16 + h]; }
  if (wave == 0) {
    const float v0 = gl[(size_t)(r0 + 2 * lane) * 32 + 8 + h], v1 = gl[(size_t)(r0 + 2 * lane + 1) * 32 + 8 + h];
    const float s = v0 + v1; float inc = s;
#pragma unroll
    for (int o = 1; o < 64; o <<= 1) { const float t = __shfl_up(inc, o); if (lane >= o) inc += t; }
    const float ex = inc - s;
    cf[2 * lane] = ex + v0; cf[2 * lane + 1] = ex + s;
  } else if (wave == 1) {
    const float v0 = gl[(size_t)(r0 + 127 - 2 * lane) * 32 + 24 + h], v1 = gl[(size_t)(r0 + 126 - 2 * lane) * 32 + 24 + h];
    const float s = v0 + v1; float inc = s;
#pragma unroll
    for (int o = 1; o < 64; o <<= 1) { const float t = __shfl_up(inc, o); if (lane >= o) inc += t; }
    const float ex = inc - s;
    cb[127 - 2 * lane] = ex + v0; cb[126 - 2 * lane] = ex + s;
  }
}

constexpr int MLA_STRIDE = 272;
constexpr int MLA_AW = 0, MLA_BV = 2 * 64 * MLA_STRIDE, MLA_G = MLA_BV + 128 * MLA_STRIDE, MLA_SMEM = MLA_G + 6 * 128 * 4;
DEV void ph_ml_state(const Params& p, char* smem, int bid, int nb) {
  const int tid = tidx(), lane = tid & 63, wave = tid >> 6, fr = lane & 15, fq = lane >> 4;
  const float* gl = (const float*)(p.ws + WS_GL);
  const bf16_t* kT = (const bf16_t*)(p.ws + WS_KT); const bf16_t* vT = (const bf16_t*)(p.ws + WS_VT);
  float* UT = (float*)(p.ws + WS_UT); float* nvec = (float*)(p.ws + WS_NVEC); float* dec = (float*)(p.ws + WS_DEC);
  char* Aw = smem + MLA_AW; char* Bv = smem + MLA_BV;
  float* li_f = (float*)(smem + MLA_G); float* cf = li_f + 128; float* li_b = cf + 128; float* cb = li_b + 128; float* wf = cb + 128; float* wb = wf + 128;
  for (int it = 0, iters = (NTILE * 8 + nb - 1) / nb; it < iters; ++it) {
    int u = bid + it * nb; const bool active = u < NTILE * 8; if (!active) u = NTILE * 8 - 1;
    const int h = u % 8, c = u / 8, r0 = c * 128;
    __syncthreads();
    if (active) {
    ml_gate_scans(gl, r0, h, li_f, cf, li_b, cb);
    }
    __syncthreads();
    if (active) {
    if (tid < 128) { wf[tid] = __expf(cf[127] - cf[tid] + li_f[tid]); wb[tid] = __expf(cb[0] - cb[tid] + li_b[tid]); }
    if (tid == 0) { dec[(c * 8 + h) * 2] = __expf(cf[127]); dec[(c * 8 + h) * 2 + 1] = __expf(cb[0]); }
#pragma unroll
    for (int i = 0; i < 8; ++i) {
      const int f = tid + 256 * i, e = f >> 4, pc = f & 15;
      *(u32x4*)(Bv + e * MLA_STRIDE + pc * 16) = *(const u32x4*)(vT + (size_t)(h * 128 + e) * T + r0 + pc * 8);
    }
    }
    __syncthreads();
    if (active) {
#pragma unroll
    for (int i = 0; i < 4; ++i) {
      const int f = tid + 256 * i, d = f >> 4, pc = f & 15;
      const u32x4 kv = *(const u32x4*)(kT + (size_t)(h * 64 + d) * T + r0 + pc * 8);
      float k8[8] = {bflo(kv.x), bfhi(kv.x), bflo(kv.y), bfhi(kv.y), bflo(kv.z), bfhi(kv.z), bflo(kv.w), bfhi(kv.w)};
      u32x4 of, ob;
      of.x = pk2(k8[0] * wf[pc * 8 + 0], k8[1] * wf[pc * 8 + 1]); of.y = pk2(k8[2] * wf[pc * 8 + 2], k8[3] * wf[pc * 8 + 3]);
      of.z = pk2(k8[4] * wf[pc * 8 + 4], k8[5] * wf[pc * 8 + 5]); of.w = pk2(k8[6] * wf[pc * 8 + 6], k8[7] * wf[pc * 8 + 7]);
      ob.x = pk2(k8[0] * wb[pc * 8 + 0], k8[1] * wb[pc * 8 + 1]); ob.y = pk2(k8[2] * wb[pc * 8 + 2], k8[3] * wb[pc * 8 + 3]);
      ob.z = pk2(k8[4] * wb[pc * 8 + 4], k8[5] * wb[pc * 8 + 5]); ob.w = pk2(k8[6] * wb[pc * 8 + 6], k8[7] * wb[pc * 8 + 7]);
      *(u32x4*)(Aw + d * MLA_STRIDE + pc * 16) = of;
      *(u32x4*)(Aw + (64 + d) * MLA_STRIDE + pc * 16) = ob;
    }
    }
    __syncthreads();
    if (active) {
    if (tid < 128) {
      float s = 0.f;
      for (int pc = 0; pc < 16; ++pc) { const u32x4 v = *(const u32x4*)(Aw + tid * MLA_STRIDE + pc * 16);
        s += (bflo(v.x) + bfhi(v.x)) + (bflo(v.y) + bfhi(v.y)) + (bflo(v.z) + bfhi(v.z)) + (bflo(v.w) + bfhi(v.w)); }
      nvec[(size_t)((c * 8 + h) * 2 + (tid >> 6)) * 64 + (tid & 63)] = s;
    }
#pragma unroll
    for (int dir = 0; dir < 2; ++dir) {
      f32x4 acc[4][2];
#pragma unroll
      for (int m = 0; m < 4; ++m) { acc[m][0] = (f32x4){0.f, 0.f, 0.f, 0.f}; acc[m][1] = (f32x4){0.f, 0.f, 0.f, 0.f}; }
#pragma unroll
      for (int ks = 0; ks < 4; ++ks) {
        bf16x8 b[2];
#pragma unroll
        for (int n = 0; n < 2; ++n) b[n] = *(const bf16x8*)(Bv + (wave * 32 + n * 16 + fr) * MLA_STRIDE + (ks * 32 + fq * 8) * 2);
#pragma unroll
        for (int m = 0; m < 4; ++m) {
          const bf16x8 a = *(const bf16x8*)(Aw + (dir * 64 + m * 16 + fr) * MLA_STRIDE + (ks * 32 + fq * 8) * 2);
          acc[m][0] = __builtin_amdgcn_mfma_f32_16x16x32_bf16(a, b[0], acc[m][0], 0, 0, 0);
          acc[m][1] = __builtin_amdgcn_mfma_f32_16x16x32_bf16(a, b[1], acc[m][1], 0, 0, 0);
        }
      }
      float* Uo = UT + (size_t)((c * 8 + h) * 2 + dir) * 8192;
#pragma unroll
      for (int m = 0; m < 4; ++m)
#pragma unroll
        for (int n = 0; n < 2; ++n) *(f32x4*)(Uo + (wave * 32 + n * 16 + fr) * 64 + m * 16 + fq * 4) = acc[m][n];
    }
    }
  }
}

DEV void ph_ml_chain(const Params& p, int bid, int nb) {
  float* UT = (float*)(p.ws + WS_UT); float* nvec = (float*)(p.ws + WS_NVEC); const float* dec = (const float*)(p.ws + WS_DEC);
  const int total = 16 * (8192 + 64);
  for (int i = bid * 256 + tidx(); i < total; i += nb * 256) {
    const int hd = i / 8256, idx = i % 8256;
    const int dir = hd & 1;
    float* base = idx < 8192 ? UT + (size_t)hd * 8192 + idx : nvec + (size_t)hd * 64 + (idx - 8192);
    const size_t cstride = idx < 8192 ? (size_t)16 * 8192 : (size_t)16 * 64;
    float st = 0.f;
#pragma unroll 1
    for (int sb = 0; sb < NTILE; sb += 13) {
      float uv[13], dc[13];
#pragma unroll
      for (int j = 0; j < 13; ++j) {
        const int s = sb + j; const int c = dir == 0 ? (s < 2 ? 128 + s : s - 2) : 129 - s;
        uv[j] = base[(size_t)c * cstride]; dc[j] = dec[c * 16 + hd];
      }
#pragma unroll
      for (int j = 0; j < 13; ++j) {
        const int s = sb + j; const int c = dir == 0 ? (s < 2 ? 128 + s : s - 2) : 129 - s;
        base[(size_t)c * cstride] = st;
        st = dc[j] * st + uv[j];
      }
    }
  }
}

constexpr int MLC_QS = 0;
constexpr int MLC_KS = 9216;
constexpr int MLC_Q2 = MLC_KS + 18432;
constexpr int MLC_BS = MLC_Q2 + 17408;
constexpr int MLC_G  = MLC_BS + 18432;
constexpr int MLC_SMEM = MLC_G + (4 * 128 + 6 * 64) * 4;
DEV void ph_ml_out(const Params& p, char* smem, int bid, int nb) {
  const int tid = tidx(), lane = tid & 63, wave = tid >> 6, fr = lane & 15, fq = lane >> 4;
  const float* gl = (const float*)(p.ws + WS_GL);
  const bf16_t* qb = (const bf16_t*)(p.ws + WS_Q); const bf16_t* kb = (const bf16_t*)(p.ws + WS_K); const bf16_t* vT = (const bf16_t*)(p.ws + WS_VT);
  const bf16_t* og = (const bf16_t*)(p.ws + WS_OG);
  const float* UT = (const float*)(p.ws + WS_UT); const float* nvec = (const float*)(p.ws + WS_NVEC);
  bf16_t* yA = (bf16_t*)(p.ws + WS_HA);
  const float* ng = p.in[30];
  char* Qs = smem + MLC_QS; char* Ks = smem + MLC_KS; char* Ps = Ks; char* Q2 = smem + MLC_Q2; char* Bs = smem + MLC_BS;
  float* li_f = (float*)(smem + MLC_G); float* cf = li_f + 128; float* li_b = cf + 128; float* cb = li_b + 128;
  float* qn = cb + 128; float* sfq = qn + 128; float* sbq = sfq + 64; float* nv = sbq + 64;
  for (int it = 0, iters = ((128 * 2 * 8) + nb - 1) / nb; it < iters; ++it) {
    int u = bid + it * nb; const bool active = u < (128 * 2 * 8); if (!active) u = (128 * 2 * 8) - 1;
    const int h = u % 8, th = (u / 8) & 1, c = u / 16, r0 = c * 128, rt = r0 + th * 64;
    __syncthreads();
    ml_gate_scans(gl, r0, h, li_f, cf, li_b, cb);
    if (tid >= 128) nv[tid - 128] = nvec[(size_t)((c * 8 + h) * 2 + ((tid - 128) >> 6)) * 64 + (tid & 63)];
#pragma unroll
    for (int i = 0; i < 2; ++i) { const int f = tid + 256 * i, r = f >> 3, pc = f & 7;
      *(u32x4*)(Qs + r * 144 + pc * 16) = *(const u32x4*)(qb + (size_t)(rt + r) * 512 + h * 64 + pc * 8); }
#pragma unroll
    for (int i = 0; i < 4; ++i) { const int f = tid + 256 * i, r = f >> 3, pc = f & 7;
      *(u32x4*)(Ks + r * 144 + pc * 16) = *(const u32x4*)(kb + (size_t)(r0 + r) * 512 + h * 64 + pc * 8); }
    __syncthreads();
    if (tid < 128) {
      const int t = tid & 63, dir = tid >> 6; float s = 0.f;
      for (int pc = 0; pc < 8; ++pc) { const u32x4 v = *(const u32x4*)(Qs + t * 144 + pc * 16); const float* nn = nv + dir * 64 + pc * 8;
        s += bflo(v.x) * nn[0] + bfhi(v.x) * nn[1] + bflo(v.y) * nn[2] + bfhi(v.y) * nn[3] + bflo(v.z) * nn[4] + bfhi(v.z) * nn[5] + bflo(v.w) * nn[6] + bfhi(v.w) * nn[7]; }
      qn[dir * 64 + t] = s;
    }
    f32x4 S[8];
#pragma unroll
    for (int n = 0; n < 8; ++n) S[n] = (f32x4){0.f, 0.f, 0.f, 0.f};
#pragma unroll
    for (int ks = 0; ks < 2; ++ks) {
      const bf16x8 a = *(const bf16x8*)(Qs + (wave * 16 + fr) * 144 + (ks * 32 + fq * 8) * 2);
#pragma unroll
      for (int n = 0; n < 8; ++n) {
        const bf16x8 b = *(const bf16x8*)(Ks + (n * 16 + fr) * 144 + (ks * 32 + fq * 8) * 2);
        S[n] = __builtin_amdgcn_mfma_f32_16x16x32_bf16(a, b, S[n], 0, 0, 0);
      }
    }
    __syncthreads();
    float rfv[4], rbv[4];
    {
      float sumf[4] = {0.f, 0.f, 0.f, 0.f}, sumb[4] = {0.f, 0.f, 0.f, 0.f};
      float Sf[8][4], Sb_[8][4];
#pragma unroll
      for (int j = 0; j < 4; ++j) {
        const int tl = wave * 16 + fq * 4 + j, tc = th * 64 + tl;
        const float cft = cf[tc], cbt = cb[tc];
#pragma unroll
        for (int n = 0; n < 8; ++n) {
          const int s = n * 16 + fr;
          const float df = s <= tc ? fexp_(cft - cf[s] + li_f[s]) : 0.f;
          const float db = s >= tc ? fexp_(cbt - cb[s] + li_b[s]) : 0.f;
          Sf[n][j] = S[n][j] * df; Sb_[n][j] = S[n][j] * db;
          sumf[j] += Sf[n][j]; sumb[j] += Sb_[n][j];
        }
      }
#pragma unroll
      for (int j = 0; j < 4; ++j) {
#pragma unroll
        for (int o = 1; o < 16; o <<= 1) { sumf[j] += __shfl_xor(sumf[j], o); sumb[j] += __shfl_xor(sumb[j], o); }
        const int tl = wave * 16 + fq * 4 + j, tc = th * 64 + tl;
        const float ef = __expf(cf[tc]), eb = __expf(cb[tc]);
        const float denf = ef * qn[tl] + sumf[j], denb = eb * qn[64 + tl] + sumb[j];
        rfv[j] = __builtin_amdgcn_rcpf(fmaxf(fabsf(denf), 1.f)); rbv[j] = __builtin_amdgcn_rcpf(fmaxf(fabsf(denb), 1.f));
        if (fr == 0) { sfq[tl] = ef * rfv[j]; sbq[tl] = eb * rbv[j]; }
      }
#pragma unroll
      for (int n = 0; n < 8; ++n)
#pragma unroll
        for (int j = 0; j < 4; ++j) {
          const int tl = wave * 16 + fq * 4 + j;
          *(bf16_t*)(Ps + tl * MLA_STRIDE + (n * 16 + fr) * 2) = f2bf(Sf[n][j] * rfv[j] + Sb_[n][j] * rbv[j]);
        }
    }
    __syncthreads();
#pragma unroll
    for (int i = 0; i < 2; ++i) { const int f = tid + 256 * i, r = f >> 3, pc = f & 7;
      const u32x4 v = *(const u32x4*)(Qs + r * 144 + pc * 16); const float a = sfq[r], b = sbq[r];
      u32x4 o1, o2;
      o1.x = pk2(bflo(v.x) * a, bfhi(v.x) * a); o1.y = pk2(bflo(v.y) * a, bfhi(v.y) * a); o1.z = pk2(bflo(v.z) * a, bfhi(v.z) * a); o1.w = pk2(bflo(v.w) * a, bfhi(v.w) * a);
      o2.x = pk2(bflo(v.x) * b, bfhi(v.x) * b); o2.y = pk2(bflo(v.y) * b, bfhi(v.y) * b); o2.z = pk2(bflo(v.z) * b, bfhi(v.z) * b); o2.w = pk2(bflo(v.w) * b, bfhi(v.w) * b);
      *(u32x4*)(Q2 + r * MLA_STRIDE + pc * 16) = o1; *(u32x4*)(Q2 + r * MLA_STRIDE + 128 + pc * 16) = o2; }
    f32x4 Hh[8];
#pragma unroll
    for (int n = 0; n < 8; ++n) Hh[n] = (f32x4){0.f, 0.f, 0.f, 0.f};
#pragma unroll
    for (int kc = 0; kc < 4; ++kc) {
      __syncthreads();
      if (kc < 2) {
#pragma unroll
        for (int i = 0; i < 4; ++i) { const int f = tid + 256 * i, e = f >> 3, pc = f & 7;
          *(u32x4*)(Bs + e * 144 + pc * 16) = *(const u32x4*)(vT + (size_t)(h * 128 + e) * T + r0 + kc * 64 + pc * 8); }
      } else {
        const float* Cs = UT + (size_t)((c * 8 + h) * 2 + (kc - 2)) * 8192;
#pragma unroll
        for (int i = 0; i < 4; ++i) { const int f = tid + 256 * i, e = f >> 3, pc = f & 7;
          const f32x4 a = *(const f32x4*)(Cs + e * 64 + pc * 8), b = *(const f32x4*)(Cs + e * 64 + pc * 8 + 4);
          u32x4 o; o.x = pk2(a.x, a.y); o.y = pk2(a.z, a.w); o.z = pk2(b.x, b.y); o.w = pk2(b.z, b.w);
          *(u32x4*)(Bs + e * 144 + pc * 16) = o; }
      }
      __syncthreads();
      const char* Asrc = kc < 2 ? Ps + kc * 128 : Q2 + (kc - 2) * 128;
#pragma unroll
      for (int ks = 0; ks < 2; ++ks) {
        const bf16x8 a = *(const bf16x8*)(Asrc + (wave * 16 + fr) * MLA_STRIDE + (ks * 32 + fq * 8) * 2);
#pragma unroll
        for (int n = 0; n < 8; ++n) {
          const bf16x8 b = *(const bf16x8*)(Bs + (n * 16 + fr) * 144 + (ks * 32 + fq * 8) * 2);
          Hh[n] = __builtin_amdgcn_mfma_f32_16x16x32_bf16(a, b, Hh[n], 0, 0, 0);
        }
      }
    }
#pragma unroll
    for (int j = 0; j < 4; ++j) {
      float ss = 0.f;
#pragma unroll
      for (int n = 0; n < 8; ++n) ss += Hh[n][j] * Hh[n][j];
#pragma unroll
      for (int o = 1; o < 16; o <<= 1) ss += __shfl_xor(ss, o);
      const float rstd = rsqrtf(ss * (1.f / 128.f) + EPS);
      const size_t row = (size_t)(rt + wave * 16 + fq * 4 + j);
#pragma unroll
      for (int n = 0; n < 8; ++n) {
        const int col = h * 128 + n * 16 + fr;
        yA[row * D + col] = f2bf(Hh[n][j] * rstd * ng[col] * bf2f(og[row * D + col]));
      }
    }
  }
}

DEV void ph_final(const Params& p, int bid, int nb) {
  const int lane = tidx() & 63, wave = tidx() >> 6;
  const float* mods1 = (const float*)(p.ws + WS_MODS) + 2 * 6144;
  const bf16_t* x1 = (const bf16_t*)(p.ws + WS_X1);
  const bf16_t* Y = (const bf16_t*)(p.ws + WS_Y); const int* pos = (const int*)(p.ws + WS_POS);
  const float* gf = p.in[39];
  for (int t0 = (bid * 4 + wave) * 2; t0 < NL; t0 += nb * 8) {
    f32x4 xv[2][4]; u32x2 ya[2][4], yb[2][4];
#pragma unroll
    for (int q = 0; q < 2; ++q) {
      const int t = t0 + q;
      const bf16_t* Ya = Y + (size_t)pos[2 * t] * D; const bf16_t* Yb = Y + (size_t)pos[2 * t + 1] * D;
#pragma unroll
      for (int i = 0; i < 4; ++i) { const int c = 4 * lane + 256 * i; xv[q][i] = ld_bf4(x1 + (size_t)t * D + c); ya[q][i] = *(const u32x2*)(Ya + c); yb[q][i] = *(const u32x2*)(Yb + c); }
    }
#pragma unroll
    for (int q = 0; q < 2; ++q) {
      const int t = t0 + q;
      float ss = 0.f;
#pragma unroll
      for (int i = 0; i < 4; ++i) {
        const int c = 4 * lane + 256 * i;
        const f32x4 gt = *(const f32x4*)(mods1 + 5120 + c);
        f32x4 f; f.x = bflo(ya[q][i].x) + bflo(yb[q][i].x); f.y = bfhi(ya[q][i].x) + bfhi(yb[q][i].x); f.z = bflo(ya[q][i].y) + bflo(yb[q][i].y); f.w = bfhi(ya[q][i].y) + bfhi(yb[q][i].y);
        xv[q][i] = xv[q][i] + gt * f;
        ss += xv[q][i].x * xv[q][i].x + xv[q][i].y * xv[q][i].y + xv[q][i].z * xv[q][i].z + xv[q][i].w * xv[q][i].w;
      }
      const float rstd = rsqrtf(wave_sum(ss) * (1.f / D) + EPS);
#pragma unroll
      for (int i = 0; i < 4; ++i) {
        const int c = 4 * lane + 256 * i;
        *(f32x4*)(p.out + (size_t)t * D + c) = xv[q][i] * rstd * *(const f32x4*)(gf + c);
      }
    }
  }
}

#define XB_TMO      128
#define XB_XCNT(j)  (256  + 64 * (j))
#define XB_XSUB(j)  (1280 + 64 * (j))
#define XB_XGEN(j)  (2304 + 64 * (j))
#define XB_TOP      3328
#define XB_TOPGEN   3392
#define XCD_BAR_WORDS 3456
#define XB_SPIN_CAP (1u << 22)
DEV unsigned xb_ld(unsigned* p)              { return __hip_atomic_load(p, __ATOMIC_RELAXED, __HIP_MEMORY_SCOPE_AGENT); }
DEV unsigned xb_add(unsigned* p, unsigned v) { return __hip_atomic_fetch_add(p, v, __ATOMIC_RELAXED, __HIP_MEMORY_SCOPE_AGENT); }
DEV unsigned xb_xcc_id() { return (unsigned)__builtin_amdgcn_s_getreg((3 << 11) | 20) & 0xFu; }
#define XB_SPIN(cond, bar) do { unsigned _sp = 0; while (cond) { __builtin_amdgcn_s_sleep(1); \
    if ((++_sp & 255u) == 0u) { if (xb_ld(&(bar)[XB_TMO])) break; if (_sp > XB_SPIN_CAP) { atomicAdd(&(bar)[XB_TMO], 1u); break; } } } } while (0)
struct XcdBarrier { unsigned* bar; unsigned x; volatile LAS unsigned* st; };
DEV XcdBarrier xcd_barrier_post(unsigned* bar, volatile LAS unsigned* st) {
  XcdBarrier b; b.bar = bar; b.x = xb_xcc_id(); b.st = st;
  if (threadIdx.x == 0) (void)xb_add(&bar[XB_XCNT(b.x)], 1u);
  return b;
}
DEV void xcd_barrier_complete(unsigned* bar, unsigned x, unsigned& nloc, unsigned& nx) {
  const unsigned G = gridDim.x * gridDim.y * gridDim.z;
  unsigned sum, cnt, mine, sp = 0u;
  for (;;) {
    sum = 0u; cnt = 0u; mine = 0u;
#pragma unroll
    for (unsigned j = 0; j < 16; ++j) { const unsigned c = xb_ld(&bar[XB_XCNT(j)]); sum += c; cnt += (c > 0u) ? 1u : 0u; mine = (j == x) ? c : mine; }
    if (sum == G) break;
    __builtin_amdgcn_s_sleep(1);
    if ((++sp & 255u) == 0u) { if (xb_ld(&bar[XB_TMO])) break; if (sp > XB_SPIN_CAP) { atomicAdd(&bar[XB_TMO], 1u); break; } }
  }
  nloc = mine > 0u ? mine : 1u; nx = cnt > 0u ? cnt : 1u;
}
DEV void xcd_barrier(const XcdBarrier& b) {
  asm volatile("s_waitcnt vmcnt(0)" ::: "memory");
  __syncthreads();
  if (threadIdx.x == 0) {
    unsigned* bar = b.bar;
    __builtin_amdgcn_s_waitcnt(0);
    unsigned nloc = b.st[0], nx = b.st[1];
    if (nloc == 0u) { xcd_barrier_complete(bar, b.x, nloc, nx); b.st[0] = nloc; b.st[1] = nx; }
    const unsigned old = xb_add(&bar[XB_XSUB(b.x)], 1u);
    const unsigned gen = old / nloc;
    if (old + 1u == (gen + 1u) * nloc) {
      __builtin_amdgcn_fence(__ATOMIC_RELEASE, "agent");
      asm volatile("s_waitcnt vmcnt(0)" ::: "memory");
      const unsigned og = xb_add(&bar[XB_TOP], 1u);
      const unsigned tg = og / nx;
      if (og + 1u == (tg + 1u) * nx) xb_add(&bar[XB_TOPGEN], 1u);
      else XB_SPIN(xb_ld(&bar[XB_TOPGEN]) == tg, bar);
      __builtin_amdgcn_fence(__ATOMIC_ACQUIRE, "agent");
      xb_add(&bar[XB_XGEN(b.x)], 1u);
      asm volatile("s_waitcnt vmcnt(0)" ::: "memory");
    } else {
      XB_SPIN(xb_ld(&bar[XB_XGEN(b.x)]) == gen, bar);
      __builtin_amdgcn_fence(__ATOMIC_ACQUIRE, "agent");
      asm volatile("s_waitcnt vmcnt(0)" ::: "memory");
    }
  }
  __syncthreads();
}

#ifndef REP_MASK
#define REP_MASK 0u
#endif
#ifndef PROBE_PH
#define PROBE_PH -1
#endif
#ifndef PROBE_M
#define PROBE_M 4
#endif
#ifndef XBAR
#define XBAR 0
#endif
constexpr int NPHASE = 22;
constexpr int HALF_SMEM = 78592;
constexpr int LDS_ST = 2 * HALF_SMEM;
constexpr int LDS_BYTES = LDS_ST + 16 + 32;
static_assert(RT_SMEM + 128 <= HALF_SMEM && RG_SMEM <= HALF_SMEM && MLA_SMEM <= HALF_SMEM && MLC_SMEM <= HALF_SMEM, "smem");
static_assert(LDS_TB + 66 * 4 <= LDS_ST && 8 * 8448 <= LDS_ST, "smem");

template <int PH>
DEV void run_phase(const Params& p, char* smem) {
  int half = threadIdx.x >> 8; asm volatile("" : "+v"(half)); half = __builtin_amdgcn_readfirstlane(half);
  char* hs = smem + half * HALF_SMEM;
  const int vb = blockIdx.x * 2 + half, nvb = gridDim.x * 2;
  if constexpr (PH == 0) { ph_adaln(p, hs, vb, nvb); __syncthreads(); ph_convert_dense(p, smem); ph_convert_moe<0>(p, smem); }
  else if constexpr (PH == 1) ph_norm0(p, vb, nvb);
  else if constexpr (PH == 2) ph_gemm_dense<0>(p, smem);
  else if constexpr (PH == 3) ph_rg_scan2(p, smem);
  else if constexpr (PH == 4) ph_rg_carry(p, hs, vb, nvb);
  else if constexpr (PH == 5) ph_rg_final(p, vb, nvb);
  else if constexpr (PH == 6) { ph_out0_ctx(p, smem); ph_gemm_dense<1>(p, smem); }
  else if constexpr (PH == 7) ph_router2<0>(p, smem);
  else if constexpr (PH == 8) ph_scatter2<0>(p, smem);
  else if constexpr (PH == 9) ph_gemm_moe<0, 0>(p, smem);
  else if constexpr (PH == 10) ph_gemm_moe<0, 1>(p, smem);
  else if constexpr (PH == 11) { ph_combine0(p, vb, nvb); __syncthreads(); conv_queue_l1(p, smem, -1); }
  else if constexpr (PH == 12) { ph_mlin_small(p, smem); ph_gemm_dense<2>(p, smem); }
  else if constexpr (PH == 13) ph_ml_state(p, hs, vb, nvb);
  else if constexpr (PH == 14) ph_ml_chain(p, vb, nvb);
  else if constexpr (PH == 15) ph_ml_out(p, hs, vb, nvb);
  else if constexpr (PH == 16) ph_gemm_dense<3>(p, smem);
  else if constexpr (PH == 17) ph_router2<1>(p, smem);
  else if constexpr (PH == 18) ph_scatter2<1>(p, smem);
  else if constexpr (PH == 19) ph_gemm_moe<1, 0>(p, smem);
  else if constexpr (PH == 20) ph_gemm_moe<1, 1>(p, smem);
  else if constexpr (PH == 21) ph_final(p, vb, nvb);
}

template <int PH>
DEV void run_from(const Params& p, char* smem) {
  run_phase<PH>(p, smem);
  if constexpr ((REP_MASK >> PH) & 1u) {
    __syncthreads();
    run_phase<PH>(p, smem);
  }
  if constexpr (XBAR > 0 && PH + 1 < NPHASE) {
#pragma unroll 1
    for (int xi = 0; xi < XBAR; ++xi) { XcdBarrier xb; xb.bar = (unsigned*)(p.ws + WS_BAR); xb.x = xb_xcc_id(); xb.st = (volatile LAS unsigned*)(LAS char*)(smem + LDS_ST); xcd_barrier(xb); }
  }
  if constexpr (PH + 1 < NPHASE) {
    XcdBarrier xb; xb.bar = (unsigned*)(p.ws + WS_BAR); xb.x = xb_xcc_id(); xb.st = (volatile LAS unsigned*)(LAS char*)(smem + LDS_ST);
    xcd_barrier(xb);
    if constexpr (PROBE_PH >= 0 && (PH == PROBE_PH || PH + 1 == PROBE_PH)) {
      if (blockIdx.x == 0 && threadIdx.x == 0) { volatile LAS unsigned long long* ts = (volatile LAS unsigned long long*)(LAS char*)(smem + LDS_ST + 16); ts[PH == PROBE_PH ? 1 : 0] = __builtin_amdgcn_s_memrealtime(); }
    }
    run_from<PH + 1>(p, smem);
  } else if constexpr (PROBE_PH >= 0) {
    if (blockIdx.x == 0 && threadIdx.x == 0) {
      volatile LAS unsigned long long* ts = (volatile LAS unsigned long long*)(LAS char*)(smem + LDS_ST + 16);
      const unsigned long long now = __builtin_amdgcn_s_memrealtime();
      const unsigned long long t1 = PROBE_PH == NPHASE - 1 ? now : ts[1];
      const unsigned long long span = (t1 - ts[0]) * PROBE_M;
      while (__builtin_amdgcn_s_memrealtime() - now < span) __builtin_amdgcn_s_sleep(8);
    }
  }
}

__global__ void __launch_bounds__(512) mega_kernel(Params p) {
  extern __shared__ __attribute__((aligned(16))) char smem[];
  volatile LAS unsigned* st = (volatile LAS unsigned*)(LAS char*)(smem + LDS_ST);
  if (threadIdx.x == 0) { st[0] = 0u; st[1] = 0u; st[2] = 0u; st[3] = 0u; }
  __syncthreads();
  (void)xcd_barrier_post((unsigned*)(p.ws + WS_BAR), st);
  if (PROBE_PH == 0 && blockIdx.x == 0 && threadIdx.x == 0) { volatile LAS unsigned long long* ts = (volatile LAS unsigned long long*)(LAS char*)(smem + LDS_ST + 16); ts[0] = __builtin_amdgcn_s_memrealtime(); }
  run_from<0>(p, smem);
}

extern "C" void kernel_launch(void* const* d_in, const int* in_sizes, int n_in, void* d_out, int out_size, void* d_ws, size_t ws_size, hipStream_t stream) {
  static int grid = 0;
  if (grid == 0) {
    if (n_in != 40 || ws_size < WS_END) { fprintf(stderr, "kernel_launch: unexpected inputs (n_in %d, ws %zu, need %zu)\n", n_in, ws_size, (size_t)WS_END); grid = -1; return; }
    int dev = 0, cus = 0, per_cu = 0;
    if (hipGetDevice(&dev) != hipSuccess || hipDeviceGetAttribute(&cus, hipDeviceAttributeMultiprocessorCount, dev) != hipSuccess) { grid = -1; return; }
    if (hipFuncSetAttribute((const void*)mega_kernel, hipFuncAttributeMaxDynamicSharedMemorySize, LDS_BYTES) != hipSuccess) { fprintf(stderr, "kernel_launch: hipFuncSetAttribute failed\n"); grid = -1; return; }
    if (hipOccupancyMaxActiveBlocksPerMultiprocessor(&per_cu, (const void*)mega_kernel, 512, LDS_BYTES) != hipSuccess || per_cu < 1) { fprintf(stderr, "kernel_launch: occupancy query failed (%d)\n", per_cu); grid = -1; return; }
    grid = cus;
    fprintf(stderr, "kernel_launch: %d CUs, occupancy %d\n", cus, per_cu);
  }
  if (grid < 0) return;
  Params p{};
  for (int i = 0; i < 40; ++i) p.in[i] = (const float*)d_in[i];
  p.out = (float*)d_out; p.ws = (char*)d_ws;
  if (hipMemsetAsync((char*)d_ws, 0, WS_ZERO_BYTES, stream) != hipSuccess) return;
  void* args[] = {&p};
  hipError_t e = hipLaunchCooperativeKernel((const void*)mega_kernel, dim3(grid), dim3(512), args, LDS_BYTES, stream);
  if (e != hipSuccess) fprintf(stderr, "cooperative launch failed: %s (grid %d)\n", hipGetErrorString(e), grid);
}
```

```cpp
#include <hip/hip_runtime.h>
#include <cstdio>
#include <cstdint>

#define DEV __device__ __forceinline__
typedef unsigned short bf16_t;
typedef short bf16x8 __attribute__((ext_vector_type(8)));
typedef short s16x4 __attribute__((ext_vector_type(4)));
typedef float f32x4 __attribute__((ext_vector_type(4)));
typedef unsigned u32x4 __attribute__((ext_vector_type(4)));
typedef unsigned u32x2 __attribute__((ext_vector_type(2)));
#define LAS __attribute__((address_space(3)))

constexpr int D = 1024, NL = 16384, NC = 256, T = NL + NC, NTILE = T / 128;
constexpr int DR = 1280, NEXP = 32, DE = 512;
constexpr int RGT = 64, NRT = T / RGT, NRT_LAT = NL / RGT;
constexpr int MLW = 3104, MLWP = 3328;
constexpr int MOE_ROWS = 41472;
constexpr float EPS = 1e-6f;

constexpr size_t al256(size_t x) { return (x + 255) & ~(size_t)255; }
constexpr size_t WS_BAR   = 0;
constexpr size_t WS_CNT   = 16384;
constexpr int CNT_STRIDE = 64;
constexpr size_t WS_CONVQ = 16384 + 2 * 32 * CNT_STRIDE * 4;
constexpr size_t WS_ZERO_BYTES = WS_CONVQ + 256;
constexpr size_t WS_MODS  = al256(WS_ZERO_BYTES);
constexpr size_t WS_LIST  = WS_MODS + al256(2 * 2 * 6144 * 4);
constexpr size_t WS_AW    = WS_LIST + al256((size_t)2 * 32 * T * 4);
constexpr size_t WS_POS   = WS_AW + al256((size_t)2 * T * 4);
constexpr size_t WS_AWP   = WS_POS + al256((size_t)2 * T * 4);
constexpr size_t WS_ROWMAP = WS_AWP + al256((size_t)MOE_ROWS * 4);
constexpr size_t WS_AGG   = WS_ROWMAP + al256((size_t)MOE_ROWS * 4);
constexpr size_t WS_CARRY = WS_AGG + al256((size_t)2 * NRT * DR * 2 * 4);
constexpr size_t WS_GL    = WS_CARRY + al256((size_t)2 * NRT * DR * 4);
constexpr size_t WS_NVEC  = WS_GL + al256((size_t)T * 32 * 4);
constexpr size_t WS_DEC   = WS_NVEC + al256((size_t)NTILE * 16 * 64 * 4);
constexpr size_t WS_WIN   = WS_DEC + al256((size_t)NTILE * 16 * 4);
constexpr size_t WS_WOUT  = WS_WIN + al256((size_t)2560 * 1024 * 2);
constexpr size_t WS_WML   = WS_WOUT + al256((size_t)1024 * 1280 * 2);
constexpr size_t WS_WMO   = WS_WML + al256((size_t)MLWP * 1024 * 2);
constexpr size_t WS_WGU   = WS_WMO + al256((size_t)1024 * 1024 * 2);
constexpr size_t WS_WD    = WS_WGU + al256((size_t)32 * 1024 * 1024 * 2);
constexpr size_t WS_WGU1  = WS_WD + al256((size_t)32 * 1024 * 512 * 2);
constexpr size_t WS_WD1   = WS_WGU1 + al256((size_t)32 * 1024 * 1024 * 2);
constexpr size_t WS_WAXT  = WS_WD1 + al256((size_t)32 * 1024 * 512 * 2);
constexpr size_t WS_WR    = WS_WAXT + al256((size_t)40 * 16384 * 2);
constexpr size_t WS_HA    = WS_WR + al256((size_t)2 * 64 * 64 * 12 * 4);
constexpr size_t WS_X1    = WS_HA + al256((size_t)T * D * 2);
constexpr size_t WS_X2    = WS_X1 + al256((size_t)T * D * 2);
constexpr size_t WS_R0    = WS_X2 + al256((size_t)T * D * 2);
constexpr size_t WS_GG    = WS_R0;
constexpr size_t WS_PR    = WS_GG + al256((size_t)T * DR * 2);
constexpr size_t WS_S     = WS_PR + al256((size_t)T * DR * 2);
constexpr size_t WS_PF    = WS_S + al256((size_t)T * DR * 2);
constexpr size_t WS_PB    = WS_PF + al256((size_t)T * DR * 2);
constexpr size_t WS_R0END = WS_PB + al256((size_t)T * DR * 2);
constexpr size_t WS_ABUF  = WS_R0;
constexpr size_t WS_HM    = WS_ABUF + al256((size_t)MOE_ROWS * D * 2);
constexpr size_t WS_Y     = WS_HM + al256((size_t)MOE_ROWS * DE * 2);
constexpr size_t WS_MOEEND = WS_Y + al256((size_t)MOE_ROWS * D * 2);
constexpr size_t WS_Q     = WS_R0;
constexpr size_t WS_K     = WS_Q + al256((size_t)T * 512 * 2);
constexpr size_t WS_KT    = WS_K + al256((size_t)T * 512 * 2);
constexpr size_t WS_VT    = WS_KT + al256((size_t)T * 512 * 2);
constexpr size_t WS_OG    = WS_VT + al256((size_t)T * D * 2);
constexpr size_t WS_UT    = WS_OG + al256((size_t)T * D * 2);
constexpr size_t WS_L1END = WS_UT + al256((size_t)NTILE * 16 * 8192 * 4);
constexpr size_t cmax(size_t a, size_t b) { return a > b ? a : b; }
constexpr size_t WS_END   = cmax(cmax(WS_R0END, WS_L1END), WS_MOEEND);

struct Params {
  const float* in[40];
  float* out;
  char* ws;
};

typedef __bf16 bf16v2_t __attribute__((ext_vector_type(2)));
typedef float f32x2_t __attribute__((ext_vector_type(2)));
DEV unsigned pk2(float lo, float hi) { const f32x2_t v = {lo, hi}; return __builtin_bit_cast(unsigned, __builtin_convertvector(v, bf16v2_t)); }
DEV float bflo(unsigned u) { return __uint_as_float(u << 16); }
DEV float bfhi(unsigned u) { return __uint_as_float(u & 0xffff0000u); }
DEV float bf2f(bf16_t b) { return __uint_as_float((unsigned)b << 16); }
DEV bf16_t f2bf(float f) { return (bf16_t)(pk2(f, 0.f) & 0xffffu); }
DEV float fexp_(float x) { return __builtin_amdgcn_exp2f(x * 1.4426950408889634f); }
DEV float sigmoidf_(float x) { return __builtin_amdgcn_rcpf(1.f + __builtin_amdgcn_exp2f(x * -1.4426950408889634f)); }
DEV float siluf_(float x) { return x * sigmoidf_(x); }
DEV float gelu_tanh(float x) { const float u = 0.7978845608028654f * (x + 0.044715f * x * x * x); return x * sigmoidf_(2.f * u); }
DEV float wave_sum(float v) {
#pragma unroll
  for (int o = 1; o < 64; o <<= 1) v += __shfl_xor(v, o);
  return v;
}
DEV s16x4 ldtr(const char* p) { return __builtin_bit_cast(s16x4, __builtin_amdgcn_ds_read_tr16_b64_v4i16((LAS s16x4*)p)); }
DEV f32x4 ld_bf4(const bf16_t* p) { const u32x2 v = *(const u32x2*)p; return (f32x4){bflo(v.x), bfhi(v.x), bflo(v.y), bfhi(v.y)}; }
DEV void st_bf4(bf16_t* p, const f32x4 v) { u32x2 o; o.x = pk2(v.x, v.y); o.y = pk2(v.z, v.w); *(u32x2*)p = o; }
DEV int tidx() { int t = threadIdx.x; asm volatile("" : "+v"(t)); return t & 255; }
DEV int tidf() { int t = threadIdx.x; asm volatile("" : "+v"(t)); return t; }
DEV int seqrow_of_token(int t) { return (t & 63) * 256 + (t >> 6); }
DEV int token_of_seqrow(int s) { return (s & 255) * 64 + (s >> 8); }

constexpr int BS_STRIDE = 320;
DEV int bs_off(int k, int n) { return k * BS_STRIDE + ((((n >> 4) ^ ((k >> 3) & 1))) << 5) + (n & 15) * 2; }

namespace pg8 {
#define PG8_LAS __attribute__((address_space(3)))
typedef unsigned short bf16_t;
typedef short bf16x8 __attribute__((ext_vector_type(8)));
typedef float f32x4 __attribute__((ext_vector_type(4)));
typedef unsigned u32x4 __attribute__((ext_vector_type(4)));
constexpr int BM = 256, BK = 64, HALF = 128, HTB = HALF * BK * 2  , STAGE_BYTES = 8 * HTB, NXCD = 8, WGM = 8;

__host__ __device__ __forceinline__ int lds_byte(int r, int c) { const int st = (r >> 4) * 2 + (c >> 5), rr = r & 15, cc = c & 31, ob = rr * 64 + cc * 2; return st * 1024 + (ob ^ (((ob >> 9) & 1) << 5)); }
__host__ __device__ __forceinline__ void stage_rc(int b, int& R, int& C) { const int st = b / 1024, sb = b % 1024, swz = sb ^ (((sb >> 9) & 1) << 5); R = (st >> 1) * 16 + swz / 64; C = (st & 1) * 32 + (swz % 64) / 2; }
__host__ __device__ __forceinline__ int perm32(int rho) { const int n = rho >> 4, i = rho & 15; return 8 * (i >> 2) + 4 * n + (i & 3); }

struct Unit { int pm, pn; };
struct Gemm { const bf16_t* A; const bf16_t* Bt; int M, N, K; };

struct StaticOrder {
    int nM, nN, nwg, G, c;
    __host__ __device__ void init(int M, int N, int G_, int c_) { nM = M / BM; nN = N / BM; nwg = nM * nN; G = G_; c = c_; }
    __host__ __device__ bool next(int i, Unit& u) const {
        const long L = (long)i * G + c; if (L >= nwg) return false;
        int wgid = (int)L; { const int q = nwg / NXCD, r = nwg % NXCD, xcd = wgid % NXCD, off = wgid / NXCD; wgid = (xcd < r ? xcd * (q + 1) : r * (q + 1) + (xcd - r) * q) + off; }
        const int nig = WGM * nN, gid = wgid / nig, fm = gid * WGM, gsz = (nM - fm) < WGM ? (nM - fm) : WGM;
        u.pm = fm + ((wgid % nig) % gsz); u.pn = (wgid % nig) / gsz; return true;
    }
    __device__ __forceinline__ void a_ready(const Unit&) const {}
    __device__ __forceinline__ void done(const Unit&) const {}
};
template <class Epi, class Sched, bool STAMP = false>
__device__ __forceinline__ void gemm_phase(PG8_LAS unsigned char* lds, const Gemm g, const Sched& S, const Epi& E, unsigned long long* stamps) {
    int tid = threadIdx.x; asm volatile("" : "+v"(tid));
    const int wid = __builtin_amdgcn_readfirstlane(tid >> 6), lane = tid & 63, wr = wid >> 2, wc = wid & 3, fr = lane & 15, fq = lane >> 4;
    const int K = g.K, nt = K / BK;
    int ts_lo = 0, ts_hi = 0, nts = 0; const unsigned long long rt_entry = STAMP ? (unsigned long long)wall_clock64() : 0ull;
#define PG8_STAMP() do { if (STAMP && wid == 0 && nts < 64) { const unsigned long long _c = (unsigned long long)clock64(); \
        ts_lo = (lane == nts) ? (int)(unsigned)_c : ts_lo; ts_hi = (lane == nts) ? (int)(unsigned)(_c >> 32) : ts_hi; ++nts; } } while (0)
    PG8_STAMP();
    unsigned voffA[2], voffB[2];
#pragma unroll
    for (int i = 0; i < 2; ++i) { int R, C; stage_rc(tid * 16 + i * 8192, R, C); const int Rb = Epi::PERM ? ((R & ~31) + perm32(R & 31)) : R;
        voffA[i] = (unsigned)(R * K + C) * 2u; voffB[i] = (unsigned)(Rb * K + C) * 2u; }
    const size_t kstep = (size_t)(BK * 2);
    const size_t hstep = (size_t)HALF * K * 2;
    const size_t tstep = 2 * hstep;
    const unsigned ldsw = (unsigned)wid * 1024u;
    const int aoff = lds_byte(wr * 64 + fr, fq * 8), boff = lds_byte(wc * 32 + fr, fq * 8);
#define PG8_SA(b, h) (((b) * 2 + (h)) * HTB)
#define PG8_SB(b, h) ((4 + (b) * 2 + (h)) * HTB)
#define PG8_STAGE(bufoff, gbase, voff) do { _Pragma("unroll") for (int _i = 0; _i < 2; ++_i) \
        __builtin_amdgcn_global_load_lds((const unsigned*)((const char*)(gbase) + (voff)[_i]), (PG8_LAS unsigned*)(lds + (bufoff) + ldsw + _i * 8192), 16, 0, 0); } while (0)
#define PG8_LDA(dst, b, h) do { _Pragma("unroll") for (int m = 0; m < 4; ++m) _Pragma("unroll") for (int k = 0; k < 2; ++k) dst[m][k] = *(const PG8_LAS bf16x8*)(lds + PG8_SA(b, h) + aoff + m * 2048 + k * 1024); } while (0)
#define PG8_LDB(dst, b, h) do { _Pragma("unroll") for (int n = 0; n < 2; ++n) _Pragma("unroll") for (int k = 0; k < 2; ++k) dst[n][k] = *(const PG8_LAS bf16x8*)(lds + PG8_SB(b, h) + boff + n * 2048 + k * 1024); } while (0)
#define PG8_MMA(ai, bj, At, Bt) do { __builtin_amdgcn_s_setprio(1); _Pragma("unroll") for (int m = 0; m < 4; ++m) _Pragma("unroll") for (int n = 0; n < 2; ++n) _Pragma("unroll") for (int k = 0; k < 2; ++k) \
        acc[ai][bj][m][n] = __builtin_amdgcn_mfma_f32_16x16x32_bf16(Bt[n][k], At[m][k], acc[ai][bj][m][n], 0, 0, 0); __builtin_amdgcn_s_setprio(0); } while (0)
#define PG8_WAIT_V(n) asm volatile("s_waitcnt vmcnt(" #n ")" ::: "memory")
#define PG8_WAIT_L(n) asm volatile("s_waitcnt lgkmcnt(" #n ")" ::: "memory")
#define PG8_BAR __builtin_amdgcn_s_barrier()
#define PG8_SCHED __builtin_amdgcn_sched_barrier(0)
    Unit cur, nxt; int ui = 0;
    if (!S.next(0, cur)) return;
    f32x4 acc[2][2][4][2];
#pragma unroll
    for (int a = 0; a < 2; ++a)
#pragma unroll
        for (int b = 0; b < 2; ++b)
#pragma unroll
            for (int m = 0; m < 4; ++m)
#pragma unroll
                for (int n = 0; n < 2; ++n) acc[a][b][m][n] = (f32x4){0.f, 0.f, 0.f, 0.f};
    bf16x8 At[4][2], B0[2][2], B1[2][2];
    const char* cA = (const char*)g.A + (size_t)cur.pm * tstep; const char* cB = (const char*)g.Bt + (size_t)cur.pn * tstep;
    S.a_ready(cur);
    PG8_STAGE(PG8_SB(0, 0), cB, voffB); PG8_STAGE(PG8_SA(0, 0), cA, voffA); PG8_STAGE(PG8_SB(0, 1), cB + hstep, voffB); PG8_STAGE(PG8_SA(0, 1), cA + hstep, voffA);
    if (wr == 1) PG8_BAR;
    PG8_WAIT_V(4); PG8_BAR;
    PG8_STAGE(PG8_SB(1, 0), cB + kstep, voffB); PG8_STAGE(PG8_SA(1, 0), cA + kstep, voffA); PG8_STAGE(PG8_SB(1, 1), cB + hstep + kstep, voffB);
    PG8_WAIT_V(6); PG8_BAR;
    PG8_STAMP();
    for (;;) {
        const bool has_next = S.next(ui + 1, nxt);
        const char* nA = has_next ? (const char*)g.A + (size_t)nxt.pm * tstep : cA; const char* nB = has_next ? (const char*)g.Bt + (size_t)nxt.pn * tstep : cB;
        for (int t = 0; t < nt; t += 2) {
            const bool last = (t == nt - 2);
            const char* a1 = cA + (size_t)(t + 1) * kstep;
            const char* a2 = last ? nA : cA + (size_t)(t + 2) * kstep; const char* b2 = last ? nB : cB + (size_t)(t + 2) * kstep;
            const char* a3 = a2 + kstep; const char* b3 = b2 + kstep;
            if (last && has_next) S.a_ready(nxt);
            PG8_LDB(B0, 0, 0); PG8_SCHED; PG8_LDA(At, 0, 0); PG8_STAGE(PG8_SA(1, 1), a1 + hstep, voffA);
            PG8_WAIT_L(8); PG8_BAR; PG8_WAIT_L(0); PG8_MMA(0, 0, At, B0); PG8_BAR; PG8_SCHED;
            PG8_LDB(B1, 0, 1); PG8_STAGE(PG8_SB(0, 0), b2, voffB);
            PG8_BAR; PG8_WAIT_L(0); PG8_MMA(0, 1, At, B1); PG8_BAR;
            PG8_LDA(At, 0, 1); PG8_STAGE(PG8_SA(0, 0), a2, voffA);
            PG8_BAR; PG8_WAIT_L(0); PG8_MMA(1, 0, At, B0); PG8_BAR; PG8_SCHED;
            PG8_STAGE(PG8_SB(0, 1), b2 + hstep, voffB);
            PG8_WAIT_V(6); PG8_BAR; PG8_MMA(1, 1, At, B1); PG8_BAR;
            PG8_LDB(B0, 1, 0); PG8_SCHED; PG8_LDA(At, 1, 0); PG8_STAGE(PG8_SA(0, 1), a2 + hstep, voffA);
            PG8_WAIT_L(8); PG8_BAR; PG8_WAIT_L(0); PG8_MMA(0, 0, At, B0); PG8_BAR; PG8_SCHED;
            PG8_LDB(B1, 1, 1); PG8_STAGE(PG8_SB(1, 0), b3, voffB);
            PG8_BAR; PG8_WAIT_L(0); PG8_MMA(0, 1, At, B1); PG8_BAR;
            PG8_LDA(At, 1, 1); PG8_STAGE(PG8_SA(1, 0), a3, voffA);
            PG8_BAR; PG8_WAIT_L(0); PG8_MMA(1, 0, At, B0); PG8_BAR; PG8_SCHED;
            PG8_STAGE(PG8_SB(1, 1), b3 + hstep, voffB);
            PG8_WAIT_V(6); PG8_BAR; PG8_MMA(1, 1, At, B1); PG8_BAR;
        }
        PG8_STAMP();
        if constexpr (!Epi::AFTER_DRAIN) { E(acc, cur, wr, wc, fr, fq); S.done(cur); }
        PG8_STAMP();
        if (!has_next) break;
#pragma unroll
        for (int a = 0; a < 2; ++a)
#pragma unroll
            for (int b = 0; b < 2; ++b)
#pragma unroll
                for (int m = 0; m < 4; ++m)
#pragma unroll
                    for (int n = 0; n < 2; ++n) acc[a][b][m][n] = (f32x4){0.f, 0.f, 0.f, 0.f};
        cur = nxt; cA = nA; cB = nB; ++ui;
    }
    PG8_WAIT_V(0);
    if (wr == 0) PG8_BAR;
    PG8_BAR;
    if constexpr (Epi::AFTER_DRAIN) { E.fused(acc, cur, wr, wc, fr, fq, lds, wid, lane); S.done(cur); }
    PG8_STAMP();
    if (STAMP && wid == 0) { stamps[lane] = lane < nts ? (((unsigned long long)(unsigned)ts_hi << 32) | (unsigned)ts_lo) : 0ull;
        if (lane == 62) stamps[62] = rt_entry; if (lane == 63) stamps[63] = (unsigned long long)wall_clock64(); }
#undef PG8_STAMP
#undef PG8_SA
#undef PG8_SB
#undef PG8_STAGE
#undef PG8_LDA
#undef PG8_LDB
#undef PG8_MMA
#undef PG8_WAIT_V
#undef PG8_WAIT_L
#undef PG8_BAR
#undef PG8_SCHED
}
template <class Epi, class Sched, bool STAMP = false>
__device__ __forceinline__ void gemm_phase_gather(PG8_LAS unsigned char* lds, const Gemm g, const Sched& S, const Epi& E, unsigned long long* stamps) {
    int tid = threadIdx.x; asm volatile("" : "+v"(tid));
    const int wid = __builtin_amdgcn_readfirstlane(tid >> 6), lane = tid & 63, wr = wid >> 2, wc = wid & 3, fr = lane & 15, fq = lane >> 4;
    const int K = g.K, nt = K / BK;
    int ts_lo = 0, ts_hi = 0, nts = 0; const unsigned long long rt_entry = STAMP ? (unsigned long long)wall_clock64() : 0ull;
#define PG8_STAMP() do { if (STAMP && wid == 0 && nts < 64) { const unsigned long long _c = (unsigned long long)clock64(); \
        ts_lo = (lane == nts) ? (int)(unsigned)_c : ts_lo; ts_hi = (lane == nts) ? (int)(unsigned)(_c >> 32) : ts_hi; ++nts; } } while (0)
    PG8_STAMP();
    unsigned voffA[2], voffB[2];
#pragma unroll
    for (int i = 0; i < 2; ++i) { int R, C; stage_rc(tid * 16 + i * 8192, R, C); const int Rb = Epi::PERM ? ((R & ~31) + perm32(R & 31)) : R;
        voffA[i] = (unsigned)(R * K + C) * 2u; voffB[i] = (unsigned)(Rb * K + C) * 2u; }
    const size_t kstep = (size_t)(BK * 2);
    const size_t hstep = (size_t)HALF * K * 2;
    const size_t tstep = 2 * hstep;
    const unsigned ldsw = (unsigned)wid * 1024u;
    const int aoff = lds_byte(wr * 64 + fr, fq * 8), boff = lds_byte(wc * 32 + fr, fq * 8);
#define PG8_SA(b, h) (((b) * 2 + (h)) * HTB)
#define PG8_SB(b, h) ((4 + (b) * 2 + (h)) * HTB)
#define PG8_STAGE(bufoff, gbase, voff) do { _Pragma("unroll") for (int _i = 0; _i < 2; ++_i) \
        __builtin_amdgcn_global_load_lds((const unsigned*)((const char*)(gbase) + (voff)[_i]), (PG8_LAS unsigned*)(lds + (bufoff) + ldsw + _i * 8192), 16, 0, 0); } while (0)
#define PG8_LDA(dst, b, h) do { _Pragma("unroll") for (int m = 0; m < 4; ++m) _Pragma("unroll") for (int k = 0; k < 2; ++k) dst[m][k] = *(const PG8_LAS bf16x8*)(lds + PG8_SA(b, h) + aoff + m * 2048 + k * 1024); } while (0)
#define PG8_LDB(dst, b, h) do { _Pragma("unroll") for (int n = 0; n < 2; ++n) _Pragma("unroll") for (int k = 0; k < 2; ++k) dst[n][k] = *(const PG8_LAS bf16x8*)(lds + PG8_SB(b, h) + boff + n * 2048 + k * 1024); } while (0)
#define PG8_MMA(ai, bj, At, Bt) do { __builtin_amdgcn_s_setprio(1); _Pragma("unroll") for (int m = 0; m < 4; ++m) _Pragma("unroll") for (int n = 0; n < 2; ++n) _Pragma("unroll") for (int k = 0; k < 2; ++k) \
        acc[ai][bj][m][n] = __builtin_amdgcn_mfma_f32_16x16x32_bf16(Bt[n][k], At[m][k], acc[ai][bj][m][n], 0, 0, 0); __builtin_amdgcn_s_setprio(0); } while (0)
#define PG8_WAIT_V(n) asm volatile("s_waitcnt vmcnt(" #n ")" ::: "memory")
#define PG8_WAIT_L(n) asm volatile("s_waitcnt lgkmcnt(" #n ")" ::: "memory")
#define PG8_BAR __builtin_amdgcn_s_barrier()
#define PG8_SCHED __builtin_amdgcn_sched_barrier(0)
    Unit cur, nxt; int ui = 0;
    if (!S.next(0, cur)) return;
    f32x4 acc[2][2][4][2];
#pragma unroll
    for (int a = 0; a < 2; ++a)
#pragma unroll
        for (int b = 0; b < 2; ++b)
#pragma unroll
            for (int m = 0; m < 4; ++m)
#pragma unroll
                for (int n = 0; n < 2; ++n) acc[a][b][m][n] = (f32x4){0.f, 0.f, 0.f, 0.f};
    bf16x8 At[4][2], B0[2][2], B1[2][2];
    const char* const cA = (const char*)g.A; const char* cB = (const char*)g.Bt + (size_t)cur.pn * tstep;
    unsigned co[2][2], no[2][2];
#pragma unroll
    for (int h = 0; h < 2; ++h)
#pragma unroll
        for (int i = 0; i < 2; ++i) { int R, C; stage_rc(tid * 16 + i * 8192, R, C); co[h][i] = (unsigned)S.src_row(cur, h * HALF + R) * (unsigned)(K * 2) + (unsigned)C * 2u; no[h][i] = co[h][i]; }
    S.a_ready(cur);
    PG8_STAGE(PG8_SB(0, 0), cB, voffB); PG8_STAGE(PG8_SA(0, 0), cA, co[0]); PG8_STAGE(PG8_SB(0, 1), cB + hstep, voffB); PG8_STAGE(PG8_SA(0, 1), cA, co[1]);
    if (wr == 1) PG8_BAR;
    PG8_WAIT_V(4); PG8_BAR;
    PG8_STAGE(PG8_SB(1, 0), cB + kstep, voffB); PG8_STAGE(PG8_SA(1, 0), cA + kstep, co[0]); PG8_STAGE(PG8_SB(1, 1), cB + hstep + kstep, voffB);
    PG8_WAIT_V(6); PG8_BAR;
    PG8_STAMP();
    for (;;) {
        const bool has_next = S.next(ui + 1, nxt);
        const char* nB = has_next ? (const char*)g.Bt + (size_t)nxt.pn * tstep : cB;
        if (has_next) {
#pragma unroll
            for (int h = 0; h < 2; ++h)
#pragma unroll
                for (int i = 0; i < 2; ++i) { int R, C; stage_rc(tid * 16 + i * 8192, R, C); no[h][i] = (unsigned)S.src_row(nxt, h * HALF + R) * (unsigned)(K * 2) + (unsigned)C * 2u; }
        }
        for (int t = 0; t < nt; t += 2) {
            const bool last = (t == nt - 2);
            const char* a1 = cA + (size_t)(t + 1) * kstep;
            const char* a2 = cA + (size_t)(last ? 0 : t + 2) * kstep; const char* b2 = last ? nB : cB + (size_t)(t + 2) * kstep;

            const char* a3 = a2 + kstep; const char* b3 = b2 + kstep;
            if (last && has_next) S.a_ready(nxt);
            PG8_LDB(B0, 0, 0); PG8_SCHED; PG8_LDA(At, 0, 0); PG8_STAGE(PG8_SA(1, 1), a1, co[1]);
            if (last) { co[0][0] = no[0][0]; co[0][1] = no[0][1]; co[1][0] = no[1][0]; co[1][1] = no[1][1]; }
            PG8_WAIT_L(8); PG8_BAR; PG8_WAIT_L(0); PG8_MMA(0, 0, At, B0); PG8_BAR; PG8_SCHED;
            PG8_LDB(B1, 0, 1); PG8_STAGE(PG8_SB(0, 0), b2, voffB);
            PG8_BAR; PG8_WAIT_L(0); PG8_MMA(0, 1, At, B1); PG8_BAR;
            PG8_LDA(At, 0, 1); PG8_STAGE(PG8_SA(0, 0), a2, co[0]);
            PG8_BAR; PG8_WAIT_L(0); PG8_MMA(1, 0, At, B0); PG8_BAR; PG8_SCHED;
            PG8_STAGE(PG8_SB(0, 1), b2 + hstep, voffB);
            PG8_WAIT_V(6); PG8_BAR; PG8_MMA(1, 1, At, B1); PG8_BAR;
            PG8_LDB(B0, 1, 0); PG8_SCHED; PG8_LDA(At, 1, 0); PG8_STAGE(PG8_SA(0, 1), a2, co[1]);
            PG8_WAIT_L(8); PG8_BAR; PG8_WAIT_L(0); PG8_MMA(0, 0, At, B0); PG8_BAR; PG8_SCHED;
            PG8_LDB(B1, 1, 1); PG8_STAGE(PG8_SB(1, 0), b3, voffB);
            PG8_BAR; PG8_WAIT_L(0); PG8_MMA(0, 1, At, B1); PG8_BAR;
            PG8_LDA(At, 1, 1); PG8_STAGE(PG8_SA(1, 0), a3, co[0]);
            PG8_BAR; PG8_WAIT_L(0); PG8_MMA(1, 0, At, B0); PG8_BAR; PG8_SCHED;
            PG8_STAGE(PG8_SB(1, 1), b3 + hstep, voffB);
            PG8_WAIT_V(6); PG8_BAR; PG8_MMA(1, 1, At, B1); PG8_BAR;
        }
        PG8_STAMP();
        if constexpr (!Epi::AFTER_DRAIN) { E(acc, cur, wr, wc, fr, fq); S.done(cur); }
        PG8_STAMP();
        if (!has_next) break;
#pragma unroll
        for (int a = 0; a < 2; ++a)
#pragma unroll
            for (int b = 0; b < 2; ++b)
#pragma unroll
                for (int m = 0; m < 4; ++m)
#pragma unroll
                    for (int n = 0; n < 2; ++n) acc[a][b][m][n] = (f32x4){0.f, 0.f, 0.f, 0.f};
        cur = nxt; cB = nB; ++ui;
    }
    PG8_WAIT_V(0);
    if (wr == 0) PG8_BAR;
    PG8_BAR;
    if constexpr (Epi::AFTER_DRAIN) { E.fused(acc, cur, wr, wc, fr, fq, lds, wid, lane); S.done(cur); }
    PG8_STAMP();
    if (STAMP && wid == 0) { stamps[lane] = lane < nts ? (((unsigned long long)(unsigned)ts_hi << 32) | (unsigned)ts_lo) : 0ull;
        if (lane == 62) stamps[62] = rt_entry; if (lane == 63) stamps[63] = (unsigned long long)wall_clock64(); }
#undef PG8_STAMP
#undef PG8_SA
#undef PG8_SB
#undef PG8_STAGE
#undef PG8_LDA
#undef PG8_LDB
#undef PG8_MMA
#undef PG8_WAIT_V
#undef PG8_WAIT_L
#undef PG8_BAR
#undef PG8_SCHED
}
}

DEV void ph_adaln(const Params& p, char* smem, int bid, int nb) {
  float* sc = (float*)smem; float* sx = sc + 1024; f32x4* red = (f32x4*)(sx + 1024);
  const int tid = tidx();
  for (int i = tid; i < 1024; i += 256) { sc[i] = siluf_(p.in[1][i]); sx[i] = siluf_(p.in[3][i]); }
  __syncthreads();
  float* mods = (float*)(p.ws + WS_MODS);
  const int cl = tid & 7, kg = tid >> 3;
  constexpr int NU = 2 * 192;
  for (int it = 0, iters = (NU + nb - 1) / nb; it < iters; ++it) {
    const int u = bid + it * nb; const bool active = u < NU;
    const int l = u / 192, c0 = (u % 192) * 32;
    const float* W = p.in[l ? 24 : 4]; const float* B = p.in[l ? 25 : 5];
    if (active) {
      f32x4 ac = {0.f, 0.f, 0.f, 0.f}, ax = {0.f, 0.f, 0.f, 0.f};
      const float* wp = W + (size_t)(kg * 32) * 6144 + c0 + 4 * cl;
#pragma unroll 16
      for (int kk = 0; kk < 32; ++kk) {
        const f32x4 w = *(const f32x4*)(wp + (size_t)kk * 6144);
        const float a = sc[kg * 32 + kk], b = sx[kg * 32 + kk];
        ac += a * w; ax += b * w;
      }
      red[kg * 8 + cl] = ac; red[256 + kg * 8 + cl] = ax;
    }
    __syncthreads();
    if (active && tid < 16) {
      const int which = tid >> 3, c = tid & 7;
      f32x4 sm = {0.f, 0.f, 0.f, 0.f};
      for (int g = 0; g < 32; ++g) sm += red[which * 256 + g * 8 + c];
      const f32x4 bb = *(const f32x4*)(B + c0 + 4 * c);
      *(f32x4*)(mods + (size_t)(l * 2 + which) * 6144 + c0 + 4 * c) = sm + bb;
    }
    __syncthreads();
  }
}

DEV void transpose_item(const float* W, int N, int K, bf16_t* WT, float* scr, int k0, int n0, int lane) {
  float wreg[32];
#pragma unroll
  for (int i = 0; i < 32; ++i) { const int kk = 2 * i + (lane >> 5); wreg[i] = W[(size_t)(k0 + kk) * N + n0 + (lane & 31)]; }
#pragma unroll
  for (int i = 0; i < 32; ++i) { const int kk = 2 * i + (lane >> 5); scr[kk * 33 + (lane & 31)] = wreg[i]; }
  asm volatile("s_waitcnt lgkmcnt(0)" ::: "memory");
  const int c = lane & 7;
#pragma unroll
  for (int j = 0; j < 4; ++j) { const int n = (lane >> 3) + 8 * j; const float* s = scr + (8 * c) * 33 + n;
    u32x4 o; o.x = pk2(s[0 * 33], s[1 * 33]); o.y = pk2(s[2 * 33], s[3 * 33]); o.z = pk2(s[4 * 33], s[5 * 33]); o.w = pk2(s[6 * 33], s[7 * 33]);
    *(u32x4*)(WT + (size_t)n * K + k0 + 8 * c) = o; }
  asm volatile("s_waitcnt lgkmcnt(0)" ::: "memory");
}
constexpr int CI_WIN = 16 * 80, CI_WOUT = 20 * 32, CI_WML = 16 * 97, CI_WMO = 16 * 32, CI_WAX = 40 * 8, CI_DENSE = CI_WIN + CI_WOUT + CI_WML + CI_WMO + CI_WAX;
constexpr int CI_MOE = 32 * 768;
DEV void ph_convert_dense(const Params& p, char* smem) {
  const int tf = tidf(), lane = tf & 63, wv = tf >> 6;
  float* scr = (float*)(smem + wv * 8448);
  const int gw = blockIdx.x * 8 + wv, ngw = gridDim.x * 8;
  for (int it = gw; it < CI_DENSE; it += ngw) {
    int r = it;
    if (r < CI_WIN) { const int kb = r / 80, nb_ = r % 80; transpose_item(p.in[8], 2560, 1024, (bf16_t*)(p.ws + WS_WIN) + (size_t)(nb_ * 32) * 1024, scr, kb * 64, nb_ * 32, lane); continue; } r -= CI_WIN;
    if (r < CI_WOUT) { const int kb = r / 32, nb_ = r % 32; transpose_item(p.in[16], 1024, 1280, (bf16_t*)(p.ws + WS_WOUT) + (size_t)(nb_ * 32) * 1280, scr, kb * 64, nb_ * 32, lane); continue; } r -= CI_WOUT;
    if (r < CI_WML) { const int kb = r / 97, nb_ = r % 97; transpose_item(p.in[28], MLW, 1024, (bf16_t*)(p.ws + WS_WML) + (size_t)(nb_ * 32) * 1024, scr, kb * 64, nb_ * 32, lane); continue; } r -= CI_WML;
    if (r < CI_WMO) { const int kb = r / 32, nb_ = r % 32; transpose_item(p.in[31], 1024, 1024, (bf16_t*)(p.ws + WS_WMO) + (size_t)(nb_ * 32) * 1024, scr, kb * 64, nb_ * 32, lane); continue; } r -= CI_WMO;
    { const int mi = r >> 3, rr = r & 7, kb = rr >> 2, nb_ = rr & 3, dh = mi >> 1, which = mi & 1;
      transpose_item((which ? p.in[13] : p.in[11]) + (size_t)dh * 16384, 128, 128, (bf16_t*)(p.ws + WS_WAXT) + (size_t)mi * 16384 + (size_t)(nb_ * 32) * 128, scr, kb * 64, nb_ * 32, lane); }
  }
  { bf16_t* Wr = (bf16_t*)(p.ws + WS_WR);
    for (int i = blockIdx.x * 512 + tf; i < 2 * 48 * 1024; i += gridDim.x * 512) {
      const int l = i / (48 * 1024), r = i % (48 * 1024), n = r >> 10, k = r & 1023;
      const float* We = p.in[l ? 34 : 19]; const float* Wg = p.in[l ? 32 : 17];
      const float w = n < 32 ? We[k * 32 + n] : (n < 36 ? Wg[k * 4 + n - 32] : 0.f);
      const bf16_t hi = f2bf(w); const bf16_t lo = f2bf(w - bf2f(hi));
      Wr[(size_t)(l * 2) * 48 * 1024 + r] = hi; Wr[(size_t)(l * 2 + 1) * 48 * 1024 + r] = lo;
    } }
  { u32x4* z = (u32x4*)((bf16_t*)(p.ws + WS_WML) + (size_t)MLW * 1024); const int n16 = (MLWP - MLW) * 1024 * 2 / 16;
    for (int i = blockIdx.x * 512 + tf; i < n16; i += gridDim.x * 512) z[i] = (u32x4){0u, 0u, 0u, 0u}; }
}
template <int LAYER>
DEV void ph_convert_moe(const Params& p, char* smem) {
  const int tf = tidf(), lane = tf & 63, wv = tf >> 6;
  float* scr = (float*)(smem + wv * 8448);
  const int gw = blockIdx.x * 8 + wv, ngw = gridDim.x * 8;
  const float* Wg = p.in[LAYER == 0 ? 21 : 36]; const float* Wu = p.in[LAYER == 0 ? 22 : 37]; const float* Wd = p.in[LAYER == 0 ? 23 : 38];
  bf16_t* WGU = (bf16_t*)(p.ws + (LAYER == 0 ? WS_WGU : WS_WGU1)); bf16_t* WD = (bf16_t*)(p.ws + (LAYER == 0 ? WS_WD : WS_WD1));
  for (int it = gw; it < CI_MOE; it += ngw) {
    const int e = it / 768, r = it % 768;
    if (r < 512) {
      const int up = r >> 8, rr = r & 255, kb = rr >> 4, nb_ = rr & 15, n0 = nb_ * 32;
      bf16_t* dst = WGU + ((size_t)e * 1024 + (n0 >> 7) * 256 + up * 128 + (n0 & 127)) * 1024;
      transpose_item((up ? Wu : Wg) + (size_t)e * 1024 * 512, 512, 1024, dst, scr, kb * 64, n0, lane);
    } else {
      const int rr = r - 512, kb = rr >> 5, nb_ = rr & 31, n0 = nb_ * 32;
      transpose_item(Wd + (size_t)e * 512 * 1024, 1024, 512, WD + ((size_t)e * 1024 + n0) * 512, scr, kb * 64, n0, lane);
    }
  }
}

DEV void conv_queue_l1(const Params& p, char* smem, int max_batches) {
  const int tf = tidf(), lane = tf & 63, wv = tf >> 6;
  float* scr = (float*)(smem + wv * 8448);
  unsigned* q = (unsigned*)(p.ws + WS_CONVQ);
  volatile int* slot = (volatile int*)(smem + 8 * 8448);
  const float* Wg = p.in[36]; const float* Wu = p.in[37]; const float* Wd = p.in[38];
  bf16_t* WGU = (bf16_t*)(p.ws + WS_WGU1); bf16_t* WD = (bf16_t*)(p.ws + WS_WD1);
  for (int bt = 0; max_batches < 0 || bt < max_batches; ++bt) {
    __syncthreads();
    if (tf == 0) *slot = (int)__hip_atomic_fetch_add(q, 8u, __ATOMIC_RELAXED, __HIP_MEMORY_SCOPE_AGENT);
    __syncthreads();
    const int base = *slot;
    if (base >= CI_MOE) break;
    const int it = base + wv;
    if (it < CI_MOE) {
      const int e = it / 768, r = it % 768;
      if (r < 512) {
        const int up = r >> 8, rr = r & 255, kb = rr >> 4, nb_ = rr & 15, n0 = nb_ * 32;
        bf16_t* dst = WGU + ((size_t)e * 1024 + (n0 >> 7) * 256 + up * 128 + (n0 & 127)) * 1024;
        transpose_item((up ? Wu : Wg) + (size_t)e * 1024 * 512, 512, 1024, dst, scr, kb * 64, n0, lane);
      } else {
        const int rr = r - 512, kb = rr >> 5, nb_ = rr & 31, n0 = nb_ * 32;
        transpose_item(Wd + (size_t)e * 512 * 1024, 1024, 512, WD + ((size_t)e * 1024 + n0) * 512, scr, kb * 64, n0, lane);
      }
    }
  }
  __syncthreads();
}

DEV void ph_norm0(const Params& p, int bid, int nb) {
  const int lane = tidx() & 63, wave = tidx() >> 6;
  const float* mods = (const float*)(p.ws + WS_MODS);
  bf16_t* hA = (bf16_t*)(p.ws + WS_HA);
  const float* g1 = p.in[6];
  for (int r0 = (bid * 4 + wave) * 4; r0 < T; r0 += nb * 16) {
    f32x4 v[4][4]; float rs[4];
#pragma unroll
    for (int q = 0; q < 4; ++q) {
      const int r = r0 + q;
      const float* src = r < NL ? p.in[0] + (size_t)r * D : p.in[2] + (size_t)(r - NL) * D;
#pragma unroll
      for (int i = 0; i < 4; ++i) v[q][i] = *(const f32x4*)(src + 4 * lane + 256 * i);
    }
#pragma unroll
    for (int q = 0; q < 4; ++q) {
      float ss = 0.f;
#pragma unroll
      for (int i = 0; i < 4; ++i) ss += v[q][i].x * v[q][i].x + v[q][i].y * v[q][i].y + v[q][i].z * v[q][i].z + v[q][i].w * v[q][i].w;
      rs[q] = rsqrtf(wave_sum(ss) * (1.f / D) + EPS);
    }
#pragma unroll
    for (int i = 0; i < 4; ++i) {
      const int c = 4 * lane + 256 * i;
      const f32x4 g = *(const f32x4*)(g1 + c);
#pragma unroll
      for (int q = 0; q < 4; ++q) {
        const int r = r0 + q;
        const float* md = mods + (r < NL ? 0 : 6144);
        const f32x4 sh = *(const f32x4*)(md + c), sc = *(const f32x4*)(md + 1024 + c);
        const f32x4 h = v[q][i] * rs[q] * g * (1.f + sc) + sh;
        u32x2 o; o.x = pk2(h.x, h.y); o.y = pk2(h.z, h.w);
        *(u32x2*)(hA + (size_t)r * D + c) = o;
      }
    }
  }
}

constexpr int RG_AS_STRIDE = 272;
constexpr int RG_MT = RGT / 16;
constexpr int RG_AS = 0, RG_BS = RGT * RG_AS_STRIDE, RG_SMEM = RG_BS + 128 * BS_STRIDE;

template <bool REV, int NT>
DEV void rg_scan(f32x4 (&A)[RG_MT][NT], f32x4 (&B)[RG_MT][NT], float (&aggP)[NT], float (&aggH)[NT]) {
  const int lane = tidx() & 63, fq = lane >> 4, fr = lane & 15;
#pragma unroll
  for (int n = 0; n < NT; ++n) {
    float cP = 1.f, cH = 0.f;
#pragma unroll
    for (int mm = 0; mm < RG_MT; ++mm) {
      const int m = REV ? RG_MT - 1 - mm : mm;
      float P[4], H[4];
      if (!REV) {
        P[0] = A[m][n][0]; H[0] = B[m][n][0];
#pragma unroll
        for (int j = 1; j < 4; ++j) { P[j] = A[m][n][j] * P[j - 1]; H[j] = A[m][n][j] * H[j - 1] + B[m][n][j]; }
      } else {
        P[3] = A[m][n][3]; H[3] = B[m][n][3];
#pragma unroll
        for (int j = 2; j >= 0; --j) { P[j] = A[m][n][j] * P[j + 1]; H[j] = A[m][n][j] * H[j + 1] + B[m][n][j]; }
      }
      float IP = REV ? P[0] : P[3], IH = REV ? H[0] : H[3];
      float tP, tH;
      tP = REV ? __shfl_down(IP, 16) : __shfl_up(IP, 16); tH = REV ? __shfl_down(IH, 16) : __shfl_up(IH, 16);
      if (REV ? (fq <= 2) : (fq >= 1)) { IH = IP * tH + IH; IP = IP * tP; }
      tP = REV ? __shfl_down(IP, 32) : __shfl_up(IP, 32); tH = REV ? __shfl_down(IH, 32) : __shfl_up(IH, 32);
      if (REV ? (fq <= 1) : (fq >= 2)) { IH = IP * tH + IH; IP = IP * tP; }
      float EP = REV ? __shfl_down(IP, 16) : __shfl_up(IP, 16), EH = REV ? __shfl_down(IH, 16) : __shfl_up(IH, 16);
      if (REV ? (fq == 3) : (fq == 0)) { EP = 1.f; EH = 0.f; }
      const float hin = EP * cH + EH, pin = EP * cP;
#pragma unroll
      for (int j = 0; j < 4; ++j) { B[m][n][j] = H[j] + P[j] * hin; A[m][n][j] = P[j] * pin; }
      const float TP = __shfl(IP, (REV ? 0 : 48) + fr), TH = __shfl(IH, (REV ? 0 : 48) + fr);
      cH = TP * cH + TH; cP = TP * cP;
    }
    aggP[n] = cP; aggH[n] = cH;
  }
}

DEV void ph_rg_scan(const Params& p, char* smem, int bid, int nb) {
  char* As = smem + RG_AS; char* Bs = smem + RG_BS;
  const bf16_t* pr = (const bf16_t*)(p.ws + WS_PR);
  bf16_t* Sb = (bf16_t*)(p.ws + WS_S); bf16_t* Pfb = (bf16_t*)(p.ws + WS_PF); bf16_t* Pbb = (bf16_t*)(p.ws + WS_PB);
  float* agg = (float*)(p.ws + WS_AGG);
  const float* conv_w = p.in[9]; const float* conv_b = p.in[10];
  for (int it = 0, iters = (NRT * 10 + nb - 1) / nb; it < iters; ++it) {
    int u = bid + it * nb; const bool active = u < NRT * 10; if (!active) u = NRT * 10 - 1;
    const int tid = tidx();
    const int lane = tid & 63, wave = tid >> 6, fr = lane & 15, fq = lane >> 4, q4 = fr >> 2, p4 = lane & 3;
    const int hb = u % 10, tile = u / 10, r0 = tile * RGT, ch0 = hb * 128;
    const int seg_lo = tile < NRT_LAT ? 0 : NL, seg_hi = tile < NRT_LAT ? NL : T;
    __syncthreads();
    {
      const int cg8 = tid & 15, rg = tid >> 4, c = ch0 + 8 * cg8;
      float w[4][8], bias[8];
#pragma unroll
      for (int j = 0; j < 4; ++j) { const f32x4 a = *(const f32x4*)(conv_w + j * DR + c), b = *(const f32x4*)(conv_w + j * DR + c + 4);
        w[j][0] = a.x; w[j][1] = a.y; w[j][2] = a.z; w[j][3] = a.w; w[j][4] = b.x; w[j][5] = b.y; w[j][6] = b.z; w[j][7] = b.w; }
      { const f32x4 a = *(const f32x4*)(conv_b + c), b = *(const f32x4*)(conv_b + c + 4);
        bias[0] = a.x; bias[1] = a.y; bias[2] = a.z; bias[3] = a.w; bias[4] = b.x; bias[5] = b.y; bias[6] = b.z; bias[7] = b.w; }
      float win[4][8];
      auto ldrow = [&](int r, float (&dst)[8]) {
        if (r >= seg_lo && r < seg_hi) { const u32x4 v = *(const u32x4*)(pr + (size_t)r * DR + c);
          dst[0] = bflo(v.x); dst[1] = bfhi(v.x); dst[2] = bflo(v.y); dst[3] = bfhi(v.y); dst[4] = bflo(v.z); dst[5] = bfhi(v.z); dst[6] = bflo(v.w); dst[7] = bfhi(v.w); }
        else {
#pragma unroll
          for (int e = 0; e < 8; ++e) dst[e] = 0.f; }
      };
      const int rb = r0 + rg * 4;
      ldrow(rb - 2, win[0]); ldrow(rb - 1, win[1]); ldrow(rb, win[2]);
#pragma unroll
      for (int t = 0; t < 4; ++t) {
        ldrow(rb + t + 1, win[(t + 3) & 3]);
        float o[8];
#pragma unroll
        for (int e = 0; e < 8; ++e) o[e] = bias[e] + w[0][e] * win[t & 3][e] + w[1][e] * win[(t + 1) & 3][e] + w[2][e] * win[(t + 2) & 3][e] + w[3][e] * win[(t + 3) & 3][e];
        u32x4 ov; ov.x = pk2(o[0], o[1]); ov.y = pk2(o[2], o[3]); ov.z = pk2(o[4], o[5]); ov.w = pk2(o[6], o[7]);
        *(u32x4*)(As + (rg * 4 + t) * RG_AS_STRIDE + cg8 * 16) = ov;
      }
    }
    u32x2 hfk[RG_MT][2];
#pragma unroll
    for (int d = 0; d < 2; ++d) {
      f32x4 accA[RG_MT][2], accX[RG_MT][2];
#pragma unroll
      for (int which = 0; which < 2; ++which) {
        const float* W = (which ? p.in[13] : p.in[11]) + (size_t)(d * 10 + hb) * 16384;
        __syncthreads();
#pragma unroll 1
        for (int ib = 0; ib < 4; ++ib) {
#pragma unroll
          for (int ii = 0; ii < 4; ++ii) {
            const int f = tid + 256 * (ib * 4 + ii), k = f >> 5, n = 4 * (f & 31);
            const f32x4 v = *(const f32x4*)(W + k * 128 + n);
            u32x2 o; o.x = pk2(v.x, v.y); o.y = pk2(v.z, v.w);
            *(u32x2*)(Bs + bs_off(k, n)) = o;
          }
        }
        __syncthreads();
        f32x4 (&acc)[RG_MT][2] = which ? accX : accA;
#pragma unroll
        for (int m = 0; m < RG_MT; ++m) { acc[m][0] = (f32x4){0.f, 0.f, 0.f, 0.f}; acc[m][1] = (f32x4){0.f, 0.f, 0.f, 0.f}; }
#pragma unroll
        for (int ks = 0; ks < 4; ++ks) {
          bf16x8 b[2];
#pragma unroll
          for (int n = 0; n < 2; ++n) {
            const int ncol = wave * 32 + n * 16 + 4 * p4;
            const s16x4 lo = ldtr(Bs + bs_off(ks * 32 + fq * 8 + q4, ncol));
            const s16x4 hi = ldtr(Bs + bs_off(ks * 32 + fq * 8 + 4 + q4, ncol));
            b[n] = (bf16x8){lo.x, lo.y, lo.z, lo.w, hi.x, hi.y, hi.z, hi.w};
          }
#pragma unroll
          for (int m = 0; m < RG_MT; ++m) {
            const bf16x8 a = *(const bf16x8*)(As + (m * 16 + fr) * RG_AS_STRIDE + (ks * 32 + fq * 8) * 2);
            acc[m][0] = __builtin_amdgcn_mfma_f32_16x16x32_bf16(a, b[0], acc[m][0], 0, 0, 0);
            acc[m][1] = __builtin_amdgcn_mfma_f32_16x16x32_bf16(a, b[1], acc[m][1], 0, 0, 0);
          }
        }
      }
#pragma unroll
      for (int n = 0; n < 2; ++n) {
        const int cl = wave * 32 + n * 16 + fr, ch = ch0 + cl;
        const float ba = p.in[12][d * DR + ch], bx = p.in[14][d * DR + ch], lam = p.in[15][d * DR + ch];
        const float nl = -lam;
        const float sp = nl > 20.f ? nl : log1pf(__expf(nl));
        const float c8 = -8.f * sp;
#pragma unroll
        for (int m = 0; m < RG_MT; ++m)
#pragma unroll
          for (int j = 0; j < 4; ++j) {
            const int row = m * 16 + fq * 4 + j;
            const float r = sigmoidf_(accA[m][n][j] + ba), ig = sigmoidf_(accX[m][n][j] + bx);
            const float la = c8 * r;
            const float a = __expf(la);
            const float x2 = 2.f * la;
            const float om = x2 > -0.1f ? -x2 * (1.f + x2 * (0.5f + x2 * (0.16666667f + x2 * 0.041666668f))) : 1.f - a * a;
            const float mult = sqrtf(om);
            const float uu = bf2f(*(const bf16_t*)(As + row * RG_AS_STRIDE + cl * 2));
            accA[m][n][j] = a; accX[m][n][j] = mult * ig * uu;
            if (j == 3) __builtin_amdgcn_sched_barrier(0);
          }
      }
      float aggP[2], aggH[2];
      if (d == 0) rg_scan<false, 2>(accA, accX, aggP, aggH); else rg_scan<true, 2>(accA, accX, aggP, aggH);
      if (fq == 0) {
#pragma unroll
        for (int n = 0; n < 2; ++n) {
          const int ch = ch0 + wave * 32 + n * 16 + fr;
          float* ag = agg + ((size_t)(d * NRT + tile) * DR + ch) * 2;
          ag[0] = aggP[n]; ag[1] = aggH[n];
        }
      }
      bf16_t* Pout = d ? Pbb : Pfb;
#pragma unroll
      for (int m = 0; m < RG_MT; ++m)
#pragma unroll
        for (int n = 0; n < 2; ++n) {
          if (d == 0) { hfk[m][n].x = pk2(accX[m][n][0], accX[m][n][1]); hfk[m][n].y = pk2(accX[m][n][2], accX[m][n][3]); }
          else { accX[m][n][0] += bflo(hfk[m][n].x); accX[m][n][1] += bfhi(hfk[m][n].x); accX[m][n][2] += bflo(hfk[m][n].y); accX[m][n][3] += bfhi(hfk[m][n].y); }
#pragma unroll
          for (int j = 0; j < 4; ++j) {
            const unsigned o = (unsigned)(r0 + m * 16 + fq * 4 + j) * DR + ch0 + wave * 32 + n * 16 + fr;
            Pout[o] = f2bf(accA[m][n][j]);
            if (d == 1) Sb[o] = f2bf(accX[m][n][j]);
          }
          __builtin_amdgcn_sched_barrier(0);
        }
    }
  }
}

DEV void ph_rg_scan2(const Params& p, char* smem) {
  int tid = threadIdx.x; asm volatile("" : "+v"(tid));
  const int lane = tid & 63, wave = tid >> 6, fr = lane & 15, fq = lane >> 4;
  const bf16_t* pr = (const bf16_t*)(p.ws + WS_PR);
  bf16_t* Sb = (bf16_t*)(p.ws + WS_S); bf16_t* Pfb = (bf16_t*)(p.ws + WS_PF); bf16_t* Pbb = (bf16_t*)(p.ws + WS_PB);
  float* agg = (float*)(p.ws + WS_AGG);
  const bf16_t* WAX = (const bf16_t*)(p.ws + WS_WAXT);
  const float* conv_w = p.in[9]; const float* conv_b = p.in[10];
  const int NU = NRT * 10;
  const int u0 = (int)((long)blockIdx.x * NU / gridDim.x), u1 = (int)((long)(blockIdx.x + 1) * NU / gridDim.x);
  int cur_hb = -1;
  bf16x8 bfr[4][4];
  float cba[2], cbx[2], cc8[2];
#pragma unroll 1
  for (int u = u0; u < u1; ++u) {
    const int hb = u / NRT, tile = u - hb * NRT, r0 = tile * RGT, ch0 = hb * 128;
    const int seg_lo = tile < NRT_LAT ? 0 : NL, seg_hi = tile < NRT_LAT ? NL : T;
    char* As = smem + ((u - u0) & 1) * (RGT * RG_AS_STRIDE);
    if (hb != cur_hb) {
      cur_hb = hb;
#pragma unroll
      for (int mat = 0; mat < 4; ++mat)
#pragma unroll
        for (int ks = 0; ks < 4; ++ks)
          bfr[mat][ks] = *(const bf16x8*)(WAX + (size_t)(((mat >> 1) * 10 + hb) * 2 + (mat & 1)) * 16384 + (16 * wave + fr) * 128 + ks * 32 + fq * 8);
#pragma unroll
      for (int d = 0; d < 2; ++d) {
        const int ch = ch0 + 16 * wave + fr;
        cba[d] = p.in[12][d * DR + ch]; cbx[d] = p.in[14][d * DR + ch];
        const float nl = -p.in[15][d * DR + ch];
        cc8[d] = -8.f * (nl > 20.f ? nl : log1pf(__expf(nl)));
      }
    }
    {
      const int cg8 = tid & 15, rg = tid >> 4, c = ch0 + 8 * cg8;
      float w[4][8], bias[8];
#pragma unroll
      for (int j = 0; j < 4; ++j) { const f32x4 a = *(const f32x4*)(conv_w + j * DR + c), b = *(const f32x4*)(conv_w + j * DR + c + 4);
        w[j][0] = a.x; w[j][1] = a.y; w[j][2] = a.z; w[j][3] = a.w; w[j][4] = b.x; w[j][5] = b.y; w[j][6] = b.z; w[j][7] = b.w; }
      { const f32x4 a = *(const f32x4*)(conv_b + c), b = *(const f32x4*)(conv_b + c + 4);
        bias[0] = a.x; bias[1] = a.y; bias[2] = a.z; bias[3] = a.w; bias[4] = b.x; bias[5] = b.y; bias[6] = b.z; bias[7] = b.w; }
      float win[5][8];
      const int rb = r0 + rg * 2;
#pragma unroll
      for (int t = 0; t < 5; ++t) {
        const int r = rb - 2 + t;
        if (r >= seg_lo && r < seg_hi) { const u32x4 v = *(const u32x4*)(pr + (size_t)r * DR + c);
          win[t][0] = bflo(v.x); win[t][1] = bfhi(v.x); win[t][2] = bflo(v.y); win[t][3] = bfhi(v.y); win[t][4] = bflo(v.z); win[t][5] = bfhi(v.z); win[t][6] = bflo(v.w); win[t][7] = bfhi(v.w); }
        else {
#pragma unroll
          for (int e = 0; e < 8; ++e) win[t][e] = 0.f; }
      }
#pragma unroll
      for (int t = 0; t < 2; ++t) {
        float o[8];
#pragma unroll
        for (int e = 0; e < 8; ++e) o[e] = bias[e] + w[0][e] * win[t][e] + w[1][e] * win[t + 1][e] + w[2][e] * win[t + 2][e] + w[3][e] * win[t + 3][e];
        u32x4 ov; ov.x = pk2(o[0], o[1]); ov.y = pk2(o[2], o[3]); ov.z = pk2(o[4], o[5]); ov.w = pk2(o[6], o[7]);
        *(u32x4*)(As + (rg * 2 + t) * RG_AS_STRIDE + cg8 * 16) = ov;
      }
    }
    __syncthreads();
    f32x4 acc[4][RG_MT][1];
#pragma unroll
    for (int mat = 0; mat < 4; ++mat)
#pragma unroll
      for (int m = 0; m < RG_MT; ++m) acc[mat][m][0] = (f32x4){0.f, 0.f, 0.f, 0.f};
#pragma unroll
    for (int ks = 0; ks < 4; ++ks)
#pragma unroll
      for (int m = 0; m < RG_MT; ++m) {
        const bf16x8 a = *(const bf16x8*)(As + (m * 16 + fr) * RG_AS_STRIDE + (ks * 32 + fq * 8) * 2);
#pragma unroll
        for (int mat = 0; mat < 4; ++mat) acc[mat][m][0] = __builtin_amdgcn_mfma_f32_16x16x32_bf16(a, bfr[mat][ks], acc[mat][m][0], 0, 0, 0);
      }
    const int cl = 16 * wave + fr;
#pragma unroll
    for (int d = 0; d < 2; ++d) {
      f32x4 (&accA)[RG_MT][1] = acc[d * 2]; f32x4 (&accX)[RG_MT][1] = acc[d * 2 + 1];
#pragma unroll
      for (int m = 0; m < RG_MT; ++m) {
#pragma unroll
        for (int j = 0; j < 4; ++j) {
          const int row = m * 16 + fq * 4 + j;
          const float r = sigmoidf_(accA[m][0][j] + cba[d]), ig = sigmoidf_(accX[m][0][j] + cbx[d]);
          const float la = cc8[d] * r;
          const float a = fexp_(la);
          const float x2 = 2.f * la;
          const float om = x2 > -0.1f ? -x2 * (1.f + x2 * (0.5f + x2 * (0.16666667f + x2 * 0.041666668f))) : 1.f - a * a;
          const float uu = bf2f(*(const bf16_t*)(As + row * RG_AS_STRIDE + cl * 2));
          accA[m][0][j] = a; accX[m][0][j] = __builtin_amdgcn_sqrtf(om) * ig * uu;
        }
        __builtin_amdgcn_sched_barrier(0);
      }
      float aggP[1], aggH[1];
      if (d == 0) rg_scan<false, 1>(accA, accX, aggP, aggH); else rg_scan<true, 1>(accA, accX, aggP, aggH);
      if (fq == 0) { float* ag = agg + ((size_t)(d * NRT + tile) * DR + ch0 + cl) * 2; ag[0] = aggP[0]; ag[1] = aggH[0]; }
      bf16_t* Pout = d ? Pbb : Pfb;
#pragma unroll
      for (int m = 0; m < RG_MT; ++m) {
        if (d == 1) accX[m][0] += acc[1][m][0];
#pragma unroll
        for (int j = 0; j < 4; ++j) {
          const unsigned o = (unsigned)(r0 + m * 16 + fq * 4 + j) * DR + ch0 + cl;
          Pout[o] = f2bf(accA[m][0][j]);
          if (d == 1) Sb[o] = f2bf(accX[m][0][j]);
        }
      }
    }
  }
  __syncthreads();
}

DEV void ph_rg_carry(const Params& p, char* smem, int bid, int nb) {
  const float* agg = (const float*)(p.ws + WS_AGG); float* carry = (float*)(p.ws + WS_CARRY);
  const int tid = tidx();
  float* sP = (float*)smem; float* sH = sP + 256;
  constexpr int NCH = 2 * DR, CPB = 25, NB = (NCH + CPB - 1) / CPB;
  for (int it = 0, iters = (NB + nb - 1) / nb; it < iters; ++it) {
    const int blk = bid + it * nb;
    const int lc = tid / 10, seg = tid % 10, chain = blk * CPB + lc;
    const bool on = blk < NB && tid < 250 && chain < NCH;
    const int d = on ? chain / DR : 0, ch = on ? chain % DR : 0;
    float ap[26], ah[26];
    if (on) {
#pragma unroll
      for (int j = 0; j < 26; ++j) {
        const int s = seg * 26 + j;
        const int tile = d == 0 ? (s < (NRT - NRT_LAT) ? NRT_LAT + s : s - (NRT - NRT_LAT)) : NRT - 1 - s;
        const float* ag = agg + ((size_t)(d * NRT + tile) * DR + ch) * 2;
        ap[j] = ag[0]; ah[j] = ag[1];
      }
      float P = 1.f, H = 0.f;
#pragma unroll
      for (int j = 0; j < 26; ++j) { H = ap[j] * H + ah[j]; P = ap[j] * P; }
      sP[tid] = P; sH[tid] = H;
    }
    __syncthreads();
    if (on) {
      float st = 0.f;
      for (int k = 0; k < seg; ++k) st = sP[lc * 10 + k] * st + sH[lc * 10 + k];
#pragma unroll
      for (int j = 0; j < 26; ++j) {
        const int s = seg * 26 + j;
        const int tile = d == 0 ? (s < (NRT - NRT_LAT) ? NRT_LAT + s : s - (NRT - NRT_LAT)) : NRT - 1 - s;
        carry[(size_t)(d * NRT + tile) * DR + ch] = st;
        st = ap[j] * st + ah[j];
      }
    }
    __syncthreads();
  }
}

DEV void ph_rg_final(const Params& p, int bid, int nb) {
  const bf16_t* gg = (const bf16_t*)(p.ws + WS_GG); const bf16_t* Sb = (const bf16_t*)(p.ws + WS_S);
  const bf16_t* Pfb = (const bf16_t*)(p.ws + WS_PF); const bf16_t* Pbb = (const bf16_t*)(p.ws + WS_PB);
  const float* carry = (const float*)(p.ws + WS_CARRY);
  bf16_t* y = (bf16_t*)(p.ws + WS_PR);
  const int total = T * (DR / 8);
  for (int i = bid * 256 + tidx(); i < total; i += nb * 256) {
    const int r = i / 160, c = (i % 160) * 8, tile = r / RGT;
    const size_t o = (size_t)r * DR + c;
    const u32x4 g = *(const u32x4*)(gg + o), s = *(const u32x4*)(Sb + o), pf = *(const u32x4*)(Pfb + o), pb = *(const u32x4*)(Pbb + o);
    const float* cf = carry + (size_t)tile * DR + c; const float* cb = carry + (size_t)(NRT + tile) * DR + c;
    const f32x4 cf0 = *(const f32x4*)cf, cf1 = *(const f32x4*)(cf + 4), cb0 = *(const f32x4*)cb, cb1 = *(const f32x4*)(cb + 4);
    u32x4 o4;
    o4.x = pk2(bflo(g.x) * (bflo(s.x) + bflo(pf.x) * cf0.x + bflo(pb.x) * cb0.x), bfhi(g.x) * (bfhi(s.x) + bfhi(pf.x) * cf0.y + bfhi(pb.x) * cb0.y));
    o4.y = pk2(bflo(g.y) * (bflo(s.y) + bflo(pf.y) * cf0.z + bflo(pb.y) * cb0.z), bfhi(g.y) * (bfhi(s.y) + bfhi(pf.y) * cf0.w + bfhi(pb.y) * cb0.w));
    o4.z = pk2(bflo(g.z) * (bflo(s.z) + bflo(pf.z) * cf1.x + bflo(pb.z) * cb1.x), bfhi(g.z) * (bfhi(s.z) + bfhi(pf.z) * cf1.y + bfhi(pb.z) * cb1.y));
    o4.w = pk2(bflo(g.w) * (bflo(s.w) + bflo(pf.w) * cf1.z + bflo(pb.w) * cb1.z), bfhi(g.w) * (bfhi(s.w) + bfhi(pf.w) * cf1.w + bfhi(pb.w) * cb1.w));
    *(u32x4*)(y + o) = o4;
  }
}

using pg8::Unit;
struct EpiRgIn {
  static constexpr bool PERM = true, AFTER_DRAIN = false;
  bf16_t* gg; bf16_t* pr;
  DEV void operator()(const f32x4 (&acc)[2][2][4][2], const Unit& u, int wr, int wc, int fr, int fq) const {
    const int row0 = u.pm * 256 + wr * 64 + fr, c0 = u.pn * 256 + wc * 32 + 8 * fq;
    const bool gate = u.pn < 5;
#pragma unroll
    for (int ai = 0; ai < 2; ++ai)
#pragma unroll
      for (int m = 0; m < 4; ++m) {
        const unsigned row = row0 + ai * 128 + m * 16;
#pragma unroll
        for (int bj = 0; bj < 2; ++bj) {
          f32x4 v0 = acc[ai][bj][m][0], v1 = acc[ai][bj][m][1];
          const int col = c0 + bj * 128;
          if (gate) {
#pragma unroll
            for (int j = 0; j < 4; ++j) { v0[j] = gelu_tanh(v0[j]); v1[j] = gelu_tanh(v1[j]); }
          }
          u32x4 w; w.x = pk2(v0[0], v0[1]); w.y = pk2(v0[2], v0[3]); w.z = pk2(v1[0], v1[1]); w.w = pk2(v1[2], v1[3]);
          if (gate) *(u32x4*)(gg + row * DR + col) = w; else *(u32x4*)(pr + row * DR + col - DR) = w;
        }
      }
  }
};
template <int LAYER> struct EpiOut {
  static constexpr bool PERM = false, AFTER_DRAIN = false;
  const float* x; const float* ctx; const bf16_t* x2; const float* mods; bf16_t* x1;
  DEV void operator()(const f32x4 (&acc)[2][2][4][2], const Unit& u, int wr, int wc, int fr, int fq) const {
    const int row0 = u.pm * 256 + wr * 64 + fr, c0 = u.pn * 256 + wc * 32 + 4 * fq;
#pragma unroll
    for (int ai = 0; ai < 2; ++ai)
#pragma unroll
      for (int m = 0; m < 4; ++m) {
        const int row = row0 + ai * 128 + m * 16;
        const int trow = LAYER == 0 ? row : token_of_seqrow(row);
        const float* xin = LAYER == 0 ? (row < NL ? x + (size_t)row * D : ctx + (size_t)(row - NL) * D) : nullptr;
        const float* gt = mods + ((LAYER == 0 && row >= NL) ? 6144 : 0) + 2048;
        bf16_t* xo = x1 + (size_t)trow * D;
#pragma unroll
        for (int bj = 0; bj < 2; ++bj)
#pragma unroll
          for (int n = 0; n < 2; ++n) {
            const int col = c0 + bj * 128 + n * 16;
            const f32x4 xi = LAYER == 0 ? *(const f32x4*)(xin + col) : ld_bf4(x2 + (size_t)trow * D + col);
            st_bf4(xo + col, xi + *(const f32x4*)(gt + col) * acc[ai][bj][m][n]);
          }
      }
  }
};
struct EpiMoe1 {
  static constexpr bool PERM = true, AFTER_DRAIN = false;
  bf16_t* Hm;
  DEV void operator()(const f32x4 (&acc)[2][2][4][2], const Unit& u, int wr, int wc, int fr, int fq) const {
    const int row0 = u.pm * 256 + wr * 64 + fr, c0 = (u.pn & 3) * 128 + wc * 32 + 8 * fq;
#pragma unroll
    for (int ai = 0; ai < 2; ++ai)
#pragma unroll
      for (int m = 0; m < 4; ++m) {
        const unsigned row = row0 + ai * 128 + m * 16;
        float h[8];
#pragma unroll
        for (int n = 0; n < 2; ++n)
#pragma unroll
          for (int j = 0; j < 4; ++j) h[n * 4 + j] = siluf_(acc[ai][0][m][n][j]) * acc[ai][1][m][n][j];
        u32x4 w; w.x = pk2(h[0], h[1]); w.y = pk2(h[2], h[3]); w.z = pk2(h[4], h[5]); w.w = pk2(h[6], h[7]);
        *(u32x4*)(Hm + row * DE + c0) = w;
      }
  }
};
struct EpiMoe2 {
  static constexpr bool PERM = true, AFTER_DRAIN = false;
  bf16_t* Y; const float* awp;
  DEV void operator()(const f32x4 (&acc)[2][2][4][2], const Unit& u, int wr, int wc, int fr, int fq) const {
    const int row0 = u.pm * 256 + wr * 64 + fr, c0 = (u.pn & 3) * 256 + wc * 32 + 8 * fq;
#pragma unroll
    for (int ai = 0; ai < 2; ++ai)
#pragma unroll
      for (int m = 0; m < 4; ++m) {
        const unsigned row = row0 + ai * 128 + m * 16;
        const float w8 = awp[row];
#pragma unroll
        for (int bj = 0; bj < 2; ++bj) {
          const f32x4 v0 = acc[ai][bj][m][0] * w8, v1 = acc[ai][bj][m][1] * w8;
          u32x4 w; w.x = pk2(v0[0], v0[1]); w.y = pk2(v0[2], v0[3]); w.z = pk2(v1[0], v1[1]); w.w = pk2(v1[2], v1[3]);
          *(u32x4*)(Y + row * D + c0 + bj * 128) = w;
        }
      }
  }
};
struct EpiMlIn {
  static constexpr bool PERM = false, AFTER_DRAIN = false;
  bf16_t* qb; bf16_t* kb; bf16_t* kT; bf16_t* vT; bf16_t* og;
  DEV void operator()(const f32x4 (&acc)[2][2][4][2], const Unit& u, int wr, int wc, int fr, int fq) const {
    const unsigned row0 = u.pm * 256 + wr * 64 + fr, c0 = u.pn * 256 + wc * 32 + 4 * fq;
    const int pn = u.pn;
#define MLIN_LOOP(BODY) _Pragma("unroll") for (int ai = 0; ai < 2; ++ai) _Pragma("unroll") for (int m = 0; m < 4; ++m) { const unsigned row = row0 + ai * 128 + m * 16; \
      _Pragma("unroll") for (int bj = 0; bj < 2; ++bj) _Pragma("unroll") for (int n = 0; n < 2; ++n) { const f32x4 v = acc[ai][bj][m][n]; const unsigned col = c0 + bj * 128 + n * 16; BODY } }
    if (pn < 2) {
      MLIN_LOOP({ u32x2 o; o.x = pk2(v[0] * 0.125f, v[1] * 0.125f); o.y = pk2(v[2] * 0.125f, v[3] * 0.125f); *(u32x2*)(qb + row * 512 + col) = o; })
    } else if (pn < 4) {
      MLIN_LOOP({ u32x2 o; o.x = pk2(v[0], v[1]); o.y = pk2(v[2], v[3]); *(u32x2*)(kb + row * 512 + col - 512) = o;
        bf16_t* kp = kT + (col - 512) * T + row;
        kp[0] = (bf16_t)(o.x & 0xffffu); kp[T] = (bf16_t)(o.x >> 16); kp[2 * T] = (bf16_t)(o.y & 0xffffu); kp[3 * T] = (bf16_t)(o.y >> 16); })
    } else if (pn < 8) {
      MLIN_LOOP({ u32x2 o; o.x = pk2(v[0], v[1]); o.y = pk2(v[2], v[3]);
        bf16_t* vp = vT + (col - 1024) * T + row;
        vp[0] = (bf16_t)(o.x & 0xffffu); vp[T] = (bf16_t)(o.x >> 16); vp[2 * T] = (bf16_t)(o.y & 0xffffu); vp[3 * T] = (bf16_t)(o.y >> 16); })
    } else {
      MLIN_LOOP({ u32x2 o; o.x = pk2(sigmoidf_(v[0]), sigmoidf_(v[1])); o.y = pk2(sigmoidf_(v[2]), sigmoidf_(v[3])); *(u32x2*)(og + row * D + col - 2048) = o; })
    }
#undef MLIN_LOOP
  }
};

struct MoeOrder {
  const int* tb; int ntn, G, c;
  DEV bool next(int i, Unit& u) const {
    const int U = tb[32], per = (U + 7) >> 3, xcd = c & 7, lo = xcd * per, hi = min(lo + per, U);
    const int L = lo + i * (G >> 3) + (c >> 3); if (L >= hi) return false;
    int e = 0;
#pragma unroll 1
    for (int k = 1; k < 32; ++k) e = (L >= tb[k]) ? k : e;
    const int r = L - tb[e], mt = (tb[e + 1] - tb[e]) / ntn;
    u.pm = tb[33 + e] + r % mt; u.pn = e * ntn + r / mt; return true;
  }
  DEV void a_ready(const Unit&) const {}
  DEV void done(const Unit&) const {}
  const int* rowmap;
  DEV int src_row(const Unit& u, int r) const { return rowmap[u.pm * 256 + r]; }
};
constexpr int LDS_TB = 131072;
DEV void moe_tables(const int* cnt, char* smem, int ntn) {
  int* tb = (int*)(smem + LDS_TB);
  if (threadIdx.x == 0) {
    int ub = 0, rb = 0;
    for (int e = 0; e < 32; ++e) { const int m = (cnt[e * CNT_STRIDE] + 255) >> 8; tb[e] = ub; tb[33 + e] = rb; ub += m * ntn; rb += m; }
    tb[32] = ub; tb[65] = rb;
  }
  __syncthreads();
}

template <int NT>
DEV void wave_gemm16(const bf16_t* A, int lda, const bf16_t* Bt, int ldb, int ks0, int ks1, f32x4 (&acc)[NT]) {
  const int lane = tidf() & 63, fr = lane & 15, fq = lane >> 4;
  const bf16_t* ap = A + (size_t)fr * lda + fq * 8; const bf16_t* bp = Bt + (size_t)fr * ldb + fq * 8;
#pragma unroll 4
  for (int ks = ks0; ks < ks1; ++ks) {
    const bf16x8 a = *(const bf16x8*)(ap + ks * 32);
#pragma unroll
    for (int n = 0; n < NT; ++n) {
      const bf16x8 b = *(const bf16x8*)(bp + (size_t)n * 16 * ldb + ks * 32);
      acc[n] = __builtin_amdgcn_mfma_f32_16x16x32_bf16(a, b, acc[n], 0, 0, 0);
    }
  }
}
DEV void ph_out0_ctx(const Params& p, char* smem) {
  const int tf = tidf(), lane = tf & 63, wv = tf >> 6, fr = lane & 15, fq = lane >> 4;
  const int b = blockIdx.x;
  f32x4* red = (f32x4*)smem;
  if (b < 256) {
    const int rt = b >> 4, cg = b & 15, nt = wv & 3, kh = wv >> 2;
    f32x4 acc[1] = {(f32x4){0.f, 0.f, 0.f, 0.f}};
    wave_gemm16<1>((const bf16_t*)(p.ws + WS_PR) + (size_t)(NL + rt * 16) * DR, DR, (const bf16_t*)(p.ws + WS_WOUT) + (size_t)(cg * 64 + nt * 16) * DR, DR, kh * 20, kh * 20 + 20, acc);
    if (kh == 1) red[nt * 64 + lane] = acc[0];
    __syncthreads();
    if (kh == 0) {
      const f32x4 v = acc[0] + red[nt * 64 + lane];
      const int col = cg * 64 + nt * 16 + fr;
      const float gt = ((const float*)(p.ws + WS_MODS))[6144 + 2048 + col];
      bf16_t* x1 = (bf16_t*)(p.ws + WS_X1);
#pragma unroll
      for (int j = 0; j < 4; ++j) { const int r = rt * 16 + fq * 4 + j; x1[(size_t)(NL + r) * D + col] = f2bf(p.in[2][(size_t)r * D + col] + gt * v[j]); }
    }
  } else __syncthreads();
  __syncthreads();
}
DEV void ph_mlin_small(const Params& p, char* smem) {
  const int tf = tidf(), lane = tf & 63, wv = tf >> 6, fr = lane & 15, fq = lane >> 4;
  const bf16_t* hA = (const bf16_t*)(p.ws + WS_HA); const bf16_t* W = (const bf16_t*)(p.ws + WS_WML);
  bf16_t* kb = (bf16_t*)(p.ws + WS_K); bf16_t* kT = (bf16_t*)(p.ws + WS_KT); bf16_t* vT = (bf16_t*)(p.ws + WS_VT); float* gl = (float*)(p.ws + WS_GL);
  const int b = blockIdx.x;
  if (b < 192) {
    const int rt = b / 12, cg = b % 12, col0 = 512 + cg * 128 + wv * 16;
    f32x4 acc[1] = {(f32x4){0.f, 0.f, 0.f, 0.f}};
    wave_gemm16<1>(hA + (size_t)(NL + rt * 16) * D, D, W + (size_t)col0 * D, D, 0, 32, acc);
    const unsigned col = col0 + fr, row = NL + rt * 16 + fq * 4;
    u32x2 o; o.x = pk2(acc[0][0], acc[0][1]); o.y = pk2(acc[0][2], acc[0][3]);
    if (col < 1024) {
      *(u32x2*)(kT + (col - 512) * T + row) = o;
      kb[(row + 0) * 512 + col - 512] = (bf16_t)(o.x & 0xffffu); kb[(row + 1) * 512 + col - 512] = (bf16_t)(o.x >> 16);
      kb[(row + 2) * 512 + col - 512] = (bf16_t)(o.y & 0xffffu); kb[(row + 3) * 512 + col - 512] = (bf16_t)(o.y >> 16);
    } else *(u32x2*)(vT + (col - 1024) * T + row) = o;
  }
  {
    char* As = smem; float* red = (float*)(smem + 16 * 2064);
    const float* bgt = p.in[29];
    for (int u = blockIdx.x; u < T / 16; u += gridDim.x) {
      __syncthreads();
#pragma unroll
      for (int rr = 0; rr < 2; ++rr) {
        const int r = wv * 2 + rr; const u32x4* src = (const u32x4*)(hA + (size_t)(u * 16 + r) * D);
        const u32x4 v0 = src[lane], v1 = src[lane + 64];
        *(u32x4*)(As + r * 2064 + lane * 16) = v0; *(u32x4*)(As + r * 2064 + 1024 + lane * 16) = v1;
      }
      __syncthreads();
      f32x4 acc[2] = {(f32x4){0.f, 0.f, 0.f, 0.f}, (f32x4){0.f, 0.f, 0.f, 0.f}};
#pragma unroll
      for (int s4 = 0; s4 < 4; ++s4) {
        const int ks = wv * 4 + s4;
        const bf16x8 a = *(const bf16x8*)(As + fr * 2064 + (ks * 32 + fq * 8) * 2);
#pragma unroll
        for (int n = 0; n < 2; ++n) {
          const bf16x8 bb = *(const bf16x8*)(W + (size_t)(3072 + n * 16 + fr) * D + ks * 32 + fq * 8);
          acc[n] = __builtin_amdgcn_mfma_f32_16x16x32_bf16(a, bb, acc[n], 0, 0, 0);
        }
      }
#pragma unroll
      for (int n = 0; n < 2; ++n)
#pragma unroll
        for (int j = 0; j < 4; ++j) red[(wv * 16 + fq * 4 + j) * 32 + n * 16 + fr] = acc[n][j];
      __syncthreads();
      {
        const int row = tf >> 5, jj = tf & 31;
        float g = bgt[jj];
#pragma unroll
        for (int w = 0; w < 8; ++w) g += red[(w * 16 + row) * 32 + jj];
        gl[(size_t)(u * 16 + row) * 32 + jj] = ((jj >> 3) & 1) ? (fminf(g, 0.f) - log1pf(__expf(-fabsf(g)))) : g;
      }
    }
    __syncthreads();
  }
}

template <int WHICH>
DEV void ph_gemm_dense(const Params& p, char* smem) {
  pg8::StaticOrder S;
  LAS unsigned char* lds = (LAS unsigned char*)smem;
  if constexpr (WHICH == 0) {
    S.init(T, 2560, gridDim.x, blockIdx.x);
    EpiRgIn E{(bf16_t*)(p.ws + WS_GG), (bf16_t*)(p.ws + WS_PR)};
    pg8::gemm_phase<EpiRgIn, pg8::StaticOrder>(lds, pg8::Gemm{(const bf16_t*)(p.ws + WS_HA), (const bf16_t*)(p.ws + WS_WIN), T, 2560, 1024}, S, E, nullptr);
  } else if constexpr (WHICH == 1) {
    S.init(NL, 1024, gridDim.x, blockIdx.x);
    EpiOut<0> E{p.in[0], p.in[2], nullptr, (const float*)(p.ws + WS_MODS), (bf16_t*)(p.ws + WS_X1)};
    pg8::gemm_phase<EpiOut<0>, pg8::StaticOrder>(lds, pg8::Gemm{(const bf16_t*)(p.ws + WS_PR), (const bf16_t*)(p.ws + WS_WOUT), NL, 1024, 1280}, S, E, nullptr);
  } else if constexpr (WHICH == 2) {
    S.init(NL, 3072, gridDim.x, blockIdx.x);
    EpiMlIn E{(bf16_t*)(p.ws + WS_Q), (bf16_t*)(p.ws + WS_K), (bf16_t*)(p.ws + WS_KT), (bf16_t*)(p.ws + WS_VT), (bf16_t*)(p.ws + WS_OG)};
    pg8::gemm_phase<EpiMlIn, pg8::StaticOrder>(lds, pg8::Gemm{(const bf16_t*)(p.ws + WS_HA), (const bf16_t*)(p.ws + WS_WML), NL, 3072, 1024}, S, E, nullptr);
  } else {
    S.init(NL, 1024, gridDim.x, blockIdx.x);
    EpiOut<1> E{nullptr, nullptr, (const bf16_t*)(p.ws + WS_X2), (const float*)(p.ws + WS_MODS) + 2 * 6144, (bf16_t*)(p.ws + WS_X1)};
    pg8::gemm_phase<EpiOut<1>, pg8::StaticOrder>(lds, pg8::Gemm{(const bf16_t*)(p.ws + WS_HA), (const bf16_t*)(p.ws + WS_WMO), NL, 1024, 1024}, S, E, nullptr);
  }
}
template <int LAYER, int STAGE>
DEV void ph_gemm_moe(const Params& p, char* smem) {
  const int* cnt = (const int*)(p.ws + WS_CNT) + LAYER * 32 * CNT_STRIDE;
  moe_tables(cnt, smem, 4);
  MoeOrder S{(const int*)(smem + LDS_TB), 4, (int)gridDim.x, (int)blockIdx.x, (const int*)(p.ws + WS_ROWMAP)};
  LAS unsigned char* lds = (LAS unsigned char*)smem;
  const bf16_t* WGU = (const bf16_t*)(p.ws + (LAYER == 0 ? WS_WGU : WS_WGU1)); const bf16_t* WD = (const bf16_t*)(p.ws + (LAYER == 0 ? WS_WD : WS_WD1));
  if constexpr (STAGE == 0) {
    EpiMoe1 E{(bf16_t*)(p.ws + WS_HM)};
    pg8::gemm_phase_gather<EpiMoe1, MoeOrder>(lds, pg8::Gemm{(const bf16_t*)(p.ws + WS_HA), WGU, T, 32 * 1024, 1024}, S, E, nullptr);
  } else {
    EpiMoe2 E{(bf16_t*)(p.ws + WS_Y), (const float*)(p.ws + WS_AWP)};
    pg8::gemm_phase<EpiMoe2, MoeOrder>(lds, pg8::Gemm{(const bf16_t*)(p.ws + WS_HM), WD, MOE_ROWS, 32 * 1024, 512}, S, E, nullptr);
  }
  if constexpr (LAYER == 0) {
    const int* tb = (const int*)(smem + LDS_TB);
    const int U = tb[32], per = (U + 7) >> 3, xcd = blockIdx.x & 7, lo = xcd * per, hi = min(lo + per, U), slot = blockIdx.x >> 3, ns = gridDim.x >> 3;
    const int n1 = max(hi - lo, 0), mine = slot < n1 ? (n1 - slot + ns - 1) / ns : 0, rounds = ((U + 7) / 8 + ns - 1) / ns;
    const int idle = rounds - mine;
    __syncthreads();
    if (idle > 0) conv_queue_l1(p, smem, idle * (STAGE == 0 ? 3 : 1));
  }
}

template <int LAYER>
DEV void ph_scatter(const Params& p, char* smem, int bid, int nb) {
  const int tid = tidx(), lane = tid & 63, wave = tid >> 6;
  constexpr int NTOK = LAYER == 0 ? T : NL;
  constexpr int NU = NTOK / 16;
  int* cnt = (int*)(p.ws + WS_CNT) + LAYER * 32 * CNT_STRIDE;
  const int* eid = (const int*)(p.ws + WS_LIST); const int* hstg = eid + T;
  const float* aw = (const float*)(p.ws + WS_AW);
  int* pos = (int*)(p.ws + WS_POS); float* awp = (float*)(p.ws + WS_AWP);
  const bf16_t* hA = (const bf16_t*)(p.ws + WS_HA); bf16_t* Ab = (bf16_t*)(p.ws + WS_ABUF);
  int* part = (int*)smem;
  int* base = part + 512;
  int* dstl = base + 32;
  {
    const int e = tid & 31, pt = tid >> 5; int tot = 0, below = 0;
    for (int v = pt * (nb / 8); v < (pt + 1) * (nb / 8); ++v) { const int h = hstg[v * 32 + e]; tot += h; below += v < bid ? h : 0; }
    part[(pt * 32 + e) * 2] = tot; part[(pt * 32 + e) * 2 + 1] = below;
  }
  __syncthreads();
  if (tid == 0) {
    int o = 0;
    for (int e = 0; e < 32; ++e) {
      int tot = 0, below = 0;
      for (int pt = 0; pt < 8; ++pt) { tot += part[(pt * 32 + e) * 2]; below += part[(pt * 32 + e) * 2 + 1]; }
      base[e] = o + below; o += ((tot + 255) >> 8) << 8;
      if (bid == 0) cnt[e * CNT_STRIDE] = tot;
    }
    for (int it = 0; bid + it * nb < NU; ++it) {
      const int t0 = (bid + it * nb) * 16;
      for (int i = 0; i < 16; ++i) {
        const int ee = eid[t0 + i], ea = ee & 255, eb = ee >> 8;
        const int da = base[ea]++, db = base[eb]++;
        dstl[it * 32 + 2 * i] = da; dstl[it * 32 + 2 * i + 1] = db;
      }
    }
  }
  __syncthreads();
  for (int it = 0; bid + it * nb < NU; ++it) {
    const int t0 = (bid + it * nb) * 16;
    if (tid < 32) { const int d = dstl[it * 32 + tid]; pos[2 * t0 + tid] = d; awp[d] = aw[2 * t0 + tid]; }
#pragma unroll
    for (int hh = 0; hh < 2; ++hh) {
      u32x4 v0[4], v1[4];
#pragma unroll
      for (int q = 0; q < 4; ++q) { const int a = wave * 8 + hh * 4 + q; const u32x4* src = (const u32x4*)(hA + (size_t)(t0 + (a >> 1)) * D); v0[q] = src[lane]; v1[q] = src[lane + 64]; }
#pragma unroll
      for (int q = 0; q < 4; ++q) { const int a = wave * 8 + hh * 4 + q; u32x4* d = (u32x4*)(Ab + (size_t)dstl[it * 32 + a] * D); d[lane] = v0[q]; d[lane + 64] = v1[q]; }
    }
  }
  __syncthreads();
}

constexpr int RT_STRIDE = 2064;
constexpr int RT_H2 = 0, RT_LO = 16 * RT_STRIDE, RT_RED = 2 * 16 * RT_STRIDE, RT_SMEM = RT_RED + 4 * 16 * 48 * 4;
constexpr int R2_ASTR = 528;
constexpr int R2_AH = 0, R2_AL = 80 * R2_ASTR, R2_RSTD = 2 * 80 * R2_ASTR;
constexpr int R2_RED = 0, R2_LG = 8 * 80 * 48 * 4, R2_HIST = R2_LG + 80 * 48 * 4, R2_SMEM = R2_HIST + 128;
template <int LAYER>
DEV void ph_router2(const Params& p, char* smem) {
  const int tf = tidf(), lane = tf & 63, wv = tf >> 6, fr = lane & 15, fq = lane >> 4;
  const int b = blockIdx.x;
  const bool has_ctx = LAYER == 0 && b < 16;
  const int nrow = has_ctx ? 80 : 64, nmt = has_ctx ? 5 : 4;
  const float* mods = (const float*)(p.ws + WS_MODS) + LAYER * 2 * 6144;
  const bf16_t* x1 = (const bf16_t*)(p.ws + WS_X1);
  bf16_t* hA = (bf16_t*)(p.ws + WS_HA);
  const float* g2 = p.in[LAYER == 0 ? 7 : 27];
  const float* Bg = p.in[LAYER == 0 ? 18 : 33]; const float* Be = p.in[LAYER == 0 ? 20 : 35];
  int* eid = (int*)(p.ws + WS_LIST); int* hstg = eid + T; float* aw = (float*)(p.ws + WS_AW);
  char* AH = smem + R2_AH; char* AL = smem + R2_AL; float* rstd_s = (float*)(smem + R2_RSTD);
  float* red = (float*)(smem + R2_RED); float* lgt = (float*)(smem + R2_LG); int* hist = (int*)(smem + R2_HIST);
  auto tok_of = [&](int r) { return r < 64 ? b * 64 + r : NL + b * 16 + (r - 64); };
  if (tf < 32) hist[tf] = 0;
  for (int rb = 0; rb < nrow; rb += 32) {
    f32x4 v[4][4]; float ss[4];
#pragma unroll
    for (int q = 0; q < 4; ++q) {
      const int r = rb + wv + 8 * q; const int t = tok_of(r < nrow ? r : 0);
      const bf16_t* src = x1 + (size_t)t * D;
#pragma unroll
      for (int i = 0; i < 4; ++i) v[q][i] = ld_bf4(src + 4 * lane + 256 * i);
    }
#pragma unroll
    for (int q = 0; q < 4; ++q) {
      ss[q] = 0.f;
#pragma unroll
      for (int i = 0; i < 4; ++i) ss[q] += v[q][i].x * v[q][i].x + v[q][i].y * v[q][i].y + v[q][i].z * v[q][i].z + v[q][i].w * v[q][i].w;
      ss[q] = rsqrtf(wave_sum(ss[q]) * (1.f / D) + EPS);
    }
#pragma unroll
    for (int q = 0; q < 4; ++q) {
      const int r = rb + wv + 8 * q;
      if (r < nrow) {
        const int t = tok_of(r);
        const float* md = mods + ((LAYER == 0 && t >= NL) ? 6144 : 0);
        if (lane == 0) rstd_s[r] = ss[q];
#pragma unroll
        for (int i = 0; i < 4; ++i) {
          const int c = 4 * lane + 256 * i;
          const f32x4 g = *(const f32x4*)(g2 + c), sh = *(const f32x4*)(md + 3072 + c), sc = *(const f32x4*)(md + 4096 + c);
          const f32x4 h = v[q][i] * ss[q] * g * (1.f + sc) + sh;
          u32x2 o; o.x = pk2(h.x, h.y); o.y = pk2(h.z, h.w);
          *(u32x2*)(hA + (size_t)t * D + c) = o;
        }
      }
    }
  }
  __syncthreads();
  f32x4 acc[5][3];
#pragma unroll
  for (int m = 0; m < 5; ++m)
#pragma unroll
    for (int n = 0; n < 3; ++n) acc[m][n] = (f32x4){0.f, 0.f, 0.f, 0.f};
  const bf16_t* Wh = (const bf16_t*)(p.ws + WS_WR) + (size_t)(LAYER * 2) * 48 * 1024 + (size_t)fr * 1024 + fq * 8;
  const bf16_t* Wl = Wh + 48 * 1024;
#pragma unroll 1
  for (int c = 0; c < 4; ++c) {
    const int k = 256 * c + 4 * lane;
    const f32x4 g = *(const f32x4*)(g2 + k);
    f32x4 xv[10];
#pragma unroll
    for (int q = 0; q < 10; ++q) { const int r = wv + 8 * q; if (r < nrow) xv[q] = ld_bf4(x1 + (size_t)tok_of(r) * D + k); }
#pragma unroll
    for (int q = 0; q < 10; ++q) {
      const int r = wv + 8 * q;
      if (r < nrow) {
        const float* md = mods + ((LAYER == 0 && r >= 64) ? 6144 : 0);
        const f32x4 sh = *(const f32x4*)(md + 3072 + k), sc = *(const f32x4*)(md + 4096 + k);
        const f32x4 h = xv[q] * rstd_s[r] * g * (1.f + sc) + sh;
        u32x2 o; o.x = pk2(h.x, h.y); o.y = pk2(h.z, h.w);
        u32x2 l; l.x = pk2(h.x - bflo(o.x), h.y - bfhi(o.x)); l.y = pk2(h.z - bflo(o.y), h.w - bfhi(o.y));
        *(u32x2*)(AH + r * R2_ASTR + lane * 8) = o; *(u32x2*)(AL + r * R2_ASTR + lane * 8) = l;
      }
    }
    __syncthreads();
    bf16x8 bh[3], bl[3];
#pragma unroll
    for (int n = 0; n < 3; ++n) { bh[n] = *(const bf16x8*)(Wh + (size_t)n * 16 * 1024 + c * 256 + wv * 32); bl[n] = *(const bf16x8*)(Wl + (size_t)n * 16 * 1024 + c * 256 + wv * 32); }
#pragma unroll
    for (int m = 0; m < 5; ++m) {
      if (m < nmt) {
        const bf16x8 ah = *(const bf16x8*)(AH + (m * 16 + fr) * R2_ASTR + (wv * 32 + fq * 8) * 2), al = *(const bf16x8*)(AL + (m * 16 + fr) * R2_ASTR + (wv * 32 + fq * 8) * 2);
#pragma unroll
        for (int n = 0; n < 3; ++n) {
          acc[m][n] = __builtin_amdgcn_mfma_f32_16x16x32_bf16(al, bh[n], acc[m][n], 0, 0, 0);
          acc[m][n] = __builtin_amdgcn_mfma_f32_16x16x32_bf16(ah, bl[n], acc[m][n], 0, 0, 0);
          acc[m][n] = __builtin_amdgcn_mfma_f32_16x16x32_bf16(ah, bh[n], acc[m][n], 0, 0, 0);
        }
      }
    }
    __syncthreads();
  }
#pragma unroll
  for (int m = 0; m < 5; ++m)
    if (m < nmt) {
#pragma unroll
      for (int n = 0; n < 3; ++n)
#pragma unroll
        for (int j = 0; j < 4; ++j) red[(wv * 80 + m * 16 + fq * 4 + j) * 48 + n * 16 + fr] = acc[m][n][j];
    }
  __syncthreads();
  for (int i = tf; i < nrow * 48; i += 512) {
    float sm = 0.f;
#pragma unroll
    for (int w = 0; w < 8; ++w) sm += red[w * 80 * 48 + i];
    lgt[i] = sm;
  }
  __syncthreads();
  if (tf < nrow) {
    const int t = tok_of(tf);
    const float* lg = lgt + tf * 48;
    float gl[4];
#pragma unroll
    for (int i = 0; i < 4; ++i) gl[i] = lg[32 + i] + Bg[i];
    int grp = 0; float gm = gl[0];
#pragma unroll
    for (int i = 1; i < 4; ++i) if (gl[i] > gm) { gm = gl[i]; grp = i; }
    float den = 0.f;
#pragma unroll
    for (int i = 0; i < 4; ++i) den += __expf(gl[i] - gm);
    const float psel = 1.f / den;
    float v0 = -INFINITY, v1 = -INFINITY; int i0 = 0, i1 = 0;
    for (int i = 0; i < 8; ++i) {
      const float v = lg[grp * 8 + i] + Be[grp * 8 + i];
      if (v > v0) { v1 = v0; i1 = i0; v0 = v; i0 = i; }
      else if (v > v1) { v1 = v; i1 = i; }
    }
    const float e1 = __expf(v1 - v0);
    const float w0 = psel / (1.f + e1), w1 = psel * e1 / (1.f + e1);
    const int ea = grp * 8 + i0, eb = grp * 8 + i1;
    eid[t] = ea | (eb << 8);
    aw[2 * t] = w0; aw[2 * t + 1] = w1;
    atomicAdd(&hist[ea], 1); atomicAdd(&hist[eb], 1);
  }
  __syncthreads();
  if (tf < 32) hstg[b * 32 + tf] = hist[tf];
}

template <int LAYER>
DEV void ph_scatter2(const Params& p, char* smem) {
  const int tf = tidf(), lane = tf & 63, wv = tf >> 6;
  const int b = blockIdx.x, G = gridDim.x;
  const bool has_ctx = LAYER == 0 && b < 16;
  const int nrow = has_ctx ? 80 : 64;
  int* cnt = (int*)(p.ws + WS_CNT) + LAYER * 32 * CNT_STRIDE;
  const int* eid = (const int*)(p.ws + WS_LIST); const int* hstg = eid + T;
  const float* aw = (const float*)(p.ws + WS_AW);
  int* pos = (int*)(p.ws + WS_POS); float* awp = (float*)(p.ws + WS_AWP);
  const bf16_t* hA = (const bf16_t*)(p.ws + WS_HA); bf16_t* Ab = (bf16_t*)(p.ws + WS_ABUF);
  int* part = (int*)smem;
  int* base = part + 1024;
  int* dstl = base + 32;
  int* tots = dstl + 160;
  auto tok_of = [&](int r) { return r < 64 ? b * 64 + r : NL + b * 16 + (r - 64); };
  { const int e = tf & 31, pt = tf >> 5, per = (G + 15) / 16; int tot = 0, below = 0;
    for (int v = pt * per; v < (pt + 1) * per && v < G; ++v) { const int h = hstg[v * 32 + e]; tot += h; below += v < b ? h : 0; }
    part[(pt * 32 + e) * 2] = tot; part[(pt * 32 + e) * 2 + 1] = below; }
  __syncthreads();
  if (tf == 0) {
    int o = 0;
    for (int e = 0; e < 32; ++e) {
      int tot = 0, below = 0;
      for (int pt = 0; pt < 16; ++pt) { tot += part[(pt * 32 + e) * 2]; below += part[(pt * 32 + e) * 2 + 1]; }
      base[e] = o + below; tots[2 * e] = tot; o += ((tot + 255) >> 8) << 8;
      if (b == 0) cnt[e * CNT_STRIDE] = tot;
    }
    for (int r = 0; r < nrow; ++r) {
      const int ee = eid[tok_of(r)], ea = ee & 255, eb = ee >> 8;
      dstl[2 * r] = base[ea]++; dstl[2 * r + 1] = base[eb]++;
    }
  }
  __syncthreads();
  int* rowmap = (int*)(p.ws + WS_ROWMAP);
  if (tf < 2 * nrow) { const int t = tok_of(tf >> 1), d = dstl[tf]; pos[2 * t + (tf & 1)] = d; awp[d] = aw[2 * t + (tf & 1)]; rowmap[d] = t; }
  if (b < 32 && tf < 256) {
    int o = 0; for (int e = 0; e < b; ++e) o += ((tots[2 * e] + 255) >> 8) << 8;
    const int tot = tots[2 * b], r = o + tot + tf; if (r < o + (((tot + 255) >> 8) << 8)) { rowmap[r] = 0; awp[r] = 0.f; }
  }
  __syncthreads();
}

DEV void ph_combine0(const Params& p, int bid, int nb) {
  const int lane = tidx() & 63, wave = tidx() >> 6;
  const float* mods0 = (const float*)(p.ws + WS_MODS); const float* mods1 = mods0 + 2 * 6144;
  const bf16_t* x1 = (const bf16_t*)(p.ws + WS_X1); bf16_t* x2 = (bf16_t*)(p.ws + WS_X2);
  const bf16_t* Y = (const bf16_t*)(p.ws + WS_Y); const int* pos = (const int*)(p.ws + WS_POS);
  bf16_t* hA = (bf16_t*)(p.ws + WS_HA);
  const float* g1 = p.in[26];
  for (int t0 = (bid * 4 + wave) * 2; t0 < T; t0 += nb * 8) {
    f32x4 xv[2][4]; u32x2 ya[2][4], yb[2][4];
#pragma unroll
    for (int q = 0; q < 2; ++q) {
      const int t = t0 + q;
      const bf16_t* Ya = Y + (size_t)pos[2 * t] * D; const bf16_t* Yb = Y + (size_t)pos[2 * t + 1] * D;
#pragma unroll
      for (int i = 0; i < 4; ++i) { const int c = 4 * lane + 256 * i; xv[q][i] = ld_bf4(x1 + (size_t)t * D + c); ya[q][i] = *(const u32x2*)(Ya + c); yb[q][i] = *(const u32x2*)(Yb + c); }
    }
#pragma unroll
    for (int q = 0; q < 2; ++q) {
      const int t = t0 + q;
      const float* m0 = mods0 + (t < NL ? 0 : 6144); const float* m1 = mods1 + (t < NL ? 0 : 6144);
      const int orow = t < NL ? seqrow_of_token(t) : t;
      float ss = 0.f;
#pragma unroll
      for (int i = 0; i < 4; ++i) {
        const int c = 4 * lane + 256 * i;
        const f32x4 gt = *(const f32x4*)(m0 + 5120 + c);
        f32x4 f; f.x = bflo(ya[q][i].x) + bflo(yb[q][i].x); f.y = bfhi(ya[q][i].x) + bfhi(yb[q][i].x); f.z = bflo(ya[q][i].y) + bflo(yb[q][i].y); f.w = bfhi(ya[q][i].y) + bfhi(yb[q][i].y);
        xv[q][i] = xv[q][i] + gt * f;
        st_bf4(x2 + (size_t)t * D + c, xv[q][i]);
        ss += xv[q][i].x * xv[q][i].x + xv[q][i].y * xv[q][i].y + xv[q][i].z * xv[q][i].z + xv[q][i].w * xv[q][i].w;
      }
      const float rstd = rsqrtf(wave_sum(ss) * (1.f / D) + EPS);
#pragma unroll
      for (int i = 0; i < 4; ++i) {
        const int c = 4 * lane + 256 * i;
        const f32x4 g = *(const f32x4*)(g1 + c), sh = *(const f32x4*)(m1 + c), sc = *(const f32x4*)(m1 + 1024 + c);
        const f32x4 h = xv[q][i] * rstd * g * (1.f + sc) + sh;
        u32x2 o; o.x = pk2(h.x, h.y); o.y = pk2(h.z, h.w);
        *(u32x2*)(hA + (size_t)orow * D + c) = o;
      }
    }
  }
}

DEV void ml_gate_scans_t(const float* gl, int r0, int h, float* li_f, float* cf, float* li_b, float* cb, int tid) {
  const int lane = tid & 63, wave = tid >> 6;
  if (tid < 128) { li_f[tid] = gl[(size_t)(r0 + tid) * 32 + h]; li_b[tid] = gl[(size_t)(r0 + tid) * 32 + 16 + h]; }
  if (wave == 0) {
    const float v0 = gl[(size_t)(r0 + 2 * lane) * 32 + 8 + h], v1 = gl[(size_t)(r0 + 2 * lane + 1) * 32 + 8 + h];
    const float s = v0 + v1; float inc = s;
#pragma unroll
    for (int o = 1; o < 64; o <<= 1) { const float t = __shfl_up(inc, o); if (lane >= o) inc += t; }
    const float ex = inc - s;
    cf[2 * lane] = ex + v0; cf[2 * lane + 1] = ex + s;
  } else if (wave == 1) {
    const float v0 = gl[(size_t)(r0 + 127 - 2 * lane) * 32 + 24 + h], v1 = gl[(size_t)(r0 + 126 - 2 * lane) * 32 + 24 + h];
    const float s = v0 + v1; float inc = s;
#pragma unroll
    for (int o = 1; o < 64; o <<= 1) { const float t = __shfl_up(inc, o); if (lane >= o) inc += t; }
    const float ex = inc - s;
    cb[127 - 2 * lane] = ex + v0; cb[126 - 2 * lane] = ex + s;
  }
}

DEV void ml_gate_scans(const float* gl, int r0, int h, float* li_f, float* cf, float* li_b, float* cb) { ml_gate_scans_t(gl, r0, h, li_f, cf, li_b, cb, tidx()); }

constexpr int MLA_STRIDE = 272;
constexpr int MLA_AW = 0, MLA_BV = 2 * 64 * MLA_STRIDE, MLA_G = MLA_BV + 128 * MLA_STRIDE, MLA_SMEM = MLA_G + 6 * 128 * 4;
DEV void ph_ml_state(const Params& p, char* smem, int bid, int nb) {
  const int tid = tidx(), lane = tid & 63, wave = tid >> 6, fr = lane & 15, fq = lane >> 4;
  const float* gl = (const float*)(p.ws + WS_GL);
  const bf16_t* kT = (const bf16_t*)(p.ws + WS_KT); const bf16_t* vT = (const bf16_t*)(p.ws + WS_VT);
  float* UT = (float*)(p.ws + WS_UT); float* nvec = (float*)(p.ws + WS_NVEC); float* dec = (float*)(p.ws + WS_DEC);
  char* Aw = smem + MLA_AW; char* Bv = smem + MLA_BV;
  float* li_f = (float*)(smem + MLA_G); float* cf = li_f + 128; float* li_b = cf + 128; float* cb = li_b + 128; float* wf = cb + 128; float* wb = wf + 128;
  for (int it = 0, iters = (NTILE * 8 + nb - 1) / nb; it < iters; ++it) {
    int u = bid + it * nb; const bool active = u < NTILE * 8; if (!active) u = NTILE * 8 - 1;
    const int h = u % 8, c = u / 8, r0 = c * 128;
    __syncthreads();
    if (active) {
    ml_gate_scans(gl, r0, h, li_f, cf, li_b, cb);
    }
    __syncthreads();
    if (active) {
    if (tid < 128) { wf[tid] = __expf(cf[127] - cf[tid] + li_f[tid]); wb[tid] = __expf(cb[0] - cb[tid] + li_b[tid]); }
    if (tid == 0) { dec[(c * 8 + h) * 2] = __expf(cf[127]); dec[(c * 8 + h) * 2 + 1] = __expf(cb[0]); }
#pragma unroll
    for (int i = 0; i < 8; ++i) {
      const int f = tid + 256 * i, e = f >> 4, pc = f & 15;
      *(u32x4*)(Bv + e * MLA_STRIDE + pc * 16) = *(const u32x4*)(vT + (size_t)(h * 128 + e) * T + r0 + pc * 8);
    }
    }
    __syncthreads();
    if (active) {
#pragma unroll
    for (int i = 0; i < 4; ++i) {
      const int f = tid + 256 * i, d = f >> 4, pc = f & 15;
      const u32x4 kv = *(const u32x4*)(kT + (size_t)(h * 64 + d) * T + r0 + pc * 8);
      float k8[8] = {bflo(kv.x), bfhi(kv.x), bflo(kv.y), bfhi(kv.y), bflo(kv.z), bfhi(kv.z), bflo(kv.w), bfhi(kv.w)};
      u32x4 of, ob;
      of.x = pk2(k8[0] * wf[pc * 8 + 0], k8[1] * wf[pc * 8 + 1]); of.y = pk2(k8[2] * wf[pc * 8 + 2], k8[3] * wf[pc * 8 + 3]);
      of.z = pk2(k8[4] * wf[pc * 8 + 4], k8[5] * wf[pc * 8 + 5]); of.w = pk2(k8[6] * wf[pc * 8 + 6], k8[7] * wf[pc * 8 + 7]);
      ob.x = pk2(k8[0] * wb[pc * 8 + 0], k8[1] * wb[pc * 8 + 1]); ob.y = pk2(k8[2] * wb[pc * 8 + 2], k8[3] * wb[pc * 8 + 3]);
      ob.z = pk2(k8[4] * wb[pc * 8 + 4], k8[5] * wb[pc * 8 + 5]); ob.w = pk2(k8[6] * wb[pc * 8 + 6], k8[7] * wb[pc * 8 + 7]);
      *(u32x4*)(Aw + d * MLA_STRIDE + pc * 16) = of;
      *(u32x4*)(Aw + (64 + d) * MLA_STRIDE + pc * 16) = ob;
    }
    }
    __syncthreads();
    if (active) {
    if (tid < 128) {
      float s = 0.f;
      for (int pc = 0; pc < 16; ++pc) { const u32x4 v = *(const u32x4*)(Aw + tid * MLA_STRIDE + pc * 16);
        s += (bflo(v.x) + bfhi(v.x)) + (bflo(v.y) + bfhi(v.y)) + (bflo(v.z) + bfhi(v.z)) + (bflo(v.w) + bfhi(v.w)); }
      nvec[(size_t)((c * 8 + h) * 2 + (tid >> 6)) * 64 + (tid & 63)] = s;
    }
#pragma unroll
    for (int dir = 0; dir < 2; ++dir) {
      f32x4 acc[4][2];
#pragma unroll
      for (int m = 0; m < 4; ++m) { acc[m][0] = (f32x4){0.f, 0.f, 0.f, 0.f}; acc[m][1] = (f32x4){0.f, 0.f, 0.f, 0.f}; }
#pragma unroll
      for (int ks = 0; ks < 4; ++ks) {
        bf16x8 b[2];
#pragma unroll
        for (int n = 0; n < 2; ++n) b[n] = *(const bf16x8*)(Bv + (wave * 32 + n * 16 + fr) * MLA_STRIDE + (ks * 32 + fq * 8) * 2);
#pragma unroll
        for (int m = 0; m < 4; ++m) {
          const bf16x8 a = *(const bf16x8*)(Aw + (dir * 64 + m * 16 + fr) * MLA_STRIDE + (ks * 32 + fq * 8) * 2);
          acc[m][0] = __builtin_amdgcn_mfma_f32_16x16x32_bf16(a, b[0], acc[m][0], 0, 0, 0);
          acc[m][1] = __builtin_amdgcn_mfma_f32_16x16x32_bf16(a, b[1], acc[m][1], 0, 0, 0);
        }
      }
      float* Uo = UT + (size_t)((c * 8 + h) * 2 + dir) * 8192;
#pragma unroll
      for (int m = 0; m < 4; ++m)
#pragma unroll
        for (int n = 0; n < 2; ++n) *(f32x4*)(Uo + (wave * 32 + n * 16 + fr) * 64 + m * 16 + fq * 4) = acc[m][n];
    }
    }
  }
}

DEV void ph_ml_chain(const Params& p, int bid, int nb) {
  float* UT = (float*)(p.ws + WS_UT); float* nvec = (float*)(p.ws + WS_NVEC); const float* dec = (const float*)(p.ws + WS_DEC);
  const int total = 16 * (8192 + 64);
  for (int i = bid * 256 + tidx(); i < total; i += nb * 256) {
    const int hd = i / 8256, idx = i % 8256;
    const int dir = hd & 1;
    float* base = idx < 8192 ? UT + (size_t)hd * 8192 + idx : nvec + (size_t)hd * 64 + (idx - 8192);
    const size_t cstride = idx < 8192 ? (size_t)16 * 8192 : (size_t)16 * 64;
    float st = 0.f;
#pragma unroll 1
    for (int sb = 0; sb < NTILE; sb += 13) {
      float uv[13], dc[13];
#pragma unroll
      for (int j = 0; j < 13; ++j) {
        const int s = sb + j; const int c = dir == 0 ? (s < 2 ? 128 + s : s - 2) : 129 - s;
        uv[j] = base[(size_t)c * cstride]; dc[j] = dec[c * 16 + hd];
      }
#pragma unroll
      for (int j = 0; j < 13; ++j) {
        const int s = sb + j; const int c = dir == 0 ? (s < 2 ? 128 + s : s - 2) : 129 - s;
        base[(size_t)c * cstride] = st;
        st = dc[j] * st + uv[j];
      }
    }
  }
}

constexpr int MLC_QS = 0;
constexpr int MLC_KS = 9216;
constexpr int MLC_Q2 = MLC_KS + 18432;
constexpr int MLC_BS = MLC_Q2 + 17408;
constexpr int MLC_G  = MLC_BS + 18432;
constexpr int MLC_SMEM = MLC_G + (4 * 128 + 6 * 64) * 4;
DEV void ph_ml_out(const Params& p, char* smem, int bid, int nb) {
  const int tid = tidx(), lane = tid & 63, wave = tid >> 6, fr = lane & 15, fq = lane >> 4;
  const float* gl = (const float*)(p.ws + WS_GL);
  const bf16_t* qb = (const bf16_t*)(p.ws + WS_Q); const bf16_t* kb = (const bf16_t*)(p.ws + WS_K); const bf16_t* vT = (const bf16_t*)(p.ws + WS_VT);
  const bf16_t* og = (const bf16_t*)(p.ws + WS_OG);
  const float* UT = (const float*)(p.ws + WS_UT); const float* nvec = (const float*)(p.ws + WS_NVEC);
  bf16_t* yA = (bf16_t*)(p.ws + WS_HA);
  const float* ng = p.in[30];
  char* Qs = smem + MLC_QS; char* Ks = smem + MLC_KS; char* Ps = Ks; char* Q2 = smem + MLC_Q2; char* Bs = smem + MLC_BS;
  float* li_f = (float*)(smem + MLC_G); float* cf = li_f + 128; float* li_b = cf + 128; float* cb = li_b + 128;
  float* qn = cb + 128; float* sfq = qn + 128; float* sbq = sfq + 64; float* nv = sbq + 64;
  for (int it = 0, iters = ((128 * 2 * 8) + nb - 1) / nb; it < iters; ++it) {
    int u = bid + it * nb; const bool active = u < (128 * 2 * 8); if (!active) u = (128 * 2 * 8) - 1;
    const int h = u % 8, th = (u / 8) & 1, c = u / 16, r0 = c * 128, rt = r0 + th * 64;
    __syncthreads();
    ml_gate_scans(gl, r0, h, li_f, cf, li_b, cb);
    if (tid >= 128) nv[tid - 128] = nvec[(size_t)((c * 8 + h) * 2 + ((tid - 128) >> 6)) * 64 + (tid & 63)];
#pragma unroll
    for (int i = 0; i < 2; ++i) { const int f = tid + 256 * i, r = f >> 3, pc = f & 7;
      *(u32x4*)(Qs + r * 144 + pc * 16) = *(const u32x4*)(qb + (size_t)(rt + r) * 512 + h * 64 + pc * 8); }
#pragma unroll
    for (int i = 0; i < 4; ++i) { const int f = tid + 256 * i, r = f >> 3, pc = f & 7;
      *(u32x4*)(Ks + r * 144 + pc * 16) = *(const u32x4*)(kb + (size_t)(r0 + r) * 512 + h * 64 + pc * 8); }
    __syncthreads();
    if (tid < 128) {
      const int t = tid & 63, dir = tid >> 6; float s = 0.f;
      for (int pc = 0; pc < 8; ++pc) { const u32x4 v = *(const u32x4*)(Qs + t * 144 + pc * 16); const float* nn = nv + dir * 64 + pc * 8;
        s += bflo(v.x) * nn[0] + bfhi(v.x) * nn[1] + bflo(v.y) * nn[2] + bfhi(v.y) * nn[3] + bflo(v.z) * nn[4] + bfhi(v.z) * nn[5] + bflo(v.w) * nn[6] + bfhi(v.w) * nn[7]; }
      qn[dir * 64 + t] = s;
    }
    f32x4 S[8];
#pragma unroll
    for (int n = 0; n < 8; ++n) S[n] = (f32x4){0.f, 0.f, 0.f, 0.f};
#pragma unroll
    for (int ks = 0; ks < 2; ++ks) {
      const bf16x8 a = *(const bf16x8*)(Qs + (wave * 16 + fr) * 144 + (ks * 32 + fq * 8) * 2);
#pragma unroll
      for (int n = 0; n < 8; ++n) {
        const bf16x8 b = *(const bf16x8*)(Ks + (n * 16 + fr) * 144 + (ks * 32 + fq * 8) * 2);
        S[n] = __builtin_amdgcn_mfma_f32_16x16x32_bf16(a, b, S[n], 0, 0, 0);
      }
    }
    __syncthreads();
    float rfv[4], rbv[4];
    {
      float sumf[4] = {0.f, 0.f, 0.f, 0.f}, sumb[4] = {0.f, 0.f, 0.f, 0.f};
      float Sf[8][4], Sb_[8][4];
#pragma unroll
      for (int j = 0; j < 4; ++j) {
        const int tl = wave * 16 + fq * 4 + j, tc = th * 64 + tl;
        const float cft = cf[tc], cbt = cb[tc];
#pragma unroll
        for (int n = 0; n < 8; ++n) {
          const int s = n * 16 + fr;
          const float df = s <= tc ? fexp_(cft - cf[s] + li_f[s]) : 0.f;
          const float db = s >= tc ? fexp_(cbt - cb[s] + li_b[s]) : 0.f;
          Sf[n][j] = S[n][j] * df; Sb_[n][j] = S[n][j] * db;
          sumf[j] += Sf[n][j]; sumb[j] += Sb_[n][j];
        }
      }
#pragma unroll
      for (int j = 0; j < 4; ++j) {
#pragma unroll
        for (int o = 1; o < 16; o <<= 1) { sumf[j] += __shfl_xor(sumf[j], o); sumb[j] += __shfl_xor(sumb[j], o); }
        const int tl = wave * 16 + fq * 4 + j, tc = th * 64 + tl;
        const float ef = __expf(cf[tc]), eb = __expf(cb[tc]);
        const float denf = ef * qn[tl] + sumf[j], denb = eb * qn[64 + tl] + sumb[j];
        rfv[j] = __builtin_amdgcn_rcpf(fmaxf(fabsf(denf), 1.f)); rbv[j] = __builtin_amdgcn_rcpf(fmaxf(fabsf(denb), 1.f));
        if (fr == 0) { sfq[tl] = ef * rfv[j]; sbq[tl] = eb * rbv[j]; }
      }
#pragma unroll
      for (int n = 0; n < 8; ++n)
#pragma unroll
        for (int j = 0; j < 4; ++j) {
          const int tl = wave * 16 + fq * 4 + j;
          *(bf16_t*)(Ps + tl * MLA_STRIDE + (n * 16 + fr) * 2) = f2bf(Sf[n][j] * rfv[j] + Sb_[n][j] * rbv[j]);
        }
    }
    __syncthreads();
#pragma unroll
    for (int i = 0; i < 2; ++i) { const int f = tid + 256 * i, r = f >> 3, pc = f & 7;
      const u32x4 v = *(const u32x4*)(Qs + r * 144 + pc * 16); const float a = sfq[r], b = sbq[r];
      u32x4 o1, o2;
      o1.x = pk2(bflo(v.x) * a, bfhi(v.x) * a); o1.y = pk2(bflo(v.y) * a, bfhi(v.y) * a); o1.z = pk2(bflo(v.z) * a, bfhi(v.z) * a); o1.w = pk2(bflo(v.w) * a, bfhi(v.w) * a);
      o2.x = pk2(bflo(v.x) * b, bfhi(v.x) * b); o2.y = pk2(bflo(v.y) * b, bfhi(v.y) * b); o2.z = pk2(bflo(v.z) * b, bfhi(v.z) * b); o2.w = pk2(bflo(v.w) * b, bfhi(v.w) * b);
      *(u32x4*)(Q2 + r * MLA_STRIDE + pc * 16) = o1; *(u32x4*)(Q2 + r * MLA_STRIDE + 128 + pc * 16) = o2; }
    f32x4 Hh[8];
#pragma unroll
    for (int n = 0; n < 8; ++n) Hh[n] = (f32x4){0.f, 0.f, 0.f, 0.f};
#pragma unroll
    for (int kc = 0; kc < 4; ++kc) {
      __syncthreads();
      if (kc < 2) {
#pragma unroll
        for (int i = 0; i < 4; ++i) { const int f = tid + 256 * i, e = f >> 3, pc = f & 7;
          *(u32x4*)(Bs + e * 144 + pc * 16) = *(const u32x4*)(vT + (size_t)(h * 128 + e) * T + r0 + kc * 64 + pc * 8); }
      } else {
        const float* Cs = UT + (size_t)((c * 8 + h) * 2 + (kc - 2)) * 8192;
#pragma unroll
        for (int i = 0; i < 4; ++i) { const int f = tid + 256 * i, e = f >> 3, pc = f & 7;
          const f32x4 a = *(const f32x4*)(Cs + e * 64 + pc * 8), b = *(const f32x4*)(Cs + e * 64 + pc * 8 + 4);
          u32x4 o; o.x = pk2(a.x, a.y); o.y = pk2(a.z, a.w); o.z = pk2(b.x, b.y); o.w = pk2(b.z, b.w);
          *(u32x4*)(Bs + e * 144 + pc * 16) = o; }
      }
      __syncthreads();
      const char* Asrc = kc < 2 ? Ps + kc * 128 : Q2 + (kc - 2) * 128;
#pragma unroll
      for (int ks = 0; ks < 2; ++ks) {
        const bf16x8 a = *(const bf16x8*)(Asrc + (wave * 16 + fr) * MLA_STRIDE + (ks * 32 + fq * 8) * 2);
#pragma unroll
        for (int n = 0; n < 8; ++n) {
          const bf16x8 b = *(const bf16x8*)(Bs + (n * 16 + fr) * 144 + (ks * 32 + fq * 8) * 2);
          Hh[n] = __builtin_amdgcn_mfma_f32_16x16x32_bf16(a, b, Hh[n], 0, 0, 0);
        }
      }
    }
#pragma unroll
    for (int j = 0; j < 4; ++j) {
      float ss = 0.f;
#pragma unroll
      for (int n = 0; n < 8; ++n) ss += Hh[n][j] * Hh[n][j];
#pragma unroll
      for (int o = 1; o < 16; o <<= 1) ss += __shfl_xor(ss, o);
      const float rstd = rsqrtf(ss * (1.f / 128.f) + EPS);
      const size_t row = (size_t)(rt + wave * 16 + fq * 4 + j);
#pragma unroll
      for (int n = 0; n < 8; ++n) {
        const int col = h * 128 + n * 16 + fr;
        yA[row * D + col] = f2bf(Hh[n][j] * rstd * ng[col] * bf2f(og[row * D + col]));
      }
    }
  }
}

constexpr int ML2_Q = 0, ML2_K = 18432, ML2_P = 0;
constexpr int ML2_VT = 36864;
constexpr int ML2_CT = ML2_VT + 34816;
constexpr int ML2_Q2 = ML2_CT + 34816;
constexpr int ML2_G  = ML2_Q2 + 34816;
constexpr int ML2_SMEM = ML2_G + (4 * 128 + 2 * 128 + 2 * 128 + 128) * 4;
DEV void ph_ml_out2(const Params& p, char* smem) {
  const int tid = tidf(), lane = tid & 63, wave = tid >> 6, fr = lane & 15, fq = lane >> 4;
  const float* gl = (const float*)(p.ws + WS_GL);
  const bf16_t* qb = (const bf16_t*)(p.ws + WS_Q); const bf16_t* kb = (const bf16_t*)(p.ws + WS_K); const bf16_t* vT = (const bf16_t*)(p.ws + WS_VT);
  const bf16_t* og = (const bf16_t*)(p.ws + WS_OG);
  const float* UT = (const float*)(p.ws + WS_UT); const float* nvec = (const float*)(p.ws + WS_NVEC);
  bf16_t* yA = (bf16_t*)(p.ws + WS_HA);
  const float* ng = p.in[30];
  char* Qs = smem + ML2_Q; char* Ks = smem + ML2_K; char* Ps = smem + ML2_P; char* VTs = smem + ML2_VT; char* CTs = smem + ML2_CT; char* Q2 = smem + ML2_Q2;
  float* li_f = (float*)(smem + ML2_G); float* cf = li_f + 128; float* li_b = cf + 128; float* cb = li_b + 128;
  float* qn = cb + 128; float* sfq = qn + 256; float* sbq = sfq + 128; float* nv = sbq + 128;
  for (int u = blockIdx.x; u < 128 * 8; u += gridDim.x) {
    const int h = u & 7, c = u >> 3, r0 = c * 128;
    __syncthreads();
    ml_gate_scans_t(gl, r0, h, li_f, cf, li_b, cb, tid);
    if (tid >= 128 && tid < 256) nv[tid - 128] = nvec[(size_t)((c * 8 + h) * 2 + ((tid - 128) >> 6)) * 64 + (tid & 63)];
#pragma unroll
    for (int i = 0; i < 2; ++i) { const int f = tid + 512 * i, r = f >> 3, pc = f & 7;
      *(u32x4*)(Qs + r * 144 + pc * 16) = *(const u32x4*)(qb + (size_t)(r0 + r) * 512 + h * 64 + pc * 8);
      *(u32x4*)(Ks + r * 144 + pc * 16) = *(const u32x4*)(kb + (size_t)(r0 + r) * 512 + h * 64 + pc * 8); }
    { u32x4 vreg[4];
#pragma unroll
      for (int i = 0; i < 4; ++i) { const int f = tid + 512 * i, e = f >> 4, pc = f & 15; vreg[i] = *(const u32x4*)(vT + (size_t)(h * 128 + e) * T + r0 + pc * 8); }
#pragma unroll
      for (int i = 0; i < 4; ++i) { const int f = tid + 512 * i, e = f >> 4, pc = f & 15; *(u32x4*)(VTs + e * MLA_STRIDE + pc * 16) = vreg[i]; } }
    __builtin_amdgcn_sched_barrier(0);
#pragma unroll
    for (int half = 0; half < 2; ++half) {
      f32x4 creg[4];
#pragma unroll
      for (int i = 0; i < 2; ++i) { const int f = tid + 512 * (half * 2 + i), dir = f >> 10, e = (f >> 3) & 127, pc = f & 7;
        const float* Cs = UT + (size_t)((c * 8 + h) * 2 + dir) * 8192 + e * 64 + pc * 8;
        creg[2 * i] = *(const f32x4*)Cs; creg[2 * i + 1] = *(const f32x4*)(Cs + 4); }
#pragma unroll
      for (int i = 0; i < 2; ++i) { const int f = tid + 512 * (half * 2 + i), dir = f >> 10, e = (f >> 3) & 127, pc = f & 7;
        u32x4 o; o.x = pk2(creg[2 * i].x, creg[2 * i].y); o.y = pk2(creg[2 * i].z, creg[2 * i].w); o.z = pk2(creg[2 * i + 1].x, creg[2 * i + 1].y); o.w = pk2(creg[2 * i + 1].z, creg[2 * i + 1].w);
        *(u32x4*)(CTs + e * MLA_STRIDE + dir * 128 + pc * 16) = o; }
      __builtin_amdgcn_sched_barrier(0);
    }
    __syncthreads();
    if (tid < 256) {
      const int t = tid & 127, dir = tid >> 7; float sm = 0.f;
      for (int pc = 0; pc < 8; ++pc) { const u32x4 v = *(const u32x4*)(Qs + t * 144 + pc * 16); const float* nn = nv + dir * 64 + pc * 8;
        sm += bflo(v.x) * nn[0] + bfhi(v.x) * nn[1] + bflo(v.y) * nn[2] + bfhi(v.y) * nn[3] + bflo(v.z) * nn[4] + bfhi(v.z) * nn[5] + bflo(v.w) * nn[6] + bfhi(v.w) * nn[7]; }
      qn[dir * 128 + t] = sm;
    }
    f32x4 S[8];
#pragma unroll
    for (int n = 0; n < 8; ++n) S[n] = (f32x4){0.f, 0.f, 0.f, 0.f};
#pragma unroll
    for (int ks = 0; ks < 2; ++ks) {
      const bf16x8 a = *(const bf16x8*)(Qs + (wave * 16 + fr) * 144 + (ks * 32 + fq * 8) * 2);
#pragma unroll
      for (int n = 0; n < 8; ++n) {
        const bf16x8 b = *(const bf16x8*)(Ks + (n * 16 + fr) * 144 + (ks * 32 + fq * 8) * 2);
        S[n] = __builtin_amdgcn_mfma_f32_16x16x32_bf16(a, b, S[n], 0, 0, 0);
      }
    }
    __syncthreads();
    {
      float sumf[4] = {0.f, 0.f, 0.f, 0.f}, sumb[4] = {0.f, 0.f, 0.f, 0.f};
      float Sb_[8][4];
#pragma unroll
      for (int j = 0; j < 4; ++j) {
        const int tc = wave * 16 + fq * 4 + j;
        const float cft = cf[tc], cbt = cb[tc];
#pragma unroll
        for (int n = 0; n < 8; ++n) {
          const int sx = n * 16 + fr;
          const float df = sx <= tc ? fexp_(cft - cf[sx] + li_f[sx]) : 0.f;
          const float db = sx >= tc ? fexp_(cbt - cb[sx] + li_b[sx]) : 0.f;
          Sb_[n][j] = S[n][j] * db; S[n][j] = S[n][j] * df;
          sumf[j] += S[n][j]; sumb[j] += Sb_[n][j];
        }
      }
#pragma unroll
      for (int j = 0; j < 4; ++j) {
#pragma unroll
        for (int o = 1; o < 16; o <<= 1) { sumf[j] += __shfl_xor(sumf[j], o); sumb[j] += __shfl_xor(sumb[j], o); }
        const int tc = wave * 16 + fq * 4 + j;
        const float ef = __expf(cf[tc]), eb = __expf(cb[tc]);
        const float denf = ef * qn[tc] + sumf[j], denb = eb * qn[128 + tc] + sumb[j];
        const float rf = __builtin_amdgcn_rcpf(fmaxf(fabsf(denf), 1.f)), rb = __builtin_amdgcn_rcpf(fmaxf(fabsf(denb), 1.f));
        if (fr == 0) { sfq[tc] = ef * rf; sbq[tc] = eb * rb; }
#pragma unroll
        for (int n = 0; n < 8; ++n) S[n][j] = S[n][j] * rf + Sb_[n][j] * rb;
      }
    }
    __syncthreads();
#pragma unroll
    for (int i = 0; i < 2; ++i) { const int f = tid + 512 * i, r = f >> 3, pc = f & 7;
      const u32x4 v = *(const u32x4*)(Qs + r * 144 + pc * 16); const float a = sfq[r], b = sbq[r];
      u32x4 o1, o2;
      o1.x = pk2(bflo(v.x) * a, bfhi(v.x) * a); o1.y = pk2(bflo(v.y) * a, bfhi(v.y) * a); o1.z = pk2(bflo(v.z) * a, bfhi(v.z) * a); o1.w = pk2(bflo(v.w) * a, bfhi(v.w) * a);
      o2.x = pk2(bflo(v.x) * b, bfhi(v.x) * b); o2.y = pk2(bflo(v.y) * b, bfhi(v.y) * b); o2.z = pk2(bflo(v.z) * b, bfhi(v.z) * b); o2.w = pk2(bflo(v.w) * b, bfhi(v.w) * b);
      *(u32x4*)(Q2 + r * MLA_STRIDE + pc * 16) = o1; *(u32x4*)(Q2 + r * MLA_STRIDE + 128 + pc * 16) = o2; }
    __syncthreads();
#pragma unroll
    for (int n = 0; n < 8; ++n)
#pragma unroll
      for (int j = 0; j < 4; ++j) *(bf16_t*)(Ps + (wave * 16 + fq * 4 + j) * MLA_STRIDE + (n * 16 + fr) * 2) = f2bf(S[n][j]);
    __syncthreads();
    f32x4 Hh[8];
#pragma unroll
    for (int n = 0; n < 8; ++n) Hh[n] = (f32x4){0.f, 0.f, 0.f, 0.f};
#pragma unroll
    for (int ks = 0; ks < 8; ++ks) {
      const char* Asrc = ks < 4 ? Ps + ks * 64 : Q2 + (ks - 4) * 64;
      const char* Bsrc = ks < 4 ? VTs + ks * 64 : CTs + (ks - 4) * 64;
      const bf16x8 a = *(const bf16x8*)(Asrc + (wave * 16 + fr) * MLA_STRIDE + fq * 16);
#pragma unroll
      for (int n = 0; n < 8; ++n) {
        const bf16x8 b = *(const bf16x8*)(Bsrc + (n * 16 + fr) * MLA_STRIDE + fq * 16);
        Hh[n] = __builtin_amdgcn_mfma_f32_16x16x32_bf16(b, a, Hh[n], 0, 0, 0);
      }
    }
    {
      float ss = 0.f;
#pragma unroll
      for (int n = 0; n < 8; ++n) ss += Hh[n][0] * Hh[n][0] + Hh[n][1] * Hh[n][1] + Hh[n][2] * Hh[n][2] + Hh[n][3] * Hh[n][3];
      ss += __shfl_xor(ss, 16); ss += __shfl_xor(ss, 32);
      const float rstd = rsqrtf(ss * (1.f / 128.f) + EPS);
      const size_t row = (size_t)(r0 + wave * 16 + fr);
#pragma unroll
      for (int n = 0; n < 8; ++n) {
        const int col = h * 128 + n * 16 + 4 * fq;
        const f32x4 o4 = ld_bf4(og + row * D + col), g4 = *(const f32x4*)(ng + col);
        st_bf4(yA + row * D + col, Hh[n] * rstd * g4 * o4);
      }
    }
  }
  __syncthreads();
}

DEV void ph_final(const Params& p, int bid, int nb) {
  const int lane = tidx() & 63, wave = tidx() >> 6;
  const float* mods1 = (const float*)(p.ws + WS_MODS) + 2 * 6144;
  const bf16_t* x1 = (const bf16_t*)(p.ws + WS_X1);
  const bf16_t* Y = (const bf16_t*)(p.ws + WS_Y); const int* pos = (const int*)(p.ws + WS_POS);
  const float* gf = p.in[39];
  for (int t0 = (bid * 4 + wave) * 2; t0 < NL; t0 += nb * 8) {
    f32x4 xv[2][4]; u32x2 ya[2][4], yb[2][4];
#pragma unroll
    for (int q = 0; q < 2; ++q) {
      const int t = t0 + q;
      const bf16_t* Ya = Y + (size_t)pos[2 * t] * D; const bf16_t* Yb = Y + (size_t)pos[2 * t + 1] * D;
#pragma unroll
      for (int i = 0; i < 4; ++i) { const int c = 4 * lane + 256 * i; xv[q][i] = ld_bf4(x1 + (size_t)t * D + c); ya[q][i] = *(const u32x2*)(Ya + c); yb[q][i] = *(const u32x2*)(Yb + c); }
    }
#pragma unroll
    for (int q = 0; q < 2; ++q) {
      const int t = t0 + q;
      float ss = 0.f;
#pragma unroll
      for (int i = 0; i < 4; ++i) {
        const int c = 4 * lane + 256 * i;
        const f32x4 gt = *(const f32x4*)(mods1 + 5120 + c);
        f32x4 f; f.x = bflo(ya[q][i].x) + bflo(yb[q][i].x); f.y = bfhi(ya[q][i].x) + bfhi(yb[q][i].x); f.z = bflo(ya[q][i].y) + bflo(yb[q][i].y); f.w = bfhi(ya[q][i].y) + bfhi(yb[q][i].y);
        xv[q][i] = xv[q][i] + gt * f;
        ss += xv[q][i].x * xv[q][i].x + xv[q][i].y * xv[q][i].y + xv[q][i].z * xv[q][i].z + xv[q][i].w * xv[q][i].w;
      }
      const float rstd = rsqrtf(wave_sum(ss) * (1.f / D) + EPS);
#pragma unroll
      for (int i = 0; i < 4; ++i) {
        const int c = 4 * lane + 256 * i;
        *(f32x4*)(p.out + (size_t)t * D + c) = xv[q][i] * rstd * *(const f32x4*)(gf + c);
      }
    }
  }
}

#define XB_TMO      128
#define XB_XCNT(j)  (256  + 64 * (j))
#define XB_XSUB(j)  (1280 + 64 * (j))
#define XB_XGEN(j)  (2304 + 64 * (j))
#define XB_TOP      3328
#define XB_TOPGEN   3392
#define XCD_BAR_WORDS 3456
#define XB_SPIN_CAP (1u << 22)
DEV unsigned xb_ld(unsigned* p)              { return __hip_atomic_load(p, __ATOMIC_RELAXED, __HIP_MEMORY_SCOPE_AGENT); }
DEV unsigned xb_add(unsigned* p, unsigned v) { return __hip_atomic_fetch_add(p, v, __ATOMIC_RELAXED, __HIP_MEMORY_SCOPE_AGENT); }
DEV unsigned xb_xcc_id() { return (unsigned)__builtin_amdgcn_s_getreg((3 << 11) | 20) & 0xFu; }
#define XB_SPIN(cond, bar) do { unsigned _sp = 0; while (cond) { __builtin_amdgcn_s_sleep(1); \
    if ((++_sp & 255u) == 0u) { if (xb_ld(&(bar)[XB_TMO])) break; if (_sp > XB_SPIN_CAP) { atomicAdd(&(bar)[XB_TMO], 1u); break; } } } } while (0)
struct XcdBarrier { unsigned* bar; unsigned x; volatile LAS unsigned* st; };
DEV XcdBarrier xcd_barrier_post(unsigned* bar, volatile LAS unsigned* st) {
  XcdBarrier b; b.bar = bar; b.x = xb_xcc_id(); b.st = st;
  if (threadIdx.x == 0) (void)xb_add(&bar[XB_XCNT(b.x)], 1u);
  return b;
}
DEV void xcd_barrier_complete(unsigned* bar, unsigned x, unsigned& nloc, unsigned& nx) {
  const unsigned G = gridDim.x * gridDim.y * gridDim.z;
  unsigned sum, cnt, mine, sp = 0u;
  for (;;) {
    sum = 0u; cnt = 0u; mine = 0u;
#pragma unroll
    for (unsigned j = 0; j < 16; ++j) { const unsigned c = xb_ld(&bar[XB_XCNT(j)]); sum += c; cnt += (c > 0u) ? 1u : 0u; mine = (j == x) ? c : mine; }
    if (sum == G) break;
    __builtin_amdgcn_s_sleep(1);
    if ((++sp & 255u) == 0u) { if (xb_ld(&bar[XB_TMO])) break; if (sp > XB_SPIN_CAP) { atomicAdd(&bar[XB_TMO], 1u); break; } }
  }
  nloc = mine > 0u ? mine : 1u; nx = cnt > 0u ? cnt : 1u;
}
DEV void xcd_barrier(const XcdBarrier& b) {
  asm volatile("s_waitcnt vmcnt(0)" ::: "memory");
  __syncthreads();
  if (threadIdx.x == 0) {
    unsigned* bar = b.bar;
    __builtin_amdgcn_s_waitcnt(0);
    unsigned nloc = b.st[0], nx = b.st[1];
    if (nloc == 0u) { xcd_barrier_complete(bar, b.x, nloc, nx); b.st[0] = nloc; b.st[1] = nx; }
    const unsigned old = xb_add(&bar[XB_XSUB(b.x)], 1u);
    const unsigned gen = old / nloc;
    if (old + 1u == (gen + 1u) * nloc) {
      __builtin_amdgcn_fence(__ATOMIC_RELEASE, "agent");
      asm volatile("s_waitcnt vmcnt(0)" ::: "memory");
      const unsigned og = xb_add(&bar[XB_TOP], 1u);
      const unsigned tg = og / nx;
      if (og + 1u == (tg + 1u) * nx) xb_add(&bar[XB_TOPGEN], 1u);
      else XB_SPIN(xb_ld(&bar[XB_TOPGEN]) == tg, bar);
      __builtin_amdgcn_fence(__ATOMIC_ACQUIRE, "agent");
      xb_add(&bar[XB_XGEN(b.x)], 1u);
      asm volatile("s_waitcnt vmcnt(0)" ::: "memory");
    } else {
      XB_SPIN(xb_ld(&bar[XB_XGEN(b.x)]) == gen, bar);
      __builtin_amdgcn_fence(__ATOMIC_ACQUIRE, "agent");
      asm volatile("s_waitcnt vmcnt(0)" ::: "memory");
    }
  }
  __syncthreads();
}

#ifndef REP_MASK
#define REP_MASK 0u
#endif
#ifndef PROBE_PH
#define PROBE_PH -1
#endif
#ifndef PROBE_M
#define PROBE_M 4
#endif
#ifndef XBAR
#define XBAR 0
#endif
constexpr int NPHASE = 22;
constexpr int HALF_SMEM = 78592;
constexpr int LDS_ST = 2 * HALF_SMEM;
constexpr int LDS_BYTES = LDS_ST + 16 + 32;
static_assert(RT_SMEM + 128 <= HALF_SMEM && RG_SMEM <= HALF_SMEM && MLA_SMEM <= HALF_SMEM && MLC_SMEM <= HALF_SMEM, "smem");
static_assert(ML2_SMEM <= LDS_ST && LDS_TB + 66 * 4 <= LDS_ST && 8 * 8448 <= LDS_ST, "smem");

template <int PH>
DEV void run_phase(const Params& p, char* smem) {
  int half = threadIdx.x; asm volatile("" : "+v"(half)); half = __builtin_amdgcn_readfirstlane(half >> 8);
  char* hs = smem + half * HALF_SMEM;
  const int vb = blockIdx.x * 2 + half, nvb = gridDim.x * 2;
  if constexpr (PH == 0) { ph_adaln(p, hs, vb, nvb); __syncthreads(); ph_convert_dense(p, smem); ph_convert_moe<0>(p, smem); }
  else if constexpr (PH == 1) ph_norm0(p, vb, nvb);
  else if constexpr (PH == 2) ph_gemm_dense<0>(p, smem);
  else if constexpr (PH == 3) ph_rg_scan2(p, smem);
  else if constexpr (PH == 4) ph_rg_carry(p, hs, vb, nvb);
  else if constexpr (PH == 5) ph_rg_final(p, vb, nvb);
  else if constexpr (PH == 6) { ph_out0_ctx(p, smem); ph_gemm_dense<1>(p, smem); }
  else if constexpr (PH == 7) ph_router2<0>(p, smem);
  else if constexpr (PH == 8) ph_scatter2<0>(p, smem);
  else if constexpr (PH == 9) ph_gemm_moe<0, 0>(p, smem);
  else if constexpr (PH == 10) ph_gemm_moe<0, 1>(p, smem);
  else if constexpr (PH == 11) { ph_combine0(p, vb, nvb); __syncthreads(); conv_queue_l1(p, smem, -1); }
  else if constexpr (PH == 12) { ph_mlin_small(p, smem); ph_gemm_dense<2>(p, smem); }
  else if constexpr (PH == 13) ph_ml_state(p, hs, vb, nvb);
  else if constexpr (PH == 14) ph_ml_chain(p, vb, nvb);
  else if constexpr (PH == 15) ph_ml_out2(p, smem);
  else if constexpr (PH == 16) ph_gemm_dense<3>(p, smem);
  else if constexpr (PH == 17) ph_router2<1>(p, smem);
  else if constexpr (PH == 18) ph_scatter2<1>(p, smem);
  else if constexpr (PH == 19) ph_gemm_moe<1, 0>(p, smem);
  else if constexpr (PH == 20) ph_gemm_moe<1, 1>(p, smem);
  else if constexpr (PH == 21) ph_final(p, vb, nvb);
}

template <int PH>
DEV void run_from(const Params& p, char* smem) {
  run_phase<PH>(p, smem);
  if constexpr ((REP_MASK >> PH) & 1u) {
    __syncthreads();
    run_phase<PH>(p, smem);
  }
  if constexpr (XBAR > 0 && PH + 1 < NPHASE) {
#pragma unroll 1
    for (int xi = 0; xi < XBAR; ++xi) { XcdBarrier xb; xb.bar = (unsigned*)(p.ws + WS_BAR); xb.x = xb_xcc_id(); xb.st = (volatile LAS unsigned*)(LAS char*)(smem + LDS_ST); xcd_barrier(xb); }
  }
  if constexpr (PH + 1 < NPHASE) {
    XcdBarrier xb; xb.bar = (unsigned*)(p.ws + WS_BAR); xb.x = xb_xcc_id(); xb.st = (volatile LAS unsigned*)(LAS char*)(smem + LDS_ST);
    xcd_barrier(xb);
    if constexpr (PROBE_PH >= 0 && (PH == PROBE_PH || PH + 1 == PROBE_PH)) {
      if (blockIdx.x == 0 && threadIdx.x == 0) { volatile LAS unsigned long long* ts = (volatile LAS unsigned long long*)(LAS char*)(smem + LDS_ST + 16); ts[PH == PROBE_PH ? 1 : 0] = __builtin_amdgcn_s_memrealtime(); }
    }
    run_from<PH + 1>(p, smem);
  } else if constexpr (PROBE_PH >= 0) {
    if (blockIdx.x == 0 && threadIdx.x == 0) {
      volatile LAS unsigned long long* ts = (volatile LAS unsigned long long*)(LAS char*)(smem + LDS_ST + 16);
      const unsigned long long now = __builtin_amdgcn_s_memrealtime();
      const unsigned long long t1 = PROBE_PH == NPHASE - 1 ? now : ts[1];
      const unsigned long long span = (t1 - ts[0]) * PROBE_M;
      while (__builtin_amdgcn_s_memrealtime() - now < span) __builtin_amdgcn_s_sleep(8);
    }
  }
}

__global__ void __launch_bounds__(512) mega_kernel(Params p) {
  extern __shared__ __attribute__((aligned(16))) char smem[];
  volatile LAS unsigned* st = (volatile LAS unsigned*)(LAS char*)(smem + LDS_ST);
  if (threadIdx.x == 0) { st[0] = 0u; st[1] = 0u; st[2] = 0u; st[3] = 0u; }
  __syncthreads();
  (void)xcd_barrier_post((unsigned*)(p.ws + WS_BAR), st);
  if (PROBE_PH == 0 && blockIdx.x == 0 && threadIdx.x == 0) { volatile LAS unsigned long long* ts = (volatile LAS unsigned long long*)(LAS char*)(smem + LDS_ST + 16); ts[0] = __builtin_amdgcn_s_memrealtime(); }
  run_from<0>(p, smem);
}

extern "C" void kernel_launch(void* const* d_in, const int* in_sizes, int n_in, void* d_out, int out_size, void* d_ws, size_t ws_size, hipStream_t stream) {
  static int grid = 0;
  if (grid == 0) {
    if (n_in != 40 || ws_size < WS_END) { fprintf(stderr, "kernel_launch: unexpected inputs (n_in %d, ws %zu, need %zu)\n", n_in, ws_size, (size_t)WS_END); grid = -1; return; }
    int dev = 0, cus = 0, per_cu = 0;
    if (hipGetDevice(&dev) != hipSuccess || hipDeviceGetAttribute(&cus, hipDeviceAttributeMultiprocessorCount, dev) != hipSuccess) { grid = -1; return; }
    if (hipFuncSetAttribute((const void*)mega_kernel, hipFuncAttributeMaxDynamicSharedMemorySize, LDS_BYTES) != hipSuccess) { fprintf(stderr, "kernel_launch: hipFuncSetAttribute failed\n"); grid = -1; return; }
    if (hipOccupancyMaxActiveBlocksPerMultiprocessor(&per_cu, (const void*)mega_kernel, 512, LDS_BYTES) != hipSuccess || per_cu < 1) { fprintf(stderr, "kernel_launch: occupancy query failed (%d)\n", per_cu); grid = -1; return; }
    grid = cus;
    fprintf(stderr, "kernel_launch: %d CUs, occupancy %d\n", cus, per_cu);
  }
  if (grid < 0) return;
  Params p{};
  for (int i = 0; i < 40; ++i) p.in[i] = (const float*)d_in[i];
  p.out = (float*)d_out; p.ws = (char*)d_ws;
  if (hipMemsetAsync((char*)d_ws, 0, WS_ZERO_BYTES, stream) != hipSuccess) return;
  void* args[] = {&p};
  hipError_t e = hipLaunchCooperativeKernel((const void*)mega_kernel, dim3(grid), dim3(512), args, LDS_BYTES, stream);
  if (e != hipSuccess) fprintf(stderr, "cooperative launch failed: %s (grid %d)\n", hipGetErrorString(e), grid);
}
```
